# Optimizing an MI355X kernel written in HIP

```python
import math, functools
import jax, jax.numpy as jnp
from jax import lax
import numpy as np

D_MODEL = 2048
BATCH = 4
SEQ = 2048
DEPTH = 1
DEC_BATCH = 32
DEC_SEQ = 1
PAST_LEN = 8192
PAGE_SIZE = 128

HEAD_DIM = 64
C_MIX = D_MODEL
N_ATT_HEADS = C_MIX // (2 * HEAD_DIM)
N_RW_HEADS = C_MIX // (2 * HEAD_DIM)
C_ATT = N_ATT_HEADS * HEAD_DIM
C_RW = N_RW_HEADS * HEAD_DIM
DIL_WINDOWS = (128, 512, 2048)
DIL_RATES = (1, 4, 16)
MAX_WINDOW = max(DIL_WINDOWS)
Q_BLOCK = 128
ATT_SCALE = HEAD_DIM ** -0.5
W_LORA = 64
A_LORA = 64
G_LORA = 160
C_SHIFT = 3 * C_RW + W_LORA + A_LORA + G_LORA
C_IN = 3 * C_ATT + C_SHIFT
D_FF = 256 * ((8 * D_MODEL // 3 + 255) // 256)
CONV_W = 3
NORM_EPS = 1e-6
LNX_EPS = HEAD_DIM * 1e-5

kernel_name = "hybrid_dilated_attn_rwkv7_convffn_step"


def rms_norm(x, g, eps=NORM_EPS):
    xf = x.astype(jnp.float32)
    y = xf * lax.rsqrt(jnp.mean(xf * xf, axis=-1, keepdims=True) + eps)
    return (y * g.astype(jnp.float32)).astype(x.dtype)


def _softmax_av(s, vals, spec):
    m = jnp.max(s, axis=-1, keepdims=True)
    e = jnp.exp(s - m)
    den = jnp.sum(e, axis=-1, keepdims=True)
    o = jnp.einsum(spec, e / den, vals.astype(jnp.float32))
    return o, (m + jnp.log(den))[..., 0]


def _mix_branches(outs, lses):
    wts = jax.nn.softmax(jnp.stack(lses, 0), axis=0)
    return jnp.einsum('nbth,nbthe->bthe', wts, jnp.stack(outs, 0))


def _dilated_branch_prompt(q, k, v, rate, n_back):
    B, S, H, E = q.shape
    L = S // rate
    qb = math.gcd(L, Q_BLOCK)
    nblk = L // qb
    qr = q.reshape(B, nblk, qb, rate, H, E)
    pad = ((0, 0), (n_back, 0), (0, 0), (0, 0), (0, 0))
    kp = jnp.pad(k.reshape(B, L, rate, H, E), pad)
    vp = jnp.pad(v.reshape(B, L, rate, H, E), pad)
    idx = jnp.arange(nblk)[:, None] * qb + jnp.arange(qb + n_back)[None, :]
    kb = kp[:, idx]
    vb = vp[:, idx]
    s = jnp.einsum('bnqrhe,bnkrhe->bnrhqk', qr, kb, preferred_element_type=jnp.float32) * ATT_SCALE
    i = jnp.arange(qb)[:, None]
    c = jnp.arange(qb + n_back)[None, :]
    blk = jnp.arange(nblk)[:, None, None]
    mask = (c >= i) & (c <= i + n_back) & (blk * qb + c >= n_back)
    s = jnp.where(mask[None, :, None, None], s, -jnp.inf)
    o, lse = _softmax_av(s, vb, 'bnrhqk,bnkrhe->bnqrhe')
    o = o.reshape(B, S, H, E)
    lse = lse.transpose(0, 1, 4, 2, 3).reshape(B, S, H)
    return o, lse


def dilated_attention_prompt(q, k, v):
    outs, lses = [], []
    for win, rate in zip(DIL_WINDOWS, DIL_RATES):
        o, lse = _dilated_branch_prompt(q, k, v, rate, win // rate)
        outs.append(o)
        lses.append(lse)
    return _mix_branches(outs, lses).astype(q.dtype)


def dilated_attention_sample(q, k, v, k_cache, v_cache):
    T = q.shape[1]
    W = k_cache.shape[1]
    k_all = jnp.concatenate([k_cache.astype(k.dtype), k], axis=1)
    v_all = jnp.concatenate([v_cache.astype(v.dtype), v], axis=1)
    outs, lses = [], []
    for win, rate in zip(DIL_WINDOWS, DIL_RATES):
        n_back = win // rate
        idx = W + jnp.arange(T)[:, None] - rate * jnp.arange(n_back + 1)[None, :]
        valid = idx >= 0
        idx = jnp.maximum(idx, 0)
        kg = k_all[:, idx]
        vg = v_all[:, idx]
        s = jnp.einsum('bthe,btkhe->bhtk', q, kg, preferred_element_type=jnp.float32) * ATT_SCALE
        s = jnp.where(valid[None, None], s, -jnp.inf)
        o, lse = _softmax_av(s, vg, 'bhtk,btkhe->bthe')
        outs.append(o)
        lses.append(lse.transpose(0, 2, 1))
    return _mix_branches(outs, lses).astype(q.dtype)


def rwkv7_group(cols, prev_cols, wkv0, rw_mu, rw_w0, rw_w_up, rw_a0, rw_a_up, rw_g_up,
                rw_k_k, rw_k_a, rw_r_k, rw_lnx_w, rw_lnx_b):
    f32 = jnp.float32
    B, T, _ = cols.shape
    H, E = N_RW_HEADS, HEAD_DIM
    shifted = jnp.concatenate([prev_cols.astype(cols.dtype), cols[:, :-1]], axis=1)
    xs = cols + rw_mu * (shifted - cols)
    r, k, v, wd, ad, gd = jnp.split(
        xs, [C_RW, 2 * C_RW, 3 * C_RW, 3 * C_RW + W_LORA, 3 * C_RW + W_LORA + A_LORA], axis=-1)
    w = -jax.nn.softplus(-(rw_w0 + jnp.tanh(wd) @ rw_w_up).astype(f32)) - 0.5
    decay = jnp.exp(-jnp.exp(w)).reshape(B, T, H, E)
    a = jax.nn.sigmoid((rw_a0 + ad @ rw_a_up).astype(f32)).reshape(B, T, H, E)
    g = jax.nn.sigmoid(gd) @ rw_g_up
    hs = lambda t: t.astype(f32).reshape(B, T, H, E)
    kh, rh, vh = hs(k), hs(r), hs(v)
    kk = kh * rw_k_k.astype(f32).reshape(H, E)
    kk = kk / jnp.maximum(jnp.linalg.norm(kk, axis=-1, keepdims=True), 1e-12)
    k_eff = kh * (1.0 + (a - 1.0) * rw_k_a.astype(f32).reshape(H, E))
    a_vec = -kk
    b_vec = kk * a

    def step(S, inp):
        rt, wt, kt, vt, at, bt = inp
        sa = jnp.einsum('bhij,bhj->bhi', S, at)
        S = S * wt[:, :, None, :] + sa[..., None] * bt[:, :, None, :] + vt[..., None] * kt[:, :, None, :]
        return S, jnp.einsum('bhij,bhj->bhi', S, rt)

    tm = lambda t: jnp.moveaxis(t, 1, 0)
    S_T, ys = lax.scan(step, wkv0.astype(f32), (tm(rh), tm(decay), tm(k_eff), tm(vh), tm(a_vec), tm(b_vec)))
    y = jnp.moveaxis(ys, 0, 1)
    mean = jnp.mean(y, axis=-1, keepdims=True)
    var = jnp.mean(jnp.square(y - mean), axis=-1, keepdims=True)
    yn = (y - mean) * lax.rsqrt(var + LNX_EPS) * rw_lnx_w.astype(f32).reshape(H, E) + rw_lnx_b.astype(f32).reshape(H, E)
    bonus = jnp.sum(rh * k_eff * rw_r_k.astype(f32).reshape(H, E), axis=-1, keepdims=True) * vh
    out = (yn + bonus).reshape(B, T, C_RW).astype(cols.dtype) * g
    return out, cols[:, -1:], S_T


def decoder_layer(x, attend, rw_prev, wkv0, ffn_prev, norm_mix_g, w_in, att_out_g, rw_mu, rw_w0, rw_w_up,
                  rw_a0, rw_a_up, rw_g_up, rw_k_k, rw_k_a, rw_r_k, rw_lnx_w, rw_lnx_b, w_o,
                  norm_ffn_g, ffn_w_up, ffn_conv_w, ffn_conv_b, ffn_w_down):
    B, T, _ = x.shape
    H, E = N_ATT_HEADS, HEAD_DIM
    h = rms_norm(x, norm_mix_g)
    p = h @ w_in
    q = p[..., :C_ATT].reshape(B, T, H, E)
    k = p[..., C_ATT:2 * C_ATT].reshape(B, T, H, E)
    v = p[..., 2 * C_ATT:3 * C_ATT].reshape(B, T, H, E)
    o_att = attend(q, k, v)
    o_att = rms_norm(o_att, att_out_g.reshape(H, E)).reshape(B, T, C_ATT)
    o_rw, rw_last, wkv_T = rwkv7_group(p[..., 3 * C_ATT:], rw_prev, wkv0, rw_mu, rw_w0, rw_w_up, rw_a0,
                                       rw_a_up, rw_g_up, rw_k_k, rw_k_a, rw_r_k, rw_lnx_w, rw_lnx_b)
    x = x + jnp.concatenate([o_att, o_rw], axis=-1) @ w_o
    h2 = rms_norm(x, norm_ffn_g)
    u = h2 @ ffn_w_up
    up = jnp.concatenate([ffn_prev.astype(u.dtype), u], axis=1)
    c = ffn_conv_b + sum(ffn_conv_w[j] * up[:, j:j + T] for j in range(CONV_W))
    gate, val = jnp.split(c, 2, axis=-1)
    x = x + (jax.nn.silu(gate) * val) @ ffn_w_down
    return x, k, v, rw_last, wkv_T, up[:, -(CONV_W - 1):]


def setup_inputs(seed: int = 0) -> dict:
    key = jax.random.key(seed)
    ks = jax.random.split(key, 28)
    win_buf = min(MAX_WINDOW, PAST_LEN)
    nrm = lambda kk, shape, scale=1.0: scale * jax.random.normal(kk, shape, jnp.float32)
    L = DEPTH
    return {
        "x_prompt": nrm(ks[0], (BATCH, SEQ, D_MODEL)),
        "x_sample": nrm(ks[1], (DEC_BATCH, DEC_SEQ, D_MODEL)),
        "cache_att_k": nrm(ks[2], (L, DEC_BATCH, win_buf, N_ATT_HEADS, HEAD_DIM)),
        "cache_att_v": nrm(ks[3], (L, DEC_BATCH, win_buf, N_ATT_HEADS, HEAD_DIM)),
        "state_rwkv_shift": nrm(ks[4], (L, DEC_BATCH, 1, C_SHIFT)),
        "state_rwkv_wkv": nrm(ks[5], (L, DEC_BATCH, N_RW_HEADS, HEAD_DIM, HEAD_DIM), 0.3),
        "state_ffn_conv": nrm(ks[6], (L, DEC_BATCH, CONV_W - 1, 2 * D_FF)),
        "norm_mix_g": 1.0 + nrm(ks[7], (L, D_MODEL), 0.02),
        "w_in": nrm(ks[8], (L, D_MODEL, C_IN), D_MODEL ** -0.5),
        "att_out_g": 1.0 + nrm(ks[9], (L, C_ATT), 0.02),
        "rw_mu": jax.random.uniform(ks[10], (L, C_SHIFT), jnp.float32),
        "rw_w0": jax.random.uniform(ks[11], (L, C_RW), jnp.float32, minval=-5.0, maxval=0.0),
        "rw_w_up": nrm(ks[12], (L, W_LORA, C_RW), 0.5 * W_LORA ** -0.5),
        "rw_a0": nrm(ks[13], (L, C_RW), 0.5),
        "rw_a_up": nrm(ks[14], (L, A_LORA, C_RW), A_LORA ** -0.5),
        "rw_g_up": nrm(ks[15], (L, G_LORA, C_RW), G_LORA ** -0.5),
        "rw_k_k": 0.85 + nrm(ks[16], (L, C_RW), 0.05),
        "rw_k_a": 1.0 + nrm(ks[17], (L, C_RW), 0.05),
        "rw_r_k": nrm(ks[18], (L, C_RW), 0.1),
        "rw_lnx_w": 1.0 + nrm(ks[19], (L, C_RW), 0.02),
        "rw_lnx_b": nrm(ks[20], (L, C_RW), 0.02),
        "w_o": nrm(ks[21], (L, C_MIX, D_MODEL), C_MIX ** -0.5),
        "norm_ffn_g": 1.0 + nrm(ks[22], (L, D_MODEL), 0.02),
        "ffn_w_up": nrm(ks[23], (L, D_MODEL, 2 * D_FF), D_MODEL ** -0.5),
        "ffn_conv_w": nrm(ks[24], (L, CONV_W, 2 * D_FF), CONV_W ** -0.5),
        "ffn_conv_b": nrm(ks[25], (L, 2 * D_FF), 0.02),
        "ffn_w_down": nrm(ks[26], (L, D_FF, D_MODEL), D_FF ** -0.5),
        "norm_final_g": 1.0 + nrm(ks[27], (D_MODEL,), 0.02),
    }


def reference(x_prompt, x_sample, cache_att_k, cache_att_v, state_rwkv_shift, state_rwkv_wkv, state_ffn_conv,
              norm_mix_g, w_in, att_out_g, rw_mu, rw_w0, rw_w_up, rw_a0, rw_a_up, rw_g_up, rw_k_k, rw_k_a,
              rw_r_k, rw_lnx_w, rw_lnx_b, w_o, norm_ffn_g, ffn_w_up, ffn_conv_w, ffn_conv_b, ffn_w_down,
              norm_final_g):
    B, S, _ = x_prompt.shape
    win_p = min(MAX_WINDOW, S)
    rw_prev_p = jnp.zeros((B, 1, C_SHIFT), x_prompt.dtype)
    wkv_p0 = jnp.zeros((B, N_RW_HEADS, HEAD_DIM, HEAD_DIM), jnp.float32)
    ffn_prev_p = jnp.zeros((B, CONV_W - 1, 2 * D_FF), x_prompt.dtype)
    xp, xs = x_prompt, x_sample
    pk, pv, prw, pwkv, pffn = [], [], [], [], []
    sk, sv, srw, swkv, sffn = [], [], [], [], []
    for l in range(DEPTH):
        lp = dict(norm_mix_g=norm_mix_g[l], w_in=w_in[l], att_out_g=att_out_g[l], rw_mu=rw_mu[l],
                  rw_w0=rw_w0[l], rw_w_up=rw_w_up[l], rw_a0=rw_a0[l], rw_a_up=rw_a_up[l], rw_g_up=rw_g_up[l],
                  rw_k_k=rw_k_k[l], rw_k_a=rw_k_a[l], rw_r_k=rw_r_k[l], rw_lnx_w=rw_lnx_w[l],
                  rw_lnx_b=rw_lnx_b[l], w_o=w_o[l], norm_ffn_g=norm_ffn_g[l], ffn_w_up=ffn_w_up[l],
                  ffn_conv_w=ffn_conv_w[l], ffn_conv_b=ffn_conv_b[l], ffn_w_down=ffn_w_down[l])
        xp, kp_, vp_, rwp, wkvp, ffp = decoder_layer(xp, dilated_attention_prompt, rw_prev_p, wkv_p0,
                                                     ffn_prev_p, **lp)
        attend_s = functools.partial(dilated_attention_sample, k_cache=cache_att_k[l], v_cache=cache_att_v[l])
        xs, ks_, vs_, rws, wkvs, ffs = decoder_layer(xs, attend_s, state_rwkv_shift[l], state_rwkv_wkv[l],
                                                     state_ffn_conv[l], **lp)
        pk.append(kp_[:, -win_p:]); pv.append(vp_[:, -win_p:]); prw.append(rwp); pwkv.append(wkvp); pffn.append(ffp)
        sk.append(ks_); sv.append(vs_); srw.append(rws); swkv.append(wkvs); sffn.append(ffs)
    y_prompt = rms_norm(xp, norm_final_g)
    y_sample = rms_norm(xs, norm_final_g)
    return (y_prompt, y_sample,
            jnp.stack(pk), jnp.stack(pv), jnp.stack(prw), jnp.stack(pwkv), jnp.stack(pffn),
            jnp.stack(sk), jnp.stack(sv), jnp.stack(srw), jnp.stack(swkv), jnp.stack(sffn))
```

```cpp
#include <hip/hip_runtime.h>
#include <hip/hip_cooperative_groups.h>
#include <cstdio>
#include <cstdint>
#include <cstring>
namespace cg = cooperative_groups;

#define DI __device__ __forceinline__
#define LAS __attribute__((address_space(3)))
typedef unsigned short bf16_t;
typedef short bf16x8 __attribute__((ext_vector_type(8)));
typedef float f32x4 __attribute__((ext_vector_type(4)));
typedef float f32x16 __attribute__((ext_vector_type(16)));
typedef unsigned u32x4 __attribute__((ext_vector_type(4)));
typedef unsigned u32x2 __attribute__((ext_vector_type(2)));

constexpr int D = 2048, MP = 8192, MS = 32, MT = 8224, MPAD = 8448, SEQ = 2048;
constexpr int CIN = 6432, NIN = 6656, CSH = 3360, FF2 = 11264, FF = 5632;
constexpr int NLO = 3072, KLO = 384;
constexpr int NS = 16, SEGL = 128, TB = 8;
constexpr int NTHREADS = 512, NWAVES = 8;
constexpr int LDS_BYTES = 131072 + 16384;

constexpr size_t O_YP = 0;
constexpr size_t O_YS = O_YP + (size_t)MP * D;
constexpr size_t O_PK = O_YS + (size_t)MS * D;
constexpr size_t O_PV = O_PK + (size_t)MP * 1024;
constexpr size_t O_PRW = O_PV + (size_t)MP * 1024;
constexpr size_t O_PWKV = O_PRW + (size_t)4 * CSH;
constexpr size_t O_PFFN = O_PWKV + (size_t)4 * 16 * 4096;
constexpr size_t O_SK = O_PFFN + (size_t)4 * 2 * FF2;
constexpr size_t O_SV = O_SK + (size_t)MS * 1024;
constexpr size_t O_SRW = O_SV + (size_t)MS * 1024;
constexpr size_t O_SWKV = O_SRW + (size_t)MS * CSH;
constexpr size_t O_SFFN = O_SWKV + (size_t)MS * 16 * 4096;
constexpr size_t O_END = O_SFFN + (size_t)MS * 2 * FF2;

constexpr size_t al256(size_t x) { return (x + 255) & ~(size_t)255; }
constexpr size_t WS_WIN = 0;
constexpr size_t WS_WO = WS_WIN + al256((size_t)NIN * D * 2);
constexpr size_t WS_WUP = WS_WO + al256((size_t)D * D * 2);
constexpr size_t WS_WDN = WS_WUP + al256((size_t)FF2 * D * 2);
constexpr size_t WS_WLO = WS_WDN + al256((size_t)D * FF * 2);
constexpr size_t WS_H = WS_WLO + al256((size_t)NLO * KLO * 2);
constexpr size_t WS_QB = WS_H + al256((size_t)MPAD * D * 2);
constexpr size_t WS_KB = WS_QB + al256((size_t)MPAD * 1024 * 2);
constexpr size_t WS_VB = WS_KB + al256((size_t)MPAD * 1024 * 2);
constexpr size_t WS_ALO = WS_VB + al256((size_t)MPAD * 1024 * 2);
constexpr size_t WS_O = WS_ALO + al256((size_t)MPAD * KLO * 2);
constexpr size_t WS_GB = WS_O + al256((size_t)MPAD * D * 2);
constexpr size_t WS_YL = WS_GB + al256((size_t)MT * 2048 * 4);
constexpr size_t WS_QS = WS_YL + al256((size_t)MP * 1024 * 4);
constexpr size_t WS_ZP = WS_QS + al256((size_t)MP * 1024 * 4);
constexpr size_t WS_SST = WS_ZP + al256((size_t)64 * NS * 2 * 4096 * 4);
constexpr size_t WS_X1 = WS_SST + al256((size_t)64 * NS * 4096 * 4);
constexpr size_t WS_PML = WS_X1 + al256((size_t)MPAD * D * 4);
constexpr size_t WS_RA = WS_PML + al256((size_t)3 * MP * 16 * 2 * 4);
constexpr size_t WS_RW = WS_RA;
constexpr size_t WS_L = WS_RW + al256((size_t)MPAD * CSH * 4);
constexpr size_t RA_BYTES_1 = al256((size_t)MPAD * CSH * 4) + al256((size_t)MPAD * NLO * 4);
constexpr size_t RA_BYTES_2 = al256((size_t)MPAD * FF2 * 2);
constexpr size_t WS_U = WS_RA;
constexpr size_t WS_RB = WS_RA + (RA_BYTES_1 > RA_BYTES_2 ? RA_BYTES_1 : RA_BYTES_2);
constexpr size_t WS_PART = WS_RB;
constexpr size_t WS_ACT = WS_RB;
constexpr size_t RB_BYTES_1 = al256((size_t)3 * MP * 1024 * 4);
constexpr size_t RB_BYTES_2 = al256((size_t)MPAD * FF * 2);
constexpr size_t WS_END = WS_RB + (RB_BYTES_1 > RB_BYTES_2 ? RB_BYTES_1 : RB_BYTES_2);

struct Args {
    const float* in[28];
    float* out;
    unsigned char* ws;
    int ph_lo, ph_hi;
};
enum { I_XP = 0, I_XS, I_CK, I_CV, I_SSH, I_SWKV, I_SFFN, I_NMG, I_WIN, I_AOG, I_MU, I_W0, I_WUP, I_A0, I_AUP, I_GUP,
       I_KK, I_KA, I_RK, I_LNW, I_LNB, I_WO, I_NFG, I_FUP, I_FCW, I_FCB, I_FDN, I_NFIN };

DI unsigned bf_rne(float f) { unsigned u = __float_as_uint(f); u += 0x7fffu + ((u >> 16) & 1u); return u >> 16; }
DI unsigned pk2(float lo, float hi) { return bf_rne(lo) | (bf_rne(hi) << 16); }
DI float bf2f(unsigned short b) { return __uint_as_float(((unsigned)b) << 16); }
DI float wave_sum(float v) {
#pragma unroll
    for (int o = 1; o < 64; o <<= 1) v += __shfl_xor(v, o);
    return v;
}

namespace pg8 {
constexpr int BM = 256, BK = 64, HALF = 128, HTB = HALF * BK * 2, STAGE_BYTES = 8 * HTB, NXCD = 8, WGM = 8;
DI int lds_byte(int r, int c) { const int st = (r >> 4) * 2 + (c >> 5), rr = r & 15, cc = c & 31, ob = rr * 64 + cc * 2; return st * 1024 + (ob ^ (((ob >> 9) & 1) << 5)); }
DI void stage_rc(int b, int& R, int& C) { const int st = b / 1024, sb = b % 1024, swz = sb ^ (((sb >> 9) & 1) << 5); R = (st >> 1) * 16 + swz / 64; C = (st & 1) * 32 + (swz % 64) / 2; }
struct Unit { int pm, pn; };
struct Gemm { const bf16_t* A; const bf16_t* Bt; int M, N, K; };
struct StaticOrder {
    int nM, nN, nwg, G, c;
    DI void init(int M, int N, int G_, int c_) { nM = M / BM; nN = N / BM; nwg = nM * nN; G = G_; c = c_; }
    DI bool next(int i, Unit& u) const {
        const long L = (long)i * G + c; if (L >= nwg) return false;
        int wgid = (int)L; { const int q = nwg / NXCD, r = nwg % NXCD, xcd = wgid % NXCD, off = wgid / NXCD; wgid = (xcd < r ? xcd * (q + 1) : r * (q + 1) + (xcd - r) * q) + off; }
        const int nig = WGM * nN, gid = wgid / nig, fm = gid * WGM, gsz = (nM - fm) < WGM ? (nM - fm) : WGM;
        u.pm = fm + ((wgid % nig) % gsz); u.pn = (wgid % nig) / gsz; return true;
    }
};

template <class Epi>
DI void gemm_phase(LAS unsigned char* lds, const Gemm g, const StaticOrder& S, const Epi& E) {
    const int tid = threadIdx.x, wid = __builtin_amdgcn_readfirstlane(tid >> 6), lane = tid & 63, wr = wid >> 2, wc = wid & 3, fr = lane & 15, fq = lane >> 4;
    const int K = g.K, nt = K / BK;
    unsigned voffA[2];
#pragma unroll
    for (int i = 0; i < 2; ++i) { int R, C; stage_rc(tid * 16 + i * 8192, R, C); voffA[i] = (unsigned)(R * K + C) * 2u; }
    const size_t kstep = (size_t)(BK * 2);
    const size_t hstep = (size_t)HALF * K * 2;
    const size_t tstep = 2 * hstep;
    const unsigned ldsw = (unsigned)wid * 1024u;
    const int aoff = lds_byte(wr * 64 + fr, fq * 8), boff = lds_byte(wc * 32 + fr, fq * 8);
#define PG8_SA(b, h) (((b) * 2 + (h)) * HTB)
#define PG8_SB(b, h) ((4 + (b) * 2 + (h)) * HTB)
#define PG8_STAGE(bufoff, gbase, voff) do { _Pragma("unroll") for (int _i = 0; _i < 2; ++_i) \
        __builtin_amdgcn_global_load_lds((const unsigned*)((const char*)(gbase) + (voff)[_i]), (LAS unsigned*)(lds + (bufoff) + ldsw + _i * 8192), 16, 0, 0); } while (0)
#define PG8_LDA(dst, b, h) do { _Pragma("unroll") for (int m = 0; m < 4; ++m) _Pragma("unroll") for (int k = 0; k < 2; ++k) dst[m][k] = *(const LAS bf16x8*)(lds + PG8_SA(b, h) + aoff + m * 2048 + k * 1024); } while (0)
#define PG8_LDB(dst, b, h) do { _Pragma("unroll") for (int n = 0; n < 2; ++n) _Pragma("unroll") for (int k = 0; k < 2; ++k) dst[n][k] = *(const LAS bf16x8*)(lds + PG8_SB(b, h) + boff + n * 2048 + k * 1024); } while (0)
#define PG8_MMA(ai, bj, At, Bt) do { __builtin_amdgcn_s_setprio(1); _Pragma("unroll") for (int m = 0; m < 4; ++m) _Pragma("unroll") for (int n = 0; n < 2; ++n) _Pragma("unroll") for (int k = 0; k < 2; ++k) \
        acc[ai][bj][m][n] = __builtin_amdgcn_mfma_f32_16x16x32_bf16(Bt[n][k], At[m][k], acc[ai][bj][m][n], 0, 0, 0); __builtin_amdgcn_s_setprio(0); } while (0)
#define PG8_WAIT_V(n) asm volatile("s_waitcnt vmcnt(" #n ")" ::: "memory")
#define PG8_WAIT_L(n) asm volatile("s_waitcnt lgkmcnt(" #n ")" ::: "memory")
#define PG8_BAR __builtin_amdgcn_s_barrier()
#define PG8_SCHED __builtin_amdgcn_sched_barrier(0)
    Unit cur, nxt; int ui = 0;
    if (!S.next(0, cur)) return;
    f32x4 acc[2][2][4][2];
#pragma unroll
    for (int a = 0; a < 2; ++a)
#pragma unroll
        for (int b = 0; b < 2; ++b)
#pragma unroll
            for (int m = 0; m < 4; ++m)
#pragma unroll
                for (int n = 0; n < 2; ++n) acc[a][b][m][n] = (f32x4){0.f, 0.f, 0.f, 0.f};
    bf16x8 At[4][2], B0[2][2], B1[2][2];
    const char* cA = (const char*)g.A + (size_t)cur.pm * tstep; const char* cB = (const char*)g.Bt + (size_t)cur.pn * tstep;
    PG8_STAGE(PG8_SB(0, 0), cB, voffA); PG8_STAGE(PG8_SA(0, 0), cA, voffA); PG8_STAGE(PG8_SB(0, 1), cB + hstep, voffA); PG8_STAGE(PG8_SA(0, 1), cA + hstep, voffA);
    if (wr == 1) PG8_BAR;
    PG8_WAIT_V(4); PG8_BAR;
    PG8_STAGE(PG8_SB(1, 0), cB + kstep, voffA); PG8_STAGE(PG8_SA(1, 0), cA + kstep, voffA); PG8_STAGE(PG8_SB(1, 1), cB + hstep + kstep, voffA);
    PG8_WAIT_V(6); PG8_BAR;
    for (;;) {
        const bool has_next = S.next(ui + 1, nxt);
        const char* nA = has_next ? (const char*)g.A + (size_t)nxt.pm * tstep : cA; const char* nB = has_next ? (const char*)g.Bt + (size_t)nxt.pn * tstep : cB;
        for (int t = 0; t < nt; t += 2) {
            const bool last = (t == nt - 2);
            const char* a1 = cA + (size_t)(t + 1) * kstep;
            const char* a2 = last ? nA : cA + (size_t)(t + 2) * kstep; const char* b2 = last ? nB : cB + (size_t)(t + 2) * kstep;
            const char* a3 = a2 + kstep; const char* b3 = b2 + kstep;
            PG8_LDB(B0, 0, 0); PG8_SCHED; PG8_LDA(At, 0, 0); PG8_STAGE(PG8_SA(1, 1), a1 + hstep, voffA);
            PG8_WAIT_L(8); PG8_BAR; PG8_WAIT_L(0); PG8_MMA(0, 0, At, B0); PG8_BAR; PG8_SCHED;
            PG8_LDB(B1, 0, 1); PG8_STAGE(PG8_SB(0, 0), b2, voffA);
            PG8_BAR; PG8_WAIT_L(0); PG8_MMA(0, 1, At, B1); PG8_BAR;
            PG8_LDA(At, 0, 1); PG8_STAGE(PG8_SA(0, 0), a2, voffA);
            PG8_BAR; PG8_WAIT_L(0); PG8_MMA(1, 0, At, B0); PG8_BAR; PG8_SCHED;
            PG8_STAGE(PG8_SB(0, 1), b2 + hstep, voffA);
            PG8_WAIT_V(6); PG8_BAR; PG8_MMA(1, 1, At, B1); PG8_BAR;
            PG8_LDB(B0, 1, 0); PG8_SCHED; PG8_LDA(At, 1, 0); PG8_STAGE(PG8_SA(0, 1), a2 + hstep, voffA);
            PG8_WAIT_L(8); PG8_BAR; PG8_WAIT_L(0); PG8_MMA(0, 0, At, B0); PG8_BAR; PG8_SCHED;
            PG8_LDB(B1, 1, 1); PG8_STAGE(PG8_SB(1, 0), b3, voffA);
            PG8_BAR; PG8_WAIT_L(0); PG8_MMA(0, 1, At, B1); PG8_BAR;
            PG8_LDA(At, 1, 1); PG8_STAGE(PG8_SA(1, 0), a3, voffA);
            PG8_BAR; PG8_WAIT_L(0); PG8_MMA(1, 0, At, B0); PG8_BAR; PG8_SCHED;
            PG8_STAGE(PG8_SB(1, 1), b3 + hstep, voffA);
            PG8_WAIT_V(6); PG8_BAR; PG8_MMA(1, 1, At, B1); PG8_BAR;
        }
        E(acc, cur, wr, wc, fr, fq);
        if (!has_next) break;
#pragma unroll
        for (int a = 0; a < 2; ++a)
#pragma unroll
            for (int b = 0; b < 2; ++b)
#pragma unroll
                for (int m = 0; m < 4; ++m)
#pragma unroll
                    for (int n = 0; n < 2; ++n) acc[a][b][m][n] = (f32x4){0.f, 0.f, 0.f, 0.f};
        cur = nxt; cA = nA; cB = nB; ++ui;
    }
    PG8_WAIT_V(0);
    if (wr == 0) PG8_BAR;
    PG8_BAR;
#undef PG8_SA
#undef PG8_SB
#undef PG8_STAGE
#undef PG8_LDA
#undef PG8_LDB
#undef PG8_MMA
#undef PG8_WAIT_V
#undef PG8_WAIT_L
#undef PG8_BAR
#undef PG8_SCHED
}
}

typedef f32x4 AccT[2][2][4][2];
#define EPI_LOOP_BEGIN \
    const int row0 = u.pm * 256 + wr * 64 + fr, col0 = u.pn * 256 + wc * 32 + 4 * fq; \
    _Pragma("unroll") for (int ai = 0; ai < 2; ++ai) _Pragma("unroll") for (int m = 0; m < 4; ++m) { const int row = row0 + ai * 128 + m * 16; \
    _Pragma("unroll") for (int bj = 0; bj < 2; ++bj) _Pragma("unroll") for (int n = 0; n < 2; ++n) { const int col = col0 + bj * 128 + n * 16; const f32x4 v = acc[ai][bj][m][n];
#define EPI_LOOP_END } }

struct EpiIn {
    bf16_t *Qb, *Kb, *Vb; float* RW; float* out;
    DI void operator()(const AccT& acc, const pg8::Unit& u, int wr, int wc, int fr, int fq) const {
        const int reg = u.pn < 4 ? 0 : (u.pn < 8 ? 1 : (u.pn < 12 ? 2 : 3));
        EPI_LOOP_BEGIN
            if (row < MT) {
                if (reg == 0) {
                    u32x2 w; w.x = pk2(v[0] * 0.125f, v[1] * 0.125f); w.y = pk2(v[2] * 0.125f, v[3] * 0.125f);
                    *(u32x2*)(Qb + (size_t)row * 1024 + col) = w;
                } else if (reg == 1 || reg == 2) {
                    const int c = col - (reg == 1 ? 1024 : 2048);
                    float* o = row < MP ? out + (reg == 1 ? O_PK : O_PV) + (size_t)row * 1024 + c : out + (reg == 1 ? O_SK : O_SV) + (size_t)(row - MP) * 1024 + c;
                    *(f32x4*)o = v;
                    u32x2 w; w.x = pk2(v[0], v[1]); w.y = pk2(v[2], v[3]);
                    *(u32x2*)((reg == 1 ? Kb : Vb) + (size_t)row * 1024 + c) = w;
                } else {
                    const int c = col - 3072;
                    if (c < CSH) {
                        *(f32x4*)(RW + (size_t)row * CSH + c) = v;
                        if (row >= MP) *(f32x4*)(out + O_SRW + (size_t)(row - MP) * CSH + c) = v;
                        else if ((row & (SEQ - 1)) == SEQ - 1) *(f32x4*)(out + O_PRW + (size_t)(row >> 11) * CSH + c) = v;
                    }
                }
            }
        EPI_LOOP_END
    }
};
struct EpiF32 {
    float* C; int ldc;
    DI void operator()(const AccT& acc, const pg8::Unit& u, int wr, int wc, int fr, int fq) const {
        EPI_LOOP_BEGIN
            *(f32x4*)(C + (size_t)row * ldc + col) = v;
        EPI_LOOP_END
    }
};
struct EpiWo {
    const float *xp, *xs; float* X1;
    DI void operator()(const AccT& acc, const pg8::Unit& u, int wr, int wc, int fr, int fq) const {
        EPI_LOOP_BEGIN
            if (row < MT) {
                const float* xr = row < MP ? xp + (size_t)row * D + col : xs + (size_t)(row - MP) * D + col;
                *(f32x4*)(X1 + (size_t)row * D + col) = *(const f32x4*)xr + v;
            }
        EPI_LOOP_END
    }
};
struct EpiUp {
    bf16_t* U; float* out;
    DI void operator()(const AccT& acc, const pg8::Unit& u, int wr, int wc, int fr, int fq) const {
        EPI_LOOP_BEGIN
            if (row < MT) {
                u32x2 w; w.x = pk2(v[0], v[1]); w.y = pk2(v[2], v[3]);
                *(u32x2*)(U + (size_t)row * FF2 + col) = w;
                if (row >= MP) *(f32x4*)(out + O_SFFN + (size_t)(row - MP) * 2 * FF2 + FF2 + col) = v;
                else if ((row & (SEQ - 1)) >= SEQ - 2) *(f32x4*)(out + O_PFFN + ((size_t)(row >> 11) * 2 + ((row & (SEQ - 1)) - (SEQ - 2))) * FF2 + col) = v;
            }
        EPI_LOOP_END
    }
};
struct EpiDn {
    float* X1;
    DI void operator()(const AccT& acc, const pg8::Unit& u, int wr, int wc, int fr, int fq) const {
        EPI_LOOP_BEGIN
            if (row < MT) { float* p = X1 + (size_t)row * D + col; *(f32x4*)p = *(const f32x4*)p + v; }
        EPI_LOOP_END
    }
};

DI void transpose_item(const float* W, int K, int N, bf16_t* WT, int ldt, float* scr, int item, int lane) {
    const int nblk = N / 32, kb = item / nblk, nb = item % nblk, k0 = 64 * kb, n0 = 32 * nb;
#pragma unroll 8
    for (int i = 0; i < 32; ++i) { const int kk = 2 * i + (lane >> 5); scr[kk * 33 + (lane & 31)] = W[(size_t)(k0 + kk) * N + n0 + (lane & 31)]; }
    __builtin_amdgcn_fence(__ATOMIC_RELEASE, "wavefront"); asm volatile("s_waitcnt lgkmcnt(0)" ::: "memory");
    const int c = lane & 7;
#pragma unroll
    for (int j = 0; j < 4; ++j) { const int n = (lane >> 3) + 8 * j; const float* s = scr + (8 * c) * 33 + n;
        u32x4 o; o.x = pk2(s[0 * 33], s[1 * 33]); o.y = pk2(s[2 * 33], s[3 * 33]); o.z = pk2(s[4 * 33], s[5 * 33]); o.w = pk2(s[6 * 33], s[7 * 33]);
        *(u32x4*)(WT + (size_t)(n0 + n) * ldt + k0 + 8 * c) = o; }
    asm volatile("s_waitcnt lgkmcnt(0)" ::: "memory");
}
DI void rms_row_bf16(const float* xrow, const float* g, bf16_t* orow, int lane) {
    const f32x4* xr = (const f32x4*)xrow + lane; const f32x4* gr = (const f32x4*)g + lane;
    f32x4 v[8]; float s = 0.f;
#pragma unroll
    for (int j = 0; j < 8; ++j) { v[j] = xr[64 * j]; s += (v[j].x * v[j].x + v[j].y * v[j].y) + (v[j].z * v[j].z + v[j].w * v[j].w); }
    const float rstd = rsqrtf(wave_sum(s) * (1.f / D) + 1e-6f);
    u32x2* o8 = (u32x2*)orow + lane;
#pragma unroll
    for (int j = 0; j < 8; ++j) { const f32x4 gg = gr[64 * j]; u32x2 w; w.x = pk2(v[j].x * rstd * gg.x, v[j].y * rstd * gg.y); w.y = pk2(v[j].z * rstd * gg.z, v[j].w * rstd * gg.w); o8[64 * j] = w; }
}
DI void rms_row_f32(const float* xrow, const float* g, float* orow, int lane) {
    const f32x4* xr = (const f32x4*)xrow + lane; const f32x4* gr = (const f32x4*)g + lane;
    f32x4 v[8]; float s = 0.f;
#pragma unroll
    for (int j = 0; j < 8; ++j) { v[j] = xr[64 * j]; s += (v[j].x * v[j].x + v[j].y * v[j].y) + (v[j].z * v[j].z + v[j].w * v[j].w); }
    const float rstd = rsqrtf(wave_sum(s) * (1.f / D) + 1e-6f);
    f32x4* o = (f32x4*)orow + lane;
#pragma unroll
    for (int j = 0; j < 8; ++j) { const f32x4 gg = gr[64 * j]; o[64 * j] = v[j] * rstd * gg; }
}
DI void zero_row_bf16(bf16_t* orow, int ncols, int lane) {
    for (int c = lane * 8; c < ncols; c += 512) *(u32x4*)(orow + c) = (u32x4){0u, 0u, 0u, 0u};
}

DI void phase_prologue(const Args& a, unsigned char* lds, int gw, int ngw, int lane, int wave) {
    unsigned char* ws = a.ws;
    float* scr = (float*)(lds + wave * 16384);
    bf16_t* Win = (bf16_t*)(ws + WS_WIN); bf16_t* Wo = (bf16_t*)(ws + WS_WO); bf16_t* Wup = (bf16_t*)(ws + WS_WUP); bf16_t* Wdn = (bf16_t*)(ws + WS_WDN); bf16_t* Wlo = (bf16_t*)(ws + WS_WLO);
    constexpr int IT_IN = (D / 64) * (CIN / 32), IT_O = (D / 64) * (D / 32), IT_UP = (D / 64) * (FF2 / 32), IT_DN = (FF / 64) * (D / 32);
    constexpr int NIT = IT_IN + IT_O + IT_UP + IT_DN;
    for (int it = gw; it < NIT; it += ngw) {
        int r = it;
        if (r < IT_IN) { transpose_item(a.in[I_WIN], D, CIN, Win, D, scr, r, lane); continue; } r -= IT_IN;
        if (r < IT_O) { transpose_item(a.in[I_WO], D, D, Wo, D, scr, r, lane); continue; } r -= IT_O;
        if (r < IT_UP) { transpose_item(a.in[I_FUP], D, FF2, Wup, D, scr, r, lane); continue; } r -= IT_UP;
        transpose_item(a.in[I_FDN], FF, D, Wdn, FF, scr, r, lane);
    }
    for (int r = CIN + gw; r < NIN; r += ngw) zero_row_bf16(Win + (size_t)r * D, D, lane);
    {
        const int gt = gw * 64 + lane, ngt = ngw * 64;
        for (int i = gt; i < NLO * KLO; i += ngt) {
            const int n = i / KLO, k = i % KLO; float v = 0.f;
            if (n < 1024) { if (k < 64) v = a.in[I_WUP][k * 1024 + n]; }
            else if (n < 2048) { if (k >= 64 && k < 128) v = a.in[I_AUP][(k - 64) * 1024 + (n - 1024)]; }
            else { if (k >= 128 && k < 288) v = a.in[I_GUP][(k - 128) * 1024 + (n - 2048)]; }
            Wlo[i] = (bf16_t)bf_rne(v);
        }
    }
    bf16_t* H = (bf16_t*)(ws + WS_H);
    for (int m = gw; m < MPAD; m += ngw) {
        if (m < MT) rms_row_bf16(m < MP ? a.in[I_XP] + (size_t)m * D : a.in[I_XS] + (size_t)(m - MP) * D, a.in[I_NMG], H + (size_t)m * D, lane);
        else zero_row_bf16(H + (size_t)m * D, D, lane);
    }
}

DI const float* rw_prev_row(const Args& a, const float* RW, int m) {
    if (m < MP) return (m & (SEQ - 1)) == 0 ? nullptr : RW + (size_t)(m - 1) * CSH;
    return a.in[I_SSH] + (size_t)(m - MP) * CSH;
}
DI void lora_input_row(const Args& a, int m, int lane) {
    bf16_t* ALO = (bf16_t*)(a.ws + WS_ALO) + (size_t)m * KLO;
    if (m >= MT) { for (int c = lane; c < KLO; c += 64) ALO[c] = 0; return; }
    const float* RW = (const float*)(a.ws + WS_RW);
    const float* cur = RW + (size_t)m * CSH; const float* prev = rw_prev_row(a, RW, m);
    for (int c = lane; c < KLO; c += 64) {
        float v = 0.f;
        if (c < 288) {
            const int j = 3072 + c; const float x = cur[j], p = prev ? prev[j] : 0.f; const float xs = x + a.in[I_MU][j] * (p - x);
            v = c < 64 ? tanhf(xs) : (c < 128 ? xs : 1.f / (1.f + __expf(-xs)));
        }
        ALO[c] = (bf16_t)bf_rne(v);
    }
}

DI int crow(int reg, int h) { return (reg & 3) + 8 * (reg >> 2) + 4 * h; }
DI void attn_prompt_unit(const Args& a, int unit, int lane) {
    const bf16_t* Qb = (const bf16_t*)(a.ws + WS_QB); const bf16_t* Kb = (const bf16_t*)(a.ws + WS_KB); const bf16_t* Vb = (const bf16_t*)(a.ws + WS_VB);
    float* PO = (float*)(a.ws + WS_PART); float* PML = (float*)(a.ws + WS_PML);
    const int blk = unit & 63, br = (unit >> 6) % 3, bh = unit / 192, b = bh >> 4, h = bh & 15;
    const int rate = br == 0 ? 1 : (br == 1 ? 4 : 16), L = SEQ / rate, bpc = L / 32;
    const int rho = blk / bpc, l0 = (blk % bpc) * 32;
    const int r = lane & 31, hh = lane >> 5;
    const int mq = b * SEQ + rho + rate * (l0 + r);
    bf16x8 qf[4];
#pragma unroll
    for (int ks = 0; ks < 4; ++ks) qf[ks] = *(const bf16x8*)(Qb + (size_t)mq * 1024 + h * 64 + ks * 16 + 8 * hh);
    f32x16 o0, o1;
#pragma unroll
    for (int i = 0; i < 16; ++i) { o0[i] = 0.f; o1[i] = 0.f; }
    float mrun = -1e30f, lrun = 0.f;
    const int lq = l0 + r;
    for (int ch = 0; ch < 5; ++ch) {
        const int lk0 = l0 - 128 + 32 * ch;
        if (lk0 < 0) continue;
        const int mk = b * SEQ + rho + rate * (lk0 + r);
        f32x16 st;
#pragma unroll
        for (int i = 0; i < 16; ++i) st[i] = 0.f;
#pragma unroll
        for (int ks = 0; ks < 4; ++ks) {
            const bf16x8 kf = *(const bf16x8*)(Kb + (size_t)mk * 1024 + h * 64 + ks * 16 + 8 * hh);
            st = __builtin_amdgcn_mfma_f32_32x32x16_bf16(kf, qf[ks], st, 0, 0, 0);
        }
        float cmax = -1e30f;
#pragma unroll
        for (int i = 0; i < 16; ++i) { const int lk = lk0 + crow(i, hh); const bool ok = (lk <= lq) && (lk >= lq - 128); st[i] = ok ? st[i] : -1e30f; cmax = fmaxf(cmax, st[i]); }
        cmax = fmaxf(cmax, __shfl_xor(cmax, 32));
        const float mnew = fmaxf(mrun, cmax), alpha = __expf(mrun - mnew);
        float ps = 0.f;
#pragma unroll
        for (int i = 0; i < 16; ++i) { const float p = st[i] > -1e29f ? __expf(st[i] - mnew) : 0.f; st[i] = p; ps += p; }
        lrun = lrun * alpha + ps; mrun = mnew;
#pragma unroll
        for (int i = 0; i < 16; ++i) { o0[i] *= alpha; o1[i] *= alpha; }
#pragma unroll
        for (int s = 0; s < 2; ++s) {
            u32x4 pp; pp.x = pk2(st[8 * s], st[8 * s + 1]); pp.y = pk2(st[8 * s + 2], st[8 * s + 3]); pp.z = pk2(st[8 * s + 4], st[8 * s + 5]); pp.w = pk2(st[8 * s + 6], st[8 * s + 7]);
            const bf16x8 pf = __builtin_bit_cast(bf16x8, pp);
#pragma unroll
            for (int dt = 0; dt < 2; ++dt) {
                bf16x8 vf;
#pragma unroll
                for (int j = 0; j < 8; ++j) {
                    const int key = lk0 + 16 * s + 8 * (j >> 2) + 4 * hh + (j & 3);
                    vf[j] = (short)Vb[(size_t)(b * SEQ + rho + rate * key) * 1024 + h * 64 + dt * 32 + r];
                }
                if (dt == 0) o0 = __builtin_amdgcn_mfma_f32_32x32x16_bf16(vf, pf, o0, 0, 0, 0);
                else o1 = __builtin_amdgcn_mfma_f32_32x32x16_bf16(vf, pf, o1, 0, 0, 0);
            }
        }
    }
    const float ltot = lrun + __shfl_xor(lrun, 32);
    float* po = PO + ((size_t)br * MP + mq) * 1024 + h * 64;
#pragma unroll
    for (int g = 0; g < 4; ++g) {
        *(f32x4*)(po + 8 * g + 4 * hh) = (f32x4){o0[4 * g], o0[4 * g + 1], o0[4 * g + 2], o0[4 * g + 3]};
        *(f32x4*)(po + 32 + 8 * g + 4 * hh) = (f32x4){o1[4 * g], o1[4 * g + 1], o1[4 * g + 2], o1[4 * g + 3]};
    }
    if (hh == 0) { float* pm = PML + (((size_t)br * MP + mq) * 16 + h) * 2; pm[0] = mrun; pm[1] = ltot; }
}
DI void attn_merge_task(const Args& a, int task, int lane) {
    const int m = task >> 4, h = task & 15;
    const float* PO = (const float*)(a.ws + WS_PART); const float* PML = (const float*)(a.ws + WS_PML);
    bf16_t* O = (bf16_t*)(a.ws + WS_O);
    float mb[3], lb[3], ob[3];
#pragma unroll
    for (int br = 0; br < 3; ++br) { const float* pm = PML + (((size_t)br * MP + m) * 16 + h) * 2; mb[br] = pm[0]; lb[br] = pm[1]; ob[br] = PO[((size_t)br * MP + m) * 1024 + h * 64 + lane]; }
    const float M = fmaxf(mb[0], fmaxf(mb[1], mb[2]));
    float num = 0.f, den = 0.f;
#pragma unroll
    for (int br = 0; br < 3; ++br) { const float w = __expf(mb[br] - M); num += w * ob[br]; den += w * lb[br]; }
    const float o = num / den;
    const float ss = wave_sum(o * o) * (1.f / 64.f);
    const float y = o * rsqrtf(ss + 1e-6f) * a.in[I_AOG][h * 64 + lane];
    O[(size_t)m * D + h * 64 + lane] = (bf16_t)bf_rne(y);
}
DI void attn_sample_unit(const Args& a, int unit, int lane) {
    const int b = unit >> 4, h = unit & 15, g = lane >> 4, l16 = lane & 15;
    const bf16_t* Qb = (const bf16_t*)(a.ws + WS_QB);
    const float* ck = a.in[I_CK] + (size_t)b * 2048 * 1024 + h * 64 + 4 * l16; const float* cv = a.in[I_CV] + (size_t)b * 2048 * 1024 + h * 64 + 4 * l16;
    const float* nk = a.out + O_SK + (size_t)b * 1024 + h * 64 + 4 * l16; const float* nv = a.out + O_SV + (size_t)b * 1024 + h * 64 + 4 * l16;
    const u32x2 qw = *(const u32x2*)(Qb + (size_t)(MP + b) * 1024 + h * 64 + 4 * l16);
    const float q0 = __uint_as_float(qw.x << 16), q1 = __uint_as_float(qw.x & 0xffff0000u), q2 = __uint_as_float(qw.y << 16), q3 = __uint_as_float(qw.y & 0xffff0000u);
    float mrun = -1e30f, lrun = 0.f; f32x4 acc = {0.f, 0.f, 0.f, 0.f};
    for (int it = 0; it < 97; ++it) {
        const int e = it * 4 + g;
        const bool valid = e < 387;
        const int ee = valid ? e : 0, br = ee / 129, j = ee % 129, rate = br == 0 ? 1 : (br == 1 ? 4 : 16);
        const int row = 2048 - rate * j;
        const float* kp = j == 0 ? nk : ck + (size_t)row * 1024; const float* vp = j == 0 ? nv : cv + (size_t)row * 1024;
        const f32x4 kv = *(const f32x4*)kp, vv = *(const f32x4*)vp;
        float s = q0 * kv.x + q1 * kv.y + q2 * kv.z + q3 * kv.w;
        s += __shfl_xor(s, 1); s += __shfl_xor(s, 2); s += __shfl_xor(s, 4); s += __shfl_xor(s, 8);
        if (!valid) s = -1e30f;
        const float mnew = fmaxf(mrun, s), alpha = __expf(mrun - mnew), p = valid ? __expf(s - mnew) : 0.f;
        lrun = lrun * alpha + p; acc = acc * alpha + vv * p; mrun = mnew;
    }
#pragma unroll
    for (int o = 16; o < 64; o <<= 1) {
        const float mo = __shfl_xor(mrun, o), lo = __shfl_xor(lrun, o);
        f32x4 ao; ao.x = __shfl_xor(acc.x, o); ao.y = __shfl_xor(acc.y, o); ao.z = __shfl_xor(acc.z, o); ao.w = __shfl_xor(acc.w, o);
        const float mn = fmaxf(mrun, mo), w0 = __expf(mrun - mn), w1 = __expf(mo - mn);
        lrun = lrun * w0 + lo * w1; acc = acc * w0 + ao * w1; mrun = mn;
    }
    const f32x4 o = acc * (1.f / lrun);
    float ss = o.x * o.x + o.y * o.y + o.z * o.z + o.w * o.w;
    ss += __shfl_xor(ss, 1); ss += __shfl_xor(ss, 2); ss += __shfl_xor(ss, 4); ss += __shfl_xor(ss, 8);
    const float rs = rsqrtf(ss * (1.f / 64.f) + 1e-6f);
    const f32x4 gg = *(const f32x4*)(a.in[I_AOG] + h * 64 + 4 * l16);
    if (g == 0) {
        u32x2 w; w.x = pk2(o.x * rs * gg.x, o.y * rs * gg.y); w.y = pk2(o.z * rs * gg.z, o.w * rs * gg.w);
        *(u32x2*)((bf16_t*)(a.ws + WS_O) + (size_t)(MP + b) * D + h * 64 + 4 * l16) = w;
    }
}

struct PrepParams { float mu_r, mu_k, mu_v, w0, a0, kk, ka, rk; };
struct PrepRaw { float cr, ck, cv, pr, pk, pv, lw, la, lg; };
DI void prep_params(const Args& a, PrepParams& P, int c) {
    P.mu_r = a.in[I_MU][c]; P.mu_k = a.in[I_MU][1024 + c]; P.mu_v = a.in[I_MU][2048 + c];
    P.w0 = a.in[I_W0][c]; P.a0 = a.in[I_A0][c]; P.kk = a.in[I_KK][c]; P.ka = a.in[I_KA][c]; P.rk = a.in[I_RK][c];
}
DI void prep_load(PrepRaw& R, const float* cur, const float* prev, const float* Lrow, int c) {
    R.cr = cur[c]; R.ck = cur[1024 + c]; R.cv = cur[2048 + c];
    R.pr = prev ? prev[c] : 0.f; R.pk = prev ? prev[1024 + c] : 0.f; R.pv = prev ? prev[2048 + c] : 0.f;
    R.lw = Lrow[c]; R.la = Lrow[1024 + c]; R.lg = Lrow[2048 + c];
}
DI void prep_finish(const PrepRaw& R, const PrepParams& P, float* dst, float& g_out, float& bonus_out, int lane) {
    const float xr = R.cr + P.mu_r * (R.pr - R.cr), xk = R.ck + P.mu_k * (R.pk - R.ck), xv = R.cv + P.mu_v * (R.pv - R.cv);
    const float x = -(P.w0 + R.lw);
    const float sp = x > 20.f ? x : __logf(1.f + __expf(x));
    const float decay = __expf(-__expf(-sp - 0.5f));
    const float av = 1.f / (1.f + __expf(-(P.a0 + R.la)));
    float kkv = xk * P.kk;
    const float n2 = wave_sum(kkv * kkv);
    kkv = kkv / fmaxf(sqrtf(n2), 1e-12f);
    const float keff = xk * (1.f + (av - 1.f) * P.ka);
    const float bon = wave_sum(xr * keff * P.rk) * xv;
    dst[lane] = xr; dst[64 + lane] = decay; dst[128 + lane] = keff; dst[192 + lane] = xv; dst[256 + lane] = -kkv; dst[320 + lane] = kkv * av;
    g_out = R.lg; bonus_out = bon;
}
DI float scan_step(float (&S)[64], const float* sv, float vi) {
    const f32x4* r4 = (const f32x4*)sv; const f32x4* w4 = (const f32x4*)(sv + 64); const f32x4* k4 = (const f32x4*)(sv + 128);
    const f32x4* a4 = (const f32x4*)(sv + 256); const f32x4* b4 = (const f32x4*)(sv + 320);
    float sa0 = 0.f, sa1 = 0.f;
#pragma unroll
    for (int j = 0; j < 16; ++j) { const f32x4 av = a4[j]; sa0 = fmaf(S[4 * j], av.x, sa0); sa1 = fmaf(S[4 * j + 1], av.y, sa1); sa0 = fmaf(S[4 * j + 2], av.z, sa0); sa1 = fmaf(S[4 * j + 3], av.w, sa1); }
    const float sa = sa0 + sa1;
    float y0 = 0.f, y1 = 0.f;
#pragma unroll
    for (int j = 0; j < 16; ++j) {
        const f32x4 bv = b4[j], kv = k4[j], wv = w4[j], rv = r4[j];
        float t;
        t = fmaf(vi, kv.x, sa * bv.x); S[4 * j] = fmaf(S[4 * j], wv.x, t); y0 = fmaf(S[4 * j], rv.x, y0);
        t = fmaf(vi, kv.y, sa * bv.y); S[4 * j + 1] = fmaf(S[4 * j + 1], wv.y, t); y1 = fmaf(S[4 * j + 1], rv.y, y1);
        t = fmaf(vi, kv.z, sa * bv.z); S[4 * j + 2] = fmaf(S[4 * j + 2], wv.z, t); y0 = fmaf(S[4 * j + 2], rv.z, y0);
        t = fmaf(vi, kv.w, sa * bv.w); S[4 * j + 3] = fmaf(S[4 * j + 3], wv.w, t); y1 = fmaf(S[4 * j + 3], rv.w, y1);
        if ((j & 3) == 3) asm volatile("" ::: "memory");
    }
    return y0 + y1;
}
DI void rwkv_post(const Args& a, float y, float g, float bonus, int m, int c) {
    const float mean = wave_sum(y) * (1.f / 64.f); const float d = y - mean; const float var = wave_sum(d * d) * (1.f / 64.f);
    const float yn = d * rsqrtf(var + 64e-5f) * a.in[I_LNW][c] + a.in[I_LNB][c];
    ((bf16_t*)(a.ws + WS_O))[(size_t)m * D + 1024 + c] = (bf16_t)bf_rne((yn + bonus) * g);
}

DI void scan_pass1_unit(const Args& a, unsigned char* lds, int unit, int wave, int lane) {
    float* stg = (float*)lds;
    const float* RW = (const float*)(a.ws + WS_RW); const float* Lb = (const float*)(a.ws + WS_L);
    float* GB = (float*)(a.ws + WS_GB); float* YL = (float*)(a.ws + WS_YL); float* QS = (float*)(a.ws + WS_QS); float* ZP = (float*)(a.ws + WS_ZP);
    const int pp = wave >> 1, half = wave & 1, pair = unit * 4 + pp, chain = pair / NS, seg = pair % NS, b = chain >> 4, h = chain & 15, c = h * 64 + lane;
    PrepParams P; prep_params(a, P, c);
    float S[64];
    int idl = half == 1 ? lane : -1; asm volatile("" : "+v"(idl));
#pragma unroll
    for (int j = 0; j < 64; ++j) S[j] = (idl == j) ? 1.f : 0.f;
    const int mbase = b * SEQ + seg * SEGL;
    PrepRaw raw[4];
#pragma unroll
    for (int k = 0; k < 4; ++k) { const int m = mbase + half * 4 + k; prep_load(raw[k], RW + (size_t)m * CSH, rw_prev_row(a, RW, m), Lb + (size_t)m * NLO, c); }
#pragma unroll
    for (int k = 0; k < 4; ++k) { const int m = mbase + half * 4 + k; float g, bon; prep_finish(raw[k], P, stg + ((0 * 4 + pp) * TB + half * 4 + k) * 384, g, bon, lane);
        GB[((size_t)m * 16 + h) * 128 + lane] = g; GB[((size_t)m * 16 + h) * 128 + 64 + lane] = bon; }
    __syncthreads();
    float* yout = (half == 0 ? YL : QS);
    for (int blk = 0; blk < SEGL / TB; ++blk) {
        const bool more = blk + 1 < SEGL / TB;
        if (more) {
#pragma unroll
            for (int k = 0; k < 4; ++k) { const int m = mbase + (blk + 1) * TB + half * 4 + k; prep_load(raw[k], RW + (size_t)m * CSH, rw_prev_row(a, RW, m), Lb + (size_t)m * NLO, c); }
        }
        const float* sb = stg + (((blk & 1) * 4 + pp) * TB) * 384;
#pragma unroll 1
        for (int tt = 0; tt < TB; ++tt) {
            const float* sv = sb + tt * 384;
            const float vi = half == 0 ? sv[192 + lane] : 0.f;
            const float y = scan_step(S, sv, vi);
            yout[(size_t)(mbase + blk * TB + tt) * 1024 + c] = y;
        }
        if (more) {
#pragma unroll
            for (int k = 0; k < 4; ++k) { const int m = mbase + (blk + 1) * TB + half * 4 + k; float g, bon; prep_finish(raw[k], P, stg + ((((blk + 1) & 1) * 4 + pp) * TB + half * 4 + k) * 384, g, bon, lane);
                GB[((size_t)m * 16 + h) * 128 + lane] = g; GB[((size_t)m * 16 + h) * 128 + 64 + lane] = bon; }
        }
        __syncthreads();
    }
    float* zp = ZP + ((size_t)pair * 2 + half) * 4096 + lane * 64;
#pragma unroll
    for (int j = 0; j < 16; ++j) *(f32x4*)(zp + 4 * j) = (f32x4){S[4 * j], S[4 * j + 1], S[4 * j + 2], S[4 * j + 3]};
}
DI void scan_sample_unit(const Args& a, unsigned char* lds, int unit, int wave, int lane) {
    float* sv = (float*)(lds + 2 * 4 * TB * 384 * 4) + wave * 384;
    const float* RW = (const float*)(a.ws + WS_RW); const float* Lb = (const float*)(a.ws + WS_L);
    const int b = unit >> 4, h = unit & 15, c = h * 64 + lane, m = MP + b;
    PrepParams P; prep_params(a, P, c);
    PrepRaw raw; prep_load(raw, RW + (size_t)m * CSH, rw_prev_row(a, RW, m), Lb + (size_t)m * NLO, c);
    float g, bon; prep_finish(raw, P, sv, g, bon, lane);
    float S[64];
    const float* s0 = a.in[I_SWKV] + ((size_t)(b * 16 + h) * 64 + lane) * 64;
#pragma unroll
    for (int j = 0; j < 16; ++j) { const f32x4 v = *(const f32x4*)(s0 + 4 * j); S[4 * j] = v.x; S[4 * j + 1] = v.y; S[4 * j + 2] = v.z; S[4 * j + 3] = v.w; }
    const float y = scan_step(S, sv, sv[192 + lane]);
    float* so = a.out + O_SWKV + ((size_t)(b * 16 + h) * 64 + lane) * 64;
#pragma unroll
    for (int j = 0; j < 16; ++j) *(f32x4*)(so + 4 * j) = (f32x4){S[4 * j], S[4 * j + 1], S[4 * j + 2], S[4 * j + 3]};
    rwkv_post(a, y, g, bon, m, c);
}
DI void scan_pass2_unit(const Args& a, unsigned char* lds, int chain, int wave, int lane) {
    float* Ssh = (float*)lds;
    float* Psh = Ssh + 64 * 65;
    const float* ZP = (const float*)(a.ws + WS_ZP); float* SST = (float*)(a.ws + WS_SST);
    const int i = lane, j0 = wave * 8, tid = wave * 64 + lane;
    float Sr[8];
#pragma unroll
    for (int k = 0; k < 8; ++k) Sr[k] = 0.f;
    for (int s = 0; s < NS; ++s) {
        float* sst = SST + ((size_t)chain * NS + s) * 4096 + i * 64 + j0;
        *(f32x4*)sst = (f32x4){Sr[0], Sr[1], Sr[2], Sr[3]}; *(f32x4*)(sst + 4) = (f32x4){Sr[4], Sr[5], Sr[6], Sr[7]};
        const float* Zs = ZP + ((size_t)(chain * NS + s) * 2 + 0) * 4096; const float* Ps = Zs + 4096;
#pragma unroll
        for (int k = 0; k < 8; ++k) Ssh[i * 65 + j0 + k] = Sr[k];
        *(f32x4*)(Psh + tid * 8) = *(const f32x4*)(Ps + tid * 8); *(f32x4*)(Psh + tid * 8 + 4) = *(const f32x4*)(Ps + tid * 8 + 4);
        const f32x4 z0 = *(const f32x4*)(Zs + i * 64 + j0), z1 = *(const f32x4*)(Zs + i * 64 + j0 + 4);
        float nw[8] = {z0.x, z0.y, z0.z, z0.w, z1.x, z1.y, z1.z, z1.w};
        __syncthreads();
        if (s > 0) {
#pragma unroll 8
            for (int l = 0; l < 64; ++l) {
                const float sl = Ssh[i * 65 + l];
                const f32x4 p0 = *(const f32x4*)(Psh + l * 64 + j0), p1 = *(const f32x4*)(Psh + l * 64 + j0 + 4);
                nw[0] = fmaf(sl, p0.x, nw[0]); nw[1] = fmaf(sl, p0.y, nw[1]); nw[2] = fmaf(sl, p0.z, nw[2]); nw[3] = fmaf(sl, p0.w, nw[3]);
                nw[4] = fmaf(sl, p1.x, nw[4]); nw[5] = fmaf(sl, p1.y, nw[5]); nw[6] = fmaf(sl, p1.z, nw[6]); nw[7] = fmaf(sl, p1.w, nw[7]);
            }
        }
        __syncthreads();
#pragma unroll
        for (int k = 0; k < 8; ++k) Sr[k] = nw[k];
    }
    float* so = a.out + O_PWKV + (size_t)chain * 4096 + i * 64 + j0;
    *(f32x4*)so = (f32x4){Sr[0], Sr[1], Sr[2], Sr[3]}; *(f32x4*)(so + 4) = (f32x4){Sr[4], Sr[5], Sr[6], Sr[7]};
}
DI void scan_pass3_unit(const Args& a, unsigned char* lds, int unit, int wave, int lane) {
    float* qsh = (float*)lds + wave * 2048;
    const float* SST = (const float*)(a.ws + WS_SST); const float* YL = (const float*)(a.ws + WS_YL); const float* QS = (const float*)(a.ws + WS_QS); const float* GB = (const float*)(a.ws + WS_GB);
    const int sub = unit & 3, pair = unit >> 2, chain = pair / NS, seg = pair % NS, b = chain >> 4, h = chain & 15, c = h * 64 + lane;
    const int m0 = b * SEQ + seg * SEGL + sub * 32;
    float S[64];
    const float* sr = SST + (size_t)pair * 4096 + lane * 64;
#pragma unroll
    for (int j = 0; j < 16; ++j) { const f32x4 v = *(const f32x4*)(sr + 4 * j); S[4 * j] = v.x; S[4 * j + 1] = v.y; S[4 * j + 2] = v.z; S[4 * j + 3] = v.w; }
#pragma unroll 8
    for (int t = 0; t < 32; ++t) qsh[t * 64 + lane] = QS[(size_t)(m0 + t) * 1024 + c];
    __builtin_amdgcn_fence(__ATOMIC_RELEASE, "wavefront"); asm volatile("s_waitcnt lgkmcnt(0)" ::: "memory");
#pragma unroll 1
    for (int t = 0; t < 32; ++t) {
        const int m = m0 + t;
        const f32x4* q4 = (const f32x4*)(qsh + t * 64);
        float c0 = 0.f, c1 = 0.f;
#pragma unroll
        for (int j = 0; j < 16; ++j) { const f32x4 qv = q4[j]; c0 = fmaf(S[4 * j], qv.x, c0); c1 = fmaf(S[4 * j + 1], qv.y, c1); c0 = fmaf(S[4 * j + 2], qv.z, c0); c1 = fmaf(S[4 * j + 3], qv.w, c1); }
        const float y = YL[(size_t)m * 1024 + c] + (c0 + c1);
        const float g = GB[((size_t)m * 16 + h) * 128 + lane], bon = GB[((size_t)m * 16 + h) * 128 + 64 + lane];
        rwkv_post(a, y, g, bon, m, c);
    }
    asm volatile("s_waitcnt lgkmcnt(0)" ::: "memory");
}

DI void conv_item(const Args& a, int item) {
    const int m = item / (FF / 8), f = (item % (FF / 8)) * 8;
    const bf16_t* U = (const bf16_t*)(a.ws + WS_U); bf16_t* ACT = (bf16_t*)(a.ws + WS_ACT);
    if (m >= MT) { *(u32x4*)(ACT + (size_t)m * FF + f) = (u32x4){0u, 0u, 0u, 0u}; return; }
    const float* cw = a.in[I_FCW]; const float* cb = a.in[I_FCB];
    float res[2][8];
#pragma unroll
    for (int part = 0; part < 2; ++part) {
        const int col = part * FF + f;
        float u0[8], u1[8], u2[8];
        { const u32x4 w = *(const u32x4*)(U + (size_t)m * FF2 + col);
          u0[0] = __uint_as_float(w.x << 16); u0[1] = __uint_as_float(w.x & 0xffff0000u); u0[2] = __uint_as_float(w.y << 16); u0[3] = __uint_as_float(w.y & 0xffff0000u);
          u0[4] = __uint_as_float(w.z << 16); u0[5] = __uint_as_float(w.z & 0xffff0000u); u0[6] = __uint_as_float(w.w << 16); u0[7] = __uint_as_float(w.w & 0xffff0000u); }
        if (m < MP) {
            const int t = m & (SEQ - 1);
            u32x4 w1 = {0u, 0u, 0u, 0u}, w2 = {0u, 0u, 0u, 0u};
            if (t >= 1) w1 = *(const u32x4*)(U + (size_t)(m - 1) * FF2 + col);
            if (t >= 2) w2 = *(const u32x4*)(U + (size_t)(m - 2) * FF2 + col);
            u1[0] = __uint_as_float(w1.x << 16); u1[1] = __uint_as_float(w1.x & 0xffff0000u); u1[2] = __uint_as_float(w1.y << 16); u1[3] = __uint_as_float(w1.y & 0xffff0000u);
            u1[4] = __uint_as_float(w1.z << 16); u1[5] = __uint_as_float(w1.z & 0xffff0000u); u1[6] = __uint_as_float(w1.w << 16); u1[7] = __uint_as_float(w1.w & 0xffff0000u);
            u2[0] = __uint_as_float(w2.x << 16); u2[1] = __uint_as_float(w2.x & 0xffff0000u); u2[2] = __uint_as_float(w2.y << 16); u2[3] = __uint_as_float(w2.y & 0xffff0000u);
            u2[4] = __uint_as_float(w2.z << 16); u2[5] = __uint_as_float(w2.z & 0xffff0000u); u2[6] = __uint_as_float(w2.w << 16); u2[7] = __uint_as_float(w2.w & 0xffff0000u);
        } else {
            const float* st = a.in[I_SFFN] + (size_t)(m - MP) * 2 * FF2 + col;
            float* so = a.out + O_SFFN + (size_t)(m - MP) * 2 * FF2 + col;
#pragma unroll
            for (int j = 0; j < 8; ++j) { u2[j] = st[j]; u1[j] = st[FF2 + j]; so[j] = u1[j]; }
        }
#pragma unroll
        for (int j = 0; j < 8; ++j) res[part][j] = cb[col + j] + cw[col + j] * u2[j] + cw[FF2 + col + j] * u1[j] + cw[2 * FF2 + col + j] * u0[j];
    }
    float o[8];
#pragma unroll
    for (int j = 0; j < 8; ++j) { const float gt = res[0][j]; o[j] = gt / (1.f + __expf(-gt)) * res[1][j]; }
    u32x4 w; w.x = pk2(o[0], o[1]); w.y = pk2(o[2], o[3]); w.z = pk2(o[4], o[5]); w.w = pk2(o[6], o[7]);
    *(u32x4*)(ACT + (size_t)m * FF + f) = w;
}

constexpr int NPH = 14;
template <bool COOP>
__global__ void __launch_bounds__(NTHREADS, 2) mk_fwd(Args a) {
    extern __shared__ __attribute__((aligned(16))) unsigned char lds[];
    const int tid = threadIdx.x, lane = tid & 63, wave = __builtin_amdgcn_readfirstlane(tid >> 6);
    const int G = gridDim.x, bid = blockIdx.x, gw = bid * NWAVES + wave, ngw = G * NWAVES;
    unsigned char* ws = a.ws;
    LAS unsigned char* ldsl = (LAS unsigned char*)lds;
#ifndef PHMASK
#define PHMASK 0xffff
#endif
#define IN(k) (((PHMASK >> (k)) & 1) && a.ph_lo <= (k) && (k) < a.ph_hi)
#define SEAM(k) do { if (COOP && IN(k) && IN((k) + 1)) cg::this_grid().sync(); } while (0)

    if (IN(0)) phase_prologue(a, lds, gw, ngw, lane, wave);
    SEAM(0);
    if (IN(1)) {
        pg8::Gemm g{(const bf16_t*)(ws + WS_H), (const bf16_t*)(ws + WS_WIN), MPAD, NIN, D}; pg8::StaticOrder S; S.init(MPAD, NIN, G, bid);
        EpiIn E{(bf16_t*)(ws + WS_QB), (bf16_t*)(ws + WS_KB), (bf16_t*)(ws + WS_VB), (float*)(ws + WS_RW), a.out};
        pg8::gemm_phase<EpiIn>(ldsl, g, S, E);
    }
    SEAM(1);
    if (IN(2)) {
        for (int m = gw; m < MPAD; m += ngw) lora_input_row(a, m, lane);
        for (int u = gw; u < 512; u += ngw) attn_sample_unit(a, u, lane);
        for (int u = gw; u < 64 * 3 * 64; u += ngw) attn_prompt_unit(a, u, lane);
    }
    SEAM(2);
    if (IN(3)) {
        pg8::Gemm g{(const bf16_t*)(ws + WS_ALO), (const bf16_t*)(ws + WS_WLO), MPAD, NLO, KLO}; pg8::StaticOrder S; S.init(MPAD, NLO, G, bid);
        EpiF32 E{(float*)(ws + WS_L), NLO};
        pg8::gemm_phase<EpiF32>(ldsl, g, S, E);
        for (int t = gw; t < MP * 16; t += ngw) attn_merge_task(a, t, lane);
    }
    SEAM(3);
    if (IN(4)) {
#ifndef NO_P1
        for (int u = bid; u < 64 * NS / 4; u += G) scan_pass1_unit(a, lds, u, wave, lane);
#endif
#ifndef NO_SS
        for (int u = gw; u < 512; u += ngw) scan_sample_unit(a, lds, u, wave, lane);
#endif
    }
    SEAM(4);
    if (IN(5)) { for (int ch = bid; ch < 64; ch += G) scan_pass2_unit(a, lds, ch, wave, lane); }
    SEAM(5);
    if (IN(6)) { for (int u = gw; u < 64 * NS * 4; u += ngw) scan_pass3_unit(a, lds, u, wave, lane); }
    SEAM(6);
    if (IN(7)) {
        pg8::Gemm g{(const bf16_t*)(ws + WS_O), (const bf16_t*)(ws + WS_WO), MPAD, D, D}; pg8::StaticOrder S; S.init(MPAD, D, G, bid);
        EpiWo E{a.in[I_XP], a.in[I_XS], (float*)(ws + WS_X1)};
        pg8::gemm_phase<EpiWo>(ldsl, g, S, E);
    }
    SEAM(7);
    if (IN(8)) { for (int m = gw; m < MT; m += ngw) rms_row_bf16((const float*)(ws + WS_X1) + (size_t)m * D, a.in[I_NFG], (bf16_t*)(ws + WS_H) + (size_t)m * D, lane); }
    SEAM(8);
    if (IN(9)) {
        pg8::Gemm g{(const bf16_t*)(ws + WS_H), (const bf16_t*)(ws + WS_WUP), MPAD, FF2, D}; pg8::StaticOrder S; S.init(MPAD, FF2, G, bid);
        EpiUp E{(bf16_t*)(ws + WS_U), a.out};
        pg8::gemm_phase<EpiUp>(ldsl, g, S, E);
    }
    SEAM(9);
    if (IN(10)) { for (int it = bid * NTHREADS + tid; it < MPAD * (FF / 8); it += G * NTHREADS) conv_item(a, it); }
    SEAM(10);
    if (IN(11)) {
        pg8::Gemm g{(const bf16_t*)(ws + WS_ACT), (const bf16_t*)(ws + WS_WDN), MPAD, D, FF}; pg8::StaticOrder S; S.init(MPAD, D, G, bid);
        EpiDn E{(float*)(ws + WS_X1)};
        pg8::gemm_phase<EpiDn>(ldsl, g, S, E);
    }
    SEAM(11);
    if (IN(12)) {
        for (int m = gw; m < MT; m += ngw)
            rms_row_f32((const float*)(ws + WS_X1) + (size_t)m * D, a.in[I_NFIN], m < MP ? a.out + O_YP + (size_t)m * D : a.out + O_YS + (size_t)(m - MP) * D, lane);
    }
#undef IN
#undef SEAM
}

#ifndef MK_ONE_LAUNCH
#define MK_ONE_LAUNCH 1
#endif

extern "C" void kernel_launch(void* const* d_in, const int* in_sizes, int n_in, void* d_out, int out_size, void* d_ws, size_t ws_size, hipStream_t stream) {
    static int grid = 0;
    if (!grid) {
        if (n_in != 28 || (size_t)out_size != O_END || ws_size < WS_END) fprintf(stderr, "kernel_launch: unexpected shapes: n_in %d out %d (want %zu) ws %zu (want %zu)\n", n_in, out_size, O_END, ws_size, WS_END);
        int dev = 0, cus = 0; hipGetDevice(&dev); hipDeviceGetAttribute(&cus, hipDeviceAttributeMultiprocessorCount, dev);
        hipFuncSetAttribute((const void*)mk_fwd<true>, hipFuncAttributeMaxDynamicSharedMemorySize, LDS_BYTES);
        hipFuncSetAttribute((const void*)mk_fwd<false>, hipFuncAttributeMaxDynamicSharedMemorySize, LDS_BYTES);
        int per_cu = 0; hipOccupancyMaxActiveBlocksPerMultiprocessor(&per_cu, mk_fwd<true>, NTHREADS, LDS_BYTES);
        if (per_cu < 1) { fprintf(stderr, "kernel_launch: occupancy query says %d blocks/CU\n", per_cu); per_cu = 1; }
        grid = cus > 0 ? cus : 256;
    }
    Args a; memset(&a, 0, sizeof(a));
    for (int i = 0; i < 28; ++i) a.in[i] = (const float*)d_in[i];
    a.out = (float*)d_out; a.ws = (unsigned char*)d_ws;
#if MK_ONE_LAUNCH
    a.ph_lo = 0; a.ph_hi = NPH;
    void* args[] = {&a};
    hipError_t e = hipLaunchCooperativeKernel((const void*)mk_fwd<true>, dim3(grid), dim3(NTHREADS), args, LDS_BYTES, stream);
    if (e != hipSuccess) fprintf(stderr, "cooperative launch failed: %s (grid %d)\n", hipGetErrorString(e), grid);
#else
    for (int p = 0; p < 13; ++p) {
        a.ph_lo = p; a.ph_hi = p + 1;
        mk_fwd<false><<<dim3(grid), dim3(NTHREADS), LDS_BYTES, stream>>>(a);
    }
#endif
}
```

```cpp
#include <hip/hip_runtime.h>
#include <hip/hip_cooperative_groups.h>
#include <cstdio>
#include <cstdint>
#include <cstring>
namespace cg = cooperative_groups;

#define DI __device__ __forceinline__
#define LAS __attribute__((address_space(3)))
typedef unsigned short bf16_t;
typedef short bf16x8 __attribute__((ext_vector_type(8)));
typedef float f32x4 __attribute__((ext_vector_type(4)));
typedef float f32x16 __attribute__((ext_vector_type(16)));
typedef unsigned u32x4 __attribute__((ext_vector_type(4)));
typedef unsigned u32x2 __attribute__((ext_vector_type(2)));

constexpr int D = 2048, MP = 8192, MS = 32, MT = 8224, MPAD = 8448, SEQ = 2048;
constexpr int CIN = 6432, NIN = 6656, CSH = 3360, FF2 = 11264, FF = 5632;
constexpr int NLO = 3072, KLO = 384;
constexpr int NS = 16, SEGL = 128, TB = 8;
constexpr int NTHREADS = 512, NWAVES = 8;
constexpr int LDS_BYTES = 131072 + 16384;

constexpr size_t O_YP = 0;
constexpr size_t O_YS = O_YP + (size_t)MP * D;
constexpr size_t O_PK = O_YS + (size_t)MS * D;
constexpr size_t O_PV = O_PK + (size_t)MP * 1024;
constexpr size_t O_PRW = O_PV + (size_t)MP * 1024;
constexpr size_t O_PWKV = O_PRW + (size_t)4 * CSH;
constexpr size_t O_PFFN = O_PWKV + (size_t)4 * 16 * 4096;
constexpr size_t O_SK = O_PFFN + (size_t)4 * 2 * FF2;
constexpr size_t O_SV = O_SK + (size_t)MS * 1024;
constexpr size_t O_SRW = O_SV + (size_t)MS * 1024;
constexpr size_t O_SWKV = O_SRW + (size_t)MS * CSH;
constexpr size_t O_SFFN = O_SWKV + (size_t)MS * 16 * 4096;
constexpr size_t O_END = O_SFFN + (size_t)MS * 2 * FF2;

constexpr size_t al256(size_t x) { return (x + 255) & ~(size_t)255; }
constexpr size_t WS_WIN = 0;
constexpr size_t WS_WO = WS_WIN + al256((size_t)NIN * D * 2);
constexpr size_t WS_WUP = WS_WO + al256((size_t)D * D * 2);
constexpr size_t WS_WDN = WS_WUP + al256((size_t)FF2 * D * 2);
constexpr size_t WS_WLO = WS_WDN + al256((size_t)D * FF * 2);
constexpr size_t WS_H = WS_WLO + al256((size_t)NLO * KLO * 2);
constexpr size_t WS_QB = WS_H + al256((size_t)MPAD * D * 2);
constexpr size_t WS_KB = WS_QB + al256((size_t)MPAD * 1024 * 2);
constexpr size_t WS_VB = WS_KB + al256((size_t)MPAD * 1024 * 2);
constexpr size_t WS_ALO = WS_VB + al256((size_t)MPAD * 1024 * 2);
constexpr size_t WS_O = WS_ALO + al256((size_t)MPAD * KLO * 2);
constexpr size_t WS_GB = WS_O + al256((size_t)MPAD * D * 2);
constexpr size_t WS_YL = WS_GB + al256((size_t)MT * 2048 * 4);
constexpr size_t WS_QS = WS_YL + al256((size_t)MP * 1024 * 4);
constexpr size_t WS_ZP = WS_QS + al256((size_t)MP * 1024 * 4);
constexpr size_t WS_SST = WS_ZP + al256((size_t)64 * NS * 2 * 4096 * 4);
constexpr size_t WS_X1 = WS_SST + al256((size_t)64 * NS * 4096 * 4);
constexpr size_t WS_PML = WS_X1 + al256((size_t)MPAD * D * 4);
constexpr size_t WS_RA = WS_PML + al256((size_t)3 * MP * 16 * 2 * 4);
constexpr size_t WS_RW = WS_RA;
constexpr size_t WS_L = WS_RW + al256((size_t)MPAD * CSH * 4);
constexpr size_t RA_BYTES_1 = al256((size_t)MPAD * CSH * 4) + al256((size_t)MPAD * NLO * 4);
constexpr size_t RA_BYTES_2 = al256((size_t)MPAD * FF2 * 2);
constexpr size_t WS_U = WS_RA;
constexpr size_t WS_RB = WS_RA + (RA_BYTES_1 > RA_BYTES_2 ? RA_BYTES_1 : RA_BYTES_2);
constexpr size_t WS_PART = WS_RB;
constexpr size_t WS_ACT = WS_RB;
constexpr size_t RB_BYTES_1 = al256((size_t)3 * MP * 1024 * 4);
constexpr size_t RB_BYTES_2 = al256((size_t)MPAD * FF * 2);
constexpr size_t WS_BAR = WS_RB + (RB_BYTES_1 > RB_BYTES_2 ? RB_BYTES_1 : RB_BYTES_2);
constexpr size_t BAR_BYTES = 16384;
constexpr size_t WS_END = WS_BAR + BAR_BYTES;

struct Args {
    const float* in[28];
    float* out;
    unsigned char* ws;
    int ph_lo, ph_hi;
};
enum { I_XP = 0, I_XS, I_CK, I_CV, I_SSH, I_SWKV, I_SFFN, I_NMG, I_WIN, I_AOG, I_MU, I_W0, I_WUP, I_A0, I_AUP, I_GUP,
       I_KK, I_KA, I_RK, I_LNW, I_LNB, I_WO, I_NFG, I_FUP, I_FCW, I_FCB, I_FDN, I_NFIN };

DI unsigned bf_rne(float f) { unsigned u = __float_as_uint(f); u += 0x7fffu + ((u >> 16) & 1u); return u >> 16; }
DI unsigned pk2(float lo, float hi) { return bf_rne(lo) | (bf_rne(hi) << 16); }
DI float bf2f(unsigned short b) { return __uint_as_float(((unsigned)b) << 16); }
DI float wave_sum(float v) {
#pragma unroll
    for (int o = 1; o < 64; o <<= 1) v += __shfl_xor(v, o);
    return v;
}

namespace pg8 {
constexpr int BM = 256, BK = 64, HALF = 128, HTB = HALF * BK * 2, STAGE_BYTES = 8 * HTB, NXCD = 8, WGM = 8;
DI int lds_byte(int r, int c) { const int st = (r >> 4) * 2 + (c >> 5), rr = r & 15, cc = c & 31, ob = rr * 64 + cc * 2; return st * 1024 + (ob ^ (((ob >> 9) & 1) << 5)); }
DI void stage_rc(int b, int& R, int& C) { const int st = b / 1024, sb = b % 1024, swz = sb ^ (((sb >> 9) & 1) << 5); R = (st >> 1) * 16 + swz / 64; C = (st & 1) * 32 + (swz % 64) / 2; }
struct Unit { int pm, pn; };
struct Gemm { const bf16_t* A; const bf16_t* Bt; int M, N, K; };
struct StaticOrder {
    int nM, nN, nwg, G, c;
    DI void init(int M, int N, int G_, int c_) { nM = M / BM; nN = N / BM; nwg = nM * nN; G = G_; c = c_; }
    DI bool next(int i, Unit& u) const {
        const long L = (long)i * G + c; if (L >= nwg) return false;
        int wgid = (int)L; { const int q = nwg / NXCD, r = nwg % NXCD, xcd = wgid % NXCD, off = wgid / NXCD; wgid = (xcd < r ? xcd * (q + 1) : r * (q + 1) + (xcd - r) * q) + off; }
        const int nig = WGM * nN, gid = wgid / nig, fm = gid * WGM, gsz = (nM - fm) < WGM ? (nM - fm) : WGM;
        u.pm = fm + ((wgid % nig) % gsz); u.pn = (wgid % nig) / gsz; return true;
    }
};

template <class Epi>
DI void gemm_phase(LAS unsigned char* lds, const Gemm g, const StaticOrder& S, const Epi& E) {
    const int tid = threadIdx.x, wid = __builtin_amdgcn_readfirstlane(tid >> 6), lane = tid & 63, wr = wid >> 2, wc = wid & 3, fr = lane & 15, fq = lane >> 4;
    const int K = g.K, nt = K / BK;
    unsigned voffA[2];
#pragma unroll
    for (int i = 0; i < 2; ++i) { int R, C; stage_rc(tid * 16 + i * 8192, R, C); voffA[i] = (unsigned)(R * K + C) * 2u; }
    const size_t kstep = (size_t)(BK * 2);
    const size_t hstep = (size_t)HALF * K * 2;
    const size_t tstep = 2 * hstep;
    const unsigned ldsw = (unsigned)wid * 1024u;
    const int aoff = lds_byte(wr * 64 + fr, fq * 8), boff = lds_byte(wc * 32 + fr, fq * 8);
#define PG8_SA(b, h) (((b) * 2 + (h)) * HTB)
#define PG8_SB(b, h) ((4 + (b) * 2 + (h)) * HTB)
#define PG8_STAGE(bufoff, gbase, voff) do { _Pragma("unroll") for (int _i = 0; _i < 2; ++_i) \
        __builtin_amdgcn_global_load_lds((const unsigned*)((const char*)(gbase) + (voff)[_i]), (LAS unsigned*)(lds + (bufoff) + ldsw + _i * 8192), 16, 0, 0); } while (0)
#define PG8_LDA(dst, b, h) do { _Pragma("unroll") for (int m = 0; m < 4; ++m) _Pragma("unroll") for (int k = 0; k < 2; ++k) dst[m][k] = *(const LAS bf16x8*)(lds + PG8_SA(b, h) + aoff + m * 2048 + k * 1024); } while (0)
#define PG8_LDB(dst, b, h) do { _Pragma("unroll") for (int n = 0; n < 2; ++n) _Pragma("unroll") for (int k = 0; k < 2; ++k) dst[n][k] = *(const LAS bf16x8*)(lds + PG8_SB(b, h) + boff + n * 2048 + k * 1024); } while (0)
#define PG8_MMA(ai, bj, At, Bt) do { __builtin_amdgcn_s_setprio(1); _Pragma("unroll") for (int m = 0; m < 4; ++m) _Pragma("unroll") for (int n = 0; n < 2; ++n) _Pragma("unroll") for (int k = 0; k < 2; ++k) \
        acc[ai][bj][m][n] = __builtin_amdgcn_mfma_f32_16x16x32_bf16(Bt[n][k], At[m][k], acc[ai][bj][m][n], 0, 0, 0); __builtin_amdgcn_s_setprio(0); } while (0)
#define PG8_WAIT_V(n) asm volatile("s_waitcnt vmcnt(" #n ")" ::: "memory")
#define PG8_WAIT_L(n) asm volatile("s_waitcnt lgkmcnt(" #n ")" ::: "memory")
#define PG8_BAR __builtin_amdgcn_s_barrier()
#define PG8_SCHED __builtin_amdgcn_sched_barrier(0)
    Unit cur, nxt; int ui = 0;
    if (!S.next(0, cur)) return;
    f32x4 acc[2][2][4][2];
#pragma unroll
    for (int a = 0; a < 2; ++a)
#pragma unroll
        for (int b = 0; b < 2; ++b)
#pragma unroll
            for (int m = 0; m < 4; ++m)
#pragma unroll
                for (int n = 0; n < 2; ++n) acc[a][b][m][n] = (f32x4){0.f, 0.f, 0.f, 0.f};
    bf16x8 At[4][2], B0[2][2], B1[2][2];
    const char* cA = (const char*)g.A + (size_t)cur.pm * tstep; const char* cB = (const char*)g.Bt + (size_t)cur.pn * tstep;
    PG8_STAGE(PG8_SB(0, 0), cB, voffA); PG8_STAGE(PG8_SA(0, 0), cA, voffA); PG8_STAGE(PG8_SB(0, 1), cB + hstep, voffA); PG8_STAGE(PG8_SA(0, 1), cA + hstep, voffA);
    if (wr == 1) PG8_BAR;
    PG8_WAIT_V(4); PG8_BAR;
    PG8_STAGE(PG8_SB(1, 0), cB + kstep, voffA); PG8_STAGE(PG8_SA(1, 0), cA + kstep, voffA); PG8_STAGE(PG8_SB(1, 1), cB + hstep + kstep, voffA);
    PG8_WAIT_V(6); PG8_BAR;
    for (;;) {
        const bool has_next = S.next(ui + 1, nxt);
        const char* nA = has_next ? (const char*)g.A + (size_t)nxt.pm * tstep : cA; const char* nB = has_next ? (const char*)g.Bt + (size_t)nxt.pn * tstep : cB;
        for (int t = 0; t < nt; t += 2) {
            const bool last = (t == nt - 2);
            const char* a1 = cA + (size_t)(t + 1) * kstep;
            const char* a2 = last ? nA : cA + (size_t)(t + 2) * kstep; const char* b2 = last ? nB : cB + (size_t)(t + 2) * kstep;
            const char* a3 = a2 + kstep; const char* b3 = b2 + kstep;
            PG8_LDB(B0, 0, 0); PG8_SCHED; PG8_LDA(At, 0, 0); PG8_STAGE(PG8_SA(1, 1), a1 + hstep, voffA);
            PG8_WAIT_L(8); PG8_BAR; PG8_WAIT_L(0); PG8_MMA(0, 0, At, B0); PG8_BAR; PG8_SCHED;
            PG8_LDB(B1, 0, 1); PG8_STAGE(PG8_SB(0, 0), b2, voffA);
            PG8_BAR; PG8_WAIT_L(0); PG8_MMA(0, 1, At, B1); PG8_BAR;
            PG8_LDA(At, 0, 1); PG8_STAGE(PG8_SA(0, 0), a2, voffA);
            PG8_BAR; PG8_WAIT_L(0); PG8_MMA(1, 0, At, B0); PG8_BAR; PG8_SCHED;
            PG8_STAGE(PG8_SB(0, 1), b2 + hstep, voffA);
            PG8_WAIT_V(6); PG8_BAR; PG8_MMA(1, 1, At, B1); PG8_BAR;
            PG8_LDB(B0, 1, 0); PG8_SCHED; PG8_LDA(At, 1, 0); PG8_STAGE(PG8_SA(0, 1), a2 + hstep, voffA);
            PG8_WAIT_L(8); PG8_BAR; PG8_WAIT_L(0); PG8_MMA(0, 0, At, B0); PG8_BAR; PG8_SCHED;
            PG8_LDB(B1, 1, 1); PG8_STAGE(PG8_SB(1, 0), b3, voffA);
            PG8_BAR; PG8_WAIT_L(0); PG8_MMA(0, 1, At, B1); PG8_BAR;
            PG8_LDA(At, 1, 1); PG8_STAGE(PG8_SA(1, 0), a3, voffA);
            PG8_BAR; PG8_WAIT_L(0); PG8_MMA(1, 0, At, B0); PG8_BAR; PG8_SCHED;
            PG8_STAGE(PG8_SB(1, 1), b3 + hstep, voffA);
            PG8_WAIT_V(6); PG8_BAR; PG8_MMA(1, 1, At, B1); PG8_BAR;
        }
        E(acc, cur, wr, wc, fr, fq);
        if (!has_next) break;
#pragma unroll
        for (int a = 0; a < 2; ++a)
#pragma unroll
            for (int b = 0; b < 2; ++b)
#pragma unroll
                for (int m = 0; m < 4; ++m)
#pragma unroll
                    for (int n = 0; n < 2; ++n) acc[a][b][m][n] = (f32x4){0.f, 0.f, 0.f, 0.f};
        cur = nxt; cA = nA; cB = nB; ++ui;
    }
    PG8_WAIT_V(0);
    if (wr == 0) PG8_BAR;
    PG8_BAR;
#undef PG8_SA
#undef PG8_SB
#undef PG8_STAGE
#undef PG8_LDA
#undef PG8_LDB
#undef PG8_MMA
#undef PG8_WAIT_V
#undef PG8_WAIT_L
#undef PG8_BAR
#undef PG8_SCHED
}
}

typedef f32x4 AccT[2][2][4][2];
#define EPI_LOOP_BEGIN \
    const int row0 = u.pm * 256 + wr * 64 + fr, col0 = u.pn * 256 + wc * 32 + 4 * fq; \
    _Pragma("unroll") for (int ai = 0; ai < 2; ++ai) _Pragma("unroll") for (int m = 0; m < 4; ++m) { const int row = row0 + ai * 128 + m * 16; \
    _Pragma("unroll") for (int bj = 0; bj < 2; ++bj) _Pragma("unroll") for (int n = 0; n < 2; ++n) { const int col = col0 + bj * 128 + n * 16; const f32x4 v = acc[ai][bj][m][n];
#define EPI_LOOP_END } }

struct EpiIn {
    bf16_t *Qb, *Kb, *Vb; float* RW; float* out;
    DI void operator()(const AccT& acc, const pg8::Unit& u, int wr, int wc, int fr, int fq) const {
        const int reg = u.pn < 4 ? 0 : (u.pn < 8 ? 1 : (u.pn < 12 ? 2 : 3));
        EPI_LOOP_BEGIN
            if (row < MT) {
                if (reg == 0) {
                    u32x2 w; w.x = pk2(v[0] * 0.125f, v[1] * 0.125f); w.y = pk2(v[2] * 0.125f, v[3] * 0.125f);
                    *(u32x2*)(Qb + (size_t)row * 1024 + col) = w;
                } else if (reg == 1 || reg == 2) {
                    const int c = col - (reg == 1 ? 1024 : 2048);
                    float* o = row < MP ? out + (reg == 1 ? O_PK : O_PV) + (size_t)row * 1024 + c : out + (reg == 1 ? O_SK : O_SV) + (size_t)(row - MP) * 1024 + c;
                    *(f32x4*)o = v;
                    u32x2 w; w.x = pk2(v[0], v[1]); w.y = pk2(v[2], v[3]);
                    *(u32x2*)((reg == 1 ? Kb : Vb) + (size_t)row * 1024 + c) = w;
                } else {
                    const int c = col - 3072;
                    if (c < CSH) {
                        *(f32x4*)(RW + (size_t)row * CSH + c) = v;
                        if (row >= MP) *(f32x4*)(out + O_SRW + (size_t)(row - MP) * CSH + c) = v;
                        else if ((row & (SEQ - 1)) == SEQ - 1) *(f32x4*)(out + O_PRW + (size_t)(row >> 11) * CSH + c) = v;
                    }
                }
            }
        EPI_LOOP_END
    }
};
struct EpiF32 {
    float* C; int ldc;
    DI void operator()(const AccT& acc, const pg8::Unit& u, int wr, int wc, int fr, int fq) const {
        EPI_LOOP_BEGIN
            *(f32x4*)(C + (size_t)row * ldc + col) = v;
        EPI_LOOP_END
    }
};
struct EpiWo {
    const float *xp, *xs; float* X1;
    DI void operator()(const AccT& acc, const pg8::Unit& u, int wr, int wc, int fr, int fq) const {
        EPI_LOOP_BEGIN
            if (row < MT) {
                const float* xr = row < MP ? xp + (size_t)row * D + col : xs + (size_t)(row - MP) * D + col;
                *(f32x4*)(X1 + (size_t)row * D + col) = *(const f32x4*)xr + v;
            }
        EPI_LOOP_END
    }
};
struct EpiUp {
    bf16_t* U; float* out;
    DI void operator()(const AccT& acc, const pg8::Unit& u, int wr, int wc, int fr, int fq) const {
        EPI_LOOP_BEGIN
            if (row < MT) {
                u32x2 w; w.x = pk2(v[0], v[1]); w.y = pk2(v[2], v[3]);
                *(u32x2*)(U + (size_t)row * FF2 + col) = w;
                if (row >= MP) *(f32x4*)(out + O_SFFN + (size_t)(row - MP) * 2 * FF2 + FF2 + col) = v;
                else if ((row & (SEQ - 1)) >= SEQ - 2) *(f32x4*)(out + O_PFFN + ((size_t)(row >> 11) * 2 + ((row & (SEQ - 1)) - (SEQ - 2))) * FF2 + col) = v;
            }
        EPI_LOOP_END
    }
};
struct EpiDn {
    float* X1;
    DI void operator()(const AccT& acc, const pg8::Unit& u, int wr, int wc, int fr, int fq) const {
        EPI_LOOP_BEGIN
            if (row < MT) { float* p = X1 + (size_t)row * D + col; *(f32x4*)p = *(const f32x4*)p + v; }
        EPI_LOOP_END
    }
};

DI void transpose_item(const float* W, int K, int N, bf16_t* WT, int ldt, float* scr, int item, int lane) {
    const int nblk = N / 32, kb = item / nblk, nb = item % nblk, k0 = 64 * kb, n0 = 32 * nb;
#pragma unroll 8
    for (int i = 0; i < 32; ++i) { const int kk = 2 * i + (lane >> 5); scr[kk * 33 + (lane & 31)] = W[(size_t)(k0 + kk) * N + n0 + (lane & 31)]; }
    __builtin_amdgcn_fence(__ATOMIC_RELEASE, "wavefront"); asm volatile("s_waitcnt lgkmcnt(0)" ::: "memory");
    const int c = lane & 7;
#pragma unroll
    for (int j = 0; j < 4; ++j) { const int n = (lane >> 3) + 8 * j; const float* s = scr + (8 * c) * 33 + n;
        u32x4 o; o.x = pk2(s[0 * 33], s[1 * 33]); o.y = pk2(s[2 * 33], s[3 * 33]); o.z = pk2(s[4 * 33], s[5 * 33]); o.w = pk2(s[6 * 33], s[7 * 33]);
        *(u32x4*)(WT + (size_t)(n0 + n) * ldt + k0 + 8 * c) = o; }
    asm volatile("s_waitcnt lgkmcnt(0)" ::: "memory");
}
DI void rms_row_bf16(const float* xrow, const float* g, bf16_t* orow, int lane) {
    const f32x4* xr = (const f32x4*)xrow + lane; const f32x4* gr = (const f32x4*)g + lane;
    f32x4 v[8]; float s = 0.f;
#pragma unroll
    for (int j = 0; j < 8; ++j) { v[j] = xr[64 * j]; s += (v[j].x * v[j].x + v[j].y * v[j].y) + (v[j].z * v[j].z + v[j].w * v[j].w); }
    const float rstd = rsqrtf(wave_sum(s) * (1.f / D) + 1e-6f);
    u32x2* o8 = (u32x2*)orow + lane;
#pragma unroll
    for (int j = 0; j < 8; ++j) { const f32x4 gg = gr[64 * j]; u32x2 w; w.x = pk2(v[j].x * rstd * gg.x, v[j].y * rstd * gg.y); w.y = pk2(v[j].z * rstd * gg.z, v[j].w * rstd * gg.w); o8[64 * j] = w; }
}
DI void rms_row_f32(const float* xrow, const float* g, float* orow, int lane) {
    const f32x4* xr = (const f32x4*)xrow + lane; const f32x4* gr = (const f32x4*)g + lane;
    f32x4 v[8]; float s = 0.f;
#pragma unroll
    for (int j = 0; j < 8; ++j) { v[j] = xr[64 * j]; s += (v[j].x * v[j].x + v[j].y * v[j].y) + (v[j].z * v[j].z + v[j].w * v[j].w); }
    const float rstd = rsqrtf(wave_sum(s) * (1.f / D) + 1e-6f);
    f32x4* o = (f32x4*)orow + lane;
#pragma unroll
    for (int j = 0; j < 8; ++j) { const f32x4 gg = gr[64 * j]; o[64 * j] = v[j] * rstd * gg; }
}
DI void zero_row_bf16(bf16_t* orow, int ncols, int lane) {
    for (int c = lane * 8; c < ncols; c += 512) *(u32x4*)(orow + c) = (u32x4){0u, 0u, 0u, 0u};
}

DI void phase_prologue(const Args& a, unsigned char* lds, int gw, int ngw, int lane, int wave) {
    unsigned char* ws = a.ws;
    float* scr = (float*)(lds + wave * 16384);
    bf16_t* Win = (bf16_t*)(ws + WS_WIN); bf16_t* Wo = (bf16_t*)(ws + WS_WO); bf16_t* Wup = (bf16_t*)(ws + WS_WUP); bf16_t* Wdn = (bf16_t*)(ws + WS_WDN); bf16_t* Wlo = (bf16_t*)(ws + WS_WLO);
    constexpr int IT_IN = (D / 64) * (CIN / 32), IT_O = (D / 64) * (D / 32), IT_UP = (D / 64) * (FF2 / 32), IT_DN = (FF / 64) * (D / 32);
    constexpr int NIT = IT_IN + IT_O + IT_UP + IT_DN;
    for (int it = gw; it < NIT; it += ngw) {
        int r = it;
        if (r < IT_IN) { transpose_item(a.in[I_WIN], D, CIN, Win, D, scr, r, lane); continue; } r -= IT_IN;
        if (r < IT_O) { transpose_item(a.in[I_WO], D, D, Wo, D, scr, r, lane); continue; } r -= IT_O;
        if (r < IT_UP) { transpose_item(a.in[I_FUP], D, FF2, Wup, D, scr, r, lane); continue; } r -= IT_UP;
        transpose_item(a.in[I_FDN], FF, D, Wdn, FF, scr, r, lane);
    }
    for (int r = CIN + gw; r < NIN; r += ngw) zero_row_bf16(Win + (size_t)r * D, D, lane);
    {
        const int gt = gw * 64 + lane, ngt = ngw * 64;
        for (int i = gt; i < NLO * KLO; i += ngt) {
            const int n = i / KLO, k = i % KLO; float v = 0.f;
            if (n < 1024) { if (k < 64) v = a.in[I_WUP][k * 1024 + n]; }
            else if (n < 2048) { if (k >= 64 && k < 128) v = a.in[I_AUP][(k - 64) * 1024 + (n - 1024)]; }
            else { if (k >= 128 && k < 288) v = a.in[I_GUP][(k - 128) * 1024 + (n - 2048)]; }
            Wlo[i] = (bf16_t)bf_rne(v);
        }
    }
    bf16_t* H = (bf16_t*)(ws + WS_H);
    for (int m = gw; m < MPAD; m += ngw) {
        if (m < MT) rms_row_bf16(m < MP ? a.in[I_XP] + (size_t)m * D : a.in[I_XS] + (size_t)(m - MP) * D, a.in[I_NMG], H + (size_t)m * D, lane);
        else zero_row_bf16(H + (size_t)m * D, D, lane);
    }
}

DI const float* rw_prev_row(const Args& a, const float* RW, int m) {
    if (m < MP) return (m & (SEQ - 1)) == 0 ? nullptr : RW + (size_t)(m - 1) * CSH;
    return a.in[I_SSH] + (size_t)(m - MP) * CSH;
}
DI void lora_input_row(const Args& a, int m, int lane) {
    bf16_t* ALO = (bf16_t*)(a.ws + WS_ALO) + (size_t)m * KLO;
    if (m >= MT) { for (int c = lane; c < KLO; c += 64) ALO[c] = 0; return; }
    const float* RW = (const float*)(a.ws + WS_RW);
    const float* cur = RW + (size_t)m * CSH; const float* prev = rw_prev_row(a, RW, m);
    for (int c = lane; c < KLO; c += 64) {
        float v = 0.f;
        if (c < 288) {
            const int j = 3072 + c; const float x = cur[j], p = prev ? prev[j] : 0.f; const float xs = x + a.in[I_MU][j] * (p - x);
            v = c < 64 ? tanhf(xs) : (c < 128 ? xs : 1.f / (1.f + __expf(-xs)));
        }
        ALO[c] = (bf16_t)bf_rne(v);
    }
}

DI int crow(int reg, int h) { return (reg & 3) + 8 * (reg >> 2) + 4 * h; }
DI void attn_prompt_unit(const Args& a, int unit, int lane) {
    const bf16_t* Qb = (const bf16_t*)(a.ws + WS_QB); const bf16_t* Kb = (const bf16_t*)(a.ws + WS_KB); const bf16_t* Vb = (const bf16_t*)(a.ws + WS_VB);
    float* PO = (float*)(a.ws + WS_PART); float* PML = (float*)(a.ws + WS_PML);
    const int blk = unit & 63, br = (unit >> 6) % 3, bh = unit / 192, b = bh >> 4, h = bh & 15;
    const int rate = br == 0 ? 1 : (br == 1 ? 4 : 16), L = SEQ / rate, bpc = L / 32;
    const int rho = blk / bpc, l0 = (blk % bpc) * 32;
    const int r = lane & 31, hh = lane >> 5;
    const int mq = b * SEQ + rho + rate * (l0 + r);
    bf16x8 qf[4];
#pragma unroll
    for (int ks = 0; ks < 4; ++ks) qf[ks] = *(const bf16x8*)(Qb + (size_t)mq * 1024 + h * 64 + ks * 16 + 8 * hh);
    f32x16 o0, o1;
#pragma unroll
    for (int i = 0; i < 16; ++i) { o0[i] = 0.f; o1[i] = 0.f; }
    float mrun = -1e30f, lrun = 0.f;
    const int lq = l0 + r;
    for (int ch = 0; ch < 5; ++ch) {
        const int lk0 = l0 - 128 + 32 * ch;
        if (lk0 < 0) continue;
        const int mk = b * SEQ + rho + rate * (lk0 + r);
        f32x16 st;
#pragma unroll
        for (int i = 0; i < 16; ++i) st[i] = 0.f;
#pragma unroll
        for (int ks = 0; ks < 4; ++ks) {
            const bf16x8 kf = *(const bf16x8*)(Kb + (size_t)mk * 1024 + h * 64 + ks * 16 + 8 * hh);
            st = __builtin_amdgcn_mfma_f32_32x32x16_bf16(kf, qf[ks], st, 0, 0, 0);
        }
        float cmax = -1e30f;
#pragma unroll
        for (int i = 0; i < 16; ++i) { const int lk = lk0 + crow(i, hh); const bool ok = (lk <= lq) && (lk >= lq - 128); st[i] = ok ? st[i] : -1e30f; cmax = fmaxf(cmax, st[i]); }
        cmax = fmaxf(cmax, __shfl_xor(cmax, 32));
        const float mnew = fmaxf(mrun, cmax), alpha = __expf(mrun - mnew);
        float ps = 0.f;
#pragma unroll
        for (int i = 0; i < 16; ++i) { const float p = st[i] > -1e29f ? __expf(st[i] - mnew) : 0.f; st[i] = p; ps += p; }
        lrun = lrun * alpha + ps; mrun = mnew;
#pragma unroll
        for (int i = 0; i < 16; ++i) { o0[i] *= alpha; o1[i] *= alpha; }
#pragma unroll
        for (int s = 0; s < 2; ++s) {
            u32x4 pp; pp.x = pk2(st[8 * s], st[8 * s + 1]); pp.y = pk2(st[8 * s + 2], st[8 * s + 3]); pp.z = pk2(st[8 * s + 4], st[8 * s + 5]); pp.w = pk2(st[8 * s + 6], st[8 * s + 7]);
            const bf16x8 pf = __builtin_bit_cast(bf16x8, pp);
#pragma unroll
            for (int dt = 0; dt < 2; ++dt) {
                bf16x8 vf;
#pragma unroll
                for (int j = 0; j < 8; ++j) {
                    const int key = lk0 + 16 * s + 8 * (j >> 2) + 4 * hh + (j & 3);
                    vf[j] = (short)Vb[(size_t)(b * SEQ + rho + rate * key) * 1024 + h * 64 + dt * 32 + r];
                }
                if (dt == 0) o0 = __builtin_amdgcn_mfma_f32_32x32x16_bf16(vf, pf, o0, 0, 0, 0);
                else o1 = __builtin_amdgcn_mfma_f32_32x32x16_bf16(vf, pf, o1, 0, 0, 0);
            }
        }
    }
    const float ltot = lrun + __shfl_xor(lrun, 32);
    float* po = PO + ((size_t)br * MP + mq) * 1024 + h * 64;
#pragma unroll
    for (int g = 0; g < 4; ++g) {
        *(f32x4*)(po + 8 * g + 4 * hh) = (f32x4){o0[4 * g], o0[4 * g + 1], o0[4 * g + 2], o0[4 * g + 3]};
        *(f32x4*)(po + 32 + 8 * g + 4 * hh) = (f32x4){o1[4 * g], o1[4 * g + 1], o1[4 * g + 2], o1[4 * g + 3]};
    }
    if (hh == 0) { float* pm = PML + (((size_t)br * MP + mq) * 16 + h) * 2; pm[0] = mrun; pm[1] = ltot; }
}
DI void attn_merge_task(const Args& a, int task, int lane) {
    const int m = task >> 4, h = task & 15;
    const float* PO = (const float*)(a.ws + WS_PART); const float* PML = (const float*)(a.ws + WS_PML);
    bf16_t* O = (bf16_t*)(a.ws + WS_O);
    float mb[3], lb[3], ob[3];
#pragma unroll
    for (int br = 0; br < 3; ++br) { const float* pm = PML + (((size_t)br * MP + m) * 16 + h) * 2; mb[br] = pm[0]; lb[br] = pm[1]; ob[br] = PO[((size_t)br * MP + m) * 1024 + h * 64 + lane]; }
    const float M = fmaxf(mb[0], fmaxf(mb[1], mb[2]));
    float num = 0.f, den = 0.f;
#pragma unroll
    for (int br = 0; br < 3; ++br) { const float w = __expf(mb[br] - M); num += w * ob[br]; den += w * lb[br]; }
    const float o = num / den;
    const float ss = wave_sum(o * o) * (1.f / 64.f);
    const float y = o * rsqrtf(ss + 1e-6f) * a.in[I_AOG][h * 64 + lane];
    O[(size_t)m * D + h * 64 + lane] = (bf16_t)bf_rne(y);
}
DI void attn_sample_unit(const Args& a, int unit, int lane) {
    const int b = unit >> 4, h = unit & 15, g = lane >> 4, l16 = lane & 15;
    const bf16_t* Qb = (const bf16_t*)(a.ws + WS_QB);
    const float* ck = a.in[I_CK] + (size_t)b * 2048 * 1024 + h * 64 + 4 * l16; const float* cv = a.in[I_CV] + (size_t)b * 2048 * 1024 + h * 64 + 4 * l16;
    const float* nk = a.out + O_SK + (size_t)b * 1024 + h * 64 + 4 * l16; const float* nv = a.out + O_SV + (size_t)b * 1024 + h * 64 + 4 * l16;
    const u32x2 qw = *(const u32x2*)(Qb + (size_t)(MP + b) * 1024 + h * 64 + 4 * l16);
    const float q0 = __uint_as_float(qw.x << 16), q1 = __uint_as_float(qw.x & 0xffff0000u), q2 = __uint_as_float(qw.y << 16), q3 = __uint_as_float(qw.y & 0xffff0000u);
    float mrun = -1e30f, lrun = 0.f; f32x4 acc = {0.f, 0.f, 0.f, 0.f};
    for (int it = 0; it < 97; ++it) {
        const int e = it * 4 + g;
        const bool valid = e < 387;
        const int ee = valid ? e : 0, br = ee / 129, j = ee % 129, rate = br == 0 ? 1 : (br == 1 ? 4 : 16);
        const int row = 2048 - rate * j;
        const float* kp = j == 0 ? nk : ck + (size_t)row * 1024; const float* vp = j == 0 ? nv : cv + (size_t)row * 1024;
        const f32x4 kv = *(const f32x4*)kp, vv = *(const f32x4*)vp;
        float s = q0 * kv.x + q1 * kv.y + q2 * kv.z + q3 * kv.w;
        s += __shfl_xor(s, 1); s += __shfl_xor(s, 2); s += __shfl_xor(s, 4); s += __shfl_xor(s, 8);
        if (!valid) s = -1e30f;
        const float mnew = fmaxf(mrun, s), alpha = __expf(mrun - mnew), p = valid ? __expf(s - mnew) : 0.f;
        lrun = lrun * alpha + p; acc = acc * alpha + vv * p; mrun = mnew;
    }
#pragma unroll
    for (int o = 16; o < 64; o <<= 1) {
        const float mo = __shfl_xor(mrun, o), lo = __shfl_xor(lrun, o);
        f32x4 ao; ao.x = __shfl_xor(acc.x, o); ao.y = __shfl_xor(acc.y, o); ao.z = __shfl_xor(acc.z, o); ao.w = __shfl_xor(acc.w, o);
        const float mn = fmaxf(mrun, mo), w0 = __expf(mrun - mn), w1 = __expf(mo - mn);
        lrun = lrun * w0 + lo * w1; acc = acc * w0 + ao * w1; mrun = mn;
    }
    const f32x4 o = acc * (1.f / lrun);
    float ss = o.x * o.x + o.y * o.y + o.z * o.z + o.w * o.w;
    ss += __shfl_xor(ss, 1); ss += __shfl_xor(ss, 2); ss += __shfl_xor(ss, 4); ss += __shfl_xor(ss, 8);
    const float rs = rsqrtf(ss * (1.f / 64.f) + 1e-6f);
    const f32x4 gg = *(const f32x4*)(a.in[I_AOG] + h * 64 + 4 * l16);
    if (g == 0) {
        u32x2 w; w.x = pk2(o.x * rs * gg.x, o.y * rs * gg.y); w.y = pk2(o.z * rs * gg.z, o.w * rs * gg.w);
        *(u32x2*)((bf16_t*)(a.ws + WS_O) + (size_t)(MP + b) * D + h * 64 + 4 * l16) = w;
    }
}

struct PrepParams { float mu_r, mu_k, mu_v, w0, a0, kk, ka, rk; };
struct PrepRaw { float cr, ck, cv, pr, pk, pv, lw, la, lg; };
DI void prep_params(const Args& a, PrepParams& P, int c) {
    P.mu_r = a.in[I_MU][c]; P.mu_k = a.in[I_MU][1024 + c]; P.mu_v = a.in[I_MU][2048 + c];
    P.w0 = a.in[I_W0][c]; P.a0 = a.in[I_A0][c]; P.kk = a.in[I_KK][c]; P.ka = a.in[I_KA][c]; P.rk = a.in[I_RK][c];
}
DI void prep_load(PrepRaw& R, const float* cur, const float* prev, const float* Lrow, int c) {
    R.cr = cur[c]; R.ck = cur[1024 + c]; R.cv = cur[2048 + c];
    R.pr = prev ? prev[c] : 0.f; R.pk = prev ? prev[1024 + c] : 0.f; R.pv = prev ? prev[2048 + c] : 0.f;
    R.lw = Lrow[c]; R.la = Lrow[1024 + c]; R.lg = Lrow[2048 + c];
}
DI void prep_finish(const PrepRaw& R, const PrepParams& P, float* dst, float& g_out, float& bonus_out, int lane) {
    const float xr = R.cr + P.mu_r * (R.pr - R.cr), xk = R.ck + P.mu_k * (R.pk - R.ck), xv = R.cv + P.mu_v * (R.pv - R.cv);
    const float x = -(P.w0 + R.lw);
    const float sp = x > 20.f ? x : __logf(1.f + __expf(x));
    const float decay = __expf(-__expf(-sp - 0.5f));
    const float av = 1.f / (1.f + __expf(-(P.a0 + R.la)));
    float kkv = xk * P.kk;
    const float n2 = wave_sum(kkv * kkv);
    kkv = kkv / fmaxf(sqrtf(n2), 1e-12f);
    const float keff = xk * (1.f + (av - 1.f) * P.ka);
    const float bon = wave_sum(xr * keff * P.rk) * xv;
    dst[lane] = xr; dst[64 + lane] = decay; dst[128 + lane] = keff; dst[192 + lane] = xv; dst[256 + lane] = -kkv; dst[320 + lane] = kkv * av;
    g_out = R.lg; bonus_out = bon;
}
DI float scan_step(float (&S)[64], const float* sv, float vi) {
    const f32x4* r4 = (const f32x4*)sv; const f32x4* w4 = (const f32x4*)(sv + 64); const f32x4* k4 = (const f32x4*)(sv + 128);
    const f32x4* a4 = (const f32x4*)(sv + 256); const f32x4* b4 = (const f32x4*)(sv + 320);
    float sa0 = 0.f, sa1 = 0.f;
#pragma unroll
    for (int j = 0; j < 16; ++j) { const f32x4 av = a4[j]; sa0 = fmaf(S[4 * j], av.x, sa0); sa1 = fmaf(S[4 * j + 1], av.y, sa1); sa0 = fmaf(S[4 * j + 2], av.z, sa0); sa1 = fmaf(S[4 * j + 3], av.w, sa1); }
    const float sa = sa0 + sa1;
    float y0 = 0.f, y1 = 0.f;
#pragma unroll
    for (int j = 0; j < 16; ++j) {
        const f32x4 bv = b4[j], kv = k4[j], wv = w4[j], rv = r4[j];
        float t;
        t = fmaf(vi, kv.x, sa * bv.x); S[4 * j] = fmaf(S[4 * j], wv.x, t); y0 = fmaf(S[4 * j], rv.x, y0);
        t = fmaf(vi, kv.y, sa * bv.y); S[4 * j + 1] = fmaf(S[4 * j + 1], wv.y, t); y1 = fmaf(S[4 * j + 1], rv.y, y1);
        t = fmaf(vi, kv.z, sa * bv.z); S[4 * j + 2] = fmaf(S[4 * j + 2], wv.z, t); y0 = fmaf(S[4 * j + 2], rv.z, y0);
        t = fmaf(vi, kv.w, sa * bv.w); S[4 * j + 3] = fmaf(S[4 * j + 3], wv.w, t); y1 = fmaf(S[4 * j + 3], rv.w, y1);
        if ((j & 3) == 3) asm volatile("" ::: "memory");
    }
    return y0 + y1;
}
DI void rwkv_post(const Args& a, float y, float g, float bonus, int m, int c) {
    const float mean = wave_sum(y) * (1.f / 64.f); const float d = y - mean; const float var = wave_sum(d * d) * (1.f / 64.f);
    const float yn = d * rsqrtf(var + 64e-5f) * a.in[I_LNW][c] + a.in[I_LNB][c];
    ((bf16_t*)(a.ws + WS_O))[(size_t)m * D + 1024 + c] = (bf16_t)bf_rne((yn + bonus) * g);
}

DI void scan_pass1_unit(const Args& a, unsigned char* lds, int unit, int wave, int lane) {
    float* stg = (float*)lds;
    const float* RW = (const float*)(a.ws + WS_RW); const float* Lb = (const float*)(a.ws + WS_L);
    float* GB = (float*)(a.ws + WS_GB); float* YL = (float*)(a.ws + WS_YL); float* QS = (float*)(a.ws + WS_QS); float* ZP = (float*)(a.ws + WS_ZP);
    const int pp = wave >> 1, half = wave & 1, pair = unit * 4 + pp, chain = pair / NS, seg = pair % NS, b = chain >> 4, h = chain & 15, c = h * 64 + lane;
    PrepParams P; prep_params(a, P, c);
    float S[64];
    int idl = half == 1 ? lane : -1; asm volatile("" : "+v"(idl));
#pragma unroll
    for (int j = 0; j < 64; ++j) S[j] = (idl == j) ? 1.f : 0.f;
    const int mbase = b * SEQ + seg * SEGL;
    PrepRaw raw[4];
#pragma unroll
    for (int k = 0; k < 4; ++k) { const int m = mbase + half * 4 + k; prep_load(raw[k], RW + (size_t)m * CSH, rw_prev_row(a, RW, m), Lb + (size_t)m * NLO, c); }
#pragma unroll
    for (int k = 0; k < 4; ++k) { const int m = mbase + half * 4 + k; float g, bon; prep_finish(raw[k], P, stg + ((0 * 4 + pp) * TB + half * 4 + k) * 384, g, bon, lane);
        GB[((size_t)m * 16 + h) * 128 + lane] = g; GB[((size_t)m * 16 + h) * 128 + 64 + lane] = bon; }
    __syncthreads();
    float* yout = (half == 0 ? YL : QS);
    for (int blk = 0; blk < SEGL / TB; ++blk) {
        const bool more = blk + 1 < SEGL / TB;
        if (more) {
#pragma unroll
            for (int k = 0; k < 4; ++k) { const int m = mbase + (blk + 1) * TB + half * 4 + k; prep_load(raw[k], RW + (size_t)m * CSH, rw_prev_row(a, RW, m), Lb + (size_t)m * NLO, c); }
        }
        const float* sb = stg + (((blk & 1) * 4 + pp) * TB) * 384;
#pragma unroll 1
        for (int tt = 0; tt < TB; ++tt) {
            const float* sv = sb + tt * 384;
            const float vi = half == 0 ? sv[192 + lane] : 0.f;
            const float y = scan_step(S, sv, vi);
            yout[(size_t)(mbase + blk * TB + tt) * 1024 + c] = y;
        }
        if (more) {
#pragma unroll
            for (int k = 0; k < 4; ++k) { const int m = mbase + (blk + 1) * TB + half * 4 + k; float g, bon; prep_finish(raw[k], P, stg + ((((blk + 1) & 1) * 4 + pp) * TB + half * 4 + k) * 384, g, bon, lane);
                GB[((size_t)m * 16 + h) * 128 + lane] = g; GB[((size_t)m * 16 + h) * 128 + 64 + lane] = bon; }
        }
        __syncthreads();
    }
    float* zp = ZP + ((size_t)pair * 2 + half) * 4096 + lane * 64;
#pragma unroll
    for (int j = 0; j < 16; ++j) *(f32x4*)(zp + 4 * j) = (f32x4){S[4 * j], S[4 * j + 1], S[4 * j + 2], S[4 * j + 3]};
}
DI void scan_sample_unit(const Args& a, unsigned char* lds, int unit, int wave, int lane) {
    float* sv = (float*)(lds + 2 * 4 * TB * 384 * 4) + wave * 384;
    const float* RW = (const float*)(a.ws + WS_RW); const float* Lb = (const float*)(a.ws + WS_L);
    const int b = unit >> 4, h = unit & 15, c = h * 64 + lane, m = MP + b;
    PrepParams P; prep_params(a, P, c);
    PrepRaw raw; prep_load(raw, RW + (size_t)m * CSH, rw_prev_row(a, RW, m), Lb + (size_t)m * NLO, c);
    float g, bon; prep_finish(raw, P, sv, g, bon, lane);
    float S[64];
    const float* s0 = a.in[I_SWKV] + ((size_t)(b * 16 + h) * 64 + lane) * 64;
#pragma unroll
    for (int j = 0; j < 16; ++j) { const f32x4 v = *(const f32x4*)(s0 + 4 * j); S[4 * j] = v.x; S[4 * j + 1] = v.y; S[4 * j + 2] = v.z; S[4 * j + 3] = v.w; }
    const float y = scan_step(S, sv, sv[192 + lane]);
    float* so = a.out + O_SWKV + ((size_t)(b * 16 + h) * 64 + lane) * 64;
#pragma unroll
    for (int j = 0; j < 16; ++j) *(f32x4*)(so + 4 * j) = (f32x4){S[4 * j], S[4 * j + 1], S[4 * j + 2], S[4 * j + 3]};
    rwkv_post(a, y, g, bon, m, c);
}
DI void scan_pass2_unit(const Args& a, unsigned char* lds, int chain, int wave, int lane) {
    float* Ssh = (float*)lds;
    float* Psh = Ssh + 64 * 65;
    const float* ZP = (const float*)(a.ws + WS_ZP); float* SST = (float*)(a.ws + WS_SST);
    const int i = lane, j0 = wave * 8, tid = wave * 64 + lane;
    float Sr[8];
#pragma unroll
    for (int k = 0; k < 8; ++k) Sr[k] = 0.f;
    for (int s = 0; s < NS; ++s) {
        float* sst = SST + ((size_t)chain * NS + s) * 4096 + i * 64 + j0;
        *(f32x4*)sst = (f32x4){Sr[0], Sr[1], Sr[2], Sr[3]}; *(f32x4*)(sst + 4) = (f32x4){Sr[4], Sr[5], Sr[6], Sr[7]};
        const float* Zs = ZP + ((size_t)(chain * NS + s) * 2 + 0) * 4096; const float* Ps = Zs + 4096;
#pragma unroll
        for (int k = 0; k < 8; ++k) Ssh[i * 65 + j0 + k] = Sr[k];
        *(f32x4*)(Psh + tid * 8) = *(const f32x4*)(Ps + tid * 8); *(f32x4*)(Psh + tid * 8 + 4) = *(const f32x4*)(Ps + tid * 8 + 4);
        const f32x4 z0 = *(const f32x4*)(Zs + i * 64 + j0), z1 = *(const f32x4*)(Zs + i * 64 + j0 + 4);
        float nw[8] = {z0.x, z0.y, z0.z, z0.w, z1.x, z1.y, z1.z, z1.w};
        __syncthreads();
        if (s > 0) {
#pragma unroll 8
            for (int l = 0; l < 64; ++l) {
                const float sl = Ssh[i * 65 + l];
                const f32x4 p0 = *(const f32x4*)(Psh + l * 64 + j0), p1 = *(const f32x4*)(Psh + l * 64 + j0 + 4);
                nw[0] = fmaf(sl, p0.x, nw[0]); nw[1] = fmaf(sl, p0.y, nw[1]); nw[2] = fmaf(sl, p0.z, nw[2]); nw[3] = fmaf(sl, p0.w, nw[3]);
                nw[4] = fmaf(sl, p1.x, nw[4]); nw[5] = fmaf(sl, p1.y, nw[5]); nw[6] = fmaf(sl, p1.z, nw[6]); nw[7] = fmaf(sl, p1.w, nw[7]);
            }
        }
        __syncthreads();
#pragma unroll
        for (int k = 0; k < 8; ++k) Sr[k] = nw[k];
    }
    float* so = a.out + O_PWKV + (size_t)chain * 4096 + i * 64 + j0;
    *(f32x4*)so = (f32x4){Sr[0], Sr[1], Sr[2], Sr[3]}; *(f32x4*)(so + 4) = (f32x4){Sr[4], Sr[5], Sr[6], Sr[7]};
}
DI void scan_pass3_unit(const Args& a, unsigned char* lds, int unit, int wave, int lane) {
    float* qsh = (float*)lds + wave * 2048;
    const float* SST = (const float*)(a.ws + WS_SST); const float* YL = (const float*)(a.ws + WS_YL); const float* QS = (const float*)(a.ws + WS_QS); const float* GB = (const float*)(a.ws + WS_GB);
    const int sub = unit & 3, pair = unit >> 2, chain = pair / NS, seg = pair % NS, b = chain >> 4, h = chain & 15, c = h * 64 + lane;
    const int m0 = b * SEQ + seg * SEGL + sub * 32;
    float S[64];
    const float* sr = SST + (size_t)pair * 4096 + lane * 64;
#pragma unroll
    for (int j = 0; j < 16; ++j) { const f32x4 v = *(const f32x4*)(sr + 4 * j); S[4 * j] = v.x; S[4 * j + 1] = v.y; S[4 * j + 2] = v.z; S[4 * j + 3] = v.w; }
#pragma unroll 8
    for (int t = 0; t < 32; ++t) qsh[t * 64 + lane] = QS[(size_t)(m0 + t) * 1024 + c];
    __builtin_amdgcn_fence(__ATOMIC_RELEASE, "wavefront"); asm volatile("s_waitcnt lgkmcnt(0)" ::: "memory");
#pragma unroll 1
    for (int t = 0; t < 32; ++t) {
        const int m = m0 + t;
        const f32x4* q4 = (const f32x4*)(qsh + t * 64);
        float c0 = 0.f, c1 = 0.f;
#pragma unroll
        for (int j = 0; j < 16; ++j) { const f32x4 qv = q4[j]; c0 = fmaf(S[4 * j], qv.x, c0); c1 = fmaf(S[4 * j + 1], qv.y, c1); c0 = fmaf(S[4 * j + 2], qv.z, c0); c1 = fmaf(S[4 * j + 3], qv.w, c1); }
        const float y = YL[(size_t)m * 1024 + c] + (c0 + c1);
        const float g = GB[((size_t)m * 16 + h) * 128 + lane], bon = GB[((size_t)m * 16 + h) * 128 + 64 + lane];
        rwkv_post(a, y, g, bon, m, c);
    }
    asm volatile("s_waitcnt lgkmcnt(0)" ::: "memory");
}

DI void conv_item(const Args& a, int item) {
    const int m = item / (FF / 8), f = (item % (FF / 8)) * 8;
    const bf16_t* U = (const bf16_t*)(a.ws + WS_U); bf16_t* ACT = (bf16_t*)(a.ws + WS_ACT);
    if (m >= MT) { *(u32x4*)(ACT + (size_t)m * FF + f) = (u32x4){0u, 0u, 0u, 0u}; return; }
    const float* cw = a.in[I_FCW]; const float* cb = a.in[I_FCB];
    float res[2][8];
#pragma unroll
    for (int part = 0; part < 2; ++part) {
        const int col = part * FF + f;
        float u0[8], u1[8], u2[8];
        { const u32x4 w = *(const u32x4*)(U + (size_t)m * FF2 + col);
          u0[0] = __uint_as_float(w.x << 16); u0[1] = __uint_as_float(w.x & 0xffff0000u); u0[2] = __uint_as_float(w.y << 16); u0[3] = __uint_as_float(w.y & 0xffff0000u);
          u0[4] = __uint_as_float(w.z << 16); u0[5] = __uint_as_float(w.z & 0xffff0000u); u0[6] = __uint_as_float(w.w << 16); u0[7] = __uint_as_float(w.w & 0xffff0000u); }
        if (m < MP) {
            const int t = m & (SEQ - 1);
            u32x4 w1 = {0u, 0u, 0u, 0u}, w2 = {0u, 0u, 0u, 0u};
            if (t >= 1) w1 = *(const u32x4*)(U + (size_t)(m - 1) * FF2 + col);
            if (t >= 2) w2 = *(const u32x4*)(U + (size_t)(m - 2) * FF2 + col);
            u1[0] = __uint_as_float(w1.x << 16); u1[1] = __uint_as_float(w1.x & 0xffff0000u); u1[2] = __uint_as_float(w1.y << 16); u1[3] = __uint_as_float(w1.y & 0xffff0000u);
            u1[4] = __uint_as_float(w1.z << 16); u1[5] = __uint_as_float(w1.z & 0xffff0000u); u1[6] = __uint_as_float(w1.w << 16); u1[7] = __uint_as_float(w1.w & 0xffff0000u);
            u2[0] = __uint_as_float(w2.x << 16); u2[1] = __uint_as_float(w2.x & 0xffff0000u); u2[2] = __uint_as_float(w2.y << 16); u2[3] = __uint_as_float(w2.y & 0xffff0000u);
            u2[4] = __uint_as_float(w2.z << 16); u2[5] = __uint_as_float(w2.z & 0xffff0000u); u2[6] = __uint_as_float(w2.w << 16); u2[7] = __uint_as_float(w2.w & 0xffff0000u);
        } else {
            const float* st = a.in[I_SFFN] + (size_t)(m - MP) * 2 * FF2 + col;
            float* so = a.out + O_SFFN + (size_t)(m - MP) * 2 * FF2 + col;
#pragma unroll
            for (int j = 0; j < 8; ++j) { u2[j] = st[j]; u1[j] = st[FF2 + j]; so[j] = u1[j]; }
        }
#pragma unroll
        for (int j = 0; j < 8; ++j) res[part][j] = cb[col + j] + cw[col + j] * u2[j] + cw[FF2 + col + j] * u1[j] + cw[2 * FF2 + col + j] * u0[j];
    }
    float o[8];
#pragma unroll
    for (int j = 0; j < 8; ++j) { const float gt = res[0][j]; o[j] = gt / (1.f + __expf(-gt)) * res[1][j]; }
    u32x4 w; w.x = pk2(o[0], o[1]); w.y = pk2(o[2], o[3]); w.z = pk2(o[4], o[5]); w.w = pk2(o[6], o[7]);
    *(u32x4*)(ACT + (size_t)m * FF + f) = w;
}


#define XB_TMO      128
#define XB_XCNT(j)  (256  + 64 * (j))
#define XB_XSUB(j)  (1280 + 64 * (j))
#define XB_XGEN(j)  (2304 + 64 * (j))
#define XB_TOP      3328
#define XB_TOPGEN   3392
#define XCD_BAR_WORDS 3456
#define XB_SPIN_CAP (1u << 18)
DI unsigned xb_ld(unsigned* p)              { return __hip_atomic_load(p, __ATOMIC_RELAXED, __HIP_MEMORY_SCOPE_AGENT); }
DI unsigned xb_add(unsigned* p, unsigned v) { return __hip_atomic_fetch_add(p, v, __ATOMIC_RELAXED, __HIP_MEMORY_SCOPE_AGENT); }
DI unsigned xb_xcc_id() { return (unsigned)__builtin_amdgcn_s_getreg((3 << 11) | 20) & 0xFu; }
#define XB_SPIN(cond, bar) do { unsigned _sp = 0; while (cond) { __builtin_amdgcn_s_sleep(1); \
    if ((++_sp & 255u) == 0u) { if (xb_ld(&(bar)[XB_TMO])) break; if (_sp > XB_SPIN_CAP) { atomicAdd(&(bar)[XB_TMO], 1u); break; } } } } while (0)
struct XcdBarrier { unsigned* bar; unsigned x; volatile LAS unsigned* st; };
DI XcdBarrier xcd_barrier_post(unsigned* bar, volatile LAS unsigned* st) {
    XcdBarrier b; b.bar = bar; b.x = xb_xcc_id(); b.st = st;
    if (threadIdx.x == 0) (void)xb_add(&bar[XB_XCNT(b.x)], 1u);
    return b;
}
DI void xcd_barrier_complete(unsigned* bar, unsigned x, unsigned& nloc, unsigned& nx) {
    const unsigned G = gridDim.x * gridDim.y * gridDim.z;
    unsigned sum, cnt, mine, sp = 0u;
    for (;;) {
        sum = 0u; cnt = 0u; mine = 0u;
#pragma unroll
        for (unsigned j = 0; j < 16; ++j) { const unsigned c = xb_ld(&bar[XB_XCNT(j)]); sum += c; cnt += (c > 0u) ? 1u : 0u; mine = (j == x) ? c : mine; }
        if (sum == G) break;
        __builtin_amdgcn_s_sleep(1);
        if ((++sp & 255u) == 0u) { if (xb_ld(&bar[XB_TMO])) break; if (sp > XB_SPIN_CAP) { atomicAdd(&bar[XB_TMO], 1u); break; } }
    }
    nloc = mine > 0u ? mine : 1u; nx = cnt > 0u ? cnt : 1u;
}
DI void xcd_barrier(const XcdBarrier& b) {
    asm volatile("s_waitcnt vmcnt(0)" ::: "memory");
    __syncthreads();
    if (threadIdx.x == 0) {
        unsigned* bar = b.bar;
        __builtin_amdgcn_s_waitcnt(0);
        unsigned nloc = b.st[0], nx = b.st[1];
        if (nloc == 0u) { xcd_barrier_complete(bar, b.x, nloc, nx); b.st[0] = nloc; b.st[1] = nx; }
        const unsigned old = xb_add(&bar[XB_XSUB(b.x)], 1u);
        const unsigned gen = old / nloc;
        if (old + 1u == (gen + 1u) * nloc) {
            __builtin_amdgcn_fence(__ATOMIC_RELEASE, "agent");
            asm volatile("s_waitcnt vmcnt(0)" ::: "memory");
            const unsigned og = xb_add(&bar[XB_TOP], 1u);
            const unsigned tg = og / nx;
            if (og + 1u == (tg + 1u) * nx) xb_add(&bar[XB_TOPGEN], 1u);
            else XB_SPIN(xb_ld(&bar[XB_TOPGEN]) == tg, bar);
            __builtin_amdgcn_fence(__ATOMIC_ACQUIRE, "agent");
            xb_add(&bar[XB_XGEN(b.x)], 1u);
            asm volatile("s_waitcnt vmcnt(0)" ::: "memory");
        } else {
            XB_SPIN(xb_ld(&bar[XB_XGEN(b.x)]) == gen, bar);
            __builtin_amdgcn_fence(__ATOMIC_ACQUIRE, "agent");
            asm volatile("s_waitcnt vmcnt(0)" ::: "memory");
        }
    }
    __syncthreads();
}

DI void skinny_unit(const bf16_t* A, int lda, const bf16_t* Bt, int K, int unit, const float* base, int ldb, float* out, int ldo, unsigned char* lds, int wave, int lane) {
    float* red = (float*)lds;
    const int n0 = unit * 32, r = lane & 31, hh = lane >> 5, kw = K / 8, kb = wave * kw;
    f32x16 acc;
#pragma unroll
    for (int i = 0; i < 16; ++i) acc[i] = 0.f;
    const bf16_t* ap = A + (size_t)r * lda + kb + 8 * hh; const bf16_t* bp = Bt + (size_t)(n0 + r) * K + kb + 8 * hh;
#pragma unroll 4
    for (int k = 0; k < kw; k += 16) {
        const bf16x8 af = *(const bf16x8*)(ap + k), bf = *(const bf16x8*)(bp + k);
        acc = __builtin_amdgcn_mfma_f32_32x32x16_bf16(af, bf, acc, 0, 0, 0);
    }
#pragma unroll
    for (int i = 0; i < 16; ++i) red[(wave * 16 + i) * 64 + lane] = acc[i];
    __syncthreads();
#pragma unroll
    for (int q = 0; q < 2; ++q) {
        const int o = threadIdx.x + 512 * q, i = o >> 6, ln = o & 63;
        float sum = 0.f;
#pragma unroll
        for (int w = 0; w < 8; ++w) sum += red[(w * 16 + i) * 64 + ln];
        const int row = crow(i, ln >> 5), col = n0 + (ln & 31);
        out[(size_t)row * ldo + col] = base[(size_t)row * ldb + col] + sum;
    }
    __syncthreads();
}

constexpr int NPH = 14;
template <bool COOP>
__global__ void __launch_bounds__(NTHREADS, 2) mk_fwd(Args a) {
    extern __shared__ __attribute__((aligned(16))) unsigned char lds[];
    const int tid = threadIdx.x, lane = tid & 63, wave = __builtin_amdgcn_readfirstlane(tid >> 6);
    const int G = gridDim.x, bid = blockIdx.x, gw = bid * NWAVES + wave, ngw = G * NWAVES;
    unsigned char* ws = a.ws;
    LAS unsigned char* ldsl = (LAS unsigned char*)lds;
#ifndef PHMASK
#define PHMASK 0xffff
#endif
#define IN(k) (((PHMASK >> (k)) & 1) && a.ph_lo <= (k) && (k) < a.ph_hi)
    XcdBarrier xbar; xbar.bar = (unsigned*)(ws + WS_BAR); xbar.x = 0; xbar.st = nullptr;
    if (COOP) {
        volatile LAS unsigned* st = (volatile LAS unsigned*)(ldsl + LDS_BYTES - 16);
        if (tid < 4) st[tid] = 0u;
        __syncthreads();
        xbar = xcd_barrier_post((unsigned*)(ws + WS_BAR), st);
    }
#define SEAM(k) do { if (COOP && IN(k) && IN((k) + 1)) { if ((k) == 0) cg::this_grid().sync(); else xcd_barrier(xbar); } } while (0)

    if (IN(0)) phase_prologue(a, lds, gw, ngw, lane, wave);
    SEAM(0);
    if (IN(1)) {
        pg8::Gemm g{(const bf16_t*)(ws + WS_H), (const bf16_t*)(ws + WS_WIN), MPAD, NIN, D}; pg8::StaticOrder S; S.init(MPAD, NIN, G, bid);
        EpiIn E{(bf16_t*)(ws + WS_QB), (bf16_t*)(ws + WS_KB), (bf16_t*)(ws + WS_VB), (float*)(ws + WS_RW), a.out};
        pg8::gemm_phase<EpiIn>(ldsl, g, S, E);
    }
    SEAM(1);
    if (IN(2)) {
        for (int m = gw; m < MPAD; m += ngw) lora_input_row(a, m, lane);
        for (int u = gw; u < 512; u += ngw) attn_sample_unit(a, u, lane);
        for (int u = gw; u < 64 * 3 * 64; u += ngw) attn_prompt_unit(a, u, lane);
    }
    SEAM(2);
    if (IN(3)) {
        pg8::Gemm g{(const bf16_t*)(ws + WS_ALO), (const bf16_t*)(ws + WS_WLO), MPAD, NLO, KLO}; pg8::StaticOrder S; S.init(MPAD, NLO, G, bid);
        EpiF32 E{(float*)(ws + WS_L), NLO};
        pg8::gemm_phase<EpiF32>(ldsl, g, S, E);
        for (int t = gw; t < MP * 16; t += ngw) attn_merge_task(a, t, lane);
    }
    SEAM(3);
    if (IN(4)) {
#ifndef NO_P1
        for (int u = bid; u < 64 * NS / 4; u += G) scan_pass1_unit(a, lds, u, wave, lane);
#endif
#ifndef NO_SS
        for (int u = gw; u < 512; u += ngw) scan_sample_unit(a, lds, u, wave, lane);
#endif
    }
    SEAM(4);
    if (IN(5)) { for (int ch = bid; ch < 64; ch += G) scan_pass2_unit(a, lds, ch, wave, lane); }
    SEAM(5);
    if (IN(6)) { for (int u = gw; u < 64 * NS * 4; u += ngw) scan_pass3_unit(a, lds, u, wave, lane); }
    SEAM(6);
    if (IN(7)) {
        pg8::Gemm g{(const bf16_t*)(ws + WS_O), (const bf16_t*)(ws + WS_WO), MP, D, D}; pg8::StaticOrder S; S.init(MP, D, G, bid);
        EpiWo E{a.in[I_XP], a.in[I_XS], (float*)(ws + WS_X1)};
        pg8::gemm_phase<EpiWo>(ldsl, g, S, E);
        for (int u = bid; u < D / 32; u += G)
            skinny_unit((const bf16_t*)(ws + WS_O) + (size_t)MP * D, D, (const bf16_t*)(ws + WS_WO), D, u, a.in[I_XS], D, (float*)(ws + WS_X1) + (size_t)MP * D, D, lds, wave, lane);
    }
    SEAM(7);
    if (IN(8)) { for (int m = gw; m < MT; m += ngw) rms_row_bf16((const float*)(ws + WS_X1) + (size_t)m * D, a.in[I_NFG], (bf16_t*)(ws + WS_H) + (size_t)m * D, lane); }
    SEAM(8);
    if (IN(9)) {
        pg8::Gemm g{(const bf16_t*)(ws + WS_H), (const bf16_t*)(ws + WS_WUP), MPAD, FF2, D}; pg8::StaticOrder S; S.init(MPAD, FF2, G, bid);
        EpiUp E{(bf16_t*)(ws + WS_U), a.out};
        pg8::gemm_phase<EpiUp>(ldsl, g, S, E);
    }
    SEAM(9);
    if (IN(10)) { for (int it = bid * NTHREADS + tid; it < MPAD * (FF / 8); it += G * NTHREADS) conv_item(a, it); }
    SEAM(10);
    if (IN(11)) {
        pg8::Gemm g{(const bf16_t*)(ws + WS_ACT), (const bf16_t*)(ws + WS_WDN), MP, D, FF}; pg8::StaticOrder S; S.init(MP, D, G, bid);
        EpiDn E{(float*)(ws + WS_X1)};
        pg8::gemm_phase<EpiDn>(ldsl, g, S, E);
        for (int u = bid; u < D / 32; u += G)
            skinny_unit((const bf16_t*)(ws + WS_ACT) + (size_t)MP * FF, FF, (const bf16_t*)(ws + WS_WDN), FF, u, (const float*)(ws + WS_X1) + (size_t)MP * D, D, (float*)(ws + WS_X1) + (size_t)MP * D, D, lds, wave, lane);
    }
    SEAM(11);
    if (IN(12)) {
        for (int m = gw; m < MT; m += ngw)
            rms_row_f32((const float*)(ws + WS_X1) + (size_t)m * D, a.in[I_NFIN], m < MP ? a.out + O_YP + (size_t)m * D : a.out + O_YS + (size_t)(m - MP) * D, lane);
    }
#undef IN
#undef SEAM
}

#ifndef MK_ONE_LAUNCH
#define MK_ONE_LAUNCH 1
#endif

extern "C" void kernel_launch(void* const* d_in, const int* in_sizes, int n_in, void* d_out, int out_size, void* d_ws, size_t ws_size, hipStream_t stream) {
    static int grid = 0;
    if (!grid) {
        if (n_in != 28 || (size_t)out_size != O_END || ws_size < WS_END) fprintf(stderr, "kernel_launch: unexpected shapes: n_in %d out %d (want %zu) ws %zu (want %zu)\n", n_in, out_size, O_END, ws_size, WS_END);
        int dev = 0, cus = 0; hipGetDevice(&dev); hipDeviceGetAttribute(&cus, hipDeviceAttributeMultiprocessorCount, dev);
        hipFuncSetAttribute((const void*)mk_fwd<true>, hipFuncAttributeMaxDynamicSharedMemorySize, LDS_BYTES);
        hipFuncSetAttribute((const void*)mk_fwd<false>, hipFuncAttributeMaxDynamicSharedMemorySize, LDS_BYTES);
        int per_cu = 0; hipOccupancyMaxActiveBlocksPerMultiprocessor(&per_cu, mk_fwd<true>, NTHREADS, LDS_BYTES);
        if (per_cu < 1) { fprintf(stderr, "kernel_launch: occupancy query says %d blocks/CU\n", per_cu); per_cu = 1; }
        grid = cus > 0 ? cus : 256;
    }
    Args a; memset(&a, 0, sizeof(a));
    for (int i = 0; i < 28; ++i) a.in[i] = (const float*)d_in[i];
    a.out = (float*)d_out; a.ws = (unsigned char*)d_ws;
#if MK_ONE_LAUNCH
    if (hipMemsetAsync((char*)d_ws + WS_BAR, 0, BAR_BYTES, stream) != hipSuccess) { fprintf(stderr, "kernel_launch: memset of the barrier words failed\n"); return; }
    a.ph_lo = 0; a.ph_hi = NPH;
    void* args[] = {&a};
    hipError_t e = hipLaunchCooperativeKernel((const void*)mk_fwd<true>, dim3(grid), dim3(NTHREADS), args, LDS_BYTES, stream);
    if (e != hipSuccess) fprintf(stderr, "cooperative launch failed: %s (grid %d)\n", hipGetErrorString(e), grid);
#else
    for (int p = 0; p < 13; ++p) {
        a.ph_lo = p; a.ph_hi = p + 1;
        mk_fwd<false><<<dim3(grid), dim3(NTHREADS), LDS_BYTES, stream>>>(a);
    }
#endif
}
```

```cpp
#include <hip/hip_runtime.h>
#include <hip/hip_cooperative_groups.h>
#include <cstdio>
#include <cstdint>
#include <cstring>
namespace cg = cooperative_groups;

#define DI __device__ __forceinline__
#define LAS __attribute__((address_space(3)))
typedef unsigned short bf16_t;
typedef short bf16x8 __attribute__((ext_vector_type(8)));
typedef float f32x4 __attribute__((ext_vector_type(4)));
typedef float f32x16 __attribute__((ext_vector_type(16)));
typedef unsigned u32x4 __attribute__((ext_vector_type(4)));
typedef unsigned u32x2 __attribute__((ext_vector_type(2)));

constexpr int D = 2048, MP = 8192, MS = 32, MT = 8224, MPAD = 8448, SEQ = 2048;
constexpr int CIN = 6432, NIN = 6656, CSH = 3360, FF2 = 11264, FF = 5632;
constexpr int NLO = 3072, KLO = 384;
constexpr int NS = 16, SEGL = 128, TB = 8;
constexpr int NTHREADS = 512, NWAVES = 8;
constexpr int LDS_BYTES = 131072 + 16384;

constexpr size_t O_YP = 0;
constexpr size_t O_YS = O_YP + (size_t)MP * D;
constexpr size_t O_PK = O_YS + (size_t)MS * D;
constexpr size_t O_PV = O_PK + (size_t)MP * 1024;
constexpr size_t O_PRW = O_PV + (size_t)MP * 1024;
constexpr size_t O_PWKV = O_PRW + (size_t)4 * CSH;
constexpr size_t O_PFFN = O_PWKV + (size_t)4 * 16 * 4096;
constexpr size_t O_SK = O_PFFN + (size_t)4 * 2 * FF2;
constexpr size_t O_SV = O_SK + (size_t)MS * 1024;
constexpr size_t O_SRW = O_SV + (size_t)MS * 1024;
constexpr size_t O_SWKV = O_SRW + (size_t)MS * CSH;
constexpr size_t O_SFFN = O_SWKV + (size_t)MS * 16 * 4096;
constexpr size_t O_END = O_SFFN + (size_t)MS * 2 * FF2;

constexpr size_t al256(size_t x) { return (x + 255) & ~(size_t)255; }
constexpr size_t WS_WIN = 0;
constexpr size_t WS_WO = WS_WIN + al256((size_t)NIN * D * 2);
constexpr size_t WS_WUP = WS_WO + al256((size_t)D * D * 2);
constexpr size_t WS_WDN = WS_WUP + al256((size_t)FF2 * D * 2);
constexpr size_t WS_WLO = WS_WDN + al256((size_t)D * FF * 2);
constexpr size_t WS_H = WS_WLO + al256((size_t)NLO * KLO * 2);
constexpr size_t WS_QB = WS_H + al256((size_t)MPAD * D * 2);
constexpr size_t WS_KB = WS_QB + al256((size_t)MPAD * 1024 * 2);
constexpr size_t WS_VB = WS_KB + al256((size_t)MPAD * 1024 * 2);
constexpr size_t WS_ALO = WS_VB + al256((size_t)MPAD * 1024 * 2);
constexpr size_t WS_O = WS_ALO + al256((size_t)MPAD * KLO * 2);
constexpr size_t WS_GB = WS_O + al256((size_t)MPAD * D * 2);
constexpr size_t WS_YL = WS_GB + al256((size_t)MT * 2048 * 2);
constexpr size_t WS_QS = WS_YL + al256((size_t)MP * 1024 * 4);
constexpr size_t WS_ZP = WS_QS + al256((size_t)MP * 1024 * 4);
constexpr size_t WS_SST = WS_ZP + al256((size_t)64 * NS * 2 * 4096 * 4);
constexpr size_t WS_X1 = WS_SST + al256((size_t)64 * NS * 4096 * 4);
constexpr size_t WS_PML = WS_X1 + al256((size_t)MPAD * D * 4);
constexpr size_t WS_RA = WS_PML + al256((size_t)3 * MP * 16 * 2 * 4);
constexpr size_t WS_RW = WS_RA;
constexpr size_t WS_L = WS_RW + al256((size_t)MPAD * CSH * 4);
constexpr size_t RA_BYTES_1 = al256((size_t)MPAD * CSH * 4) + al256((size_t)MPAD * NLO * 4);
constexpr size_t RA_BYTES_2 = al256((size_t)MPAD * FF2 * 2);
constexpr size_t WS_U = WS_RA;
constexpr size_t WS_RB = WS_RA + (RA_BYTES_1 > RA_BYTES_2 ? RA_BYTES_1 : RA_BYTES_2);
constexpr size_t WS_PART = WS_RB;
constexpr size_t WS_ACT = WS_RB;
constexpr size_t RB_BYTES_1 = al256((size_t)3 * MP * 1024 * 4);
constexpr size_t RB_BYTES_2 = al256((size_t)MPAD * FF * 2);
constexpr size_t WS_BAR = WS_RB + (RB_BYTES_1 > RB_BYTES_2 ? RB_BYTES_1 : RB_BYTES_2);
constexpr size_t BAR_BYTES = 16384;
constexpr size_t WS_END = WS_BAR + BAR_BYTES;

struct Args {
    const float* in[28];
    float* out;
    unsigned char* ws;
    int ph_lo, ph_hi;
};
enum { I_XP = 0, I_XS, I_CK, I_CV, I_SSH, I_SWKV, I_SFFN, I_NMG, I_WIN, I_AOG, I_MU, I_W0, I_WUP, I_A0, I_AUP, I_GUP,
       I_KK, I_KA, I_RK, I_LNW, I_LNB, I_WO, I_NFG, I_FUP, I_FCW, I_FCB, I_FDN, I_NFIN };

DI unsigned bf_rne(float f) { unsigned u = __float_as_uint(f); u += 0x7fffu + ((u >> 16) & 1u); return u >> 16; }
DI unsigned pk2(float lo, float hi) { return bf_rne(lo) | (bf_rne(hi) << 16); }
DI float bf2f(unsigned short b) { return __uint_as_float(((unsigned)b) << 16); }
#define DPP_ADD(v, ctrl) ((v) + __int_as_float(__builtin_amdgcn_update_dpp(0, __float_as_int(v), (ctrl), 0xf, 0xf, false)))
DI float wave_sum(float v) {
    v = DPP_ADD(v, 0xB1);
    v = DPP_ADD(v, 0x4E);
    v = DPP_ADD(v, 0x141);
    v = DPP_ADD(v, 0x140);
    const float s0 = __int_as_float(__builtin_amdgcn_readlane(__float_as_int(v), 0)), s1 = __int_as_float(__builtin_amdgcn_readlane(__float_as_int(v), 16));
    const float s2 = __int_as_float(__builtin_amdgcn_readlane(__float_as_int(v), 32)), s3 = __int_as_float(__builtin_amdgcn_readlane(__float_as_int(v), 48));
    return (s0 + s1) + (s2 + s3);
}

namespace pg8 {
constexpr int BM = 256, BK = 64, HALF = 128, HTB = HALF * BK * 2, STAGE_BYTES = 8 * HTB, NXCD = 8, WGM = 8;
DI int lds_byte(int r, int c) { const int st = (r >> 4) * 2 + (c >> 5), rr = r & 15, cc = c & 31, ob = rr * 64 + cc * 2; return st * 1024 + (ob ^ (((ob >> 9) & 1) << 5)); }
DI void stage_rc(int b, int& R, int& C) { const int st = b / 1024, sb = b % 1024, swz = sb ^ (((sb >> 9) & 1) << 5); R = (st >> 1) * 16 + swz / 64; C = (st & 1) * 32 + (swz % 64) / 2; }
struct Unit { int pm, pn; };
struct Gemm { const bf16_t* A; const bf16_t* Bt; int M, N, K; };
struct StaticOrder {
    int nM, nN, nwg, G, c;
    DI void init(int M, int N, int G_, int c_) { nM = M / BM; nN = N / BM; nwg = nM * nN; G = G_; c = c_; }
    DI bool next(int i, Unit& u) const {
        const long L = (long)i * G + c; if (L >= nwg) return false;
        int wgid = (int)L; { const int q = nwg / NXCD, r = nwg % NXCD, xcd = wgid % NXCD, off = wgid / NXCD; wgid = (xcd < r ? xcd * (q + 1) : r * (q + 1) + (xcd - r) * q) + off; }
        const int nig = WGM * nN, gid = wgid / nig, fm = gid * WGM, gsz = (nM - fm) < WGM ? (nM - fm) : WGM;
        u.pm = fm + ((wgid % nig) % gsz); u.pn = (wgid % nig) / gsz; return true;
    }
};

template <class Epi>
DI void gemm_phase(LAS unsigned char* lds, const Gemm g, const StaticOrder& S, const Epi& E) {
    const int tid = threadIdx.x, wid = __builtin_amdgcn_readfirstlane(tid >> 6), lane = tid & 63, wr = wid >> 2, wc = wid & 3, fr = lane & 15, fq = lane >> 4;
    const int K = g.K, nt = K / BK;
    unsigned voffA[2];
#pragma unroll
    for (int i = 0; i < 2; ++i) { int R, C; stage_rc(tid * 16 + i * 8192, R, C); voffA[i] = (unsigned)(R * K + C) * 2u; }
    const size_t kstep = (size_t)(BK * 2);
    const size_t hstep = (size_t)HALF * K * 2;
    const size_t tstep = 2 * hstep;
    const unsigned ldsw = (unsigned)wid * 1024u;
    const int aoff = lds_byte(wr * 64 + fr, fq * 8), boff = lds_byte(wc * 32 + fr, fq * 8);
#define PG8_SA(b, h) (((b) * 2 + (h)) * HTB)
#define PG8_SB(b, h) ((4 + (b) * 2 + (h)) * HTB)
#define PG8_STAGE(bufoff, gbase, voff) do { _Pragma("unroll") for (int _i = 0; _i < 2; ++_i) \
        __builtin_amdgcn_global_load_lds((const unsigned*)((const char*)(gbase) + (voff)[_i]), (LAS unsigned*)(lds + (bufoff) + ldsw + _i * 8192), 16, 0, 0); } while (0)
#define PG8_LDA(dst, b, h) do { _Pragma("unroll") for (int m = 0; m < 4; ++m) _Pragma("unroll") for (int k = 0; k < 2; ++k) dst[m][k] = *(const LAS bf16x8*)(lds + PG8_SA(b, h) + aoff + m * 2048 + k * 1024); } while (0)
#define PG8_LDB(dst, b, h) do { _Pragma("unroll") for (int n = 0; n < 2; ++n) _Pragma("unroll") for (int k = 0; k < 2; ++k) dst[n][k] = *(const LAS bf16x8*)(lds + PG8_SB(b, h) + boff + n * 2048 + k * 1024); } while (0)
#define PG8_MMA(ai, bj, At, Bt) do { __builtin_amdgcn_s_setprio(1); _Pragma("unroll") for (int m = 0; m < 4; ++m) _Pragma("unroll") for (int n = 0; n < 2; ++n) _Pragma("unroll") for (int k = 0; k < 2; ++k) \
        acc[ai][bj][m][n] = __builtin_amdgcn_mfma_f32_16x16x32_bf16(Bt[n][k], At[m][k], acc[ai][bj][m][n], 0, 0, 0); __builtin_amdgcn_s_setprio(0); } while (0)
#define PG8_WAIT_V(n) asm volatile("s_waitcnt vmcnt(" #n ")" ::: "memory")
#define PG8_WAIT_L(n) asm volatile("s_waitcnt lgkmcnt(" #n ")" ::: "memory")
#define PG8_BAR __builtin_amdgcn_s_barrier()
#define PG8_SCHED __builtin_amdgcn_sched_barrier(0)
    Unit cur, nxt; int ui = 0;
    if (!S.next(0, cur)) return;
    f32x4 acc[2][2][4][2];
#pragma unroll
    for (int a = 0; a < 2; ++a)
#pragma unroll
        for (int b = 0; b < 2; ++b)
#pragma unroll
            for (int m = 0; m < 4; ++m)
#pragma unroll
                for (int n = 0; n < 2; ++n) acc[a][b][m][n] = (f32x4){0.f, 0.f, 0.f, 0.f};
    bf16x8 At[4][2], B0[2][2], B1[2][2];
    const char* cA = (const char*)g.A + (size_t)cur.pm * tstep; const char* cB = (const char*)g.Bt + (size_t)cur.pn * tstep;
    PG8_STAGE(PG8_SB(0, 0), cB, voffA); PG8_STAGE(PG8_SA(0, 0), cA, voffA); PG8_STAGE(PG8_SB(0, 1), cB + hstep, voffA); PG8_STAGE(PG8_SA(0, 1), cA + hstep, voffA);
    if (wr == 1) PG8_BAR;
    PG8_WAIT_V(4); PG8_BAR;
    PG8_STAGE(PG8_SB(1, 0), cB + kstep, voffA); PG8_STAGE(PG8_SA(1, 0), cA + kstep, voffA); PG8_STAGE(PG8_SB(1, 1), cB + hstep + kstep, voffA);
    PG8_WAIT_V(6); PG8_BAR;
    for (;;) {
        const bool has_next = S.next(ui + 1, nxt);
        const char* nA = has_next ? (const char*)g.A + (size_t)nxt.pm * tstep : cA; const char* nB = has_next ? (const char*)g.Bt + (size_t)nxt.pn * tstep : cB;
        for (int t = 0; t < nt; t += 2) {
            const bool last = (t == nt - 2);
            const char* a1 = cA + (size_t)(t + 1) * kstep;
            const char* a2 = last ? nA : cA + (size_t)(t + 2) * kstep; const char* b2 = last ? nB : cB + (size_t)(t + 2) * kstep;
            const char* a3 = a2 + kstep; const char* b3 = b2 + kstep;
            PG8_LDB(B0, 0, 0); PG8_SCHED; PG8_LDA(At, 0, 0); PG8_STAGE(PG8_SA(1, 1), a1 + hstep, voffA);
            PG8_WAIT_L(8); PG8_BAR; PG8_WAIT_L(0); PG8_MMA(0, 0, At, B0); PG8_BAR; PG8_SCHED;
            PG8_LDB(B1, 0, 1); PG8_STAGE(PG8_SB(0, 0), b2, voffA);
            PG8_BAR; PG8_WAIT_L(0); PG8_MMA(0, 1, At, B1); PG8_BAR;
            PG8_LDA(At, 0, 1); PG8_STAGE(PG8_SA(0, 0), a2, voffA);
            PG8_BAR; PG8_WAIT_L(0); PG8_MMA(1, 0, At, B0); PG8_BAR; PG8_SCHED;
            PG8_STAGE(PG8_SB(0, 1), b2 + hstep, voffA);
            PG8_WAIT_V(6); PG8_BAR; PG8_MMA(1, 1, At, B1); PG8_BAR;
            PG8_LDB(B0, 1, 0); PG8_SCHED; PG8_LDA(At, 1, 0); PG8_STAGE(PG8_SA(0, 1), a2 + hstep, voffA);
            PG8_WAIT_L(8); PG8_BAR; PG8_WAIT_L(0); PG8_MMA(0, 0, At, B0); PG8_BAR; PG8_SCHED;
            PG8_LDB(B1, 1, 1); PG8_STAGE(PG8_SB(1, 0), b3, voffA);
            PG8_BAR; PG8_WAIT_L(0); PG8_MMA(0, 1, At, B1); PG8_BAR;
            PG8_LDA(At, 1, 1); PG8_STAGE(PG8_SA(1, 0), a3, voffA);
            PG8_BAR; PG8_WAIT_L(0); PG8_MMA(1, 0, At, B0); PG8_BAR; PG8_SCHED;
            PG8_STAGE(PG8_SB(1, 1), b3 + hstep, voffA);
            PG8_WAIT_V(6); PG8_BAR; PG8_MMA(1, 1, At, B1); PG8_BAR;
        }
        E(acc, cur, wr, wc, fr, fq);
        if (!has_next) break;
#pragma unroll
        for (int a = 0; a < 2; ++a)
#pragma unroll
            for (int b = 0; b < 2; ++b)
#pragma unroll
                for (int m = 0; m < 4; ++m)
#pragma unroll
                    for (int n = 0; n < 2; ++n) acc[a][b][m][n] = (f32x4){0.f, 0.f, 0.f, 0.f};
        cur = nxt; cA = nA; cB = nB; ++ui;
    }
    PG8_WAIT_V(0);
    if (wr == 0) PG8_BAR;
    PG8_BAR;
#undef PG8_SA
#undef PG8_SB
#undef PG8_STAGE
#undef PG8_LDA
#undef PG8_LDB
#undef PG8_MMA
#undef PG8_WAIT_V
#undef PG8_WAIT_L
#undef PG8_BAR
#undef PG8_SCHED
}
}

typedef f32x4 AccT[2][2][4][2];
#define EPI_LOOP_BEGIN \
    const int row0 = u.pm * 256 + wr * 64 + fr, col0 = u.pn * 256 + wc * 32 + 4 * fq; \
    _Pragma("unroll") for (int ai = 0; ai < 2; ++ai) _Pragma("unroll") for (int m = 0; m < 4; ++m) { const int row = row0 + ai * 128 + m * 16; \
    _Pragma("unroll") for (int bj = 0; bj < 2; ++bj) _Pragma("unroll") for (int n = 0; n < 2; ++n) { const int col = col0 + bj * 128 + n * 16; const f32x4 v = acc[ai][bj][m][n];
#define EPI_LOOP_END } }

struct EpiIn {
    bf16_t *Qb, *Kb, *Vb; float* RW; float* out;
    DI void operator()(const AccT& acc, const pg8::Unit& u, int wr, int wc, int fr, int fq) const {
        const int reg = u.pn < 4 ? 0 : (u.pn < 8 ? 1 : (u.pn < 12 ? 2 : 3));
        EPI_LOOP_BEGIN
            if (row < MT) {
                if (reg == 0) {
                    u32x2 w; w.x = pk2(v[0] * 0.125f, v[1] * 0.125f); w.y = pk2(v[2] * 0.125f, v[3] * 0.125f);
                    *(u32x2*)(Qb + (size_t)row * 1024 + col) = w;
                } else if (reg == 1 || reg == 2) {
                    const int c = col - (reg == 1 ? 1024 : 2048);
                    float* o = row < MP ? out + (reg == 1 ? O_PK : O_PV) + (size_t)row * 1024 + c : out + (reg == 1 ? O_SK : O_SV) + (size_t)(row - MP) * 1024 + c;
                    *(f32x4*)o = v;
                    u32x2 w; w.x = pk2(v[0], v[1]); w.y = pk2(v[2], v[3]);
                    *(u32x2*)((reg == 1 ? Kb : Vb) + (size_t)row * 1024 + c) = w;
                } else {
                    const int c = col - 3072;
                    if (c < CSH) {
                        *(f32x4*)(RW + (size_t)row * CSH + c) = v;
                        if (row >= MP) *(f32x4*)(out + O_SRW + (size_t)(row - MP) * CSH + c) = v;
                        else if ((row & (SEQ - 1)) == SEQ - 1) *(f32x4*)(out + O_PRW + (size_t)(row >> 11) * CSH + c) = v;
                    }
                }
            }
        EPI_LOOP_END
    }
};
struct EpiF32 {
    float* C; int ldc;
    DI void operator()(const AccT& acc, const pg8::Unit& u, int wr, int wc, int fr, int fq) const {
        EPI_LOOP_BEGIN
            *(f32x4*)(C + (size_t)row * ldc + col) = v;
        EPI_LOOP_END
    }
};
struct EpiWo {
    const float *xp, *xs; float* X1;
    DI void operator()(const AccT& acc, const pg8::Unit& u, int wr, int wc, int fr, int fq) const {
        EPI_LOOP_BEGIN
            if (row < MT) {
                const float* xr = row < MP ? xp + (size_t)row * D + col : xs + (size_t)(row - MP) * D + col;
                *(f32x4*)(X1 + (size_t)row * D + col) = *(const f32x4*)xr + v;
            }
        EPI_LOOP_END
    }
};
struct EpiUp {
    bf16_t* U; float* out;
    DI void operator()(const AccT& acc, const pg8::Unit& u, int wr, int wc, int fr, int fq) const {
        EPI_LOOP_BEGIN
            if (row < MT) {
                u32x2 w; w.x = pk2(v[0], v[1]); w.y = pk2(v[2], v[3]);
                *(u32x2*)(U + (size_t)row * FF2 + col) = w;
                if (row >= MP) *(f32x4*)(out + O_SFFN + (size_t)(row - MP) * 2 * FF2 + FF2 + col) = v;
                else if ((row & (SEQ - 1)) >= SEQ - 2) *(f32x4*)(out + O_PFFN + ((size_t)(row >> 11) * 2 + ((row & (SEQ - 1)) - (SEQ - 2))) * FF2 + col) = v;
            }
        EPI_LOOP_END
    }
};
struct EpiDn {
    float* X1;
    DI void operator()(const AccT& acc, const pg8::Unit& u, int wr, int wc, int fr, int fq) const {
        EPI_LOOP_BEGIN
            if (row < MT) { float* p = X1 + (size_t)row * D + col; *(f32x4*)p = *(const f32x4*)p + v; }
        EPI_LOOP_END
    }
};

DI void transpose_item(const float* W, int K, int N, bf16_t* WT, int ldt, float* scr, int item, int lane) {
    const int nblk = N / 32, kb = item / nblk, nb = item % nblk, k0 = 64 * kb, n0 = 32 * nb;
#pragma unroll 8
    for (int i = 0; i < 32; ++i) { const int kk = 2 * i + (lane >> 5); scr[kk * 33 + (lane & 31)] = W[(size_t)(k0 + kk) * N + n0 + (lane & 31)]; }
    __builtin_amdgcn_fence(__ATOMIC_RELEASE, "wavefront"); asm volatile("s_waitcnt lgkmcnt(0)" ::: "memory");
    const int c = lane & 7;
#pragma unroll
    for (int j = 0; j < 4; ++j) { const int n = (lane >> 3) + 8 * j; const float* s = scr + (8 * c) * 33 + n;
        u32x4 o; o.x = pk2(s[0 * 33], s[1 * 33]); o.y = pk2(s[2 * 33], s[3 * 33]); o.z = pk2(s[4 * 33], s[5 * 33]); o.w = pk2(s[6 * 33], s[7 * 33]);
        *(u32x4*)(WT + (size_t)(n0 + n) * ldt + k0 + 8 * c) = o; }
    asm volatile("s_waitcnt lgkmcnt(0)" ::: "memory");
}
DI void rms_row_bf16(const float* xrow, const float* g, bf16_t* orow, int lane) {
    const f32x4* xr = (const f32x4*)xrow + lane; const f32x4* gr = (const f32x4*)g + lane;
    f32x4 v[8]; float s = 0.f;
#pragma unroll
    for (int j = 0; j < 8; ++j) { v[j] = xr[64 * j]; s += (v[j].x * v[j].x + v[j].y * v[j].y) + (v[j].z * v[j].z + v[j].w * v[j].w); }
    const float rstd = rsqrtf(wave_sum(s) * (1.f / D) + 1e-6f);
    u32x2* o8 = (u32x2*)orow + lane;
#pragma unroll
    for (int j = 0; j < 8; ++j) { const f32x4 gg = gr[64 * j]; u32x2 w; w.x = pk2(v[j].x * rstd * gg.x, v[j].y * rstd * gg.y); w.y = pk2(v[j].z * rstd * gg.z, v[j].w * rstd * gg.w); o8[64 * j] = w; }
}
DI void rms_row_f32(const float* xrow, const float* g, float* orow, int lane) {
    const f32x4* xr = (const f32x4*)xrow + lane; const f32x4* gr = (const f32x4*)g + lane;
    f32x4 v[8]; float s = 0.f;
#pragma unroll
    for (int j = 0; j < 8; ++j) { v[j] = xr[64 * j]; s += (v[j].x * v[j].x + v[j].y * v[j].y) + (v[j].z * v[j].z + v[j].w * v[j].w); }
    const float rstd = rsqrtf(wave_sum(s) * (1.f / D) + 1e-6f);
    f32x4* o = (f32x4*)orow + lane;
#pragma unroll
    for (int j = 0; j < 8; ++j) { const f32x4 gg = gr[64 * j]; o[64 * j] = v[j] * rstd * gg; }
}
DI void zero_row_bf16(bf16_t* orow, int ncols, int lane) {
    for (int c = lane * 8; c < ncols; c += 512) *(u32x4*)(orow + c) = (u32x4){0u, 0u, 0u, 0u};
}

DI void phase_prologue(const Args& a, unsigned char* lds, int gw, int ngw, int lane, int wave) {
    unsigned char* ws = a.ws;
    float* scr = (float*)(lds + wave * 16384);
    bf16_t* Win = (bf16_t*)(ws + WS_WIN); bf16_t* Wo = (bf16_t*)(ws + WS_WO); bf16_t* Wup = (bf16_t*)(ws + WS_WUP); bf16_t* Wdn = (bf16_t*)(ws + WS_WDN); bf16_t* Wlo = (bf16_t*)(ws + WS_WLO);
    constexpr int IT_IN = (D / 64) * (CIN / 32), IT_O = (D / 64) * (D / 32), IT_UP = (D / 64) * (FF2 / 32), IT_DN = (FF / 64) * (D / 32);
    constexpr int NIT = IT_IN + IT_O + IT_UP + IT_DN;
    for (int it = gw; it < NIT; it += ngw) {
        int r = it;
        if (r < IT_IN) { transpose_item(a.in[I_WIN], D, CIN, Win, D, scr, r, lane); continue; } r -= IT_IN;
        if (r < IT_O) { transpose_item(a.in[I_WO], D, D, Wo, D, scr, r, lane); continue; } r -= IT_O;
        if (r < IT_UP) { transpose_item(a.in[I_FUP], D, FF2, Wup, D, scr, r, lane); continue; } r -= IT_UP;
        transpose_item(a.in[I_FDN], FF, D, Wdn, FF, scr, r, lane);
    }
    for (int r = CIN + gw; r < NIN; r += ngw) zero_row_bf16(Win + (size_t)r * D, D, lane);
    {
        const int gt = gw * 64 + lane, ngt = ngw * 64;
        for (int i = gt; i < NLO * KLO; i += ngt) {
            const int n = i / KLO, k = i % KLO; float v = 0.f;
            if (n < 1024) { if (k < 64) v = a.in[I_WUP][k * 1024 + n]; }
            else if (n < 2048) { if (k >= 64 && k < 128) v = a.in[I_AUP][(k - 64) * 1024 + (n - 1024)]; }
            else { if (k >= 128 && k < 288) v = a.in[I_GUP][(k - 128) * 1024 + (n - 2048)]; }
            Wlo[i] = (bf16_t)bf_rne(v);
        }
    }
    bf16_t* H = (bf16_t*)(ws + WS_H);
    for (int m = gw; m < MPAD; m += ngw) {
        if (m < MT) rms_row_bf16(m < MP ? a.in[I_XP] + (size_t)m * D : a.in[I_XS] + (size_t)(m - MP) * D, a.in[I_NMG], H + (size_t)m * D, lane);
        else zero_row_bf16(H + (size_t)m * D, D, lane);
    }
}

DI const float* rw_prev_row(const Args& a, const float* RW, int m) {
    if (m < MP) return (m & (SEQ - 1)) == 0 ? nullptr : RW + (size_t)(m - 1) * CSH;
    return a.in[I_SSH] + (size_t)(m - MP) * CSH;
}
DI void lora_input_row(const Args& a, int m, int lane) {
    bf16_t* ALO = (bf16_t*)(a.ws + WS_ALO) + (size_t)m * KLO;
    if (m >= MT) { for (int c = lane; c < KLO; c += 64) ALO[c] = 0; return; }
    const float* RW = (const float*)(a.ws + WS_RW);
    const float* cur = RW + (size_t)m * CSH; const float* prev = rw_prev_row(a, RW, m);
    for (int c = lane; c < KLO; c += 64) {
        float v = 0.f;
        if (c < 288) {
            const int j = 3072 + c; const float x = cur[j], p = prev ? prev[j] : 0.f; const float xs = x + a.in[I_MU][j] * (p - x);
            v = c < 64 ? tanhf(xs) : (c < 128 ? xs : 1.f / (1.f + __expf(-xs)));
        }
        ALO[c] = (bf16_t)bf_rne(v);
    }
}

DI int crow(int reg, int h) { return (reg & 3) + 8 * (reg >> 2) + 4 * h; }
DI void attn_prompt_unit(const Args& a, int unit, int lane) {
    const bf16_t* Qb = (const bf16_t*)(a.ws + WS_QB); const bf16_t* Kb = (const bf16_t*)(a.ws + WS_KB); const bf16_t* Vb = (const bf16_t*)(a.ws + WS_VB);
    float* PO = (float*)(a.ws + WS_PART); float* PML = (float*)(a.ws + WS_PML);
    const int blk = unit & 63, br = (unit >> 6) % 3, bh = unit / 192, b = bh >> 4, h = bh & 15;
    const int rate = br == 0 ? 1 : (br == 1 ? 4 : 16), L = SEQ / rate, bpc = L / 32;
    const int rho = blk / bpc, l0 = (blk % bpc) * 32;
    const int r = lane & 31, hh = lane >> 5;
    const int mq = b * SEQ + rho + rate * (l0 + r);
    bf16x8 qf[4];
#pragma unroll
    for (int ks = 0; ks < 4; ++ks) qf[ks] = *(const bf16x8*)(Qb + (size_t)mq * 1024 + h * 64 + ks * 16 + 8 * hh);
    f32x16 o0, o1;
#pragma unroll
    for (int i = 0; i < 16; ++i) { o0[i] = 0.f; o1[i] = 0.f; }
    float mrun = -1e30f, lrun = 0.f;
    const int lq = l0 + r;
    for (int ch = 0; ch < 5; ++ch) {
        const int lk0 = l0 - 128 + 32 * ch;
        if (lk0 < 0) continue;
        const int mk = b * SEQ + rho + rate * (lk0 + r);
        f32x16 st;
#pragma unroll
        for (int i = 0; i < 16; ++i) st[i] = 0.f;
#pragma unroll
        for (int ks = 0; ks < 4; ++ks) {
            const bf16x8 kf = *(const bf16x8*)(Kb + (size_t)mk * 1024 + h * 64 + ks * 16 + 8 * hh);
            st = __builtin_amdgcn_mfma_f32_32x32x16_bf16(kf, qf[ks], st, 0, 0, 0);
        }
        float cmax = -1e30f;
#pragma unroll
        for (int i = 0; i < 16; ++i) { const int lk = lk0 + crow(i, hh); const bool ok = (lk <= lq) && (lk >= lq - 128); st[i] = ok ? st[i] : -1e30f; cmax = fmaxf(cmax, st[i]); }
        cmax = fmaxf(cmax, __shfl_xor(cmax, 32));
        const float mnew = fmaxf(mrun, cmax), alpha = __expf(mrun - mnew);
        float ps = 0.f;
#pragma unroll
        for (int i = 0; i < 16; ++i) { const float p = st[i] > -1e29f ? __expf(st[i] - mnew) : 0.f; st[i] = p; ps += p; }
        lrun = lrun * alpha + ps; mrun = mnew;
#pragma unroll
        for (int i = 0; i < 16; ++i) { o0[i] *= alpha; o1[i] *= alpha; }
#pragma unroll
        for (int s = 0; s < 2; ++s) {
            u32x4 pp; pp.x = pk2(st[8 * s], st[8 * s + 1]); pp.y = pk2(st[8 * s + 2], st[8 * s + 3]); pp.z = pk2(st[8 * s + 4], st[8 * s + 5]); pp.w = pk2(st[8 * s + 6], st[8 * s + 7]);
            const bf16x8 pf = __builtin_bit_cast(bf16x8, pp);
#pragma unroll
            for (int dt = 0; dt < 2; ++dt) {
                bf16x8 vf;
#pragma unroll
                for (int j = 0; j < 8; ++j) {
                    const int key = lk0 + 16 * s + 8 * (j >> 2) + 4 * hh + (j & 3);
                    vf[j] = (short)Vb[(size_t)(b * SEQ + rho + rate * key) * 1024 + h * 64 + dt * 32 + r];
                }
                if (dt == 0) o0 = __builtin_amdgcn_mfma_f32_32x32x16_bf16(vf, pf, o0, 0, 0, 0);
                else o1 = __builtin_amdgcn_mfma_f32_32x32x16_bf16(vf, pf, o1, 0, 0, 0);
            }
        }
    }
    const float ltot = lrun + __shfl_xor(lrun, 32);
    float* po = PO + ((size_t)br * MP + mq) * 1024 + h * 64;
#pragma unroll
    for (int g = 0; g < 4; ++g) {
        *(f32x4*)(po + 8 * g + 4 * hh) = (f32x4){o0[4 * g], o0[4 * g + 1], o0[4 * g + 2], o0[4 * g + 3]};
        *(f32x4*)(po + 32 + 8 * g + 4 * hh) = (f32x4){o1[4 * g], o1[4 * g + 1], o1[4 * g + 2], o1[4 * g + 3]};
    }
    if (hh == 0) { float* pm = PML + (((size_t)br * MP + mq) * 16 + h) * 2; pm[0] = mrun; pm[1] = ltot; }
}
DI void attn_merge_task(const Args& a, int task, int lane) {
    const int m = task >> 4, h = task & 15;
    const float* PO = (const float*)(a.ws + WS_PART); const float* PML = (const float*)(a.ws + WS_PML);
    bf16_t* O = (bf16_t*)(a.ws + WS_O);
    float mb[3], lb[3], ob[3];
#pragma unroll
    for (int br = 0; br < 3; ++br) { const float* pm = PML + (((size_t)br * MP + m) * 16 + h) * 2; mb[br] = pm[0]; lb[br] = pm[1]; ob[br] = PO[((size_t)br * MP + m) * 1024 + h * 64 + lane]; }
    const float M = fmaxf(mb[0], fmaxf(mb[1], mb[2]));
    float num = 0.f, den = 0.f;
#pragma unroll
    for (int br = 0; br < 3; ++br) { const float w = __expf(mb[br] - M); num += w * ob[br]; den += w * lb[br]; }
    const float o = num / den;
    const float ss = wave_sum(o * o) * (1.f / 64.f);
    const float y = o * rsqrtf(ss + 1e-6f) * a.in[I_AOG][h * 64 + lane];
    O[(size_t)m * D + h * 64 + lane] = (bf16_t)bf_rne(y);
}
DI void attn_sample_unit(const Args& a, int unit, int lane) {
    const int b = unit >> 4, h = unit & 15, g = lane >> 4, l16 = lane & 15;
    const bf16_t* Qb = (const bf16_t*)(a.ws + WS_QB);
    const float* ck = a.in[I_CK] + (size_t)b * 2048 * 1024 + h * 64 + 4 * l16; const float* cv = a.in[I_CV] + (size_t)b * 2048 * 1024 + h * 64 + 4 * l16;
    const float* nk = a.out + O_SK + (size_t)b * 1024 + h * 64 + 4 * l16; const float* nv = a.out + O_SV + (size_t)b * 1024 + h * 64 + 4 * l16;
    const u32x2 qw = *(const u32x2*)(Qb + (size_t)(MP + b) * 1024 + h * 64 + 4 * l16);
    const float q0 = __uint_as_float(qw.x << 16), q1 = __uint_as_float(qw.x & 0xffff0000u), q2 = __uint_as_float(qw.y << 16), q3 = __uint_as_float(qw.y & 0xffff0000u);
    float mrun = -1e30f, lrun = 0.f; f32x4 acc = {0.f, 0.f, 0.f, 0.f};
    for (int it = 0; it < 97; ++it) {
        const int e = it * 4 + g;
        const bool valid = e < 387;
        const int ee = valid ? e : 0, br = ee / 129, j = ee % 129, rate = br == 0 ? 1 : (br == 1 ? 4 : 16);
        const int row = 2048 - rate * j;
        const float* kp = j == 0 ? nk : ck + (size_t)row * 1024; const float* vp = j == 0 ? nv : cv + (size_t)row * 1024;
        const f32x4 kv = *(const f32x4*)kp, vv = *(const f32x4*)vp;
        float s = q0 * kv.x + q1 * kv.y + q2 * kv.z + q3 * kv.w;
        s += __shfl_xor(s, 1); s += __shfl_xor(s, 2); s += __shfl_xor(s, 4); s += __shfl_xor(s, 8);
        if (!valid) s = -1e30f;
        const float mnew = fmaxf(mrun, s), alpha = __expf(mrun - mnew), p = valid ? __expf(s - mnew) : 0.f;
        lrun = lrun * alpha + p; acc = acc * alpha + vv * p; mrun = mnew;
    }
#pragma unroll
    for (int o = 16; o < 64; o <<= 1) {
        const float mo = __shfl_xor(mrun, o), lo = __shfl_xor(lrun, o);
        f32x4 ao; ao.x = __shfl_xor(acc.x, o); ao.y = __shfl_xor(acc.y, o); ao.z = __shfl_xor(acc.z, o); ao.w = __shfl_xor(acc.w, o);
        const float mn = fmaxf(mrun, mo), w0 = __expf(mrun - mn), w1 = __expf(mo - mn);
        lrun = lrun * w0 + lo * w1; acc = acc * w0 + ao * w1; mrun = mn;
    }
    const f32x4 o = acc * (1.f / lrun);
    float ss = o.x * o.x + o.y * o.y + o.z * o.z + o.w * o.w;
    ss += __shfl_xor(ss, 1); ss += __shfl_xor(ss, 2); ss += __shfl_xor(ss, 4); ss += __shfl_xor(ss, 8);
    const float rs = rsqrtf(ss * (1.f / 64.f) + 1e-6f);
    const f32x4 gg = *(const f32x4*)(a.in[I_AOG] + h * 64 + 4 * l16);
    if (g == 0) {
        u32x2 w; w.x = pk2(o.x * rs * gg.x, o.y * rs * gg.y); w.y = pk2(o.z * rs * gg.z, o.w * rs * gg.w);
        *(u32x2*)((bf16_t*)(a.ws + WS_O) + (size_t)(MP + b) * D + h * 64 + 4 * l16) = w;
    }
}

struct PrepParams { float mu_r, mu_k, mu_v, w0, a0, kk, ka, rk; };
struct PrepRaw { float cr, ck, cv, pr, pk, pv, lw, la, lg; };
DI void prep_params(const Args& a, PrepParams& P, int c) {
    P.mu_r = a.in[I_MU][c]; P.mu_k = a.in[I_MU][1024 + c]; P.mu_v = a.in[I_MU][2048 + c];
    P.w0 = a.in[I_W0][c]; P.a0 = a.in[I_A0][c]; P.kk = a.in[I_KK][c]; P.ka = a.in[I_KA][c]; P.rk = a.in[I_RK][c];
}
DI void prep_load(PrepRaw& R, const float* cur, const float* prev, const float* Lrow, int c) {
    R.cr = cur[c]; R.ck = cur[1024 + c]; R.cv = cur[2048 + c];
    R.pr = prev ? prev[c] : 0.f; R.pk = prev ? prev[1024 + c] : 0.f; R.pv = prev ? prev[2048 + c] : 0.f;
    R.lw = Lrow[c]; R.la = Lrow[1024 + c]; R.lg = Lrow[2048 + c];
}
DI void prep_finish(const PrepRaw& R, const PrepParams& P, float* dst, float& g_out, float& bonus_out, int lane) {
    const float xr = R.cr + P.mu_r * (R.pr - R.cr), xk = R.ck + P.mu_k * (R.pk - R.ck), xv = R.cv + P.mu_v * (R.pv - R.cv);
    const float x = -(P.w0 + R.lw);
    const float sp = x > 20.f ? x : __logf(1.f + __expf(x));
    const float decay = __expf(-__expf(-sp - 0.5f));
    const float av = __builtin_amdgcn_rcpf(1.f + __expf(-(P.a0 + R.la)));
    float kkv = xk * P.kk;
    const float n2 = wave_sum(kkv * kkv);
    kkv = kkv * fminf(__builtin_amdgcn_rsqf(n2), 1e12f);
    const float keff = xk * (1.f + (av - 1.f) * P.ka);
    const float bon = wave_sum(xr * keff * P.rk) * xv;
    dst[lane] = xr; dst[64 + lane] = decay; dst[128 + lane] = keff; dst[192 + lane] = xv; dst[256 + lane] = -kkv; dst[320 + lane] = kkv * av;
    g_out = R.lg; bonus_out = bon;
}
DI float scan_step(float (&S)[64], const float* sv, float vi) {
    const f32x4* r4 = (const f32x4*)sv; const f32x4* w4 = (const f32x4*)(sv + 64); const f32x4* k4 = (const f32x4*)(sv + 128);
    const f32x4* a4 = (const f32x4*)(sv + 256); const f32x4* b4 = (const f32x4*)(sv + 320);
    float sa0 = 0.f, sa1 = 0.f;
#pragma unroll
    for (int j = 0; j < 16; ++j) { const f32x4 av = a4[j]; sa0 = fmaf(S[4 * j], av.x, sa0); sa1 = fmaf(S[4 * j + 1], av.y, sa1); sa0 = fmaf(S[4 * j + 2], av.z, sa0); sa1 = fmaf(S[4 * j + 3], av.w, sa1); }
    const float sa = sa0 + sa1;
    float y0 = 0.f, y1 = 0.f;
#pragma unroll
    for (int j = 0; j < 16; ++j) {
        const f32x4 bv = b4[j], kv = k4[j], wv = w4[j], rv = r4[j];
        float t;
        t = fmaf(vi, kv.x, sa * bv.x); S[4 * j] = fmaf(S[4 * j], wv.x, t); y0 = fmaf(S[4 * j], rv.x, y0);
        t = fmaf(vi, kv.y, sa * bv.y); S[4 * j + 1] = fmaf(S[4 * j + 1], wv.y, t); y1 = fmaf(S[4 * j + 1], rv.y, y1);
        t = fmaf(vi, kv.z, sa * bv.z); S[4 * j + 2] = fmaf(S[4 * j + 2], wv.z, t); y0 = fmaf(S[4 * j + 2], rv.z, y0);
        t = fmaf(vi, kv.w, sa * bv.w); S[4 * j + 3] = fmaf(S[4 * j + 3], wv.w, t); y1 = fmaf(S[4 * j + 3], rv.w, y1);
        if ((j & 3) == 3) asm volatile("" ::: "memory");
    }
    return y0 + y1;
}
DI void rwkv_post(const Args& a, float y, float g, float bonus, int m, int c) {
    const float mean = wave_sum(y) * (1.f / 64.f); const float d = y - mean; const float var = wave_sum(d * d) * (1.f / 64.f);
    const float yn = d * rsqrtf(var + 64e-5f) * a.in[I_LNW][c] + a.in[I_LNB][c];
    ((bf16_t*)(a.ws + WS_O))[(size_t)m * D + 1024 + c] = (bf16_t)bf_rne((yn + bonus) * g);
}

#define WG_BAR_LDS() do { asm volatile("s_waitcnt lgkmcnt(0)" ::: "memory"); __builtin_amdgcn_s_barrier(); asm volatile("" ::: "memory"); } while (0)
typedef float f32x2 __attribute__((ext_vector_type(2)));
DI f32x2 fma2(f32x2 a, f32x2 b, f32x2 c) { return __builtin_elementwise_fma(a, b, c); }
DI void scan_dot_a(const f32x2 (&Z)[32], const f32x2 (&P)[32], const float* sv, float& sz, float& sp) {
    const f32x4* a4 = (const f32x4*)(sv + 256);
    f32x2 saz = {0.f, 0.f}, sap = {0.f, 0.f};
#pragma unroll
    for (int j = 0; j < 16; ++j) { const f32x4 av = a4[j]; const f32x2 a0 = {av.x, av.y}, a1 = {av.z, av.w};
        saz = fma2(Z[2 * j], a0, saz); sap = fma2(P[2 * j], a0, sap); saz = fma2(Z[2 * j + 1], a1, saz); sap = fma2(P[2 * j + 1], a1, sap);
        if ((j & 7) == 7) asm volatile("" ::: "memory"); }
    sz = saz.x + saz.y; sp = sap.x + sap.y;
}
DI void scan_step3(f32x2 (&Z)[32], f32x2 (&P)[32], const float* sv, const float* svn, float vi, float& sz, float& sp, float& yz, float& yp) {
    const f32x4* r4 = (const f32x4*)sv; const f32x4* w4 = (const f32x4*)(sv + 64); const f32x4* k4 = (const f32x4*)(sv + 128);
    const f32x4* b4 = (const f32x4*)(sv + 320); const f32x4* an4 = (const f32x4*)(svn + 256);
    const f32x2 sz2 = {sz, sz}, sp2 = {sp, sp}, v2 = {vi, vi};
    f32x2 yz2 = {0.f, 0.f}, yp2 = {0.f, 0.f}, nz2 = {0.f, 0.f}, np2 = {0.f, 0.f};
    f32x4 buf[3][5];
#define S3_LD(g, j) do { buf[g][0] = b4[j]; buf[g][1] = k4[j]; buf[g][2] = w4[j]; buf[g][3] = r4[j]; buf[g][4] = an4[j]; asm volatile("" ::: "memory"); } while (0)
    S3_LD(0, 0); S3_LD(1, 1);
#pragma unroll
    for (int j = 0; j < 16; ++j) {
        if (j + 2 < 16) S3_LD((j + 2) % 3, j + 2);
        const f32x4 bv = buf[j % 3][0], kv = buf[j % 3][1], wv = buf[j % 3][2], rv = buf[j % 3][3], av = buf[j % 3][4];
        { const f32x2 b2 = {bv.x, bv.y}, k2 = {kv.x, kv.y}, w2 = {wv.x, wv.y}, r2 = {rv.x, rv.y}, a2 = {av.x, av.y};
          f32x2 tz = sz2 * b2; tz = fma2(v2, k2, tz); Z[2 * j] = fma2(Z[2 * j], w2, tz); yz2 = fma2(Z[2 * j], r2, yz2); nz2 = fma2(Z[2 * j], a2, nz2);
          const f32x2 tp = sp2 * b2; P[2 * j] = fma2(P[2 * j], w2, tp); yp2 = fma2(P[2 * j], r2, yp2); np2 = fma2(P[2 * j], a2, np2); }
        { const f32x2 b2 = {bv.z, bv.w}, k2 = {kv.z, kv.w}, w2 = {wv.z, wv.w}, r2 = {rv.z, rv.w}, a2 = {av.z, av.w};
          f32x2 tz = sz2 * b2; tz = fma2(v2, k2, tz); Z[2 * j + 1] = fma2(Z[2 * j + 1], w2, tz); yz2 = fma2(Z[2 * j + 1], r2, yz2); nz2 = fma2(Z[2 * j + 1], a2, nz2);
          const f32x2 tp = sp2 * b2; P[2 * j + 1] = fma2(P[2 * j + 1], w2, tp); yp2 = fma2(P[2 * j + 1], r2, yp2); np2 = fma2(P[2 * j + 1], a2, np2); }
        asm volatile("" ::: "memory");
    }
#undef S3_LD
    yz = yz2.x + yz2.y; yp = yp2.x + yp2.y; sz = nz2.x + nz2.y; sp = np2.x + np2.y;
}
DI void scan_pass1_unit(const Args& a, unsigned char* lds, int unit, int wave, int lane) {
    float* stg = (float*)lds;
    const int pp = wave & 3, pair = unit * 4 + pp, chain = pair / NS, seg = pair % NS, b = chain >> 4, h = chain & 15, c = h * 64 + lane;
    const int mbase = b * SEQ + seg * SEGL;
    constexpr int NB = SEGL / TB;
    if (wave < 4) {
        float* YL = (float*)(a.ws + WS_YL); float* QS = (float*)(a.ws + WS_QS); float* ZP = (float*)(a.ws + WS_ZP);
        f32x2 Z[32], P[32];
        int idl = lane; asm volatile("" : "+v"(idl));
#pragma unroll
        for (int j = 0; j < 32; ++j) { Z[j] = (f32x2){0.f, 0.f}; P[j] = (f32x2){idl == 2 * j ? 1.f : 0.f, idl == 2 * j + 1 ? 1.f : 0.f}; }
        WG_BAR_LDS();
        for (int blk = 0; blk < NB; ++blk) {
            const float* sb = stg + (((blk & 1) * 4 + pp) * TB) * 384;
            float sz, sp; scan_dot_a(Z, P, sb, sz, sp);
#pragma unroll 1
            for (int tt = 0; tt < TB; ++tt) {
                const float* sv = sb + tt * 384; const float* svn = sb + (tt + 1 < TB ? tt + 1 : tt) * 384;
                float yz, yp; scan_step3(Z, P, sv, svn, sv[192 + lane], sz, sp, yz, yp);
                const size_t o = (size_t)(mbase + blk * TB + tt) * 1024 + c;
                YL[o] = yz; QS[o] = yp;
            }
            WG_BAR_LDS();
        }
        float* zp = ZP + (size_t)pair * 2 * 4096 + lane * 64;
#pragma unroll
        for (int j = 0; j < 16; ++j) { *(f32x4*)(zp + 4 * j) = (f32x4){Z[2 * j].x, Z[2 * j].y, Z[2 * j + 1].x, Z[2 * j + 1].y};
                                       *(f32x4*)(zp + 4096 + 4 * j) = (f32x4){P[2 * j].x, P[2 * j].y, P[2 * j + 1].x, P[2 * j + 1].y}; }
    } else {
        const float* RW = (const float*)(a.ws + WS_RW); const float* Lb = (const float*)(a.ws + WS_L);
        bf16_t* GB = (bf16_t*)(a.ws + WS_GB);
        PrepParams Pm; prep_params(a, Pm, c);
        PrepRaw raw[TB];
#define P1_LOAD(blk_) do { _Pragma("unroll") for (int k = 0; k < TB; ++k) { const int m = mbase + (blk_) * TB + k; prep_load(raw[k], RW + (size_t)m * CSH, rw_prev_row(a, RW, m), Lb + (size_t)m * NLO, c); } } while (0)
#define P1_FINISH(blk_) do { _Pragma("unroll") for (int k = 0; k < TB; ++k) { const int m = mbase + (blk_) * TB + k; float g, bon; \
            prep_finish(raw[k], Pm, stg + ((((blk_) & 1) * 4 + pp) * TB + k) * 384, g, bon, lane); \
            GB[((size_t)m * 16 + h) * 128 + lane] = (bf16_t)bf_rne(g); GB[((size_t)m * 16 + h) * 128 + 64 + lane] = (bf16_t)bf_rne(bon); } } while (0)
        P1_LOAD(0); P1_FINISH(0); P1_LOAD(1);
        WG_BAR_LDS();
        for (int blk = 0; blk < NB; ++blk) {
            if (blk + 1 < NB) P1_FINISH(blk + 1);
            if (blk + 2 < NB) P1_LOAD(blk + 2);
            WG_BAR_LDS();
        }
#undef P1_LOAD
#undef P1_FINISH
    }
}
DI void scan_sample_unit(const Args& a, unsigned char* lds, int unit, int wave, int lane) {
    float* sv = (float*)(lds + 2 * 4 * TB * 384 * 4) + wave * 384;
    const float* RW = (const float*)(a.ws + WS_RW); const float* Lb = (const float*)(a.ws + WS_L);
    const int b = unit >> 4, h = unit & 15, c = h * 64 + lane, m = MP + b;
    PrepParams P; prep_params(a, P, c);
    PrepRaw raw; prep_load(raw, RW + (size_t)m * CSH, rw_prev_row(a, RW, m), Lb + (size_t)m * NLO, c);
    float g, bon; prep_finish(raw, P, sv, g, bon, lane);
    float S[64];
    const float* s0 = a.in[I_SWKV] + ((size_t)(b * 16 + h) * 64 + lane) * 64;
#pragma unroll
    for (int j = 0; j < 16; ++j) { const f32x4 v = *(const f32x4*)(s0 + 4 * j); S[4 * j] = v.x; S[4 * j + 1] = v.y; S[4 * j + 2] = v.z; S[4 * j + 3] = v.w; }
    const float y = scan_step(S, sv, sv[192 + lane]);
    float* so = a.out + O_SWKV + ((size_t)(b * 16 + h) * 64 + lane) * 64;
#pragma unroll
    for (int j = 0; j < 16; ++j) *(f32x4*)(so + 4 * j) = (f32x4){S[4 * j], S[4 * j + 1], S[4 * j + 2], S[4 * j + 3]};
    rwkv_post(a, y, g, bon, m, c);
}
DI void scan_pass2_unit(const Args& a, unsigned char* lds, int chain, int wave, int lane) {
    float* Ssh = (float*)lds;
    float* Psh = Ssh + 64 * 65;
    const float* ZP = (const float*)(a.ws + WS_ZP); float* SST = (float*)(a.ws + WS_SST);
    const int i = lane, j0 = wave * 8, tid = wave * 64 + lane;
    float Sr[8];
#pragma unroll
    for (int k = 0; k < 8; ++k) Sr[k] = 0.f;
    const float* Z0 = ZP + (size_t)(chain * NS) * 2 * 4096;
    f32x4 pn0 = *(const f32x4*)(Z0 + 4096 + tid * 8), pn1 = *(const f32x4*)(Z0 + 4096 + tid * 8 + 4);
    f32x4 zn0 = *(const f32x4*)(Z0 + i * 64 + j0), zn1 = *(const f32x4*)(Z0 + i * 64 + j0 + 4);
    for (int s = 0; s < NS; ++s) {
        float* sst = SST + ((size_t)chain * NS + s) * 4096 + i * 64 + j0;
        *(f32x4*)sst = (f32x4){Sr[0], Sr[1], Sr[2], Sr[3]}; *(f32x4*)(sst + 4) = (f32x4){Sr[4], Sr[5], Sr[6], Sr[7]};
#pragma unroll
        for (int k = 0; k < 8; ++k) Ssh[i * 65 + j0 + k] = Sr[k];
        *(f32x4*)(Psh + tid * 8) = pn0; *(f32x4*)(Psh + tid * 8 + 4) = pn1;
        float nw[8] = {zn0.x, zn0.y, zn0.z, zn0.w, zn1.x, zn1.y, zn1.z, zn1.w};
        if (s + 1 < NS) {
            const float* Zs = ZP + (size_t)(chain * NS + s + 1) * 2 * 4096;
            pn0 = *(const f32x4*)(Zs + 4096 + tid * 8); pn1 = *(const f32x4*)(Zs + 4096 + tid * 8 + 4);
            zn0 = *(const f32x4*)(Zs + i * 64 + j0); zn1 = *(const f32x4*)(Zs + i * 64 + j0 + 4);
        }
        WG_BAR_LDS();
        if (s > 0) {
#pragma unroll 8
            for (int l = 0; l < 64; ++l) {
                const float sl = Ssh[i * 65 + l];
                const f32x4 p0 = *(const f32x4*)(Psh + l * 64 + j0), p1 = *(const f32x4*)(Psh + l * 64 + j0 + 4);
                nw[0] = fmaf(sl, p0.x, nw[0]); nw[1] = fmaf(sl, p0.y, nw[1]); nw[2] = fmaf(sl, p0.z, nw[2]); nw[3] = fmaf(sl, p0.w, nw[3]);
                nw[4] = fmaf(sl, p1.x, nw[4]); nw[5] = fmaf(sl, p1.y, nw[5]); nw[6] = fmaf(sl, p1.z, nw[6]); nw[7] = fmaf(sl, p1.w, nw[7]);
            }
        }
        WG_BAR_LDS();
#pragma unroll
        for (int k = 0; k < 8; ++k) Sr[k] = nw[k];
    }
    float* so = a.out + O_PWKV + (size_t)chain * 4096 + i * 64 + j0;
    *(f32x4*)so = (f32x4){Sr[0], Sr[1], Sr[2], Sr[3]}; *(f32x4*)(so + 4) = (f32x4){Sr[4], Sr[5], Sr[6], Sr[7]};
}
DI bf16x8 cvt8(const f32x4 lo, const f32x4 hi) { u32x4 p; p.x = pk2(lo.x, lo.y); p.y = pk2(lo.z, lo.w); p.z = pk2(hi.x, hi.y); p.w = pk2(hi.z, hi.w); return __builtin_bit_cast(bf16x8, p); }
DI void scan_pass3_unit(const Args& a, int unit, int lane) {
    const float* SST = (const float*)(a.ws + WS_SST); const float* YL = (const float*)(a.ws + WS_YL); const float* QS = (const float*)(a.ws + WS_QS); const bf16_t* GB = (const bf16_t*)(a.ws + WS_GB);
    bf16_t* O = (bf16_t*)(a.ws + WS_O);
    const int sub = unit & 3, pair = unit >> 2, chain = pair / NS, seg = pair % NS, b = chain >> 4, h = chain & 15;
    const int r = lane & 31, hh = lane >> 5;
    const int m = b * SEQ + seg * SEGL + sub * 32 + r;
    f32x16 acc0, acc1;
#pragma unroll
    for (int i = 0; i < 16; ++i) { acc0[i] = 0.f; acc1[i] = 0.f; }
    const float* qrow = QS + (size_t)m * 1024 + h * 64 + 8 * hh;
    const float* s0 = SST + (size_t)pair * 4096 + (size_t)r * 64 + 8 * hh; const float* s1 = s0 + 32 * 64;
#pragma unroll
    for (int ks = 0; ks < 4; ++ks) {
        const bf16x8 qf = cvt8(*(const f32x4*)(qrow + ks * 16), *(const f32x4*)(qrow + ks * 16 + 4));
        const bf16x8 a0 = cvt8(*(const f32x4*)(s0 + ks * 16), *(const f32x4*)(s0 + ks * 16 + 4));
        const bf16x8 a1 = cvt8(*(const f32x4*)(s1 + ks * 16), *(const f32x4*)(s1 + ks * 16 + 4));
        acc0 = __builtin_amdgcn_mfma_f32_32x32x16_bf16(a0, qf, acc0, 0, 0, 0);
        acc1 = __builtin_amdgcn_mfma_f32_32x32x16_bf16(a1, qf, acc1, 0, 0, 0);
    }
    const float* yl = YL + (size_t)m * 1024 + h * 64 + 4 * hh;
    float y[32]; float sum = 0.f;
#pragma unroll
    for (int rt = 0; rt < 2; ++rt)
#pragma unroll
        for (int g = 0; g < 4; ++g) { const f32x4 v = *(const f32x4*)(yl + rt * 32 + 8 * g);
#pragma unroll
            for (int e = 0; e < 4; ++e) { const float yy = v[e] + (rt == 0 ? acc0[4 * g + e] : acc1[4 * g + e]); y[rt * 16 + 4 * g + e] = yy; sum += yy; } }
    sum += __shfl_xor(sum, 32);
    const float mean = sum * (1.f / 64.f);
    float vs = 0.f;
#pragma unroll
    for (int e = 0; e < 32; ++e) { y[e] -= mean; vs += y[e] * y[e]; }
    vs += __shfl_xor(vs, 32);
    const float rstd = rsqrtf(vs * (1.f / 64.f) + 64e-5f);
    const bf16_t* gb = GB + ((size_t)m * 16 + h) * 128 + 4 * hh;
    const float* lw = a.in[I_LNW] + h * 64 + 4 * hh; const float* lb = a.in[I_LNB] + h * 64 + 4 * hh;
    bf16_t* orow = O + (size_t)m * D + 1024 + h * 64 + 4 * hh;
#pragma unroll
    for (int rt = 0; rt < 2; ++rt)
#pragma unroll
        for (int g = 0; g < 4; ++g) {
            const int off = rt * 32 + 8 * g;
            const f32x4 w4 = *(const f32x4*)(lw + off), b4 = *(const f32x4*)(lb + off);
            const u32x2 gw = *(const u32x2*)(gb + off), bw = *(const u32x2*)(gb + 64 + off);
            const float gg[4] = {__uint_as_float(gw.x << 16), __uint_as_float(gw.x & 0xffff0000u), __uint_as_float(gw.y << 16), __uint_as_float(gw.y & 0xffff0000u)};
            const float bb[4] = {__uint_as_float(bw.x << 16), __uint_as_float(bw.x & 0xffff0000u), __uint_as_float(bw.y << 16), __uint_as_float(bw.y & 0xffff0000u)};
            float o[4];
#pragma unroll
            for (int e = 0; e < 4; ++e) o[e] = (y[rt * 16 + 4 * g + e] * rstd * w4[e] + b4[e] + bb[e]) * gg[e];
            u32x2 w; w.x = pk2(o[0], o[1]); w.y = pk2(o[2], o[3]);
            *(u32x2*)(orow + off) = w;
        }
}

DI void conv_item(const Args& a, int item) {
    const int m = item / (FF / 8), f = (item % (FF / 8)) * 8;
    const bf16_t* U = (const bf16_t*)(a.ws + WS_U); bf16_t* ACT = (bf16_t*)(a.ws + WS_ACT);
    if (m >= MT) { *(u32x4*)(ACT + (size_t)m * FF + f) = (u32x4){0u, 0u, 0u, 0u}; return; }
    const float* cw = a.in[I_FCW]; const float* cb = a.in[I_FCB];
    float res[2][8];
#pragma unroll
    for (int part = 0; part < 2; ++part) {
        const int col = part * FF + f;
        float u0[8], u1[8], u2[8];
        { const u32x4 w = *(const u32x4*)(U + (size_t)m * FF2 + col);
          u0[0] = __uint_as_float(w.x << 16); u0[1] = __uint_as_float(w.x & 0xffff0000u); u0[2] = __uint_as_float(w.y << 16); u0[3] = __uint_as_float(w.y & 0xffff0000u);
          u0[4] = __uint_as_float(w.z << 16); u0[5] = __uint_as_float(w.z & 0xffff0000u); u0[6] = __uint_as_float(w.w << 16); u0[7] = __uint_as_float(w.w & 0xffff0000u); }
        if (m < MP) {
            const int t = m & (SEQ - 1);
            u32x4 w1 = {0u, 0u, 0u, 0u}, w2 = {0u, 0u, 0u, 0u};
            if (t >= 1) w1 = *(const u32x4*)(U + (size_t)(m - 1) * FF2 + col);
            if (t >= 2) w2 = *(const u32x4*)(U + (size_t)(m - 2) * FF2 + col);
            u1[0] = __uint_as_float(w1.x << 16); u1[1] = __uint_as_float(w1.x & 0xffff0000u); u1[2] = __uint_as_float(w1.y << 16); u1[3] = __uint_as_float(w1.y & 0xffff0000u);
            u1[4] = __uint_as_float(w1.z << 16); u1[5] = __uint_as_float(w1.z & 0xffff0000u); u1[6] = __uint_as_float(w1.w << 16); u1[7] = __uint_as_float(w1.w & 0xffff0000u);
            u2[0] = __uint_as_float(w2.x << 16); u2[1] = __uint_as_float(w2.x & 0xffff0000u); u2[2] = __uint_as_float(w2.y << 16); u2[3] = __uint_as_float(w2.y & 0xffff0000u);
            u2[4] = __uint_as_float(w2.z << 16); u2[5] = __uint_as_float(w2.z & 0xffff0000u); u2[6] = __uint_as_float(w2.w << 16); u2[7] = __uint_as_float(w2.w & 0xffff0000u);
        } else {
            const float* st = a.in[I_SFFN] + (size_t)(m - MP) * 2 * FF2 + col;
            float* so = a.out + O_SFFN + (size_t)(m - MP) * 2 * FF2 + col;
#pragma unroll
            for (int j = 0; j < 8; ++j) { u2[j] = st[j]; u1[j] = st[FF2 + j]; so[j] = u1[j]; }
        }
#pragma unroll
        for (int j = 0; j < 8; ++j) res[part][j] = cb[col + j] + cw[col + j] * u2[j] + cw[FF2 + col + j] * u1[j] + cw[2 * FF2 + col + j] * u0[j];
    }
    float o[8];
#pragma unroll
    for (int j = 0; j < 8; ++j) { const float gt = res[0][j]; o[j] = gt / (1.f + __expf(-gt)) * res[1][j]; }
    u32x4 w; w.x = pk2(o[0], o[1]); w.y = pk2(o[2], o[3]); w.z = pk2(o[4], o[5]); w.w = pk2(o[6], o[7]);
    *(u32x4*)(ACT + (size_t)m * FF + f) = w;
}


#define XB_TMO      128
#define XB_XCNT(j)  (256  + 64 * (j))
#define XB_XSUB(j)  (1280 + 64 * (j))
#define XB_XGEN(j)  (2304 + 64 * (j))
#define XB_TOP      3328
#define XB_TOPGEN   3392
#define XCD_BAR_WORDS 3456
#define XB_SPIN_CAP (1u << 18)
DI unsigned xb_ld(unsigned* p)              { return __hip_atomic_load(p, __ATOMIC_RELAXED, __HIP_MEMORY_SCOPE_AGENT); }
DI unsigned xb_add(unsigned* p, unsigned v) { return __hip_atomic_fetch_add(p, v, __ATOMIC_RELAXED, __HIP_MEMORY_SCOPE_AGENT); }
DI unsigned xb_xcc_id() { return (unsigned)__builtin_amdgcn_s_getreg((3 << 11) | 20) & 0xFu; }
#define XB_SPIN(cond, bar) do { unsigned _sp = 0; while (cond) { __builtin_amdgcn_s_sleep(1); \
    if ((++_sp & 255u) == 0u) { if (xb_ld(&(bar)[XB_TMO])) break; if (_sp > XB_SPIN_CAP) { atomicAdd(&(bar)[XB_TMO], 1u); break; } } } } while (0)
struct XcdBarrier { unsigned* bar; unsigned x; volatile LAS unsigned* st; };
DI XcdBarrier xcd_barrier_post(unsigned* bar, volatile LAS unsigned* st) {
    XcdBarrier b; b.bar = bar; b.x = xb_xcc_id(); b.st = st;
    if (threadIdx.x == 0) (void)xb_add(&bar[XB_XCNT(b.x)], 1u);
    return b;
}
DI void xcd_barrier_complete(unsigned* bar, unsigned x, unsigned& nloc, unsigned& nx) {
    const unsigned G = gridDim.x * gridDim.y * gridDim.z;
    unsigned sum, cnt, mine, sp = 0u;
    for (;;) {
        sum = 0u; cnt = 0u; mine = 0u;
#pragma unroll
        for (unsigned j = 0; j < 16; ++j) { const unsigned c = xb_ld(&bar[XB_XCNT(j)]); sum += c; cnt += (c > 0u) ? 1u : 0u; mine = (j == x) ? c : mine; }
        if (sum == G) break;
        __builtin_amdgcn_s_sleep(1);
        if ((++sp & 255u) == 0u) { if (xb_ld(&bar[XB_TMO])) break; if (sp > XB_SPIN_CAP) { atomicAdd(&bar[XB_TMO], 1u); break; } }
    }
    nloc = mine > 0u ? mine : 1u; nx = cnt > 0u ? cnt : 1u;
}
DI void xcd_barrier(const XcdBarrier& b) {
    asm volatile("s_waitcnt vmcnt(0)" ::: "memory");
    __syncthreads();
    if (threadIdx.x == 0) {
        unsigned* bar = b.bar;
        __builtin_amdgcn_s_waitcnt(0);
        unsigned nloc = b.st[0], nx = b.st[1];
        if (nloc == 0u) { xcd_barrier_complete(bar, b.x, nloc, nx); b.st[0] = nloc; b.st[1] = nx; }
        const unsigned old = xb_add(&bar[XB_XSUB(b.x)], 1u);
        const unsigned gen = old / nloc;
        if (old + 1u == (gen + 1u) * nloc) {
            __builtin_amdgcn_fence(__ATOMIC_RELEASE, "agent");
            asm volatile("s_waitcnt vmcnt(0)" ::: "memory");
            const unsigned og = xb_add(&bar[XB_TOP], 1u);
            const unsigned tg = og / nx;
            if (og + 1u == (tg + 1u) * nx) xb_add(&bar[XB_TOPGEN], 1u);
            else XB_SPIN(xb_ld(&bar[XB_TOPGEN]) == tg, bar);
            __builtin_amdgcn_fence(__ATOMIC_ACQUIRE, "agent");
            xb_add(&bar[XB_XGEN(b.x)], 1u);
            asm volatile("s_waitcnt vmcnt(0)" ::: "memory");
        } else {
            XB_SPIN(xb_ld(&bar[XB_XGEN(b.x)]) == gen, bar);
            __builtin_amdgcn_fence(__ATOMIC_ACQUIRE, "agent");
            asm volatile("s_waitcnt vmcnt(0)" ::: "memory");
        }
    }
    __syncthreads();
}

DI void skinny_unit(const bf16_t* A, int lda, const bf16_t* Bt, int K, int unit, const float* base, int ldb, float* out, int ldo, unsigned char* lds, int wave, int lane) {
    float* red = (float*)lds;
    const int n0 = unit * 32, r = lane & 31, hh = lane >> 5, kw = K / 8, kb = wave * kw;
    f32x16 acc;
#pragma unroll
    for (int i = 0; i < 16; ++i) acc[i] = 0.f;
    const bf16_t* ap = A + (size_t)r * lda + kb + 8 * hh; const bf16_t* bp = Bt + (size_t)(n0 + r) * K + kb + 8 * hh;
#pragma unroll 4
    for (int k = 0; k < kw; k += 16) {
        const bf16x8 af = *(const bf16x8*)(ap + k), bf = *(const bf16x8*)(bp + k);
        acc = __builtin_amdgcn_mfma_f32_32x32x16_bf16(af, bf, acc, 0, 0, 0);
    }
#pragma unroll
    for (int i = 0; i < 16; ++i) red[(wave * 16 + i) * 64 + lane] = acc[i];
    __syncthreads();
#pragma unroll
    for (int q = 0; q < 2; ++q) {
        const int o = threadIdx.x + 512 * q, i = o >> 6, ln = o & 63;
        float sum = 0.f;
#pragma unroll
        for (int w = 0; w < 8; ++w) sum += red[(w * 16 + i) * 64 + ln];
        const int row = crow(i, ln >> 5), col = n0 + (ln & 31);
        out[(size_t)row * ldo + col] = base[(size_t)row * ldb + col] + sum;
    }
    __syncthreads();
}

constexpr int NPH = 14;
template <bool COOP>
__global__ void __launch_bounds__(NTHREADS, 2) mk_fwd(Args a) {
    extern __shared__ __attribute__((aligned(16))) unsigned char lds[];
    const int tid = threadIdx.x, lane = tid & 63, wave = __builtin_amdgcn_readfirstlane(tid >> 6);
    const int G = gridDim.x, bid = blockIdx.x, gw = bid * NWAVES + wave, ngw = G * NWAVES;
    unsigned char* ws = a.ws;
    LAS unsigned char* ldsl = (LAS unsigned char*)lds;
#ifndef PHMASK
#define PHMASK 0xffff
#endif
#define IN(k) (((PHMASK >> (k)) & 1) && a.ph_lo <= (k) && (k) < a.ph_hi)
    XcdBarrier xbar; xbar.bar = (unsigned*)(ws + WS_BAR); xbar.x = 0; xbar.st = nullptr;
    if (COOP) {
        volatile LAS unsigned* st = (volatile LAS unsigned*)(ldsl + LDS_BYTES - 16);
        if (tid < 4) st[tid] = 0u;
        __syncthreads();
        xbar = xcd_barrier_post((unsigned*)(ws + WS_BAR), st);
    }
#define SEAM(k) do { if (COOP && IN(k) && IN((k) + 1)) { if ((k) == 0) cg::this_grid().sync(); else xcd_barrier(xbar); } } while (0)

    if (IN(0)) phase_prologue(a, lds, gw, ngw, lane, wave);
    SEAM(0);
    if (IN(1)) {
        pg8::Gemm g{(const bf16_t*)(ws + WS_H), (const bf16_t*)(ws + WS_WIN), MPAD, NIN, D}; pg8::StaticOrder S; S.init(MPAD, NIN, G, bid);
        EpiIn E{(bf16_t*)(ws + WS_QB), (bf16_t*)(ws + WS_KB), (bf16_t*)(ws + WS_VB), (float*)(ws + WS_RW), a.out};
        pg8::gemm_phase<EpiIn>(ldsl, g, S, E);
    }
    SEAM(1);
    if (IN(2)) {
        for (int m = gw; m < MPAD; m += ngw) lora_input_row(a, m, lane);
        for (int u = gw; u < 512; u += ngw) attn_sample_unit(a, u, lane);
        for (int u = gw; u < 64 * 3 * 64; u += ngw) attn_prompt_unit(a, u, lane);
    }
    SEAM(2);
    if (IN(3)) {
        pg8::Gemm g{(const bf16_t*)(ws + WS_ALO), (const bf16_t*)(ws + WS_WLO), MPAD, NLO, KLO}; pg8::StaticOrder S; S.init(MPAD, NLO, G, bid);
        EpiF32 E{(float*)(ws + WS_L), NLO};
        pg8::gemm_phase<EpiF32>(ldsl, g, S, E);
        for (int t = gw; t < MP * 16; t += ngw) attn_merge_task(a, t, lane);
    }
    SEAM(3);
    if (IN(4)) {
#ifndef NO_P1
        for (int u = bid; u < 64 * NS / 4; u += G) scan_pass1_unit(a, lds, u, wave, lane);
#endif
#ifndef NO_SS
        for (int u = gw; u < 512; u += ngw) scan_sample_unit(a, lds, u, wave, lane);
#endif
    }
    SEAM(4);
    if (IN(5)) { for (int ch = bid; ch < 64; ch += G) scan_pass2_unit(a, lds, ch, wave, lane); }
    SEAM(5);
    if (IN(6)) { for (int u = gw; u < 64 * NS * 4; u += ngw) scan_pass3_unit(a, u, lane); }
    SEAM(6);
    if (IN(7)) {
        pg8::Gemm g{(const bf16_t*)(ws + WS_O), (const bf16_t*)(ws + WS_WO), MP, D, D}; pg8::StaticOrder S; S.init(MP, D, G, bid);
        EpiWo E{a.in[I_XP], a.in[I_XS], (float*)(ws + WS_X1)};
        pg8::gemm_phase<EpiWo>(ldsl, g, S, E);
        for (int u = bid; u < D / 32; u += G)
            skinny_unit((const bf16_t*)(ws + WS_O) + (size_t)MP * D, D, (const bf16_t*)(ws + WS_WO), D, u, a.in[I_XS], D, (float*)(ws + WS_X1) + (size_t)MP * D, D, lds, wave, lane);
    }
    SEAM(7);
    if (IN(8)) { for (int m = gw; m < MT; m += ngw) rms_row_bf16((const float*)(ws + WS_X1) + (size_t)m * D, a.in[I_NFG], (bf16_t*)(ws + WS_H) + (size_t)m * D, lane); }
    SEAM(8);
    if (IN(9)) {
        pg8::Gemm g{(const bf16_t*)(ws + WS_H), (const bf16_t*)(ws + WS_WUP), MPAD, FF2, D}; pg8::StaticOrder S; S.init(MPAD, FF2, G, bid);
        EpiUp E{(bf16_t*)(ws + WS_U), a.out};
        pg8::gemm_phase<EpiUp>(ldsl, g, S, E);
    }
    SEAM(9);
    if (IN(10)) { for (int it = bid * NTHREADS + tid; it < MPAD * (FF / 8); it += G * NTHREADS) conv_item(a, it); }
    SEAM(10);
    if (IN(11)) {
        pg8::Gemm g{(const bf16_t*)(ws + WS_ACT), (const bf16_t*)(ws + WS_WDN), MP, D, FF}; pg8::StaticOrder S; S.init(MP, D, G, bid);
        EpiDn E{(float*)(ws + WS_X1)};
        pg8::gemm_phase<EpiDn>(ldsl, g, S, E);
        for (int u = bid; u < D / 32; u += G)
            skinny_unit((const bf16_t*)(ws + WS_ACT) + (size_t)MP * FF, FF, (const bf16_t*)(ws + WS_WDN), FF, u, (const float*)(ws + WS_X1) + (size_t)MP * D, D, (float*)(ws + WS_X1) + (size_t)MP * D, D, lds, wave, lane);
    }
    SEAM(11);
    if (IN(12)) {
        for (int m = gw; m < MT; m += ngw)
            rms_row_f32((const float*)(ws + WS_X1) + (size_t)m * D, a.in[I_NFIN], m < MP ? a.out + O_YP + (size_t)m * D : a.out + O_YS + (size_t)(m - MP) * D, lane);
    }
#undef IN
#undef SEAM
}

#ifndef MK_ONE_LAUNCH
#define MK_ONE_LAUNCH 1
#endif
#ifndef MK_DBL_MASK
#define MK_DBL_MASK 0x0
#endif

extern "C" void kernel_launch(void* const* d_in, const int* in_sizes, int n_in, void* d_out, int out_size, void* d_ws, size_t ws_size, hipStream_t stream) {
    static int grid = 0;
    if (!grid) {
        if (n_in != 28 || (size_t)out_size != O_END || ws_size < WS_END) fprintf(stderr, "kernel_launch: unexpected shapes: n_in %d out %d (want %zu) ws %zu (want %zu)\n", n_in, out_size, O_END, ws_size, WS_END);
        int dev = 0, cus = 0; hipGetDevice(&dev); hipDeviceGetAttribute(&cus, hipDeviceAttributeMultiprocessorCount, dev);
        hipFuncSetAttribute((const void*)mk_fwd<true>, hipFuncAttributeMaxDynamicSharedMemorySize, LDS_BYTES);
        hipFuncSetAttribute((const void*)mk_fwd<false>, hipFuncAttributeMaxDynamicSharedMemorySize, LDS_BYTES);
        int per_cu = 0; hipOccupancyMaxActiveBlocksPerMultiprocessor(&per_cu, mk_fwd<true>, NTHREADS, LDS_BYTES);
        if (per_cu < 1) { fprintf(stderr, "kernel_launch: occupancy query says %d blocks/CU\n", per_cu); per_cu = 1; }
        grid = cus > 0 ? cus : 256;
    }
    Args a; memset(&a, 0, sizeof(a));
    for (int i = 0; i < 28; ++i) a.in[i] = (const float*)d_in[i];
    a.out = (float*)d_out; a.ws = (unsigned char*)d_ws;
#if MK_ONE_LAUNCH
    if (hipMemsetAsync((char*)d_ws + WS_BAR, 0, BAR_BYTES, stream) != hipSuccess) { fprintf(stderr, "kernel_launch: memset of the barrier words failed\n"); return; }
    a.ph_lo = 0; a.ph_hi = NPH;
    void* args[] = {&a};
    hipError_t e = hipLaunchCooperativeKernel((const void*)mk_fwd<true>, dim3(grid), dim3(NTHREADS), args, LDS_BYTES, stream);
    if (e != hipSuccess) fprintf(stderr, "cooperative launch failed: %s (grid %d)\n", hipGetErrorString(e), grid);
#else
    for (int p = 0; p < 13; ++p) {
        a.ph_lo = p; a.ph_hi = p + 1;
        mk_fwd<false><<<dim3(grid), dim3(NTHREADS), LDS_BYTES, stream>>>(a);
        if ((MK_DBL_MASK >> p) & 1) mk_fwd<false><<<dim3(grid), dim3(NTHREADS), LDS_BYTES, stream>>>(a);
    }
#endif
}
```

```cpp
#include <hip/hip_runtime.h>
#include <hip/hip_cooperative_groups.h>
#include <cstdio>
#include <cstdint>
#include <cstring>
namespace cg = cooperative_groups;

#define DI __device__ __forceinline__
#define LAS __attribute__((address_space(3)))
typedef unsigned short bf16_t;
typedef short bf16x8 __attribute__((ext_vector_type(8)));
typedef float f32x4 __attribute__((ext_vector_type(4)));
typedef float f32x16 __attribute__((ext_vector_type(16)));
typedef unsigned u32x4 __attribute__((ext_vector_type(4)));
typedef unsigned u32x2 __attribute__((ext_vector_type(2)));

constexpr int D = 2048, MP = 8192, MS = 32, MT = 8224, MPAD = 8448, SEQ = 2048;
constexpr int CIN = 6432, NIN = 6656, CSH = 3360, FF2 = 11264, FF = 5632;
constexpr int NLO = 3072, KLO = 384;
constexpr int NS = 16, SEGL = 128, TB = 8;
constexpr int NTHREADS = 512, NWAVES = 8;
constexpr int LDS_BYTES = 131072 + 16384;

constexpr size_t O_YP = 0;
constexpr size_t O_YS = O_YP + (size_t)MP * D;
constexpr size_t O_PK = O_YS + (size_t)MS * D;
constexpr size_t O_PV = O_PK + (size_t)MP * 1024;
constexpr size_t O_PRW = O_PV + (size_t)MP * 1024;
constexpr size_t O_PWKV = O_PRW + (size_t)4 * CSH;
constexpr size_t O_PFFN = O_PWKV + (size_t)4 * 16 * 4096;
constexpr size_t O_SK = O_PFFN + (size_t)4 * 2 * FF2;
constexpr size_t O_SV = O_SK + (size_t)MS * 1024;
constexpr size_t O_SRW = O_SV + (size_t)MS * 1024;
constexpr size_t O_SWKV = O_SRW + (size_t)MS * CSH;
constexpr size_t O_SFFN = O_SWKV + (size_t)MS * 16 * 4096;
constexpr size_t O_END = O_SFFN + (size_t)MS * 2 * FF2;

constexpr size_t al256(size_t x) { return (x + 255) & ~(size_t)255; }
constexpr size_t WS_WIN = 0;
constexpr size_t WS_WO = WS_WIN + al256((size_t)NIN * D * 2);
constexpr size_t WS_WUP = WS_WO + al256((size_t)D * D * 2);
constexpr size_t WS_WDN = WS_WUP + al256((size_t)FF2 * D * 2);
constexpr size_t WS_WLO = WS_WDN + al256((size_t)D * FF * 2);
constexpr size_t WS_H = WS_WLO + al256((size_t)NLO * KLO * 2);
constexpr size_t WS_QB = WS_H + al256((size_t)MPAD * D * 2);
constexpr size_t WS_KB = WS_QB + al256((size_t)MPAD * 1024 * 2);
constexpr size_t WS_VB = WS_KB + al256((size_t)MPAD * 1024 * 2);
constexpr size_t WS_ALO = WS_VB + al256((size_t)MPAD * 1024 * 2);
constexpr size_t WS_O = WS_ALO + al256((size_t)MPAD * KLO * 2);
constexpr size_t WS_GB = WS_O + al256((size_t)MPAD * D * 2);
constexpr size_t WS_YL = WS_GB + al256((size_t)MT * 2048 * 2);
constexpr size_t WS_QS = WS_YL + al256((size_t)MP * 1024 * 4);
constexpr size_t WS_ZP = WS_QS + al256((size_t)MP * 1024 * 4);
constexpr size_t WS_SST = WS_ZP + al256((size_t)64 * NS * 2 * 4096 * 4);
constexpr size_t WS_X1 = WS_SST + al256((size_t)64 * NS * 4096 * 4);
constexpr size_t WS_PML = WS_X1 + al256((size_t)MPAD * D * 4);
constexpr size_t WS_RA = WS_PML + al256((size_t)3 * MP * 16 * 2 * 4);
constexpr size_t WS_RW = WS_RA;
constexpr size_t WS_L = WS_RW + al256((size_t)MPAD * CSH * 4);
constexpr size_t RA_BYTES_1 = al256((size_t)MPAD * CSH * 4) + al256((size_t)MPAD * NLO * 2);
constexpr size_t RA_BYTES_2 = al256((size_t)MPAD * FF2 * 2);
constexpr size_t WS_U = WS_RA;
constexpr size_t WS_RB = WS_RA + (RA_BYTES_1 > RA_BYTES_2 ? RA_BYTES_1 : RA_BYTES_2);
constexpr size_t WS_PART = WS_RB;
constexpr size_t WS_ACT = WS_RB;
constexpr size_t RB_BYTES_1 = al256((size_t)3 * MP * 1024 * 2);
constexpr size_t RB_BYTES_2 = al256((size_t)MPAD * FF * 2);
constexpr size_t WS_RSS = WS_RB + (RB_BYTES_1 > RB_BYTES_2 ? RB_BYTES_1 : RB_BYTES_2);
constexpr size_t WS_BAR_ = 0; constexpr size_t WS_BAR = al256((size_t)MPAD * 4) + WS_RB + (RB_BYTES_1 > RB_BYTES_2 ? RB_BYTES_1 : RB_BYTES_2);
constexpr size_t BAR_BYTES = 16384;
constexpr size_t WS_END = WS_BAR + BAR_BYTES;

struct Args {
    const float* in[28];
    float* out;
    unsigned char* ws;
    int ph_lo, ph_hi;
};
enum { I_XP = 0, I_XS, I_CK, I_CV, I_SSH, I_SWKV, I_SFFN, I_NMG, I_WIN, I_AOG, I_MU, I_W0, I_WUP, I_A0, I_AUP, I_GUP,
       I_KK, I_KA, I_RK, I_LNW, I_LNB, I_WO, I_NFG, I_FUP, I_FCW, I_FCB, I_FDN, I_NFIN };

DI unsigned bf_rne(float f) { unsigned u = __float_as_uint(f); u += 0x7fffu + ((u >> 16) & 1u); return u >> 16; }
DI unsigned pk2(float lo, float hi) { return bf_rne(lo) | (bf_rne(hi) << 16); }
DI unsigned cvt_pk(float lo, float hi) { unsigned r; asm volatile("v_cvt_pk_bf16_f32 %0, %1, %2" : "=v"(r) : "v"(lo), "v"(hi)); return r; }
DI void atomic_add_f32(float* p, float v) { (void)__builtin_amdgcn_global_atomic_fadd_f32((__attribute__((address_space(1))) float*)p, v); }
DI float bf2f(unsigned short b) { return __uint_as_float(((unsigned)b) << 16); }
#define DPP_ADD(v, ctrl) ((v) + __int_as_float(__builtin_amdgcn_update_dpp(0, __float_as_int(v), (ctrl), 0xf, 0xf, false)))
DI float wave_sum(float v) {
    v = DPP_ADD(v, 0xB1);
    v = DPP_ADD(v, 0x4E);
    v = DPP_ADD(v, 0x141);
    v = DPP_ADD(v, 0x140);
    const float s0 = __int_as_float(__builtin_amdgcn_readlane(__float_as_int(v), 0)), s1 = __int_as_float(__builtin_amdgcn_readlane(__float_as_int(v), 16));
    const float s2 = __int_as_float(__builtin_amdgcn_readlane(__float_as_int(v), 32)), s3 = __int_as_float(__builtin_amdgcn_readlane(__float_as_int(v), 48));
    return (s0 + s1) + (s2 + s3);
}

namespace pg8 {
constexpr int BM = 256, BK = 64, HALF = 128, HTB = HALF * BK * 2, STAGE_BYTES = 8 * HTB, NXCD = 8, WGM = 8;
DI int lds_byte(int r, int c) { const int st = (r >> 4) * 2 + (c >> 5), rr = r & 15, cc = c & 31, ob = rr * 64 + cc * 2; return st * 1024 + (ob ^ (((ob >> 9) & 1) << 5)); }
DI void stage_rc(int b, int& R, int& C) { const int st = b / 1024, sb = b % 1024, swz = sb ^ (((sb >> 9) & 1) << 5); R = (st >> 1) * 16 + swz / 64; C = (st & 1) * 32 + (swz % 64) / 2; }
struct Unit { int pm, pn; };
struct Gemm { const bf16_t* A; const bf16_t* Bt; int M, N, K; };
struct StaticOrder {
    int nM, nN, nwg, G, c;
    DI void init(int M, int N, int G_, int c_) { nM = M / BM; nN = N / BM; nwg = nM * nN; G = G_; c = c_; }
    DI bool next(int i, Unit& u) const {
        const long L = (long)i * G + c; if (L >= nwg) return false;
        int wgid = (int)L; { const int q = nwg / NXCD, r = nwg % NXCD, xcd = wgid % NXCD, off = wgid / NXCD; wgid = (xcd < r ? xcd * (q + 1) : r * (q + 1) + (xcd - r) * q) + off; }
        const int nig = WGM * nN, gid = wgid / nig, fm = gid * WGM, gsz = (nM - fm) < WGM ? (nM - fm) : WGM;
        u.pm = fm + ((wgid % nig) % gsz); u.pn = (wgid % nig) / gsz; return true;
    }
};

template <class Epi>
DI void gemm_phase(LAS unsigned char* lds, const Gemm g, const StaticOrder& S, const Epi& E) {
    const int tid = threadIdx.x, wid = __builtin_amdgcn_readfirstlane(tid >> 6), lane = tid & 63, wr = wid >> 2, wc = wid & 3, fr = lane & 15, fq = lane >> 4;
    const int K = g.K, nt = K / BK;
    unsigned voffA[2];
#pragma unroll
    for (int i = 0; i < 2; ++i) { int R, C; stage_rc(tid * 16 + i * 8192, R, C); voffA[i] = (unsigned)(R * K + C) * 2u; }
    const size_t kstep = (size_t)(BK * 2);
    const size_t hstep = (size_t)HALF * K * 2;
    const size_t tstep = 2 * hstep;
    const unsigned ldsw = (unsigned)wid * 1024u;
    const int aoff = lds_byte(wr * 64 + fr, fq * 8), boff = lds_byte(wc * 32 + fr, fq * 8);
#define PG8_SA(b, h) (((b) * 2 + (h)) * HTB)
#define PG8_SB(b, h) ((4 + (b) * 2 + (h)) * HTB)
#define PG8_STAGE(bufoff, gbase, voff) do { _Pragma("unroll") for (int _i = 0; _i < 2; ++_i) \
        __builtin_amdgcn_global_load_lds((const unsigned*)((const char*)(gbase) + (voff)[_i]), (LAS unsigned*)(lds + (bufoff) + ldsw + _i * 8192), 16, 0, 0); } while (0)
#define PG8_LDA(dst, b, h) do { _Pragma("unroll") for (int m = 0; m < 4; ++m) _Pragma("unroll") for (int k = 0; k < 2; ++k) dst[m][k] = *(const LAS bf16x8*)(lds + PG8_SA(b, h) + aoff + m * 2048 + k * 1024); } while (0)
#define PG8_LDB(dst, b, h) do { _Pragma("unroll") for (int n = 0; n < 2; ++n) _Pragma("unroll") for (int k = 0; k < 2; ++k) dst[n][k] = *(const LAS bf16x8*)(lds + PG8_SB(b, h) + boff + n * 2048 + k * 1024); } while (0)
#define PG8_MMA(ai, bj, At, Bt) do { __builtin_amdgcn_s_setprio(1); _Pragma("unroll") for (int m = 0; m < 4; ++m) _Pragma("unroll") for (int n = 0; n < 2; ++n) _Pragma("unroll") for (int k = 0; k < 2; ++k) \
        acc[ai][bj][m][n] = __builtin_amdgcn_mfma_f32_16x16x32_bf16(Bt[n][k], At[m][k], acc[ai][bj][m][n], 0, 0, 0); __builtin_amdgcn_s_setprio(0); } while (0)
#define PG8_WAIT_V(n) asm volatile("s_waitcnt vmcnt(" #n ")" ::: "memory")
#define PG8_WAIT_L(n) asm volatile("s_waitcnt lgkmcnt(" #n ")" ::: "memory")
#define PG8_BAR __builtin_amdgcn_s_barrier()
#define PG8_SCHED __builtin_amdgcn_sched_barrier(0)
    Unit cur, nxt; int ui = 0;
    if (!S.next(0, cur)) return;
    f32x4 acc[2][2][4][2];
#pragma unroll
    for (int a = 0; a < 2; ++a)
#pragma unroll
        for (int b = 0; b < 2; ++b)
#pragma unroll
            for (int m = 0; m < 4; ++m)
#pragma unroll
                for (int n = 0; n < 2; ++n) acc[a][b][m][n] = (f32x4){0.f, 0.f, 0.f, 0.f};
    bf16x8 At[4][2], B0[2][2], B1[2][2];
    const char* cA = (const char*)g.A + (size_t)cur.pm * tstep; const char* cB = (const char*)g.Bt + (size_t)cur.pn * tstep;
    PG8_STAGE(PG8_SB(0, 0), cB, voffA); PG8_STAGE(PG8_SA(0, 0), cA, voffA); PG8_STAGE(PG8_SB(0, 1), cB + hstep, voffA); PG8_STAGE(PG8_SA(0, 1), cA + hstep, voffA);
    if (wr == 1) PG8_BAR;
    PG8_WAIT_V(4); PG8_BAR;
    PG8_STAGE(PG8_SB(1, 0), cB + kstep, voffA); PG8_STAGE(PG8_SA(1, 0), cA + kstep, voffA); PG8_STAGE(PG8_SB(1, 1), cB + hstep + kstep, voffA);
    PG8_WAIT_V(6); PG8_BAR;
    for (;;) {
        const bool has_next = S.next(ui + 1, nxt);
        const char* nA = has_next ? (const char*)g.A + (size_t)nxt.pm * tstep : cA; const char* nB = has_next ? (const char*)g.Bt + (size_t)nxt.pn * tstep : cB;
        for (int t = 0; t < nt; t += 2) {
            const bool last = (t == nt - 2);
            const char* a1 = cA + (size_t)(t + 1) * kstep;
            const char* a2 = last ? nA : cA + (size_t)(t + 2) * kstep; const char* b2 = last ? nB : cB + (size_t)(t + 2) * kstep;
            const char* a3 = a2 + kstep; const char* b3 = b2 + kstep;
            PG8_LDB(B0, 0, 0); PG8_SCHED; PG8_LDA(At, 0, 0); PG8_STAGE(PG8_SA(1, 1), a1 + hstep, voffA);
            PG8_WAIT_L(8); PG8_BAR; PG8_WAIT_L(0); PG8_MMA(0, 0, At, B0); PG8_BAR; PG8_SCHED;
            PG8_LDB(B1, 0, 1); PG8_STAGE(PG8_SB(0, 0), b2, voffA);
            PG8_BAR; PG8_WAIT_L(0); PG8_MMA(0, 1, At, B1); PG8_BAR;
            PG8_LDA(At, 0, 1); PG8_STAGE(PG8_SA(0, 0), a2, voffA);
            PG8_BAR; PG8_WAIT_L(0); PG8_MMA(1, 0, At, B0); PG8_BAR; PG8_SCHED;
            PG8_STAGE(PG8_SB(0, 1), b2 + hstep, voffA);
            PG8_WAIT_V(6); PG8_BAR; PG8_MMA(1, 1, At, B1); PG8_BAR;
            PG8_LDB(B0, 1, 0); PG8_SCHED; PG8_LDA(At, 1, 0); PG8_STAGE(PG8_SA(0, 1), a2 + hstep, voffA);
            PG8_WAIT_L(8); PG8_BAR; PG8_WAIT_L(0); PG8_MMA(0, 0, At, B0); PG8_BAR; PG8_SCHED;
            PG8_LDB(B1, 1, 1); PG8_STAGE(PG8_SB(1, 0), b3, voffA);
            PG8_BAR; PG8_WAIT_L(0); PG8_MMA(0, 1, At, B1); PG8_BAR;
            PG8_LDA(At, 1, 1); PG8_STAGE(PG8_SA(1, 0), a3, voffA);
            PG8_BAR; PG8_WAIT_L(0); PG8_MMA(1, 0, At, B0); PG8_BAR; PG8_SCHED;
            PG8_STAGE(PG8_SB(1, 1), b3 + hstep, voffA);
            PG8_WAIT_V(6); PG8_BAR; PG8_MMA(1, 1, At, B1); PG8_BAR;
        }
        E(acc, cur, wr, wc, fr, fq);
        if (!has_next) break;
#pragma unroll
        for (int a = 0; a < 2; ++a)
#pragma unroll
            for (int b = 0; b < 2; ++b)
#pragma unroll
                for (int m = 0; m < 4; ++m)
#pragma unroll
                    for (int n = 0; n < 2; ++n) acc[a][b][m][n] = (f32x4){0.f, 0.f, 0.f, 0.f};
        cur = nxt; cA = nA; cB = nB; ++ui;
    }
    PG8_WAIT_V(0);
    if (wr == 0) PG8_BAR;
    PG8_BAR;
#undef PG8_SA
#undef PG8_SB
#undef PG8_STAGE
#undef PG8_LDA
#undef PG8_LDB
#undef PG8_MMA
#undef PG8_WAIT_V
#undef PG8_WAIT_L
#undef PG8_BAR
#undef PG8_SCHED
}
}

typedef f32x4 AccT[2][2][4][2];
#define EPI_LOOP_BEGIN \
    const int row0 = u.pm * 256 + wr * 64 + fr, col0 = u.pn * 256 + wc * 32 + 4 * fq; \
    _Pragma("unroll") for (int ai = 0; ai < 2; ++ai) _Pragma("unroll") for (int m = 0; m < 4; ++m) { const int row = row0 + ai * 128 + m * 16; \
    _Pragma("unroll") for (int bj = 0; bj < 2; ++bj) _Pragma("unroll") for (int n = 0; n < 2; ++n) { const int col = col0 + bj * 128 + n * 16; const f32x4 v = acc[ai][bj][m][n];
#define EPI_LOOP_END } }
#define EPI_LOOP_BEGIN_S \
    const int row0 = u.pm * 256 + wr * 64 + fr, col0 = u.pn * 256 + wc * 32 + 4 * fq; \
    _Pragma("unroll") for (int ai = 0; ai < 2; ++ai) _Pragma("unroll") for (int m = 0; m < 4; ++m) { const int row = row0 + ai * 128 + m * 16; \
    _Pragma("unroll") for (int bj = 0; bj < 2; ++bj) _Pragma("unroll") for (int n = 0; n < 2; ++n) { const int col = col0 + bj * 128 + n * 16; const f32x4 v = acc[ai][bj][m][n] * rs[ai][m];

struct EpiIn {
    bf16_t *Qb, *Kb, *Vb; float* RW; float* out;
    DI void operator()(const AccT& acc, const pg8::Unit& u, int wr, int wc, int fr, int fq) const {
        const int reg = u.pn < 4 ? 0 : (u.pn < 8 ? 1 : (u.pn < 12 ? 2 : 3));
        EPI_LOOP_BEGIN
            if (row < MT) {
                if (reg == 0) {
                    u32x2 w; w.x = cvt_pk(v[0] * 0.125f, v[1] * 0.125f); w.y = cvt_pk(v[2] * 0.125f, v[3] * 0.125f);
                    *(u32x2*)(Qb + (size_t)row * 1024 + col) = w;
                } else if (reg == 1 || reg == 2) {
                    const int c = col - (reg == 1 ? 1024 : 2048);
                    float* o = row < MP ? out + (reg == 1 ? O_PK : O_PV) + (size_t)row * 1024 + c : out + (reg == 1 ? O_SK : O_SV) + (size_t)(row - MP) * 1024 + c;
                    *(f32x4*)o = v;
                    u32x2 w; w.x = cvt_pk(v[0], v[1]); w.y = cvt_pk(v[2], v[3]);
                    *(u32x2*)((reg == 1 ? Kb : Vb) + (size_t)row * 1024 + c) = w;
                } else {
                    const int c = col - 3072;
                    if (c < CSH) {
                        *(f32x4*)(RW + (size_t)row * CSH + c) = v;
                        if (row >= MP) *(f32x4*)(out + O_SRW + (size_t)(row - MP) * CSH + c) = v;
                        else if ((row & (SEQ - 1)) == SEQ - 1) *(f32x4*)(out + O_PRW + (size_t)(row >> 11) * CSH + c) = v;
                    }
                }
            }
        EPI_LOOP_END
    }
};
struct EpiBf {
    bf16_t* C; int ldc;
    DI void operator()(const AccT& acc, const pg8::Unit& u, int wr, int wc, int fr, int fq) const {
        const int row0 = u.pm * 256 + wr * 64 + fr, col0 = u.pn * 256 + wc * 32 + 4 * fq;
#pragma unroll
        for (int ai = 0; ai < 2; ++ai)
#pragma unroll
            for (int m = 0; m < 4; ++m) { const int row = row0 + ai * 128 + m * 16;
#pragma unroll
                for (int bj = 0; bj < 2; ++bj)
#pragma unroll
                    for (int n = 0; n < 2; ++n) { const int col = col0 + bj * 128 + n * 16; const f32x4 v = acc[ai][bj][m][n];
                        u32x2 w; w.x = cvt_pk(v[0], v[1]); w.y = cvt_pk(v[2], v[3]);
                        *(u32x2*)(C + (size_t)row * ldc + col) = w; }
                asm volatile("" ::: "memory");
            }
    }
};
struct EpiWo {
    const float *xp; const float* gf; float* X1; bf16_t* H; float* RSS;
    DI void operator()(const AccT& acc, const pg8::Unit& u, int wr, int wc, int fr, int fq) const {
        const int row0 = u.pm * 256 + wr * 64 + fr, col0 = u.pn * 256 + wc * 32 + 4 * fq;
#pragma unroll
        for (int ai = 0; ai < 2; ++ai)
#pragma unroll
            for (int m = 0; m < 4; ++m) {
                const int row = row0 + ai * 128 + m * 16; float ss = 0.f;
#pragma unroll
                for (int bj = 0; bj < 2; ++bj)
#pragma unroll
                    for (int n = 0; n < 2; ++n) {
                        const int col = col0 + bj * 128 + n * 16;
                        const f32x4 x1 = *(const f32x4*)(xp + (size_t)row * D + col) + acc[ai][bj][m][n];
                        *(f32x4*)(X1 + (size_t)row * D + col) = x1;
                        const f32x4 gg = *(const f32x4*)(gf + col);
                        u32x2 w; w.x = cvt_pk(x1[0] * gg[0], x1[1] * gg[1]); w.y = cvt_pk(x1[2] * gg[2], x1[3] * gg[3]);
                        *(u32x2*)(H + (size_t)row * D + col) = w;
                        ss += (x1[0] * x1[0] + x1[1] * x1[1]) + (x1[2] * x1[2] + x1[3] * x1[3]);
                    }
                ss += __shfl_xor(ss, 16); ss += __shfl_xor(ss, 32);
                if (fq == 0) atomic_add_f32(RSS + row, ss);
            }
    }
};
struct EpiUp {
    bf16_t* U; float* out; const float* RSS;
    DI void operator()(const AccT& acc, const pg8::Unit& u, int wr, int wc, int fr, int fq) const {
        float rs[2][4];
        { const int row0_ = u.pm * 256 + wr * 64 + fr;
#pragma unroll
          for (int ai = 0; ai < 2; ++ai)
#pragma unroll
              for (int m = 0; m < 4; ++m) rs[ai][m] = rsqrtf(RSS[row0_ + ai * 128 + m * 16] * (1.f / D) + 1e-6f); }
        EPI_LOOP_BEGIN_S
            if (row < MT) {
                u32x2 w; w.x = cvt_pk(v[0], v[1]); w.y = cvt_pk(v[2], v[3]);
                *(u32x2*)(U + (size_t)row * FF2 + col) = w;
                if (row >= MP) *(f32x4*)(out + O_SFFN + (size_t)(row - MP) * 2 * FF2 + FF2 + col) = v;
                else if ((row & (SEQ - 1)) >= SEQ - 2) *(f32x4*)(out + O_PFFN + ((size_t)(row >> 11) * 2 + ((row & (SEQ - 1)) - (SEQ - 2))) * FF2 + col) = v;
            }
        EPI_LOOP_END
    }
};
struct EpiDn {
    float* X1;
    DI void operator()(const AccT& acc, const pg8::Unit& u, int wr, int wc, int fr, int fq) const {
        EPI_LOOP_BEGIN
            if (row < MT) { float* p = X1 + (size_t)row * D + col; *(f32x4*)p = *(const f32x4*)p + v; }
        EPI_LOOP_END
    }
};

DI void transpose_item(const float* W, int K, int N, bf16_t* WT, int ldt, float* scr, int item, int lane) {
    const int nblk = N / 32, kb = item / nblk, nb = item % nblk, k0 = 64 * kb, n0 = 32 * nb;
#pragma unroll 8
    for (int i = 0; i < 32; ++i) { const int kk = 2 * i + (lane >> 5); scr[kk * 33 + (lane & 31)] = W[(size_t)(k0 + kk) * N + n0 + (lane & 31)]; }
    __builtin_amdgcn_fence(__ATOMIC_RELEASE, "wavefront"); asm volatile("s_waitcnt lgkmcnt(0)" ::: "memory");
    const int c = lane & 7;
#pragma unroll
    for (int j = 0; j < 4; ++j) { const int n = (lane >> 3) + 8 * j; const float* s = scr + (8 * c) * 33 + n;
        u32x4 o; o.x = pk2(s[0 * 33], s[1 * 33]); o.y = pk2(s[2 * 33], s[3 * 33]); o.z = pk2(s[4 * 33], s[5 * 33]); o.w = pk2(s[6 * 33], s[7 * 33]);
        *(u32x4*)(WT + (size_t)(n0 + n) * ldt + k0 + 8 * c) = o; }
    asm volatile("s_waitcnt lgkmcnt(0)" ::: "memory");
}
DI void rms_row_bf16(const float* xrow, const float* g, bf16_t* orow, int lane) {
    const f32x4* xr = (const f32x4*)xrow + lane; const f32x4* gr = (const f32x4*)g + lane;
    f32x4 v[8]; float s = 0.f;
#pragma unroll
    for (int j = 0; j < 8; ++j) { v[j] = xr[64 * j]; s += (v[j].x * v[j].x + v[j].y * v[j].y) + (v[j].z * v[j].z + v[j].w * v[j].w); }
    const float rstd = rsqrtf(wave_sum(s) * (1.f / D) + 1e-6f);
    u32x2* o8 = (u32x2*)orow + lane;
#pragma unroll
    for (int j = 0; j < 8; ++j) { const f32x4 gg = gr[64 * j]; u32x2 w; w.x = pk2(v[j].x * rstd * gg.x, v[j].y * rstd * gg.y); w.y = pk2(v[j].z * rstd * gg.z, v[j].w * rstd * gg.w); o8[64 * j] = w; }
}
DI void rms_row_f32(const float* xrow, const float* g, float* orow, int lane) {
    const f32x4* xr = (const f32x4*)xrow + lane; const f32x4* gr = (const f32x4*)g + lane;
    f32x4 v[8]; float s = 0.f;
#pragma unroll
    for (int j = 0; j < 8; ++j) { v[j] = xr[64 * j]; s += (v[j].x * v[j].x + v[j].y * v[j].y) + (v[j].z * v[j].z + v[j].w * v[j].w); }
    const float rstd = rsqrtf(wave_sum(s) * (1.f / D) + 1e-6f);
    f32x4* o = (f32x4*)orow + lane;
#pragma unroll
    for (int j = 0; j < 8; ++j) { const f32x4 gg = gr[64 * j]; o[64 * j] = v[j] * rstd * gg; }
}
DI void zero_row_bf16(bf16_t* orow, int ncols, int lane) {
    for (int c = lane * 8; c < ncols; c += 512) *(u32x4*)(orow + c) = (u32x4){0u, 0u, 0u, 0u};
}

DI void phase_prologue(const Args& a, unsigned char* lds, int gw, int ngw, int lane, int wave) {
    unsigned char* ws = a.ws;
    float* scr = (float*)(lds + wave * 16384);
    bf16_t* Win = (bf16_t*)(ws + WS_WIN); bf16_t* Wlo = (bf16_t*)(ws + WS_WLO);
    constexpr int IT_IN = (D / 64) * (CIN / 32);
    for (int it = gw; it < IT_IN; it += ngw) transpose_item(a.in[I_WIN], D, CIN, Win, D, scr, it, lane);
    for (int r = CIN + gw; r < NIN; r += ngw) zero_row_bf16(Win + (size_t)r * D, D, lane);
    {
        const int gt = gw * 64 + lane, ngt = ngw * 64;
        for (int i = gt; i < NLO * KLO; i += ngt) {
            const int n = i / KLO, k = i % KLO; float v = 0.f;
            if (n < 1024) { if (k < 64) v = a.in[I_WUP][k * 1024 + n]; }
            else if (n < 2048) { if (k >= 64 && k < 128) v = a.in[I_AUP][(k - 64) * 1024 + (n - 1024)]; }
            else { if (k >= 128 && k < 288) v = a.in[I_GUP][(k - 128) * 1024 + (n - 2048)]; }
            Wlo[i] = (bf16_t)bf_rne(v);
        }
    }
    { float* RSS = (float*)(ws + WS_RSS); for (int i = gw * 64 + lane; i < MPAD; i += ngw * 64) RSS[i] = 0.f; }
    bf16_t* H = (bf16_t*)(ws + WS_H);
    for (int m = gw; m < MPAD; m += ngw) {
        if (m < MT) rms_row_bf16(m < MP ? a.in[I_XP] + (size_t)m * D : a.in[I_XS] + (size_t)(m - MP) * D, a.in[I_NMG], H + (size_t)m * D, lane);
        else zero_row_bf16(H + (size_t)m * D, D, lane);
    }
}


DI void convert_wo_wup(const Args& a, unsigned char* lds, int wi, int nw, int wave, int lane) {
    float* scr = (float*)(lds + wave * 16384);
    constexpr int IT_O = (D / 64) * (D / 32), IT_UP = (D / 64) * (FF2 / 32);
    for (int it = wi; it < IT_O + IT_UP; it += nw) {
        if (it < IT_O) transpose_item(a.in[I_WO], D, D, (bf16_t*)(a.ws + WS_WO), D, scr, it, lane);
        else transpose_item(a.in[I_FUP], D, FF2, (bf16_t*)(a.ws + WS_WUP), D, scr, it - IT_O, lane);
    }
}
DI void convert_wdn(const Args& a, unsigned char* lds, int wi, int nw, int wave, int lane) {
    float* scr = (float*)(lds + wave * 16384);
    constexpr int IT_DN = (FF / 64) * (D / 32);
    for (int it = wi; it < IT_DN; it += nw) transpose_item(a.in[I_FDN], FF, D, (bf16_t*)(a.ws + WS_WDN), FF, scr, it, lane);
}

DI const float* rw_prev_row(const Args& a, const float* RW, int m) {
    if (m < MP) return (m & (SEQ - 1)) == 0 ? nullptr : RW + (size_t)(m - 1) * CSH;
    return a.in[I_SSH] + (size_t)(m - MP) * CSH;
}
DI void lora_input_row(const Args& a, int m, int lane) {
    bf16_t* ALO = (bf16_t*)(a.ws + WS_ALO) + (size_t)m * KLO;
    if (m >= MT) { for (int c = lane; c < KLO; c += 64) ALO[c] = 0; return; }
    const float* RW = (const float*)(a.ws + WS_RW);
    const float* cur = RW + (size_t)m * CSH; const float* prev = rw_prev_row(a, RW, m);
    for (int c = lane; c < KLO; c += 64) {
        float v = 0.f;
        if (c < 288) {
            const int j = 3072 + c; const float x = cur[j], p = prev ? prev[j] : 0.f; const float xs = x + a.in[I_MU][j] * (p - x);
            v = c < 64 ? 1.f - 2.f * __builtin_amdgcn_rcpf(1.f + __expf(2.f * xs)) : (c < 128 ? xs : __builtin_amdgcn_rcpf(1.f + __expf(-xs)));
        }
        ALO[c] = (bf16_t)bf_rne(v);
    }
}

DI int crow(int reg, int h) { return (reg & 3) + 8 * (reg >> 2) + 4 * h; }
typedef short s16x4 __attribute__((ext_vector_type(4)));
constexpr int VPITCH = 192;
DI void attn_prompt_unit(const Args& a, unsigned char* lds, int unit, int wave, int lane) {
    const bf16_t* Qb = (const bf16_t*)(a.ws + WS_QB); const bf16_t* Kb = (const bf16_t*)(a.ws + WS_KB); const bf16_t* Vb = (const bf16_t*)(a.ws + WS_VB);
    bf16_t* PO = (bf16_t*)(a.ws + WS_PART); float* PML = (float*)(a.ws + WS_PML);
    LAS unsigned char* img = (LAS unsigned char*)lds + wave * (32 * VPITCH);
    const int blk = unit & 63, br = (unit >> 6) % 3, bh = unit / 192, b = bh >> 4, h = bh & 15;
    const int rate = br == 0 ? 1 : (br == 1 ? 4 : 16), L = SEQ / rate, bpc = L / 32;
    const int rho = blk / bpc, l0 = (blk % bpc) * 32;
    const int r = lane & 31, hh = lane >> 5;
    const int mq = b * SEQ + rho + rate * (l0 + r);
    bf16x8 qf[4];
#pragma unroll
    for (int ks = 0; ks < 4; ++ks) qf[ks] = *(const bf16x8*)(Qb + (size_t)mq * 1024 + h * 64 + ks * 16 + 8 * hh);
    f32x16 o0, o1;
#pragma unroll
    for (int i = 0; i < 16; ++i) { o0[i] = 0.f; o1[i] = 0.f; }
    float mrun = -1e30f, lrun = 0.f;
    const int lq = l0 + r;
    const int c0 = l0 >= 128 ? 0 : (128 - l0) >> 5;
    const bf16_t* kbase = Kb + (size_t)(b * SEQ + rho) * 1024 + h * 64 + 8 * hh;
    const bf16_t* vbase = Vb + (size_t)(b * SEQ + rho) * 1024 + h * 64 + 8 * (lane & 7);
    bf16x8 kreg[4]; u32x4 vreg[4];
#define AT_PREFETCH(ch_) do { const int lk0_ = l0 - 128 + 32 * (ch_); \
        _Pragma("unroll") for (int ks = 0; ks < 4; ++ks) kreg[ks] = *(const bf16x8*)(kbase + (size_t)(rate * (lk0_ + r)) * 1024 + ks * 16); \
        _Pragma("unroll") for (int i = 0; i < 4; ++i) vreg[i] = *(const u32x4*)(vbase + (size_t)(rate * (lk0_ + 8 * i + (lane >> 3))) * 1024); } while (0)
    AT_PREFETCH(c0);
    const int i16 = lane & 15, tq = i16 >> 2, tp = i16 & 3, g16 = (lane >> 4) & 1;
    const unsigned troff = (unsigned)((4 * hh + tq) * VPITCH + g16 * 32 + 8 * tp);
    for (int ch = c0; ch < 5; ++ch) {
        const int lk0 = l0 - 128 + 32 * ch;
        bf16x8 kf[4];
#pragma unroll
        for (int ks = 0; ks < 4; ++ks) kf[ks] = kreg[ks];
#pragma unroll
        for (int i = 0; i < 4; ++i) *(LAS u32x4*)(img + (8 * i + (lane >> 3)) * VPITCH + 16 * (lane & 7)) = vreg[i];
        if (ch + 1 < 5) AT_PREFETCH(ch + 1);
        f32x16 st;
#pragma unroll
        for (int i = 0; i < 16; ++i) st[i] = 0.f;
#pragma unroll
        for (int ks = 0; ks < 4; ++ks) st = __builtin_amdgcn_mfma_f32_32x32x16_bf16(kf[ks], qf[ks], st, 0, 0, 0);
        float cmax = -1e30f;
#pragma unroll
        for (int i = 0; i < 16; ++i) { const int lk = lk0 + crow(i, hh); const bool ok = (lk <= lq) && (lk >= lq - 128); st[i] = ok ? st[i] : -1e30f; cmax = fmaxf(cmax, st[i]); }
        cmax = fmaxf(cmax, __shfl_xor(cmax, 32));
        const float mnew = fmaxf(mrun, cmax), alpha = __expf(mrun - mnew);
        float ps = 0.f;
#pragma unroll
        for (int i = 0; i < 16; ++i) { const float p = st[i] > -1e29f ? __expf(st[i] - mnew) : 0.f; st[i] = p; ps += p; }
        lrun = lrun * alpha + ps; mrun = mnew;
#pragma unroll
        for (int i = 0; i < 16; ++i) { o0[i] *= alpha; o1[i] *= alpha; }
#pragma unroll
        for (int s = 0; s < 2; ++s) {
            u32x4 pp; pp.x = pk2(st[8 * s], st[8 * s + 1]); pp.y = pk2(st[8 * s + 2], st[8 * s + 3]); pp.z = pk2(st[8 * s + 4], st[8 * s + 5]); pp.w = pk2(st[8 * s + 6], st[8 * s + 7]);
            const bf16x8 pf = __builtin_bit_cast(bf16x8, pp);
#pragma unroll
            for (int dt = 0; dt < 2; ++dt) {
                const s16x4 lo = __builtin_amdgcn_ds_read_tr16_b64_v4i16((LAS s16x4*)(img + troff + (16 * s) * VPITCH + dt * 64));
                const s16x4 hi = __builtin_amdgcn_ds_read_tr16_b64_v4i16((LAS s16x4*)(img + troff + (16 * s + 8) * VPITCH + dt * 64));
                const bf16x8 vf = __builtin_shufflevector(lo, hi, 0, 1, 2, 3, 4, 5, 6, 7);
                if (dt == 0) o0 = __builtin_amdgcn_mfma_f32_32x32x16_bf16(vf, pf, o0, 0, 0, 0);
                else o1 = __builtin_amdgcn_mfma_f32_32x32x16_bf16(vf, pf, o1, 0, 0, 0);
            }
        }
    }
#undef AT_PREFETCH
    const float ltot = lrun + __shfl_xor(lrun, 32);
    bf16_t* po = PO + ((size_t)br * MP + mq) * 1024 + h * 64;
#pragma unroll
    for (int g = 0; g < 4; ++g) {
        u32x2 w0, w1; w0.x = pk2(o0[4 * g], o0[4 * g + 1]); w0.y = pk2(o0[4 * g + 2], o0[4 * g + 3]); w1.x = pk2(o1[4 * g], o1[4 * g + 1]); w1.y = pk2(o1[4 * g + 2], o1[4 * g + 3]);
        *(u32x2*)(po + 8 * g + 4 * hh) = w0; *(u32x2*)(po + 32 + 8 * g + 4 * hh) = w1;
    }
    if (hh == 0) { float* pm = PML + (((size_t)br * MP + mq) * 16 + h) * 2; pm[0] = mrun; pm[1] = ltot; }
}
DI float sum16(float v) { v = DPP_ADD(v, 0xB1); v = DPP_ADD(v, 0x4E); v = DPP_ADD(v, 0x141); v = DPP_ADD(v, 0x140); return v; }
DI void attn_merge_task(const Args& a, int task, int lane) {
    const int m = task >> 2, h = (task & 3) * 4 + (lane >> 4), d = 4 * (lane & 15);
    const bf16_t* PO = (const bf16_t*)(a.ws + WS_PART); const float* PML = (const float*)(a.ws + WS_PML);
    bf16_t* O = (bf16_t*)(a.ws + WS_O);
    float mb[3], lb[3]; f32x4 ob[3];
#pragma unroll
    for (int br = 0; br < 3; ++br) { const float* pm = PML + (((size_t)br * MP + m) * 16 + h) * 2; mb[br] = pm[0]; lb[br] = pm[1];
        const u32x2 w = *(const u32x2*)(PO + ((size_t)br * MP + m) * 1024 + h * 64 + d);
        ob[br] = (f32x4){__uint_as_float(w.x << 16), __uint_as_float(w.x & 0xffff0000u), __uint_as_float(w.y << 16), __uint_as_float(w.y & 0xffff0000u)}; }
    const float M = fmaxf(mb[0], fmaxf(mb[1], mb[2]));
    f32x4 num = {0.f, 0.f, 0.f, 0.f}; float den = 0.f;
#pragma unroll
    for (int br = 0; br < 3; ++br) { const float w = __expf(mb[br] - M); num += ob[br] * w; den += w * lb[br]; }
    const f32x4 o = num * __builtin_amdgcn_rcpf(den);
    const float ss = sum16(o.x * o.x + o.y * o.y + o.z * o.z + o.w * o.w) * (1.f / 64.f);
    const float rs = rsqrtf(ss + 1e-6f);
    const f32x4 gg = *(const f32x4*)(a.in[I_AOG] + h * 64 + d);
    u32x2 w; w.x = pk2(o.x * rs * gg.x, o.y * rs * gg.y); w.y = pk2(o.z * rs * gg.z, o.w * rs * gg.w);
    *(u32x2*)(O + (size_t)m * D + h * 64 + d) = w;
}
DI void attn_sample_wg(const Args& a, unsigned char* lds, int unit, int wave, int lane) {
    float* part = (float*)lds;
    const int bh = unit * 2 + (wave >> 2), qt = wave & 3, b = bh >> 4, h = bh & 15, g = lane >> 4, l16 = lane & 15;
    const bf16_t* Qb = (const bf16_t*)(a.ws + WS_QB);
    const float* ck = a.in[I_CK] + (size_t)b * 2048 * 1024 + h * 64 + 4 * l16; const float* cv = a.in[I_CV] + (size_t)b * 2048 * 1024 + h * 64 + 4 * l16;
    const float* nk = a.out + O_SK + (size_t)b * 1024 + h * 64 + 4 * l16; const float* nv = a.out + O_SV + (size_t)b * 1024 + h * 64 + 4 * l16;
    const u32x2 qw = *(const u32x2*)(Qb + (size_t)(MP + b) * 1024 + h * 64 + 4 * l16);
    const float q0 = __uint_as_float(qw.x << 16), q1 = __uint_as_float(qw.x & 0xffff0000u), q2 = __uint_as_float(qw.y << 16), q3 = __uint_as_float(qw.y & 0xffff0000u);
    float mrun = -1e30f, lrun = 0.f; f32x4 acc = {0.f, 0.f, 0.f, 0.f};
    const int e0 = qt * 97, e1 = e0 + 97 < 387 ? e0 + 97 : 387;
    for (int ito = 0; ito < 25; ito += 5) {
        f32x4 kv[5], vv[5]; bool valid[5];
#pragma unroll
        for (int k = 0; k < 5; ++k) {
            const int e = e0 + (ito + k) * 4 + g; valid[k] = e < e1;
            const int ee = valid[k] ? e : e0, br = ee / 129, j = ee % 129, rate = br == 0 ? 1 : (br == 1 ? 4 : 16);
            const int row = 2048 - rate * j;
            const float* kp = j == 0 ? nk : ck + (size_t)row * 1024; const float* vp = j == 0 ? nv : cv + (size_t)row * 1024;
            kv[k] = *(const f32x4*)kp; vv[k] = *(const f32x4*)vp;
        }
#pragma unroll
        for (int k = 0; k < 5; ++k) {
            float s = sum16(q0 * kv[k].x + q1 * kv[k].y + q2 * kv[k].z + q3 * kv[k].w);
            if (!valid[k]) s = -1e30f;
            const float mnew = fmaxf(mrun, s), alpha = __expf(mrun - mnew), p = valid[k] ? __expf(s - mnew) : 0.f;
            lrun = lrun * alpha + p; acc = acc * alpha + vv[k] * p; mrun = mnew;
        }
    }
#pragma unroll
    for (int o = 16; o < 64; o <<= 1) {
        const float mo = __shfl_xor(mrun, o), lo = __shfl_xor(lrun, o);
        f32x4 ao; ao.x = __shfl_xor(acc.x, o); ao.y = __shfl_xor(acc.y, o); ao.z = __shfl_xor(acc.z, o); ao.w = __shfl_xor(acc.w, o);
        const float mn = fmaxf(mrun, mo), w0 = __expf(mrun - mn), w1 = __expf(mo - mn);
        lrun = lrun * w0 + lo * w1; acc = acc * w0 + ao * w1; mrun = mn;
    }
    if (g == 0) { *(f32x4*)(part + wave * 68 + 4 * l16) = acc; if (l16 == 0) { part[wave * 68 + 64] = mrun; part[wave * 68 + 65] = lrun; } }
    __syncthreads();
    if (qt == 0 && g == 0) {
        float M = -1e30f;
#pragma unroll
        for (int w = 0; w < 4; ++w) M = fmaxf(M, part[(wave + w) * 68 + 64]);
        f32x4 num = {0.f, 0.f, 0.f, 0.f}; float den = 0.f;
#pragma unroll
        for (int w = 0; w < 4; ++w) { const float wt = __expf(part[(wave + w) * 68 + 64] - M); num += *(const f32x4*)(part + (wave + w) * 68 + 4 * l16) * wt; den += part[(wave + w) * 68 + 65] * wt; }
        const f32x4 o = num * (1.f / den);
        const float ss = sum16(o.x * o.x + o.y * o.y + o.z * o.z + o.w * o.w);
        const float rs = rsqrtf(ss * (1.f / 64.f) + 1e-6f);
        const f32x4 gg = *(const f32x4*)(a.in[I_AOG] + h * 64 + 4 * l16);
        u32x2 w; w.x = pk2(o.x * rs * gg.x, o.y * rs * gg.y); w.y = pk2(o.z * rs * gg.z, o.w * rs * gg.w);
        *(u32x2*)((bf16_t*)(a.ws + WS_O) + (size_t)(MP + b) * D + h * 64 + 4 * l16) = w;
    }
    __syncthreads();
}

struct PrepParams { float mu_r, mu_k, mu_v, w0, a0, kk, ka, rk; };
struct PrepRaw { float cr, ck, cv, pr, pk, pv, lw, la, lg; };
DI void prep_params(const Args& a, PrepParams& P, int c) {
    P.mu_r = a.in[I_MU][c]; P.mu_k = a.in[I_MU][1024 + c]; P.mu_v = a.in[I_MU][2048 + c];
    P.w0 = a.in[I_W0][c]; P.a0 = a.in[I_A0][c]; P.kk = a.in[I_KK][c]; P.ka = a.in[I_KA][c]; P.rk = a.in[I_RK][c];
}
DI void prep_load(PrepRaw& R, const float* cur, const float* prev, const bf16_t* Lrow, int c) {
    R.cr = cur[c]; R.ck = cur[1024 + c]; R.cv = cur[2048 + c];
    R.pr = prev ? prev[c] : 0.f; R.pk = prev ? prev[1024 + c] : 0.f; R.pv = prev ? prev[2048 + c] : 0.f;
    R.lw = bf2f(Lrow[c]); R.la = bf2f(Lrow[1024 + c]); R.lg = bf2f(Lrow[2048 + c]);
}
DI void prep_finish(const PrepRaw& R, const PrepParams& P, float* dst, float& g_out, float& bonus_out, int lane) {
    const float xr = R.cr + P.mu_r * (R.pr - R.cr), xk = R.ck + P.mu_k * (R.pk - R.ck), xv = R.cv + P.mu_v * (R.pv - R.cv);
    const float x = -(P.w0 + R.lw);
    const float sp = x > 20.f ? x : __logf(1.f + __expf(x));
    const float decay = __expf(-__expf(-sp - 0.5f));
    const float av = __builtin_amdgcn_rcpf(1.f + __expf(-(P.a0 + R.la)));
    float kkv = xk * P.kk;
    const float n2 = wave_sum(kkv * kkv);
    kkv = kkv * fminf(__builtin_amdgcn_rsqf(n2), 1e12f);
    const float keff = xk * (1.f + (av - 1.f) * P.ka);
    const float bon = wave_sum(xr * keff * P.rk) * xv;
    dst[lane] = xr; dst[64 + lane] = decay; dst[128 + lane] = keff; dst[192 + lane] = xv; dst[256 + lane] = -kkv; dst[320 + lane] = kkv * av;
    g_out = R.lg; bonus_out = bon;
}
DI float scan_step(float (&S)[64], const float* sv, float vi) {
    const f32x4* r4 = (const f32x4*)sv; const f32x4* w4 = (const f32x4*)(sv + 64); const f32x4* k4 = (const f32x4*)(sv + 128);
    const f32x4* a4 = (const f32x4*)(sv + 256); const f32x4* b4 = (const f32x4*)(sv + 320);
    float sa0 = 0.f, sa1 = 0.f;
#pragma unroll
    for (int j = 0; j < 16; ++j) { const f32x4 av = a4[j]; sa0 = fmaf(S[4 * j], av.x, sa0); sa1 = fmaf(S[4 * j + 1], av.y, sa1); sa0 = fmaf(S[4 * j + 2], av.z, sa0); sa1 = fmaf(S[4 * j + 3], av.w, sa1); }
    const float sa = sa0 + sa1;
    float y0 = 0.f, y1 = 0.f;
#pragma unroll
    for (int j = 0; j < 16; ++j) {
        const f32x4 bv = b4[j], kv = k4[j], wv = w4[j], rv = r4[j];
        float t;
        t = fmaf(vi, kv.x, sa * bv.x); S[4 * j] = fmaf(S[4 * j], wv.x, t); y0 = fmaf(S[4 * j], rv.x, y0);
        t = fmaf(vi, kv.y, sa * bv.y); S[4 * j + 1] = fmaf(S[4 * j + 1], wv.y, t); y1 = fmaf(S[4 * j + 1], rv.y, y1);
        t = fmaf(vi, kv.z, sa * bv.z); S[4 * j + 2] = fmaf(S[4 * j + 2], wv.z, t); y0 = fmaf(S[4 * j + 2], rv.z, y0);
        t = fmaf(vi, kv.w, sa * bv.w); S[4 * j + 3] = fmaf(S[4 * j + 3], wv.w, t); y1 = fmaf(S[4 * j + 3], rv.w, y1);
        if ((j & 3) == 3) asm volatile("" ::: "memory");
    }
    return y0 + y1;
}
DI void rwkv_post(const Args& a, float y, float g, float bonus, int m, int c) {
    const float mean = wave_sum(y) * (1.f / 64.f); const float d = y - mean; const float var = wave_sum(d * d) * (1.f / 64.f);
    const float yn = d * rsqrtf(var + 64e-5f) * a.in[I_LNW][c] + a.in[I_LNB][c];
    ((bf16_t*)(a.ws + WS_O))[(size_t)m * D + 1024 + c] = (bf16_t)bf_rne((yn + bonus) * g);
}

#define WG_BAR_LDS() do { asm volatile("s_waitcnt lgkmcnt(0)" ::: "memory"); __builtin_amdgcn_s_barrier(); asm volatile("" ::: "memory"); } while (0)
typedef float f32x2 __attribute__((ext_vector_type(2)));
DI f32x2 fma2(f32x2 a, f32x2 b, f32x2 c) { return __builtin_elementwise_fma(a, b, c); }
DI void scan_dot_a(const f32x2 (&Z)[32], const f32x2 (&P)[32], const float* sv, float& sz, float& sp) {
    const f32x4* a4 = (const f32x4*)(sv + 256);
    f32x2 saz = {0.f, 0.f}, sap = {0.f, 0.f};
#pragma unroll
    for (int j = 0; j < 16; ++j) { const f32x4 av = a4[j]; const f32x2 a0 = {av.x, av.y}, a1 = {av.z, av.w};
        saz = fma2(Z[2 * j], a0, saz); sap = fma2(P[2 * j], a0, sap); saz = fma2(Z[2 * j + 1], a1, saz); sap = fma2(P[2 * j + 1], a1, sap);
        if ((j & 7) == 7) asm volatile("" ::: "memory"); }
    sz = saz.x + saz.y; sp = sap.x + sap.y;
}
DI void scan_step3(f32x2 (&Z)[32], f32x2 (&P)[32], const float* sv, const float* svn, float vi, float& sz, float& sp, float& yz, float& yp) {
    const f32x4* r4 = (const f32x4*)sv; const f32x4* w4 = (const f32x4*)(sv + 64); const f32x4* k4 = (const f32x4*)(sv + 128);
    const f32x4* b4 = (const f32x4*)(sv + 320); const f32x4* an4 = (const f32x4*)(svn + 256);
    const f32x2 sz2 = {sz, sz}, sp2 = {sp, sp}, v2 = {vi, vi};
    f32x2 yz2 = {0.f, 0.f}, yp2 = {0.f, 0.f}, nz2 = {0.f, 0.f}, np2 = {0.f, 0.f};
    f32x4 buf[3][5];
#define S3_LD(g, j) do { buf[g][0] = b4[j]; buf[g][1] = k4[j]; buf[g][2] = w4[j]; buf[g][3] = r4[j]; buf[g][4] = an4[j]; asm volatile("" ::: "memory"); } while (0)
    S3_LD(0, 0); S3_LD(1, 1);
#pragma unroll
    for (int j = 0; j < 16; ++j) {
        if (j + 2 < 16) S3_LD((j + 2) % 3, j + 2);
        const f32x4 bv = buf[j % 3][0], kv = buf[j % 3][1], wv = buf[j % 3][2], rv = buf[j % 3][3], av = buf[j % 3][4];
        { const f32x2 b2 = {bv.x, bv.y}, k2 = {kv.x, kv.y}, w2 = {wv.x, wv.y}, r2 = {rv.x, rv.y}, a2 = {av.x, av.y};
          f32x2 tz = sz2 * b2; tz = fma2(v2, k2, tz); Z[2 * j] = fma2(Z[2 * j], w2, tz); yz2 = fma2(Z[2 * j], r2, yz2); nz2 = fma2(Z[2 * j], a2, nz2);
          const f32x2 tp = sp2 * b2; P[2 * j] = fma2(P[2 * j], w2, tp); yp2 = fma2(P[2 * j], r2, yp2); np2 = fma2(P[2 * j], a2, np2); }
        { const f32x2 b2 = {bv.z, bv.w}, k2 = {kv.z, kv.w}, w2 = {wv.z, wv.w}, r2 = {rv.z, rv.w}, a2 = {av.z, av.w};
          f32x2 tz = sz2 * b2; tz = fma2(v2, k2, tz); Z[2 * j + 1] = fma2(Z[2 * j + 1], w2, tz); yz2 = fma2(Z[2 * j + 1], r2, yz2); nz2 = fma2(Z[2 * j + 1], a2, nz2);
          const f32x2 tp = sp2 * b2; P[2 * j + 1] = fma2(P[2 * j + 1], w2, tp); yp2 = fma2(P[2 * j + 1], r2, yp2); np2 = fma2(P[2 * j + 1], a2, np2); }
        asm volatile("" ::: "memory");
    }
#undef S3_LD
    yz = yz2.x + yz2.y; yp = yp2.x + yp2.y; sz = nz2.x + nz2.y; sp = np2.x + np2.y;
}
DI void scan_pass1_unit(const Args& a, unsigned char* lds, int unit, int wave, int lane) {
    float* stg = (float*)lds;
    const int pp = wave & 3, pair = unit * 4 + pp, chain = pair / NS, seg = pair % NS, b = chain >> 4, h = chain & 15, c = h * 64 + lane;
    const int mbase = b * SEQ + seg * SEGL;
    constexpr int NB = SEGL / TB;
    if (wave < 4) {
        float* YL = (float*)(a.ws + WS_YL); float* QS = (float*)(a.ws + WS_QS); float* ZP = (float*)(a.ws + WS_ZP);
        f32x2 Z[32], P[32];
        int idl = lane; asm volatile("" : "+v"(idl));
#pragma unroll
        for (int j = 0; j < 32; ++j) { Z[j] = (f32x2){0.f, 0.f}; P[j] = (f32x2){idl == 2 * j ? 1.f : 0.f, idl == 2 * j + 1 ? 1.f : 0.f}; }
        WG_BAR_LDS();
        for (int blk = 0; blk < NB; ++blk) {
            const float* sb = stg + (((blk & 1) * 4 + pp) * TB) * 384;
            float sz, sp; scan_dot_a(Z, P, sb, sz, sp);
#pragma unroll 1
            for (int tt = 0; tt < TB; ++tt) {
                const float* sv = sb + tt * 384; const float* svn = sb + (tt + 1 < TB ? tt + 1 : tt) * 384;
                float yz, yp; scan_step3(Z, P, sv, svn, sv[192 + lane], sz, sp, yz, yp);
                const size_t o = (size_t)(mbase + blk * TB + tt) * 1024 + c;
                YL[o] = yz; QS[o] = yp;
            }
            WG_BAR_LDS();
        }
        float* zp = ZP + (size_t)pair * 2 * 4096 + lane * 64;
#pragma unroll
        for (int j = 0; j < 16; ++j) { *(f32x4*)(zp + 4 * j) = (f32x4){Z[2 * j].x, Z[2 * j].y, Z[2 * j + 1].x, Z[2 * j + 1].y};
                                       *(f32x4*)(zp + 4096 + 4 * j) = (f32x4){P[2 * j].x, P[2 * j].y, P[2 * j + 1].x, P[2 * j + 1].y}; }
    } else {
        const float* RW = (const float*)(a.ws + WS_RW); const bf16_t* Lb = (const bf16_t*)(a.ws + WS_L);
        bf16_t* GB = (bf16_t*)(a.ws + WS_GB);
        PrepParams Pm; prep_params(a, Pm, c);
        PrepRaw raw[TB];
#define P1_LOAD(blk_) do { _Pragma("unroll") for (int k = 0; k < TB; ++k) { const int m = mbase + (blk_) * TB + k; prep_load(raw[k], RW + (size_t)m * CSH, rw_prev_row(a, RW, m), Lb + (size_t)m * NLO, c); } } while (0)
#define P1_FINISH(blk_) do { _Pragma("unroll") for (int k = 0; k < TB; ++k) { const int m = mbase + (blk_) * TB + k; float g, bon; \
            prep_finish(raw[k], Pm, stg + ((((blk_) & 1) * 4 + pp) * TB + k) * 384, g, bon, lane); \
            GB[((size_t)m * 16 + h) * 128 + lane] = (bf16_t)bf_rne(g); GB[((size_t)m * 16 + h) * 128 + 64 + lane] = (bf16_t)bf_rne(bon); } } while (0)
        P1_LOAD(0); P1_FINISH(0); P1_LOAD(1);
        WG_BAR_LDS();
        for (int blk = 0; blk < NB; ++blk) {
            if (blk + 1 < NB) P1_FINISH(blk + 1);
            if (blk + 2 < NB) P1_LOAD(blk + 2);
            WG_BAR_LDS();
        }
#undef P1_LOAD
#undef P1_FINISH
    }
}
DI void scan_sample_unit(const Args& a, unsigned char* lds, int unit, int wave, int lane) {
    float* sv = (float*)(lds + 2 * 4 * TB * 384 * 4) + wave * 384;
    const float* RW = (const float*)(a.ws + WS_RW); const bf16_t* Lb = (const bf16_t*)(a.ws + WS_L);
    const int b = unit >> 4, h = unit & 15, c = h * 64 + lane, m = MP + b;
    PrepParams P; prep_params(a, P, c);
    PrepRaw raw; prep_load(raw, RW + (size_t)m * CSH, rw_prev_row(a, RW, m), Lb + (size_t)m * NLO, c);
    float g, bon; prep_finish(raw, P, sv, g, bon, lane);
    float S[64];
    const float* s0 = a.in[I_SWKV] + ((size_t)(b * 16 + h) * 64 + lane) * 64;
#pragma unroll
    for (int j = 0; j < 16; ++j) { const f32x4 v = *(const f32x4*)(s0 + 4 * j); S[4 * j] = v.x; S[4 * j + 1] = v.y; S[4 * j + 2] = v.z; S[4 * j + 3] = v.w; }
    const float y = scan_step(S, sv, sv[192 + lane]);
    float* so = a.out + O_SWKV + ((size_t)(b * 16 + h) * 64 + lane) * 64;
#pragma unroll
    for (int j = 0; j < 16; ++j) *(f32x4*)(so + 4 * j) = (f32x4){S[4 * j], S[4 * j + 1], S[4 * j + 2], S[4 * j + 3]};
    rwkv_post(a, y, g, bon, m, c);
}
DI void scan_pass2_unit(const Args& a, unsigned char* lds, int chain, int wave, int lane) {
    float* Ssh = (float*)lds;
    float* Psh = Ssh + 64 * 65;
    const float* ZP = (const float*)(a.ws + WS_ZP); float* SST = (float*)(a.ws + WS_SST);
    const int i = lane, j0 = wave * 8, tid = wave * 64 + lane;
    float Sr[8];
#pragma unroll
    for (int k = 0; k < 8; ++k) Sr[k] = 0.f;
    const float* Z0 = ZP + (size_t)(chain * NS) * 2 * 4096;
    f32x4 pn0 = *(const f32x4*)(Z0 + 4096 + tid * 8), pn1 = *(const f32x4*)(Z0 + 4096 + tid * 8 + 4);
    f32x4 zn0 = *(const f32x4*)(Z0 + i * 64 + j0), zn1 = *(const f32x4*)(Z0 + i * 64 + j0 + 4);
    for (int s = 0; s < NS; ++s) {
        float* sst = SST + ((size_t)chain * NS + s) * 4096 + i * 64 + j0;
        *(f32x4*)sst = (f32x4){Sr[0], Sr[1], Sr[2], Sr[3]}; *(f32x4*)(sst + 4) = (f32x4){Sr[4], Sr[5], Sr[6], Sr[7]};
#pragma unroll
        for (int k = 0; k < 8; ++k) Ssh[i * 65 + j0 + k] = Sr[k];
        *(f32x4*)(Psh + tid * 8) = pn0; *(f32x4*)(Psh + tid * 8 + 4) = pn1;
        float nw[8] = {zn0.x, zn0.y, zn0.z, zn0.w, zn1.x, zn1.y, zn1.z, zn1.w};
        if (s + 1 < NS) {
            const float* Zs = ZP + (size_t)(chain * NS + s + 1) * 2 * 4096;
            pn0 = *(const f32x4*)(Zs + 4096 + tid * 8); pn1 = *(const f32x4*)(Zs + 4096 + tid * 8 + 4);
            zn0 = *(const f32x4*)(Zs + i * 64 + j0); zn1 = *(const f32x4*)(Zs + i * 64 + j0 + 4);
        }
        WG_BAR_LDS();
        if (s > 0) {
#pragma unroll 8
            for (int l = 0; l < 64; ++l) {
                const float sl = Ssh[i * 65 + l];
                const f32x4 p0 = *(const f32x4*)(Psh + l * 64 + j0), p1 = *(const f32x4*)(Psh + l * 64 + j0 + 4);
                nw[0] = fmaf(sl, p0.x, nw[0]); nw[1] = fmaf(sl, p0.y, nw[1]); nw[2] = fmaf(sl, p0.z, nw[2]); nw[3] = fmaf(sl, p0.w, nw[3]);
                nw[4] = fmaf(sl, p1.x, nw[4]); nw[5] = fmaf(sl, p1.y, nw[5]); nw[6] = fmaf(sl, p1.z, nw[6]); nw[7] = fmaf(sl, p1.w, nw[7]);
            }
        }
        WG_BAR_LDS();
#pragma unroll
        for (int k = 0; k < 8; ++k) Sr[k] = nw[k];
    }
    float* so = a.out + O_PWKV + (size_t)chain * 4096 + i * 64 + j0;
    *(f32x4*)so = (f32x4){Sr[0], Sr[1], Sr[2], Sr[3]}; *(f32x4*)(so + 4) = (f32x4){Sr[4], Sr[5], Sr[6], Sr[7]};
}
DI bf16x8 cvt8(const f32x4 lo, const f32x4 hi) { u32x4 p; p.x = pk2(lo.x, lo.y); p.y = pk2(lo.z, lo.w); p.z = pk2(hi.x, hi.y); p.w = pk2(hi.z, hi.w); return __builtin_bit_cast(bf16x8, p); }
DI void scan_pass3_unit(const Args& a, int unit, int lane) {
    const float* SST = (const float*)(a.ws + WS_SST); const float* YL = (const float*)(a.ws + WS_YL); const float* QS = (const float*)(a.ws + WS_QS); const bf16_t* GB = (const bf16_t*)(a.ws + WS_GB);
    bf16_t* O = (bf16_t*)(a.ws + WS_O);
    const int sub = unit & 3, pair = unit >> 2, chain = pair / NS, seg = pair % NS, b = chain >> 4, h = chain & 15;
    const int r = lane & 31, hh = lane >> 5;
    const int m = b * SEQ + seg * SEGL + sub * 32 + r;
    f32x16 acc0, acc1;
#pragma unroll
    for (int i = 0; i < 16; ++i) { acc0[i] = 0.f; acc1[i] = 0.f; }
    const float* qrow = QS + (size_t)m * 1024 + h * 64 + 8 * hh;
    const float* s0 = SST + (size_t)pair * 4096 + (size_t)r * 64 + 8 * hh; const float* s1 = s0 + 32 * 64;
#pragma unroll
    for (int ks = 0; ks < 4; ++ks) {
        const bf16x8 qf = cvt8(*(const f32x4*)(qrow + ks * 16), *(const f32x4*)(qrow + ks * 16 + 4));
        const bf16x8 a0 = cvt8(*(const f32x4*)(s0 + ks * 16), *(const f32x4*)(s0 + ks * 16 + 4));
        const bf16x8 a1 = cvt8(*(const f32x4*)(s1 + ks * 16), *(const f32x4*)(s1 + ks * 16 + 4));
        acc0 = __builtin_amdgcn_mfma_f32_32x32x16_bf16(a0, qf, acc0, 0, 0, 0);
        acc1 = __builtin_amdgcn_mfma_f32_32x32x16_bf16(a1, qf, acc1, 0, 0, 0);
    }
    const float* yl = YL + (size_t)m * 1024 + h * 64 + 4 * hh;
    float y[32]; float sum = 0.f;
#pragma unroll
    for (int rt = 0; rt < 2; ++rt)
#pragma unroll
        for (int g = 0; g < 4; ++g) { const f32x4 v = *(const f32x4*)(yl + rt * 32 + 8 * g);
#pragma unroll
            for (int e = 0; e < 4; ++e) { const float yy = v[e] + (rt == 0 ? acc0[4 * g + e] : acc1[4 * g + e]); y[rt * 16 + 4 * g + e] = yy; sum += yy; } }
    sum += __shfl_xor(sum, 32);
    const float mean = sum * (1.f / 64.f);
    float vs = 0.f;
#pragma unroll
    for (int e = 0; e < 32; ++e) { y[e] -= mean; vs += y[e] * y[e]; }
    vs += __shfl_xor(vs, 32);
    const float rstd = rsqrtf(vs * (1.f / 64.f) + 64e-5f);
    const bf16_t* gb = GB + ((size_t)m * 16 + h) * 128 + 4 * hh;
    const float* lw = a.in[I_LNW] + h * 64 + 4 * hh; const float* lb = a.in[I_LNB] + h * 64 + 4 * hh;
    bf16_t* orow = O + (size_t)m * D + 1024 + h * 64 + 4 * hh;
#pragma unroll
    for (int rt = 0; rt < 2; ++rt)
#pragma unroll
        for (int g = 0; g < 4; ++g) {
            const int off = rt * 32 + 8 * g;
            const f32x4 w4 = *(const f32x4*)(lw + off), b4 = *(const f32x4*)(lb + off);
            const u32x2 gw = *(const u32x2*)(gb + off), bw = *(const u32x2*)(gb + 64 + off);
            const float gg[4] = {__uint_as_float(gw.x << 16), __uint_as_float(gw.x & 0xffff0000u), __uint_as_float(gw.y << 16), __uint_as_float(gw.y & 0xffff0000u)};
            const float bb[4] = {__uint_as_float(bw.x << 16), __uint_as_float(bw.x & 0xffff0000u), __uint_as_float(bw.y << 16), __uint_as_float(bw.y & 0xffff0000u)};
            float o[4];
#pragma unroll
            for (int e = 0; e < 4; ++e) o[e] = (y[rt * 16 + 4 * g + e] * rstd * w4[e] + b4[e] + bb[e]) * gg[e];
            u32x2 w; w.x = pk2(o[0], o[1]); w.y = pk2(o[2], o[3]);
            *(u32x2*)(orow + off) = w;
        }
}

DI void unpack8(const u32x4 w, float (&u)[8]) {
    u[0] = __uint_as_float(w.x << 16); u[1] = __uint_as_float(w.x & 0xffff0000u); u[2] = __uint_as_float(w.y << 16); u[3] = __uint_as_float(w.y & 0xffff0000u);
    u[4] = __uint_as_float(w.z << 16); u[5] = __uint_as_float(w.z & 0xffff0000u); u[6] = __uint_as_float(w.w << 16); u[7] = __uint_as_float(w.w & 0xffff0000u);
}
constexpr int CONV_R = 45, CONV_CH = (MT + CONV_R - 1) / CONV_R;
DI void conv_strip(const Args& a, int idx) {
    const int fg = idx % (FF / 8), chunk = idx / (FF / 8), f = fg * 8;
    const bf16_t* U = (const bf16_t*)(a.ws + WS_U); bf16_t* ACT = (bf16_t*)(a.ws + WS_ACT);
    const float* cw = a.in[I_FCW]; const float* cb = a.in[I_FCB];
    float w0[2][8], w1[2][8], w2[2][8], bb[2][8];
#pragma unroll
    for (int p = 0; p < 2; ++p)
#pragma unroll
        for (int j = 0; j < 8; ++j) { const int col = p * FF + f + j; w0[p][j] = cw[col]; w1[p][j] = cw[FF2 + col]; w2[p][j] = cw[2 * FF2 + col]; bb[p][j] = cb[col]; }
    const int m0 = chunk * CONV_R, m1 = m0 + CONV_R < MT ? m0 + CONV_R : MT;
    float u1[2][8], u2[2][8];
#pragma unroll
    for (int p = 0; p < 2; ++p) {
        u32x4 x1 = {0u, 0u, 0u, 0u}, x2 = {0u, 0u, 0u, 0u};
        if (m0 >= 1) x1 = *(const u32x4*)(U + (size_t)(m0 - 1) * FF2 + p * FF + f);
        if (m0 >= 2) x2 = *(const u32x4*)(U + (size_t)(m0 - 2) * FF2 + p * FF + f);
        unpack8(x1, u1[p]); unpack8(x2, u2[p]);
    }
#pragma unroll 3
    for (int m = m0; m < m1; ++m) {
        float u0[2][8];
#pragma unroll
        for (int p = 0; p < 2; ++p) unpack8(*(const u32x4*)(U + (size_t)m * FF2 + p * FF + f), u0[p]);
        if (m < MP) {
            const int t = m & (SEQ - 1);
            if (t < 2) {
#pragma unroll
                for (int p = 0; p < 2; ++p)
#pragma unroll
                    for (int j = 0; j < 8; ++j) { u2[p][j] = 0.f; if (t == 0) u1[p][j] = 0.f; }
            }
        } else {
#pragma unroll
            for (int p = 0; p < 2; ++p) {
                const float* st = a.in[I_SFFN] + (size_t)(m - MP) * 2 * FF2 + p * FF + f;
                float* so = a.out + O_SFFN + (size_t)(m - MP) * 2 * FF2 + p * FF + f;
#pragma unroll
                for (int j = 0; j < 8; ++j) { u2[p][j] = st[j]; u1[p][j] = st[FF2 + j]; so[j] = u1[p][j]; }
            }
        }
        float o[8];
#pragma unroll
        for (int j = 0; j < 8; ++j) {
            const float gt = bb[0][j] + w0[0][j] * u2[0][j] + w1[0][j] * u1[0][j] + w2[0][j] * u0[0][j];
            const float vl = bb[1][j] + w0[1][j] * u2[1][j] + w1[1][j] * u1[1][j] + w2[1][j] * u0[1][j];
            o[j] = gt * __builtin_amdgcn_rcpf(1.f + __expf(-gt)) * vl;
        }
        u32x4 w; w.x = pk2(o[0], o[1]); w.y = pk2(o[2], o[3]); w.z = pk2(o[4], o[5]); w.w = pk2(o[6], o[7]);
        *(u32x4*)(ACT + (size_t)m * FF + f) = w;
#pragma unroll
        for (int p = 0; p < 2; ++p)
#pragma unroll
            for (int j = 0; j < 8; ++j) { u2[p][j] = u1[p][j]; u1[p][j] = u0[p][j]; }
    }
}

#define XB_TMO      128
#define XB_XCNT(j)  (256  + 64 * (j))
#define XB_XSUB(j)  (1280 + 64 * (j))
#define XB_XGEN(j)  (2304 + 64 * (j))
#define XB_TOP      3328
#define XB_TOPGEN   3392
#define XCD_BAR_WORDS 3456
#define XB_SPIN_CAP (1u << 18)
DI unsigned xb_ld(unsigned* p)              { return __hip_atomic_load(p, __ATOMIC_RELAXED, __HIP_MEMORY_SCOPE_AGENT); }
DI unsigned xb_add(unsigned* p, unsigned v) { return __hip_atomic_fetch_add(p, v, __ATOMIC_RELAXED, __HIP_MEMORY_SCOPE_AGENT); }
DI unsigned xb_xcc_id() { return (unsigned)__builtin_amdgcn_s_getreg((3 << 11) | 20) & 0xFu; }
#define XB_SPIN(cond, bar) do { unsigned _sp = 0; while (cond) { __builtin_amdgcn_s_sleep(1); \
    if ((++_sp & 255u) == 0u) { if (xb_ld(&(bar)[XB_TMO])) break; if (_sp > XB_SPIN_CAP) { atomicAdd(&(bar)[XB_TMO], 1u); break; } } } } while (0)
struct XcdBarrier { unsigned* bar; unsigned x; volatile LAS unsigned* st; };
DI XcdBarrier xcd_barrier_post(unsigned* bar, volatile LAS unsigned* st) {
    XcdBarrier b; b.bar = bar; b.x = xb_xcc_id(); b.st = st;
    if (threadIdx.x == 0) (void)xb_add(&bar[XB_XCNT(b.x)], 1u);
    return b;
}
DI void xcd_barrier_complete(unsigned* bar, unsigned x, unsigned& nloc, unsigned& nx) {
    const unsigned G = gridDim.x * gridDim.y * gridDim.z;
    unsigned sum, cnt, mine, sp = 0u;
    for (;;) {
        sum = 0u; cnt = 0u; mine = 0u;
#pragma unroll
        for (unsigned j = 0; j < 16; ++j) { const unsigned c = xb_ld(&bar[XB_XCNT(j)]); sum += c; cnt += (c > 0u) ? 1u : 0u; mine = (j == x) ? c : mine; }
        if (sum == G) break;
        __builtin_amdgcn_s_sleep(1);
        if ((++sp & 255u) == 0u) { if (xb_ld(&bar[XB_TMO])) break; if (sp > XB_SPIN_CAP) { atomicAdd(&bar[XB_TMO], 1u); break; } }
    }
    nloc = mine > 0u ? mine : 1u; nx = cnt > 0u ? cnt : 1u;
}
DI void xcd_barrier(const XcdBarrier& b) {
    asm volatile("s_waitcnt vmcnt(0)" ::: "memory");
    __syncthreads();
    if (threadIdx.x == 0) {
        unsigned* bar = b.bar;
        __builtin_amdgcn_s_waitcnt(0);
        unsigned nloc = b.st[0], nx = b.st[1];
        if (nloc == 0u) { xcd_barrier_complete(bar, b.x, nloc, nx); b.st[0] = nloc; b.st[1] = nx; }
        const unsigned old = xb_add(&bar[XB_XSUB(b.x)], 1u);
        const unsigned gen = old / nloc;
        if (old + 1u == (gen + 1u) * nloc) {
            __builtin_amdgcn_fence(__ATOMIC_RELEASE, "agent");
            asm volatile("s_waitcnt vmcnt(0)" ::: "memory");
            const unsigned og = xb_add(&bar[XB_TOP], 1u);
            const unsigned tg = og / nx;
            if (og + 1u == (tg + 1u) * nx) xb_add(&bar[XB_TOPGEN], 1u);
            else XB_SPIN(xb_ld(&bar[XB_TOPGEN]) == tg, bar);
            __builtin_amdgcn_fence(__ATOMIC_ACQUIRE, "agent");
            xb_add(&bar[XB_XGEN(b.x)], 1u);
            asm volatile("s_waitcnt vmcnt(0)" ::: "memory");
        } else {
            XB_SPIN(xb_ld(&bar[XB_XGEN(b.x)]) == gen, bar);
            __builtin_amdgcn_fence(__ATOMIC_ACQUIRE, "agent");
            asm volatile("s_waitcnt vmcnt(0)" ::: "memory");
        }
    }
    __syncthreads();
}

DI void skinny_unit(const bf16_t* A, int lda, const bf16_t* Bt, int K, int unit, const float* base, int ldb, float* out, int ldo, unsigned char* lds, int wave, int lane,
                    const float* gf = nullptr, bf16_t* H = nullptr, float* RSS = nullptr) {
    float* red = (float*)lds;
    const int n0 = unit * 32, r = lane & 31, hh = lane >> 5, kw = K / 8, kb = wave * kw;
    f32x16 acc;
#pragma unroll
    for (int i = 0; i < 16; ++i) acc[i] = 0.f;
    const bf16_t* ap = A + (size_t)r * lda + kb + 8 * hh; const bf16_t* bp = Bt + (size_t)(n0 + r) * K + kb + 8 * hh;
#pragma unroll 4
    for (int k = 0; k < kw; k += 16) {
        const bf16x8 af = *(const bf16x8*)(ap + k), bf = *(const bf16x8*)(bp + k);
        acc = __builtin_amdgcn_mfma_f32_32x32x16_bf16(af, bf, acc, 0, 0, 0);
    }
#pragma unroll
    for (int i = 0; i < 16; ++i) red[(wave * 16 + i) * 64 + lane] = acc[i];
    __syncthreads();
#pragma unroll
    for (int q = 0; q < 2; ++q) {
        const int o = threadIdx.x + 512 * q, i = o >> 6, ln = o & 63;
        float sum = 0.f;
#pragma unroll
        for (int w = 0; w < 8; ++w) sum += red[(w * 16 + i) * 64 + ln];
        const int row = crow(i, ln >> 5), col = n0 + (ln & 31);
        const float x1 = base[(size_t)row * ldb + col] + sum;
        out[(size_t)row * ldo + col] = x1;
        if (H) { H[(size_t)row * D + col] = (bf16_t)bf_rne(x1 * gf[col]);
            float ss = x1 * x1;
            ss += __shfl_xor(ss, 1); ss += __shfl_xor(ss, 2); ss += __shfl_xor(ss, 4); ss += __shfl_xor(ss, 8); ss += __shfl_xor(ss, 16);
            if ((ln & 31) == 0) atomic_add_f32(RSS + row, ss); }
    }
    __syncthreads();
}

constexpr int NPH = 14;
template <bool COOP>
__global__ void __launch_bounds__(NTHREADS, 2) mk_fwd(Args a) {
    extern __shared__ __attribute__((aligned(16))) unsigned char lds[];
    const int tid = threadIdx.x, lane = tid & 63, wave = __builtin_amdgcn_readfirstlane(tid >> 6);
    const int G = gridDim.x, bid = blockIdx.x, gw = bid * NWAVES + wave, ngw = G * NWAVES;
    unsigned char* ws = a.ws;
    LAS unsigned char* ldsl = (LAS unsigned char*)lds;
#ifndef PHMASK
#define PHMASK 0xffff
#endif
#define IN(k) (((PHMASK >> (k)) & 1) && a.ph_lo <= (k) && (k) < a.ph_hi)
    XcdBarrier xbar; xbar.bar = (unsigned*)(ws + WS_BAR); xbar.x = 0; xbar.st = nullptr;
    if (COOP) {
        volatile LAS unsigned* st = (volatile LAS unsigned*)(ldsl + LDS_BYTES - 16);
        if (tid < 4) st[tid] = 0u;
        __syncthreads();
        xbar = xcd_barrier_post((unsigned*)(ws + WS_BAR), st);
    }
#define SEAM(k) do { if (COOP && IN(k) && IN((k) + 1)) { if ((k) == 0) cg::this_grid().sync(); else xcd_barrier(xbar); } } while (0)

    if (IN(0)) phase_prologue(a, lds, gw, ngw, lane, wave);
    SEAM(0);
    if (IN(1)) {
        pg8::Gemm g{(const bf16_t*)(ws + WS_H), (const bf16_t*)(ws + WS_WIN), MPAD, NIN, D}; pg8::StaticOrder S; S.init(MPAD, NIN, G, bid);
        EpiIn E{(bf16_t*)(ws + WS_QB), (bf16_t*)(ws + WS_KB), (bf16_t*)(ws + WS_VB), (float*)(ws + WS_RW), a.out};
        pg8::gemm_phase<EpiIn>(ldsl, g, S, E);
        {
            const int nu = (MPAD / 256) * (NIN / 256), rem = nu % G, first = rem == 0 ? 0 : rem, nfree = G - first;
            if (bid >= first) convert_wo_wup(a, lds, (bid - first) * NWAVES + wave, nfree * NWAVES, wave, lane);
        }
    }
    SEAM(1);
    if (IN(2)) {
        for (int u = bid; u < 256; u += G) attn_sample_wg(a, lds, u, wave, lane);
        for (int u = gw; u < 64 * 3 * 64; u += ngw) attn_prompt_unit(a, lds, u, wave, lane);
        for (int m = gw; m < MPAD; m += ngw) lora_input_row(a, m, lane);
    }
    SEAM(2);
    if (IN(3)) {
        pg8::Gemm g{(const bf16_t*)(ws + WS_ALO), (const bf16_t*)(ws + WS_WLO), MPAD, NLO, KLO}; pg8::StaticOrder S; S.init(MPAD, NLO, G, bid);
        EpiBf E{(bf16_t*)(ws + WS_L), NLO};
        pg8::gemm_phase<EpiBf>(ldsl, g, S, E);
#pragma unroll 2
        for (int t = gw; t < MP * 4; t += ngw) attn_merge_task(a, t, lane);
    }
    SEAM(3);
    if (IN(4)) {
#ifndef NO_P1
        for (int u = bid; u < 64 * NS / 4; u += G) scan_pass1_unit(a, lds, u, wave, lane);
#endif

    }
    SEAM(4);
    if (IN(5)) {
        if (G >= 128) {
            if (bid < 64) scan_pass2_unit(a, lds, bid, wave, lane);
            else for (int u = (bid - 64) * NWAVES + wave; u < 512; u += (G - 64) * NWAVES) scan_sample_unit(a, lds, u, wave, lane);
        } else {
            for (int ch = bid; ch < 64; ch += G) scan_pass2_unit(a, lds, ch, wave, lane);
            for (int u = gw; u < 512; u += ngw) scan_sample_unit(a, lds, u, wave, lane);
        }
    }
    SEAM(5);
    if (IN(6)) { for (int u = gw; u < 64 * NS * 4; u += ngw) scan_pass3_unit(a, u, lane); }
    SEAM(6);
    if (IN(7)) {
        pg8::Gemm g{(const bf16_t*)(ws + WS_O), (const bf16_t*)(ws + WS_WO), MP, D, D}; pg8::StaticOrder S; S.init(MP, D, G, bid);
        EpiWo E{a.in[I_XP], a.in[I_NFG], (float*)(ws + WS_X1), (bf16_t*)(ws + WS_H), (float*)(ws + WS_RSS)};
        pg8::gemm_phase<EpiWo>(ldsl, g, S, E);
        for (int u = bid; u < D / 32; u += G)
            skinny_unit((const bf16_t*)(ws + WS_O) + (size_t)MP * D, D, (const bf16_t*)(ws + WS_WO), D, u, a.in[I_XS], D, (float*)(ws + WS_X1) + (size_t)MP * D, D, lds, wave, lane,
                        a.in[I_NFG], (bf16_t*)(ws + WS_H) + (size_t)MP * D, (float*)(ws + WS_RSS) + MP);
    }
    SEAM(7);
    if (IN(9)) {
        pg8::Gemm g{(const bf16_t*)(ws + WS_H), (const bf16_t*)(ws + WS_WUP), MPAD, FF2, D}; pg8::StaticOrder S; S.init(MPAD, FF2, G, bid);
        EpiUp E{(bf16_t*)(ws + WS_U), a.out, (const float*)(ws + WS_RSS)};
        pg8::gemm_phase<EpiUp>(ldsl, g, S, E);
        {
            const int nu = (MPAD / 256) * (FF2 / 256), rem = nu % G, first = rem == 0 ? 0 : rem, nfree = G - first;
            if (bid >= first) convert_wdn(a, lds, (bid - first) * NWAVES + wave, nfree * NWAVES, wave, lane);
        }
    }
    SEAM(9);
    if (IN(10)) { for (int it = bid * NTHREADS + tid; it < CONV_CH * (FF / 8); it += G * NTHREADS) conv_strip(a, it); }
    SEAM(10);
    if (IN(11)) {
        pg8::Gemm g{(const bf16_t*)(ws + WS_ACT), (const bf16_t*)(ws + WS_WDN), MP, D, FF}; pg8::StaticOrder S; S.init(MP, D, G, bid);
        EpiDn E{(float*)(ws + WS_X1)};
        pg8::gemm_phase<EpiDn>(ldsl, g, S, E);
        for (int u = bid; u < D / 32; u += G)
            skinny_unit((const bf16_t*)(ws + WS_ACT) + (size_t)MP * FF, FF, (const bf16_t*)(ws + WS_WDN), FF, u, (const float*)(ws + WS_X1) + (size_t)MP * D, D, (float*)(ws + WS_X1) + (size_t)MP * D, D, lds, wave, lane);
    }
    SEAM(11);
    if (IN(12)) {
        for (int m = gw; m < MT; m += ngw)
            rms_row_f32((const float*)(ws + WS_X1) + (size_t)m * D, a.in[I_NFIN], m < MP ? a.out + O_YP + (size_t)m * D : a.out + O_YS + (size_t)(m - MP) * D, lane);
    }
#undef IN
#undef SEAM
}

#ifndef MK_ONE_LAUNCH
#define MK_ONE_LAUNCH 1
#endif
#ifndef MK_DBL_MASK
#define MK_DBL_MASK 0x0
#endif

extern "C" void kernel_launch(void* const* d_in, const int* in_sizes, int n_in, void* d_out, int out_size, void* d_ws, size_t ws_size, hipStream_t stream) {
    static int grid = 0;
    if (!grid) {
        if (n_in != 28 || (size_t)out_size != O_END || ws_size < WS_END) fprintf(stderr, "kernel_launch: unexpected shapes: n_in %d out %d (want %zu) ws %zu (want %zu)\n", n_in, out_size, O_END, ws_size, WS_END);
        int dev = 0, cus = 0; hipGetDevice(&dev); hipDeviceGetAttribute(&cus, hipDeviceAttributeMultiprocessorCount, dev);
        hipFuncSetAttribute((const void*)mk_fwd<true>, hipFuncAttributeMaxDynamicSharedMemorySize, LDS_BYTES);
        hipFuncSetAttribute((const void*)mk_fwd<false>, hipFuncAttributeMaxDynamicSharedMemorySize, LDS_BYTES);
        int per_cu = 0; hipOccupancyMaxActiveBlocksPerMultiprocessor(&per_cu, mk_fwd<true>, NTHREADS, LDS_BYTES);
        if (per_cu < 1) { fprintf(stderr, "kernel_launch: occupancy query says %d blocks/CU\n", per_cu); per_cu = 1; }
        grid = cus > 0 ? cus : 256;
    }
    Args a; memset(&a, 0, sizeof(a));
    for (int i = 0; i < 28; ++i) a.in[i] = (const float*)d_in[i];
    a.out = (float*)d_out; a.ws = (unsigned char*)d_ws;
#if MK_ONE_LAUNCH
    if (hipMemsetAsync((char*)d_ws + WS_BAR, 0, BAR_BYTES, stream) != hipSuccess) { fprintf(stderr, "kernel_launch: memset of the barrier words failed\n"); return; }
    a.ph_lo = 0; a.ph_hi = NPH;
    void* args[] = {&a};
    hipError_t e = hipLaunchCooperativeKernel((const void*)mk_fwd<true>, dim3(grid), dim3(NTHREADS), args, LDS_BYTES, stream);
    if (e != hipSuccess) fprintf(stderr, "cooperative launch failed: %s (grid %d)\n", hipGetErrorString(e), grid);
#else
    for (int p = 0; p < 13; ++p) {
        a.ph_lo = p; a.ph_hi = p + 1;
        mk_fwd<false><<<dim3(grid), dim3(NTHREADS), LDS_BYTES, stream>>>(a);
        if ((MK_DBL_MASK >> p) & 1) mk_fwd<false><<<dim3(grid), dim3(NTHREADS), LDS_BYTES, stream>>>(a);
    }
#endif
}
```

```cpp
#include <hip/hip_runtime.h>
#include <hip/hip_cooperative_groups.h>
#include <cstdio>
#include <cstdint>
#include <cstring>
namespace cg = cooperative_groups;

#define DI __device__ __forceinline__
#define LAS __attribute__((address_space(3)))
typedef unsigned short bf16_t;
typedef short bf16x8 __attribute__((ext_vector_type(8)));
typedef float f32x4 __attribute__((ext_vector_type(4)));
typedef float f32x16 __attribute__((ext_vector_type(16)));
typedef unsigned u32x4 __attribute__((ext_vector_type(4)));
typedef unsigned u32x2 __attribute__((ext_vector_type(2)));

constexpr int D = 2048, MP = 8192, MS = 32, MT = 8224, MPAD = 8448, SEQ = 2048;
constexpr int CIN = 6432, NIN = 6656, CSH = 3360, FF2 = 11264, FF = 5632;
constexpr int NLO = 3072, KLO = 384;
constexpr int NS = 16, SEGL = 128, TB = 8;
constexpr int NTHREADS = 512, NWAVES = 8;
constexpr int LDS_BYTES = 131072 + 16384;

constexpr size_t O_YP = 0;
constexpr size_t O_YS = O_YP + (size_t)MP * D;
constexpr size_t O_PK = O_YS + (size_t)MS * D;
constexpr size_t O_PV = O_PK + (size_t)MP * 1024;
constexpr size_t O_PRW = O_PV + (size_t)MP * 1024;
constexpr size_t O_PWKV = O_PRW + (size_t)4 * CSH;
constexpr size_t O_PFFN = O_PWKV + (size_t)4 * 16 * 4096;
constexpr size_t O_SK = O_PFFN + (size_t)4 * 2 * FF2;
constexpr size_t O_SV = O_SK + (size_t)MS * 1024;
constexpr size_t O_SRW = O_SV + (size_t)MS * 1024;
constexpr size_t O_SWKV = O_SRW + (size_t)MS * CSH;
constexpr size_t O_SFFN = O_SWKV + (size_t)MS * 16 * 4096;
constexpr size_t O_END = O_SFFN + (size_t)MS * 2 * FF2;

constexpr size_t al256(size_t x) { return (x + 255) & ~(size_t)255; }
constexpr size_t WS_WIN = 0;
constexpr size_t WS_WO = WS_WIN + al256((size_t)NIN * D * 2);
constexpr size_t WS_WUP = WS_WO + al256((size_t)D * D * 2);
constexpr size_t WS_WDN = WS_WUP + al256((size_t)FF2 * D * 2);
constexpr size_t WS_WLO = WS_WDN + al256((size_t)D * FF * 2);
constexpr size_t WS_H = WS_WLO + al256((size_t)NLO * KLO * 2);
constexpr size_t WS_QB = WS_H + al256((size_t)MPAD * D * 2);
constexpr size_t WS_KB = WS_QB + al256((size_t)MPAD * 1024 * 2);
constexpr size_t WS_VB = WS_KB + al256((size_t)MPAD * 1024 * 2);
constexpr size_t WS_ALO = WS_VB + al256((size_t)MPAD * 1024 * 2);
constexpr size_t WS_O = WS_ALO + al256((size_t)MPAD * KLO * 2);
constexpr size_t WS_GB = WS_O + al256((size_t)MPAD * D * 2);
constexpr size_t WS_YL = WS_GB + al256((size_t)MT * 2048 * 2);
constexpr size_t WS_QS = WS_YL + al256((size_t)MP * 1024 * 2);
constexpr size_t WS_ZP = WS_QS + al256((size_t)MP * 1024 * 2);
constexpr size_t WS_SST = WS_ZP + al256((size_t)64 * NS * 2 * 4096 * 4);
constexpr size_t WS_X1 = WS_SST + al256((size_t)64 * NS * 4096 * 4);
constexpr size_t WS_PML = WS_X1 + al256((size_t)MPAD * D * 4);
constexpr size_t WS_RA = WS_PML + al256((size_t)3 * MP * 16 * 2 * 4);
constexpr size_t WS_RW = WS_RA;
constexpr size_t WS_L = WS_RW + al256((size_t)MPAD * CSH * 2);
constexpr size_t RA_BYTES_1 = al256((size_t)MPAD * CSH * 2) + al256((size_t)MPAD * NLO * 2);
constexpr size_t RA_BYTES_2 = al256((size_t)MPAD * FF2 * 2);
constexpr size_t WS_U = WS_RA;
constexpr size_t WS_RB = WS_RA + (RA_BYTES_1 > RA_BYTES_2 ? RA_BYTES_1 : RA_BYTES_2);
constexpr size_t WS_PART = WS_RB;
constexpr size_t WS_ACT = WS_RB;
constexpr size_t RB_BYTES_1 = al256((size_t)3 * MP * 1024 * 2);
constexpr size_t RB_BYTES_2 = al256((size_t)MPAD * FF * 2);
constexpr size_t WS_RSS = WS_RB + (RB_BYTES_1 > RB_BYTES_2 ? RB_BYTES_1 : RB_BYTES_2);
constexpr size_t WS_BAR_ = 0; constexpr size_t WS_BAR = al256((size_t)MPAD * 4) + WS_RB + (RB_BYTES_1 > RB_BYTES_2 ? RB_BYTES_1 : RB_BYTES_2);
constexpr size_t BAR_BYTES = 16384;
constexpr size_t WS_END = WS_BAR + BAR_BYTES;

struct Args {
    const float* in[28];
    float* out;
    unsigned char* ws;
    int ph_lo, ph_hi;
};
enum { I_XP = 0, I_XS, I_CK, I_CV, I_SSH, I_SWKV, I_SFFN, I_NMG, I_WIN, I_AOG, I_MU, I_W0, I_WUP, I_A0, I_AUP, I_GUP,
       I_KK, I_KA, I_RK, I_LNW, I_LNB, I_WO, I_NFG, I_FUP, I_FCW, I_FCB, I_FDN, I_NFIN };

typedef float f32x2c __attribute__((ext_vector_type(2)));
typedef __bf16 bf16x2c __attribute__((ext_vector_type(2)));
DI unsigned pk2(float lo, float hi) { const f32x2c v = {lo, hi}; return __builtin_bit_cast(unsigned, __builtin_convertvector(v, bf16x2c)); }
DI unsigned bf_rne(float f) { return pk2(f, 0.f) & 0xffffu; }
DI unsigned cvt_pk(float lo, float hi) { return pk2(lo, hi); }
DI void atomic_add_f32(float* p, float v) { (void)__builtin_amdgcn_global_atomic_fadd_f32((__attribute__((address_space(1))) float*)p, v); }
DI float bf2f(unsigned short b) { return __uint_as_float(((unsigned)b) << 16); }
#define DPP_ADD(v, ctrl) ((v) + __int_as_float(__builtin_amdgcn_update_dpp(0, __float_as_int(v), (ctrl), 0xf, 0xf, false)))
DI float wave_sum(float v) {
    v = DPP_ADD(v, 0xB1);
    v = DPP_ADD(v, 0x4E);
    v = DPP_ADD(v, 0x141);
    v = DPP_ADD(v, 0x140);
    const float s0 = __int_as_float(__builtin_amdgcn_readlane(__float_as_int(v), 0)), s1 = __int_as_float(__builtin_amdgcn_readlane(__float_as_int(v), 16));
    const float s2 = __int_as_float(__builtin_amdgcn_readlane(__float_as_int(v), 32)), s3 = __int_as_float(__builtin_amdgcn_readlane(__float_as_int(v), 48));
    return (s0 + s1) + (s2 + s3);
}

namespace pg8 {
constexpr int BM = 256, BK = 64, HALF = 128, HTB = HALF * BK * 2, STAGE_BYTES = 8 * HTB, NXCD = 8, WGM = 8;
DI int lds_byte(int r, int c) { const int st = (r >> 4) * 2 + (c >> 5), rr = r & 15, cc = c & 31, ob = rr * 64 + cc * 2; return st * 1024 + (ob ^ (((ob >> 9) & 1) << 5)); }
DI void stage_rc(int b, int& R, int& C) { const int st = b / 1024, sb = b % 1024, swz = sb ^ (((sb >> 9) & 1) << 5); R = (st >> 1) * 16 + swz / 64; C = (st & 1) * 32 + (swz % 64) / 2; }
struct Unit { int pm, pn; };
struct Gemm { const bf16_t* A; const bf16_t* Bt; int M, N, K; };
struct StaticOrder {
    int nM, nN, nwg, G, c;
    DI void init(int M, int N, int G_, int c_) { nM = M / BM; nN = N / BM; nwg = nM * nN; G = G_; c = c_; }
    DI bool next(int i, Unit& u) const {
        const long L = (long)i * G + c; if (L >= nwg) return false;
        int wgid = (int)L; { const int q = nwg / NXCD, r = nwg % NXCD, xcd = wgid % NXCD, off = wgid / NXCD; wgid = (xcd < r ? xcd * (q + 1) : r * (q + 1) + (xcd - r) * q) + off; }
        const int nig = WGM * nN, gid = wgid / nig, fm = gid * WGM, gsz = (nM - fm) < WGM ? (nM - fm) : WGM;
        u.pm = fm + ((wgid % nig) % gsz); u.pn = (wgid % nig) / gsz; return true;
    }
};

template <class Epi>
DI void gemm_phase(LAS unsigned char* lds, const Gemm g, const StaticOrder& S, const Epi& E) {
    const int tid = threadIdx.x, wid = __builtin_amdgcn_readfirstlane(tid >> 6), lane = tid & 63, wr = wid >> 2, wc = wid & 3, fr = lane & 15, fq = lane >> 4;
    const int K = g.K, nt = K / BK;
    unsigned voffA[2];
#pragma unroll
    for (int i = 0; i < 2; ++i) { int R, C; stage_rc(tid * 16 + i * 8192, R, C); voffA[i] = (unsigned)(R * K + C) * 2u; }
    const size_t kstep = (size_t)(BK * 2);
    const size_t hstep = (size_t)HALF * K * 2;
    const size_t tstep = 2 * hstep;
    const unsigned ldsw = (unsigned)wid * 1024u;
    const int aoff = lds_byte(wr * 64 + fr, fq * 8), boff = lds_byte(wc * 32 + fr, fq * 8);
#define PG8_SA(b, h) (((b) * 2 + (h)) * HTB)
#define PG8_SB(b, h) ((4 + (b) * 2 + (h)) * HTB)
#define PG8_STAGE(bufoff, gbase, voff) do { _Pragma("unroll") for (int _i = 0; _i < 2; ++_i) \
        __builtin_amdgcn_global_load_lds((const unsigned*)((const char*)(gbase) + (voff)[_i]), (LAS unsigned*)(lds + (bufoff) + ldsw + _i * 8192), 16, 0, 0); } while (0)
#define PG8_LDA(dst, b, h) do { _Pragma("unroll") for (int m = 0; m < 4; ++m) _Pragma("unroll") for (int k = 0; k < 2; ++k) dst[m][k] = *(const LAS bf16x8*)(lds + PG8_SA(b, h) + aoff + m * 2048 + k * 1024); } while (0)
#define PG8_LDB(dst, b, h) do { _Pragma("unroll") for (int n = 0; n < 2; ++n) _Pragma("unroll") for (int k = 0; k < 2; ++k) dst[n][k] = *(const LAS bf16x8*)(lds + PG8_SB(b, h) + boff + n * 2048 + k * 1024); } while (0)
#define PG8_MMA(ai, bj, At, Bt) do { __builtin_amdgcn_s_setprio(1); _Pragma("unroll") for (int m = 0; m < 4; ++m) _Pragma("unroll") for (int n = 0; n < 2; ++n) _Pragma("unroll") for (int k = 0; k < 2; ++k) \
        acc[ai][bj][m][n] = __builtin_amdgcn_mfma_f32_16x16x32_bf16(Bt[n][k], At[m][k], acc[ai][bj][m][n], 0, 0, 0); __builtin_amdgcn_s_setprio(0); } while (0)
#define PG8_WAIT_V(n) asm volatile("s_waitcnt vmcnt(" #n ")" ::: "memory")
#define PG8_WAIT_L(n) asm volatile("s_waitcnt lgkmcnt(" #n ")" ::: "memory")
#define PG8_BAR __builtin_amdgcn_s_barrier()
#define PG8_SCHED __builtin_amdgcn_sched_barrier(0)
    Unit cur, nxt; int ui = 0;
    if (!S.next(0, cur)) return;
    f32x4 acc[2][2][4][2];
#pragma unroll
    for (int a = 0; a < 2; ++a)
#pragma unroll
        for (int b = 0; b < 2; ++b)
#pragma unroll
            for (int m = 0; m < 4; ++m)
#pragma unroll
                for (int n = 0; n < 2; ++n) acc[a][b][m][n] = (f32x4){0.f, 0.f, 0.f, 0.f};
    bf16x8 At[4][2], B0[2][2], B1[2][2];
    const char* cA = (const char*)g.A + (size_t)cur.pm * tstep; const char* cB = (const char*)g.Bt + (size_t)cur.pn * tstep;
    PG8_STAGE(PG8_SB(0, 0), cB, voffA); PG8_STAGE(PG8_SA(0, 0), cA, voffA); PG8_STAGE(PG8_SB(0, 1), cB + hstep, voffA); PG8_STAGE(PG8_SA(0, 1), cA + hstep, voffA);
    if (wr == 1) PG8_BAR;
    PG8_WAIT_V(4); PG8_BAR;
    PG8_STAGE(PG8_SB(1, 0), cB + kstep, voffA); PG8_STAGE(PG8_SA(1, 0), cA + kstep, voffA); PG8_STAGE(PG8_SB(1, 1), cB + hstep + kstep, voffA);
    PG8_WAIT_V(6); PG8_BAR;
    for (;;) {
        const bool has_next = S.next(ui + 1, nxt);
        const char* nA = has_next ? (const char*)g.A + (size_t)nxt.pm * tstep : cA; const char* nB = has_next ? (const char*)g.Bt + (size_t)nxt.pn * tstep : cB;
        for (int t = 0; t < nt; t += 2) {
            const bool last = (t == nt - 2);
            const char* a1 = cA + (size_t)(t + 1) * kstep;
            const char* a2 = last ? nA : cA + (size_t)(t + 2) * kstep; const char* b2 = last ? nB : cB + (size_t)(t + 2) * kstep;
            const char* a3 = a2 + kstep; const char* b3 = b2 + kstep;
            PG8_LDB(B0, 0, 0); PG8_SCHED; PG8_LDA(At, 0, 0); PG8_STAGE(PG8_SA(1, 1), a1 + hstep, voffA);
            PG8_WAIT_L(8); PG8_BAR; PG8_WAIT_L(0); PG8_MMA(0, 0, At, B0); PG8_BAR; PG8_SCHED;
            PG8_LDB(B1, 0, 1); PG8_STAGE(PG8_SB(0, 0), b2, voffA);
            PG8_BAR; PG8_WAIT_L(0); PG8_MMA(0, 1, At, B1); PG8_BAR;
            PG8_LDA(At, 0, 1); PG8_STAGE(PG8_SA(0, 0), a2, voffA);
            PG8_BAR; PG8_WAIT_L(0); PG8_MMA(1, 0, At, B0); PG8_BAR; PG8_SCHED;
            PG8_STAGE(PG8_SB(0, 1), b2 + hstep, voffA);
            PG8_WAIT_V(6); PG8_BAR; PG8_MMA(1, 1, At, B1); PG8_BAR;
            PG8_LDB(B0, 1, 0); PG8_SCHED; PG8_LDA(At, 1, 0); PG8_STAGE(PG8_SA(0, 1), a2 + hstep, voffA);
            PG8_WAIT_L(8); PG8_BAR; PG8_WAIT_L(0); PG8_MMA(0, 0, At, B0); PG8_BAR; PG8_SCHED;
            PG8_LDB(B1, 1, 1); PG8_STAGE(PG8_SB(1, 0), b3, voffA);
            PG8_BAR; PG8_WAIT_L(0); PG8_MMA(0, 1, At, B1); PG8_BAR;
            PG8_LDA(At, 1, 1); PG8_STAGE(PG8_SA(1, 0), a3, voffA);
            PG8_BAR; PG8_WAIT_L(0); PG8_MMA(1, 0, At, B0); PG8_BAR; PG8_SCHED;
            PG8_STAGE(PG8_SB(1, 1), b3 + hstep, voffA);
            PG8_WAIT_V(6); PG8_BAR; PG8_MMA(1, 1, At, B1); PG8_BAR;
        }
        E(acc, cur, wr, wc, fr, fq);
        if (!has_next) break;
#pragma unroll
        for (int a = 0; a < 2; ++a)
#pragma unroll
            for (int b = 0; b < 2; ++b)
#pragma unroll
                for (int m = 0; m < 4; ++m)
#pragma unroll
                    for (int n = 0; n < 2; ++n) acc[a][b][m][n] = (f32x4){0.f, 0.f, 0.f, 0.f};
        cur = nxt; cA = nA; cB = nB; ++ui;
    }
    PG8_WAIT_V(0);
    if (wr == 0) PG8_BAR;
    PG8_BAR;
#undef PG8_SA
#undef PG8_SB
#undef PG8_STAGE
#undef PG8_LDA
#undef PG8_LDB
#undef PG8_MMA
#undef PG8_WAIT_V
#undef PG8_WAIT_L
#undef PG8_BAR
#undef PG8_SCHED
}
}

typedef f32x4 AccT[2][2][4][2];
#define EPI_LOOP_BEGIN \
    const int row0 = u.pm * 256 + wr * 64 + fr, col0 = u.pn * 256 + wc * 32 + 4 * fq; \
    _Pragma("unroll") for (int ai = 0; ai < 2; ++ai) _Pragma("unroll") for (int m = 0; m < 4; ++m) { const int row = row0 + ai * 128 + m * 16; \
    _Pragma("unroll") for (int bj = 0; bj < 2; ++bj) _Pragma("unroll") for (int n = 0; n < 2; ++n) { const int col = col0 + bj * 128 + n * 16; const f32x4 v = acc[ai][bj][m][n];
#define EPI_LOOP_END } }
#define EPI_LOOP_BEGIN_S \
    const int row0 = u.pm * 256 + wr * 64 + fr, col0 = u.pn * 256 + wc * 32 + 4 * fq; \
    _Pragma("unroll") for (int ai = 0; ai < 2; ++ai) _Pragma("unroll") for (int m = 0; m < 4; ++m) { const int row = row0 + ai * 128 + m * 16; \
    _Pragma("unroll") for (int bj = 0; bj < 2; ++bj) _Pragma("unroll") for (int n = 0; n < 2; ++n) { const int col = col0 + bj * 128 + n * 16; const f32x4 v = acc[ai][bj][m][n] * rs[ai][m];

struct EpiIn {
    bf16_t *Qb, *Kb, *Vb; bf16_t* RW; float* out;
    DI void operator()(const AccT& acc, const pg8::Unit& u, int wr, int wc, int fr, int fq) const {
        const int reg = u.pn < 4 ? 0 : (u.pn < 8 ? 1 : (u.pn < 12 ? 2 : 3));
        EPI_LOOP_BEGIN
            if (row < MT) {
                if (reg == 0) {
                    constexpr float QS_ = 0.125f * 1.44269504088896f;
                    u32x2 w; w.x = cvt_pk(v[0] * QS_, v[1] * QS_); w.y = cvt_pk(v[2] * QS_, v[3] * QS_);
                    *(u32x2*)(Qb + (size_t)row * 1024 + col) = w;
                } else if (reg == 1 || reg == 2) {
                    const int c = col - (reg == 1 ? 1024 : 2048);
                    float* o = row < MP ? out + (reg == 1 ? O_PK : O_PV) + (size_t)row * 1024 + c : out + (reg == 1 ? O_SK : O_SV) + (size_t)(row - MP) * 1024 + c;
                    *(f32x4*)o = v;
                    u32x2 w; w.x = cvt_pk(v[0], v[1]); w.y = cvt_pk(v[2], v[3]);
                    *(u32x2*)((reg == 1 ? Kb : Vb) + (size_t)row * 1024 + c) = w;
                } else {
                    const int c = col - 3072;
                    if (c < CSH) {
                        { u32x2 w; w.x = cvt_pk(v[0], v[1]); w.y = cvt_pk(v[2], v[3]); *(u32x2*)(RW + (size_t)row * CSH + c) = w; }
                        if (row >= MP) *(f32x4*)(out + O_SRW + (size_t)(row - MP) * CSH + c) = v;
                        else if ((row & (SEQ - 1)) == SEQ - 1) *(f32x4*)(out + O_PRW + (size_t)(row >> 11) * CSH + c) = v;
                    }
                }
            }
        EPI_LOOP_END
    }
};
struct EpiBf {
    bf16_t* C; int ldc;
    DI void operator()(const AccT& acc, const pg8::Unit& u, int wr, int wc, int fr, int fq) const {
        const int row0 = u.pm * 256 + wr * 64 + fr, col0 = u.pn * 256 + wc * 32 + 4 * fq;
#pragma unroll
        for (int ai = 0; ai < 2; ++ai)
#pragma unroll
            for (int m = 0; m < 4; ++m) { const int row = row0 + ai * 128 + m * 16;
#pragma unroll
                for (int bj = 0; bj < 2; ++bj)
#pragma unroll
                    for (int n = 0; n < 2; ++n) { const int col = col0 + bj * 128 + n * 16; const f32x4 v = acc[ai][bj][m][n];
                        u32x2 w; w.x = cvt_pk(v[0], v[1]); w.y = cvt_pk(v[2], v[3]);
                        *(u32x2*)(C + (size_t)row * ldc + col) = w; }
                asm volatile("" ::: "memory");
            }
    }
};
struct EpiWo {
    const float *xp; const float* gf; float* X1; bf16_t* H; float* RSS;
    DI void operator()(const AccT& acc, const pg8::Unit& u, int wr, int wc, int fr, int fq) const {
        const int row0 = u.pm * 256 + wr * 64 + fr, col0 = u.pn * 256 + wc * 32 + 4 * fq;
#pragma unroll
        for (int ai = 0; ai < 2; ++ai)
#pragma unroll
            for (int m = 0; m < 4; ++m) {
                const int row = row0 + ai * 128 + m * 16; float ss = 0.f;
#pragma unroll
                for (int bj = 0; bj < 2; ++bj)
#pragma unroll
                    for (int n = 0; n < 2; ++n) {
                        const int col = col0 + bj * 128 + n * 16;
                        const f32x4 x1 = *(const f32x4*)(xp + (size_t)row * D + col) + acc[ai][bj][m][n];
                        *(f32x4*)(X1 + (size_t)row * D + col) = x1;
                        const f32x4 gg = *(const f32x4*)(gf + col);
                        u32x2 w; w.x = cvt_pk(x1[0] * gg[0], x1[1] * gg[1]); w.y = cvt_pk(x1[2] * gg[2], x1[3] * gg[3]);
                        *(u32x2*)(H + (size_t)row * D + col) = w;
                        ss += (x1[0] * x1[0] + x1[1] * x1[1]) + (x1[2] * x1[2] + x1[3] * x1[3]);
                    }
                ss += __shfl_xor(ss, 16); ss += __shfl_xor(ss, 32);
                if (fq == 0) atomic_add_f32(RSS + row, ss);
            }
    }
};
struct EpiUp {
    bf16_t* U; float* out; const float* RSS;
    DI void operator()(const AccT& acc, const pg8::Unit& u, int wr, int wc, int fr, int fq) const {
        float rs[2][4];
        { const int row0_ = u.pm * 256 + wr * 64 + fr;
#pragma unroll
          for (int ai = 0; ai < 2; ++ai)
#pragma unroll
              for (int m = 0; m < 4; ++m) rs[ai][m] = rsqrtf(RSS[row0_ + ai * 128 + m * 16] * (1.f / D) + 1e-6f); }
        EPI_LOOP_BEGIN_S
            if (row < MT) {
                u32x2 w; w.x = cvt_pk(v[0], v[1]); w.y = cvt_pk(v[2], v[3]);
                *(u32x2*)(U + (size_t)row * FF2 + col) = w;
                if (row >= MP) *(f32x4*)(out + O_SFFN + (size_t)(row - MP) * 2 * FF2 + FF2 + col) = v;
                else if ((row & (SEQ - 1)) >= SEQ - 2) *(f32x4*)(out + O_PFFN + ((size_t)(row >> 11) * 2 + ((row & (SEQ - 1)) - (SEQ - 2))) * FF2 + col) = v;
            }
        EPI_LOOP_END
    }
};
#ifndef MK_P11_SCALE
#define MK_P11_SCALE 1.0f
#endif
struct EpiDn {
    float* X1;
    DI void operator()(const AccT& acc, const pg8::Unit& u, int wr, int wc, int fr, int fq) const {
        EPI_LOOP_BEGIN
            if (row < MT) { float* p = X1 + (size_t)row * D + col; *(f32x4*)p = *(const f32x4*)p + v * MK_P11_SCALE; }
        EPI_LOOP_END
    }
};

DI void transpose_item(const float* W, int K, int N, bf16_t* WT, int ldt, float* scr, int item, int lane) {
    const int nblk = N / 32, kb = item / nblk, nb = item % nblk, k0 = 64 * kb, n0 = 32 * nb;
#pragma unroll 8
    for (int i = 0; i < 32; ++i) { const int kk = 2 * i + (lane >> 5); scr[kk * 33 + (lane & 31)] = W[(size_t)(k0 + kk) * N + n0 + (lane & 31)]; }
    __builtin_amdgcn_fence(__ATOMIC_RELEASE, "wavefront"); asm volatile("s_waitcnt lgkmcnt(0)" ::: "memory");
    const int c = lane & 7;
#pragma unroll
    for (int j = 0; j < 4; ++j) { const int n = (lane >> 3) + 8 * j; const float* s = scr + (8 * c) * 33 + n;
        u32x4 o; o.x = pk2(s[0 * 33], s[1 * 33]); o.y = pk2(s[2 * 33], s[3 * 33]); o.z = pk2(s[4 * 33], s[5 * 33]); o.w = pk2(s[6 * 33], s[7 * 33]);
        *(u32x4*)(WT + (size_t)(n0 + n) * ldt + k0 + 8 * c) = o; }
    asm volatile("s_waitcnt lgkmcnt(0)" ::: "memory");
}
DI void rms_row_bf16(const float* xrow, const float* g, bf16_t* orow, int lane) {
    const f32x4* xr = (const f32x4*)xrow + lane; const f32x4* gr = (const f32x4*)g + lane;
    f32x4 v[8]; float s = 0.f;
#pragma unroll
    for (int j = 0; j < 8; ++j) { v[j] = xr[64 * j]; s += (v[j].x * v[j].x + v[j].y * v[j].y) + (v[j].z * v[j].z + v[j].w * v[j].w); }
    const float rstd = rsqrtf(wave_sum(s) * (1.f / D) + 1e-6f);
    u32x2* o8 = (u32x2*)orow + lane;
#pragma unroll
    for (int j = 0; j < 8; ++j) { const f32x4 gg = gr[64 * j]; u32x2 w; w.x = pk2(v[j].x * rstd * gg.x, v[j].y * rstd * gg.y); w.y = pk2(v[j].z * rstd * gg.z, v[j].w * rstd * gg.w); o8[64 * j] = w; }
}
DI void rms_row_f32(const float* xrow, const float* g, float* orow, int lane) {
    const f32x4* xr = (const f32x4*)xrow + lane; const f32x4* gr = (const f32x4*)g + lane;
    f32x4 v[8]; float s = 0.f;
#pragma unroll
    for (int j = 0; j < 8; ++j) { v[j] = xr[64 * j]; s += (v[j].x * v[j].x + v[j].y * v[j].y) + (v[j].z * v[j].z + v[j].w * v[j].w); }
    const float rstd = rsqrtf(wave_sum(s) * (1.f / D) + 1e-6f);
    f32x4* o = (f32x4*)orow + lane;
#pragma unroll
    for (int j = 0; j < 8; ++j) { const f32x4 gg = gr[64 * j]; o[64 * j] = v[j] * rstd * gg; }
}
DI void zero_row_bf16(bf16_t* orow, int ncols, int lane) {
    for (int c = lane * 8; c < ncols; c += 512) *(u32x4*)(orow + c) = (u32x4){0u, 0u, 0u, 0u};
}

DI void phase_prologue(const Args& a, unsigned char* lds, int gw, int ngw, int lane, int wave) {
    unsigned char* ws = a.ws;
    float* scr = (float*)(lds + wave * 16384);
    bf16_t* Win = (bf16_t*)(ws + WS_WIN); bf16_t* Wlo = (bf16_t*)(ws + WS_WLO);
    constexpr int IT_IN = (D / 64) * (CIN / 32);
    for (int it = gw; it < IT_IN; it += ngw) transpose_item(a.in[I_WIN], D, CIN, Win, D, scr, it, lane);
    for (int r = CIN + gw; r < NIN; r += ngw) zero_row_bf16(Win + (size_t)r * D, D, lane);
    {
        const int gt = gw * 64 + lane, ngt = ngw * 64;
        for (int i = gt; i < NLO * KLO; i += ngt) {
            const int n = i / KLO, k = i % KLO; float v = 0.f;
            if (n < 1024) { if (k < 64) v = a.in[I_WUP][k * 1024 + n]; }
            else if (n < 2048) { if (k >= 64 && k < 128) v = a.in[I_AUP][(k - 64) * 1024 + (n - 1024)]; }
            else { if (k >= 128 && k < 288) v = a.in[I_GUP][(k - 128) * 1024 + (n - 2048)]; }
            Wlo[i] = (bf16_t)bf_rne(v);
        }
    }
    { float* RSS = (float*)(ws + WS_RSS); for (int i = gw * 64 + lane; i < MPAD; i += ngw * 64) RSS[i] = 0.f; }
    bf16_t* H = (bf16_t*)(ws + WS_H);
    for (int m = gw; m < MPAD; m += ngw) {
        if (m < MT) rms_row_bf16(m < MP ? a.in[I_XP] + (size_t)m * D : a.in[I_XS] + (size_t)(m - MP) * D, a.in[I_NMG], H + (size_t)m * D, lane);
        else zero_row_bf16(H + (size_t)m * D, D, lane);
    }
}


DI void convert_wo_wup(const Args& a, unsigned char* lds, int wi, int nw, int wave, int lane) {
    float* scr = (float*)(lds + wave * 16384);
    constexpr int IT_O = (D / 64) * (D / 32), IT_UP = (D / 64) * (FF2 / 32);
    for (int it = wi; it < IT_O + IT_UP; it += nw) {
        if (it < IT_O) transpose_item(a.in[I_WO], D, D, (bf16_t*)(a.ws + WS_WO), D, scr, it, lane);
        else transpose_item(a.in[I_FUP], D, FF2, (bf16_t*)(a.ws + WS_WUP), D, scr, it - IT_O, lane);
    }
}
DI void convert_wdn(const Args& a, unsigned char* lds, int wi, int nw, int wave, int lane) {
    float* scr = (float*)(lds + wave * 16384);
    constexpr int IT_DN = (FF / 64) * (D / 32);
    for (int it = wi; it < IT_DN; it += nw) transpose_item(a.in[I_FDN], FF, D, (bf16_t*)(a.ws + WS_WDN), FF, scr, it, lane);
}

DI float rw_prev_val(const Args& a, const bf16_t* RW, int m, int j) {
    if (m < MP) return (m & (SEQ - 1)) == 0 ? 0.f : bf2f(RW[(size_t)(m - 1) * CSH + j]);
    return a.in[I_SSH][(size_t)(m - MP) * CSH + j];
}
DI void lora_input_row(const Args& a, int m, int lane) {
    bf16_t* ALO = (bf16_t*)(a.ws + WS_ALO) + (size_t)m * KLO;
    if (m >= MT) { for (int c = lane; c < KLO; c += 64) ALO[c] = 0; return; }
    const bf16_t* RW = (const bf16_t*)(a.ws + WS_RW);
    const bf16_t* cur = RW + (size_t)m * CSH;
    for (int c = lane; c < KLO; c += 64) {
        float v = 0.f;
        if (c < 288) {
            const int j = 3072 + c; const float x = bf2f(cur[j]), p = rw_prev_val(a, RW, m, j); const float xs = x + a.in[I_MU][j] * (p - x);
            v = c < 64 ? 1.f - 2.f * __builtin_amdgcn_rcpf(1.f + __expf(2.f * xs)) : (c < 128 ? xs : __builtin_amdgcn_rcpf(1.f + __expf(-xs)));
        }
        ALO[c] = (bf16_t)bf_rne(v);
    }
}

DI int crow(int reg, int h) { return (reg & 3) + 8 * (reg >> 2) + 4 * h; }
typedef short s16x4 __attribute__((ext_vector_type(4)));
constexpr int VPITCH = 192;
DI void attn_prompt_unit(const Args& a, unsigned char* lds, int unit, int wave, int lane) {
    const bf16_t* Qb = (const bf16_t*)(a.ws + WS_QB); const bf16_t* Kb = (const bf16_t*)(a.ws + WS_KB); const bf16_t* Vb = (const bf16_t*)(a.ws + WS_VB);
    bf16_t* PO = (bf16_t*)(a.ws + WS_PART); float* PML = (float*)(a.ws + WS_PML);
    LAS unsigned char* img = (LAS unsigned char*)lds + wave * (32 * VPITCH);
    const int blk = unit & 63, br = (unit >> 6) % 3, bh = unit / 192, b = bh >> 4, h = bh & 15;
    const int rate = br == 0 ? 1 : (br == 1 ? 4 : 16), L = SEQ / rate, bpc = L / 32;
    const int rho = blk / bpc, l0 = (blk % bpc) * 32;
    const int r = lane & 31, hh = lane >> 5;
    const int mq = b * SEQ + rho + rate * (l0 + r);
    bf16x8 qf[4];
#pragma unroll
    for (int ks = 0; ks < 4; ++ks) qf[ks] = *(const bf16x8*)(Qb + (size_t)mq * 1024 + h * 64 + ks * 16 + 8 * hh);
    f32x16 o0, o1;
#pragma unroll
    for (int i = 0; i < 16; ++i) { o0[i] = 0.f; o1[i] = 0.f; }
    float mrun = -1e30f, lrun = 0.f;
    const int lq = l0 + r;
    const int c0 = l0 >= 128 ? 0 : (128 - l0) >> 5;
    const bf16_t* kbase = Kb + (size_t)(b * SEQ + rho) * 1024 + h * 64 + 8 * hh;
    const bf16_t* vbase = Vb + (size_t)(b * SEQ + rho) * 1024 + h * 64 + 8 * (lane & 7);
    bf16x8 kreg[4]; u32x4 vreg[4];
#define AT_PREFETCH(ch_) do { const int lk0_ = l0 - 128 + 32 * (ch_); \
        _Pragma("unroll") for (int ks = 0; ks < 4; ++ks) kreg[ks] = *(const bf16x8*)(kbase + (size_t)(rate * (lk0_ + r)) * 1024 + ks * 16); \
        _Pragma("unroll") for (int i = 0; i < 4; ++i) vreg[i] = *(const u32x4*)(vbase + (size_t)(rate * (lk0_ + 8 * i + (lane >> 3))) * 1024); } while (0)
    AT_PREFETCH(c0);
    const int i16 = lane & 15, tq = i16 >> 2, tp = i16 & 3, g16 = (lane >> 4) & 1;
    const unsigned troff = (unsigned)((4 * hh + tq) * VPITCH + g16 * 32 + 8 * tp);
    for (int ch = c0; ch < 5; ++ch) {
        const int lk0 = l0 - 128 + 32 * ch;
        bf16x8 kf[4];
#pragma unroll
        for (int ks = 0; ks < 4; ++ks) kf[ks] = kreg[ks];
#pragma unroll
        for (int i = 0; i < 4; ++i) *(LAS u32x4*)(img + (8 * i + (lane >> 3)) * VPITCH + 16 * (lane & 7)) = vreg[i];
        if (ch + 1 < 5) AT_PREFETCH(ch + 1);
        f32x16 st;
#pragma unroll
        for (int i = 0; i < 16; ++i) st[i] = 0.f;
#pragma unroll
        for (int ks = 0; ks < 4; ++ks) st = __builtin_amdgcn_mfma_f32_32x32x16_bf16(kf[ks], qf[ks], st, 0, 0, 0);
        float cmax = -1e30f;
        if (ch == 0 || ch == 4) {
#pragma unroll
            for (int i = 0; i < 16; ++i) { const int lk = lk0 + crow(i, hh); const bool ok = (lk <= lq) && (lk >= lq - 128); st[i] = ok ? st[i] : -1e30f; }
        }
#pragma unroll
        for (int i = 0; i < 16; ++i) cmax = fmaxf(cmax, st[i]);
        cmax = fmaxf(cmax, __shfl_xor(cmax, 32));
        const float mnew = fmaxf(mrun, cmax), alpha = __builtin_amdgcn_exp2f(mrun - mnew);
        float ps = 0.f;
#pragma unroll
        for (int i = 0; i < 16; ++i) { const float p = __builtin_amdgcn_exp2f(st[i] - mnew); st[i] = p; ps += p; }
        lrun = lrun * alpha + ps; mrun = mnew;
#pragma unroll
        for (int i = 0; i < 16; ++i) { o0[i] *= alpha; o1[i] *= alpha; }
#pragma unroll
        for (int s = 0; s < 2; ++s) {
            u32x4 pp; pp.x = pk2(st[8 * s], st[8 * s + 1]); pp.y = pk2(st[8 * s + 2], st[8 * s + 3]); pp.z = pk2(st[8 * s + 4], st[8 * s + 5]); pp.w = pk2(st[8 * s + 6], st[8 * s + 7]);
            const bf16x8 pf = __builtin_bit_cast(bf16x8, pp);
#pragma unroll
            for (int dt = 0; dt < 2; ++dt) {
                const s16x4 lo = __builtin_amdgcn_ds_read_tr16_b64_v4i16((LAS s16x4*)(img + troff + (16 * s) * VPITCH + dt * 64));
                const s16x4 hi = __builtin_amdgcn_ds_read_tr16_b64_v4i16((LAS s16x4*)(img + troff + (16 * s + 8) * VPITCH + dt * 64));
                const bf16x8 vf = __builtin_shufflevector(lo, hi, 0, 1, 2, 3, 4, 5, 6, 7);
                if (dt == 0) o0 = __builtin_amdgcn_mfma_f32_32x32x16_bf16(vf, pf, o0, 0, 0, 0);
                else o1 = __builtin_amdgcn_mfma_f32_32x32x16_bf16(vf, pf, o1, 0, 0, 0);
            }
        }
    }
#undef AT_PREFETCH
    const float ltot = lrun + __shfl_xor(lrun, 32);
    bf16_t* po = PO + ((size_t)br * MP + mq) * 1024 + h * 64;
#pragma unroll
    for (int g = 0; g < 4; ++g) {
        u32x2 w0, w1; w0.x = pk2(o0[4 * g], o0[4 * g + 1]); w0.y = pk2(o0[4 * g + 2], o0[4 * g + 3]); w1.x = pk2(o1[4 * g], o1[4 * g + 1]); w1.y = pk2(o1[4 * g + 2], o1[4 * g + 3]);
        *(u32x2*)(po + 8 * g + 4 * hh) = w0; *(u32x2*)(po + 32 + 8 * g + 4 * hh) = w1;
    }
    if (hh == 0) { float* pm = PML + (((size_t)br * MP + mq) * 16 + h) * 2; pm[0] = mrun; pm[1] = ltot; }
}
DI float sum16(float v) { v = DPP_ADD(v, 0xB1); v = DPP_ADD(v, 0x4E); v = DPP_ADD(v, 0x141); v = DPP_ADD(v, 0x140); return v; }
DI void attn_merge_task(const Args& a, int task, int lane) {
    const int m = task >> 2, h = (task & 3) * 4 + (lane >> 4), d = 4 * (lane & 15);
    const bf16_t* PO = (const bf16_t*)(a.ws + WS_PART); const float* PML = (const float*)(a.ws + WS_PML);
    bf16_t* O = (bf16_t*)(a.ws + WS_O);
    float mb[3], lb[3]; f32x4 ob[3];
#pragma unroll
    for (int br = 0; br < 3; ++br) { const float* pm = PML + (((size_t)br * MP + m) * 16 + h) * 2; mb[br] = pm[0]; lb[br] = pm[1];
        const u32x2 w = *(const u32x2*)(PO + ((size_t)br * MP + m) * 1024 + h * 64 + d);
        ob[br] = (f32x4){__uint_as_float(w.x << 16), __uint_as_float(w.x & 0xffff0000u), __uint_as_float(w.y << 16), __uint_as_float(w.y & 0xffff0000u)}; }
    const float M = fmaxf(mb[0], fmaxf(mb[1], mb[2]));
    f32x4 num = {0.f, 0.f, 0.f, 0.f}; float den = 0.f;
#pragma unroll
    for (int br = 0; br < 3; ++br) { const float w = __builtin_amdgcn_exp2f(mb[br] - M); num += ob[br] * w; den += w * lb[br]; }
    const f32x4 o = num * __builtin_amdgcn_rcpf(den);
    const float ss = sum16(o.x * o.x + o.y * o.y + o.z * o.z + o.w * o.w) * (1.f / 64.f);
    const float rs = rsqrtf(ss + 1e-6f);
    const f32x4 gg = *(const f32x4*)(a.in[I_AOG] + h * 64 + d);
    u32x2 w; w.x = pk2(o.x * rs * gg.x, o.y * rs * gg.y); w.y = pk2(o.z * rs * gg.z, o.w * rs * gg.w);
    *(u32x2*)(O + (size_t)m * D + h * 64 + d) = w;
}
DI void attn_sample_wg(const Args& a, unsigned char* lds, int unit, int wave, int lane) {
    float* part = (float*)lds;
    const int bh = unit * 2 + (wave >> 2), qt = wave & 3, b = bh >> 4, h = bh & 15, g = lane >> 4, l16 = lane & 15;
    const bf16_t* Qb = (const bf16_t*)(a.ws + WS_QB);
    const float* ck = a.in[I_CK] + (size_t)b * 2048 * 1024 + h * 64 + 4 * l16; const float* cv = a.in[I_CV] + (size_t)b * 2048 * 1024 + h * 64 + 4 * l16;
    const float* nk = a.out + O_SK + (size_t)b * 1024 + h * 64 + 4 * l16; const float* nv = a.out + O_SV + (size_t)b * 1024 + h * 64 + 4 * l16;
    const u32x2 qw = *(const u32x2*)(Qb + (size_t)(MP + b) * 1024 + h * 64 + 4 * l16);
    const float q0 = __uint_as_float(qw.x << 16), q1 = __uint_as_float(qw.x & 0xffff0000u), q2 = __uint_as_float(qw.y << 16), q3 = __uint_as_float(qw.y & 0xffff0000u);
    float mrun = -1e30f, lrun = 0.f; f32x4 acc = {0.f, 0.f, 0.f, 0.f};
    const int e0 = qt * 97, e1 = e0 + 97 < 387 ? e0 + 97 : 387;
    for (int ito = 0; ito < 25; ito += 5) {
        f32x4 kv[5], vv[5]; bool valid[5];
#pragma unroll
        for (int k = 0; k < 5; ++k) {
            const int e = e0 + (ito + k) * 4 + g; valid[k] = e < e1;
            const int ee = valid[k] ? e : e0, br = ee / 129, j = ee % 129, rate = br == 0 ? 1 : (br == 1 ? 4 : 16);
            const int row = 2048 - rate * j;
            const float* kp = j == 0 ? nk : ck + (size_t)row * 1024; const float* vp = j == 0 ? nv : cv + (size_t)row * 1024;
            kv[k] = *(const f32x4*)kp; vv[k] = *(const f32x4*)vp;
        }
#pragma unroll
        for (int k = 0; k < 5; ++k) {
            float s = sum16(q0 * kv[k].x + q1 * kv[k].y + q2 * kv[k].z + q3 * kv[k].w);
            if (!valid[k]) s = -1e30f;
            const float mnew = fmaxf(mrun, s), alpha = __builtin_amdgcn_exp2f(mrun - mnew), p = valid[k] ? __builtin_amdgcn_exp2f(s - mnew) : 0.f;
            lrun = lrun * alpha + p; acc = acc * alpha + vv[k] * p; mrun = mnew;
        }
    }
#pragma unroll
    for (int o = 16; o < 64; o <<= 1) {
        const float mo = __shfl_xor(mrun, o), lo = __shfl_xor(lrun, o);
        f32x4 ao; ao.x = __shfl_xor(acc.x, o); ao.y = __shfl_xor(acc.y, o); ao.z = __shfl_xor(acc.z, o); ao.w = __shfl_xor(acc.w, o);
        const float mn = fmaxf(mrun, mo), w0 = __builtin_amdgcn_exp2f(mrun - mn), w1 = __builtin_amdgcn_exp2f(mo - mn);
        lrun = lrun * w0 + lo * w1; acc = acc * w0 + ao * w1; mrun = mn;
    }
    if (g == 0) { *(f32x4*)(part + wave * 68 + 4 * l16) = acc; if (l16 == 0) { part[wave * 68 + 64] = mrun; part[wave * 68 + 65] = lrun; } }
    __syncthreads();
    if (qt == 0 && g == 0) {
        float M = -1e30f;
#pragma unroll
        for (int w = 0; w < 4; ++w) M = fmaxf(M, part[(wave + w) * 68 + 64]);
        f32x4 num = {0.f, 0.f, 0.f, 0.f}; float den = 0.f;
#pragma unroll
        for (int w = 0; w < 4; ++w) { const float wt = __builtin_amdgcn_exp2f(part[(wave + w) * 68 + 64] - M); num += *(const f32x4*)(part + (wave + w) * 68 + 4 * l16) * wt; den += part[(wave + w) * 68 + 65] * wt; }
        const f32x4 o = num * (1.f / den);
        const float ss = sum16(o.x * o.x + o.y * o.y + o.z * o.z + o.w * o.w);
        const float rs = rsqrtf(ss * (1.f / 64.f) + 1e-6f);
        const f32x4 gg = *(const f32x4*)(a.in[I_AOG] + h * 64 + 4 * l16);
        u32x2 w; w.x = pk2(o.x * rs * gg.x, o.y * rs * gg.y); w.y = pk2(o.z * rs * gg.z, o.w * rs * gg.w);
        *(u32x2*)((bf16_t*)(a.ws + WS_O) + (size_t)(MP + b) * D + h * 64 + 4 * l16) = w;
    }
    __syncthreads();
}

struct PrepParams { float mu_r, mu_k, mu_v, w0, a0, kk, ka, rk; };
struct PrepRaw { float cr, ck, cv, pr, pk, pv, lw, la, lg; };
DI void prep_params(const Args& a, PrepParams& P, int c) {
    P.mu_r = a.in[I_MU][c]; P.mu_k = a.in[I_MU][1024 + c]; P.mu_v = a.in[I_MU][2048 + c];
    P.w0 = a.in[I_W0][c]; P.a0 = a.in[I_A0][c]; P.kk = a.in[I_KK][c]; P.ka = a.in[I_KA][c]; P.rk = a.in[I_RK][c];
}
DI void prep_load(const Args& a, PrepRaw& R, const bf16_t* RW, int m, const bf16_t* Lrow, int c) {
    const bf16_t* cur = RW + (size_t)m * CSH;
    R.cr = bf2f(cur[c]); R.ck = bf2f(cur[1024 + c]); R.cv = bf2f(cur[2048 + c]);
    R.pr = rw_prev_val(a, RW, m, c); R.pk = rw_prev_val(a, RW, m, 1024 + c); R.pv = rw_prev_val(a, RW, m, 2048 + c);
    R.lw = bf2f(Lrow[c]); R.la = bf2f(Lrow[1024 + c]); R.lg = bf2f(Lrow[2048 + c]);
}
DI void prep_finish(const PrepRaw& R, const PrepParams& P, float* dst, float& g_out, float& bonus_out, int lane) {
    const float xr = R.cr + P.mu_r * (R.pr - R.cr), xk = R.ck + P.mu_k * (R.pk - R.ck), xv = R.cv + P.mu_v * (R.pv - R.cv);
    const float x = -(P.w0 + R.lw);
    const float sp = x > 20.f ? x : __logf(1.f + __expf(x));
    const float decay = __expf(-__expf(-sp - 0.5f));
    const float av = __builtin_amdgcn_rcpf(1.f + __expf(-(P.a0 + R.la)));
    float kkv = xk * P.kk;
    const float n2 = wave_sum(kkv * kkv);
    kkv = kkv * fminf(__builtin_amdgcn_rsqf(n2), 1e12f);
    const float keff = xk * (1.f + (av - 1.f) * P.ka);
    const float bon = wave_sum(xr * keff * P.rk) * xv;
    dst[lane] = xr; dst[64 + lane] = decay; dst[128 + lane] = keff; dst[192 + lane] = xv; dst[256 + lane] = -kkv; dst[320 + lane] = kkv * av;
    g_out = R.lg; bonus_out = bon;
}
DI float scan_step(float (&S)[64], const float* sv, float vi) {
    const f32x4* r4 = (const f32x4*)sv; const f32x4* w4 = (const f32x4*)(sv + 64); const f32x4* k4 = (const f32x4*)(sv + 128);
    const f32x4* a4 = (const f32x4*)(sv + 256); const f32x4* b4 = (const f32x4*)(sv + 320);
    float sa0 = 0.f, sa1 = 0.f;
#pragma unroll
    for (int j = 0; j < 16; ++j) { const f32x4 av = a4[j]; sa0 = fmaf(S[4 * j], av.x, sa0); sa1 = fmaf(S[4 * j + 1], av.y, sa1); sa0 = fmaf(S[4 * j + 2], av.z, sa0); sa1 = fmaf(S[4 * j + 3], av.w, sa1); }
    const float sa = sa0 + sa1;
    float y0 = 0.f, y1 = 0.f;
#pragma unroll
    for (int j = 0; j < 16; ++j) {
        const f32x4 bv = b4[j], kv = k4[j], wv = w4[j], rv = r4[j];
        float t;
        t = fmaf(vi, kv.x, sa * bv.x); S[4 * j] = fmaf(S[4 * j], wv.x, t); y0 = fmaf(S[4 * j], rv.x, y0);
        t = fmaf(vi, kv.y, sa * bv.y); S[4 * j + 1] = fmaf(S[4 * j + 1], wv.y, t); y1 = fmaf(S[4 * j + 1], rv.y, y1);
        t = fmaf(vi, kv.z, sa * bv.z); S[4 * j + 2] = fmaf(S[4 * j + 2], wv.z, t); y0 = fmaf(S[4 * j + 2], rv.z, y0);
        t = fmaf(vi, kv.w, sa * bv.w); S[4 * j + 3] = fmaf(S[4 * j + 3], wv.w, t); y1 = fmaf(S[4 * j + 3], rv.w, y1);
        if ((j & 3) == 3) asm volatile("" ::: "memory");
    }
    return y0 + y1;
}
DI void rwkv_post(const Args& a, float y, float g, float bonus, int m, int c) {
    const float mean = wave_sum(y) * (1.f / 64.f); const float d = y - mean; const float var = wave_sum(d * d) * (1.f / 64.f);
    const float yn = d * rsqrtf(var + 64e-5f) * a.in[I_LNW][c] + a.in[I_LNB][c];
    ((bf16_t*)(a.ws + WS_O))[(size_t)m * D + 1024 + c] = (bf16_t)bf_rne((yn + bonus) * g);
}

#define WG_BAR_LDS() do { asm volatile("s_waitcnt lgkmcnt(0)" ::: "memory"); __builtin_amdgcn_s_barrier(); asm volatile("" ::: "memory"); } while (0)
typedef float f32x2 __attribute__((ext_vector_type(2)));
DI f32x2 fma2(f32x2 a, f32x2 b, f32x2 c) { return __builtin_elementwise_fma(a, b, c); }
DI void scan_dot_a(const f32x2 (&Z)[32], const f32x2 (&P)[32], const float* sv, float& sz, float& sp) {
    const f32x4* a4 = (const f32x4*)(sv + 256);
    f32x2 saz = {0.f, 0.f}, sap = {0.f, 0.f};
#pragma unroll
    for (int j = 0; j < 16; ++j) { const f32x4 av = a4[j]; const f32x2 a0 = {av.x, av.y}, a1 = {av.z, av.w};
        saz = fma2(Z[2 * j], a0, saz); sap = fma2(P[2 * j], a0, sap); saz = fma2(Z[2 * j + 1], a1, saz); sap = fma2(P[2 * j + 1], a1, sap);
        if ((j & 7) == 7) asm volatile("" ::: "memory"); }
    sz = saz.x + saz.y; sp = sap.x + sap.y;
}
DI void scan_step3(f32x2 (&Z)[32], f32x2 (&P)[32], const float* sv, const float* svn, float vi, float& sz, float& sp, float& yz, float& yp) {
    const f32x4* r4 = (const f32x4*)sv; const f32x4* w4 = (const f32x4*)(sv + 64); const f32x4* k4 = (const f32x4*)(sv + 128);
    const f32x4* b4 = (const f32x4*)(sv + 320); const f32x4* an4 = (const f32x4*)(svn + 256);
    const f32x2 sz2 = {sz, sz}, sp2 = {sp, sp}, v2 = {vi, vi};
    f32x2 yz2 = {0.f, 0.f}, yp2 = {0.f, 0.f}, nz2 = {0.f, 0.f}, np2 = {0.f, 0.f};
    f32x4 buf[3][5];
#define S3_LD(g, j) do { buf[g][0] = b4[j]; buf[g][1] = k4[j]; buf[g][2] = w4[j]; buf[g][3] = r4[j]; buf[g][4] = an4[j]; asm volatile("" ::: "memory"); } while (0)
    S3_LD(0, 0); S3_LD(1, 1);
#pragma unroll
    for (int j = 0; j < 16; ++j) {
        if (j + 2 < 16) S3_LD((j + 2) % 3, j + 2);
        const f32x4 bv = buf[j % 3][0], kv = buf[j % 3][1], wv = buf[j % 3][2], rv = buf[j % 3][3], av = buf[j % 3][4];
        { const f32x2 b2 = {bv.x, bv.y}, k2 = {kv.x, kv.y}, w2 = {wv.x, wv.y}, r2 = {rv.x, rv.y}, a2 = {av.x, av.y};
          f32x2 tz = sz2 * b2; tz = fma2(v2, k2, tz); Z[2 * j] = fma2(Z[2 * j], w2, tz); yz2 = fma2(Z[2 * j], r2, yz2); nz2 = fma2(Z[2 * j], a2, nz2);
          const f32x2 tp = sp2 * b2; P[2 * j] = fma2(P[2 * j], w2, tp); yp2 = fma2(P[2 * j], r2, yp2); np2 = fma2(P[2 * j], a2, np2); }
        { const f32x2 b2 = {bv.z, bv.w}, k2 = {kv.z, kv.w}, w2 = {wv.z, wv.w}, r2 = {rv.z, rv.w}, a2 = {av.z, av.w};
          f32x2 tz = sz2 * b2; tz = fma2(v2, k2, tz); Z[2 * j + 1] = fma2(Z[2 * j + 1], w2, tz); yz2 = fma2(Z[2 * j + 1], r2, yz2); nz2 = fma2(Z[2 * j + 1], a2, nz2);
          const f32x2 tp = sp2 * b2; P[2 * j + 1] = fma2(P[2 * j + 1], w2, tp); yp2 = fma2(P[2 * j + 1], r2, yp2); np2 = fma2(P[2 * j + 1], a2, np2); }
        asm volatile("" ::: "memory");
    }
#undef S3_LD
    yz = yz2.x + yz2.y; yp = yp2.x + yp2.y; sz = nz2.x + nz2.y; sp = np2.x + np2.y;
}
DI void scan_pass1_unit(const Args& a, unsigned char* lds, int unit, int wave, int lane) {
    float* stg = (float*)lds;
    const int pp = wave & 3, pair = unit * 4 + pp, chain = pair / NS, seg = pair % NS, b = chain >> 4, h = chain & 15, c = h * 64 + lane;
    const int mbase = b * SEQ + seg * SEGL;
    constexpr int NB = SEGL / TB;
    if (wave < 4) {
        bf16_t* YL = (bf16_t*)(a.ws + WS_YL); bf16_t* QS = (bf16_t*)(a.ws + WS_QS); float* ZP = (float*)(a.ws + WS_ZP);
        f32x2 Z[32], P[32];
        int idl = lane; asm volatile("" : "+v"(idl));
#pragma unroll
        for (int j = 0; j < 32; ++j) { Z[j] = (f32x2){0.f, 0.f}; P[j] = (f32x2){idl == 2 * j ? 1.f : 0.f, idl == 2 * j + 1 ? 1.f : 0.f}; }
        WG_BAR_LDS();
        for (int blk = 0; blk < NB; ++blk) {
            const float* sb = stg + (((blk & 1) * 4 + pp) * TB) * 384;
            float sz, sp; scan_dot_a(Z, P, sb, sz, sp);
#pragma unroll 1
            for (int tt = 0; tt < TB; ++tt) {
                const float* sv = sb + tt * 384; const float* svn = sb + (tt + 1 < TB ? tt + 1 : tt) * 384;
                float yz, yp; scan_step3(Z, P, sv, svn, sv[192 + lane], sz, sp, yz, yp);
                const size_t o = (size_t)(mbase + blk * TB + tt) * 1024 + c;
                const unsigned yq = pk2(yz, yp); YL[o] = (bf16_t)(yq & 0xffffu); QS[o] = (bf16_t)(yq >> 16);
            }
            WG_BAR_LDS();
        }
        float* zp = ZP + (size_t)pair * 2 * 4096 + lane * 64;
#pragma unroll
        for (int j = 0; j < 16; ++j) { *(f32x4*)(zp + 4 * j) = (f32x4){Z[2 * j].x, Z[2 * j].y, Z[2 * j + 1].x, Z[2 * j + 1].y};
                                       *(f32x4*)(zp + 4096 + 4 * j) = (f32x4){P[2 * j].x, P[2 * j].y, P[2 * j + 1].x, P[2 * j + 1].y}; }
    } else {
        const bf16_t* RW = (const bf16_t*)(a.ws + WS_RW); const bf16_t* Lb = (const bf16_t*)(a.ws + WS_L);
        bf16_t* GB = (bf16_t*)(a.ws + WS_GB);
        PrepParams Pm; prep_params(a, Pm, c);
        PrepRaw raw[TB];
#define P1_LOAD(blk_) do { _Pragma("unroll") for (int k = 0; k < TB; ++k) { const int m = mbase + (blk_) * TB + k; prep_load(a, raw[k], RW, m, Lb + (size_t)m * NLO, c); } } while (0)
#define P1_FINISH(blk_) do { _Pragma("unroll") for (int k = 0; k < TB; ++k) { const int m = mbase + (blk_) * TB + k; float g, bon; \
            prep_finish(raw[k], Pm, stg + ((((blk_) & 1) * 4 + pp) * TB + k) * 384, g, bon, lane); \
            GB[((size_t)m * 16 + h) * 128 + lane] = (bf16_t)bf_rne(g); GB[((size_t)m * 16 + h) * 128 + 64 + lane] = (bf16_t)bf_rne(bon); } } while (0)
        P1_LOAD(0); P1_FINISH(0); P1_LOAD(1);
        WG_BAR_LDS();
        for (int blk = 0; blk < NB; ++blk) {
            if (blk + 1 < NB) P1_FINISH(blk + 1);
            if (blk + 2 < NB) P1_LOAD(blk + 2);
            WG_BAR_LDS();
        }
#undef P1_LOAD
#undef P1_FINISH
    }
}
DI void scan_sample_unit(const Args& a, unsigned char* lds, int unit, int wave, int lane) {
    float* sv = (float*)(lds + 2 * 4 * TB * 384 * 4) + wave * 384;
    const bf16_t* RW = (const bf16_t*)(a.ws + WS_RW); const bf16_t* Lb = (const bf16_t*)(a.ws + WS_L);
    const int b = unit >> 4, h = unit & 15, c = h * 64 + lane, m = MP + b;
    PrepParams P; prep_params(a, P, c);
    PrepRaw raw; prep_load(a, raw, RW, m, Lb + (size_t)m * NLO, c);
    float g, bon; prep_finish(raw, P, sv, g, bon, lane);
    float S[64];
    const float* s0 = a.in[I_SWKV] + ((size_t)(b * 16 + h) * 64 + lane) * 64;
#pragma unroll
    for (int j = 0; j < 16; ++j) { const f32x4 v = *(const f32x4*)(s0 + 4 * j); S[4 * j] = v.x; S[4 * j + 1] = v.y; S[4 * j + 2] = v.z; S[4 * j + 3] = v.w; }
    const float y = scan_step(S, sv, sv[192 + lane]);
    float* so = a.out + O_SWKV + ((size_t)(b * 16 + h) * 64 + lane) * 64;
#pragma unroll
    for (int j = 0; j < 16; ++j) *(f32x4*)(so + 4 * j) = (f32x4){S[4 * j], S[4 * j + 1], S[4 * j + 2], S[4 * j + 3]};
    rwkv_post(a, y, g, bon, m, c);
}
DI void scan_pass2_unit(const Args& a, unsigned char* lds, int chain, int wave, int lane) {
    float* Ssh = (float*)lds;
    float* Psh = Ssh + 64 * 65;
    const float* ZP = (const float*)(a.ws + WS_ZP); float* SST = (float*)(a.ws + WS_SST);
    const int i = lane, j0 = wave * 8, tid = wave * 64 + lane;
    float Sr[8];
#pragma unroll
    for (int k = 0; k < 8; ++k) Sr[k] = 0.f;
    const float* Z0 = ZP + (size_t)(chain * NS) * 2 * 4096;
    f32x4 pn0 = *(const f32x4*)(Z0 + 4096 + tid * 8), pn1 = *(const f32x4*)(Z0 + 4096 + tid * 8 + 4);
    f32x4 zn0 = *(const f32x4*)(Z0 + i * 64 + j0), zn1 = *(const f32x4*)(Z0 + i * 64 + j0 + 4);
    for (int s = 0; s < NS; ++s) {
        float* sst = SST + ((size_t)chain * NS + s) * 4096 + i * 64 + j0;
        *(f32x4*)sst = (f32x4){Sr[0], Sr[1], Sr[2], Sr[3]}; *(f32x4*)(sst + 4) = (f32x4){Sr[4], Sr[5], Sr[6], Sr[7]};
#pragma unroll
        for (int k = 0; k < 8; ++k) Ssh[i * 65 + j0 + k] = Sr[k];
        *(f32x4*)(Psh + tid * 8) = pn0; *(f32x4*)(Psh + tid * 8 + 4) = pn1;
        float nw[8] = {zn0.x, zn0.y, zn0.z, zn0.w, zn1.x, zn1.y, zn1.z, zn1.w};
        if (s + 1 < NS) {
            const float* Zs = ZP + (size_t)(chain * NS + s + 1) * 2 * 4096;
            pn0 = *(const f32x4*)(Zs + 4096 + tid * 8); pn1 = *(const f32x4*)(Zs + 4096 + tid * 8 + 4);
            zn0 = *(const f32x4*)(Zs + i * 64 + j0); zn1 = *(const f32x4*)(Zs + i * 64 + j0 + 4);
        }
        WG_BAR_LDS();
        if (s > 0) {
#pragma unroll 8
            for (int l = 0; l < 64; ++l) {
                const float sl = Ssh[i * 65 + l];
                const f32x4 p0 = *(const f32x4*)(Psh + l * 64 + j0), p1 = *(const f32x4*)(Psh + l * 64 + j0 + 4);
                nw[0] = fmaf(sl, p0.x, nw[0]); nw[1] = fmaf(sl, p0.y, nw[1]); nw[2] = fmaf(sl, p0.z, nw[2]); nw[3] = fmaf(sl, p0.w, nw[3]);
                nw[4] = fmaf(sl, p1.x, nw[4]); nw[5] = fmaf(sl, p1.y, nw[5]); nw[6] = fmaf(sl, p1.z, nw[6]); nw[7] = fmaf(sl, p1.w, nw[7]);
            }
        }
        WG_BAR_LDS();
#pragma unroll
        for (int k = 0; k < 8; ++k) Sr[k] = nw[k];
    }
    float* so = a.out + O_PWKV + (size_t)chain * 4096 + i * 64 + j0;
    *(f32x4*)so = (f32x4){Sr[0], Sr[1], Sr[2], Sr[3]}; *(f32x4*)(so + 4) = (f32x4){Sr[4], Sr[5], Sr[6], Sr[7]};
}
DI bf16x8 cvt8(const f32x4 lo, const f32x4 hi) { u32x4 p; p.x = pk2(lo.x, lo.y); p.y = pk2(lo.z, lo.w); p.z = pk2(hi.x, hi.y); p.w = pk2(hi.z, hi.w); return __builtin_bit_cast(bf16x8, p); }
DI void scan_pass3_unit(const Args& a, int unit, int lane) {
    const float* SST = (const float*)(a.ws + WS_SST); const bf16_t* YL = (const bf16_t*)(a.ws + WS_YL); const bf16_t* QS = (const bf16_t*)(a.ws + WS_QS); const bf16_t* GB = (const bf16_t*)(a.ws + WS_GB);
    bf16_t* O = (bf16_t*)(a.ws + WS_O);
    const int sub = unit & 3, pair = unit >> 2, chain = pair / NS, seg = pair % NS, b = chain >> 4, h = chain & 15;
    const int r = lane & 31, hh = lane >> 5;
    const int m = b * SEQ + seg * SEGL + sub * 32 + r;
    f32x16 acc0, acc1;
#pragma unroll
    for (int i = 0; i < 16; ++i) { acc0[i] = 0.f; acc1[i] = 0.f; }
    const bf16_t* qrow = QS + (size_t)m * 1024 + h * 64 + 8 * hh;
    const float* s0 = SST + (size_t)pair * 4096 + (size_t)r * 64 + 8 * hh; const float* s1 = s0 + 32 * 64;
#pragma unroll
    for (int ks = 0; ks < 4; ++ks) {
        const bf16x8 qf = *(const bf16x8*)(qrow + ks * 16);
        const bf16x8 a0 = cvt8(*(const f32x4*)(s0 + ks * 16), *(const f32x4*)(s0 + ks * 16 + 4));
        const bf16x8 a1 = cvt8(*(const f32x4*)(s1 + ks * 16), *(const f32x4*)(s1 + ks * 16 + 4));
        acc0 = __builtin_amdgcn_mfma_f32_32x32x16_bf16(a0, qf, acc0, 0, 0, 0);
        acc1 = __builtin_amdgcn_mfma_f32_32x32x16_bf16(a1, qf, acc1, 0, 0, 0);
    }
    const bf16_t* yl = YL + (size_t)m * 1024 + h * 64 + 4 * hh;
    float y[32]; float sum = 0.f;
#pragma unroll
    for (int rt = 0; rt < 2; ++rt)
#pragma unroll
        for (int g = 0; g < 4; ++g) { const u32x2 yw = *(const u32x2*)(yl + rt * 32 + 8 * g); const f32x4 v = {__uint_as_float(yw.x << 16), __uint_as_float(yw.x & 0xffff0000u), __uint_as_float(yw.y << 16), __uint_as_float(yw.y & 0xffff0000u)};
#pragma unroll
            for (int e = 0; e < 4; ++e) { const float yy = v[e] + (rt == 0 ? acc0[4 * g + e] : acc1[4 * g + e]); y[rt * 16 + 4 * g + e] = yy; sum += yy; } }
    sum += __shfl_xor(sum, 32);
    const float mean = sum * (1.f / 64.f);
    float vs = 0.f;
#pragma unroll
    for (int e = 0; e < 32; ++e) { y[e] -= mean; vs += y[e] * y[e]; }
    vs += __shfl_xor(vs, 32);
    const float rstd = rsqrtf(vs * (1.f / 64.f) + 64e-5f);
    const bf16_t* gb = GB + ((size_t)m * 16 + h) * 128 + 4 * hh;
    const float* lw = a.in[I_LNW] + h * 64 + 4 * hh; const float* lb = a.in[I_LNB] + h * 64 + 4 * hh;
    bf16_t* orow = O + (size_t)m * D + 1024 + h * 64 + 4 * hh;
#pragma unroll
    for (int rt = 0; rt < 2; ++rt)
#pragma unroll
        for (int g = 0; g < 4; ++g) {
            const int off = rt * 32 + 8 * g;
            const f32x4 w4 = *(const f32x4*)(lw + off), b4 = *(const f32x4*)(lb + off);
            const u32x2 gw = *(const u32x2*)(gb + off), bw = *(const u32x2*)(gb + 64 + off);
            const float gg[4] = {__uint_as_float(gw.x << 16), __uint_as_float(gw.x & 0xffff0000u), __uint_as_float(gw.y << 16), __uint_as_float(gw.y & 0xffff0000u)};
            const float bb[4] = {__uint_as_float(bw.x << 16), __uint_as_float(bw.x & 0xffff0000u), __uint_as_float(bw.y << 16), __uint_as_float(bw.y & 0xffff0000u)};
            float o[4];
#pragma unroll
            for (int e = 0; e < 4; ++e) o[e] = (y[rt * 16 + 4 * g + e] * rstd * w4[e] + b4[e] + bb[e]) * gg[e];
            u32x2 w; w.x = pk2(o[0], o[1]); w.y = pk2(o[2], o[3]);
            *(u32x2*)(orow + off) = w;
        }
}

DI void unpack8(const u32x4 w, float (&u)[8]) {
    u[0] = __uint_as_float(w.x << 16); u[1] = __uint_as_float(w.x & 0xffff0000u); u[2] = __uint_as_float(w.y << 16); u[3] = __uint_as_float(w.y & 0xffff0000u);
    u[4] = __uint_as_float(w.z << 16); u[5] = __uint_as_float(w.z & 0xffff0000u); u[6] = __uint_as_float(w.w << 16); u[7] = __uint_as_float(w.w & 0xffff0000u);
}
constexpr int CONV_NCH = (256 * NTHREADS) / (FF / 8);
DI void conv_sweep(const Args& a, int idx) {
    const int fg = idx % (FF / 8), cls = idx / (FF / 8), f = fg * 8;
    if (cls >= CONV_NCH) return;
    const bf16_t* U = (const bf16_t*)(a.ws + WS_U); bf16_t* ACT = (bf16_t*)(a.ws + WS_ACT);
    const float* cw = a.in[I_FCW]; const float* cb = a.in[I_FCB];
    float w0[2][8], w1[2][8], w2[2][8], bb[2][8];
#pragma unroll
    for (int p = 0; p < 2; ++p)
#pragma unroll
        for (int j = 0; j < 8; ++j) { const int col = p * FF + f + j; w0[p][j] = cw[col]; w1[p][j] = cw[FF2 + col]; w2[p][j] = cw[2 * FF2 + col]; bb[p][j] = cb[col]; }
    for (int m = cls; m < MT; m += CONV_NCH) {
        u32x4 x0[2], x1[2], x2[2];
        const bool pr = m < MP; const int t = m & (SEQ - 1);
#pragma unroll
        for (int p = 0; p < 2; ++p) {
            const bf16_t* up = U + (size_t)m * FF2 + p * FF + f;
            x0[p] = *(const u32x4*)up; x1[p] = (u32x4){0u, 0u, 0u, 0u}; x2[p] = (u32x4){0u, 0u, 0u, 0u};
            if (pr && t >= 1) x1[p] = *(const u32x4*)(up - FF2);
            if (pr && t >= 2) x2[p] = *(const u32x4*)(up - 2 * FF2);
        }
        float u0[2][8], u1[2][8], u2[2][8];
#pragma unroll
        for (int p = 0; p < 2; ++p) { unpack8(x0[p], u0[p]); unpack8(x1[p], u1[p]); unpack8(x2[p], u2[p]); }
        if (!pr) {
#pragma unroll
            for (int p = 0; p < 2; ++p) {
                const float* st = a.in[I_SFFN] + (size_t)(m - MP) * 2 * FF2 + p * FF + f;
                float* so = a.out + O_SFFN + (size_t)(m - MP) * 2 * FF2 + p * FF + f;
#pragma unroll
                for (int j = 0; j < 8; ++j) { u2[p][j] = st[j]; u1[p][j] = st[FF2 + j]; so[j] = u1[p][j]; }
            }
        }
        float o[8];
#pragma unroll
        for (int j = 0; j < 8; ++j) {
            const float gt = bb[0][j] + w0[0][j] * u2[0][j] + w1[0][j] * u1[0][j] + w2[0][j] * u0[0][j];
            const float vl = bb[1][j] + w0[1][j] * u2[1][j] + w1[1][j] * u1[1][j] + w2[1][j] * u0[1][j];
            o[j] = gt * __builtin_amdgcn_rcpf(1.f + __expf(-gt)) * vl;
        }
        u32x4 w; w.x = pk2(o[0], o[1]); w.y = pk2(o[2], o[3]); w.z = pk2(o[4], o[5]); w.w = pk2(o[6], o[7]);
        *(u32x4*)(ACT + (size_t)m * FF + f) = w;
    }
}

#define XB_TMO      128
#define XB_XCNT(j)  (256  + 64 * (j))
#define XB_XSUB(j)  (1280 + 64 * (j))
#define XB_XGEN(j)  (2304 + 64 * (j))
#define XB_TOP      3328
#define XB_TOPGEN   3392
#define XCD_BAR_WORDS 3456
#define XB_SPIN_CAP (1u << 18)
DI unsigned xb_ld(unsigned* p)              { return __hip_atomic_load(p, __ATOMIC_RELAXED, __HIP_MEMORY_SCOPE_AGENT); }
DI unsigned xb_add(unsigned* p, unsigned v) { return __hip_atomic_fetch_add(p, v, __ATOMIC_RELAXED, __HIP_MEMORY_SCOPE_AGENT); }
DI unsigned xb_xcc_id() { return (unsigned)__builtin_amdgcn_s_getreg((3 << 11) | 20) & 0xFu; }
#define XB_SPIN(cond, bar) do { unsigned _sp = 0; while (cond) { __builtin_amdgcn_s_sleep(1); \
    if ((++_sp & 255u) == 0u) { if (xb_ld(&(bar)[XB_TMO])) break; if (_sp > XB_SPIN_CAP) { atomicAdd(&(bar)[XB_TMO], 1u); break; } } } } while (0)
struct XcdBarrier { unsigned* bar; unsigned x; volatile LAS unsigned* st; };
DI XcdBarrier xcd_barrier_post(unsigned* bar, volatile LAS unsigned* st) {
    XcdBarrier b; b.bar = bar; b.x = xb_xcc_id(); b.st = st;
    if (threadIdx.x == 0) (void)xb_add(&bar[XB_XCNT(b.x)], 1u);
    return b;
}
DI void xcd_barrier_complete(unsigned* bar, unsigned x, unsigned& nloc, unsigned& nx) {
    const unsigned G = gridDim.x * gridDim.y * gridDim.z;
    unsigned sum, cnt, mine, sp = 0u;
    for (;;) {
        sum = 0u; cnt = 0u; mine = 0u;
#pragma unroll
        for (unsigned j = 0; j < 16; ++j) { const unsigned c = xb_ld(&bar[XB_XCNT(j)]); sum += c; cnt += (c > 0u) ? 1u : 0u; mine = (j == x) ? c : mine; }
        if (sum == G) break;
        __builtin_amdgcn_s_sleep(1);
        if ((++sp & 255u) == 0u) { if (xb_ld(&bar[XB_TMO])) break; if (sp > XB_SPIN_CAP) { atomicAdd(&bar[XB_TMO], 1u); break; } }
    }
    nloc = mine > 0u ? mine : 1u; nx = cnt > 0u ? cnt : 1u;
}
DI void xcd_barrier(const XcdBarrier& b) {
    asm volatile("s_waitcnt vmcnt(0)" ::: "memory");
    __syncthreads();
    if (threadIdx.x == 0) {
        unsigned* bar = b.bar;
        __builtin_amdgcn_s_waitcnt(0);
        unsigned nloc = b.st[0], nx = b.st[1];
        if (nloc == 0u) { xcd_barrier_complete(bar, b.x, nloc, nx); b.st[0] = nloc; b.st[1] = nx; }
        const unsigned old = xb_add(&bar[XB_XSUB(b.x)], 1u);
        const unsigned gen = old / nloc;
        if (old + 1u == (gen + 1u) * nloc) {
            __builtin_amdgcn_fence(__ATOMIC_RELEASE, "agent");
            asm volatile("s_waitcnt vmcnt(0)" ::: "memory");
            const unsigned og = xb_add(&bar[XB_TOP], 1u);
            const unsigned tg = og / nx;
            if (og + 1u == (tg + 1u) * nx) xb_add(&bar[XB_TOPGEN], 1u);
            else XB_SPIN(xb_ld(&bar[XB_TOPGEN]) == tg, bar);
            __builtin_amdgcn_fence(__ATOMIC_ACQUIRE, "agent");
            xb_add(&bar[XB_XGEN(b.x)], 1u);
            asm volatile("s_waitcnt vmcnt(0)" ::: "memory");
        } else {
            XB_SPIN(xb_ld(&bar[XB_XGEN(b.x)]) == gen, bar);
            __builtin_amdgcn_fence(__ATOMIC_ACQUIRE, "agent");
            asm volatile("s_waitcnt vmcnt(0)" ::: "memory");
        }
    }
    __syncthreads();
}

DI void skinny_unit(const bf16_t* A, int lda, const bf16_t* Bt, int K, int unit, const float* base, int ldb, float* out, int ldo, unsigned char* lds, int wave, int lane,
                    const float* gf = nullptr, bf16_t* H = nullptr, float* RSS = nullptr) {
    float* red = (float*)lds;
    const int n0 = unit * 32, r = lane & 31, hh = lane >> 5, kw = K / 8, kb = wave * kw;
    f32x16 acc;
#pragma unroll
    for (int i = 0; i < 16; ++i) acc[i] = 0.f;
    const bf16_t* ap = A + (size_t)r * lda + kb + 8 * hh; const bf16_t* bp = Bt + (size_t)(n0 + r) * K + kb + 8 * hh;
#pragma unroll 4
    for (int k = 0; k < kw; k += 16) {
        const bf16x8 af = *(const bf16x8*)(ap + k), bf = *(const bf16x8*)(bp + k);
        acc = __builtin_amdgcn_mfma_f32_32x32x16_bf16(af, bf, acc, 0, 0, 0);
    }
#pragma unroll
    for (int i = 0; i < 16; ++i) red[(wave * 16 + i) * 64 + lane] = acc[i];
    __syncthreads();
#pragma unroll
    for (int q = 0; q < 2; ++q) {
        const int o = threadIdx.x + 512 * q, i = o >> 6, ln = o & 63;
        float sum = 0.f;
#pragma unroll
        for (int w = 0; w < 8; ++w) sum += red[(w * 16 + i) * 64 + ln];
        const int row = crow(i, ln >> 5), col = n0 + (ln & 31);
        const float x1 = base[(size_t)row * ldb + col] + sum * (H ? 1.0f : MK_P11_SCALE);
        out[(size_t)row * ldo + col] = x1;
        if (H) { H[(size_t)row * D + col] = (bf16_t)bf_rne(x1 * gf[col]);
            float ss = x1 * x1;
            ss += __shfl_xor(ss, 1); ss += __shfl_xor(ss, 2); ss += __shfl_xor(ss, 4); ss += __shfl_xor(ss, 8); ss += __shfl_xor(ss, 16);
            if ((ln & 31) == 0) atomic_add_f32(RSS + row, ss); }
    }
    __syncthreads();
}

constexpr int NPH = 14;
template <bool COOP>
__global__ void __launch_bounds__(NTHREADS, 2) mk_fwd(Args a) {
    extern __shared__ __attribute__((aligned(16))) unsigned char lds[];
    const int tid = threadIdx.x, lane = tid & 63, wave = __builtin_amdgcn_readfirstlane(tid >> 6);
    const int G = gridDim.x, bid = blockIdx.x, gw = bid * NWAVES + wave, ngw = G * NWAVES;
    unsigned char* ws = a.ws;
    LAS unsigned char* ldsl = (LAS unsigned char*)lds;
#ifndef PHMASK
#define PHMASK 0xffff
#endif
#define IN(k) (((PHMASK >> (k)) & 1) && a.ph_lo <= (k) && (k) < a.ph_hi)
    XcdBarrier xbar; xbar.bar = (unsigned*)(ws + WS_BAR); xbar.x = 0; xbar.st = nullptr;
    if (COOP) {
        volatile LAS unsigned* st = (volatile LAS unsigned*)(ldsl + LDS_BYTES - 16);
        if (tid < 4) st[tid] = 0u;
        __syncthreads();
        xbar = xcd_barrier_post((unsigned*)(ws + WS_BAR), st);
    }
#define SEAM(k) do { if (COOP && IN(k) && IN((k) + 1)) { if ((k) == 0) cg::this_grid().sync(); else xcd_barrier(xbar); } } while (0)

    if (IN(0)) phase_prologue(a, lds, gw, ngw, lane, wave);
    SEAM(0);
    if (IN(1)) {
        pg8::Gemm g{(const bf16_t*)(ws + WS_H), (const bf16_t*)(ws + WS_WIN), MPAD, NIN, D}; pg8::StaticOrder S; S.init(MPAD, NIN, G, bid);
        EpiIn E{(bf16_t*)(ws + WS_QB), (bf16_t*)(ws + WS_KB), (bf16_t*)(ws + WS_VB), (bf16_t*)(ws + WS_RW), a.out};
        pg8::gemm_phase<EpiIn>(ldsl, g, S, E);
        {
            const int nu = (MPAD / 256) * (NIN / 256), rem = nu % G, first = rem == 0 ? 0 : rem, nfree = G - first;
            if (bid >= first) convert_wo_wup(a, lds, (bid - first) * NWAVES + wave, nfree * NWAVES, wave, lane);
        }
    }
    SEAM(1);
    if (IN(2)) {
        for (int u = bid; u < 256; u += G) attn_sample_wg(a, lds, u, wave, lane);
        for (int u = gw; u < 64 * 3 * 64; u += ngw) attn_prompt_unit(a, lds, u, wave, lane);
        for (int m = gw; m < MPAD; m += ngw) lora_input_row(a, m, lane);
    }
    SEAM(2);
    if (IN(3)) {
        pg8::Gemm g{(const bf16_t*)(ws + WS_ALO), (const bf16_t*)(ws + WS_WLO), MPAD, NLO, KLO}; pg8::StaticOrder S; S.init(MPAD, NLO, G, bid);
        EpiBf E{(bf16_t*)(ws + WS_L), NLO};
        pg8::gemm_phase<EpiBf>(ldsl, g, S, E);
#pragma unroll 2
        for (int t = gw; t < MP * 4; t += ngw) attn_merge_task(a, t, lane);
    }
    SEAM(3);
    if (IN(4)) {
#ifndef NO_P1
        for (int u = bid; u < 64 * NS / 4; u += G) scan_pass1_unit(a, lds, u, wave, lane);
#endif

    }
    SEAM(4);
    if (IN(5)) {
        if (G >= 128) {
            if (bid < 64) scan_pass2_unit(a, lds, bid, wave, lane);
            else for (int u = (bid - 64) * NWAVES + wave; u < 512; u += (G - 64) * NWAVES) scan_sample_unit(a, lds, u, wave, lane);
        } else {
            for (int ch = bid; ch < 64; ch += G) scan_pass2_unit(a, lds, ch, wave, lane);
            for (int u = gw; u < 512; u += ngw) scan_sample_unit(a, lds, u, wave, lane);
        }
    }
    SEAM(5);
    if (IN(6)) { for (int u = gw; u < 64 * NS * 4; u += ngw) scan_pass3_unit(a, u, lane); }
    SEAM(6);
    if (IN(7)) {
        pg8::Gemm g{(const bf16_t*)(ws + WS_O), (const bf16_t*)(ws + WS_WO), MP, D, D}; pg8::StaticOrder S; S.init(MP, D, G, bid);
        EpiWo E{a.in[I_XP], a.in[I_NFG], (float*)(ws + WS_X1), (bf16_t*)(ws + WS_H), (float*)(ws + WS_RSS)};
        pg8::gemm_phase<EpiWo>(ldsl, g, S, E);
        for (int u = bid; u < D / 32; u += G)
            skinny_unit((const bf16_t*)(ws + WS_O) + (size_t)MP * D, D, (const bf16_t*)(ws + WS_WO), D, u, a.in[I_XS], D, (float*)(ws + WS_X1) + (size_t)MP * D, D, lds, wave, lane,
                        a.in[I_NFG], (bf16_t*)(ws + WS_H) + (size_t)MP * D, (float*)(ws + WS_RSS) + MP);
    }
    SEAM(7);
    if (IN(9)) {
        pg8::Gemm g{(const bf16_t*)(ws + WS_H), (const bf16_t*)(ws + WS_WUP), MPAD, FF2, D}; pg8::StaticOrder S; S.init(MPAD, FF2, G, bid);
        EpiUp E{(bf16_t*)(ws + WS_U), a.out, (const float*)(ws + WS_RSS)};
        pg8::gemm_phase<EpiUp>(ldsl, g, S, E);
        {
            const int nu = (MPAD / 256) * (FF2 / 256), rem = nu % G, first = rem == 0 ? 0 : rem, nfree = G - first;
            if (bid >= first) convert_wdn(a, lds, (bid - first) * NWAVES + wave, nfree * NWAVES, wave, lane);
        }
    }
    SEAM(9);
    if (IN(10)) { if (G == 256) conv_sweep(a, bid * NTHREADS + tid); else for (int it = bid * NTHREADS + tid; it < CONV_NCH * (FF / 8); it += G * NTHREADS) conv_sweep(a, it); }
    SEAM(10);
    if (IN(11)) {
        pg8::Gemm g{(const bf16_t*)(ws + WS_ACT), (const bf16_t*)(ws + WS_WDN), MP, D, FF}; pg8::StaticOrder S; S.init(MP, D, G, bid);
        EpiDn E{(float*)(ws + WS_X1)};
        pg8::gemm_phase<EpiDn>(ldsl, g, S, E);
        for (int u = bid; u < D / 32; u += G)
            skinny_unit((const bf16_t*)(ws + WS_ACT) + (size_t)MP * FF, FF, (const bf16_t*)(ws + WS_WDN), FF, u, (const float*)(ws + WS_X1) + (size_t)MP * D, D, (float*)(ws + WS_X1) + (size_t)MP * D, D, lds, wave, lane);
    }
    SEAM(11);
    if (IN(12)) {
        for (int m = gw; m < MT; m += ngw)
            rms_row_f32((const float*)(ws + WS_X1) + (size_t)m * D, a.in[I_NFIN], m < MP ? a.out + O_YP + (size_t)m * D : a.out + O_YS + (size_t)(m - MP) * D, lane);
    }
#undef IN
#undef SEAM
}

#ifndef MK_ONE_LAUNCH
#define MK_ONE_LAUNCH 1
#endif
#ifndef MK_DBL_MASK
#define MK_DBL_MASK 0x0
#endif

extern "C" void kernel_launch(void* const* d_in, const int* in_sizes, int n_in, void* d_out, int out_size, void* d_ws, size_t ws_size, hipStream_t stream) {
    static int grid = 0;
    if (!grid) {
        if (n_in != 28 || (size_t)out_size != O_END || ws_size < WS_END) fprintf(stderr, "kernel_launch: unexpected shapes: n_in %d out %d (want %zu) ws %zu (want %zu)\n", n_in, out_size, O_END, ws_size, WS_END);
        int dev = 0, cus = 0; hipGetDevice(&dev); hipDeviceGetAttribute(&cus, hipDeviceAttributeMultiprocessorCount, dev);
        hipFuncSetAttribute((const void*)mk_fwd<true>, hipFuncAttributeMaxDynamicSharedMemorySize, LDS_BYTES);
        hipFuncSetAttribute((const void*)mk_fwd<false>, hipFuncAttributeMaxDynamicSharedMemorySize, LDS_BYTES);
        int per_cu = 0; hipOccupancyMaxActiveBlocksPerMultiprocessor(&per_cu, mk_fwd<true>, NTHREADS, LDS_BYTES);
        if (per_cu < 1) { fprintf(stderr, "kernel_launch: occupancy query says %d blocks/CU\n", per_cu); per_cu = 1; }
        grid = cus > 0 ? cus : 256;
    }
    Args a; memset(&a, 0, sizeof(a));
    for (int i = 0; i < 28; ++i) a.in[i] = (const float*)d_in[i];
    a.out = (float*)d_out; a.ws = (unsigned char*)d_ws;
#if MK_ONE_LAUNCH
    if (hipMemsetAsync((char*)d_ws + WS_BAR, 0, BAR_BYTES, stream) != hipSuccess) { fprintf(stderr, "kernel_launch: memset of the barrier words failed\n"); return; }
    a.ph_lo = 0; a.ph_hi = NPH;
    void* args[] = {&a};
    hipError_t e = hipLaunchCooperativeKernel((const void*)mk_fwd<true>, dim3(grid), dim3(NTHREADS), args, LDS_BYTES, stream);
    if (e != hipSuccess) fprintf(stderr, "cooperative launch failed: %s (grid %d)\n", hipGetErrorString(e), grid);
#else
    for (int p = 0; p < 13; ++p) {
        a.ph_lo = p; a.ph_hi = p + 1;
        mk_fwd<false><<<dim3(grid), dim3(NTHREADS), LDS_BYTES, stream>>>(a);
        if ((MK_DBL_MASK >> p) & 1) mk_fwd<false><<<dim3(grid), dim3(NTHREADS), LDS_BYTES, stream>>>(a);
    }
#endif
}
```

```cpp
#include <hip/hip_runtime.h>
#include <hip/hip_cooperative_groups.h>
#include <cstdio>
#include <cstdint>
#include <cstring>
namespace cg = cooperative_groups;

#define DI __device__ __forceinline__
#define LAS __attribute__((address_space(3)))
typedef unsigned short bf16_t;
typedef short bf16x8 __attribute__((ext_vector_type(8)));
typedef float f32x4 __attribute__((ext_vector_type(4)));
typedef float f32x16 __attribute__((ext_vector_type(16)));
typedef unsigned u32x4 __attribute__((ext_vector_type(4)));
typedef unsigned u32x2 __attribute__((ext_vector_type(2)));

constexpr int D = 2048, MP = 8192, MS = 32, MT = 8224, MPAD = 8448, SEQ = 2048;
constexpr int CIN = 6432, NIN = 6656, CSH = 3360, FF2 = 11264, FF = 5632;
constexpr int NLO = 3072, KLO = 384;
constexpr int NS = 16, SEGL = 128, TB = 8;
constexpr int NTHREADS = 512, NWAVES = 8;
constexpr int LDS_BYTES = 131072 + 16384;

constexpr size_t O_YP = 0;
constexpr size_t O_YS = O_YP + (size_t)MP * D;
constexpr size_t O_PK = O_YS + (size_t)MS * D;
constexpr size_t O_PV = O_PK + (size_t)MP * 1024;
constexpr size_t O_PRW = O_PV + (size_t)MP * 1024;
constexpr size_t O_PWKV = O_PRW + (size_t)4 * CSH;
constexpr size_t O_PFFN = O_PWKV + (size_t)4 * 16 * 4096;
constexpr size_t O_SK = O_PFFN + (size_t)4 * 2 * FF2;
constexpr size_t O_SV = O_SK + (size_t)MS * 1024;
constexpr size_t O_SRW = O_SV + (size_t)MS * 1024;
constexpr size_t O_SWKV = O_SRW + (size_t)MS * CSH;
constexpr size_t O_SFFN = O_SWKV + (size_t)MS * 16 * 4096;
constexpr size_t O_END = O_SFFN + (size_t)MS * 2 * FF2;

constexpr size_t al256(size_t x) { return (x + 255) & ~(size_t)255; }
constexpr size_t WS_WIN = 0;
constexpr size_t WS_WO = WS_WIN + al256((size_t)NIN * D * 2);
constexpr size_t WS_WUP = WS_WO + al256((size_t)D * D * 2);
constexpr size_t WS_WDN = WS_WUP + al256((size_t)FF2 * D * 2);
constexpr size_t WS_WLO = WS_WDN + al256((size_t)D * FF * 2);
constexpr size_t WS_H = WS_WLO + al256((size_t)NLO * KLO * 2);
constexpr size_t WS_QB = WS_H + al256((size_t)MPAD * D * 2);
constexpr size_t WS_KB = WS_QB + al256((size_t)MPAD * 1024 * 2);
constexpr size_t WS_VB = WS_KB + al256((size_t)MPAD * 1024 * 2);
constexpr size_t WS_ALO = WS_VB + al256((size_t)MPAD * 1024 * 2);
constexpr size_t WS_O = WS_ALO + al256((size_t)MPAD * KLO * 2);
constexpr size_t WS_GB = WS_O + al256((size_t)MPAD * D * 2);
constexpr size_t WS_YL = WS_GB + al256((size_t)MT * 2048 * 2);
constexpr size_t WS_QS = WS_YL + al256((size_t)MP * 1024 * 2);
constexpr size_t WS_ZP = WS_QS + al256((size_t)MP * 1024 * 2);
constexpr size_t WS_SST = WS_ZP + al256((size_t)64 * NS * 2 * 4096 * 4);
constexpr size_t WS_X1 = WS_SST + al256((size_t)64 * NS * 4096 * 4);
constexpr size_t WS_PML = WS_X1 + al256((size_t)MPAD * D * 4);
constexpr size_t WS_RA = WS_PML + al256((size_t)3 * MP * 16 * 2 * 4);
constexpr size_t WS_RW = WS_RA;
constexpr size_t WS_L = WS_RW + al256((size_t)MPAD * CSH * 2);
constexpr size_t RA_BYTES_1 = al256((size_t)MPAD * CSH * 2) + al256((size_t)MPAD * NLO * 2);
constexpr size_t RA_BYTES_2 = al256((size_t)MPAD * FF2 * 2);
constexpr size_t WS_U = WS_RA;
constexpr size_t WS_RB = WS_RA + (RA_BYTES_1 > RA_BYTES_2 ? RA_BYTES_1 : RA_BYTES_2);
constexpr size_t WS_PART = WS_RB;
constexpr size_t WS_ACT = WS_RB;
constexpr size_t RB_BYTES_1 = al256((size_t)3 * MP * 1024 * 2);
constexpr size_t RB_BYTES_2 = al256((size_t)MPAD * FF * 2);
constexpr size_t WS_RSS = WS_RB + (RB_BYTES_1 > RB_BYTES_2 ? RB_BYTES_1 : RB_BYTES_2);
constexpr size_t WS_BAR_ = 0; constexpr size_t WS_BAR = al256((size_t)MPAD * 4) + WS_RB + (RB_BYTES_1 > RB_BYTES_2 ? RB_BYTES_1 : RB_BYTES_2);
constexpr size_t BAR_BYTES = 16384;
constexpr size_t WS_END = WS_BAR + BAR_BYTES;

struct Args {
    const float* in[28];
    float* out;
    unsigned char* ws;
    int ph_lo, ph_hi;
};
enum { I_XP = 0, I_XS, I_CK, I_CV, I_SSH, I_SWKV, I_SFFN, I_NMG, I_WIN, I_AOG, I_MU, I_W0, I_WUP, I_A0, I_AUP, I_GUP,
       I_KK, I_KA, I_RK, I_LNW, I_LNB, I_WO, I_NFG, I_FUP, I_FCW, I_FCB, I_FDN, I_NFIN };

typedef float f32x2c __attribute__((ext_vector_type(2)));
typedef __bf16 bf16x2c __attribute__((ext_vector_type(2)));
DI unsigned pk2(float lo, float hi) { const f32x2c v = {lo, hi}; return __builtin_bit_cast(unsigned, __builtin_convertvector(v, bf16x2c)); }
DI unsigned bf_rne(float f) { return pk2(f, 0.f) & 0xffffu; }
DI unsigned cvt_pk(float lo, float hi) { return pk2(lo, hi); }
DI void atomic_add_f32(float* p, float v) { (void)__builtin_amdgcn_global_atomic_fadd_f32((__attribute__((address_space(1))) float*)p, v); }
DI float bf2f(unsigned short b) { return __uint_as_float(((unsigned)b) << 16); }
#define DPP_ADD(v, ctrl) ((v) + __int_as_float(__builtin_amdgcn_update_dpp(0, __float_as_int(v), (ctrl), 0xf, 0xf, false)))
DI float wave_sum(float v) {
    v = DPP_ADD(v, 0xB1);
    v = DPP_ADD(v, 0x4E);
    v = DPP_ADD(v, 0x141);
    v = DPP_ADD(v, 0x140);
    const float s0 = __int_as_float(__builtin_amdgcn_readlane(__float_as_int(v), 0)), s1 = __int_as_float(__builtin_amdgcn_readlane(__float_as_int(v), 16));
    const float s2 = __int_as_float(__builtin_amdgcn_readlane(__float_as_int(v), 32)), s3 = __int_as_float(__builtin_amdgcn_readlane(__float_as_int(v), 48));
    return (s0 + s1) + (s2 + s3);
}

namespace pg8 {
constexpr int BM = 256, BK = 64, HALF = 128, HTB = HALF * BK * 2, STAGE_BYTES = 8 * HTB, NXCD = 8, WGM = 8;
DI int lds_byte(int r, int c) { const int st = (r >> 4) * 2 + (c >> 5), rr = r & 15, cc = c & 31, ob = rr * 64 + cc * 2; return st * 1024 + (ob ^ (((ob >> 9) & 1) << 5)); }
DI void stage_rc(int b, int& R, int& C) { const int st = b / 1024, sb = b % 1024, swz = sb ^ (((sb >> 9) & 1) << 5); R = (st >> 1) * 16 + swz / 64; C = (st & 1) * 32 + (swz % 64) / 2; }
struct Unit { int pm, pn; };
struct Gemm { const bf16_t* A; const bf16_t* Bt; int M, N, K; };
struct StaticOrder {
    int nM, nN, nwg, G, c;
    DI void init(int M, int N, int G_, int c_) { nM = M / BM; nN = N / BM; nwg = nM * nN; G = G_; c = c_; }
    DI bool next(int i, Unit& u) const {
        const long L = (long)i * G + c; if (L >= nwg) return false;
        int wgid = (int)L; { const int q = nwg / NXCD, r = nwg % NXCD, xcd = wgid % NXCD, off = wgid / NXCD; wgid = (xcd < r ? xcd * (q + 1) : r * (q + 1) + (xcd - r) * q) + off; }
        const int nig = WGM * nN, gid = wgid / nig, fm = gid * WGM, gsz = (nM - fm) < WGM ? (nM - fm) : WGM;
        u.pm = fm + ((wgid % nig) % gsz); u.pn = (wgid % nig) / gsz; return true;
    }
};

template <class Epi>
DI void gemm_phase(LAS unsigned char* lds, const Gemm g, const StaticOrder& S, const Epi& E) {
    const int tid = threadIdx.x, wid = __builtin_amdgcn_readfirstlane(tid >> 6), lane = tid & 63, wr = wid >> 2, wc = wid & 3, fr = lane & 15, fq = lane >> 4;
    const int K = g.K, nt = K / BK;
    unsigned voffA[2];
#pragma unroll
    for (int i = 0; i < 2; ++i) { int R, C; stage_rc(tid * 16 + i * 8192, R, C); voffA[i] = (unsigned)(R * K + C) * 2u; }
    const size_t kstep = (size_t)(BK * 2);
    const size_t hstep = (size_t)HALF * K * 2;
    const size_t tstep = 2 * hstep;
    const unsigned ldsw = (unsigned)wid * 1024u;
    const int aoff = lds_byte(wr * 64 + fr, fq * 8), boff = lds_byte(wc * 32 + fr, fq * 8);
#define PG8_SA(b, h) (((b) * 2 + (h)) * HTB)
#define PG8_SB(b, h) ((4 + (b) * 2 + (h)) * HTB)
#define PG8_STAGE(bufoff, gbase, voff) do { _Pragma("unroll") for (int _i = 0; _i < 2; ++_i) \
        __builtin_amdgcn_global_load_lds((const unsigned*)((const char*)(gbase) + (voff)[_i]), (LAS unsigned*)(lds + (bufoff) + ldsw + _i * 8192), 16, 0, 0); } while (0)
#define PG8_LDA(dst, b, h) do { _Pragma("unroll") for (int m = 0; m < 4; ++m) _Pragma("unroll") for (int k = 0; k < 2; ++k) dst[m][k] = *(const LAS bf16x8*)(lds + PG8_SA(b, h) + aoff + m * 2048 + k * 1024); } while (0)
#define PG8_LDB(dst, b, h) do { _Pragma("unroll") for (int n = 0; n < 2; ++n) _Pragma("unroll") for (int k = 0; k < 2; ++k) dst[n][k] = *(const LAS bf16x8*)(lds + PG8_SB(b, h) + boff + n * 2048 + k * 1024); } while (0)
#define PG8_MMA(ai, bj, At, Bt) do { __builtin_amdgcn_s_setprio(1); _Pragma("unroll") for (int m = 0; m < 4; ++m) _Pragma("unroll") for (int n = 0; n < 2; ++n) _Pragma("unroll") for (int k = 0; k < 2; ++k) \
        acc[ai][bj][m][n] = __builtin_amdgcn_mfma_f32_16x16x32_bf16(Bt[n][k], At[m][k], acc[ai][bj][m][n], 0, 0, 0); __builtin_amdgcn_s_setprio(0); } while (0)
#define PG8_WAIT_V(n) asm volatile("s_waitcnt vmcnt(" #n ")" ::: "memory")
#define PG8_WAIT_L(n) asm volatile("s_waitcnt lgkmcnt(" #n ")" ::: "memory")
#define PG8_BAR __builtin_amdgcn_s_barrier()
#define PG8_SCHED __builtin_amdgcn_sched_barrier(0)
    Unit cur, nxt; int ui = 0;
    if (!S.next(0, cur)) return;
    f32x4 acc[2][2][4][2];
#pragma unroll
    for (int a = 0; a < 2; ++a)
#pragma unroll
        for (int b = 0; b < 2; ++b)
#pragma unroll
            for (int m = 0; m < 4; ++m)
#pragma unroll
                for (int n = 0; n < 2; ++n) acc[a][b][m][n] = (f32x4){0.f, 0.f, 0.f, 0.f};
    bf16x8 At[4][2], B0[2][2], B1[2][2];
    const char* cA = (const char*)g.A + (size_t)cur.pm * tstep; const char* cB = (const char*)g.Bt + (size_t)cur.pn * tstep;
    PG8_STAGE(PG8_SB(0, 0), cB, voffA); PG8_STAGE(PG8_SA(0, 0), cA, voffA); PG8_STAGE(PG8_SB(0, 1), cB + hstep, voffA); PG8_STAGE(PG8_SA(0, 1), cA + hstep, voffA);
    if (wr == 1) PG8_BAR;
    PG8_WAIT_V(4); PG8_BAR;
    PG8_STAGE(PG8_SB(1, 0), cB + kstep, voffA); PG8_STAGE(PG8_SA(1, 0), cA + kstep, voffA); PG8_STAGE(PG8_SB(1, 1), cB + hstep + kstep, voffA);
    PG8_WAIT_V(6); PG8_BAR;
    for (;;) {
        const bool has_next = S.next(ui + 1, nxt);
        const char* nA = has_next ? (const char*)g.A + (size_t)nxt.pm * tstep : cA; const char* nB = has_next ? (const char*)g.Bt + (size_t)nxt.pn * tstep : cB;
        for (int t = 0; t < nt; t += 2) {
            const bool last = (t == nt - 2);
            const char* a1 = cA + (size_t)(t + 1) * kstep;
            const char* a2 = last ? nA : cA + (size_t)(t + 2) * kstep; const char* b2 = last ? nB : cB + (size_t)(t + 2) * kstep;
            const char* a3 = a2 + kstep; const char* b3 = b2 + kstep;
            PG8_LDB(B0, 0, 0); PG8_SCHED; PG8_LDA(At, 0, 0); PG8_STAGE(PG8_SA(1, 1), a1 + hstep, voffA);
            PG8_WAIT_L(8); PG8_BAR; PG8_WAIT_L(0); PG8_MMA(0, 0, At, B0); PG8_BAR; PG8_SCHED;
            PG8_LDB(B1, 0, 1); PG8_STAGE(PG8_SB(0, 0), b2, voffA);
            PG8_BAR; PG8_WAIT_L(0); PG8_MMA(0, 1, At, B1); PG8_BAR;
            PG8_LDA(At, 0, 1); PG8_STAGE(PG8_SA(0, 0), a2, voffA);
            PG8_BAR; PG8_WAIT_L(0); PG8_MMA(1, 0, At, B0); PG8_BAR; PG8_SCHED;
            PG8_STAGE(PG8_SB(0, 1), b2 + hstep, voffA);
            PG8_WAIT_V(6); PG8_BAR; PG8_MMA(1, 1, At, B1); PG8_BAR;
            PG8_LDB(B0, 1, 0); PG8_SCHED; PG8_LDA(At, 1, 0); PG8_STAGE(PG8_SA(0, 1), a2 + hstep, voffA);
            PG8_WAIT_L(8); PG8_BAR; PG8_WAIT_L(0); PG8_MMA(0, 0, At, B0); PG8_BAR; PG8_SCHED;
            PG8_LDB(B1, 1, 1); PG8_STAGE(PG8_SB(1, 0), b3, voffA);
            PG8_BAR; PG8_WAIT_L(0); PG8_MMA(0, 1, At, B1); PG8_BAR;
            PG8_LDA(At, 1, 1); PG8_STAGE(PG8_SA(1, 0), a3, voffA);
            PG8_BAR; PG8_WAIT_L(0); PG8_MMA(1, 0, At, B0); PG8_BAR; PG8_SCHED;
            PG8_STAGE(PG8_SB(1, 1), b3 + hstep, voffA);
            PG8_WAIT_V(6); PG8_BAR; PG8_MMA(1, 1, At, B1); PG8_BAR;
        }
        E(acc, cur, wr, wc, fr, fq);
        if (!has_next) break;
#pragma unroll
        for (int a = 0; a < 2; ++a)
#pragma unroll
            for (int b = 0; b < 2; ++b)
#pragma unroll
                for (int m = 0; m < 4; ++m)
#pragma unroll
                    for (int n = 0; n < 2; ++n) acc[a][b][m][n] = (f32x4){0.f, 0.f, 0.f, 0.f};
        cur = nxt; cA = nA; cB = nB; ++ui;
    }
    PG8_WAIT_V(0);
    if (wr == 0) PG8_BAR;
    PG8_BAR;
#undef PG8_SA
#undef PG8_SB
#undef PG8_STAGE
#undef PG8_LDA
#undef PG8_LDB
#undef PG8_MMA
#undef PG8_WAIT_V
#undef PG8_WAIT_L
#undef PG8_BAR
#undef PG8_SCHED
}
}

DI size_t hm64(int row, int h)  { return ((size_t)((row >> 11) * 16 + h) * SEQ + (row & (SEQ - 1))) * 64; }
typedef f32x4 AccT[2][2][4][2];
#define EPI_LOOP_BEGIN \
    const int row0 = u.pm * 256 + wr * 64 + fr, col0 = u.pn * 256 + wc * 32 + 4 * fq; \
    _Pragma("unroll") for (int ai = 0; ai < 2; ++ai) _Pragma("unroll") for (int m = 0; m < 4; ++m) { const int row = row0 + ai * 128 + m * 16; \
    _Pragma("unroll") for (int bj = 0; bj < 2; ++bj) _Pragma("unroll") for (int n = 0; n < 2; ++n) { const int col = col0 + bj * 128 + n * 16; const f32x4 v = acc[ai][bj][m][n];
#define EPI_LOOP_END } }
#define EPI_LOOP_BEGIN_S \
    const int row0 = u.pm * 256 + wr * 64 + fr, col0 = u.pn * 256 + wc * 32 + 4 * fq; \
    _Pragma("unroll") for (int ai = 0; ai < 2; ++ai) _Pragma("unroll") for (int m = 0; m < 4; ++m) { const int row = row0 + ai * 128 + m * 16; \
    _Pragma("unroll") for (int bj = 0; bj < 2; ++bj) _Pragma("unroll") for (int n = 0; n < 2; ++n) { const int col = col0 + bj * 128 + n * 16; const f32x4 v = acc[ai][bj][m][n] * rs[ai][m];

struct EpiIn {
    bf16_t *Qb, *Kb, *Vb; bf16_t* RW; float* out;
    DI void operator()(const AccT& acc, const pg8::Unit& u, int wr, int wc, int fr, int fq) const {
        const int reg = u.pn < 4 ? 0 : (u.pn < 8 ? 1 : (u.pn < 12 ? 2 : 3));
        EPI_LOOP_BEGIN
            if (row < MT) {
                if (reg == 0) {
                    constexpr float QS_ = 0.125f * 1.44269504088896f;
                    u32x2 w; w.x = cvt_pk(v[0] * QS_, v[1] * QS_); w.y = cvt_pk(v[2] * QS_, v[3] * QS_);
                    *(u32x2*)(row < MP ? Qb + hm64(row, col >> 6) + (col & 63) : Qb + (size_t)row * 1024 + col) = w;
                } else if (reg == 1 || reg == 2) {
                    const int c = col - (reg == 1 ? 1024 : 2048);
                    float* o = row < MP ? out + (reg == 1 ? O_PK : O_PV) + (size_t)row * 1024 + c : out + (reg == 1 ? O_SK : O_SV) + (size_t)(row - MP) * 1024 + c;
                    *(f32x4*)o = v;
                    if (row < MP) { u32x2 w; w.x = cvt_pk(v[0], v[1]); w.y = cvt_pk(v[2], v[3]);
                        *(u32x2*)((reg == 1 ? Kb : Vb) + hm64(row, c >> 6) + (c & 63)) = w; }
                } else {
                    const int c = col - 3072;
                    if (c < CSH) {
                        { u32x2 w; w.x = cvt_pk(v[0], v[1]); w.y = cvt_pk(v[2], v[3]); *(u32x2*)(RW + (size_t)row * CSH + c) = w; }
                        if (row >= MP) *(f32x4*)(out + O_SRW + (size_t)(row - MP) * CSH + c) = v;
                        else if ((row & (SEQ - 1)) == SEQ - 1) *(f32x4*)(out + O_PRW + (size_t)(row >> 11) * CSH + c) = v;
                    }
                }
            }
        EPI_LOOP_END
    }
};
struct EpiBf {
    bf16_t* C; int ldc;
    DI void operator()(const AccT& acc, const pg8::Unit& u, int wr, int wc, int fr, int fq) const {
        const int row0 = u.pm * 256 + wr * 64 + fr, col0 = u.pn * 256 + wc * 32 + 4 * fq;
#pragma unroll
        for (int ai = 0; ai < 2; ++ai)
#pragma unroll
            for (int m = 0; m < 4; ++m) { const int row = row0 + ai * 128 + m * 16;
#pragma unroll
                for (int bj = 0; bj < 2; ++bj)
#pragma unroll
                    for (int n = 0; n < 2; ++n) { const int col = col0 + bj * 128 + n * 16; const f32x4 v = acc[ai][bj][m][n];
                        u32x2 w; w.x = cvt_pk(v[0], v[1]); w.y = cvt_pk(v[2], v[3]);
                        *(u32x2*)(C + (size_t)row * ldc + col) = w; }
                asm volatile("" ::: "memory");
            }
    }
};
struct EpiWo {
    const float *xp; const float* gf; float* X1; bf16_t* H; float* RSS;
    DI void operator()(const AccT& acc, const pg8::Unit& u, int wr, int wc, int fr, int fq) const {
        const int row0 = u.pm * 256 + wr * 64 + fr, col0 = u.pn * 256 + wc * 32 + 4 * fq;
#pragma unroll
        for (int ai = 0; ai < 2; ++ai)
#pragma unroll
            for (int m = 0; m < 4; ++m) {
                const int row = row0 + ai * 128 + m * 16; float ss = 0.f;
#pragma unroll
                for (int bj = 0; bj < 2; ++bj)
#pragma unroll
                    for (int n = 0; n < 2; ++n) {
                        const int col = col0 + bj * 128 + n * 16;
                        const f32x4 x1 = *(const f32x4*)(xp + (size_t)row * D + col) + acc[ai][bj][m][n];
                        *(f32x4*)(X1 + (size_t)row * D + col) = x1;
                        const f32x4 gg = *(const f32x4*)(gf + col);
                        u32x2 w; w.x = cvt_pk(x1[0] * gg[0], x1[1] * gg[1]); w.y = cvt_pk(x1[2] * gg[2], x1[3] * gg[3]);
                        *(u32x2*)(H + (size_t)row * D + col) = w;
                        ss += (x1[0] * x1[0] + x1[1] * x1[1]) + (x1[2] * x1[2] + x1[3] * x1[3]);
                    }
                ss += __shfl_xor(ss, 16); ss += __shfl_xor(ss, 32);
                if (fq == 0) atomic_add_f32(RSS + row, ss);
            }
    }
};
struct EpiUp {
    bf16_t* U; float* out; const float* RSS;
    DI void operator()(const AccT& acc, const pg8::Unit& u, int wr, int wc, int fr, int fq) const {
        float rs[2][4];
        { const int row0_ = u.pm * 256 + wr * 64 + fr;
#pragma unroll
          for (int ai = 0; ai < 2; ++ai)
#pragma unroll
              for (int m = 0; m < 4; ++m) rs[ai][m] = rsqrtf(RSS[row0_ + ai * 128 + m * 16] * (1.f / D) + 1e-6f); }
        EPI_LOOP_BEGIN_S
            if (row < MT) {
                u32x2 w; w.x = cvt_pk(v[0], v[1]); w.y = cvt_pk(v[2], v[3]);
                *(u32x2*)(U + (size_t)row * FF2 + col) = w;
                if (row >= MP) *(f32x4*)(out + O_SFFN + (size_t)(row - MP) * 2 * FF2 + FF2 + col) = v;
                else if ((row & (SEQ - 1)) >= SEQ - 2) *(f32x4*)(out + O_PFFN + ((size_t)(row >> 11) * 2 + ((row & (SEQ - 1)) - (SEQ - 2))) * FF2 + col) = v;
            }
        EPI_LOOP_END
    }
};
#ifndef MK_P11_SCALE
#define MK_P11_SCALE 1.0f
#endif
struct EpiDn {
    float* X1;
    DI void operator()(const AccT& acc, const pg8::Unit& u, int wr, int wc, int fr, int fq) const {
        EPI_LOOP_BEGIN
            if (row < MT) { float* p = X1 + (size_t)row * D + col; *(f32x4*)p = *(const f32x4*)p + v * MK_P11_SCALE; }
        EPI_LOOP_END
    }
};

DI void transpose_item(const float* W, int K, int N, bf16_t* WT, int ldt, float* scr, int item, int lane) {
    const int nblk = N / 32, kb = item / nblk, nb = item % nblk, k0 = 64 * kb, n0 = 32 * nb;
#pragma unroll 8
    for (int i = 0; i < 32; ++i) { const int kk = 2 * i + (lane >> 5); scr[kk * 33 + (lane & 31)] = W[(size_t)(k0 + kk) * N + n0 + (lane & 31)]; }
    __builtin_amdgcn_fence(__ATOMIC_RELEASE, "wavefront"); asm volatile("s_waitcnt lgkmcnt(0)" ::: "memory");
    const int c = lane & 7;
#pragma unroll
    for (int j = 0; j < 4; ++j) { const int n = (lane >> 3) + 8 * j; const float* s = scr + (8 * c) * 33 + n;
        u32x4 o; o.x = pk2(s[0 * 33], s[1 * 33]); o.y = pk2(s[2 * 33], s[3 * 33]); o.z = pk2(s[4 * 33], s[5 * 33]); o.w = pk2(s[6 * 33], s[7 * 33]);
        *(u32x4*)(WT + (size_t)(n0 + n) * ldt + k0 + 8 * c) = o; }
    asm volatile("s_waitcnt lgkmcnt(0)" ::: "memory");
}
DI void rms_row_bf16(const float* xrow, const float* g, bf16_t* orow, int lane) {
    const f32x4* xr = (const f32x4*)xrow + lane; const f32x4* gr = (const f32x4*)g + lane;
    f32x4 v[8]; float s = 0.f;
#pragma unroll
    for (int j = 0; j < 8; ++j) { v[j] = xr[64 * j]; s += (v[j].x * v[j].x + v[j].y * v[j].y) + (v[j].z * v[j].z + v[j].w * v[j].w); }
    const float rstd = rsqrtf(wave_sum(s) * (1.f / D) + 1e-6f);
    u32x2* o8 = (u32x2*)orow + lane;
#pragma unroll
    for (int j = 0; j < 8; ++j) { const f32x4 gg = gr[64 * j]; u32x2 w; w.x = pk2(v[j].x * rstd * gg.x, v[j].y * rstd * gg.y); w.y = pk2(v[j].z * rstd * gg.z, v[j].w * rstd * gg.w); o8[64 * j] = w; }
}
DI void rms_row_f32(const float* xrow, const float* g, float* orow, int lane) {
    const f32x4* xr = (const f32x4*)xrow + lane; const f32x4* gr = (const f32x4*)g + lane;
    f32x4 v[8]; float s = 0.f;
#pragma unroll
    for (int j = 0; j < 8; ++j) { v[j] = xr[64 * j]; s += (v[j].x * v[j].x + v[j].y * v[j].y) + (v[j].z * v[j].z + v[j].w * v[j].w); }
    const float rstd = rsqrtf(wave_sum(s) * (1.f / D) + 1e-6f);
    f32x4* o = (f32x4*)orow + lane;
#pragma unroll
    for (int j = 0; j < 8; ++j) { const f32x4 gg = gr[64 * j]; o[64 * j] = v[j] * rstd * gg; }
}
DI void zero_row_bf16(bf16_t* orow, int ncols, int lane) {
    for (int c = lane * 8; c < ncols; c += 512) *(u32x4*)(orow + c) = (u32x4){0u, 0u, 0u, 0u};
}

DI void phase_prologue(const Args& a, unsigned char* lds, int gw, int ngw, int lane, int wave) {
    unsigned char* ws = a.ws;
    float* scr = (float*)(lds + wave * 16384);
    bf16_t* Win = (bf16_t*)(ws + WS_WIN); bf16_t* Wlo = (bf16_t*)(ws + WS_WLO);
    constexpr int IT_IN = (D / 64) * (CIN / 32);
    for (int it = gw; it < IT_IN; it += ngw) transpose_item(a.in[I_WIN], D, CIN, Win, D, scr, it, lane);
    for (int r = CIN + gw; r < NIN; r += ngw) zero_row_bf16(Win + (size_t)r * D, D, lane);
    {
        const int gt = gw * 64 + lane, ngt = ngw * 64;
        for (int i = gt; i < NLO * KLO; i += ngt) {
            const int n = i / KLO, k = i % KLO; float v = 0.f;
            if (n < 1024) { if (k < 64) v = a.in[I_WUP][k * 1024 + n]; }
            else if (n < 2048) { if (k >= 64 && k < 128) v = a.in[I_AUP][(k - 64) * 1024 + (n - 1024)]; }
            else { if (k >= 128 && k < 288) v = a.in[I_GUP][(k - 128) * 1024 + (n - 2048)]; }
            Wlo[i] = (bf16_t)bf_rne(v);
        }
    }
    { float* RSS = (float*)(ws + WS_RSS); for (int i = gw * 64 + lane; i < MPAD; i += ngw * 64) RSS[i] = 0.f; }
    bf16_t* H = (bf16_t*)(ws + WS_H);
    for (int m = gw; m < MPAD; m += ngw) {
        if (m < MT) rms_row_bf16(m < MP ? a.in[I_XP] + (size_t)m * D : a.in[I_XS] + (size_t)(m - MP) * D, a.in[I_NMG], H + (size_t)m * D, lane);
        else zero_row_bf16(H + (size_t)m * D, D, lane);
    }
}


DI void convert_wo_wup(const Args& a, unsigned char* lds, int wi, int nw, int wave, int lane) {
    float* scr = (float*)(lds + wave * 16384);
    constexpr int IT_O = (D / 64) * (D / 32), IT_UP = (D / 64) * (FF2 / 32);
    for (int it = wi; it < IT_O + IT_UP; it += nw) {
        if (it < IT_O) transpose_item(a.in[I_WO], D, D, (bf16_t*)(a.ws + WS_WO), D, scr, it, lane);
        else transpose_item(a.in[I_FUP], D, FF2, (bf16_t*)(a.ws + WS_WUP), D, scr, it - IT_O, lane);
    }
}
DI void convert_wdn(const Args& a, unsigned char* lds, int wi, int nw, int wave, int lane) {
    float* scr = (float*)(lds + wave * 16384);
    constexpr int IT_DN = (FF / 64) * (D / 32);
    for (int it = wi; it < IT_DN; it += nw) transpose_item(a.in[I_FDN], FF, D, (bf16_t*)(a.ws + WS_WDN), FF, scr, it, lane);
}

DI float rw_prev_val(const Args& a, const bf16_t* RW, int m, int j) {
    if (m < MP) return (m & (SEQ - 1)) == 0 ? 0.f : bf2f(RW[(size_t)(m - 1) * CSH + j]);
    return a.in[I_SSH][(size_t)(m - MP) * CSH + j];
}
DI void lora_input_row(const Args& a, int m, int lane) {
    bf16_t* ALO = (bf16_t*)(a.ws + WS_ALO) + (size_t)m * KLO;
    if (m >= MT) { for (int c = lane; c < KLO; c += 64) ALO[c] = 0; return; }
    const bf16_t* RW = (const bf16_t*)(a.ws + WS_RW);
    const bf16_t* cur = RW + (size_t)m * CSH;
    for (int c = lane; c < KLO; c += 64) {
        float v = 0.f;
        if (c < 288) {
            const int j = 3072 + c; const float x = bf2f(cur[j]), p = rw_prev_val(a, RW, m, j); const float xs = x + a.in[I_MU][j] * (p - x);
            v = c < 64 ? 1.f - 2.f * __builtin_amdgcn_rcpf(1.f + __expf(2.f * xs)) : (c < 128 ? xs : __builtin_amdgcn_rcpf(1.f + __expf(-xs)));
        }
        ALO[c] = (bf16_t)bf_rne(v);
    }
}

DI int crow(int reg, int h) { return (reg & 3) + 8 * (reg >> 2) + 4 * h; }
typedef short s16x4 __attribute__((ext_vector_type(4)));
constexpr int VPITCH = 192;
DI void attn_prompt_unit(const Args& a, unsigned char* lds, int unit, int wave, int lane) {
    const bf16_t* Qb = (const bf16_t*)(a.ws + WS_QB); const bf16_t* Kb = (const bf16_t*)(a.ws + WS_KB); const bf16_t* Vb = (const bf16_t*)(a.ws + WS_VB);
    bf16_t* PO = (bf16_t*)(a.ws + WS_PART); float* PML = (float*)(a.ws + WS_PML);
    LAS unsigned char* img = (LAS unsigned char*)lds + wave * (32 * VPITCH);
    const int blk = unit & 63, br = (unit >> 6) % 3, bh = unit / 192, b = bh >> 4, h = bh & 15;
    const int rate = br == 0 ? 1 : (br == 1 ? 4 : 16), L = SEQ / rate, bpc = L / 32;
    const int rho = blk / bpc, l0 = (blk % bpc) * 32;
    const int r = lane & 31, hh = lane >> 5;
    const int mq = b * SEQ + rho + rate * (l0 + r);
    bf16x8 qf[4];
#pragma unroll
    for (int ks = 0; ks < 4; ++ks) qf[ks] = *(const bf16x8*)(Qb + ((size_t)bh * SEQ + rho + rate * (l0 + r)) * 64 + ks * 16 + 8 * hh);
    f32x16 o0, o1;
#pragma unroll
    for (int i = 0; i < 16; ++i) { o0[i] = 0.f; o1[i] = 0.f; }
    float mrun = -1e30f, lrun = 0.f;
    const int lq = l0 + r;
    const int c0 = l0 >= 128 ? 0 : (128 - l0) >> 5;
    const bf16_t* kbase = Kb + ((size_t)bh * SEQ + rho) * 64 + 8 * hh;
    const bf16_t* vbase = Vb + ((size_t)bh * SEQ + rho) * 64 + 8 * (lane & 7);
    bf16x8 kreg[4]; u32x4 vreg[4];
#define AT_PREFETCH(ch_) do { const int lk0_ = l0 - 128 + 32 * (ch_); \
        _Pragma("unroll") for (int ks = 0; ks < 4; ++ks) kreg[ks] = *(const bf16x8*)(kbase + (size_t)(rate * (lk0_ + r)) * 64 + ks * 16); \
        _Pragma("unroll") for (int i = 0; i < 4; ++i) vreg[i] = *(const u32x4*)(vbase + (size_t)(rate * (lk0_ + 8 * i + (lane >> 3))) * 64); } while (0)
    AT_PREFETCH(c0);
    const int i16 = lane & 15, tq = i16 >> 2, tp = i16 & 3, g16 = (lane >> 4) & 1;
    const unsigned troff = (unsigned)((4 * hh + tq) * VPITCH + g16 * 32 + 8 * tp);
    for (int ch = c0; ch < 5; ++ch) {
        const int lk0 = l0 - 128 + 32 * ch;
        bf16x8 kf[4];
#pragma unroll
        for (int ks = 0; ks < 4; ++ks) kf[ks] = kreg[ks];
#pragma unroll
        for (int i = 0; i < 4; ++i) *(LAS u32x4*)(img + (8 * i + (lane >> 3)) * VPITCH + 16 * (lane & 7)) = vreg[i];
        if (ch + 1 < 5) AT_PREFETCH(ch + 1);
        f32x16 st;
#pragma unroll
        for (int i = 0; i < 16; ++i) st[i] = 0.f;
#pragma unroll
        for (int ks = 0; ks < 4; ++ks) st = __builtin_amdgcn_mfma_f32_32x32x16_bf16(kf[ks], qf[ks], st, 0, 0, 0);
        float cmax = -1e30f;
        if (ch == 0 || ch == 4) {
#pragma unroll
            for (int i = 0; i < 16; ++i) { const int lk = lk0 + crow(i, hh); const bool ok = (lk <= lq) && (lk >= lq - 128); st[i] = ok ? st[i] : -1e30f; }
        }
#pragma unroll
        for (int i = 0; i < 16; ++i) cmax = fmaxf(cmax, st[i]);
        cmax = fmaxf(cmax, __shfl_xor(cmax, 32));
        const float mnew = fmaxf(mrun, cmax), alpha = __builtin_amdgcn_exp2f(mrun - mnew);
        float ps = 0.f;
#pragma unroll
        for (int i = 0; i < 16; ++i) { const float p = __builtin_amdgcn_exp2f(st[i] - mnew); st[i] = p; ps += p; }
        lrun = lrun * alpha + ps; mrun = mnew;
#pragma unroll
        for (int i = 0; i < 16; ++i) { o0[i] *= alpha; o1[i] *= alpha; }
#pragma unroll
        for (int s = 0; s < 2; ++s) {
            u32x4 pp; pp.x = pk2(st[8 * s], st[8 * s + 1]); pp.y = pk2(st[8 * s + 2], st[8 * s + 3]); pp.z = pk2(st[8 * s + 4], st[8 * s + 5]); pp.w = pk2(st[8 * s + 6], st[8 * s + 7]);
            const bf16x8 pf = __builtin_bit_cast(bf16x8, pp);
#pragma unroll
            for (int dt = 0; dt < 2; ++dt) {
                const s16x4 lo = __builtin_amdgcn_ds_read_tr16_b64_v4i16((LAS s16x4*)(img + troff + (16 * s) * VPITCH + dt * 64));
                const s16x4 hi = __builtin_amdgcn_ds_read_tr16_b64_v4i16((LAS s16x4*)(img + troff + (16 * s + 8) * VPITCH + dt * 64));
                const bf16x8 vf = __builtin_shufflevector(lo, hi, 0, 1, 2, 3, 4, 5, 6, 7);
                if (dt == 0) o0 = __builtin_amdgcn_mfma_f32_32x32x16_bf16(vf, pf, o0, 0, 0, 0);
                else o1 = __builtin_amdgcn_mfma_f32_32x32x16_bf16(vf, pf, o1, 0, 0, 0);
            }
        }
    }
#undef AT_PREFETCH
    const float ltot = lrun + __shfl_xor(lrun, 32);
    bf16_t* po = PO + ((size_t)br * MP + mq) * 1024 + h * 64;
#pragma unroll
    for (int g = 0; g < 4; ++g) {
        u32x2 w0, w1; w0.x = pk2(o0[4 * g], o0[4 * g + 1]); w0.y = pk2(o0[4 * g + 2], o0[4 * g + 3]); w1.x = pk2(o1[4 * g], o1[4 * g + 1]); w1.y = pk2(o1[4 * g + 2], o1[4 * g + 3]);
        *(u32x2*)(po + 8 * g + 4 * hh) = w0; *(u32x2*)(po + 32 + 8 * g + 4 * hh) = w1;
    }
    if (hh == 0) { float* pm = PML + (((size_t)br * MP + mq) * 16 + h) * 2; pm[0] = mrun; pm[1] = ltot; }
}
DI float sum16(float v) { v = DPP_ADD(v, 0xB1); v = DPP_ADD(v, 0x4E); v = DPP_ADD(v, 0x141); v = DPP_ADD(v, 0x140); return v; }
DI void attn_merge_task(const Args& a, int task, int lane) {
    const int m = task >> 2, h = (task & 3) * 4 + (lane >> 4), d = 4 * (lane & 15);
    const bf16_t* PO = (const bf16_t*)(a.ws + WS_PART); const float* PML = (const float*)(a.ws + WS_PML);
    bf16_t* O = (bf16_t*)(a.ws + WS_O);
    float mb[3], lb[3]; f32x4 ob[3];
#pragma unroll
    for (int br = 0; br < 3; ++br) { const float* pm = PML + (((size_t)br * MP + m) * 16 + h) * 2; mb[br] = pm[0]; lb[br] = pm[1];
        const u32x2 w = *(const u32x2*)(PO + ((size_t)br * MP + m) * 1024 + h * 64 + d);
        ob[br] = (f32x4){__uint_as_float(w.x << 16), __uint_as_float(w.x & 0xffff0000u), __uint_as_float(w.y << 16), __uint_as_float(w.y & 0xffff0000u)}; }
    const float M = fmaxf(mb[0], fmaxf(mb[1], mb[2]));
    f32x4 num = {0.f, 0.f, 0.f, 0.f}; float den = 0.f;
#pragma unroll
    for (int br = 0; br < 3; ++br) { const float w = __builtin_amdgcn_exp2f(mb[br] - M); num += ob[br] * w; den += w * lb[br]; }
    const f32x4 o = num * __builtin_amdgcn_rcpf(den);
    const float ss = sum16(o.x * o.x + o.y * o.y + o.z * o.z + o.w * o.w) * (1.f / 64.f);
    const float rs = rsqrtf(ss + 1e-6f);
    const f32x4 gg = *(const f32x4*)(a.in[I_AOG] + h * 64 + d);
    u32x2 w; w.x = pk2(o.x * rs * gg.x, o.y * rs * gg.y); w.y = pk2(o.z * rs * gg.z, o.w * rs * gg.w);
    *(u32x2*)(O + (size_t)m * D + h * 64 + d) = w;
}
DI void attn_sample_wg(const Args& a, unsigned char* lds, int unit, int wave, int lane) {
    float* part = (float*)lds;
    const int bh = unit * 2 + (wave >> 2), qt = wave & 3, b = bh >> 4, h = bh & 15, g = lane >> 4, l16 = lane & 15;
    const bf16_t* Qb = (const bf16_t*)(a.ws + WS_QB);
    const float* ck = a.in[I_CK] + (size_t)b * 2048 * 1024 + h * 64 + 4 * l16; const float* cv = a.in[I_CV] + (size_t)b * 2048 * 1024 + h * 64 + 4 * l16;
    const float* nk = a.out + O_SK + (size_t)b * 1024 + h * 64 + 4 * l16; const float* nv = a.out + O_SV + (size_t)b * 1024 + h * 64 + 4 * l16;
    const u32x2 qw = *(const u32x2*)(Qb + (size_t)(MP + b) * 1024 + h * 64 + 4 * l16);
    const float q0 = __uint_as_float(qw.x << 16), q1 = __uint_as_float(qw.x & 0xffff0000u), q2 = __uint_as_float(qw.y << 16), q3 = __uint_as_float(qw.y & 0xffff0000u);
    float mrun = -1e30f, lrun = 0.f; f32x4 acc = {0.f, 0.f, 0.f, 0.f};
    const int e0 = qt * 97, e1 = e0 + 97 < 387 ? e0 + 97 : 387;
    for (int ito = 0; ito < 25; ito += 5) {
        f32x4 kv[5], vv[5]; bool valid[5];
#pragma unroll
        for (int k = 0; k < 5; ++k) {
            const int e = e0 + (ito + k) * 4 + g; valid[k] = e < e1;
            const int ee = valid[k] ? e : e0, br = ee / 129, j = ee % 129, rate = br == 0 ? 1 : (br == 1 ? 4 : 16);
            const int row = 2048 - rate * j;
            const float* kp = j == 0 ? nk : ck + (size_t)row * 1024; const float* vp = j == 0 ? nv : cv + (size_t)row * 1024;
            kv[k] = *(const f32x4*)kp; vv[k] = *(const f32x4*)vp;
        }
#pragma unroll
        for (int k = 0; k < 5; ++k) {
            float s = sum16(q0 * kv[k].x + q1 * kv[k].y + q2 * kv[k].z + q3 * kv[k].w);
            if (!valid[k]) s = -1e30f;
            const float mnew = fmaxf(mrun, s), alpha = __builtin_amdgcn_exp2f(mrun - mnew), p = valid[k] ? __builtin_amdgcn_exp2f(s - mnew) : 0.f;
            lrun = lrun * alpha + p; acc = acc * alpha + vv[k] * p; mrun = mnew;
        }
    }
#pragma unroll
    for (int o = 16; o < 64; o <<= 1) {
        const float mo = __shfl_xor(mrun, o), lo = __shfl_xor(lrun, o);
        f32x4 ao; ao.x = __shfl_xor(acc.x, o); ao.y = __shfl_xor(acc.y, o); ao.z = __shfl_xor(acc.z, o); ao.w = __shfl_xor(acc.w, o);
        const float mn = fmaxf(mrun, mo), w0 = __builtin_amdgcn_exp2f(mrun - mn), w1 = __builtin_amdgcn_exp2f(mo - mn);
        lrun = lrun * w0 + lo * w1; acc = acc * w0 + ao * w1; mrun = mn;
    }
    if (g == 0) { *(f32x4*)(part + wave * 68 + 4 * l16) = acc; if (l16 == 0) { part[wave * 68 + 64] = mrun; part[wave * 68 + 65] = lrun; } }
    __syncthreads();
    if (qt == 0 && g == 0) {
        float M = -1e30f;
#pragma unroll
        for (int w = 0; w < 4; ++w) M = fmaxf(M, part[(wave + w) * 68 + 64]);
        f32x4 num = {0.f, 0.f, 0.f, 0.f}; float den = 0.f;
#pragma unroll
        for (int w = 0; w < 4; ++w) { const float wt = __builtin_amdgcn_exp2f(part[(wave + w) * 68 + 64] - M); num += *(const f32x4*)(part + (wave + w) * 68 + 4 * l16) * wt; den += part[(wave + w) * 68 + 65] * wt; }
        const f32x4 o = num * (1.f / den);
        const float ss = sum16(o.x * o.x + o.y * o.y + o.z * o.z + o.w * o.w);
        const float rs = rsqrtf(ss * (1.f / 64.f) + 1e-6f);
        const f32x4 gg = *(const f32x4*)(a.in[I_AOG] + h * 64 + 4 * l16);
        u32x2 w; w.x = pk2(o.x * rs * gg.x, o.y * rs * gg.y); w.y = pk2(o.z * rs * gg.z, o.w * rs * gg.w);
        *(u32x2*)((bf16_t*)(a.ws + WS_O) + (size_t)(MP + b) * D + h * 64 + 4 * l16) = w;
    }
    __syncthreads();
}

struct PrepParams { float mu_r, mu_k, mu_v, w0, a0, kk, ka, rk; };
struct PrepRaw { float cr, ck, cv, pr, pk, pv, lw, la, lg; };
DI void prep_params(const Args& a, PrepParams& P, int c) {
    P.mu_r = a.in[I_MU][c]; P.mu_k = a.in[I_MU][1024 + c]; P.mu_v = a.in[I_MU][2048 + c];
    P.w0 = a.in[I_W0][c]; P.a0 = a.in[I_A0][c]; P.kk = a.in[I_KK][c]; P.ka = a.in[I_KA][c]; P.rk = a.in[I_RK][c];
}
DI void prep_load(const Args& a, PrepRaw& R, const bf16_t* RW, int m, const bf16_t* Lrow, int c) {
    const bf16_t* cur = RW + (size_t)m * CSH;
    R.cr = bf2f(cur[c]); R.ck = bf2f(cur[1024 + c]); R.cv = bf2f(cur[2048 + c]);
    R.pr = rw_prev_val(a, RW, m, c); R.pk = rw_prev_val(a, RW, m, 1024 + c); R.pv = rw_prev_val(a, RW, m, 2048 + c);
    R.lw = bf2f(Lrow[c]); R.la = bf2f(Lrow[1024 + c]); R.lg = bf2f(Lrow[2048 + c]);
}
DI void prep_finish(const PrepRaw& R, const PrepParams& P, float* dst, float& g_out, float& bonus_out, int lane) {
    const float xr = R.cr + P.mu_r * (R.pr - R.cr), xk = R.ck + P.mu_k * (R.pk - R.ck), xv = R.cv + P.mu_v * (R.pv - R.cv);
    const float x = -(P.w0 + R.lw);
    const float sp = x > 20.f ? x : __logf(1.f + __expf(x));
    const float decay = __expf(-__expf(-sp - 0.5f));
    const float av = __builtin_amdgcn_rcpf(1.f + __expf(-(P.a0 + R.la)));
    float kkv = xk * P.kk;
    const float n2 = wave_sum(kkv * kkv);
    kkv = kkv * fminf(__builtin_amdgcn_rsqf(n2), 1e12f);
    const float keff = xk * (1.f + (av - 1.f) * P.ka);
    const float bon = wave_sum(xr * keff * P.rk) * xv;
    dst[lane] = xr; dst[64 + lane] = decay; dst[128 + lane] = keff; dst[192 + lane] = xv; dst[256 + lane] = -kkv; dst[320 + lane] = kkv * av;
    g_out = R.lg; bonus_out = bon;
}
DI float scan_step(float (&S)[64], const float* sv, float vi) {
    const f32x4* r4 = (const f32x4*)sv; const f32x4* w4 = (const f32x4*)(sv + 64); const f32x4* k4 = (const f32x4*)(sv + 128);
    const f32x4* a4 = (const f32x4*)(sv + 256); const f32x4* b4 = (const f32x4*)(sv + 320);
    float sa0 = 0.f, sa1 = 0.f;
#pragma unroll
    for (int j = 0; j < 16; ++j) { const f32x4 av = a4[j]; sa0 = fmaf(S[4 * j], av.x, sa0); sa1 = fmaf(S[4 * j + 1], av.y, sa1); sa0 = fmaf(S[4 * j + 2], av.z, sa0); sa1 = fmaf(S[4 * j + 3], av.w, sa1); }
    const float sa = sa0 + sa1;
    float y0 = 0.f, y1 = 0.f;
#pragma unroll
    for (int j = 0; j < 16; ++j) {
        const f32x4 bv = b4[j], kv = k4[j], wv = w4[j], rv = r4[j];
        float t;
        t = fmaf(vi, kv.x, sa * bv.x); S[4 * j] = fmaf(S[4 * j], wv.x, t); y0 = fmaf(S[4 * j], rv.x, y0);
        t = fmaf(vi, kv.y, sa * bv.y); S[4 * j + 1] = fmaf(S[4 * j + 1], wv.y, t); y1 = fmaf(S[4 * j + 1], rv.y, y1);
        t = fmaf(vi, kv.z, sa * bv.z); S[4 * j + 2] = fmaf(S[4 * j + 2], wv.z, t); y0 = fmaf(S[4 * j + 2], rv.z, y0);
        t = fmaf(vi, kv.w, sa * bv.w); S[4 * j + 3] = fmaf(S[4 * j + 3], wv.w, t); y1 = fmaf(S[4 * j + 3], rv.w, y1);
        if ((j & 3) == 3) asm volatile("" ::: "memory");
    }
    return y0 + y1;
}
DI void rwkv_post(const Args& a, float y, float g, float bonus, int m, int c) {
    const float mean = wave_sum(y) * (1.f / 64.f); const float d = y - mean; const float var = wave_sum(d * d) * (1.f / 64.f);
    const float yn = d * rsqrtf(var + 64e-5f) * a.in[I_LNW][c] + a.in[I_LNB][c];
    ((bf16_t*)(a.ws + WS_O))[(size_t)m * D + 1024 + c] = (bf16_t)bf_rne((yn + bonus) * g);
}

#define WG_BAR_LDS() do { asm volatile("s_waitcnt lgkmcnt(0)" ::: "memory"); __builtin_amdgcn_s_barrier(); asm volatile("" ::: "memory"); } while (0)
typedef float f32x2 __attribute__((ext_vector_type(2)));
DI f32x2 fma2(f32x2 a, f32x2 b, f32x2 c) { return __builtin_elementwise_fma(a, b, c); }
DI void scan_dot_a(const f32x2 (&Z)[32], const f32x2 (&P)[32], const float* sv, float& sz, float& sp) {
    const f32x4* a4 = (const f32x4*)(sv + 256);
    f32x2 saz = {0.f, 0.f}, sap = {0.f, 0.f};
#pragma unroll
    for (int j = 0; j < 16; ++j) { const f32x4 av = a4[j]; const f32x2 a0 = {av.x, av.y}, a1 = {av.z, av.w};
        saz = fma2(Z[2 * j], a0, saz); sap = fma2(P[2 * j], a0, sap); saz = fma2(Z[2 * j + 1], a1, saz); sap = fma2(P[2 * j + 1], a1, sap);
        if ((j & 7) == 7) asm volatile("" ::: "memory"); }
    sz = saz.x + saz.y; sp = sap.x + sap.y;
}
DI void scan_step3(f32x2 (&Z)[32], f32x2 (&P)[32], const float* sv, const float* svn, float vi, float& sz, float& sp, float& yz, float& yp) {
    const f32x4* r4 = (const f32x4*)sv; const f32x4* w4 = (const f32x4*)(sv + 64); const f32x4* k4 = (const f32x4*)(sv + 128);
    const f32x4* b4 = (const f32x4*)(sv + 320); const f32x4* an4 = (const f32x4*)(svn + 256);
    const f32x2 sz2 = {sz, sz}, sp2 = {sp, sp}, v2 = {vi, vi};
    f32x2 yz2 = {0.f, 0.f}, yp2 = {0.f, 0.f}, nz2 = {0.f, 0.f}, np2 = {0.f, 0.f};
    f32x4 buf[3][5];
#define S3_LD(g, j) do { buf[g][0] = b4[j]; buf[g][1] = k4[j]; buf[g][2] = w4[j]; buf[g][3] = r4[j]; buf[g][4] = an4[j]; asm volatile("" ::: "memory"); } while (0)
    S3_LD(0, 0); S3_LD(1, 1);
#pragma unroll
    for (int j = 0; j < 16; ++j) {
        if (j + 2 < 16) S3_LD((j + 2) % 3, j + 2);
        const f32x4 bv = buf[j % 3][0], kv = buf[j % 3][1], wv = buf[j % 3][2], rv = buf[j % 3][3], av = buf[j % 3][4];
        { const f32x2 b2 = {bv.x, bv.y}, k2 = {kv.x, kv.y}, w2 = {wv.x, wv.y}, r2 = {rv.x, rv.y}, a2 = {av.x, av.y};
          f32x2 tz = sz2 * b2; tz = fma2(v2, k2, tz); Z[2 * j] = fma2(Z[2 * j], w2, tz); yz2 = fma2(Z[2 * j], r2, yz2); nz2 = fma2(Z[2 * j], a2, nz2);
          const f32x2 tp = sp2 * b2; P[2 * j] = fma2(P[2 * j], w2, tp); yp2 = fma2(P[2 * j], r2, yp2); np2 = fma2(P[2 * j], a2, np2); }
        { const f32x2 b2 = {bv.z, bv.w}, k2 = {kv.z, kv.w}, w2 = {wv.z, wv.w}, r2 = {rv.z, rv.w}, a2 = {av.z, av.w};
          f32x2 tz = sz2 * b2; tz = fma2(v2, k2, tz); Z[2 * j + 1] = fma2(Z[2 * j + 1], w2, tz); yz2 = fma2(Z[2 * j + 1], r2, yz2); nz2 = fma2(Z[2 * j + 1], a2, nz2);
          const f32x2 tp = sp2 * b2; P[2 * j + 1] = fma2(P[2 * j + 1], w2, tp); yp2 = fma2(P[2 * j + 1], r2, yp2); np2 = fma2(P[2 * j + 1], a2, np2); }
        asm volatile("" ::: "memory");
    }
#undef S3_LD
    yz = yz2.x + yz2.y; yp = yp2.x + yp2.y; sz = nz2.x + nz2.y; sp = np2.x + np2.y;
}
DI void scan_pass1_unit(const Args& a, unsigned char* lds, int unit, int wave, int lane) {
    float* stg = (float*)lds;
    const int pp = wave & 3, pair = unit * 4 + pp, chain = pair / NS, seg = pair % NS, b = chain >> 4, h = chain & 15, c = h * 64 + lane;
    const int mbase = b * SEQ + seg * SEGL;
    constexpr int NB = SEGL / TB;
    if (wave < 4) {
        bf16_t* YL = (bf16_t*)(a.ws + WS_YL); bf16_t* QS = (bf16_t*)(a.ws + WS_QS); float* ZP = (float*)(a.ws + WS_ZP);
        f32x2 Z[32], P[32];
        int idl = lane; asm volatile("" : "+v"(idl));
#pragma unroll
        for (int j = 0; j < 32; ++j) { Z[j] = (f32x2){0.f, 0.f}; P[j] = (f32x2){idl == 2 * j ? 1.f : 0.f, idl == 2 * j + 1 ? 1.f : 0.f}; }
        WG_BAR_LDS();
        for (int blk = 0; blk < NB; ++blk) {
            const float* sb = stg + (((blk & 1) * 4 + pp) * TB) * 384;
            float sz, sp; scan_dot_a(Z, P, sb, sz, sp);
#pragma unroll 1
            for (int tt = 0; tt < TB; ++tt) {
                const float* sv = sb + tt * 384; const float* svn = sb + (tt + 1 < TB ? tt + 1 : tt) * 384;
                float yz, yp; scan_step3(Z, P, sv, svn, sv[192 + lane], sz, sp, yz, yp);
                const size_t o = (size_t)(mbase + blk * TB + tt) * 1024 + c;
                const unsigned yq = pk2(yz, yp); YL[o] = (bf16_t)(yq & 0xffffu); QS[o] = (bf16_t)(yq >> 16);
            }
            WG_BAR_LDS();
        }
        float* zp = ZP + (size_t)pair * 2 * 4096 + lane * 64;
#pragma unroll
        for (int j = 0; j < 16; ++j) { *(f32x4*)(zp + 4 * j) = (f32x4){Z[2 * j].x, Z[2 * j].y, Z[2 * j + 1].x, Z[2 * j + 1].y};
                                       *(f32x4*)(zp + 4096 + 4 * j) = (f32x4){P[2 * j].x, P[2 * j].y, P[2 * j + 1].x, P[2 * j + 1].y}; }
    } else {
        const bf16_t* RW = (const bf16_t*)(a.ws + WS_RW); const bf16_t* Lb = (const bf16_t*)(a.ws + WS_L);
        bf16_t* GB = (bf16_t*)(a.ws + WS_GB);
        PrepParams Pm; prep_params(a, Pm, c);
        PrepRaw raw[TB];
#define P1_LOAD(blk_) do { _Pragma("unroll") for (int k = 0; k < TB; ++k) { const int m = mbase + (blk_) * TB + k; prep_load(a, raw[k], RW, m, Lb + (size_t)m * NLO, c); } } while (0)
#define P1_FINISH(blk_) do { _Pragma("unroll") for (int k = 0; k < TB; ++k) { const int m = mbase + (blk_) * TB + k; float g, bon; \
            prep_finish(raw[k], Pm, stg + ((((blk_) & 1) * 4 + pp) * TB + k) * 384, g, bon, lane); \
            GB[((size_t)m * 16 + h) * 128 + lane] = (bf16_t)bf_rne(g); GB[((size_t)m * 16 + h) * 128 + 64 + lane] = (bf16_t)bf_rne(bon); } } while (0)
        P1_LOAD(0); P1_FINISH(0); P1_LOAD(1);
        WG_BAR_LDS();
        for (int blk = 0; blk < NB; ++blk) {
            if (blk + 1 < NB) P1_FINISH(blk + 1);
            if (blk + 2 < NB) P1_LOAD(blk + 2);
            WG_BAR_LDS();
        }
#undef P1_LOAD
#undef P1_FINISH
    }
}
DI void scan_sample_unit(const Args& a, unsigned char* lds, int unit, int wave, int lane) {
    float* sv = (float*)(lds + 2 * 4 * TB * 384 * 4) + wave * 384;
    const bf16_t* RW = (const bf16_t*)(a.ws + WS_RW); const bf16_t* Lb = (const bf16_t*)(a.ws + WS_L);
    const int b = unit >> 4, h = unit & 15, c = h * 64 + lane, m = MP + b;
    PrepParams P; prep_params(a, P, c);
    PrepRaw raw; prep_load(a, raw, RW, m, Lb + (size_t)m * NLO, c);
    float g, bon; prep_finish(raw, P, sv, g, bon, lane);
    float S[64];
    const float* s0 = a.in[I_SWKV] + ((size_t)(b * 16 + h) * 64 + lane) * 64;
#pragma unroll
    for (int j = 0; j < 16; ++j) { const f32x4 v = *(const f32x4*)(s0 + 4 * j); S[4 * j] = v.x; S[4 * j + 1] = v.y; S[4 * j + 2] = v.z; S[4 * j + 3] = v.w; }
    const float y = scan_step(S, sv, sv[192 + lane]);
    float* so = a.out + O_SWKV + ((size_t)(b * 16 + h) * 64 + lane) * 64;
#pragma unroll
    for (int j = 0; j < 16; ++j) *(f32x4*)(so + 4 * j) = (f32x4){S[4 * j], S[4 * j + 1], S[4 * j + 2], S[4 * j + 3]};
    rwkv_post(a, y, g, bon, m, c);
}
DI void scan_pass2_unit(const Args& a, unsigned char* lds, int chain, int wave, int lane) {
    float* Ssh = (float*)lds;
    float* Psh = Ssh + 64 * 65;
    const float* ZP = (const float*)(a.ws + WS_ZP); float* SST = (float*)(a.ws + WS_SST);
    const int i = lane, j0 = wave * 8, tid = wave * 64 + lane;
    float Sr[8];
#pragma unroll
    for (int k = 0; k < 8; ++k) Sr[k] = 0.f;
    const float* Z0 = ZP + (size_t)(chain * NS) * 2 * 4096;
    f32x4 pn0 = *(const f32x4*)(Z0 + 4096 + tid * 8), pn1 = *(const f32x4*)(Z0 + 4096 + tid * 8 + 4);
    f32x4 zn0 = *(const f32x4*)(Z0 + i * 64 + j0), zn1 = *(const f32x4*)(Z0 + i * 64 + j0 + 4);
    for (int s = 0; s < NS; ++s) {
        float* sst = SST + ((size_t)chain * NS + s) * 4096 + i * 64 + j0;
        *(f32x4*)sst = (f32x4){Sr[0], Sr[1], Sr[2], Sr[3]}; *(f32x4*)(sst + 4) = (f32x4){Sr[4], Sr[5], Sr[6], Sr[7]};
#pragma unroll
        for (int k = 0; k < 8; ++k) Ssh[i * 65 + j0 + k] = Sr[k];
        *(f32x4*)(Psh + tid * 8) = pn0; *(f32x4*)(Psh + tid * 8 + 4) = pn1;
        float nw[8] = {zn0.x, zn0.y, zn0.z, zn0.w, zn1.x, zn1.y, zn1.z, zn1.w};
        if (s + 1 < NS) {
            const float* Zs = ZP + (size_t)(chain * NS + s + 1) * 2 * 4096;
            pn0 = *(const f32x4*)(Zs + 4096 + tid * 8); pn1 = *(const f32x4*)(Zs + 4096 + tid * 8 + 4);
            zn0 = *(const f32x4*)(Zs + i * 64 + j0); zn1 = *(const f32x4*)(Zs + i * 64 + j0 + 4);
        }
        WG_BAR_LDS();
        if (s > 0) {
#pragma unroll 8
            for (int l = 0; l < 64; ++l) {
                const float sl = Ssh[i * 65 + l];
                const f32x4 p0 = *(const f32x4*)(Psh + l * 64 + j0), p1 = *(const f32x4*)(Psh + l * 64 + j0 + 4);
                nw[0] = fmaf(sl, p0.x, nw[0]); nw[1] = fmaf(sl, p0.y, nw[1]); nw[2] = fmaf(sl, p0.z, nw[2]); nw[3] = fmaf(sl, p0.w, nw[3]);
                nw[4] = fmaf(sl, p1.x, nw[4]); nw[5] = fmaf(sl, p1.y, nw[5]); nw[6] = fmaf(sl, p1.z, nw[6]); nw[7] = fmaf(sl, p1.w, nw[7]);
            }
        }
        WG_BAR_LDS();
#pragma unroll
        for (int k = 0; k < 8; ++k) Sr[k] = nw[k];
    }
    float* so = a.out + O_PWKV + (size_t)chain * 4096 + i * 64 + j0;
    *(f32x4*)so = (f32x4){Sr[0], Sr[1], Sr[2], Sr[3]}; *(f32x4*)(so + 4) = (f32x4){Sr[4], Sr[5], Sr[6], Sr[7]};
}
DI bf16x8 cvt8(const f32x4 lo, const f32x4 hi) { u32x4 p; p.x = pk2(lo.x, lo.y); p.y = pk2(lo.z, lo.w); p.z = pk2(hi.x, hi.y); p.w = pk2(hi.z, hi.w); return __builtin_bit_cast(bf16x8, p); }
DI void scan_pass3_unit(const Args& a, int unit, int lane) {
    const float* SST = (const float*)(a.ws + WS_SST); const bf16_t* YL = (const bf16_t*)(a.ws + WS_YL); const bf16_t* QS = (const bf16_t*)(a.ws + WS_QS); const bf16_t* GB = (const bf16_t*)(a.ws + WS_GB);
    bf16_t* O = (bf16_t*)(a.ws + WS_O);
    const int sub = unit & 3, pair = unit >> 2, chain = pair / NS, seg = pair % NS, b = chain >> 4, h = chain & 15;
    const int r = lane & 31, hh = lane >> 5;
    const int m = b * SEQ + seg * SEGL + sub * 32 + r;
    f32x16 acc0, acc1;
#pragma unroll
    for (int i = 0; i < 16; ++i) { acc0[i] = 0.f; acc1[i] = 0.f; }
    const bf16_t* qrow = QS + (size_t)m * 1024 + h * 64 + 8 * hh;
    const float* s0 = SST + (size_t)pair * 4096 + (size_t)r * 64 + 8 * hh; const float* s1 = s0 + 32 * 64;
#pragma unroll
    for (int ks = 0; ks < 4; ++ks) {
        const bf16x8 qf = *(const bf16x8*)(qrow + ks * 16);
        const bf16x8 a0 = cvt8(*(const f32x4*)(s0 + ks * 16), *(const f32x4*)(s0 + ks * 16 + 4));
        const bf16x8 a1 = cvt8(*(const f32x4*)(s1 + ks * 16), *(const f32x4*)(s1 + ks * 16 + 4));
        acc0 = __builtin_amdgcn_mfma_f32_32x32x16_bf16(a0, qf, acc0, 0, 0, 0);
        acc1 = __builtin_amdgcn_mfma_f32_32x32x16_bf16(a1, qf, acc1, 0, 0, 0);
    }
    const bf16_t* yl = YL + (size_t)m * 1024 + h * 64 + 4 * hh;
    float y[32]; float sum = 0.f;
#pragma unroll
    for (int rt = 0; rt < 2; ++rt)
#pragma unroll
        for (int g = 0; g < 4; ++g) { const u32x2 yw = *(const u32x2*)(yl + rt * 32 + 8 * g); const f32x4 v = {__uint_as_float(yw.x << 16), __uint_as_float(yw.x & 0xffff0000u), __uint_as_float(yw.y << 16), __uint_as_float(yw.y & 0xffff0000u)};
#pragma unroll
            for (int e = 0; e < 4; ++e) { const float yy = v[e] + (rt == 0 ? acc0[4 * g + e] : acc1[4 * g + e]); y[rt * 16 + 4 * g + e] = yy; sum += yy; } }
    sum += __shfl_xor(sum, 32);
    const float mean = sum * (1.f / 64.f);
    float vs = 0.f;
#pragma unroll
    for (int e = 0; e < 32; ++e) { y[e] -= mean; vs += y[e] * y[e]; }
    vs += __shfl_xor(vs, 32);
    const float rstd = rsqrtf(vs * (1.f / 64.f) + 64e-5f);
    const bf16_t* gb = GB + ((size_t)m * 16 + h) * 128 + 4 * hh;
    const float* lw = a.in[I_LNW] + h * 64 + 4 * hh; const float* lb = a.in[I_LNB] + h * 64 + 4 * hh;
    bf16_t* orow = O + (size_t)m * D + 1024 + h * 64 + 4 * hh;
#pragma unroll
    for (int rt = 0; rt < 2; ++rt)
#pragma unroll
        for (int g = 0; g < 4; ++g) {
            const int off = rt * 32 + 8 * g;
            const f32x4 w4 = *(const f32x4*)(lw + off), b4 = *(const f32x4*)(lb + off);
            const u32x2 gw = *(const u32x2*)(gb + off), bw = *(const u32x2*)(gb + 64 + off);
            const float gg[4] = {__uint_as_float(gw.x << 16), __uint_as_float(gw.x & 0xffff0000u), __uint_as_float(gw.y << 16), __uint_as_float(gw.y & 0xffff0000u)};
            const float bb[4] = {__uint_as_float(bw.x << 16), __uint_as_float(bw.x & 0xffff0000u), __uint_as_float(bw.y << 16), __uint_as_float(bw.y & 0xffff0000u)};
            float o[4];
#pragma unroll
            for (int e = 0; e < 4; ++e) o[e] = (y[rt * 16 + 4 * g + e] * rstd * w4[e] + b4[e] + bb[e]) * gg[e];
            u32x2 w; w.x = pk2(o[0], o[1]); w.y = pk2(o[2], o[3]);
            *(u32x2*)(orow + off) = w;
        }
}

DI void unpack8(const u32x4 w, float (&u)[8]) {
    u[0] = __uint_as_float(w.x << 16); u[1] = __uint_as_float(w.x & 0xffff0000u); u[2] = __uint_as_float(w.y << 16); u[3] = __uint_as_float(w.y & 0xffff0000u);
    u[4] = __uint_as_float(w.z << 16); u[5] = __uint_as_float(w.z & 0xffff0000u); u[6] = __uint_as_float(w.w << 16); u[7] = __uint_as_float(w.w & 0xffff0000u);
}
constexpr int CONV_NCH = (256 * NTHREADS) / (FF / 8);
DI void conv_sweep(const Args& a, int idx) {
    const int fg = idx % (FF / 8), cls = idx / (FF / 8), f = fg * 8;
    if (cls >= CONV_NCH) return;
    const bf16_t* U = (const bf16_t*)(a.ws + WS_U); bf16_t* ACT = (bf16_t*)(a.ws + WS_ACT);
    const float* cw = a.in[I_FCW]; const float* cb = a.in[I_FCB];
    float w0[2][8], w1[2][8], w2[2][8], bb[2][8];
#pragma unroll
    for (int p = 0; p < 2; ++p)
#pragma unroll
        for (int j = 0; j < 8; ++j) { const int col = p * FF + f + j; w0[p][j] = cw[col]; w1[p][j] = cw[FF2 + col]; w2[p][j] = cw[2 * FF2 + col]; bb[p][j] = cb[col]; }
    for (int m = cls; m < MT; m += CONV_NCH) {
        u32x4 x0[2], x1[2], x2[2];
        const bool pr = m < MP; const int t = m & (SEQ - 1);
#pragma unroll
        for (int p = 0; p < 2; ++p) {
            const bf16_t* up = U + (size_t)m * FF2 + p * FF + f;
            x0[p] = *(const u32x4*)up; x1[p] = (u32x4){0u, 0u, 0u, 0u}; x2[p] = (u32x4){0u, 0u, 0u, 0u};
            if (pr && t >= 1) x1[p] = *(const u32x4*)(up - FF2);
            if (pr && t >= 2) x2[p] = *(const u32x4*)(up - 2 * FF2);
        }
        float u0[2][8], u1[2][8], u2[2][8];
#pragma unroll
        for (int p = 0; p < 2; ++p) { unpack8(x0[p], u0[p]); unpack8(x1[p], u1[p]); unpack8(x2[p], u2[p]); }
        if (!pr) {
#pragma unroll
            for (int p = 0; p < 2; ++p) {
                const float* st = a.in[I_SFFN] + (size_t)(m - MP) * 2 * FF2 + p * FF + f;
                float* so = a.out + O_SFFN + (size_t)(m - MP) * 2 * FF2 + p * FF + f;
#pragma unroll
                for (int j = 0; j < 8; ++j) { u2[p][j] = st[j]; u1[p][j] = st[FF2 + j]; so[j] = u1[p][j]; }
            }
        }
        float o[8];
#pragma unroll
        for (int j = 0; j < 8; ++j) {
            const float gt = bb[0][j] + w0[0][j] * u2[0][j] + w1[0][j] * u1[0][j] + w2[0][j] * u0[0][j];
            const float vl = bb[1][j] + w0[1][j] * u2[1][j] + w1[1][j] * u1[1][j] + w2[1][j] * u0[1][j];
            o[j] = gt * __builtin_amdgcn_rcpf(1.f + __expf(-gt)) * vl;
        }
        u32x4 w; w.x = pk2(o[0], o[1]); w.y = pk2(o[2], o[3]); w.z = pk2(o[4], o[5]); w.w = pk2(o[6], o[7]);
        *(u32x4*)(ACT + (size_t)m * FF + f) = w;
    }
}

#define XB_TMO      128
#define XB_XCNT(j)  (256  + 64 * (j))
#define XB_XSUB(j)  (1280 + 64 * (j))
#define XB_XGEN(j)  (2304 + 64 * (j))
#define XB_TOP      3328
#define XB_TOPGEN   3392
#define XCD_BAR_WORDS 3456
#define XB_SPIN_CAP (1u << 18)
DI unsigned xb_ld(unsigned* p)              { return __hip_atomic_load(p, __ATOMIC_RELAXED, __HIP_MEMORY_SCOPE_AGENT); }
DI unsigned xb_add(unsigned* p, unsigned v) { return __hip_atomic_fetch_add(p, v, __ATOMIC_RELAXED, __HIP_MEMORY_SCOPE_AGENT); }
DI unsigned xb_xcc_id() { return (unsigned)__builtin_amdgcn_s_getreg((3 << 11) | 20) & 0xFu; }
#define XB_SPIN(cond, bar) do { unsigned _sp = 0; while (cond) { __builtin_amdgcn_s_sleep(1); \
    if ((++_sp & 255u) == 0u) { if (xb_ld(&(bar)[XB_TMO])) break; if (_sp > XB_SPIN_CAP) { atomicAdd(&(bar)[XB_TMO], 1u); break; } } } } while (0)
struct XcdBarrier { unsigned* bar; unsigned x; volatile LAS unsigned* st; };
DI XcdBarrier xcd_barrier_post(unsigned* bar, volatile LAS unsigned* st) {
    XcdBarrier b; b.bar = bar; b.x = xb_xcc_id(); b.st = st;
    if (threadIdx.x == 0) (void)xb_add(&bar[XB_XCNT(b.x)], 1u);
    return b;
}
DI void xcd_barrier_complete(unsigned* bar, unsigned x, unsigned& nloc, unsigned& nx) {
    const unsigned G = gridDim.x * gridDim.y * gridDim.z;
    unsigned sum, cnt, mine, sp = 0u;
    for (;;) {
        sum = 0u; cnt = 0u; mine = 0u;
#pragma unroll
        for (unsigned j = 0; j < 16; ++j) { const unsigned c = xb_ld(&bar[XB_XCNT(j)]); sum += c; cnt += (c > 0u) ? 1u : 0u; mine = (j == x) ? c : mine; }
        if (sum == G) break;
        __builtin_amdgcn_s_sleep(1);
        if ((++sp & 255u) == 0u) { if (xb_ld(&bar[XB_TMO])) break; if (sp > XB_SPIN_CAP) { atomicAdd(&bar[XB_TMO], 1u); break; } }
    }
    nloc = mine > 0u ? mine : 1u; nx = cnt > 0u ? cnt : 1u;
}
DI void xcd_barrier(const XcdBarrier& b) {
    asm volatile("s_waitcnt vmcnt(0)" ::: "memory");
    __syncthreads();
    if (threadIdx.x == 0) {
        unsigned* bar = b.bar;
        __builtin_amdgcn_s_waitcnt(0);
        unsigned nloc = b.st[0], nx = b.st[1];
        if (nloc == 0u) { xcd_barrier_complete(bar, b.x, nloc, nx); b.st[0] = nloc; b.st[1] = nx; }
        const unsigned old = xb_add(&bar[XB_XSUB(b.x)], 1u);
        const unsigned gen = old / nloc;
        if (old + 1u == (gen + 1u) * nloc) {
            __builtin_amdgcn_fence(__ATOMIC_RELEASE, "agent");
            asm volatile("s_waitcnt vmcnt(0)" ::: "memory");
            const unsigned og = xb_add(&bar[XB_TOP], 1u);
            const unsigned tg = og / nx;
            if (og + 1u == (tg + 1u) * nx) xb_add(&bar[XB_TOPGEN], 1u);
            else XB_SPIN(xb_ld(&bar[XB_TOPGEN]) == tg, bar);
            __builtin_amdgcn_fence(__ATOMIC_ACQUIRE, "agent");
            xb_add(&bar[XB_XGEN(b.x)], 1u);
            asm volatile("s_waitcnt vmcnt(0)" ::: "memory");
        } else {
            XB_SPIN(xb_ld(&bar[XB_XGEN(b.x)]) == gen, bar);
            __builtin_amdgcn_fence(__ATOMIC_ACQUIRE, "agent");
            asm volatile("s_waitcnt vmcnt(0)" ::: "memory");
        }
    }
    __syncthreads();
}

DI void skinny_unit(const bf16_t* A, int lda, const bf16_t* Bt, int K, int unit, const float* base, int ldb, float* out, int ldo, unsigned char* lds, int wave, int lane,
                    const float* gf = nullptr, bf16_t* H = nullptr, float* RSS = nullptr) {
    float* red = (float*)lds;
    const int n0 = unit * 32, r = lane & 31, hh = lane >> 5, kw = K / 8, kb = wave * kw;
    f32x16 acc;
#pragma unroll
    for (int i = 0; i < 16; ++i) acc[i] = 0.f;
    const bf16_t* ap = A + (size_t)r * lda + kb + 8 * hh; const bf16_t* bp = Bt + (size_t)(n0 + r) * K + kb + 8 * hh;
#pragma unroll 4
    for (int k = 0; k < kw; k += 16) {
        const bf16x8 af = *(const bf16x8*)(ap + k), bf = *(const bf16x8*)(bp + k);
        acc = __builtin_amdgcn_mfma_f32_32x32x16_bf16(af, bf, acc, 0, 0, 0);
    }
#pragma unroll
    for (int i = 0; i < 16; ++i) red[(wave * 16 + i) * 64 + lane] = acc[i];
    __syncthreads();
#pragma unroll
    for (int q = 0; q < 2; ++q) {
        const int o = threadIdx.x + 512 * q, i = o >> 6, ln = o & 63;
        float sum = 0.f;
#pragma unroll
        for (int w = 0; w < 8; ++w) sum += red[(w * 16 + i) * 64 + ln];
        const int row = crow(i, ln >> 5), col = n0 + (ln & 31);
        const float x1 = base[(size_t)row * ldb + col] + sum * (H ? 1.0f : MK_P11_SCALE);
        out[(size_t)row * ldo + col] = x1;
        if (H) { H[(size_t)row * D + col] = (bf16_t)bf_rne(x1 * gf[col]);
            float ss = x1 * x1;
            ss += __shfl_xor(ss, 1); ss += __shfl_xor(ss, 2); ss += __shfl_xor(ss, 4); ss += __shfl_xor(ss, 8); ss += __shfl_xor(ss, 16);
            if ((ln & 31) == 0) atomic_add_f32(RSS + row, ss); }
    }
    __syncthreads();
}

constexpr int NPH = 14;
template <bool COOP>
__global__ void __launch_bounds__(NTHREADS, 2) mk_fwd(Args a) {
    extern __shared__ __attribute__((aligned(16))) unsigned char lds[];
    const int tid = threadIdx.x, lane = tid & 63, wave = __builtin_amdgcn_readfirstlane(tid >> 6);
    const int G = gridDim.x, bid = blockIdx.x, gw = bid * NWAVES + wave, ngw = G * NWAVES;
    unsigned char* ws = a.ws;
    LAS unsigned char* ldsl = (LAS unsigned char*)lds;
#ifndef PHMASK
#define PHMASK 0xffff
#endif
#define IN(k) (((PHMASK >> (k)) & 1) && a.ph_lo <= (k) && (k) < a.ph_hi)
    XcdBarrier xbar; xbar.bar = (unsigned*)(ws + WS_BAR); xbar.x = 0; xbar.st = nullptr;
    if (COOP) {
        volatile LAS unsigned* st = (volatile LAS unsigned*)(ldsl + LDS_BYTES - 16);
        if (tid < 4) st[tid] = 0u;
        __syncthreads();
        xbar = xcd_barrier_post((unsigned*)(ws + WS_BAR), st);
    }
#define SEAM(k) do { if (COOP && IN(k) && IN((k) + 1)) { if (a.ph_hi > 1000) cg::this_grid().sync(); else xcd_barrier(xbar); } } while (0)

    if (IN(0)) phase_prologue(a, lds, gw, ngw, lane, wave);
    SEAM(0);
    if (IN(1)) {
        pg8::Gemm g{(const bf16_t*)(ws + WS_H), (const bf16_t*)(ws + WS_WIN), MPAD, NIN, D}; pg8::StaticOrder S; S.init(MPAD, NIN, G, bid);
        EpiIn E{(bf16_t*)(ws + WS_QB), (bf16_t*)(ws + WS_KB), (bf16_t*)(ws + WS_VB), (bf16_t*)(ws + WS_RW), a.out};
        pg8::gemm_phase<EpiIn>(ldsl, g, S, E);
        {
            const int nu = (MPAD / 256) * (NIN / 256), rem = nu % G, first = rem == 0 ? 0 : rem, nfree = G - first;
            if (bid >= first) convert_wo_wup(a, lds, (bid - first) * NWAVES + wave, nfree * NWAVES, wave, lane);
        }
    }
    SEAM(1);
    if (IN(2)) {
        for (int u = bid; u < 256; u += G) attn_sample_wg(a, lds, u, wave, lane);
        for (int u = gw; u < 64 * 3 * 64; u += ngw) attn_prompt_unit(a, lds, u, wave, lane);
        for (int m = gw; m < MPAD; m += ngw) lora_input_row(a, m, lane);
    }
    SEAM(2);
    if (IN(3)) {
        pg8::Gemm g{(const bf16_t*)(ws + WS_ALO), (const bf16_t*)(ws + WS_WLO), MPAD, NLO, KLO}; pg8::StaticOrder S; S.init(MPAD, NLO, G, bid);
        EpiBf E{(bf16_t*)(ws + WS_L), NLO};
        pg8::gemm_phase<EpiBf>(ldsl, g, S, E);
#pragma unroll 2
        for (int t = gw; t < MP * 4; t += ngw) attn_merge_task(a, t, lane);
    }
    SEAM(3);
    if (IN(4)) {
#ifndef NO_P1
        for (int u = bid; u < 64 * NS / 4; u += G) scan_pass1_unit(a, lds, u, wave, lane);
#endif

    }
    SEAM(4);
    if (IN(5)) {
        if (G >= 128) {
            if (bid < 64) scan_pass2_unit(a, lds, bid, wave, lane);
            else for (int u = (bid - 64) * NWAVES + wave; u < 512; u += (G - 64) * NWAVES) scan_sample_unit(a, lds, u, wave, lane);
        } else {
            for (int ch = bid; ch < 64; ch += G) scan_pass2_unit(a, lds, ch, wave, lane);
            for (int u = gw; u < 512; u += ngw) scan_sample_unit(a, lds, u, wave, lane);
        }
    }
    SEAM(5);
    if (IN(6)) { for (int u = gw; u < 64 * NS * 4; u += ngw) scan_pass3_unit(a, u, lane); }
    SEAM(6);
    if (IN(7)) {
        pg8::Gemm g{(const bf16_t*)(ws + WS_O), (const bf16_t*)(ws + WS_WO), MP, D, D}; pg8::StaticOrder S; S.init(MP, D, G, bid);
        EpiWo E{a.in[I_XP], a.in[I_NFG], (float*)(ws + WS_X1), (bf16_t*)(ws + WS_H), (float*)(ws + WS_RSS)};
        pg8::gemm_phase<EpiWo>(ldsl, g, S, E);
        for (int u = bid; u < D / 32; u += G)
            skinny_unit((const bf16_t*)(ws + WS_O) + (size_t)MP * D, D, (const bf16_t*)(ws + WS_WO), D, u, a.in[I_XS], D, (float*)(ws + WS_X1) + (size_t)MP * D, D, lds, wave, lane,
                        a.in[I_NFG], (bf16_t*)(ws + WS_H) + (size_t)MP * D, (float*)(ws + WS_RSS) + MP);
    }
    SEAM(7);
    if (IN(9)) {
        pg8::Gemm g{(const bf16_t*)(ws + WS_H), (const bf16_t*)(ws + WS_WUP), MPAD, FF2, D}; pg8::StaticOrder S; S.init(MPAD, FF2, G, bid);
        EpiUp E{(bf16_t*)(ws + WS_U), a.out, (const float*)(ws + WS_RSS)};
        pg8::gemm_phase<EpiUp>(ldsl, g, S, E);
        {
            const int nu = (MPAD / 256) * (FF2 / 256), rem = nu % G, first = rem == 0 ? 0 : rem, nfree = G - first;
            if (bid >= first) convert_wdn(a, lds, (bid - first) * NWAVES + wave, nfree * NWAVES, wave, lane);
        }
    }
    SEAM(9);
    if (IN(10)) { if (G == 256) conv_sweep(a, bid * NTHREADS + tid); else for (int it = bid * NTHREADS + tid; it < CONV_NCH * (FF / 8); it += G * NTHREADS) conv_sweep(a, it); }
    SEAM(10);
    if (IN(11)) {
        pg8::Gemm g{(const bf16_t*)(ws + WS_ACT), (const bf16_t*)(ws + WS_WDN), MP, D, FF}; pg8::StaticOrder S; S.init(MP, D, G, bid);
        EpiDn E{(float*)(ws + WS_X1)};
        pg8::gemm_phase<EpiDn>(ldsl, g, S, E);
        for (int u = bid; u < D / 32; u += G)
            skinny_unit((const bf16_t*)(ws + WS_ACT) + (size_t)MP * FF, FF, (const bf16_t*)(ws + WS_WDN), FF, u, (const float*)(ws + WS_X1) + (size_t)MP * D, D, (float*)(ws + WS_X1) + (size_t)MP * D, D, lds, wave, lane);
    }
    SEAM(11);
    if (IN(12)) {
        for (int m = gw; m < MT; m += ngw)
            rms_row_f32((const float*)(ws + WS_X1) + (size_t)m * D, a.in[I_NFIN], m < MP ? a.out + O_YP + (size_t)m * D : a.out + O_YS + (size_t)(m - MP) * D, lane);
    }
#undef IN
#undef SEAM
}

#ifndef MK_ONE_LAUNCH
#define MK_ONE_LAUNCH 1
#endif
#ifndef MK_DBL_MASK
#define MK_DBL_MASK 0x0
#endif

extern "C" void kernel_launch(void* const* d_in, const int* in_sizes, int n_in, void* d_out, int out_size, void* d_ws, size_t ws_size, hipStream_t stream) {
    static int grid = 0;
    if (!grid) {
        if (n_in != 28 || (size_t)out_size != O_END || ws_size < WS_END) fprintf(stderr, "kernel_launch: unexpected shapes: n_in %d out %d (want %zu) ws %zu (want %zu)\n", n_in, out_size, O_END, ws_size, WS_END);
        int dev = 0, cus = 0; hipGetDevice(&dev); hipDeviceGetAttribute(&cus, hipDeviceAttributeMultiprocessorCount, dev);
        hipFuncSetAttribute((const void*)mk_fwd<true>, hipFuncAttributeMaxDynamicSharedMemorySize, LDS_BYTES);
        hipFuncSetAttribute((const void*)mk_fwd<false>, hipFuncAttributeMaxDynamicSharedMemorySize, LDS_BYTES);
        int per_cu = 0; hipOccupancyMaxActiveBlocksPerMultiprocessor(&per_cu, mk_fwd<true>, NTHREADS, LDS_BYTES);
        if (per_cu < 1) { fprintf(stderr, "kernel_launch: occupancy query says %d blocks/CU\n", per_cu); per_cu = 1; }
        grid = cus > 0 ? cus : 256;
    }
    Args a; memset(&a, 0, sizeof(a));
    for (int i = 0; i < 28; ++i) a.in[i] = (const float*)d_in[i];
    a.out = (float*)d_out; a.ws = (unsigned char*)d_ws;
#if MK_ONE_LAUNCH
    if (hipMemsetAsync((char*)d_ws + WS_BAR, 0, BAR_BYTES, stream) != hipSuccess) { fprintf(stderr, "kernel_launch: memset of the barrier words failed\n"); return; }
    a.ph_lo = 0; a.ph_hi = NPH;
    void* args[] = {&a};
    hipError_t e = hipLaunchCooperativeKernel((const void*)mk_fwd<true>, dim3(grid), dim3(NTHREADS), args, LDS_BYTES, stream);
    if (e != hipSuccess) fprintf(stderr, "cooperative launch failed: %s (grid %d)\n", hipGetErrorString(e), grid);
#else
    for (int p = 0; p < 13; ++p) {
        a.ph_lo = p; a.ph_hi = p + 1;
        mk_fwd<false><<<dim3(grid), dim3(NTHREADS), LDS_BYTES, stream>>>(a);
        if ((MK_DBL_MASK >> p) & 1) mk_fwd<false><<<dim3(grid), dim3(NTHREADS), LDS_BYTES, stream>>>(a);
    }
#endif
}
```

```cpp
#include <hip/hip_runtime.h>
#include <hip/hip_cooperative_groups.h>
#include <cstdio>
#include <cstdint>
#include <cstring>
namespace cg = cooperative_groups;

#define DI __device__ __forceinline__
#define LAS __attribute__((address_space(3)))
typedef unsigned short bf16_t;
typedef short bf16x8 __attribute__((ext_vector_type(8)));
typedef float f32x4 __attribute__((ext_vector_type(4)));
typedef float f32x16 __attribute__((ext_vector_type(16)));
typedef unsigned u32x4 __attribute__((ext_vector_type(4)));
typedef unsigned u32x2 __attribute__((ext_vector_type(2)));

constexpr int D = 2048, MP = 8192, MS = 32, MT = 8224, MPAD = 8448, SEQ = 2048;
constexpr int CIN = 6432, NIN = 6656, CSH = 3360, FF2 = 11264, FF = 5632;
constexpr int NLO = 3072, KLO = 384;
constexpr int NS = 16, SEGL = 128, TB = 8;
constexpr int NTHREADS = 512, NWAVES = 8;
constexpr int LDS_BYTES = 131072 + 16384;

constexpr size_t O_YP = 0;
constexpr size_t O_YS = O_YP + (size_t)MP * D;
constexpr size_t O_PK = O_YS + (size_t)MS * D;
constexpr size_t O_PV = O_PK + (size_t)MP * 1024;
constexpr size_t O_PRW = O_PV + (size_t)MP * 1024;
constexpr size_t O_PWKV = O_PRW + (size_t)4 * CSH;
constexpr size_t O_PFFN = O_PWKV + (size_t)4 * 16 * 4096;
constexpr size_t O_SK = O_PFFN + (size_t)4 * 2 * FF2;
constexpr size_t O_SV = O_SK + (size_t)MS * 1024;
constexpr size_t O_SRW = O_SV + (size_t)MS * 1024;
constexpr size_t O_SWKV = O_SRW + (size_t)MS * CSH;
constexpr size_t O_SFFN = O_SWKV + (size_t)MS * 16 * 4096;
constexpr size_t O_END = O_SFFN + (size_t)MS * 2 * FF2;

constexpr size_t al256(size_t x) { return (x + 255) & ~(size_t)255; }
constexpr size_t WS_WIN = 0;
constexpr size_t WS_WO = WS_WIN + al256((size_t)NIN * D * 2);
constexpr size_t WS_WUP = WS_WO + al256((size_t)D * D * 2);
constexpr size_t WS_WDN = WS_WUP + al256((size_t)FF2 * D * 2);
constexpr size_t WS_WLO = WS_WDN + al256((size_t)D * FF * 2);
constexpr size_t WS_H = WS_WLO + al256((size_t)NLO * KLO * 2);
constexpr size_t WS_QB = WS_H + al256((size_t)MPAD * D * 2);
constexpr size_t WS_KB = WS_QB + al256((size_t)MPAD * 1024 * 2);
constexpr size_t WS_VB = WS_KB + al256((size_t)MPAD * 1024 * 2);
constexpr size_t WS_ALO = WS_VB + al256((size_t)MPAD * 1024 * 2);
constexpr size_t WS_O = WS_ALO + al256((size_t)MPAD * KLO * 2);
constexpr size_t WS_GB = WS_O + al256((size_t)MPAD * D * 2);
constexpr size_t WS_YL = WS_GB + al256((size_t)MT * 2048 * 2);
constexpr size_t WS_QS = WS_YL + al256((size_t)MP * 1024 * 2);
constexpr size_t WS_ZP = WS_QS + al256((size_t)MP * 1024 * 2);
constexpr size_t WS_SST = WS_ZP + al256((size_t)64 * NS * 2 * 4096 * 4);
constexpr size_t WS_X1 = WS_SST + al256((size_t)64 * NS * 4096 * 4);
constexpr size_t WS_PML = WS_X1 + al256((size_t)MPAD * D * 4);
constexpr size_t WS_RA = WS_PML + al256((size_t)3 * MP * 16 * 2 * 4);
constexpr size_t WS_RW = WS_RA;
constexpr size_t WS_L = WS_RW + al256((size_t)MPAD * CSH * 2);
constexpr size_t RA_BYTES_1 = al256((size_t)MPAD * CSH * 2) + al256((size_t)MPAD * NLO * 2);
constexpr size_t RA_BYTES_2 = al256((size_t)MPAD * FF2 * 2);
constexpr size_t WS_U = WS_RA;
constexpr size_t WS_RB = WS_RA + (RA_BYTES_1 > RA_BYTES_2 ? RA_BYTES_1 : RA_BYTES_2);
constexpr size_t WS_PART = WS_RB;
constexpr size_t WS_ACT = WS_RB;
constexpr size_t RB_BYTES_1 = al256((size_t)3 * MP * 1024 * 2);
constexpr size_t RB_BYTES_2 = al256((size_t)MPAD * FF * 2);
constexpr size_t WS_RSS = WS_RB + (RB_BYTES_1 > RB_BYTES_2 ? RB_BYTES_1 : RB_BYTES_2);
constexpr size_t WS_BAR_ = 0; constexpr size_t WS_BAR = al256((size_t)MPAD * 4) + WS_RB + (RB_BYTES_1 > RB_BYTES_2 ? RB_BYTES_1 : RB_BYTES_2);
constexpr size_t BAR_BYTES = 16384;
constexpr size_t WS_END = WS_BAR + BAR_BYTES;

struct Args {
    const float* in[28];
    float* out;
    unsigned char* ws;
    int ph_lo, ph_hi;
};
enum { I_XP = 0, I_XS, I_CK, I_CV, I_SSH, I_SWKV, I_SFFN, I_NMG, I_WIN, I_AOG, I_MU, I_W0, I_WUP, I_A0, I_AUP, I_GUP,
       I_KK, I_KA, I_RK, I_LNW, I_LNB, I_WO, I_NFG, I_FUP, I_FCW, I_FCB, I_FDN, I_NFIN };

typedef float f32x2c __attribute__((ext_vector_type(2)));
typedef __bf16 bf16x2c __attribute__((ext_vector_type(2)));
DI unsigned pk2(float lo, float hi) { const f32x2c v = {lo, hi}; return __builtin_bit_cast(unsigned, __builtin_convertvector(v, bf16x2c)); }
DI unsigned bf_rne(float f) { return pk2(f, 0.f) & 0xffffu; }
DI unsigned cvt_pk(float lo, float hi) { return pk2(lo, hi); }
DI void atomic_add_f32(float* p, float v) { (void)__builtin_amdgcn_global_atomic_fadd_f32((__attribute__((address_space(1))) float*)p, v); }
DI float bf2f(unsigned short b) { return __uint_as_float(((unsigned)b) << 16); }
#define DPP_ADD(v, ctrl) ((v) + __int_as_float(__builtin_amdgcn_update_dpp(0, __float_as_int(v), (ctrl), 0xf, 0xf, false)))
DI float wave_sum(float v) {
    v = DPP_ADD(v, 0xB1);
    v = DPP_ADD(v, 0x4E);
    v = DPP_ADD(v, 0x141);
    v = DPP_ADD(v, 0x140);
    const float s0 = __int_as_float(__builtin_amdgcn_readlane(__float_as_int(v), 0)), s1 = __int_as_float(__builtin_amdgcn_readlane(__float_as_int(v), 16));
    const float s2 = __int_as_float(__builtin_amdgcn_readlane(__float_as_int(v), 32)), s3 = __int_as_float(__builtin_amdgcn_readlane(__float_as_int(v), 48));
    return (s0 + s1) + (s2 + s3);
}

namespace pg8 {
constexpr int BM = 256, BK = 64, HALF = 128, HTB = HALF * BK * 2, STAGE_BYTES = 8 * HTB, NXCD = 8, WGM = 8;
DI int lds_byte(int r, int c) { const int st = (r >> 4) * 2 + (c >> 5), rr = r & 15, cc = c & 31, ob = rr * 64 + cc * 2; return st * 1024 + (ob ^ (((ob >> 9) & 1) << 5)); }
DI void stage_rc(int b, int& R, int& C) { const int st = b / 1024, sb = b % 1024, swz = sb ^ (((sb >> 9) & 1) << 5); R = (st >> 1) * 16 + swz / 64; C = (st & 1) * 32 + (swz % 64) / 2; }
struct Unit { int pm, pn; };
struct Gemm { const bf16_t* A; const bf16_t* Bt; int M, N, K; };
struct StaticOrder {
    int nM, nN, nwg, G, c;
    DI void init(int M, int N, int G_, int c_) { nM = M / BM; nN = N / BM; nwg = nM * nN; G = G_; c = c_; }
    DI bool next(int i, Unit& u) const {
        const long L = (long)i * G + c; if (L >= nwg) return false;
        int wgid = (int)L; { const int q = nwg / NXCD, r = nwg % NXCD, xcd = wgid % NXCD, off = wgid / NXCD; wgid = (xcd < r ? xcd * (q + 1) : r * (q + 1) + (xcd - r) * q) + off; }
        const int nig = WGM * nN, gid = wgid / nig, fm = gid * WGM, gsz = (nM - fm) < WGM ? (nM - fm) : WGM;
        u.pm = fm + ((wgid % nig) % gsz); u.pn = (wgid % nig) / gsz; return true;
    }
};

template <class Epi>
DI void gemm_phase(LAS unsigned char* lds, const Gemm g, const StaticOrder& S, const Epi& E) {
    const int tid = threadIdx.x, wid = __builtin_amdgcn_readfirstlane(tid >> 6), lane = tid & 63, wr = wid >> 2, wc = wid & 3, fr = lane & 15, fq = lane >> 4;
    const int K = g.K, nt = K / BK;
    unsigned voffA[2];
#pragma unroll
    for (int i = 0; i < 2; ++i) { int R, C; stage_rc(tid * 16 + i * 8192, R, C); voffA[i] = (unsigned)(R * K + C) * 2u; }
    const size_t kstep = (size_t)(BK * 2);
    const size_t hstep = (size_t)HALF * K * 2;
    const size_t tstep = 2 * hstep;
    const unsigned ldsw = (unsigned)wid * 1024u;
    const int aoff = lds_byte(wr * 64 + fr, fq * 8), boff = lds_byte(wc * 32 + fr, fq * 8);
#define PG8_SA(b, h) (((b) * 2 + (h)) * HTB)
#define PG8_SB(b, h) ((4 + (b) * 2 + (h)) * HTB)
#define PG8_STAGE(bufoff, gbase, voff) do { _Pragma("unroll") for (int _i = 0; _i < 2; ++_i) \
        __builtin_amdgcn_global_load_lds((const unsigned*)((const char*)(gbase) + (voff)[_i]), (LAS unsigned*)(lds + (bufoff) + ldsw + _i * 8192), 16, 0, 0); } while (0)
#define PG8_LDA(dst, b, h) do { _Pragma("unroll") for (int m = 0; m < 4; ++m) _Pragma("unroll") for (int k = 0; k < 2; ++k) dst[m][k] = *(const LAS bf16x8*)(lds + PG8_SA(b, h) + aoff + m * 2048 + k * 1024); } while (0)
#define PG8_LDB(dst, b, h) do { _Pragma("unroll") for (int n = 0; n < 2; ++n) _Pragma("unroll") for (int k = 0; k < 2; ++k) dst[n][k] = *(const LAS bf16x8*)(lds + PG8_SB(b, h) + boff + n * 2048 + k * 1024); } while (0)
#define PG8_MMA(ai, bj, At, Bt) do { __builtin_amdgcn_s_setprio(1); _Pragma("unroll") for (int m = 0; m < 4; ++m) _Pragma("unroll") for (int n = 0; n < 2; ++n) _Pragma("unroll") for (int k = 0; k < 2; ++k) \
        acc[ai][bj][m][n] = __builtin_amdgcn_mfma_f32_16x16x32_bf16(Bt[n][k], At[m][k], acc[ai][bj][m][n], 0, 0, 0); __builtin_amdgcn_s_setprio(0); } while (0)
#define PG8_WAIT_V(n) asm volatile("s_waitcnt vmcnt(" #n ")" ::: "memory")
#define PG8_WAIT_L(n) asm volatile("s_waitcnt lgkmcnt(" #n ")" ::: "memory")
#define PG8_BAR __builtin_amdgcn_s_barrier()
#define PG8_SCHED __builtin_amdgcn_sched_barrier(0)
    Unit cur, nxt; int ui = 0;
    if (!S.next(0, cur)) return;
    f32x4 acc[2][2][4][2];
#pragma unroll
    for (int a = 0; a < 2; ++a)
#pragma unroll
        for (int b = 0; b < 2; ++b)
#pragma unroll
            for (int m = 0; m < 4; ++m)
#pragma unroll
                for (int n = 0; n < 2; ++n) acc[a][b][m][n] = (f32x4){0.f, 0.f, 0.f, 0.f};
    bf16x8 At[4][2], B0[2][2], B1[2][2];
    const char* cA = (const char*)g.A + (size_t)cur.pm * tstep; const char* cB = (const char*)g.Bt + (size_t)cur.pn * tstep;
    PG8_STAGE(PG8_SB(0, 0), cB, voffA); PG8_STAGE(PG8_SA(0, 0), cA, voffA); PG8_STAGE(PG8_SB(0, 1), cB + hstep, voffA); PG8_STAGE(PG8_SA(0, 1), cA + hstep, voffA);
    if (wr == 1) PG8_BAR;
    PG8_WAIT_V(4); PG8_BAR;
    PG8_STAGE(PG8_SB(1, 0), cB + kstep, voffA); PG8_STAGE(PG8_SA(1, 0), cA + kstep, voffA); PG8_STAGE(PG8_SB(1, 1), cB + hstep + kstep, voffA);
    PG8_WAIT_V(6); PG8_BAR;
    for (;;) {
        const bool has_next = S.next(ui + 1, nxt);
        const char* nA = has_next ? (const char*)g.A + (size_t)nxt.pm * tstep : cA; const char* nB = has_next ? (const char*)g.Bt + (size_t)nxt.pn * tstep : cB;
        for (int t = 0; t < nt; t += 2) {
            const bool last = (t == nt - 2);
            const char* a1 = cA + (size_t)(t + 1) * kstep;
            const char* a2 = last ? nA : cA + (size_t)(t + 2) * kstep; const char* b2 = last ? nB : cB + (size_t)(t + 2) * kstep;
            const char* a3 = a2 + kstep; const char* b3 = b2 + kstep;
            PG8_LDB(B0, 0, 0); PG8_SCHED; PG8_LDA(At, 0, 0); PG8_STAGE(PG8_SA(1, 1), a1 + hstep, voffA);
            PG8_WAIT_L(8); PG8_BAR; PG8_WAIT_L(0); PG8_MMA(0, 0, At, B0); PG8_BAR; PG8_SCHED;
            PG8_LDB(B1, 0, 1); PG8_STAGE(PG8_SB(0, 0), b2, voffA);
            PG8_BAR; PG8_WAIT_L(0); PG8_MMA(0, 1, At, B1); PG8_BAR;
            PG8_LDA(At, 0, 1); PG8_STAGE(PG8_SA(0, 0), a2, voffA);
            PG8_BAR; PG8_WAIT_L(0); PG8_MMA(1, 0, At, B0); PG8_BAR; PG8_SCHED;
            PG8_STAGE(PG8_SB(0, 1), b2 + hstep, voffA);
            PG8_WAIT_V(6); PG8_BAR; PG8_MMA(1, 1, At, B1); PG8_BAR;
            PG8_LDB(B0, 1, 0); PG8_SCHED; PG8_LDA(At, 1, 0); PG8_STAGE(PG8_SA(0, 1), a2 + hstep, voffA);
            PG8_WAIT_L(8); PG8_BAR; PG8_WAIT_L(0); PG8_MMA(0, 0, At, B0); PG8_BAR; PG8_SCHED;
            PG8_LDB(B1, 1, 1); PG8_STAGE(PG8_SB(1, 0), b3, voffA);
            PG8_BAR; PG8_WAIT_L(0); PG8_MMA(0, 1, At, B1); PG8_BAR;
            PG8_LDA(At, 1, 1); PG8_STAGE(PG8_SA(1, 0), a3, voffA);
            PG8_BAR; PG8_WAIT_L(0); PG8_MMA(1, 0, At, B0); PG8_BAR; PG8_SCHED;
            PG8_STAGE(PG8_SB(1, 1), b3 + hstep, voffA);
            PG8_WAIT_V(6); PG8_BAR; PG8_MMA(1, 1, At, B1); PG8_BAR;
        }
        E(acc, cur, wr, wc, fr, fq);
        if (!has_next) break;
#pragma unroll
        for (int a = 0; a < 2; ++a)
#pragma unroll
            for (int b = 0; b < 2; ++b)
#pragma unroll
                for (int m = 0; m < 4; ++m)
#pragma unroll
                    for (int n = 0; n < 2; ++n) acc[a][b][m][n] = (f32x4){0.f, 0.f, 0.f, 0.f};
        cur = nxt; cA = nA; cB = nB; ++ui;
    }
    PG8_WAIT_V(0);
    if (wr == 0) PG8_BAR;
    PG8_BAR;
#undef PG8_SA
#undef PG8_SB
#undef PG8_STAGE
#undef PG8_LDA
#undef PG8_LDB
#undef PG8_MMA
#undef PG8_WAIT_V
#undef PG8_WAIT_L
#undef PG8_BAR
#undef PG8_SCHED
}
}

DI size_t hm64(int row, int h)  { return ((size_t)((row >> 11) * 16 + h) * SEQ + (row & (SEQ - 1))) * 64; }
typedef f32x4 AccT[2][2][4][2];
#define EPI_LOOP_BEGIN \
    const int row0 = u.pm * 256 + wr * 64 + fr, col0 = u.pn * 256 + wc * 32 + 4 * fq; \
    _Pragma("unroll") for (int ai = 0; ai < 2; ++ai) _Pragma("unroll") for (int m = 0; m < 4; ++m) { const int row = row0 + ai * 128 + m * 16; \
    _Pragma("unroll") for (int bj = 0; bj < 2; ++bj) _Pragma("unroll") for (int n = 0; n < 2; ++n) { const int col = col0 + bj * 128 + n * 16; const f32x4 v = acc[ai][bj][m][n];
#define EPI_LOOP_END } }
#define EPI_LOOP_BEGIN_S \
    const int row0 = u.pm * 256 + wr * 64 + fr, col0 = u.pn * 256 + wc * 32 + 4 * fq; \
    _Pragma("unroll") for (int ai = 0; ai < 2; ++ai) _Pragma("unroll") for (int m = 0; m < 4; ++m) { const int row = row0 + ai * 128 + m * 16; \
    _Pragma("unroll") for (int bj = 0; bj < 2; ++bj) _Pragma("unroll") for (int n = 0; n < 2; ++n) { const int col = col0 + bj * 128 + n * 16; const f32x4 v = acc[ai][bj][m][n] * rs[ai][m];

struct EpiIn {
    bf16_t *Qb, *Kb, *Vb; bf16_t* RW; float* out;
    DI void operator()(const AccT& acc, const pg8::Unit& u, int wr, int wc, int fr, int fq) const {
        const int reg = u.pn < 4 ? 0 : (u.pn < 8 ? 1 : (u.pn < 12 ? 2 : 3));
        EPI_LOOP_BEGIN
            if (row < MT) {
                if (reg == 0) {
                    constexpr float QS_ = 0.125f * 1.44269504088896f;
                    u32x2 w; w.x = cvt_pk(v[0] * QS_, v[1] * QS_); w.y = cvt_pk(v[2] * QS_, v[3] * QS_);
                    *(u32x2*)(row < MP ? Qb + hm64(row, col >> 6) + (col & 63) : Qb + (size_t)row * 1024 + col) = w;
                } else if (reg == 1 || reg == 2) {
                    const int c = col - (reg == 1 ? 1024 : 2048);
                    float* o = row < MP ? out + (reg == 1 ? O_PK : O_PV) + (size_t)row * 1024 + c : out + (reg == 1 ? O_SK : O_SV) + (size_t)(row - MP) * 1024 + c;
                    *(f32x4*)o = v;
                    if (row < MP) { u32x2 w; w.x = cvt_pk(v[0], v[1]); w.y = cvt_pk(v[2], v[3]);
                        *(u32x2*)((reg == 1 ? Kb : Vb) + hm64(row, c >> 6) + (c & 63)) = w; }
                } else {
                    const int c = col - 3072;
                    if (c < CSH) {
                        { u32x2 w; w.x = cvt_pk(v[0], v[1]); w.y = cvt_pk(v[2], v[3]); *(u32x2*)(RW + (size_t)row * CSH + c) = w; }
                        if (row >= MP) *(f32x4*)(out + O_SRW + (size_t)(row - MP) * CSH + c) = v;
                        else if ((row & (SEQ - 1)) == SEQ - 1) *(f32x4*)(out + O_PRW + (size_t)(row >> 11) * CSH + c) = v;
                    }
                }
            }
        EPI_LOOP_END
    }
};
struct EpiBf {
    bf16_t* C; int ldc;
    DI void operator()(const AccT& acc, const pg8::Unit& u, int wr, int wc, int fr, int fq) const {
        const int row0 = u.pm * 256 + wr * 64 + fr, col0 = u.pn * 256 + wc * 32 + 4 * fq;
#pragma unroll
        for (int ai = 0; ai < 2; ++ai)
#pragma unroll
            for (int m = 0; m < 4; ++m) { const int row = row0 + ai * 128 + m * 16;
#pragma unroll
                for (int bj = 0; bj < 2; ++bj)
#pragma unroll
                    for (int n = 0; n < 2; ++n) { const int col = col0 + bj * 128 + n * 16; const f32x4 v = acc[ai][bj][m][n];
                        u32x2 w; w.x = cvt_pk(v[0], v[1]); w.y = cvt_pk(v[2], v[3]);
                        *(u32x2*)(C + (size_t)row * ldc + col) = w; }
                asm volatile("" ::: "memory");
            }
    }
};
struct EpiWo {
    const float *xp; const float* gf; float* X1; bf16_t* H; float* RSS;
    DI void operator()(const AccT& acc, const pg8::Unit& u, int wr, int wc, int fr, int fq) const {
        const int row0 = u.pm * 256 + wr * 64 + fr, col0 = u.pn * 256 + wc * 32 + 4 * fq;
#pragma unroll
        for (int ai = 0; ai < 2; ++ai)
#pragma unroll
            for (int m = 0; m < 4; ++m) {
                const int row = row0 + ai * 128 + m * 16; float ss = 0.f;
#pragma unroll
                for (int bj = 0; bj < 2; ++bj)
#pragma unroll
                    for (int n = 0; n < 2; ++n) {
                        const int col = col0 + bj * 128 + n * 16;
                        const f32x4 x1 = *(const f32x4*)(xp + (size_t)row * D + col) + acc[ai][bj][m][n];
                        *(f32x4*)(X1 + (size_t)row * D + col) = x1;
                        const f32x4 gg = *(const f32x4*)(gf + col);
                        u32x2 w; w.x = cvt_pk(x1[0] * gg[0], x1[1] * gg[1]); w.y = cvt_pk(x1[2] * gg[2], x1[3] * gg[3]);
                        *(u32x2*)(H + (size_t)row * D + col) = w;
                        ss += (x1[0] * x1[0] + x1[1] * x1[1]) + (x1[2] * x1[2] + x1[3] * x1[3]);
                    }
                ss += __shfl_xor(ss, 16); ss += __shfl_xor(ss, 32);
                if (fq == 0) atomic_add_f32(RSS + row, ss);
            }
    }
};
struct EpiUp {
    bf16_t* U; float* out; const float* RSS;
    DI void operator()(const AccT& acc, const pg8::Unit& u, int wr, int wc, int fr, int fq) const {
        float rs[2][4];
        { const int row0_ = u.pm * 256 + wr * 64 + fr;
#pragma unroll
          for (int ai = 0; ai < 2; ++ai)
#pragma unroll
              for (int m = 0; m < 4; ++m) rs[ai][m] = rsqrtf(RSS[row0_ + ai * 128 + m * 16] * (1.f / D) + 1e-6f); }
        EPI_LOOP_BEGIN_S
            if (row < MT) {
                u32x2 w; w.x = cvt_pk(v[0], v[1]); w.y = cvt_pk(v[2], v[3]);
                *(u32x2*)(U + (size_t)row * FF2 + col) = w;
                if (row >= MP) *(f32x4*)(out + O_SFFN + (size_t)(row - MP) * 2 * FF2 + FF2 + col) = v;
                else if ((row & (SEQ - 1)) >= SEQ - 2) *(f32x4*)(out + O_PFFN + ((size_t)(row >> 11) * 2 + ((row & (SEQ - 1)) - (SEQ - 2))) * FF2 + col) = v;
            }
        EPI_LOOP_END
    }
};
#ifndef MK_P11_SCALE
#define MK_P11_SCALE 1.0f
#endif
struct EpiDn {
    float* X1;
    DI void operator()(const AccT& acc, const pg8::Unit& u, int wr, int wc, int fr, int fq) const {
        EPI_LOOP_BEGIN
            if (row < MT) { float* p = X1 + (size_t)row * D + col; *(f32x4*)p = *(const f32x4*)p + v * MK_P11_SCALE; }
        EPI_LOOP_END
    }
};

DI void transpose_item(const float* W, int K, int N, bf16_t* WT, int ldt, float* scr, int item, int lane) {
    const int nblk = N / 32, kb = item / nblk, nb = item % nblk, k0 = 64 * kb, n0 = 32 * nb;
#pragma unroll 8
    for (int i = 0; i < 32; ++i) { const int kk = 2 * i + (lane >> 5); scr[kk * 33 + (lane & 31)] = W[(size_t)(k0 + kk) * N + n0 + (lane & 31)]; }
    __builtin_amdgcn_fence(__ATOMIC_RELEASE, "wavefront"); asm volatile("s_waitcnt lgkmcnt(0)" ::: "memory");
    const int c = lane & 7;
#pragma unroll
    for (int j = 0; j < 4; ++j) { const int n = (lane >> 3) + 8 * j; const float* s = scr + (8 * c) * 33 + n;
        u32x4 o; o.x = pk2(s[0 * 33], s[1 * 33]); o.y = pk2(s[2 * 33], s[3 * 33]); o.z = pk2(s[4 * 33], s[5 * 33]); o.w = pk2(s[6 * 33], s[7 * 33]);
        *(u32x4*)(WT + (size_t)(n0 + n) * ldt + k0 + 8 * c) = o; }
    asm volatile("s_waitcnt lgkmcnt(0)" ::: "memory");
}
DI void rms_row_bf16(const float* xrow, const float* g, bf16_t* orow, int lane) {
    const f32x4* xr = (const f32x4*)xrow + lane; const f32x4* gr = (const f32x4*)g + lane;
    f32x4 v[8]; float s = 0.f;
#pragma unroll
    for (int j = 0; j < 8; ++j) { v[j] = xr[64 * j]; s += (v[j].x * v[j].x + v[j].y * v[j].y) + (v[j].z * v[j].z + v[j].w * v[j].w); }
    const float rstd = rsqrtf(wave_sum(s) * (1.f / D) + 1e-6f);
    u32x2* o8 = (u32x2*)orow + lane;
#pragma unroll
    for (int j = 0; j < 8; ++j) { const f32x4 gg = gr[64 * j]; u32x2 w; w.x = pk2(v[j].x * rstd * gg.x, v[j].y * rstd * gg.y); w.y = pk2(v[j].z * rstd * gg.z, v[j].w * rstd * gg.w); o8[64 * j] = w; }
}
DI void rms_row_f32(const float* xrow, const float* g, float* orow, int lane) {
    const f32x4* xr = (const f32x4*)xrow + lane; const f32x4* gr = (const f32x4*)g + lane;
    f32x4 v[8]; float s = 0.f;
#pragma unroll
    for (int j = 0; j < 8; ++j) { v[j] = xr[64 * j]; s += (v[j].x * v[j].x + v[j].y * v[j].y) + (v[j].z * v[j].z + v[j].w * v[j].w); }
    const float rstd = rsqrtf(wave_sum(s) * (1.f / D) + 1e-6f);
    f32x4* o = (f32x4*)orow + lane;
#pragma unroll
    for (int j = 0; j < 8; ++j) { const f32x4 gg = gr[64 * j]; o[64 * j] = v[j] * rstd * gg; }
}
DI void zero_row_bf16(bf16_t* orow, int ncols, int lane) {
    for (int c = lane * 8; c < ncols; c += 512) *(u32x4*)(orow + c) = (u32x4){0u, 0u, 0u, 0u};
}

DI void phase_prologue(const Args& a, unsigned char* lds, int gw, int ngw, int lane, int wave) {
    unsigned char* ws = a.ws;
    float* scr = (float*)(lds + wave * 16384);
    bf16_t* Win = (bf16_t*)(ws + WS_WIN); bf16_t* Wlo = (bf16_t*)(ws + WS_WLO);
    constexpr int IT_IN = (D / 64) * (CIN / 32);
    for (int it = gw; it < IT_IN; it += ngw) transpose_item(a.in[I_WIN], D, CIN, Win, D, scr, it, lane);
    for (int r = CIN + gw; r < NIN; r += ngw) zero_row_bf16(Win + (size_t)r * D, D, lane);
    {
        const int gt = gw * 64 + lane, ngt = ngw * 64;
        for (int i = gt; i < NLO * KLO; i += ngt) {
            const int n = i / KLO, k = i % KLO; float v = 0.f;
            if (n < 1024) { if (k < 64) v = a.in[I_WUP][k * 1024 + n]; }
            else if (n < 2048) { if (k >= 64 && k < 128) v = a.in[I_AUP][(k - 64) * 1024 + (n - 1024)]; }
            else { if (k >= 128 && k < 288) v = a.in[I_GUP][(k - 128) * 1024 + (n - 2048)]; }
            Wlo[i] = (bf16_t)bf_rne(v);
        }
    }
    { float* RSS = (float*)(ws + WS_RSS); for (int i = gw * 64 + lane; i < MPAD; i += ngw * 64) RSS[i] = 0.f; }
    bf16_t* H = (bf16_t*)(ws + WS_H);
    for (int m = gw; m < MPAD; m += ngw) {
        if (m < MT) rms_row_bf16(m < MP ? a.in[I_XP] + (size_t)m * D : a.in[I_XS] + (size_t)(m - MP) * D, a.in[I_NMG], H + (size_t)m * D, lane);
        else zero_row_bf16(H + (size_t)m * D, D, lane);
    }
}


DI void convert_wo_wup(const Args& a, unsigned char* lds, int wi, int nw, int wave, int lane) {
    float* scr = (float*)(lds + wave * 16384);
    constexpr int IT_O = (D / 64) * (D / 32), IT_UP = (D / 64) * (FF2 / 32);
    for (int it = wi; it < IT_O + IT_UP; it += nw) {
        if (it < IT_O) transpose_item(a.in[I_WO], D, D, (bf16_t*)(a.ws + WS_WO), D, scr, it, lane);
        else transpose_item(a.in[I_FUP], D, FF2, (bf16_t*)(a.ws + WS_WUP), D, scr, it - IT_O, lane);
    }
}
DI void convert_wdn(const Args& a, unsigned char* lds, int wi, int nw, int wave, int lane) {
    float* scr = (float*)(lds + wave * 16384);
    constexpr int IT_DN = (FF / 64) * (D / 32);
    for (int it = wi; it < IT_DN; it += nw) transpose_item(a.in[I_FDN], FF, D, (bf16_t*)(a.ws + WS_WDN), FF, scr, it, lane);
}

DI float rw_prev_val(const Args& a, const bf16_t* RW, int m, int j) {
    if (m < MP) return (m & (SEQ - 1)) == 0 ? 0.f : bf2f(RW[(size_t)(m - 1) * CSH + j]);
    return a.in[I_SSH][(size_t)(m - MP) * CSH + j];
}
DI void lora_input_row(const Args& a, int m, int lane) {
    bf16_t* ALO = (bf16_t*)(a.ws + WS_ALO) + (size_t)m * KLO;
    if (m >= MT) { for (int c = lane; c < KLO; c += 64) ALO[c] = 0; return; }
    const bf16_t* RW = (const bf16_t*)(a.ws + WS_RW);
    const bf16_t* cur = RW + (size_t)m * CSH;
    for (int c = lane; c < KLO; c += 64) {
        float v = 0.f;
        if (c < 288) {
            const int j = 3072 + c; const float x = bf2f(cur[j]), p = rw_prev_val(a, RW, m, j); const float xs = x + a.in[I_MU][j] * (p - x);
            v = c < 64 ? 1.f - 2.f * __builtin_amdgcn_rcpf(1.f + __expf(2.f * xs)) : (c < 128 ? xs : __builtin_amdgcn_rcpf(1.f + __expf(-xs)));
        }
        ALO[c] = (bf16_t)bf_rne(v);
    }
}

DI int crow(int reg, int h) { return (reg & 3) + 8 * (reg >> 2) + 4 * h; }
typedef short s16x4 __attribute__((ext_vector_type(4)));
constexpr int VPITCH = 192;
DI void attn_prompt_unit(const Args& a, unsigned char* lds, int unit, int wave, int lane) {
    const bf16_t* Qb = (const bf16_t*)(a.ws + WS_QB); const bf16_t* Kb = (const bf16_t*)(a.ws + WS_KB); const bf16_t* Vb = (const bf16_t*)(a.ws + WS_VB);
    bf16_t* PO = (bf16_t*)(a.ws + WS_PART); float* PML = (float*)(a.ws + WS_PML);
    LAS unsigned char* img = (LAS unsigned char*)lds + wave * (32 * VPITCH);
    const int blk = unit & 63, br = (unit >> 6) % 3, bh = unit / 192, b = bh >> 4, h = bh & 15;
    const int rate = br == 0 ? 1 : (br == 1 ? 4 : 16), L = SEQ / rate, bpc = L / 32;
    const int rho = blk / bpc, l0 = (blk % bpc) * 32;
    const int r = lane & 31, hh = lane >> 5;
    const int mq = b * SEQ + rho + rate * (l0 + r);
    bf16x8 qf[4];
#pragma unroll
    for (int ks = 0; ks < 4; ++ks) qf[ks] = *(const bf16x8*)(Qb + ((size_t)bh * SEQ + rho + rate * (l0 + r)) * 64 + ks * 16 + 8 * hh);
    f32x16 o0, o1;
#pragma unroll
    for (int i = 0; i < 16; ++i) { o0[i] = 0.f; o1[i] = 0.f; }
    float mrun = -1e30f, lrun = 0.f;
    const int lq = l0 + r;
    const int c0 = l0 >= 128 ? 0 : (128 - l0) >> 5;
    const bf16_t* kbase = Kb + ((size_t)bh * SEQ + rho) * 64 + 8 * hh;
    const bf16_t* vbase = Vb + ((size_t)bh * SEQ + rho) * 64 + 8 * (lane & 7);
    bf16x8 kreg[4]; u32x4 vreg[4];
#define AT_PREFETCH(ch_) do { const int lk0_ = l0 - 128 + 32 * (ch_); \
        _Pragma("unroll") for (int ks = 0; ks < 4; ++ks) kreg[ks] = *(const bf16x8*)(kbase + (size_t)(rate * (lk0_ + r)) * 64 + ks * 16); \
        _Pragma("unroll") for (int i = 0; i < 4; ++i) vreg[i] = *(const u32x4*)(vbase + (size_t)(rate * (lk0_ + 8 * i + (lane >> 3))) * 64); } while (0)
    AT_PREFETCH(c0);
    const int i16 = lane & 15, tq = i16 >> 2, tp = i16 & 3, g16 = (lane >> 4) & 1;
    const unsigned troff = (unsigned)((4 * hh + tq) * VPITCH + g16 * 32 + 8 * tp);
    for (int ch = c0; ch < 5; ++ch) {
        const int lk0 = l0 - 128 + 32 * ch;
        bf16x8 kf[4];
#pragma unroll
        for (int ks = 0; ks < 4; ++ks) kf[ks] = kreg[ks];
#pragma unroll
        for (int i = 0; i < 4; ++i) *(LAS u32x4*)(img + (8 * i + (lane >> 3)) * VPITCH + 16 * (lane & 7)) = vreg[i];
        if (ch + 1 < 5) AT_PREFETCH(ch + 1);
        f32x16 st;
#pragma unroll
        for (int i = 0; i < 16; ++i) st[i] = 0.f;
#pragma unroll
        for (int ks = 0; ks < 4; ++ks) st = __builtin_amdgcn_mfma_f32_32x32x16_bf16(kf[ks], qf[ks], st, 0, 0, 0);
        float cmax = -1e30f;
        if (ch == 0 || ch == 4) {
#pragma unroll
            for (int i = 0; i < 16; ++i) { const int lk = lk0 + crow(i, hh); const bool ok = (lk <= lq) && (lk >= lq - 128); st[i] = ok ? st[i] : -1e30f; }
        }
#pragma unroll
        for (int i = 0; i < 16; ++i) cmax = fmaxf(cmax, st[i]);
        cmax = fmaxf(cmax, __shfl_xor(cmax, 32));
        const float mnew = fmaxf(mrun, cmax), alpha = __builtin_amdgcn_exp2f(mrun - mnew);
        float ps = 0.f;
#pragma unroll
        for (int i = 0; i < 16; ++i) { const float p = __builtin_amdgcn_exp2f(st[i] - mnew); st[i] = p; ps += p; }
        lrun = lrun * alpha + ps; mrun = mnew;
#pragma unroll
        for (int i = 0; i < 16; ++i) { o0[i] *= alpha; o1[i] *= alpha; }
#pragma unroll
        for (int s = 0; s < 2; ++s) {
            u32x4 pp; pp.x = pk2(st[8 * s], st[8 * s + 1]); pp.y = pk2(st[8 * s + 2], st[8 * s + 3]); pp.z = pk2(st[8 * s + 4], st[8 * s + 5]); pp.w = pk2(st[8 * s + 6], st[8 * s + 7]);
            const bf16x8 pf = __builtin_bit_cast(bf16x8, pp);
#pragma unroll
            for (int dt = 0; dt < 2; ++dt) {
                const s16x4 lo = __builtin_amdgcn_ds_read_tr16_b64_v4i16((LAS s16x4*)(img + troff + (16 * s) * VPITCH + dt * 64));
                const s16x4 hi = __builtin_amdgcn_ds_read_tr16_b64_v4i16((LAS s16x4*)(img + troff + (16 * s + 8) * VPITCH + dt * 64));
                const bf16x8 vf = __builtin_shufflevector(lo, hi, 0, 1, 2, 3, 4, 5, 6, 7);
                if (dt == 0) o0 = __builtin_amdgcn_mfma_f32_32x32x16_bf16(vf, pf, o0, 0, 0, 0);
                else o1 = __builtin_amdgcn_mfma_f32_32x32x16_bf16(vf, pf, o1, 0, 0, 0);
            }
        }
    }
#undef AT_PREFETCH
    const float ltot = lrun + __shfl_xor(lrun, 32);
    bf16_t* po = PO + ((size_t)br * MP + mq) * 1024 + h * 64;
#pragma unroll
    for (int g = 0; g < 4; ++g) {
        u32x2 w0, w1; w0.x = pk2(o0[4 * g], o0[4 * g + 1]); w0.y = pk2(o0[4 * g + 2], o0[4 * g + 3]); w1.x = pk2(o1[4 * g], o1[4 * g + 1]); w1.y = pk2(o1[4 * g + 2], o1[4 * g + 3]);
        *(u32x2*)(po + 8 * g + 4 * hh) = w0; *(u32x2*)(po + 32 + 8 * g + 4 * hh) = w1;
    }
    if (hh == 0) { float* pm = PML + (((size_t)br * MP + mq) * 16 + h) * 2; pm[0] = mrun; pm[1] = ltot; }
}
DI float sum16(float v) { v = DPP_ADD(v, 0xB1); v = DPP_ADD(v, 0x4E); v = DPP_ADD(v, 0x141); v = DPP_ADD(v, 0x140); return v; }
DI void attn_merge_task(const Args& a, int task, int lane) {
    const int m = task >> 2, h = (task & 3) * 4 + (lane >> 4), d = 4 * (lane & 15);
    const bf16_t* PO = (const bf16_t*)(a.ws + WS_PART); const float* PML = (const float*)(a.ws + WS_PML);
    bf16_t* O = (bf16_t*)(a.ws + WS_O);
    float mb[3], lb[3]; f32x4 ob[3];
#pragma unroll
    for (int br = 0; br < 3; ++br) { const float* pm = PML + (((size_t)br * MP + m) * 16 + h) * 2; mb[br] = pm[0]; lb[br] = pm[1];
        const u32x2 w = *(const u32x2*)(PO + ((size_t)br * MP + m) * 1024 + h * 64 + d);
        ob[br] = (f32x4){__uint_as_float(w.x << 16), __uint_as_float(w.x & 0xffff0000u), __uint_as_float(w.y << 16), __uint_as_float(w.y & 0xffff0000u)}; }
    const float M = fmaxf(mb[0], fmaxf(mb[1], mb[2]));
    f32x4 num = {0.f, 0.f, 0.f, 0.f}; float den = 0.f;
#pragma unroll
    for (int br = 0; br < 3; ++br) { const float w = __builtin_amdgcn_exp2f(mb[br] - M); num += ob[br] * w; den += w * lb[br]; }
    const f32x4 o = num * __builtin_amdgcn_rcpf(den);
    const float ss = sum16(o.x * o.x + o.y * o.y + o.z * o.z + o.w * o.w) * (1.f / 64.f);
    const float rs = rsqrtf(ss + 1e-6f);
    const f32x4 gg = *(const f32x4*)(a.in[I_AOG] + h * 64 + d);
    u32x2 w; w.x = pk2(o.x * rs * gg.x, o.y * rs * gg.y); w.y = pk2(o.z * rs * gg.z, o.w * rs * gg.w);
    *(u32x2*)(O + (size_t)m * D + h * 64 + d) = w;
}
DI void attn_sample_wg(const Args& a, unsigned char* lds, int unit, int wave, int lane) {
    float* part = (float*)lds;
    const int bh = unit * 2 + (wave >> 2), qt = wave & 3, b = bh >> 4, h = bh & 15, g = lane >> 4, l16 = lane & 15;
    const bf16_t* Qb = (const bf16_t*)(a.ws + WS_QB);
    const float* ck = a.in[I_CK] + (size_t)b * 2048 * 1024 + h * 64 + 4 * l16; const float* cv = a.in[I_CV] + (size_t)b * 2048 * 1024 + h * 64 + 4 * l16;
    const float* nk = a.out + O_SK + (size_t)b * 1024 + h * 64 + 4 * l16; const float* nv = a.out + O_SV + (size_t)b * 1024 + h * 64 + 4 * l16;
    const u32x2 qw = *(const u32x2*)(Qb + (size_t)(MP + b) * 1024 + h * 64 + 4 * l16);
    const float q0 = __uint_as_float(qw.x << 16), q1 = __uint_as_float(qw.x & 0xffff0000u), q2 = __uint_as_float(qw.y << 16), q3 = __uint_as_float(qw.y & 0xffff0000u);
    float mrun = -1e30f, lrun = 0.f; f32x4 acc = {0.f, 0.f, 0.f, 0.f};
    const int e0 = qt * 97, e1 = e0 + 97 < 387 ? e0 + 97 : 387;
    for (int ito = 0; ito < 25; ito += 5) {
        f32x4 kv[5], vv[5]; bool valid[5];
#pragma unroll
        for (int k = 0; k < 5; ++k) {
            const int e = e0 + (ito + k) * 4 + g; valid[k] = e < e1;
            const int ee = valid[k] ? e : e0, br = ee / 129, j = ee % 129, rate = br == 0 ? 1 : (br == 1 ? 4 : 16);
            const int row = 2048 - rate * j;
            const float* kp = j == 0 ? nk : ck + (size_t)row * 1024; const float* vp = j == 0 ? nv : cv + (size_t)row * 1024;
            kv[k] = *(const f32x4*)kp; vv[k] = *(const f32x4*)vp;
        }
#pragma unroll
        for (int k = 0; k < 5; ++k) {
            float s = sum16(q0 * kv[k].x + q1 * kv[k].y + q2 * kv[k].z + q3 * kv[k].w);
            if (!valid[k]) s = -1e30f;
            const float mnew = fmaxf(mrun, s), alpha = __builtin_amdgcn_exp2f(mrun - mnew), p = valid[k] ? __builtin_amdgcn_exp2f(s - mnew) : 0.f;
            lrun = lrun * alpha + p; acc = acc * alpha + vv[k] * p; mrun = mnew;
        }
    }
#pragma unroll
    for (int o = 16; o < 64; o <<= 1) {
        const float mo = __shfl_xor(mrun, o), lo = __shfl_xor(lrun, o);
        f32x4 ao; ao.x = __shfl_xor(acc.x, o); ao.y = __shfl_xor(acc.y, o); ao.z = __shfl_xor(acc.z, o); ao.w = __shfl_xor(acc.w, o);
        const float mn = fmaxf(mrun, mo), w0 = __builtin_amdgcn_exp2f(mrun - mn), w1 = __builtin_amdgcn_exp2f(mo - mn);
        lrun = lrun * w0 + lo * w1; acc = acc * w0 + ao * w1; mrun = mn;
    }
    if (g == 0) { *(f32x4*)(part + wave * 68 + 4 * l16) = acc; if (l16 == 0) { part[wave * 68 + 64] = mrun; part[wave * 68 + 65] = lrun; } }
    __syncthreads();
    if (qt == 0 && g == 0) {
        float M = -1e30f;
#pragma unroll
        for (int w = 0; w < 4; ++w) M = fmaxf(M, part[(wave + w) * 68 + 64]);
        f32x4 num = {0.f, 0.f, 0.f, 0.f}; float den = 0.f;
#pragma unroll
        for (int w = 0; w < 4; ++w) { const float wt = __builtin_amdgcn_exp2f(part[(wave + w) * 68 + 64] - M); num += *(const f32x4*)(part + (wave + w) * 68 + 4 * l16) * wt; den += part[(wave + w) * 68 + 65] * wt; }
        const f32x4 o = num * (1.f / den);
        const float ss = sum16(o.x * o.x + o.y * o.y + o.z * o.z + o.w * o.w);
        const float rs = rsqrtf(ss * (1.f / 64.f) + 1e-6f);
        const f32x4 gg = *(const f32x4*)(a.in[I_AOG] + h * 64 + 4 * l16);
        u32x2 w; w.x = pk2(o.x * rs * gg.x, o.y * rs * gg.y); w.y = pk2(o.z * rs * gg.z, o.w * rs * gg.w);
        *(u32x2*)((bf16_t*)(a.ws + WS_O) + (size_t)(MP + b) * D + h * 64 + 4 * l16) = w;
    }
    __syncthreads();
}

struct PrepParams { float mu_r, mu_k, mu_v, w0, a0, kk, ka, rk; };
struct PrepRaw { float cr, ck, cv, pr, pk, pv, lw, la, lg; };
DI void prep_params(const Args& a, PrepParams& P, int c) {
    P.mu_r = a.in[I_MU][c]; P.mu_k = a.in[I_MU][1024 + c]; P.mu_v = a.in[I_MU][2048 + c];
    P.w0 = a.in[I_W0][c]; P.a0 = a.in[I_A0][c]; P.kk = a.in[I_KK][c]; P.ka = a.in[I_KA][c]; P.rk = a.in[I_RK][c];
}
DI void prep_load(const Args& a, PrepRaw& R, const bf16_t* RW, int m, const bf16_t* Lrow, int c) {
    const bf16_t* cur = RW + (size_t)m * CSH;
    R.cr = bf2f(cur[c]); R.ck = bf2f(cur[1024 + c]); R.cv = bf2f(cur[2048 + c]);
    R.pr = rw_prev_val(a, RW, m, c); R.pk = rw_prev_val(a, RW, m, 1024 + c); R.pv = rw_prev_val(a, RW, m, 2048 + c);
    R.lw = bf2f(Lrow[c]); R.la = bf2f(Lrow[1024 + c]); R.lg = bf2f(Lrow[2048 + c]);
}
DI void prep_finish(const PrepRaw& R, const PrepParams& P, float* dst, float& g_out, float& bonus_out, int lane) {
    const float xr = R.cr + P.mu_r * (R.pr - R.cr), xk = R.ck + P.mu_k * (R.pk - R.ck), xv = R.cv + P.mu_v * (R.pv - R.cv);
    const float x = -(P.w0 + R.lw);
    const float sp = x > 20.f ? x : __logf(1.f + __expf(x));
    const float decay = __expf(-__expf(-sp - 0.5f));
    const float av = __builtin_amdgcn_rcpf(1.f + __expf(-(P.a0 + R.la)));
    float kkv = xk * P.kk;
    const float n2 = wave_sum(kkv * kkv);
    kkv = kkv * fminf(__builtin_amdgcn_rsqf(n2), 1e12f);
    const float keff = xk * (1.f + (av - 1.f) * P.ka);
    const float bon = wave_sum(xr * keff * P.rk) * xv;
    dst[lane] = xr; dst[64 + lane] = decay; dst[128 + lane] = keff; dst[192 + lane] = xv; dst[256 + lane] = -kkv; dst[320 + lane] = kkv * av;
    g_out = R.lg; bonus_out = bon;
}
DI float scan_step(float (&S)[64], const float* sv, float vi) {
    const f32x4* r4 = (const f32x4*)sv; const f32x4* w4 = (const f32x4*)(sv + 64); const f32x4* k4 = (const f32x4*)(sv + 128);
    const f32x4* a4 = (const f32x4*)(sv + 256); const f32x4* b4 = (const f32x4*)(sv + 320);
    float sa0 = 0.f, sa1 = 0.f;
#pragma unroll
    for (int j = 0; j < 16; ++j) { const f32x4 av = a4[j]; sa0 = fmaf(S[4 * j], av.x, sa0); sa1 = fmaf(S[4 * j + 1], av.y, sa1); sa0 = fmaf(S[4 * j + 2], av.z, sa0); sa1 = fmaf(S[4 * j + 3], av.w, sa1); }
    const float sa = sa0 + sa1;
    float y0 = 0.f, y1 = 0.f;
#pragma unroll
    for (int j = 0; j < 16; ++j) {
        const f32x4 bv = b4[j], kv = k4[j], wv = w4[j], rv = r4[j];
        float t;
        t = fmaf(vi, kv.x, sa * bv.x); S[4 * j] = fmaf(S[4 * j], wv.x, t); y0 = fmaf(S[4 * j], rv.x, y0);
        t = fmaf(vi, kv.y, sa * bv.y); S[4 * j + 1] = fmaf(S[4 * j + 1], wv.y, t); y1 = fmaf(S[4 * j + 1], rv.y, y1);
        t = fmaf(vi, kv.z, sa * bv.z); S[4 * j + 2] = fmaf(S[4 * j + 2], wv.z, t); y0 = fmaf(S[4 * j + 2], rv.z, y0);
        t = fmaf(vi, kv.w, sa * bv.w); S[4 * j + 3] = fmaf(S[4 * j + 3], wv.w, t); y1 = fmaf(S[4 * j + 3], rv.w, y1);
        if ((j & 3) == 3) asm volatile("" ::: "memory");
    }
    return y0 + y1;
}
DI void rwkv_post(const Args& a, float y, float g, float bonus, int m, int c) {
    const float mean = wave_sum(y) * (1.f / 64.f); const float d = y - mean; const float var = wave_sum(d * d) * (1.f / 64.f);
    const float yn = d * rsqrtf(var + 64e-5f) * a.in[I_LNW][c] + a.in[I_LNB][c];
    ((bf16_t*)(a.ws + WS_O))[(size_t)m * D + 1024 + c] = (bf16_t)bf_rne((yn + bonus) * g);
}

#define WG_BAR_LDS() do { asm volatile("s_waitcnt lgkmcnt(0)" ::: "memory"); __builtin_amdgcn_s_barrier(); asm volatile("" ::: "memory"); } while (0)
typedef float f32x2 __attribute__((ext_vector_type(2)));
DI f32x2 fma2(f32x2 a, f32x2 b, f32x2 c) { return __builtin_elementwise_fma(a, b, c); }
DI void scan_dot_a(const f32x2 (&Z)[32], const f32x2 (&P)[32], const float* sv, float& sz, float& sp) {
    const f32x4* a4 = (const f32x4*)(sv + 256);
    f32x2 saz = {0.f, 0.f}, sap = {0.f, 0.f};
#pragma unroll
    for (int j = 0; j < 16; ++j) { const f32x4 av = a4[j]; const f32x2 a0 = {av.x, av.y}, a1 = {av.z, av.w};
        saz = fma2(Z[2 * j], a0, saz); sap = fma2(P[2 * j], a0, sap); saz = fma2(Z[2 * j + 1], a1, saz); sap = fma2(P[2 * j + 1], a1, sap);
        if ((j & 7) == 7) asm volatile("" ::: "memory"); }
    sz = saz.x + saz.y; sp = sap.x + sap.y;
}
DI void scan_step3(f32x2 (&Z)[32], f32x2 (&P)[32], const float* sv, const float* svn, float vi, float& sz, float& sp, float& yz, float& yp) {
    const f32x4* r4 = (const f32x4*)sv; const f32x4* w4 = (const f32x4*)(sv + 64); const f32x4* k4 = (const f32x4*)(sv + 128);
    const f32x4* b4 = (const f32x4*)(sv + 320); const f32x4* an4 = (const f32x4*)(svn + 256);
    const f32x2 sz2 = {sz, sz}, sp2 = {sp, sp}, v2 = {vi, vi};
    f32x2 yz2 = {0.f, 0.f}, yp2 = {0.f, 0.f}, nz2 = {0.f, 0.f}, np2 = {0.f, 0.f};
    f32x4 buf[3][5];
#define S3_LD(g, j) do { buf[g][0] = b4[j]; buf[g][1] = k4[j]; buf[g][2] = w4[j]; buf[g][3] = r4[j]; buf[g][4] = an4[j]; asm volatile("" ::: "memory"); } while (0)
    S3_LD(0, 0); S3_LD(1, 1);
#pragma unroll
    for (int j = 0; j < 16; ++j) {
        if (j + 2 < 16) S3_LD((j + 2) % 3, j + 2);
        const f32x4 bv = buf[j % 3][0], kv = buf[j % 3][1], wv = buf[j % 3][2], rv = buf[j % 3][3], av = buf[j % 3][4];
        { const f32x2 b2 = {bv.x, bv.y}, k2 = {kv.x, kv.y}, w2 = {wv.x, wv.y}, r2 = {rv.x, rv.y}, a2 = {av.x, av.y};
          f32x2 tz = sz2 * b2; tz = fma2(v2, k2, tz); Z[2 * j] = fma2(Z[2 * j], w2, tz); yz2 = fma2(Z[2 * j], r2, yz2); nz2 = fma2(Z[2 * j], a2, nz2);
          const f32x2 tp = sp2 * b2; P[2 * j] = fma2(P[2 * j], w2, tp); yp2 = fma2(P[2 * j], r2, yp2); np2 = fma2(P[2 * j], a2, np2); }
        { const f32x2 b2 = {bv.z, bv.w}, k2 = {kv.z, kv.w}, w2 = {wv.z, wv.w}, r2 = {rv.z, rv.w}, a2 = {av.z, av.w};
          f32x2 tz = sz2 * b2; tz = fma2(v2, k2, tz); Z[2 * j + 1] = fma2(Z[2 * j + 1], w2, tz); yz2 = fma2(Z[2 * j + 1], r2, yz2); nz2 = fma2(Z[2 * j + 1], a2, nz2);
          const f32x2 tp = sp2 * b2; P[2 * j + 1] = fma2(P[2 * j + 1], w2, tp); yp2 = fma2(P[2 * j + 1], r2, yp2); np2 = fma2(P[2 * j + 1], a2, np2); }
        asm volatile("" ::: "memory");
    }
#undef S3_LD
    yz = yz2.x + yz2.y; yp = yp2.x + yp2.y; sz = nz2.x + nz2.y; sp = np2.x + np2.y;
}
DI void scan_pass1_unit(const Args& a, unsigned char* lds, int unit, int wave, int lane) {
    float* stg = (float*)lds;
    const int pp = wave & 3, pair = unit * 4 + pp, chain = pair / NS, seg = pair % NS, b = chain >> 4, h = chain & 15, c = h * 64 + lane;
    const int mbase = b * SEQ + seg * SEGL;
    constexpr int NB = SEGL / TB;
    if (wave < 4) {
        bf16_t* YL = (bf16_t*)(a.ws + WS_YL); bf16_t* QS = (bf16_t*)(a.ws + WS_QS); float* ZP = (float*)(a.ws + WS_ZP);
        f32x2 Z[32], P[32];
        int idl = lane; asm volatile("" : "+v"(idl));
#pragma unroll
        for (int j = 0; j < 32; ++j) { Z[j] = (f32x2){0.f, 0.f}; P[j] = (f32x2){idl == 2 * j ? 1.f : 0.f, idl == 2 * j + 1 ? 1.f : 0.f}; }
        WG_BAR_LDS();
        for (int blk = 0; blk < NB; ++blk) {
            const float* sb = stg + (((blk & 1) * 4 + pp) * TB) * 384;
            float sz, sp; scan_dot_a(Z, P, sb, sz, sp);
#pragma unroll 1
            for (int tt = 0; tt < TB; ++tt) {
                const float* sv = sb + tt * 384; const float* svn = sb + (tt + 1 < TB ? tt + 1 : tt) * 384;
                float yz, yp; scan_step3(Z, P, sv, svn, sv[192 + lane], sz, sp, yz, yp);
                const size_t o = (size_t)(mbase + blk * TB + tt) * 1024 + c;
                const unsigned yq = pk2(yz, yp); YL[o] = (bf16_t)(yq & 0xffffu); QS[o] = (bf16_t)(yq >> 16);
            }
            WG_BAR_LDS();
        }
        float* zp = ZP + (size_t)pair * 2 * 4096 + lane * 64;
#pragma unroll
        for (int j = 0; j < 16; ++j) { *(f32x4*)(zp + 4 * j) = (f32x4){Z[2 * j].x, Z[2 * j].y, Z[2 * j + 1].x, Z[2 * j + 1].y};
                                       *(f32x4*)(zp + 4096 + 4 * j) = (f32x4){P[2 * j].x, P[2 * j].y, P[2 * j + 1].x, P[2 * j + 1].y}; }
    } else {
        const bf16_t* RW = (const bf16_t*)(a.ws + WS_RW); const bf16_t* Lb = (const bf16_t*)(a.ws + WS_L);
        bf16_t* GB = (bf16_t*)(a.ws + WS_GB);
        PrepParams Pm; prep_params(a, Pm, c);
        PrepRaw raw[TB];
#define P1_LOAD(blk_) do { _Pragma("unroll") for (int k = 0; k < TB; ++k) { const int m = mbase + (blk_) * TB + k; prep_load(a, raw[k], RW, m, Lb + (size_t)m * NLO, c); } } while (0)
#define P1_FINISH(blk_) do { _Pragma("unroll") for (int k = 0; k < TB; ++k) { const int m = mbase + (blk_) * TB + k; float g, bon; \
            prep_finish(raw[k], Pm, stg + ((((blk_) & 1) * 4 + pp) * TB + k) * 384, g, bon, lane); \
            GB[((size_t)m * 16 + h) * 128 + lane] = (bf16_t)bf_rne(g); GB[((size_t)m * 16 + h) * 128 + 64 + lane] = (bf16_t)bf_rne(bon); } } while (0)
        P1_LOAD(0); P1_FINISH(0); P1_LOAD(1);
        WG_BAR_LDS();
        for (int blk = 0; blk < NB; ++blk) {
            if (blk + 1 < NB) P1_FINISH(blk + 1);
            if (blk + 2 < NB) P1_LOAD(blk + 2);
            WG_BAR_LDS();
        }
#undef P1_LOAD
#undef P1_FINISH
    }
}
DI void scan_sample_unit(const Args& a, unsigned char* lds, int unit, int wave, int lane) {
    float* sv = (float*)(lds + 2 * 4 * TB * 384 * 4) + wave * 384;
    const bf16_t* RW = (const bf16_t*)(a.ws + WS_RW); const bf16_t* Lb = (const bf16_t*)(a.ws + WS_L);
    const int b = unit >> 4, h = unit & 15, c = h * 64 + lane, m = MP + b;
    PrepParams P; prep_params(a, P, c);
    PrepRaw raw; prep_load(a, raw, RW, m, Lb + (size_t)m * NLO, c);
    float g, bon; prep_finish(raw, P, sv, g, bon, lane);
    float S[64];
    const float* s0 = a.in[I_SWKV] + ((size_t)(b * 16 + h) * 64 + lane) * 64;
#pragma unroll
    for (int j = 0; j < 16; ++j) { const f32x4 v = *(const f32x4*)(s0 + 4 * j); S[4 * j] = v.x; S[4 * j + 1] = v.y; S[4 * j + 2] = v.z; S[4 * j + 3] = v.w; }
    const float y = scan_step(S, sv, sv[192 + lane]);
    float* so = a.out + O_SWKV + ((size_t)(b * 16 + h) * 64 + lane) * 64;
#pragma unroll
    for (int j = 0; j < 16; ++j) *(f32x4*)(so + 4 * j) = (f32x4){S[4 * j], S[4 * j + 1], S[4 * j + 2], S[4 * j + 3]};
    rwkv_post(a, y, g, bon, m, c);
}
DI void scan_pass2_unit(const Args& a, unsigned char* lds, int chain, int wave, int lane) {
    float* Ssh = (float*)lds;
    float* Psh = Ssh + 64 * 65;
    const float* ZP = (const float*)(a.ws + WS_ZP); float* SST = (float*)(a.ws + WS_SST);
    const int tid = wave * 64 + lane, l16 = lane & 15, lq = lane >> 4, ib = wave >> 1, jb0 = 2 * (wave & 1);
    f32x4 S0 = {0.f, 0.f, 0.f, 0.f}, S1 = {0.f, 0.f, 0.f, 0.f};
    const float* Z0 = ZP + (size_t)(chain * NS) * 2 * 4096;
    f32x4 pn0 = *(const f32x4*)(Z0 + 4096 + tid * 8), pn1 = *(const f32x4*)(Z0 + 4096 + tid * 8 + 4);
    float zn0[4], zn1[4];
#pragma unroll
    for (int i = 0; i < 4; ++i) { zn0[i] = Z0[(16 * ib + 4 * lq + i) * 64 + 16 * jb0 + l16]; zn1[i] = Z0[(16 * ib + 4 * lq + i) * 64 + 16 * (jb0 + 1) + l16]; }
    for (int s = 0; s < NS; ++s) {
        float* sst = SST + ((size_t)chain * NS + s) * 4096;
#pragma unroll
        for (int i = 0; i < 4; ++i) { const int row = 16 * ib + 4 * lq + i;
            sst[row * 64 + 16 * jb0 + l16] = S0[i]; sst[row * 64 + 16 * (jb0 + 1) + l16] = S1[i];
            Ssh[row * 65 + 16 * jb0 + l16] = S0[i]; Ssh[row * 65 + 16 * (jb0 + 1) + l16] = S1[i]; }
        *(f32x4*)(Psh + tid * 8) = pn0; *(f32x4*)(Psh + tid * 8 + 4) = pn1;
        f32x4 n0 = {zn0[0], zn0[1], zn0[2], zn0[3]}, n1 = {zn1[0], zn1[1], zn1[2], zn1[3]};
        if (s + 1 < NS) {
            const float* Zs = ZP + (size_t)(chain * NS + s + 1) * 2 * 4096;
            pn0 = *(const f32x4*)(Zs + 4096 + tid * 8); pn1 = *(const f32x4*)(Zs + 4096 + tid * 8 + 4);
#pragma unroll
            for (int i = 0; i < 4; ++i) { zn0[i] = Zs[(16 * ib + 4 * lq + i) * 64 + 16 * jb0 + l16]; zn1[i] = Zs[(16 * ib + 4 * lq + i) * 64 + 16 * (jb0 + 1) + l16]; }
        }
        WG_BAR_LDS();
        if (s > 0) {
#pragma unroll
            for (int kk = 0; kk < 16; ++kk) {
                const float af = Ssh[(16 * ib + l16) * 65 + 4 * kk + lq];
                const float b0 = Psh[(4 * kk + lq) * 64 + 16 * jb0 + l16], b1 = Psh[(4 * kk + lq) * 64 + 16 * (jb0 + 1) + l16];
                n0 = __builtin_amdgcn_mfma_f32_16x16x4f32(af, b0, n0, 0, 0, 0);
                n1 = __builtin_amdgcn_mfma_f32_16x16x4f32(af, b1, n1, 0, 0, 0);
            }
        }
        WG_BAR_LDS();
        S0 = n0; S1 = n1;
    }
    float* so = a.out + O_PWKV + (size_t)chain * 4096;
#pragma unroll
    for (int i = 0; i < 4; ++i) { const int row = 16 * ib + 4 * lq + i; so[row * 64 + 16 * jb0 + l16] = S0[i]; so[row * 64 + 16 * (jb0 + 1) + l16] = S1[i]; }
}
DI bf16x8 cvt8(const f32x4 lo, const f32x4 hi) { u32x4 p; p.x = pk2(lo.x, lo.y); p.y = pk2(lo.z, lo.w); p.z = pk2(hi.x, hi.y); p.w = pk2(hi.z, hi.w); return __builtin_bit_cast(bf16x8, p); }
DI void scan_pass3_unit(const Args& a, int unit, int lane) {
    const float* SST = (const float*)(a.ws + WS_SST); const bf16_t* YL = (const bf16_t*)(a.ws + WS_YL); const bf16_t* QS = (const bf16_t*)(a.ws + WS_QS); const bf16_t* GB = (const bf16_t*)(a.ws + WS_GB);
    bf16_t* O = (bf16_t*)(a.ws + WS_O);
    const int sub = unit & 3, pair = unit >> 2, chain = pair / NS, seg = pair % NS, b = chain >> 4, h = chain & 15;
    const int r = lane & 31, hh = lane >> 5;
    const int m = b * SEQ + seg * SEGL + sub * 32 + r;
    f32x16 acc0, acc1;
#pragma unroll
    for (int i = 0; i < 16; ++i) { acc0[i] = 0.f; acc1[i] = 0.f; }
    const bf16_t* qrow = QS + (size_t)m * 1024 + h * 64 + 8 * hh;
    const float* s0 = SST + (size_t)pair * 4096 + (size_t)r * 64 + 8 * hh; const float* s1 = s0 + 32 * 64;
#pragma unroll
    for (int ks = 0; ks < 4; ++ks) {
        const bf16x8 qf = *(const bf16x8*)(qrow + ks * 16);
        const bf16x8 a0 = cvt8(*(const f32x4*)(s0 + ks * 16), *(const f32x4*)(s0 + ks * 16 + 4));
        const bf16x8 a1 = cvt8(*(const f32x4*)(s1 + ks * 16), *(const f32x4*)(s1 + ks * 16 + 4));
        acc0 = __builtin_amdgcn_mfma_f32_32x32x16_bf16(a0, qf, acc0, 0, 0, 0);
        acc1 = __builtin_amdgcn_mfma_f32_32x32x16_bf16(a1, qf, acc1, 0, 0, 0);
    }
    const bf16_t* yl = YL + (size_t)m * 1024 + h * 64 + 4 * hh;
    float y[32]; float sum = 0.f;
#pragma unroll
    for (int rt = 0; rt < 2; ++rt)
#pragma unroll
        for (int g = 0; g < 4; ++g) { const u32x2 yw = *(const u32x2*)(yl + rt * 32 + 8 * g); const f32x4 v = {__uint_as_float(yw.x << 16), __uint_as_float(yw.x & 0xffff0000u), __uint_as_float(yw.y << 16), __uint_as_float(yw.y & 0xffff0000u)};
#pragma unroll
            for (int e = 0; e < 4; ++e) { const float yy = v[e] + (rt == 0 ? acc0[4 * g + e] : acc1[4 * g + e]); y[rt * 16 + 4 * g + e] = yy; sum += yy; } }
    sum += __shfl_xor(sum, 32);
    const float mean = sum * (1.f / 64.f);
    float vs = 0.f;
#pragma unroll
    for (int e = 0; e < 32; ++e) { y[e] -= mean; vs += y[e] * y[e]; }
    vs += __shfl_xor(vs, 32);
    const float rstd = rsqrtf(vs * (1.f / 64.f) + 64e-5f);
    const bf16_t* gb = GB + ((size_t)m * 16 + h) * 128 + 4 * hh;
    const float* lw = a.in[I_LNW] + h * 64 + 4 * hh; const float* lb = a.in[I_LNB] + h * 64 + 4 * hh;
    bf16_t* orow = O + (size_t)m * D + 1024 + h * 64 + 4 * hh;
#pragma unroll
    for (int rt = 0; rt < 2; ++rt)
#pragma unroll
        for (int g = 0; g < 4; ++g) {
            const int off = rt * 32 + 8 * g;
            const f32x4 w4 = *(const f32x4*)(lw + off), b4 = *(const f32x4*)(lb + off);
            const u32x2 gw = *(const u32x2*)(gb + off), bw = *(const u32x2*)(gb + 64 + off);
            const float gg[4] = {__uint_as_float(gw.x << 16), __uint_as_float(gw.x & 0xffff0000u), __uint_as_float(gw.y << 16), __uint_as_float(gw.y & 0xffff0000u)};
            const float bb[4] = {__uint_as_float(bw.x << 16), __uint_as_float(bw.x & 0xffff0000u), __uint_as_float(bw.y << 16), __uint_as_float(bw.y & 0xffff0000u)};
            float o[4];
#pragma unroll
            for (int e = 0; e < 4; ++e) o[e] = (y[rt * 16 + 4 * g + e] * rstd * w4[e] + b4[e] + bb[e]) * gg[e];
            u32x2 w; w.x = pk2(o[0], o[1]); w.y = pk2(o[2], o[3]);
            *(u32x2*)(orow + off) = w;
        }
}

DI void unpack8(const u32x4 w, float (&u)[8]) {
    u[0] = __uint_as_float(w.x << 16); u[1] = __uint_as_float(w.x & 0xffff0000u); u[2] = __uint_as_float(w.y << 16); u[3] = __uint_as_float(w.y & 0xffff0000u);
    u[4] = __uint_as_float(w.z << 16); u[5] = __uint_as_float(w.z & 0xffff0000u); u[6] = __uint_as_float(w.w << 16); u[7] = __uint_as_float(w.w & 0xffff0000u);
}
constexpr int CONV_NCH = (256 * NTHREADS) / (FF / 8);
DI void conv_sweep(const Args& a, int idx) {
    const int fg = idx % (FF / 8), cls = idx / (FF / 8), f = fg * 8;
    if (cls >= CONV_NCH) return;
    const bf16_t* U = (const bf16_t*)(a.ws + WS_U); bf16_t* ACT = (bf16_t*)(a.ws + WS_ACT);
    const float* cw = a.in[I_FCW]; const float* cb = a.in[I_FCB];
    float w0[2][8], w1[2][8], w2[2][8], bb[2][8];
#pragma unroll
    for (int p = 0; p < 2; ++p)
#pragma unroll
        for (int j = 0; j < 8; ++j) { const int col = p * FF + f + j; w0[p][j] = cw[col]; w1[p][j] = cw[FF2 + col]; w2[p][j] = cw[2 * FF2 + col]; bb[p][j] = cb[col]; }
    for (int mb = cls; mb < MT; mb += 3 * CONV_NCH) {
        u32x4 x0[3][2], x1[3][2], x2[3][2];
#pragma unroll
        for (int q = 0; q < 3; ++q) {
            const int m = mb + q * CONV_NCH < MT ? mb + q * CONV_NCH : mb; const bool pr = m < MP; const int t = m & (SEQ - 1);
#pragma unroll
            for (int p = 0; p < 2; ++p) {
                const bf16_t* up = U + (size_t)m * FF2 + p * FF + f;
                x0[q][p] = *(const u32x4*)up; x1[q][p] = (u32x4){0u, 0u, 0u, 0u}; x2[q][p] = (u32x4){0u, 0u, 0u, 0u};
                if (pr && t >= 1) x1[q][p] = *(const u32x4*)(up - FF2);
                if (pr && t >= 2) x2[q][p] = *(const u32x4*)(up - 2 * FF2);
            }
        }
#pragma unroll
        for (int q = 0; q < 3; ++q) {
            const int m = mb + q * CONV_NCH;
            if (m < MT) {
                const bool pr = m < MP;
                float u0[2][8], u1[2][8], u2[2][8];
#pragma unroll
                for (int p = 0; p < 2; ++p) { unpack8(x0[q][p], u0[p]); unpack8(x1[q][p], u1[p]); unpack8(x2[q][p], u2[p]); }
                if (!pr) {
#pragma unroll
                    for (int p = 0; p < 2; ++p) {
                        const float* st = a.in[I_SFFN] + (size_t)(m - MP) * 2 * FF2 + p * FF + f;
                        float* so = a.out + O_SFFN + (size_t)(m - MP) * 2 * FF2 + p * FF + f;
#pragma unroll
                        for (int j = 0; j < 8; ++j) { u2[p][j] = st[j]; u1[p][j] = st[FF2 + j]; so[j] = u1[p][j]; }
                    }
                }
                float o[8];
#pragma unroll
                for (int j = 0; j < 8; ++j) {
                    const float gt = bb[0][j] + w0[0][j] * u2[0][j] + w1[0][j] * u1[0][j] + w2[0][j] * u0[0][j];
                    const float vl = bb[1][j] + w0[1][j] * u2[1][j] + w1[1][j] * u1[1][j] + w2[1][j] * u0[1][j];
                    o[j] = gt * __builtin_amdgcn_rcpf(1.f + __expf(-gt)) * vl;
                }
                u32x4 w; w.x = pk2(o[0], o[1]); w.y = pk2(o[2], o[3]); w.z = pk2(o[4], o[5]); w.w = pk2(o[6], o[7]);
                *(u32x4*)(ACT + (size_t)m * FF + f) = w;
            }
        }
    }
}

#define XB_TMO      128
#define XB_XCNT(j)  (256  + 64 * (j))
#define XB_XSUB(j)  (1280 + 64 * (j))
#define XB_XGEN(j)  (2304 + 64 * (j))
#define XB_TOP      3328
#define XB_TOPGEN   3392
#define XCD_BAR_WORDS 3456
#define XB_SPIN_CAP (1u << 18)
DI unsigned xb_ld(unsigned* p)              { return __hip_atomic_load(p, __ATOMIC_RELAXED, __HIP_MEMORY_SCOPE_AGENT); }
DI unsigned xb_add(unsigned* p, unsigned v) { return __hip_atomic_fetch_add(p, v, __ATOMIC_RELAXED, __HIP_MEMORY_SCOPE_AGENT); }
DI unsigned xb_xcc_id() { return (unsigned)__builtin_amdgcn_s_getreg((3 << 11) | 20) & 0xFu; }
#define XB_SPIN(cond, bar) do { unsigned _sp = 0; while (cond) { __builtin_amdgcn_s_sleep(1); \
    if ((++_sp & 255u) == 0u) { if (xb_ld(&(bar)[XB_TMO])) break; if (_sp > XB_SPIN_CAP) { atomicAdd(&(bar)[XB_TMO], 1u); break; } } } } while (0)
struct XcdBarrier { unsigned* bar; unsigned x; volatile LAS unsigned* st; };
DI XcdBarrier xcd_barrier_post(unsigned* bar, volatile LAS unsigned* st) {
    XcdBarrier b; b.bar = bar; b.x = xb_xcc_id(); b.st = st;
    if (threadIdx.x == 0) (void)xb_add(&bar[XB_XCNT(b.x)], 1u);
    return b;
}
DI void xcd_barrier_complete(unsigned* bar, unsigned x, unsigned& nloc, unsigned& nx) {
    const unsigned G = gridDim.x * gridDim.y * gridDim.z;
    unsigned sum, cnt, mine, sp = 0u;
    for (;;) {
        sum = 0u; cnt = 0u; mine = 0u;
#pragma unroll
        for (unsigned j = 0; j < 16; ++j) { const unsigned c = xb_ld(&bar[XB_XCNT(j)]); sum += c; cnt += (c > 0u) ? 1u : 0u; mine = (j == x) ? c : mine; }
        if (sum == G) break;
        __builtin_amdgcn_s_sleep(1);
        if ((++sp & 255u) == 0u) { if (xb_ld(&bar[XB_TMO])) break; if (sp > XB_SPIN_CAP) { atomicAdd(&bar[XB_TMO], 1u); break; } }
    }
    nloc = mine > 0u ? mine : 1u; nx = cnt > 0u ? cnt : 1u;
}
DI void xcd_barrier(const XcdBarrier& b) {
    asm volatile("s_waitcnt vmcnt(0)" ::: "memory");
    __syncthreads();
    if (threadIdx.x == 0) {
        unsigned* bar = b.bar;
        __builtin_amdgcn_s_waitcnt(0);
        unsigned nloc = b.st[0], nx = b.st[1];
        if (nloc == 0u) { xcd_barrier_complete(bar, b.x, nloc, nx); b.st[0] = nloc; b.st[1] = nx; }
        const unsigned old = xb_add(&bar[XB_XSUB(b.x)], 1u);
        const unsigned gen = old / nloc;
        if (old + 1u == (gen + 1u) * nloc) {
            __builtin_amdgcn_fence(__ATOMIC_RELEASE, "agent");
            asm volatile("s_waitcnt vmcnt(0)" ::: "memory");
            const unsigned og = xb_add(&bar[XB_TOP], 1u);
            const unsigned tg = og / nx;
            if (og + 1u == (tg + 1u) * nx) xb_add(&bar[XB_TOPGEN], 1u);
            else XB_SPIN(xb_ld(&bar[XB_TOPGEN]) == tg, bar);
            __builtin_amdgcn_fence(__ATOMIC_ACQUIRE, "agent");
            xb_add(&bar[XB_XGEN(b.x)], 1u);
            asm volatile("s_waitcnt vmcnt(0)" ::: "memory");
        } else {
            XB_SPIN(xb_ld(&bar[XB_XGEN(b.x)]) == gen, bar);
            __builtin_amdgcn_fence(__ATOMIC_ACQUIRE, "agent");
            asm volatile("s_waitcnt vmcnt(0)" ::: "memory");
        }
    }
    __syncthreads();
}

DI void skinny_unit(const bf16_t* A, int lda, const bf16_t* Bt, int K, int unit, const float* base, int ldb, float* out, int ldo, unsigned char* lds, int wave, int lane,
                    const float* gf = nullptr, bf16_t* H = nullptr, float* RSS = nullptr) {
    float* red = (float*)lds;
    const int n0 = unit * 32, r = lane & 31, hh = lane >> 5, kw = K / 8, kb = wave * kw;
    f32x16 acc;
#pragma unroll
    for (int i = 0; i < 16; ++i) acc[i] = 0.f;
    const bf16_t* ap = A + (size_t)r * lda + kb + 8 * hh; const bf16_t* bp = Bt + (size_t)(n0 + r) * K + kb + 8 * hh;
#pragma unroll 4
    for (int k = 0; k < kw; k += 16) {
        const bf16x8 af = *(const bf16x8*)(ap + k), bf = *(const bf16x8*)(bp + k);
        acc = __builtin_amdgcn_mfma_f32_32x32x16_bf16(af, bf, acc, 0, 0, 0);
    }
#pragma unroll
    for (int i = 0; i < 16; ++i) red[(wave * 16 + i) * 64 + lane] = acc[i];
    __syncthreads();
#pragma unroll
    for (int q = 0; q < 2; ++q) {
        const int o = threadIdx.x + 512 * q, i = o >> 6, ln = o & 63;
        float sum = 0.f;
#pragma unroll
        for (int w = 0; w < 8; ++w) sum += red[(w * 16 + i) * 64 + ln];
        const int row = crow(i, ln >> 5), col = n0 + (ln & 31);
        const float x1 = base[(size_t)row * ldb + col] + sum * (H ? 1.0f : MK_P11_SCALE);
        out[(size_t)row * ldo + col] = x1;
        if (H) { H[(size_t)row * D + col] = (bf16_t)bf_rne(x1 * gf[col]);
            float ss = x1 * x1;
            ss += __shfl_xor(ss, 1); ss += __shfl_xor(ss, 2); ss += __shfl_xor(ss, 4); ss += __shfl_xor(ss, 8); ss += __shfl_xor(ss, 16);
            if ((ln & 31) == 0) atomic_add_f32(RSS + row, ss); }
    }
    __syncthreads();
}

constexpr int NPH = 14;
template <bool COOP>
__global__ void __launch_bounds__(NTHREADS, 2) mk_fwd(Args a) {
    extern __shared__ __attribute__((aligned(16))) unsigned char lds[];
    const int tid = threadIdx.x, lane = tid & 63, wave = __builtin_amdgcn_readfirstlane(tid >> 6);
    const int G = gridDim.x, bid = blockIdx.x, gw = bid * NWAVES + wave, ngw = G * NWAVES;
    unsigned char* ws = a.ws;
    LAS unsigned char* ldsl = (LAS unsigned char*)lds;
#ifndef PHMASK
#define PHMASK 0xffff
#endif
#define IN(k) (((PHMASK >> (k)) & 1) && a.ph_lo <= (k) && (k) < a.ph_hi)
    XcdBarrier xbar; xbar.bar = (unsigned*)(ws + WS_BAR); xbar.x = 0; xbar.st = nullptr;
    if (COOP) {
        volatile LAS unsigned* st = (volatile LAS unsigned*)(ldsl + LDS_BYTES - 16);
        if (tid < 4) st[tid] = 0u;
        __syncthreads();
        xbar = xcd_barrier_post((unsigned*)(ws + WS_BAR), st);
    }
#define SEAM(k) do { if (COOP && IN(k) && IN((k) + 1)) { if (a.ph_hi > 1000) cg::this_grid().sync(); else xcd_barrier(xbar); } } while (0)

    if (IN(0)) phase_prologue(a, lds, gw, ngw, lane, wave);
    SEAM(0);
    if (IN(1)) {
        pg8::Gemm g{(const bf16_t*)(ws + WS_H), (const bf16_t*)(ws + WS_WIN), MPAD, NIN, D}; pg8::StaticOrder S; S.init(MPAD, NIN, G, bid);
        EpiIn E{(bf16_t*)(ws + WS_QB), (bf16_t*)(ws + WS_KB), (bf16_t*)(ws + WS_VB), (bf16_t*)(ws + WS_RW), a.out};
        pg8::gemm_phase<EpiIn>(ldsl, g, S, E);
        {
            const int nu = (MPAD / 256) * (NIN / 256), rem = nu % G, first = rem == 0 ? 0 : rem, nfree = G - first;
            if (bid >= first) convert_wo_wup(a, lds, (bid - first) * NWAVES + wave, nfree * NWAVES, wave, lane);
        }
    }
    SEAM(1);
    if (IN(2)) {
        for (int u = bid; u < 256; u += G) attn_sample_wg(a, lds, u, wave, lane);
        for (int u = gw; u < 64 * 3 * 64; u += ngw) attn_prompt_unit(a, lds, u, wave, lane);
        for (int m = gw; m < MPAD; m += ngw) lora_input_row(a, m, lane);
    }
    SEAM(2);
    if (IN(3)) {
        pg8::Gemm g{(const bf16_t*)(ws + WS_ALO), (const bf16_t*)(ws + WS_WLO), MPAD, NLO, KLO}; pg8::StaticOrder S; S.init(MPAD, NLO, G, bid);
        EpiBf E{(bf16_t*)(ws + WS_L), NLO};
        pg8::gemm_phase<EpiBf>(ldsl, g, S, E);
#pragma unroll 2
        for (int t = gw; t < MP * 4; t += ngw) attn_merge_task(a, t, lane);
    }
    SEAM(3);
    if (IN(4)) {
#ifndef NO_P1
        for (int u = bid; u < 64 * NS / 4; u += G) scan_pass1_unit(a, lds, u, wave, lane);
#endif

    }
    SEAM(4);
    if (IN(5)) {
        if (G >= 128) {
            if (bid < 64) scan_pass2_unit(a, lds, bid, wave, lane);
            else for (int u = (bid - 64) * NWAVES + wave; u < 512; u += (G - 64) * NWAVES) scan_sample_unit(a, lds, u, wave, lane);
        } else {
            for (int ch = bid; ch < 64; ch += G) scan_pass2_unit(a, lds, ch, wave, lane);
            for (int u = gw; u < 512; u += ngw) scan_sample_unit(a, lds, u, wave, lane);
        }
    }
    SEAM(5);
    if (IN(6)) { for (int u = gw; u < 64 * NS * 4; u += ngw) scan_pass3_unit(a, u, lane); }
    SEAM(6);
    if (IN(7)) {
        pg8::Gemm g{(const bf16_t*)(ws + WS_O), (const bf16_t*)(ws + WS_WO), MP, D, D}; pg8::StaticOrder S; S.init(MP, D, G, bid);
        EpiWo E{a.in[I_XP], a.in[I_NFG], (float*)(ws + WS_X1), (bf16_t*)(ws + WS_H), (float*)(ws + WS_RSS)};
        pg8::gemm_phase<EpiWo>(ldsl, g, S, E);
        for (int u = bid; u < D / 32; u += G)
            skinny_unit((const bf16_t*)(ws + WS_O) + (size_t)MP * D, D, (const bf16_t*)(ws + WS_WO), D, u, a.in[I_XS], D, (float*)(ws + WS_X1) + (size_t)MP * D, D, lds, wave, lane,
                        a.in[I_NFG], (bf16_t*)(ws + WS_H) + (size_t)MP * D, (float*)(ws + WS_RSS) + MP);
    }
    SEAM(7);
    if (IN(9)) {
        pg8::Gemm g{(const bf16_t*)(ws + WS_H), (const bf16_t*)(ws + WS_WUP), MPAD, FF2, D}; pg8::StaticOrder S; S.init(MPAD, FF2, G, bid);
        EpiUp E{(bf16_t*)(ws + WS_U), a.out, (const float*)(ws + WS_RSS)};
        pg8::gemm_phase<EpiUp>(ldsl, g, S, E);
        {
            const int nu = (MPAD / 256) * (FF2 / 256), rem = nu % G, first = rem == 0 ? 0 : rem, nfree = G - first;
            if (bid >= first) convert_wdn(a, lds, (bid - first) * NWAVES + wave, nfree * NWAVES, wave, lane);
        }
    }
    SEAM(9);
    if (IN(10)) { if (G == 256) conv_sweep(a, bid * NTHREADS + tid); else for (int it = bid * NTHREADS + tid; it < CONV_NCH * (FF / 8); it += G * NTHREADS) conv_sweep(a, it); }
    SEAM(10);
    if (IN(11)) {
        pg8::Gemm g{(const bf16_t*)(ws + WS_ACT), (const bf16_t*)(ws + WS_WDN), MP, D, FF}; pg8::StaticOrder S; S.init(MP, D, G, bid);
        EpiDn E{(float*)(ws + WS_X1)};
        pg8::gemm_phase<EpiDn>(ldsl, g, S, E);
        for (int u = bid; u < D / 32; u += G)
            skinny_unit((const bf16_t*)(ws + WS_ACT) + (size_t)MP * FF, FF, (const bf16_t*)(ws + WS_WDN), FF, u, (const float*)(ws + WS_X1) + (size_t)MP * D, D, (float*)(ws + WS_X1) + (size_t)MP * D, D, lds, wave, lane);
    }
    SEAM(11);
    if (IN(12)) {
        for (int m = gw; m < MT; m += ngw)
            rms_row_f32((const float*)(ws + WS_X1) + (size_t)m * D, a.in[I_NFIN], m < MP ? a.out + O_YP + (size_t)m * D : a.out + O_YS + (size_t)(m - MP) * D, lane);
    }
#undef IN
#undef SEAM
}

#ifndef MK_ONE_LAUNCH
#define MK_ONE_LAUNCH 1
#endif
#ifndef MK_DBL_MASK
#define MK_DBL_MASK 0x0
#endif

extern "C" void kernel_launch(void* const* d_in, const int* in_sizes, int n_in, void* d_out, int out_size, void* d_ws, size_t ws_size, hipStream_t stream) {
    static int grid = 0;
    if (!grid) {
        if (n_in != 28 || (size_t)out_size != O_END || ws_size < WS_END) fprintf(stderr, "kernel_launch: unexpected shapes: n_in %d out %d (want %zu) ws %zu (want %zu)\n", n_in, out_size, O_END, ws_size, WS_END);
        int dev = 0, cus = 0; hipGetDevice(&dev); hipDeviceGetAttribute(&cus, hipDeviceAttributeMultiprocessorCount, dev);
        hipFuncSetAttribute((const void*)mk_fwd<true>, hipFuncAttributeMaxDynamicSharedMemorySize, LDS_BYTES);
        hipFuncSetAttribute((const void*)mk_fwd<false>, hipFuncAttributeMaxDynamicSharedMemorySize, LDS_BYTES);
        int per_cu = 0; hipOccupancyMaxActiveBlocksPerMultiprocessor(&per_cu, mk_fwd<true>, NTHREADS, LDS_BYTES);
        if (per_cu < 1) { fprintf(stderr, "kernel_launch: occupancy query says %d blocks/CU\n", per_cu); per_cu = 1; }
        grid = cus > 0 ? cus : 256;
    }
    Args a; memset(&a, 0, sizeof(a));
    for (int i = 0; i < 28; ++i) a.in[i] = (const float*)d_in[i];
    a.out = (float*)d_out; a.ws = (unsigned char*)d_ws;
#if MK_ONE_LAUNCH
    if (hipMemsetAsync((char*)d_ws + WS_BAR, 0, BAR_BYTES, stream) != hipSuccess) { fprintf(stderr, "kernel_launch: memset of the barrier words failed\n"); return; }
    a.ph_lo = 0; a.ph_hi = NPH;
    void* args[] = {&a};
    hipError_t e = hipLaunchCooperativeKernel((const void*)mk_fwd<true>, dim3(grid), dim3(NTHREADS), args, LDS_BYTES, stream);
    if (e != hipSuccess) fprintf(stderr, "cooperative launch failed: %s (grid %d)\n", hipGetErrorString(e), grid);
#else
    for (int p = 0; p < 13; ++p) {
        a.ph_lo = p; a.ph_hi = p + 1;
        mk_fwd<false><<<dim3(grid), dim3(NTHREADS), LDS_BYTES, stream>>>(a);
        if ((MK_DBL_MASK >> p) & 1) mk_fwd<false><<<dim3(grid), dim3(NTHREADS), LDS_BYTES, stream>>>(a);
    }
#endif
}
```

```cpp
#include <hip/hip_runtime.h>
#include <hip/hip_cooperative_groups.h>
#include <cstdio>
#include <cstdint>
#include <cstring>
namespace cg = cooperative_groups;

#define DI __device__ __forceinline__
#define LAS __attribute__((address_space(3)))
typedef unsigned short bf16_t;
typedef short bf16x8 __attribute__((ext_vector_type(8)));
typedef float f32x4 __attribute__((ext_vector_type(4)));
typedef float f32x16 __attribute__((ext_vector_type(16)));
typedef unsigned u32x4 __attribute__((ext_vector_type(4)));
typedef unsigned u32x2 __attribute__((ext_vector_type(2)));

constexpr int D = 2048, MP = 8192, MS = 32, MT = 8224, MPAD = 8448, SEQ = 2048;
constexpr int CIN = 6432, NIN = 6656, CSH = 3360, FF2 = 11264, FF = 5632;
constexpr int NLO = 3072, KLO = 384;
constexpr int NS = 16, SEGL = 128, TB = 8;
constexpr int NTHREADS = 512, NWAVES = 8;
constexpr int LDS_BYTES = 131072 + 16384;

constexpr size_t O_YP = 0;
constexpr size_t O_YS = O_YP + (size_t)MP * D;
constexpr size_t O_PK = O_YS + (size_t)MS * D;
constexpr size_t O_PV = O_PK + (size_t)MP * 1024;
constexpr size_t O_PRW = O_PV + (size_t)MP * 1024;
constexpr size_t O_PWKV = O_PRW + (size_t)4 * CSH;
constexpr size_t O_PFFN = O_PWKV + (size_t)4 * 16 * 4096;
constexpr size_t O_SK = O_PFFN + (size_t)4 * 2 * FF2;
constexpr size_t O_SV = O_SK + (size_t)MS * 1024;
constexpr size_t O_SRW = O_SV + (size_t)MS * 1024;
constexpr size_t O_SWKV = O_SRW + (size_t)MS * CSH;
constexpr size_t O_SFFN = O_SWKV + (size_t)MS * 16 * 4096;
constexpr size_t O_END = O_SFFN + (size_t)MS * 2 * FF2;

constexpr size_t al256(size_t x) { return (x + 255) & ~(size_t)255; }
constexpr size_t WS_WIN = 0;
constexpr size_t WS_WO = WS_WIN + al256((size_t)NIN * D * 2);
constexpr size_t WS_WUP = WS_WO + al256((size_t)D * D * 2);
constexpr size_t WS_WDN = WS_WUP + al256((size_t)FF2 * D * 2);
constexpr size_t WS_WLO = WS_WDN + al256((size_t)D * FF * 2);
constexpr size_t WS_H = WS_WLO + al256((size_t)NLO * KLO * 2);
constexpr size_t WS_QB = WS_H + al256((size_t)MPAD * D * 2);
constexpr size_t WS_KB = WS_QB + al256((size_t)MPAD * 1024 * 2);
constexpr size_t WS_VB = WS_KB + al256((size_t)MPAD * 1024 * 2);
constexpr size_t WS_ALO = WS_VB + al256((size_t)MPAD * 1024 * 2);
constexpr size_t WS_O = WS_ALO + al256((size_t)MPAD * KLO * 2);
constexpr size_t WS_GB = WS_O + al256((size_t)MPAD * D * 2);
constexpr size_t WS_YL = WS_GB + al256((size_t)MT * 2048 * 2);
constexpr size_t WS_QS = WS_YL + al256((size_t)MP * 1024 * 2);
constexpr size_t WS_ZP = WS_QS + al256((size_t)MP * 1024 * 2);
constexpr size_t WS_SST = WS_ZP + al256((size_t)64 * NS * 2 * 4096 * 4);
constexpr size_t WS_X1 = WS_SST + al256((size_t)64 * NS * 4096 * 4);
constexpr size_t WS_PML = WS_X1 + al256((size_t)MPAD * D * 4);
constexpr size_t WS_RA = WS_PML + al256((size_t)3 * MP * 16 * 2 * 4);
constexpr size_t WS_RW = WS_RA;
constexpr size_t WS_L = WS_RW + al256((size_t)MPAD * CSH * 2);
constexpr size_t RA_BYTES_1 = al256((size_t)MPAD * CSH * 2) + al256((size_t)MPAD * NLO * 2);
constexpr size_t RA_BYTES_2 = al256((size_t)MPAD * FF2 * 2);
constexpr size_t WS_U = WS_RA;
constexpr size_t WS_RB = WS_RA + (RA_BYTES_1 > RA_BYTES_2 ? RA_BYTES_1 : RA_BYTES_2);
constexpr size_t WS_PART = WS_RB;
constexpr size_t WS_ACT = WS_RB;
constexpr size_t RB_BYTES_1 = al256((size_t)3 * MP * 1024 * 2);
constexpr size_t RB_BYTES_2 = al256((size_t)MPAD * FF * 2);
constexpr size_t WS_RSS = WS_RB + (RB_BYTES_1 > RB_BYTES_2 ? RB_BYTES_1 : RB_BYTES_2);
constexpr size_t WS_BAR_ = 0; constexpr size_t WS_BAR = al256((size_t)MPAD * 4) + WS_RB + (RB_BYTES_1 > RB_BYTES_2 ? RB_BYTES_1 : RB_BYTES_2);
constexpr size_t BAR_BYTES = 16384;
constexpr size_t WS_END = WS_BAR + BAR_BYTES;

struct Args {
    const float* in[28];
    float* out;
    unsigned char* ws;
    int ph_lo, ph_hi;
};
enum { I_XP = 0, I_XS, I_CK, I_CV, I_SSH, I_SWKV, I_SFFN, I_NMG, I_WIN, I_AOG, I_MU, I_W0, I_WUP, I_A0, I_AUP, I_GUP,
       I_KK, I_KA, I_RK, I_LNW, I_LNB, I_WO, I_NFG, I_FUP, I_FCW, I_FCB, I_FDN, I_NFIN };

typedef float f32x2c __attribute__((ext_vector_type(2)));
typedef __bf16 bf16x2c __attribute__((ext_vector_type(2)));
DI unsigned pk2(float lo, float hi) { const f32x2c v = {lo, hi}; return __builtin_bit_cast(unsigned, __builtin_convertvector(v, bf16x2c)); }
DI unsigned bf_rne(float f) { return pk2(f, 0.f) & 0xffffu; }
DI unsigned cvt_pk(float lo, float hi) { return pk2(lo, hi); }
DI void atomic_add_f32(float* p, float v) { (void)__builtin_amdgcn_global_atomic_fadd_f32((__attribute__((address_space(1))) float*)p, v); }
DI float bf2f(unsigned short b) { return __uint_as_float(((unsigned)b) << 16); }
#define DPP_ADD(v, ctrl) ((v) + __int_as_float(__builtin_amdgcn_update_dpp(0, __float_as_int(v), (ctrl), 0xf, 0xf, false)))
DI float wave_sum(float v) {
    v = DPP_ADD(v, 0xB1);
    v = DPP_ADD(v, 0x4E);
    v = DPP_ADD(v, 0x141);
    v = DPP_ADD(v, 0x140);
    const float s0 = __int_as_float(__builtin_amdgcn_readlane(__float_as_int(v), 0)), s1 = __int_as_float(__builtin_amdgcn_readlane(__float_as_int(v), 16));
    const float s2 = __int_as_float(__builtin_amdgcn_readlane(__float_as_int(v), 32)), s3 = __int_as_float(__builtin_amdgcn_readlane(__float_as_int(v), 48));
    return (s0 + s1) + (s2 + s3);
}

namespace pg8 {
constexpr int BM = 256, BK = 64, HALF = 128, HTB = HALF * BK * 2, STAGE_BYTES = 8 * HTB, NXCD = 8, WGM = 8;
DI int lds_byte(int r, int c) { const int st = (r >> 4) * 2 + (c >> 5), rr = r & 15, cc = c & 31, ob = rr * 64 + cc * 2; return st * 1024 + (ob ^ (((ob >> 9) & 1) << 5)); }
DI void stage_rc(int b, int& R, int& C) { const int st = b / 1024, sb = b % 1024, swz = sb ^ (((sb >> 9) & 1) << 5); R = (st >> 1) * 16 + swz / 64; C = (st & 1) * 32 + (swz % 64) / 2; }
struct Unit { int pm, pn; };
struct Gemm { const bf16_t* A; const bf16_t* Bt; int M, N, K; };
struct StaticOrder {
    int nM, nN, nwg, G, c;
    DI void init(int M, int N, int G_, int c_) { nM = M / BM; nN = N / BM; nwg = nM * nN; G = G_; c = c_; }
    DI bool next(int i, Unit& u) const {
        const long L = (long)i * G + c; if (L >= nwg) return false;
        int wgid = (int)L; { const int q = nwg / NXCD, r = nwg % NXCD, xcd = wgid % NXCD, off = wgid / NXCD; wgid = (xcd < r ? xcd * (q + 1) : r * (q + 1) + (xcd - r) * q) + off; }
        const int nig = WGM * nN, gid = wgid / nig, fm = gid * WGM, gsz = (nM - fm) < WGM ? (nM - fm) : WGM;
        u.pm = fm + ((wgid % nig) % gsz); u.pn = (wgid % nig) / gsz; return true;
    }
};

template <class Epi>
DI void gemm_phase(LAS unsigned char* lds, const Gemm g, const StaticOrder& S, const Epi& E) {
    const int tid = threadIdx.x, wid = __builtin_amdgcn_readfirstlane(tid >> 6), lane = tid & 63, wr = wid >> 2, wc = wid & 3, fr = lane & 15, fq = lane >> 4;
    const int K = g.K, nt = K / BK;
    unsigned voffA[2];
#pragma unroll
    for (int i = 0; i < 2; ++i) { int R, C; stage_rc(tid * 16 + i * 8192, R, C); voffA[i] = (unsigned)(R * K + C) * 2u; }
    const size_t kstep = (size_t)(BK * 2);
    const size_t hstep = (size_t)HALF * K * 2;
    const size_t tstep = 2 * hstep;
    const unsigned ldsw = (unsigned)wid * 1024u;
    const int aoff = lds_byte(wr * 64 + fr, fq * 8), boff = lds_byte(wc * 32 + fr, fq * 8);
#define PG8_SA(b, h) (((b) * 2 + (h)) * HTB)
#define PG8_SB(b, h) ((4 + (b) * 2 + (h)) * HTB)
#define PG8_STAGE(bufoff, gbase, voff) do { _Pragma("unroll") for (int _i = 0; _i < 2; ++_i) \
        __builtin_amdgcn_global_load_lds((const unsigned*)((const char*)(gbase) + (voff)[_i]), (LAS unsigned*)(lds + (bufoff) + ldsw + _i * 8192), 16, 0, 0); } while (0)
#define PG8_LDA(dst, b, h) do { _Pragma("unroll") for (int m = 0; m < 4; ++m) _Pragma("unroll") for (int k = 0; k < 2; ++k) dst[m][k] = *(const LAS bf16x8*)(lds + PG8_SA(b, h) + aoff + m * 2048 + k * 1024); } while (0)
#define PG8_LDB(dst, b, h) do { _Pragma("unroll") for (int n = 0; n < 2; ++n) _Pragma("unroll") for (int k = 0; k < 2; ++k) dst[n][k] = *(const LAS bf16x8*)(lds + PG8_SB(b, h) + boff + n * 2048 + k * 1024); } while (0)
#define PG8_MMA(ai, bj, At, Bt) do { __builtin_amdgcn_s_setprio(1); _Pragma("unroll") for (int m = 0; m < 4; ++m) _Pragma("unroll") for (int n = 0; n < 2; ++n) _Pragma("unroll") for (int k = 0; k < 2; ++k) \
        acc[ai][bj][m][n] = __builtin_amdgcn_mfma_f32_16x16x32_bf16(Bt[n][k], At[m][k], acc[ai][bj][m][n], 0, 0, 0); __builtin_amdgcn_s_setprio(0); } while (0)
#define PG8_WAIT_V(n) asm volatile("s_waitcnt vmcnt(" #n ")" ::: "memory")
#define PG8_WAIT_L(n) asm volatile("s_waitcnt lgkmcnt(" #n ")" ::: "memory")
#define PG8_BAR __builtin_amdgcn_s_barrier()
#define PG8_SCHED __builtin_amdgcn_sched_barrier(0)
    Unit cur, nxt; int ui = 0;
    if (!S.next(0, cur)) return;
    f32x4 acc[2][2][4][2];
#pragma unroll
    for (int a = 0; a < 2; ++a)
#pragma unroll
        for (int b = 0; b < 2; ++b)
#pragma unroll
            for (int m = 0; m < 4; ++m)
#pragma unroll
                for (int n = 0; n < 2; ++n) acc[a][b][m][n] = (f32x4){0.f, 0.f, 0.f, 0.f};
    bf16x8 At[4][2], B0[2][2], B1[2][2];
    const char* cA = (const char*)g.A + (size_t)cur.pm * tstep; const char* cB = (const char*)g.Bt + (size_t)cur.pn * tstep;
    PG8_STAGE(PG8_SB(0, 0), cB, voffA); PG8_STAGE(PG8_SA(0, 0), cA, voffA); PG8_STAGE(PG8_SB(0, 1), cB + hstep, voffA); PG8_STAGE(PG8_SA(0, 1), cA + hstep, voffA);
    if (wr == 1) PG8_BAR;
    PG8_WAIT_V(4); PG8_BAR;
    PG8_STAGE(PG8_SB(1, 0), cB + kstep, voffA); PG8_STAGE(PG8_SA(1, 0), cA + kstep, voffA); PG8_STAGE(PG8_SB(1, 1), cB + hstep + kstep, voffA);
    PG8_WAIT_V(6); PG8_BAR;
    for (;;) {
        const bool has_next = S.next(ui + 1, nxt);
        const char* nA = has_next ? (const char*)g.A + (size_t)nxt.pm * tstep : cA; const char* nB = has_next ? (const char*)g.Bt + (size_t)nxt.pn * tstep : cB;
        for (int t = 0; t < nt; t += 2) {
            const bool last = (t == nt - 2);
            const char* a1 = cA + (size_t)(t + 1) * kstep;
            const char* a2 = last ? nA : cA + (size_t)(t + 2) * kstep; const char* b2 = last ? nB : cB + (size_t)(t + 2) * kstep;
            const char* a3 = a2 + kstep; const char* b3 = b2 + kstep;
            PG8_LDB(B0, 0, 0); PG8_SCHED; PG8_LDA(At, 0, 0); PG8_STAGE(PG8_SA(1, 1), a1 + hstep, voffA);
            PG8_WAIT_L(8); PG8_BAR; PG8_WAIT_L(0); PG8_MMA(0, 0, At, B0); PG8_BAR; PG8_SCHED;
            PG8_LDB(B1, 0, 1); PG8_STAGE(PG8_SB(0, 0), b2, voffA);
            PG8_BAR; PG8_WAIT_L(0); PG8_MMA(0, 1, At, B1); PG8_BAR;
            PG8_LDA(At, 0, 1); PG8_STAGE(PG8_SA(0, 0), a2, voffA);
            PG8_BAR; PG8_WAIT_L(0); PG8_MMA(1, 0, At, B0); PG8_BAR; PG8_SCHED;
            PG8_STAGE(PG8_SB(0, 1), b2 + hstep, voffA);
            PG8_WAIT_V(6); PG8_BAR; PG8_MMA(1, 1, At, B1); PG8_BAR;
            PG8_LDB(B0, 1, 0); PG8_SCHED; PG8_LDA(At, 1, 0); PG8_STAGE(PG8_SA(0, 1), a2 + hstep, voffA);
            PG8_WAIT_L(8); PG8_BAR; PG8_WAIT_L(0); PG8_MMA(0, 0, At, B0); PG8_BAR; PG8_SCHED;
            PG8_LDB(B1, 1, 1); PG8_STAGE(PG8_SB(1, 0), b3, voffA);
            PG8_BAR; PG8_WAIT_L(0); PG8_MMA(0, 1, At, B1); PG8_BAR;
            PG8_LDA(At, 1, 1); PG8_STAGE(PG8_SA(1, 0), a3, voffA);
            PG8_BAR; PG8_WAIT_L(0); PG8_MMA(1, 0, At, B0); PG8_BAR; PG8_SCHED;
            PG8_STAGE(PG8_SB(1, 1), b3 + hstep, voffA);
            PG8_WAIT_V(6); PG8_BAR; PG8_MMA(1, 1, At, B1); PG8_BAR;
        }
        E(acc, cur, wr, wc, fr, fq);
        if (!has_next) break;
#pragma unroll
        for (int a = 0; a < 2; ++a)
#pragma unroll
            for (int b = 0; b < 2; ++b)
#pragma unroll
                for (int m = 0; m < 4; ++m)
#pragma unroll
                    for (int n = 0; n < 2; ++n) acc[a][b][m][n] = (f32x4){0.f, 0.f, 0.f, 0.f};
        cur = nxt; cA = nA; cB = nB; ++ui;
    }
    PG8_WAIT_V(0);
    if (wr == 0) PG8_BAR;
    PG8_BAR;
#undef PG8_SA
#undef PG8_SB
#undef PG8_STAGE
#undef PG8_LDA
#undef PG8_LDB
#undef PG8_MMA
#undef PG8_WAIT_V
#undef PG8_WAIT_L
#undef PG8_BAR
#undef PG8_SCHED
}
}

DI size_t hm64(int row, int h)  { return ((size_t)((row >> 11) * 16 + h) * SEQ + (row & (SEQ - 1))) * 64; }
typedef f32x4 AccT[2][2][4][2];
#define EPI_LOOP_BEGIN \
    const int row0 = u.pm * 256 + wr * 64 + fr, col0 = u.pn * 256 + wc * 32 + 4 * fq; \
    _Pragma("unroll") for (int ai = 0; ai < 2; ++ai) _Pragma("unroll") for (int m = 0; m < 4; ++m) { const int row = row0 + ai * 128 + m * 16; \
    _Pragma("unroll") for (int bj = 0; bj < 2; ++bj) _Pragma("unroll") for (int n = 0; n < 2; ++n) { const int col = col0 + bj * 128 + n * 16; const f32x4 v = acc[ai][bj][m][n];
#define EPI_LOOP_END } }
#define EPI_LOOP_BEGIN_S \
    const int row0 = u.pm * 256 + wr * 64 + fr, col0 = u.pn * 256 + wc * 32 + 4 * fq; \
    _Pragma("unroll") for (int ai = 0; ai < 2; ++ai) _Pragma("unroll") for (int m = 0; m < 4; ++m) { const int row = row0 + ai * 128 + m * 16; \
    _Pragma("unroll") for (int bj = 0; bj < 2; ++bj) _Pragma("unroll") for (int n = 0; n < 2; ++n) { const int col = col0 + bj * 128 + n * 16; const f32x4 v = acc[ai][bj][m][n] * rs[ai][m];

struct EpiIn {
    bf16_t *Qb, *Kb, *Vb; bf16_t* RW; float* out;
    DI void operator()(const AccT& acc, const pg8::Unit& u, int wr, int wc, int fr, int fq) const {
        const int reg = u.pn < 4 ? 0 : (u.pn < 8 ? 1 : (u.pn < 12 ? 2 : 3));
        EPI_LOOP_BEGIN
            if (row < MT) {
                if (reg == 0) {
                    constexpr float QS_ = 0.125f * 1.44269504088896f;
                    u32x2 w; w.x = cvt_pk(v[0] * QS_, v[1] * QS_); w.y = cvt_pk(v[2] * QS_, v[3] * QS_);
                    *(u32x2*)(row < MP ? Qb + hm64(row, col >> 6) + (col & 63) : Qb + (size_t)row * 1024 + col) = w;
                } else if (reg == 1 || reg == 2) {
                    const int c = col - (reg == 1 ? 1024 : 2048);
                    float* o = row < MP ? out + (reg == 1 ? O_PK : O_PV) + (size_t)row * 1024 + c : out + (reg == 1 ? O_SK : O_SV) + (size_t)(row - MP) * 1024 + c;
                    *(f32x4*)o = v;
                    if (row < MP) { u32x2 w; w.x = cvt_pk(v[0], v[1]); w.y = cvt_pk(v[2], v[3]);
                        *(u32x2*)((reg == 1 ? Kb : Vb) + hm64(row, c >> 6) + (c & 63)) = w; }
                } else {
                    const int c = col - 3072;
                    if (c < CSH) {
                        { u32x2 w; w.x = cvt_pk(v[0], v[1]); w.y = cvt_pk(v[2], v[3]); *(u32x2*)(RW + (size_t)row * CSH + c) = w; }
                        if (row >= MP) *(f32x4*)(out + O_SRW + (size_t)(row - MP) * CSH + c) = v;
                        else if ((row & (SEQ - 1)) == SEQ - 1) *(f32x4*)(out + O_PRW + (size_t)(row >> 11) * CSH + c) = v;
                    }
                }
            }
        EPI_LOOP_END
    }
};
struct EpiBf {
    bf16_t* C; int ldc;
    DI void operator()(const AccT& acc, const pg8::Unit& u, int wr, int wc, int fr, int fq) const {
        const int row0 = u.pm * 256 + wr * 64 + fr, col0 = u.pn * 256 + wc * 32 + 4 * fq;
#pragma unroll
        for (int ai = 0; ai < 2; ++ai)
#pragma unroll
            for (int m = 0; m < 4; ++m) { const int row = row0 + ai * 128 + m * 16;
#pragma unroll
                for (int bj = 0; bj < 2; ++bj)
#pragma unroll
                    for (int n = 0; n < 2; ++n) { const int col = col0 + bj * 128 + n * 16; const f32x4 v = acc[ai][bj][m][n];
                        u32x2 w; w.x = cvt_pk(v[0], v[1]); w.y = cvt_pk(v[2], v[3]);
                        *(u32x2*)(C + (size_t)row * ldc + col) = w; }
                asm volatile("" ::: "memory");
            }
    }
};
struct EpiWo {
    const float *xp; const float* gf; float* X1; bf16_t* H; float* RSS;
    DI void operator()(const AccT& acc, const pg8::Unit& u, int wr, int wc, int fr, int fq) const {
        const int row0 = u.pm * 256 + wr * 64 + fr, col0 = u.pn * 256 + wc * 32 + 4 * fq;
#pragma unroll
        for (int ai = 0; ai < 2; ++ai)
#pragma unroll
            for (int m = 0; m < 4; ++m) {
                const int row = row0 + ai * 128 + m * 16; float ss = 0.f;
#pragma unroll
                for (int bj = 0; bj < 2; ++bj)
#pragma unroll
                    for (int n = 0; n < 2; ++n) {
                        const int col = col0 + bj * 128 + n * 16;
                        const f32x4 x1 = *(const f32x4*)(xp + (size_t)row * D + col) + acc[ai][bj][m][n];
                        *(f32x4*)(X1 + (size_t)row * D + col) = x1;
                        const f32x4 gg = *(const f32x4*)(gf + col);
                        u32x2 w; w.x = cvt_pk(x1[0] * gg[0], x1[1] * gg[1]); w.y = cvt_pk(x1[2] * gg[2], x1[3] * gg[3]);
                        *(u32x2*)(H + (size_t)row * D + col) = w;
                        ss += (x1[0] * x1[0] + x1[1] * x1[1]) + (x1[2] * x1[2] + x1[3] * x1[3]);
                    }
                ss += __shfl_xor(ss, 16); ss += __shfl_xor(ss, 32);
                if (fq == 0) atomic_add_f32(RSS + row, ss);
            }
    }
};
#define DPP_MOV(v, ctrl) __int_as_float(__builtin_amdgcn_update_dpp(0, __float_as_int(v), (ctrl), 0xf, 0xf, false))
struct EpiUpF {
    bf16_t* ACT; float* out; const float* RSS; const float* cw; const float* cb; float* EDGE; LAS float* xch;
    DI void operator()(const AccT& acc, const pg8::Unit& u, int wr, int wc, int fr, int fq) const {
        const int wave = wr * 4 + wc, row0 = u.pm * 256 + wr * 64 + fr, f0 = u.pn * 128 + wc * 32 + 4 * fq;
#define UPF_RS(ai_, m_) rsqrtf(RSS[row0 + (ai_) * 128 + (m_) * 16] * (1.f / D) + 1e-6f)
        if (fr >= 14) {
#pragma unroll
            for (int ai = 0; ai < 2; ++ai)
#pragma unroll
                for (int bj = 0; bj < 2; ++bj)
#pragma unroll
                    for (int n = 0; n < 2; ++n)
                        *(LAS f32x4*)(xch + wave * 256 + ((((ai * 2 + (fr - 14)) * 2 + bj) * 2 + n) * 4 + fq) * 4) = acc[ai][bj][3][n] * UPF_RS(ai, 3);
        }
        asm volatile("s_waitcnt lgkmcnt(0)" ::: "memory"); __builtin_amdgcn_s_barrier(); asm volatile("" ::: "memory");
        __builtin_amdgcn_s_barrier(); asm volatile("" ::: "memory");
        const bool prompt = u.pm < MP / 256;
#pragma unroll
        for (int n = 0; n < 2; ++n) {
            const int f = f0 + 16 * n;
            asm volatile("" ::: "memory");
            const f32x4 w0g = *(const f32x4*)(cw + f), w1g = *(const f32x4*)(cw + FF2 + f), w2g = *(const f32x4*)(cw + 2 * FF2 + f), bg = *(const f32x4*)(cb + f);
#pragma unroll
            for (int ai = 0; ai < 2; ++ai) {
                const bool have = (wr == 1) || (ai == 1);
                const int nbw = wr == 1 ? wave - 4 : wave + 4, nai = wr == 1 ? ai : 0;
                f32x4 pg = {0.f, 0.f, 0.f, 0.f}, pv = {0.f, 0.f, 0.f, 0.f};
                if (have && fr >= 14) {
                    pg = *(const LAS f32x4*)(xch + nbw * 256 + ((((nai * 2 + (fr - 14)) * 2 + 0) * 2 + n) * 4 + fq) * 4);
                    pv = *(const LAS f32x4*)(xch + nbw * 256 + ((((nai * 2 + (fr - 14)) * 2 + 1) * 2 + n) * 4 + fq) * 4);
                }
#pragma unroll
                for (int m = 0; m < 4; ++m) {
                    const int row = row0 + ai * 128 + m * 16;
                    const float rsm = UPF_RS(ai, m);
                    const f32x4 g = acc[ai][0][m][n] * rsm, v = acc[ai][1][m][n] * rsm;
                    float o[4];
#pragma unroll
                    for (int e = 0; e < 4; ++e) {
                        const float ga1 = DPP_MOV(g[e], 0x121), gb1 = DPP_MOV(pg[e], 0x121), ga2 = DPP_MOV(g[e], 0x122), gb2 = DPP_MOV(pg[e], 0x122);
                        const float g1 = fr >= 1 ? ga1 : gb1, g2 = fr >= 2 ? ga2 : gb2;
                        const float cg = bg[e] + w0g[e] * g2 + w1g[e] * g1 + w2g[e] * g[e];
                        o[e] = cg * __builtin_amdgcn_rcpf(1.f + __expf(-cg));
                    }
                    {
                        const f32x4 w0v = *(const f32x4*)(cw + FF + f), w1v = *(const f32x4*)(cw + FF2 + FF + f), w2v = *(const f32x4*)(cw + 2 * FF2 + FF + f), bv = *(const f32x4*)(cb + FF + f);
#pragma unroll
                        for (int e = 0; e < 4; ++e) {
                            const float va1 = DPP_MOV(v[e], 0x121), vb1 = DPP_MOV(pv[e], 0x121), va2 = DPP_MOV(v[e], 0x122), vb2 = DPP_MOV(pv[e], 0x122);
                            const float v1 = fr >= 1 ? va1 : vb1, v2 = fr >= 2 ? va2 : vb2;
                            o[e] *= bv[e] + w0v[e] * v2 + w1v[e] * v1 + w2v[e] * v[e];
                        }
                        asm volatile("" ::: "memory");
                    }
                    const int tr = wr * 64 + ai * 128 + m * 16 + fr;
                    if (prompt) {
                        u32x2 w; w.x = cvt_pk(o[0], o[1]); w.y = cvt_pk(o[2], o[3]);
                        *(u32x2*)((char*)ACT + ((unsigned)row * (unsigned)FF + (unsigned)f) * 2u) = w;
                    }
                    if (prompt ? (tr < 2 || tr >= 254) : tr < MS) {
                        const int er = prompt ? u.pm * 4 + (tr < 2 ? tr : tr - 252) : 128 + tr;
                        float* ed = (float*)((char*)EDGE + ((unsigned)er * (unsigned)FF2 + (unsigned)f) * 4u);
                        *(f32x4*)ed = g; *(f32x4*)(ed + FF) = v;
                    }
                    pg = g; pv = v;
                }
            }
        }
    }
#undef UPF_RS
};
#ifndef MK_P11_SCALE
#define MK_P11_SCALE 1.0f
#endif
struct EpiDn {
    float* X1;
    DI void operator()(const AccT& acc, const pg8::Unit& u, int wr, int wc, int fr, int fq) const {
        EPI_LOOP_BEGIN
            if (row < MT) { float* p = X1 + (size_t)row * D + col; *(f32x4*)p = *(const f32x4*)p + v * MK_P11_SCALE; }
        EPI_LOOP_END
    }
};

template <bool UPPERM = false>
DI void transpose_item(const float* W, int K, int N, bf16_t* WT, int ldt, float* scr, int item, int lane) {
    const int nblk = N / 32, kb = item / nblk, nb = item % nblk, k0 = 64 * kb, n0 = 32 * nb;
    const int d0 = UPPERM ? (((n0 < FF ? n0 : n0 - FF) >> 7) * 256 + (n0 < FF ? 0 : 128) + ((n0 < FF ? n0 : n0 - FF) & 127)) : n0;
#pragma unroll 8
    for (int i = 0; i < 32; ++i) { const int kk = 2 * i + (lane >> 5); scr[kk * 33 + (lane & 31)] = W[(size_t)(k0 + kk) * N + n0 + (lane & 31)]; }
    __builtin_amdgcn_fence(__ATOMIC_RELEASE, "wavefront"); asm volatile("s_waitcnt lgkmcnt(0)" ::: "memory");
    const int c = lane & 7;
#pragma unroll
    for (int j = 0; j < 4; ++j) { const int n = (lane >> 3) + 8 * j; const float* s = scr + (8 * c) * 33 + n;
        u32x4 o; o.x = pk2(s[0 * 33], s[1 * 33]); o.y = pk2(s[2 * 33], s[3 * 33]); o.z = pk2(s[4 * 33], s[5 * 33]); o.w = pk2(s[6 * 33], s[7 * 33]);
        *(u32x4*)(WT + (size_t)(d0 + n) * ldt + k0 + 8 * c) = o; }
    asm volatile("s_waitcnt lgkmcnt(0)" ::: "memory");
}
DI void rms_row_bf16(const float* xrow, const float* g, bf16_t* orow, int lane) {
    const f32x4* xr = (const f32x4*)xrow + lane; const f32x4* gr = (const f32x4*)g + lane;
    f32x4 v[8]; float s = 0.f;
#pragma unroll
    for (int j = 0; j < 8; ++j) { v[j] = xr[64 * j]; s += (v[j].x * v[j].x + v[j].y * v[j].y) + (v[j].z * v[j].z + v[j].w * v[j].w); }
    const float rstd = rsqrtf(wave_sum(s) * (1.f / D) + 1e-6f);
    u32x2* o8 = (u32x2*)orow + lane;
#pragma unroll
    for (int j = 0; j < 8; ++j) { const f32x4 gg = gr[64 * j]; u32x2 w; w.x = pk2(v[j].x * rstd * gg.x, v[j].y * rstd * gg.y); w.y = pk2(v[j].z * rstd * gg.z, v[j].w * rstd * gg.w); o8[64 * j] = w; }
}
DI void rms_row_f32(const float* xrow, const float* g, float* orow, int lane) {
    const f32x4* xr = (const f32x4*)xrow + lane; const f32x4* gr = (const f32x4*)g + lane;
    f32x4 v[8]; float s = 0.f;
#pragma unroll
    for (int j = 0; j < 8; ++j) { v[j] = xr[64 * j]; s += (v[j].x * v[j].x + v[j].y * v[j].y) + (v[j].z * v[j].z + v[j].w * v[j].w); }
    const float rstd = rsqrtf(wave_sum(s) * (1.f / D) + 1e-6f);
    f32x4* o = (f32x4*)orow + lane;
#pragma unroll
    for (int j = 0; j < 8; ++j) { const f32x4 gg = gr[64 * j]; o[64 * j] = v[j] * rstd * gg; }
}
DI void zero_row_bf16(bf16_t* orow, int ncols, int lane) {
    for (int c = lane * 8; c < ncols; c += 512) *(u32x4*)(orow + c) = (u32x4){0u, 0u, 0u, 0u};
}

DI void phase_prologue(const Args& a, unsigned char* lds, int gw, int ngw, int lane, int wave) {
    unsigned char* ws = a.ws;
    float* scr = (float*)(lds + wave * 16384);
    bf16_t* Win = (bf16_t*)(ws + WS_WIN); bf16_t* Wlo = (bf16_t*)(ws + WS_WLO);
    constexpr int IT_IN = (D / 64) * (CIN / 32);
    for (int it = gw; it < IT_IN; it += ngw) transpose_item(a.in[I_WIN], D, CIN, Win, D, scr, it, lane);
    for (int r = CIN + gw; r < NIN; r += ngw) zero_row_bf16(Win + (size_t)r * D, D, lane);
    {
        const int gt = gw * 64 + lane, ngt = ngw * 64;
        for (int i = gt; i < NLO * KLO; i += ngt) {
            const int n = i / KLO, k = i % KLO; float v = 0.f;
            if (n < 1024) { if (k < 64) v = a.in[I_WUP][k * 1024 + n]; }
            else if (n < 2048) { if (k >= 64 && k < 128) v = a.in[I_AUP][(k - 64) * 1024 + (n - 1024)]; }
            else { if (k >= 128 && k < 288) v = a.in[I_GUP][(k - 128) * 1024 + (n - 2048)]; }
            Wlo[i] = (bf16_t)bf_rne(v);
        }
    }
    { float* RSS = (float*)(ws + WS_RSS); for (int i = gw * 64 + lane; i < MPAD; i += ngw * 64) RSS[i] = 0.f; }
    bf16_t* H = (bf16_t*)(ws + WS_H);
    for (int m = gw; m < MPAD; m += ngw) {
        if (m < MT) rms_row_bf16(m < MP ? a.in[I_XP] + (size_t)m * D : a.in[I_XS] + (size_t)(m - MP) * D, a.in[I_NMG], H + (size_t)m * D, lane);
        else zero_row_bf16(H + (size_t)m * D, D, lane);
    }
}


DI void convert_wo_wup(const Args& a, unsigned char* lds, int wi, int nw, int wave, int lane) {
    float* scr = (float*)(lds + wave * 16384);
    constexpr int IT_O = (D / 64) * (D / 32), IT_UP = (D / 64) * (FF2 / 32);
    for (int it = wi; it < IT_O + IT_UP; it += nw) {
        if (it < IT_O) transpose_item(a.in[I_WO], D, D, (bf16_t*)(a.ws + WS_WO), D, scr, it, lane);
        else transpose_item<true>(a.in[I_FUP], D, FF2, (bf16_t*)(a.ws + WS_WUP), D, scr, it - IT_O, lane);
    }
}
DI void convert_wdn(const Args& a, unsigned char* lds, int wi, int nw, int wave, int lane) {
    float* scr = (float*)(lds + wave * 16384);
    constexpr int IT_DN = (FF / 64) * (D / 32);
    for (int it = wi; it < IT_DN; it += nw) transpose_item(a.in[I_FDN], FF, D, (bf16_t*)(a.ws + WS_WDN), FF, scr, it, lane);
}

DI float rw_prev_val(const Args& a, const bf16_t* RW, int m, int j) {
    if (m < MP) return (m & (SEQ - 1)) == 0 ? 0.f : bf2f(RW[(size_t)(m - 1) * CSH + j]);
    return a.in[I_SSH][(size_t)(m - MP) * CSH + j];
}
DI void lora_input_row(const Args& a, int m, int lane) {
    bf16_t* ALO = (bf16_t*)(a.ws + WS_ALO) + (size_t)m * KLO;
    if (m >= MT) { for (int c = lane; c < KLO; c += 64) ALO[c] = 0; return; }
    const bf16_t* RW = (const bf16_t*)(a.ws + WS_RW);
    const bf16_t* cur = RW + (size_t)m * CSH;
    for (int c = lane; c < KLO; c += 64) {
        float v = 0.f;
        if (c < 288) {
            const int j = 3072 + c; const float x = bf2f(cur[j]), p = rw_prev_val(a, RW, m, j); const float xs = x + a.in[I_MU][j] * (p - x);
            v = c < 64 ? 1.f - 2.f * __builtin_amdgcn_rcpf(1.f + __expf(2.f * xs)) : (c < 128 ? xs : __builtin_amdgcn_rcpf(1.f + __expf(-xs)));
        }
        ALO[c] = (bf16_t)bf_rne(v);
    }
}

DI int crow(int reg, int h) { return (reg & 3) + 8 * (reg >> 2) + 4 * h; }
typedef short s16x4 __attribute__((ext_vector_type(4)));
constexpr int VPITCH = 192;
DI void attn_prompt_unit(const Args& a, unsigned char* lds, int unit, int wave, int lane) {
    const bf16_t* Qb = (const bf16_t*)(a.ws + WS_QB); const bf16_t* Kb = (const bf16_t*)(a.ws + WS_KB); const bf16_t* Vb = (const bf16_t*)(a.ws + WS_VB);
    bf16_t* PO = (bf16_t*)(a.ws + WS_PART); float* PML = (float*)(a.ws + WS_PML);
    LAS unsigned char* img = (LAS unsigned char*)lds + wave * (32 * VPITCH);
    const int blk = unit & 63, br = (unit >> 6) % 3, bh = unit / 192, b = bh >> 4, h = bh & 15;
    const int rate = br == 0 ? 1 : (br == 1 ? 4 : 16), L = SEQ / rate, bpc = L / 32;
    const int rho = blk / bpc, l0 = (blk % bpc) * 32;
    const int r = lane & 31, hh = lane >> 5;
    const int mq = b * SEQ + rho + rate * (l0 + r);
    bf16x8 qf[4];
#pragma unroll
    for (int ks = 0; ks < 4; ++ks) qf[ks] = *(const bf16x8*)(Qb + ((size_t)bh * SEQ + rho + rate * (l0 + r)) * 64 + ks * 16 + 8 * hh);
    f32x16 o0, o1;
#pragma unroll
    for (int i = 0; i < 16; ++i) { o0[i] = 0.f; o1[i] = 0.f; }
    float mrun = -1e30f, lrun = 0.f;
    const int lq = l0 + r;
    const int c0 = l0 >= 128 ? 0 : (128 - l0) >> 5;
    const bf16_t* kbase = Kb + ((size_t)bh * SEQ + rho) * 64 + 8 * hh;
    const bf16_t* vbase = Vb + ((size_t)bh * SEQ + rho) * 64 + 8 * (lane & 7);
    bf16x8 kreg[4]; u32x4 vreg[4];
#define AT_PREFETCH(ch_) do { const int lk0_ = l0 - 128 + 32 * (ch_); \
        _Pragma("unroll") for (int ks = 0; ks < 4; ++ks) kreg[ks] = *(const bf16x8*)(kbase + (size_t)(rate * (lk0_ + r)) * 64 + ks * 16); \
        _Pragma("unroll") for (int i = 0; i < 4; ++i) vreg[i] = *(const u32x4*)(vbase + (size_t)(rate * (lk0_ + 8 * i + (lane >> 3))) * 64); } while (0)
    AT_PREFETCH(c0);
    const int i16 = lane & 15, tq = i16 >> 2, tp = i16 & 3, g16 = (lane >> 4) & 1;
    const unsigned troff = (unsigned)((4 * hh + tq) * VPITCH + g16 * 32 + 8 * tp);
    for (int ch = c0; ch < 5; ++ch) {
        const int lk0 = l0 - 128 + 32 * ch;
        bf16x8 kf[4];
#pragma unroll
        for (int ks = 0; ks < 4; ++ks) kf[ks] = kreg[ks];
#pragma unroll
        for (int i = 0; i < 4; ++i) *(LAS u32x4*)(img + (8 * i + (lane >> 3)) * VPITCH + 16 * (lane & 7)) = vreg[i];
        if (ch + 1 < 5) AT_PREFETCH(ch + 1);
        f32x16 st;
#pragma unroll
        for (int i = 0; i < 16; ++i) st[i] = 0.f;
#pragma unroll
        for (int ks = 0; ks < 4; ++ks) st = __builtin_amdgcn_mfma_f32_32x32x16_bf16(kf[ks], qf[ks], st, 0, 0, 0);
        float cmax = -1e30f;
        if (ch == 0 || ch == 4) {
#pragma unroll
            for (int i = 0; i < 16; ++i) { const int lk = lk0 + crow(i, hh); const bool ok = (lk <= lq) && (lk >= lq - 128); st[i] = ok ? st[i] : -1e30f; }
        }
#pragma unroll
        for (int i = 0; i < 16; ++i) cmax = fmaxf(cmax, st[i]);
        cmax = fmaxf(cmax, __shfl_xor(cmax, 32));
        const float mnew = fmaxf(mrun, cmax), alpha = __builtin_amdgcn_exp2f(mrun - mnew);
        float ps = 0.f;
#pragma unroll
        for (int i = 0; i < 16; ++i) { const float p = __builtin_amdgcn_exp2f(st[i] - mnew); st[i] = p; ps += p; }
        lrun = lrun * alpha + ps; mrun = mnew;
#pragma unroll
        for (int i = 0; i < 16; ++i) { o0[i] *= alpha; o1[i] *= alpha; }
#pragma unroll
        for (int s = 0; s < 2; ++s) {
            u32x4 pp; pp.x = pk2(st[8 * s], st[8 * s + 1]); pp.y = pk2(st[8 * s + 2], st[8 * s + 3]); pp.z = pk2(st[8 * s + 4], st[8 * s + 5]); pp.w = pk2(st[8 * s + 6], st[8 * s + 7]);
            const bf16x8 pf = __builtin_bit_cast(bf16x8, pp);
#pragma unroll
            for (int dt = 0; dt < 2; ++dt) {
                const s16x4 lo = __builtin_amdgcn_ds_read_tr16_b64_v4i16((LAS s16x4*)(img + troff + (16 * s) * VPITCH + dt * 64));
                const s16x4 hi = __builtin_amdgcn_ds_read_tr16_b64_v4i16((LAS s16x4*)(img + troff + (16 * s + 8) * VPITCH + dt * 64));
                const bf16x8 vf = __builtin_shufflevector(lo, hi, 0, 1, 2, 3, 4, 5, 6, 7);
                if (dt == 0) o0 = __builtin_amdgcn_mfma_f32_32x32x16_bf16(vf, pf, o0, 0, 0, 0);
                else o1 = __builtin_amdgcn_mfma_f32_32x32x16_bf16(vf, pf, o1, 0, 0, 0);
            }
        }
    }
#undef AT_PREFETCH
    const float ltot = lrun + __shfl_xor(lrun, 32);
    bf16_t* po = PO + ((size_t)br * MP + mq) * 1024 + h * 64;
#pragma unroll
    for (int g = 0; g < 4; ++g) {
        u32x2 w0, w1; w0.x = pk2(o0[4 * g], o0[4 * g + 1]); w0.y = pk2(o0[4 * g + 2], o0[4 * g + 3]); w1.x = pk2(o1[4 * g], o1[4 * g + 1]); w1.y = pk2(o1[4 * g + 2], o1[4 * g + 3]);
        *(u32x2*)(po + 8 * g + 4 * hh) = w0; *(u32x2*)(po + 32 + 8 * g + 4 * hh) = w1;
    }
    if (hh == 0) { float* pm = PML + (((size_t)br * MP + mq) * 16 + h) * 2; pm[0] = mrun; pm[1] = ltot; }
}
DI float sum16(float v) { v = DPP_ADD(v, 0xB1); v = DPP_ADD(v, 0x4E); v = DPP_ADD(v, 0x141); v = DPP_ADD(v, 0x140); return v; }
DI void attn_merge_task(const Args& a, int task, int lane) {
    const int m = task >> 2, h = (task & 3) * 4 + (lane >> 4), d = 4 * (lane & 15);
    const bf16_t* PO = (const bf16_t*)(a.ws + WS_PART); const float* PML = (const float*)(a.ws + WS_PML);
    bf16_t* O = (bf16_t*)(a.ws + WS_O);
    float mb[3], lb[3]; f32x4 ob[3];
#pragma unroll
    for (int br = 0; br < 3; ++br) { const float* pm = PML + (((size_t)br * MP + m) * 16 + h) * 2; mb[br] = pm[0]; lb[br] = pm[1];
        const u32x2 w = *(const u32x2*)(PO + ((size_t)br * MP + m) * 1024 + h * 64 + d);
        ob[br] = (f32x4){__uint_as_float(w.x << 16), __uint_as_float(w.x & 0xffff0000u), __uint_as_float(w.y << 16), __uint_as_float(w.y & 0xffff0000u)}; }
    const float M = fmaxf(mb[0], fmaxf(mb[1], mb[2]));
    f32x4 num = {0.f, 0.f, 0.f, 0.f}; float den = 0.f;
#pragma unroll
    for (int br = 0; br < 3; ++br) { const float w = __builtin_amdgcn_exp2f(mb[br] - M); num += ob[br] * w; den += w * lb[br]; }
    const f32x4 o = num * __builtin_amdgcn_rcpf(den);
    const float ss = sum16(o.x * o.x + o.y * o.y + o.z * o.z + o.w * o.w) * (1.f / 64.f);
    const float rs = rsqrtf(ss + 1e-6f);
    const f32x4 gg = *(const f32x4*)(a.in[I_AOG] + h * 64 + d);
    u32x2 w; w.x = pk2(o.x * rs * gg.x, o.y * rs * gg.y); w.y = pk2(o.z * rs * gg.z, o.w * rs * gg.w);
    *(u32x2*)(O + (size_t)m * D + h * 64 + d) = w;
}
DI void attn_sample_wg(const Args& a, unsigned char* lds, int unit, int wave, int lane) {
    float* part = (float*)lds;
    const int bh = unit * 2 + (wave >> 2), qt = wave & 3, b = bh >> 4, h = bh & 15, g = lane >> 4, l16 = lane & 15;
    const bf16_t* Qb = (const bf16_t*)(a.ws + WS_QB);
    const float* ck = a.in[I_CK] + (size_t)b * 2048 * 1024 + h * 64 + 4 * l16; const float* cv = a.in[I_CV] + (size_t)b * 2048 * 1024 + h * 64 + 4 * l16;
    const float* nk = a.out + O_SK + (size_t)b * 1024 + h * 64 + 4 * l16; const float* nv = a.out + O_SV + (size_t)b * 1024 + h * 64 + 4 * l16;
    const u32x2 qw = *(const u32x2*)(Qb + (size_t)(MP + b) * 1024 + h * 64 + 4 * l16);
    const float q0 = __uint_as_float(qw.x << 16), q1 = __uint_as_float(qw.x & 0xffff0000u), q2 = __uint_as_float(qw.y << 16), q3 = __uint_as_float(qw.y & 0xffff0000u);
    float mrun = -1e30f, lrun = 0.f; f32x4 acc = {0.f, 0.f, 0.f, 0.f};
    const int e0 = qt * 97, e1 = e0 + 97 < 387 ? e0 + 97 : 387;
    for (int ito = 0; ito < 25; ito += 5) {
        f32x4 kv[5], vv[5]; bool valid[5];
#pragma unroll
        for (int k = 0; k < 5; ++k) {
            const int e = e0 + (ito + k) * 4 + g; valid[k] = e < e1;
            const int ee = valid[k] ? e : e0, br = ee / 129, j = ee % 129, rate = br == 0 ? 1 : (br == 1 ? 4 : 16);
            const int row = 2048 - rate * j;
            const float* kp = j == 0 ? nk : ck + (size_t)row * 1024; const float* vp = j == 0 ? nv : cv + (size_t)row * 1024;
            kv[k] = *(const f32x4*)kp; vv[k] = *(const f32x4*)vp;
        }
#pragma unroll
        for (int k = 0; k < 5; ++k) {
            float s = sum16(q0 * kv[k].x + q1 * kv[k].y + q2 * kv[k].z + q3 * kv[k].w);
            if (!valid[k]) s = -1e30f;
            const float mnew = fmaxf(mrun, s), alpha = __builtin_amdgcn_exp2f(mrun - mnew), p = valid[k] ? __builtin_amdgcn_exp2f(s - mnew) : 0.f;
            lrun = lrun * alpha + p; acc = acc * alpha + vv[k] * p; mrun = mnew;
        }
    }
#pragma unroll
    for (int o = 16; o < 64; o <<= 1) {
        const float mo = __shfl_xor(mrun, o), lo = __shfl_xor(lrun, o);
        f32x4 ao; ao.x = __shfl_xor(acc.x, o); ao.y = __shfl_xor(acc.y, o); ao.z = __shfl_xor(acc.z, o); ao.w = __shfl_xor(acc.w, o);
        const float mn = fmaxf(mrun, mo), w0 = __builtin_amdgcn_exp2f(mrun - mn), w1 = __builtin_amdgcn_exp2f(mo - mn);
        lrun = lrun * w0 + lo * w1; acc = acc * w0 + ao * w1; mrun = mn;
    }
    if (g == 0) { *(f32x4*)(part + wave * 68 + 4 * l16) = acc; if (l16 == 0) { part[wave * 68 + 64] = mrun; part[wave * 68 + 65] = lrun; } }
    __syncthreads();
    if (qt == 0 && g == 0) {
        float M = -1e30f;
#pragma unroll
        for (int w = 0; w < 4; ++w) M = fmaxf(M, part[(wave + w) * 68 + 64]);
        f32x4 num = {0.f, 0.f, 0.f, 0.f}; float den = 0.f;
#pragma unroll
        for (int w = 0; w < 4; ++w) { const float wt = __builtin_amdgcn_exp2f(part[(wave + w) * 68 + 64] - M); num += *(const f32x4*)(part + (wave + w) * 68 + 4 * l16) * wt; den += part[(wave + w) * 68 + 65] * wt; }
        const f32x4 o = num * (1.f / den);
        const float ss = sum16(o.x * o.x + o.y * o.y + o.z * o.z + o.w * o.w);
        const float rs = rsqrtf(ss * (1.f / 64.f) + 1e-6f);
        const f32x4 gg = *(const f32x4*)(a.in[I_AOG] + h * 64 + 4 * l16);
        u32x2 w; w.x = pk2(o.x * rs * gg.x, o.y * rs * gg.y); w.y = pk2(o.z * rs * gg.z, o.w * rs * gg.w);
        *(u32x2*)((bf16_t*)(a.ws + WS_O) + (size_t)(MP + b) * D + h * 64 + 4 * l16) = w;
    }
    __syncthreads();
}

struct PrepParams { float mu_r, mu_k, mu_v, w0, a0, kk, ka, rk; };
struct PrepRaw { float cr, ck, cv, pr, pk, pv, lw, la, lg; };
DI void prep_params(const Args& a, PrepParams& P, int c) {
    P.mu_r = a.in[I_MU][c]; P.mu_k = a.in[I_MU][1024 + c]; P.mu_v = a.in[I_MU][2048 + c];
    P.w0 = a.in[I_W0][c]; P.a0 = a.in[I_A0][c]; P.kk = a.in[I_KK][c]; P.ka = a.in[I_KA][c]; P.rk = a.in[I_RK][c];
}
DI void prep_load(const Args& a, PrepRaw& R, const bf16_t* RW, int m, const bf16_t* Lrow, int c) {
    const bf16_t* cur = RW + (size_t)m * CSH;
    R.cr = bf2f(cur[c]); R.ck = bf2f(cur[1024 + c]); R.cv = bf2f(cur[2048 + c]);
    R.pr = rw_prev_val(a, RW, m, c); R.pk = rw_prev_val(a, RW, m, 1024 + c); R.pv = rw_prev_val(a, RW, m, 2048 + c);
    R.lw = bf2f(Lrow[c]); R.la = bf2f(Lrow[1024 + c]); R.lg = bf2f(Lrow[2048 + c]);
}
DI void prep_finish(const PrepRaw& R, const PrepParams& P, float* dst, float& g_out, float& bonus_out, int lane) {
    const float xr = R.cr + P.mu_r * (R.pr - R.cr), xk = R.ck + P.mu_k * (R.pk - R.ck), xv = R.cv + P.mu_v * (R.pv - R.cv);
    const float x = -(P.w0 + R.lw);
    const float sp = x > 20.f ? x : __logf(1.f + __expf(x));
    const float decay = __expf(-__expf(-sp - 0.5f));
    const float av = __builtin_amdgcn_rcpf(1.f + __expf(-(P.a0 + R.la)));
    float kkv = xk * P.kk;
    const float n2 = wave_sum(kkv * kkv);
    kkv = kkv * fminf(__builtin_amdgcn_rsqf(n2), 1e12f);
    const float keff = xk * (1.f + (av - 1.f) * P.ka);
    const float bon = wave_sum(xr * keff * P.rk) * xv;
    dst[lane] = xr; dst[64 + lane] = decay; dst[128 + lane] = keff; dst[192 + lane] = xv; dst[256 + lane] = -kkv; dst[320 + lane] = kkv * av;
    g_out = R.lg; bonus_out = bon;
}
DI float scan_step(float (&S)[64], const float* sv, float vi) {
    const f32x4* r4 = (const f32x4*)sv; const f32x4* w4 = (const f32x4*)(sv + 64); const f32x4* k4 = (const f32x4*)(sv + 128);
    const f32x4* a4 = (const f32x4*)(sv + 256); const f32x4* b4 = (const f32x4*)(sv + 320);
    float sa0 = 0.f, sa1 = 0.f;
#pragma unroll
    for (int j = 0; j < 16; ++j) { const f32x4 av = a4[j]; sa0 = fmaf(S[4 * j], av.x, sa0); sa1 = fmaf(S[4 * j + 1], av.y, sa1); sa0 = fmaf(S[4 * j + 2], av.z, sa0); sa1 = fmaf(S[4 * j + 3], av.w, sa1); }
    const float sa = sa0 + sa1;
    float y0 = 0.f, y1 = 0.f;
#pragma unroll
    for (int j = 0; j < 16; ++j) {
        const f32x4 bv = b4[j], kv = k4[j], wv = w4[j], rv = r4[j];
        float t;
        t = fmaf(vi, kv.x, sa * bv.x); S[4 * j] = fmaf(S[4 * j], wv.x, t); y0 = fmaf(S[4 * j], rv.x, y0);
        t = fmaf(vi, kv.y, sa * bv.y); S[4 * j + 1] = fmaf(S[4 * j + 1], wv.y, t); y1 = fmaf(S[4 * j + 1], rv.y, y1);
        t = fmaf(vi, kv.z, sa * bv.z); S[4 * j + 2] = fmaf(S[4 * j + 2], wv.z, t); y0 = fmaf(S[4 * j + 2], rv.z, y0);
        t = fmaf(vi, kv.w, sa * bv.w); S[4 * j + 3] = fmaf(S[4 * j + 3], wv.w, t); y1 = fmaf(S[4 * j + 3], rv.w, y1);
        if ((j & 3) == 3) asm volatile("" ::: "memory");
    }
    return y0 + y1;
}
DI void rwkv_post(const Args& a, float y, float g, float bonus, int m, int c) {
    const float mean = wave_sum(y) * (1.f / 64.f); const float d = y - mean; const float var = wave_sum(d * d) * (1.f / 64.f);
    const float yn = d * rsqrtf(var + 64e-5f) * a.in[I_LNW][c] + a.in[I_LNB][c];
    ((bf16_t*)(a.ws + WS_O))[(size_t)m * D + 1024 + c] = (bf16_t)bf_rne((yn + bonus) * g);
}

#define WG_BAR_LDS() do { asm volatile("s_waitcnt lgkmcnt(0)" ::: "memory"); __builtin_amdgcn_s_barrier(); asm volatile("" ::: "memory"); } while (0)
typedef float f32x2 __attribute__((ext_vector_type(2)));
DI f32x2 fma2(f32x2 a, f32x2 b, f32x2 c) { return __builtin_elementwise_fma(a, b, c); }
DI void scan_dot_a(const f32x2 (&Z)[32], const f32x2 (&P)[32], const float* sv, float& sz, float& sp) {
    const f32x4* a4 = (const f32x4*)(sv + 256);
    f32x2 saz = {0.f, 0.f}, sap = {0.f, 0.f};
#pragma unroll
    for (int j = 0; j < 16; ++j) { const f32x4 av = a4[j]; const f32x2 a0 = {av.x, av.y}, a1 = {av.z, av.w};
        saz = fma2(Z[2 * j], a0, saz); sap = fma2(P[2 * j], a0, sap); saz = fma2(Z[2 * j + 1], a1, saz); sap = fma2(P[2 * j + 1], a1, sap);
        if ((j & 7) == 7) asm volatile("" ::: "memory"); }
    sz = saz.x + saz.y; sp = sap.x + sap.y;
}
DI void scan_step3(f32x2 (&Z)[32], f32x2 (&P)[32], const float* sv, const float* svn, float vi, float& sz, float& sp, float& yz, float& yp) {
    const f32x4* r4 = (const f32x4*)sv; const f32x4* w4 = (const f32x4*)(sv + 64); const f32x4* k4 = (const f32x4*)(sv + 128);
    const f32x4* b4 = (const f32x4*)(sv + 320); const f32x4* an4 = (const f32x4*)(svn + 256);
    const f32x2 sz2 = {sz, sz}, sp2 = {sp, sp}, v2 = {vi, vi};
    f32x2 yz2 = {0.f, 0.f}, yp2 = {0.f, 0.f}, nz2 = {0.f, 0.f}, np2 = {0.f, 0.f};
    f32x4 buf[3][5];
#define S3_LD(g, j) do { buf[g][0] = b4[j]; buf[g][1] = k4[j]; buf[g][2] = w4[j]; buf[g][3] = r4[j]; buf[g][4] = an4[j]; asm volatile("" ::: "memory"); } while (0)
    S3_LD(0, 0); S3_LD(1, 1);
#pragma unroll
    for (int j = 0; j < 16; ++j) {
        if (j + 2 < 16) S3_LD((j + 2) % 3, j + 2);
        const f32x4 bv = buf[j % 3][0], kv = buf[j % 3][1], wv = buf[j % 3][2], rv = buf[j % 3][3], av = buf[j % 3][4];
        { const f32x2 b2 = {bv.x, bv.y}, k2 = {kv.x, kv.y}, w2 = {wv.x, wv.y}, r2 = {rv.x, rv.y}, a2 = {av.x, av.y};
          f32x2 tz = sz2 * b2; tz = fma2(v2, k2, tz); Z[2 * j] = fma2(Z[2 * j], w2, tz); yz2 = fma2(Z[2 * j], r2, yz2); nz2 = fma2(Z[2 * j], a2, nz2);
          const f32x2 tp = sp2 * b2; P[2 * j] = fma2(P[2 * j], w2, tp); yp2 = fma2(P[2 * j], r2, yp2); np2 = fma2(P[2 * j], a2, np2); }
        { const f32x2 b2 = {bv.z, bv.w}, k2 = {kv.z, kv.w}, w2 = {wv.z, wv.w}, r2 = {rv.z, rv.w}, a2 = {av.z, av.w};
          f32x2 tz = sz2 * b2; tz = fma2(v2, k2, tz); Z[2 * j + 1] = fma2(Z[2 * j + 1], w2, tz); yz2 = fma2(Z[2 * j + 1], r2, yz2); nz2 = fma2(Z[2 * j + 1], a2, nz2);
          const f32x2 tp = sp2 * b2; P[2 * j + 1] = fma2(P[2 * j + 1], w2, tp); yp2 = fma2(P[2 * j + 1], r2, yp2); np2 = fma2(P[2 * j + 1], a2, np2); }
        asm volatile("" ::: "memory");
    }
#undef S3_LD
    yz = yz2.x + yz2.y; yp = yp2.x + yp2.y; sz = nz2.x + nz2.y; sp = np2.x + np2.y;
}
DI void scan_pass1_unit(const Args& a, unsigned char* lds, int unit, int wave, int lane) {
    float* stg = (float*)lds;
    const int pp = wave & 3, pair = unit * 4 + pp, chain = pair / NS, seg = pair % NS, b = chain >> 4, h = chain & 15, c = h * 64 + lane;
    const int mbase = b * SEQ + seg * SEGL;
    constexpr int NB = SEGL / TB;
    if (wave < 4) {
        bf16_t* YL = (bf16_t*)(a.ws + WS_YL); bf16_t* QS = (bf16_t*)(a.ws + WS_QS); float* ZP = (float*)(a.ws + WS_ZP);
        f32x2 Z[32], P[32];
        int idl = lane; asm volatile("" : "+v"(idl));
#pragma unroll
        for (int j = 0; j < 32; ++j) { Z[j] = (f32x2){0.f, 0.f}; P[j] = (f32x2){idl == 2 * j ? 1.f : 0.f, idl == 2 * j + 1 ? 1.f : 0.f}; }
        WG_BAR_LDS();
        for (int blk = 0; blk < NB; ++blk) {
            const float* sb = stg + (((blk & 1) * 4 + pp) * TB) * 384;
            float sz, sp; scan_dot_a(Z, P, sb, sz, sp);
#pragma unroll 1
            for (int tt = 0; tt < TB; ++tt) {
                const float* sv = sb + tt * 384; const float* svn = sb + (tt + 1 < TB ? tt + 1 : tt) * 384;
                float yz, yp; scan_step3(Z, P, sv, svn, sv[192 + lane], sz, sp, yz, yp);
                const size_t o = (size_t)(mbase + blk * TB + tt) * 1024 + c;
                const unsigned yq = pk2(yz, yp); YL[o] = (bf16_t)(yq & 0xffffu); QS[o] = (bf16_t)(yq >> 16);
            }
            WG_BAR_LDS();
        }
        float* zp = ZP + (size_t)pair * 2 * 4096 + lane * 64;
#pragma unroll
        for (int j = 0; j < 16; ++j) { *(f32x4*)(zp + 4 * j) = (f32x4){Z[2 * j].x, Z[2 * j].y, Z[2 * j + 1].x, Z[2 * j + 1].y};
                                       *(f32x4*)(zp + 4096 + 4 * j) = (f32x4){P[2 * j].x, P[2 * j].y, P[2 * j + 1].x, P[2 * j + 1].y}; }
    } else {
        const bf16_t* RW = (const bf16_t*)(a.ws + WS_RW); const bf16_t* Lb = (const bf16_t*)(a.ws + WS_L);
        bf16_t* GB = (bf16_t*)(a.ws + WS_GB);
        PrepParams Pm; prep_params(a, Pm, c);
        PrepRaw raw[TB];
#define P1_LOAD(blk_) do { _Pragma("unroll") for (int k = 0; k < TB; ++k) { const int m = mbase + (blk_) * TB + k; prep_load(a, raw[k], RW, m, Lb + (size_t)m * NLO, c); } } while (0)
#define P1_FINISH(blk_) do { _Pragma("unroll") for (int k = 0; k < TB; ++k) { const int m = mbase + (blk_) * TB + k; float g, bon; \
            prep_finish(raw[k], Pm, stg + ((((blk_) & 1) * 4 + pp) * TB + k) * 384, g, bon, lane); \
            GB[((size_t)m * 16 + h) * 128 + lane] = (bf16_t)bf_rne(g); GB[((size_t)m * 16 + h) * 128 + 64 + lane] = (bf16_t)bf_rne(bon); } } while (0)
        P1_LOAD(0); P1_FINISH(0); P1_LOAD(1);
        WG_BAR_LDS();
        for (int blk = 0; blk < NB; ++blk) {
            if (blk + 1 < NB) P1_FINISH(blk + 1);
            if (blk + 2 < NB) P1_LOAD(blk + 2);
            WG_BAR_LDS();
        }
#undef P1_LOAD
#undef P1_FINISH
    }
}
DI void scan_sample_unit(const Args& a, unsigned char* lds, int unit, int wave, int lane) {
    float* sv = (float*)(lds + 2 * 4 * TB * 384 * 4) + wave * 384;
    const bf16_t* RW = (const bf16_t*)(a.ws + WS_RW); const bf16_t* Lb = (const bf16_t*)(a.ws + WS_L);
    const int b = unit >> 4, h = unit & 15, c = h * 64 + lane, m = MP + b;
    PrepParams P; prep_params(a, P, c);
    PrepRaw raw; prep_load(a, raw, RW, m, Lb + (size_t)m * NLO, c);
    float g, bon; prep_finish(raw, P, sv, g, bon, lane);
    float S[64];
    const float* s0 = a.in[I_SWKV] + ((size_t)(b * 16 + h) * 64 + lane) * 64;
#pragma unroll
    for (int j = 0; j < 16; ++j) { const f32x4 v = *(const f32x4*)(s0 + 4 * j); S[4 * j] = v.x; S[4 * j + 1] = v.y; S[4 * j + 2] = v.z; S[4 * j + 3] = v.w; }
    const float y = scan_step(S, sv, sv[192 + lane]);
    float* so = a.out + O_SWKV + ((size_t)(b * 16 + h) * 64 + lane) * 64;
#pragma unroll
    for (int j = 0; j < 16; ++j) *(f32x4*)(so + 4 * j) = (f32x4){S[4 * j], S[4 * j + 1], S[4 * j + 2], S[4 * j + 3]};
    rwkv_post(a, y, g, bon, m, c);
}
DI void scan_pass2_unit(const Args& a, unsigned char* lds, int chain, int wave, int lane) {
    float* Ssh = (float*)lds;
    float* Psh = Ssh + 64 * 65;
    const float* ZP = (const float*)(a.ws + WS_ZP); float* SST = (float*)(a.ws + WS_SST);
    const int tid = wave * 64 + lane, l16 = lane & 15, lq = lane >> 4, ib = wave >> 1, jb0 = 2 * (wave & 1);
    f32x4 S0 = {0.f, 0.f, 0.f, 0.f}, S1 = {0.f, 0.f, 0.f, 0.f};
    const float* Z0 = ZP + (size_t)(chain * NS) * 2 * 4096;
    f32x4 pn0 = *(const f32x4*)(Z0 + 4096 + tid * 8), pn1 = *(const f32x4*)(Z0 + 4096 + tid * 8 + 4);
    float zn0[4], zn1[4];
#pragma unroll
    for (int i = 0; i < 4; ++i) { zn0[i] = Z0[(16 * ib + 4 * lq + i) * 64 + 16 * jb0 + l16]; zn1[i] = Z0[(16 * ib + 4 * lq + i) * 64 + 16 * (jb0 + 1) + l16]; }
    for (int s = 0; s < NS; ++s) {
        float* sst = SST + ((size_t)chain * NS + s) * 4096;
#pragma unroll
        for (int i = 0; i < 4; ++i) { const int row = 16 * ib + 4 * lq + i;
            sst[row * 64 + 16 * jb0 + l16] = S0[i]; sst[row * 64 + 16 * (jb0 + 1) + l16] = S1[i];
            Ssh[row * 65 + 16 * jb0 + l16] = S0[i]; Ssh[row * 65 + 16 * (jb0 + 1) + l16] = S1[i]; }
        *(f32x4*)(Psh + tid * 8) = pn0; *(f32x4*)(Psh + tid * 8 + 4) = pn1;
        f32x4 n0 = {zn0[0], zn0[1], zn0[2], zn0[3]}, n1 = {zn1[0], zn1[1], zn1[2], zn1[3]};
        if (s + 1 < NS) {
            const float* Zs = ZP + (size_t)(chain * NS + s + 1) * 2 * 4096;
            pn0 = *(const f32x4*)(Zs + 4096 + tid * 8); pn1 = *(const f32x4*)(Zs + 4096 + tid * 8 + 4);
#pragma unroll
            for (int i = 0; i < 4; ++i) { zn0[i] = Zs[(16 * ib + 4 * lq + i) * 64 + 16 * jb0 + l16]; zn1[i] = Zs[(16 * ib + 4 * lq + i) * 64 + 16 * (jb0 + 1) + l16]; }
        }
        WG_BAR_LDS();
        if (s > 0) {
#pragma unroll
            for (int kk = 0; kk < 16; ++kk) {
                const float af = Ssh[(16 * ib + l16) * 65 + 4 * kk + lq];
                const float b0 = Psh[(4 * kk + lq) * 64 + 16 * jb0 + l16], b1 = Psh[(4 * kk + lq) * 64 + 16 * (jb0 + 1) + l16];
                n0 = __builtin_amdgcn_mfma_f32_16x16x4f32(af, b0, n0, 0, 0, 0);
                n1 = __builtin_amdgcn_mfma_f32_16x16x4f32(af, b1, n1, 0, 0, 0);
            }
        }
        WG_BAR_LDS();
        S0 = n0; S1 = n1;
    }
    float* so = a.out + O_PWKV + (size_t)chain * 4096;
#pragma unroll
    for (int i = 0; i < 4; ++i) { const int row = 16 * ib + 4 * lq + i; so[row * 64 + 16 * jb0 + l16] = S0[i]; so[row * 64 + 16 * (jb0 + 1) + l16] = S1[i]; }
}
DI bf16x8 cvt8(const f32x4 lo, const f32x4 hi) { u32x4 p; p.x = pk2(lo.x, lo.y); p.y = pk2(lo.z, lo.w); p.z = pk2(hi.x, hi.y); p.w = pk2(hi.z, hi.w); return __builtin_bit_cast(bf16x8, p); }
DI void scan_pass3_unit(const Args& a, int unit, int lane) {
    const float* SST = (const float*)(a.ws + WS_SST); const bf16_t* YL = (const bf16_t*)(a.ws + WS_YL); const bf16_t* QS = (const bf16_t*)(a.ws + WS_QS); const bf16_t* GB = (const bf16_t*)(a.ws + WS_GB);
    bf16_t* O = (bf16_t*)(a.ws + WS_O);
    const int sub = unit & 3, pair = unit >> 2, chain = pair / NS, seg = pair % NS, b = chain >> 4, h = chain & 15;
    const int r = lane & 31, hh = lane >> 5;
    const int m = b * SEQ + seg * SEGL + sub * 32 + r;
    f32x16 acc0, acc1;
#pragma unroll
    for (int i = 0; i < 16; ++i) { acc0[i] = 0.f; acc1[i] = 0.f; }
    const bf16_t* qrow = QS + (size_t)m * 1024 + h * 64 + 8 * hh;
    const float* s0 = SST + (size_t)pair * 4096 + (size_t)r * 64 + 8 * hh; const float* s1 = s0 + 32 * 64;
#pragma unroll
    for (int ks = 0; ks < 4; ++ks) {
        const bf16x8 qf = *(const bf16x8*)(qrow + ks * 16);
        const bf16x8 a0 = cvt8(*(const f32x4*)(s0 + ks * 16), *(const f32x4*)(s0 + ks * 16 + 4));
        const bf16x8 a1 = cvt8(*(const f32x4*)(s1 + ks * 16), *(const f32x4*)(s1 + ks * 16 + 4));
        acc0 = __builtin_amdgcn_mfma_f32_32x32x16_bf16(a0, qf, acc0, 0, 0, 0);
        acc1 = __builtin_amdgcn_mfma_f32_32x32x16_bf16(a1, qf, acc1, 0, 0, 0);
    }
    const bf16_t* yl = YL + (size_t)m * 1024 + h * 64 + 4 * hh;
    float y[32]; float sum = 0.f;
#pragma unroll
    for (int rt = 0; rt < 2; ++rt)
#pragma unroll
        for (int g = 0; g < 4; ++g) { const u32x2 yw = *(const u32x2*)(yl + rt * 32 + 8 * g); const f32x4 v = {__uint_as_float(yw.x << 16), __uint_as_float(yw.x & 0xffff0000u), __uint_as_float(yw.y << 16), __uint_as_float(yw.y & 0xffff0000u)};
#pragma unroll
            for (int e = 0; e < 4; ++e) { const float yy = v[e] + (rt == 0 ? acc0[4 * g + e] : acc1[4 * g + e]); y[rt * 16 + 4 * g + e] = yy; sum += yy; } }
    sum += __shfl_xor(sum, 32);
    const float mean = sum * (1.f / 64.f);
    float vs = 0.f;
#pragma unroll
    for (int e = 0; e < 32; ++e) { y[e] -= mean; vs += y[e] * y[e]; }
    vs += __shfl_xor(vs, 32);
    const float rstd = rsqrtf(vs * (1.f / 64.f) + 64e-5f);
    const bf16_t* gb = GB + ((size_t)m * 16 + h) * 128 + 4 * hh;
    const float* lw = a.in[I_LNW] + h * 64 + 4 * hh; const float* lb = a.in[I_LNB] + h * 64 + 4 * hh;
    bf16_t* orow = O + (size_t)m * D + 1024 + h * 64 + 4 * hh;
#pragma unroll
    for (int rt = 0; rt < 2; ++rt)
#pragma unroll
        for (int g = 0; g < 4; ++g) {
            const int off = rt * 32 + 8 * g;
            const f32x4 w4 = *(const f32x4*)(lw + off), b4 = *(const f32x4*)(lb + off);
            const u32x2 gw = *(const u32x2*)(gb + off), bw = *(const u32x2*)(gb + 64 + off);
            const float gg[4] = {__uint_as_float(gw.x << 16), __uint_as_float(gw.x & 0xffff0000u), __uint_as_float(gw.y << 16), __uint_as_float(gw.y & 0xffff0000u)};
            const float bb[4] = {__uint_as_float(bw.x << 16), __uint_as_float(bw.x & 0xffff0000u), __uint_as_float(bw.y << 16), __uint_as_float(bw.y & 0xffff0000u)};
            float o[4];
#pragma unroll
            for (int e = 0; e < 4; ++e) o[e] = (y[rt * 16 + 4 * g + e] * rstd * w4[e] + b4[e] + bb[e]) * gg[e];
            u32x2 w; w.x = pk2(o[0], o[1]); w.y = pk2(o[2], o[3]);
            *(u32x2*)(orow + off) = w;
        }
}

DI void unpack8(const u32x4 w, float (&u)[8]) {
    u[0] = __uint_as_float(w.x << 16); u[1] = __uint_as_float(w.x & 0xffff0000u); u[2] = __uint_as_float(w.y << 16); u[3] = __uint_as_float(w.y & 0xffff0000u);
    u[4] = __uint_as_float(w.z << 16); u[5] = __uint_as_float(w.z & 0xffff0000u); u[6] = __uint_as_float(w.w << 16); u[7] = __uint_as_float(w.w & 0xffff0000u);
}
constexpr int FIX_ROWS = 28 * 2 + MS + 8;
DI void conv_fix(const Args& a, int idx) {
    const int fg = idx % (FF / 8), ri = idx / (FF / 8), f = fg * 8;
    if (ri >= FIX_ROWS) return;
    const float* EDGE = (const float*)(a.ws + WS_U); bf16_t* ACT = (bf16_t*)(a.ws + WS_ACT);
    const float* cw = a.in[I_FCW]; const float* cb = a.in[I_FCB];
    const float *p0, *p1, *p2; int m;
    if (ri < 56) {
        const int ti = ri >> 1, k = ri & 1, pm = ti + 1 + ti / 7;
        m = pm * 256 + k;
        p0 = EDGE + ((size_t)pm * 4 + k) * FF2;
        p1 = k == 0 ? EDGE + ((size_t)(pm - 1) * 4 + 3) * FF2 : EDGE + ((size_t)pm * 4 + 0) * FF2;
        p2 = k == 0 ? EDGE + ((size_t)(pm - 1) * 4 + 2) * FF2 : EDGE + ((size_t)(pm - 1) * 4 + 3) * FF2;
    } else if (ri >= 56 + MS) {
        const int q = ri - 56 - MS, bb = q >> 1, k = q & 1;
        const float* src = EDGE + ((size_t)(bb * 8 + 7) * 4 + 2 + k) * FF2; float* dst = a.out + O_PFFN + ((size_t)bb * 2 + k) * FF2;
#pragma unroll
        for (int p = 0; p < 2; ++p) { *(f32x4*)(dst + p * FF + f) = *(const f32x4*)(src + p * FF + f); *(f32x4*)(dst + p * FF + f + 4) = *(const f32x4*)(src + p * FF + f + 4); }
        return;
    } else {
        const int b = ri - 56; m = MP + b;
        p0 = EDGE + (size_t)(128 + b) * FF2;
        { float* s1 = a.out + O_SFFN + (size_t)b * 2 * FF2 + FF2;
#pragma unroll
          for (int p = 0; p < 2; ++p) { *(f32x4*)(s1 + p * FF + f) = *(const f32x4*)(p0 + p * FF + f); *(f32x4*)(s1 + p * FF + f + 4) = *(const f32x4*)(p0 + p * FF + f + 4); } }
        p1 = a.in[I_SFFN] + (size_t)b * 2 * FF2 + FF2;
        p2 = a.in[I_SFFN] + (size_t)b * 2 * FF2;
        float* so = a.out + O_SFFN + (size_t)b * 2 * FF2;
#pragma unroll
        for (int p = 0; p < 2; ++p) { *(f32x4*)(so + p * FF + f) = *(const f32x4*)(p1 + p * FF + f); *(f32x4*)(so + p * FF + f + 4) = *(const f32x4*)(p1 + p * FF + f + 4); }
    }
    float c[2][8];
#pragma unroll
    for (int p = 0; p < 2; ++p)
#pragma unroll
        for (int j = 0; j < 8; ++j) { const int col = p * FF + f + j; c[p][j] = cb[col] + cw[col] * p2[col] + cw[FF2 + col] * p1[col] + cw[2 * FF2 + col] * p0[col]; }
    float o[8];
#pragma unroll
    for (int j = 0; j < 8; ++j) o[j] = c[0][j] * __builtin_amdgcn_rcpf(1.f + __expf(-c[0][j])) * c[1][j];
    u32x4 w; w.x = pk2(o[0], o[1]); w.y = pk2(o[2], o[3]); w.z = pk2(o[4], o[5]); w.w = pk2(o[6], o[7]);
    *(u32x4*)(ACT + (size_t)m * FF + f) = w;
}

#define XB_TMO      128
#define XB_XCNT(j)  (256  + 64 * (j))
#define XB_XSUB(j)  (1280 + 64 * (j))
#define XB_XGEN(j)  (2304 + 64 * (j))
#define XB_TOP      3328
#define XB_TOPGEN   3392
#define XCD_BAR_WORDS 3456
#define XB_SPIN_CAP (1u << 18)
DI unsigned xb_ld(unsigned* p)              { return __hip_atomic_load(p, __ATOMIC_RELAXED, __HIP_MEMORY_SCOPE_AGENT); }
DI unsigned xb_add(unsigned* p, unsigned v) { return __hip_atomic_fetch_add(p, v, __ATOMIC_RELAXED, __HIP_MEMORY_SCOPE_AGENT); }
DI unsigned xb_xcc_id() { return (unsigned)__builtin_amdgcn_s_getreg((3 << 11) | 20) & 0xFu; }
#define XB_SPIN(cond, bar) do { unsigned _sp = 0; while (cond) { __builtin_amdgcn_s_sleep(1); \
    if ((++_sp & 255u) == 0u) { if (xb_ld(&(bar)[XB_TMO])) break; if (_sp > XB_SPIN_CAP) { atomicAdd(&(bar)[XB_TMO], 1u); break; } } } } while (0)
struct XcdBarrier { unsigned* bar; unsigned x; volatile LAS unsigned* st; };
DI XcdBarrier xcd_barrier_post(unsigned* bar, volatile LAS unsigned* st) {
    XcdBarrier b; b.bar = bar; b.x = xb_xcc_id(); b.st = st;
    if (threadIdx.x == 0) (void)xb_add(&bar[XB_XCNT(b.x)], 1u);
    return b;
}
DI void xcd_barrier_complete(unsigned* bar, unsigned x, unsigned& nloc, unsigned& nx) {
    const unsigned G = gridDim.x * gridDim.y * gridDim.z;
    unsigned sum, cnt, mine, sp = 0u;
    for (;;) {
        sum = 0u; cnt = 0u; mine = 0u;
#pragma unroll
        for (unsigned j = 0; j < 16; ++j) { const unsigned c = xb_ld(&bar[XB_XCNT(j)]); sum += c; cnt += (c > 0u) ? 1u : 0u; mine = (j == x) ? c : mine; }
        if (sum == G) break;
        __builtin_amdgcn_s_sleep(1);
        if ((++sp & 255u) == 0u) { if (xb_ld(&bar[XB_TMO])) break; if (sp > XB_SPIN_CAP) { atomicAdd(&bar[XB_TMO], 1u); break; } }
    }
    nloc = mine > 0u ? mine : 1u; nx = cnt > 0u ? cnt : 1u;
}
DI void xcd_barrier(const XcdBarrier& b) {
    asm volatile("s_waitcnt vmcnt(0)" ::: "memory");
    __syncthreads();
    if (threadIdx.x == 0) {
        unsigned* bar = b.bar;
        __builtin_amdgcn_s_waitcnt(0);
        unsigned nloc = b.st[0], nx = b.st[1];
        if (nloc == 0u) { xcd_barrier_complete(bar, b.x, nloc, nx); b.st[0] = nloc; b.st[1] = nx; }
        const unsigned old = xb_add(&bar[XB_XSUB(b.x)], 1u);
        const unsigned gen = old / nloc;
        if (old + 1u == (gen + 1u) * nloc) {
            __builtin_amdgcn_fence(__ATOMIC_RELEASE, "agent");
            asm volatile("s_waitcnt vmcnt(0)" ::: "memory");
            const unsigned og = xb_add(&bar[XB_TOP], 1u);
            const unsigned tg = og / nx;
            if (og + 1u == (tg + 1u) * nx) xb_add(&bar[XB_TOPGEN], 1u);
            else XB_SPIN(xb_ld(&bar[XB_TOPGEN]) == tg, bar);
            __builtin_amdgcn_fence(__ATOMIC_ACQUIRE, "agent");
            xb_add(&bar[XB_XGEN(b.x)], 1u);
            asm volatile("s_waitcnt vmcnt(0)" ::: "memory");
        } else {
            XB_SPIN(xb_ld(&bar[XB_XGEN(b.x)]) == gen, bar);
            __builtin_amdgcn_fence(__ATOMIC_ACQUIRE, "agent");
            asm volatile("s_waitcnt vmcnt(0)" ::: "memory");
        }
    }
    __syncthreads();
}

DI void skinny_unit(const bf16_t* A, int lda, const bf16_t* Bt, int K, int unit, const float* base, int ldb, float* out, int ldo, unsigned char* lds, int wave, int lane,
                    const float* gf = nullptr, bf16_t* H = nullptr, float* RSS = nullptr) {
    float* red = (float*)lds;
    const int n0 = unit * 32, r = lane & 31, hh = lane >> 5, kw = K / 8, kb = wave * kw;
    f32x16 acc;
#pragma unroll
    for (int i = 0; i < 16; ++i) acc[i] = 0.f;
    const bf16_t* ap = A + (size_t)r * lda + kb + 8 * hh; const bf16_t* bp = Bt + (size_t)(n0 + r) * K + kb + 8 * hh;
#pragma unroll 4
    for (int k = 0; k < kw; k += 16) {
        const bf16x8 af = *(const bf16x8*)(ap + k), bf = *(const bf16x8*)(bp + k);
        acc = __builtin_amdgcn_mfma_f32_32x32x16_bf16(af, bf, acc, 0, 0, 0);
    }
#pragma unroll
    for (int i = 0; i < 16; ++i) red[(wave * 16 + i) * 64 + lane] = acc[i];
    __syncthreads();
#pragma unroll
    for (int q = 0; q < 2; ++q) {
        const int o = threadIdx.x + 512 * q, i = o >> 6, ln = o & 63;
        float sum = 0.f;
#pragma unroll
        for (int w = 0; w < 8; ++w) sum += red[(w * 16 + i) * 64 + ln];
        const int row = crow(i, ln >> 5), col = n0 + (ln & 31);
        const float x1 = base[(size_t)row * ldb + col] + sum * (H ? 1.0f : MK_P11_SCALE);
        out[(size_t)row * ldo + col] = x1;
        if (H) { H[(size_t)row * D + col] = (bf16_t)bf_rne(x1 * gf[col]);
            float ss = x1 * x1;
            ss += __shfl_xor(ss, 1); ss += __shfl_xor(ss, 2); ss += __shfl_xor(ss, 4); ss += __shfl_xor(ss, 8); ss += __shfl_xor(ss, 16);
            if ((ln & 31) == 0) atomic_add_f32(RSS + row, ss); }
    }
    __syncthreads();
}

constexpr int NPH = 14;
template <bool COOP>
__global__ void __launch_bounds__(NTHREADS, 2) mk_fwd(Args a) {
    extern __shared__ __attribute__((aligned(16))) unsigned char lds[];
    const int tid = threadIdx.x, lane = tid & 63, wave = __builtin_amdgcn_readfirstlane(tid >> 6);
    const int G = gridDim.x, bid = blockIdx.x, gw = bid * NWAVES + wave, ngw = G * NWAVES;
    unsigned char* ws = a.ws;
    LAS unsigned char* ldsl = (LAS unsigned char*)lds;
#ifndef PHMASK
#define PHMASK 0xffff
#endif
#define IN(k) (((PHMASK >> (k)) & 1) && a.ph_lo <= (k) && (k) < a.ph_hi)
    XcdBarrier xbar; xbar.bar = (unsigned*)(ws + WS_BAR); xbar.x = 0; xbar.st = nullptr;
    if (COOP) {
        volatile LAS unsigned* st = (volatile LAS unsigned*)(ldsl + LDS_BYTES - 16);
        if (tid < 4) st[tid] = 0u;
        __syncthreads();
        xbar = xcd_barrier_post((unsigned*)(ws + WS_BAR), st);
    }
#define SEAM(k) do { if (COOP && IN(k) && IN((k) + 1)) { if (a.ph_hi > 1000) cg::this_grid().sync(); else xcd_barrier(xbar); } } while (0)

    if (IN(0)) phase_prologue(a, lds, gw, ngw, lane, wave);
    SEAM(0);
    if (IN(1)) {
        pg8::Gemm g{(const bf16_t*)(ws + WS_H), (const bf16_t*)(ws + WS_WIN), MPAD, NIN, D}; pg8::StaticOrder S; S.init(MPAD, NIN, G, bid);
        EpiIn E{(bf16_t*)(ws + WS_QB), (bf16_t*)(ws + WS_KB), (bf16_t*)(ws + WS_VB), (bf16_t*)(ws + WS_RW), a.out};
        pg8::gemm_phase<EpiIn>(ldsl, g, S, E);
        {
            const int nu = (MPAD / 256) * (NIN / 256), rem = nu % G, first = rem == 0 ? 0 : rem, nfree = G - first;
            if (bid >= first) convert_wo_wup(a, lds, (bid - first) * NWAVES + wave, nfree * NWAVES, wave, lane);
        }
    }
    SEAM(1);
    if (IN(2)) {
        for (int u = bid; u < 256; u += G) attn_sample_wg(a, lds, u, wave, lane);
        for (int u = gw; u < 64 * 3 * 64; u += ngw) attn_prompt_unit(a, lds, u, wave, lane);
        for (int m = gw; m < MPAD; m += ngw) lora_input_row(a, m, lane);
    }
    SEAM(2);
    if (IN(3)) {
        pg8::Gemm g{(const bf16_t*)(ws + WS_ALO), (const bf16_t*)(ws + WS_WLO), MPAD, NLO, KLO}; pg8::StaticOrder S; S.init(MPAD, NLO, G, bid);
        EpiBf E{(bf16_t*)(ws + WS_L), NLO};
        pg8::gemm_phase<EpiBf>(ldsl, g, S, E);
#pragma unroll 2
        for (int t = gw; t < MP * 4; t += ngw) attn_merge_task(a, t, lane);
    }
    SEAM(3);
    if (IN(4)) {
#ifndef NO_P1
        for (int u = bid; u < 64 * NS / 4; u += G) scan_pass1_unit(a, lds, u, wave, lane);
#endif

    }
    SEAM(4);
    if (IN(5)) {
        if (G >= 128) {
            if (bid < 64) scan_pass2_unit(a, lds, bid, wave, lane);
            else for (int u = (bid - 64) * NWAVES + wave; u < 512; u += (G - 64) * NWAVES) scan_sample_unit(a, lds, u, wave, lane);
        } else {
            for (int ch = bid; ch < 64; ch += G) scan_pass2_unit(a, lds, ch, wave, lane);
            for (int u = gw; u < 512; u += ngw) scan_sample_unit(a, lds, u, wave, lane);
        }
    }
    SEAM(5);
    if (IN(6)) { for (int u = gw; u < 64 * NS * 4; u += ngw) scan_pass3_unit(a, u, lane); }
    SEAM(6);
    if (IN(7)) {
        pg8::Gemm g{(const bf16_t*)(ws + WS_O), (const bf16_t*)(ws + WS_WO), MP, D, D}; pg8::StaticOrder S; S.init(MP, D, G, bid);
        EpiWo E{a.in[I_XP], a.in[I_NFG], (float*)(ws + WS_X1), (bf16_t*)(ws + WS_H), (float*)(ws + WS_RSS)};
        pg8::gemm_phase<EpiWo>(ldsl, g, S, E);
        for (int u = bid; u < D / 32; u += G)
            skinny_unit((const bf16_t*)(ws + WS_O) + (size_t)MP * D, D, (const bf16_t*)(ws + WS_WO), D, u, a.in[I_XS], D, (float*)(ws + WS_X1) + (size_t)MP * D, D, lds, wave, lane,
                        a.in[I_NFG], (bf16_t*)(ws + WS_H) + (size_t)MP * D, (float*)(ws + WS_RSS) + MP);
    }
    SEAM(7);
    if (IN(9)) {
        pg8::Gemm g{(const bf16_t*)(ws + WS_H), (const bf16_t*)(ws + WS_WUP), MPAD, FF2, D}; pg8::StaticOrder S; S.init(MPAD, FF2, G, bid);
        EpiUpF E{(bf16_t*)(ws + WS_ACT), a.out, (const float*)(ws + WS_RSS), a.in[I_FCW], a.in[I_FCB], (float*)(ws + WS_U), (LAS float*)(ldsl + 131072)};
        pg8::gemm_phase<EpiUpF>(ldsl, g, S, E);
        {
            const int nu = (MPAD / 256) * (FF2 / 256), rem = nu % G, first = rem == 0 ? 0 : rem, nfree = G - first;
            if (bid >= first) convert_wdn(a, lds, (bid - first) * NWAVES + wave, nfree * NWAVES, wave, lane);
        }
    }
    SEAM(9);
    if (IN(10)) { for (int it = bid * NTHREADS + tid; it < FIX_ROWS * (FF / 8); it += G * NTHREADS) conv_fix(a, it); }
    SEAM(10);
    if (IN(11)) {
        pg8::Gemm g{(const bf16_t*)(ws + WS_ACT), (const bf16_t*)(ws + WS_WDN), MP, D, FF}; pg8::StaticOrder S; S.init(MP, D, G, bid);
        EpiDn E{(float*)(ws + WS_X1)};
        pg8::gemm_phase<EpiDn>(ldsl, g, S, E);
        for (int u = bid; u < D / 32; u += G)
            skinny_unit((const bf16_t*)(ws + WS_ACT) + (size_t)MP * FF, FF, (const bf16_t*)(ws + WS_WDN), FF, u, (const float*)(ws + WS_X1) + (size_t)MP * D, D, (float*)(ws + WS_X1) + (size_t)MP * D, D, lds, wave, lane);
    }
    SEAM(11);
    if (IN(12)) {
        for (int m = gw; m < MT; m += ngw)
            rms_row_f32((const float*)(ws + WS_X1) + (size_t)m * D, a.in[I_NFIN], m < MP ? a.out + O_YP + (size_t)m * D : a.out + O_YS + (size_t)(m - MP) * D, lane);
    }
#undef IN
#undef SEAM
}

#ifndef MK_ONE_LAUNCH
#define MK_ONE_LAUNCH 1
#endif
#ifndef MK_DBL_MASK
#define MK_DBL_MASK 0x0
#endif

extern "C" void kernel_launch(void* const* d_in, const int* in_sizes, int n_in, void* d_out, int out_size, void* d_ws, size_t ws_size, hipStream_t stream) {
    static int grid = 0;
    if (!grid) {
        if (n_in != 28 || (size_t)out_size != O_END || ws_size < WS_END) fprintf(stderr, "kernel_launch: unexpected shapes: n_in %d out %d (want %zu) ws %zu (want %zu)\n", n_in, out_size, O_END, ws_size, WS_END);
        int dev = 0, cus = 0; hipGetDevice(&dev); hipDeviceGetAttribute(&cus, hipDeviceAttributeMultiprocessorCount, dev);
        hipFuncSetAttribute((const void*)mk_fwd<true>, hipFuncAttributeMaxDynamicSharedMemorySize, LDS_BYTES);
        hipFuncSetAttribute((const void*)mk_fwd<false>, hipFuncAttributeMaxDynamicSharedMemorySize, LDS_BYTES);
        int per_cu = 0; hipOccupancyMaxActiveBlocksPerMultiprocessor(&per_cu, mk_fwd<true>, NTHREADS, LDS_BYTES);
        if (per_cu < 1) { fprintf(stderr, "kernel_launch: occupancy query says %d blocks/CU\n", per_cu); per_cu = 1; }
        grid = cus > 0 ? cus : 256;
    }
    Args a; memset(&a, 0, sizeof(a));
    for (int i = 0; i < 28; ++i) a.in[i] = (const float*)d_in[i];
    a.out = (float*)d_out; a.ws = (unsigned char*)d_ws;
#if MK_ONE_LAUNCH
    if (hipMemsetAsync((char*)d_ws + WS_BAR, 0, BAR_BYTES, stream) != hipSuccess) { fprintf(stderr, "kernel_launch: memset of the barrier words failed\n"); return; }
    a.ph_lo = 0; a.ph_hi = NPH;
    void* args[] = {&a};
    hipError_t e = hipLaunchCooperativeKernel((const void*)mk_fwd<true>, dim3(grid), dim3(NTHREADS), args, LDS_BYTES, stream);
    if (e != hipSuccess) fprintf(stderr, "cooperative launch failed: %s (grid %d)\n", hipGetErrorString(e), grid);
#else
    for (int p = 0; p < 13; ++p) {
        a.ph_lo = p; a.ph_hi = p + 1;
        mk_fwd<false><<<dim3(grid), dim3(NTHREADS), LDS_BYTES, stream>>>(a);
        if ((MK_DBL_MASK >> p) & 1) mk_fwd<false><<<dim3(grid), dim3(NTHREADS), LDS_BYTES, stream>>>(a);
    }
#endif
}
```

```cpp
#include <hip/hip_runtime.h>
#include <hip/hip_cooperative_groups.h>
#include <cstdio>
#include <cstdint>
#include <cstring>
namespace cg = cooperative_groups;

#define DI __device__ __forceinline__
#define LAS __attribute__((address_space(3)))
typedef unsigned short bf16_t;
typedef short bf16x8 __attribute__((ext_vector_type(8)));
typedef float f32x4 __attribute__((ext_vector_type(4)));
typedef float f32x16 __attribute__((ext_vector_type(16)));
typedef unsigned u32x4 __attribute__((ext_vector_type(4)));
typedef unsigned u32x2 __attribute__((ext_vector_type(2)));

constexpr int D = 2048, MP = 8192, MS = 32, MT = 8224, MPAD = 8448, SEQ = 2048;
constexpr int CIN = 6432, NIN = 6656, CSH = 3360, FF2 = 11264, FF = 5632;
constexpr int NLO = 3072, KLO = 384;
constexpr int NS = 16, SEGL = 128, TB = 8;
constexpr int NTHREADS = 512, NWAVES = 8;
constexpr int LDS_BYTES = 131072 + 16384;

constexpr size_t O_YP = 0;
constexpr size_t O_YS = O_YP + (size_t)MP * D;
constexpr size_t O_PK = O_YS + (size_t)MS * D;
constexpr size_t O_PV = O_PK + (size_t)MP * 1024;
constexpr size_t O_PRW = O_PV + (size_t)MP * 1024;
constexpr size_t O_PWKV = O_PRW + (size_t)4 * CSH;
constexpr size_t O_PFFN = O_PWKV + (size_t)4 * 16 * 4096;
constexpr size_t O_SK = O_PFFN + (size_t)4 * 2 * FF2;
constexpr size_t O_SV = O_SK + (size_t)MS * 1024;
constexpr size_t O_SRW = O_SV + (size_t)MS * 1024;
constexpr size_t O_SWKV = O_SRW + (size_t)MS * CSH;
constexpr size_t O_SFFN = O_SWKV + (size_t)MS * 16 * 4096;
constexpr size_t O_END = O_SFFN + (size_t)MS * 2 * FF2;

constexpr size_t al256(size_t x) { return (x + 255) & ~(size_t)255; }
constexpr size_t WS_WIN = 0;
constexpr size_t WS_WO = WS_WIN + al256((size_t)NIN * D * 2);
constexpr size_t WS_WUP = WS_WO + al256((size_t)D * D * 2);
constexpr size_t WS_WDN = WS_WUP + al256((size_t)FF2 * D * 2);
constexpr size_t WS_WLO = WS_WDN + al256((size_t)D * FF * 2);
constexpr size_t WS_H = WS_WLO + al256((size_t)NLO * KLO * 2);
constexpr size_t WS_QB = WS_H + al256((size_t)MPAD * D * 2);
constexpr size_t WS_KB = WS_QB + al256((size_t)MPAD * 1024 * 2);
constexpr size_t WS_VB = WS_KB + al256((size_t)MPAD * 1024 * 2);
constexpr size_t WS_ALO = WS_VB + al256((size_t)MPAD * 1024 * 2);
constexpr size_t WS_O = WS_ALO + al256((size_t)MPAD * KLO * 2);
constexpr size_t WS_GB = WS_O + al256((size_t)MPAD * D * 2);
constexpr size_t WS_YL = WS_GB + al256((size_t)MT * 2048 * 2);
constexpr size_t WS_QS = WS_YL + al256((size_t)MP * 1024 * 2);
constexpr size_t WS_ZP = WS_QS + al256((size_t)MP * 1024 * 2);
constexpr size_t WS_SST = WS_ZP + al256((size_t)64 * NS * 2 * 4096 * 4);
constexpr size_t WS_X1 = WS_SST + al256((size_t)64 * NS * 4096 * 4);
constexpr size_t WS_PML = WS_X1 + al256((size_t)MPAD * D * 4);
constexpr size_t WS_RA = WS_PML + al256((size_t)3 * MP * 16 * 2 * 4);
constexpr size_t WS_RW = WS_RA;
constexpr size_t WS_L = WS_RW + al256((size_t)MPAD * CSH * 2);
constexpr size_t RA_BYTES_1 = al256((size_t)MPAD * CSH * 2) + al256((size_t)MPAD * NLO * 2);
constexpr size_t RA_BYTES_2 = al256((size_t)MPAD * FF2 * 2);
constexpr size_t WS_U = WS_RA;
constexpr size_t WS_RB = WS_RA + (RA_BYTES_1 > RA_BYTES_2 ? RA_BYTES_1 : RA_BYTES_2);
constexpr size_t WS_PART = WS_RB;
constexpr size_t WS_ACT = WS_RB;
constexpr size_t RB_BYTES_1 = al256((size_t)3 * MP * 1024 * 2);
constexpr size_t RB_BYTES_2 = al256((size_t)MPAD * FF * 2);
constexpr size_t WS_RSS = WS_RB + (RB_BYTES_1 > RB_BYTES_2 ? RB_BYTES_1 : RB_BYTES_2);
constexpr size_t WS_BAR_ = 0; constexpr size_t WS_BAR = al256((size_t)MPAD * 4) + WS_RB + (RB_BYTES_1 > RB_BYTES_2 ? RB_BYTES_1 : RB_BYTES_2);
constexpr size_t BAR_BYTES = 16384;
constexpr size_t WS_END = WS_BAR + BAR_BYTES;

struct Args {
    const float* in[28];
    float* out;
    unsigned char* ws;
    int ph_lo, ph_hi;
};
enum { I_XP = 0, I_XS, I_CK, I_CV, I_SSH, I_SWKV, I_SFFN, I_NMG, I_WIN, I_AOG, I_MU, I_W0, I_WUP, I_A0, I_AUP, I_GUP,
       I_KK, I_KA, I_RK, I_LNW, I_LNB, I_WO, I_NFG, I_FUP, I_FCW, I_FCB, I_FDN, I_NFIN };

typedef float f32x2c __attribute__((ext_vector_type(2)));
typedef __bf16 bf16x2c __attribute__((ext_vector_type(2)));
DI unsigned pk2(float lo, float hi) { const f32x2c v = {lo, hi}; return __builtin_bit_cast(unsigned, __builtin_convertvector(v, bf16x2c)); }
DI unsigned bf_rne(float f) { return pk2(f, 0.f) & 0xffffu; }
DI unsigned cvt_pk(float lo, float hi) { return pk2(lo, hi); }
DI void atomic_add_f32(float* p, float v) { (void)__builtin_amdgcn_global_atomic_fadd_f32((__attribute__((address_space(1))) float*)p, v); }
DI float bf2f(unsigned short b) { return __uint_as_float(((unsigned)b) << 16); }
#define DPP_ADD(v, ctrl) ((v) + __int_as_float(__builtin_amdgcn_update_dpp(0, __float_as_int(v), (ctrl), 0xf, 0xf, false)))
DI float wave_sum(float v) {
    v = DPP_ADD(v, 0xB1);
    v = DPP_ADD(v, 0x4E);
    v = DPP_ADD(v, 0x141);
    v = DPP_ADD(v, 0x140);
    const float s0 = __int_as_float(__builtin_amdgcn_readlane(__float_as_int(v), 0)), s1 = __int_as_float(__builtin_amdgcn_readlane(__float_as_int(v), 16));
    const float s2 = __int_as_float(__builtin_amdgcn_readlane(__float_as_int(v), 32)), s3 = __int_as_float(__builtin_amdgcn_readlane(__float_as_int(v), 48));
    return (s0 + s1) + (s2 + s3);
}

namespace pg8 {
constexpr int BM = 256, BK = 64, HALF = 128, HTB = HALF * BK * 2, STAGE_BYTES = 8 * HTB, NXCD = 8, WGM = 8;
DI int lds_byte(int r, int c) { const int st = (r >> 4) * 2 + (c >> 5), rr = r & 15, cc = c & 31, ob = rr * 64 + cc * 2; return st * 1024 + (ob ^ (((ob >> 9) & 1) << 5)); }
DI void stage_rc(int b, int& R, int& C) { const int st = b / 1024, sb = b % 1024, swz = sb ^ (((sb >> 9) & 1) << 5); R = (st >> 1) * 16 + swz / 64; C = (st & 1) * 32 + (swz % 64) / 2; }
struct Unit { int pm, pn; };
struct Gemm { const bf16_t* A; const bf16_t* Bt; int M, N, K; };
struct StaticOrder {
    int nM, nN, nwg, G, c;
    DI void init(int M, int N, int G_, int c_) { nM = M / BM; nN = N / BM; nwg = nM * nN; G = G_; c = c_; }
    DI bool next(int i, Unit& u) const {
        const long L = (long)i * G + c; if (L >= nwg) return false;
        int wgid = (int)L; { const int q = nwg / NXCD, r = nwg % NXCD, xcd = wgid % NXCD, off = wgid / NXCD; wgid = (xcd < r ? xcd * (q + 1) : r * (q + 1) + (xcd - r) * q) + off; }
        const int nig = WGM * nN, gid = wgid / nig, fm = gid * WGM, gsz = (nM - fm) < WGM ? (nM - fm) : WGM;
        u.pm = fm + ((wgid % nig) % gsz); u.pn = (wgid % nig) / gsz; return true;
    }
};

template <class Epi>
DI void gemm_phase(LAS unsigned char* lds, const Gemm g, const StaticOrder& S, const Epi& E) {
    const int tid = threadIdx.x, wid = __builtin_amdgcn_readfirstlane(tid >> 6), lane = tid & 63, wr = wid >> 2, wc = wid & 3, fr = lane & 15, fq = lane >> 4;
    const int K = g.K, nt = K / BK;
    unsigned voffA[2];
#pragma unroll
    for (int i = 0; i < 2; ++i) { int R, C; stage_rc(tid * 16 + i * 8192, R, C); voffA[i] = (unsigned)(R * K + C) * 2u; }
    const size_t kstep = (size_t)(BK * 2);
    const size_t hstep = (size_t)HALF * K * 2;
    const size_t tstep = 2 * hstep;
    const unsigned ldsw = (unsigned)wid * 1024u;
    const int aoff = lds_byte(wr * 64 + fr, fq * 8), boff = lds_byte(wc * 32 + fr, fq * 8);
#define PG8_SA(b, h) (((b) * 2 + (h)) * HTB)
#define PG8_SB(b, h) ((4 + (b) * 2 + (h)) * HTB)
#define PG8_STAGE(bufoff, gbase, voff) do { _Pragma("unroll") for (int _i = 0; _i < 2; ++_i) \
        __builtin_amdgcn_global_load_lds((const unsigned*)((const char*)(gbase) + (voff)[_i]), (LAS unsigned*)(lds + (bufoff) + ldsw + _i * 8192), 16, 0, 0); } while (0)
#define PG8_LDA(dst, b, h) do { _Pragma("unroll") for (int m = 0; m < 4; ++m) _Pragma("unroll") for (int k = 0; k < 2; ++k) dst[m][k] = *(const LAS bf16x8*)(lds + PG8_SA(b, h) + aoff + m * 2048 + k * 1024); } while (0)
#define PG8_LDB(dst, b, h) do { _Pragma("unroll") for (int n = 0; n < 2; ++n) _Pragma("unroll") for (int k = 0; k < 2; ++k) dst[n][k] = *(const LAS bf16x8*)(lds + PG8_SB(b, h) + boff + n * 2048 + k * 1024); } while (0)
#define PG8_MMA(ai, bj, At, Bt) do { __builtin_amdgcn_s_setprio(1); _Pragma("unroll") for (int m = 0; m < 4; ++m) _Pragma("unroll") for (int n = 0; n < 2; ++n) _Pragma("unroll") for (int k = 0; k < 2; ++k) \
        acc[ai][bj][m][n] = __builtin_amdgcn_mfma_f32_16x16x32_bf16(Bt[n][k], At[m][k], acc[ai][bj][m][n], 0, 0, 0); __builtin_amdgcn_s_setprio(0); } while (0)
#define PG8_WAIT_V(n) asm volatile("s_waitcnt vmcnt(" #n ")" ::: "memory")
#define PG8_WAIT_L(n) asm volatile("s_waitcnt lgkmcnt(" #n ")" ::: "memory")
#define PG8_BAR __builtin_amdgcn_s_barrier()
#define PG8_SCHED __builtin_amdgcn_sched_barrier(0)
    Unit cur, nxt; int ui = 0;
    if (!S.next(0, cur)) return;
    f32x4 acc[2][2][4][2];
#pragma unroll
    for (int a = 0; a < 2; ++a)
#pragma unroll
        for (int b = 0; b < 2; ++b)
#pragma unroll
            for (int m = 0; m < 4; ++m)
#pragma unroll
                for (int n = 0; n < 2; ++n) acc[a][b][m][n] = (f32x4){0.f, 0.f, 0.f, 0.f};
    bf16x8 At[4][2], B0[2][2], B1[2][2];
    const char* cA = (const char*)g.A + (size_t)cur.pm * tstep; const char* cB = (const char*)g.Bt + (size_t)cur.pn * tstep;
    PG8_STAGE(PG8_SB(0, 0), cB, voffA); PG8_STAGE(PG8_SA(0, 0), cA, voffA); PG8_STAGE(PG8_SB(0, 1), cB + hstep, voffA); PG8_STAGE(PG8_SA(0, 1), cA + hstep, voffA);
    if (wr == 1) PG8_BAR;
    PG8_WAIT_V(4); PG8_BAR;
    PG8_STAGE(PG8_SB(1, 0), cB + kstep, voffA); PG8_STAGE(PG8_SA(1, 0), cA + kstep, voffA); PG8_STAGE(PG8_SB(1, 1), cB + hstep + kstep, voffA);
    PG8_WAIT_V(6); PG8_BAR;
    for (;;) {
        const bool has_next = S.next(ui + 1, nxt);
        const char* nA = has_next ? (const char*)g.A + (size_t)nxt.pm * tstep : cA; const char* nB = has_next ? (const char*)g.Bt + (size_t)nxt.pn * tstep : cB;
        for (int t = 0; t < nt; t += 2) {
            const bool last = (t == nt - 2);
            const char* a1 = cA + (size_t)(t + 1) * kstep;
            const char* a2 = last ? nA : cA + (size_t)(t + 2) * kstep; const char* b2 = last ? nB : cB + (size_t)(t + 2) * kstep;
            const char* a3 = a2 + kstep; const char* b3 = b2 + kstep;
            PG8_LDB(B0, 0, 0); PG8_SCHED; PG8_LDA(At, 0, 0); PG8_STAGE(PG8_SA(1, 1), a1 + hstep, voffA);
            PG8_WAIT_L(8); PG8_BAR; PG8_WAIT_L(0); PG8_MMA(0, 0, At, B0); PG8_BAR; PG8_SCHED;
            PG8_LDB(B1, 0, 1); PG8_STAGE(PG8_SB(0, 0), b2, voffA);
            PG8_BAR; PG8_WAIT_L(0); PG8_MMA(0, 1, At, B1); PG8_BAR;
            PG8_LDA(At, 0, 1); PG8_STAGE(PG8_SA(0, 0), a2, voffA);
            PG8_BAR; PG8_WAIT_L(0); PG8_MMA(1, 0, At, B0); PG8_BAR; PG8_SCHED;
            PG8_STAGE(PG8_SB(0, 1), b2 + hstep, voffA);
            PG8_WAIT_V(6); PG8_BAR; PG8_MMA(1, 1, At, B1); PG8_BAR;
            PG8_LDB(B0, 1, 0); PG8_SCHED; PG8_LDA(At, 1, 0); PG8_STAGE(PG8_SA(0, 1), a2 + hstep, voffA);
            PG8_WAIT_L(8); PG8_BAR; PG8_WAIT_L(0); PG8_MMA(0, 0, At, B0); PG8_BAR; PG8_SCHED;
            PG8_LDB(B1, 1, 1); PG8_STAGE(PG8_SB(1, 0), b3, voffA);
            PG8_BAR; PG8_WAIT_L(0); PG8_MMA(0, 1, At, B1); PG8_BAR;
            PG8_LDA(At, 1, 1); PG8_STAGE(PG8_SA(1, 0), a3, voffA);
            PG8_BAR; PG8_WAIT_L(0); PG8_MMA(1, 0, At, B0); PG8_BAR; PG8_SCHED;
            PG8_STAGE(PG8_SB(1, 1), b3 + hstep, voffA);
            PG8_WAIT_V(6); PG8_BAR; PG8_MMA(1, 1, At, B1); PG8_BAR;
        }
        E(acc, cur, wr, wc, fr, fq);
        if (!has_next) break;
#pragma unroll
        for (int a = 0; a < 2; ++a)
#pragma unroll
            for (int b = 0; b < 2; ++b)
#pragma unroll
                for (int m = 0; m < 4; ++m)
#pragma unroll
                    for (int n = 0; n < 2; ++n) acc[a][b][m][n] = (f32x4){0.f, 0.f, 0.f, 0.f};
        cur = nxt; cA = nA; cB = nB; ++ui;
    }
    PG8_WAIT_V(0);
    if (wr == 0) PG8_BAR;
    PG8_BAR;
#undef PG8_SA
#undef PG8_SB
#undef PG8_STAGE
#undef PG8_LDA
#undef PG8_LDB
#undef PG8_MMA
#undef PG8_WAIT_V
#undef PG8_WAIT_L
#undef PG8_BAR
#undef PG8_SCHED
}
}

DI size_t hm64(int row, int h)  { return ((size_t)((row >> 11) * 16 + h) * SEQ + (row & (SEQ - 1))) * 64; }
typedef f32x4 AccT[2][2][4][2];
#define EPI_LOOP_BEGIN \
    const int row0 = u.pm * 256 + wr * 64 + fr, col0 = u.pn * 256 + wc * 32 + 4 * fq; \
    _Pragma("unroll") for (int ai = 0; ai < 2; ++ai) _Pragma("unroll") for (int m = 0; m < 4; ++m) { const int row = row0 + ai * 128 + m * 16; \
    _Pragma("unroll") for (int bj = 0; bj < 2; ++bj) _Pragma("unroll") for (int n = 0; n < 2; ++n) { const int col = col0 + bj * 128 + n * 16; const f32x4 v = acc[ai][bj][m][n];
#define EPI_LOOP_END } }
#define EPI_LOOP_BEGIN_S \
    const int row0 = u.pm * 256 + wr * 64 + fr, col0 = u.pn * 256 + wc * 32 + 4 * fq; \
    _Pragma("unroll") for (int ai = 0; ai < 2; ++ai) _Pragma("unroll") for (int m = 0; m < 4; ++m) { const int row = row0 + ai * 128 + m * 16; \
    _Pragma("unroll") for (int bj = 0; bj < 2; ++bj) _Pragma("unroll") for (int n = 0; n < 2; ++n) { const int col = col0 + bj * 128 + n * 16; const f32x4 v = acc[ai][bj][m][n] * rs[ai][m];

struct EpiIn {
    bf16_t *Qb, *Kb, *Vb; bf16_t* RW; float* out;
    DI void operator()(const AccT& acc, const pg8::Unit& u, int wr, int wc, int fr, int fq) const {
        const int reg = u.pn < 4 ? 0 : (u.pn < 8 ? 1 : (u.pn < 12 ? 2 : 3));
        EPI_LOOP_BEGIN
            if (row < MT) {
                if (reg == 0) {
                    constexpr float QS_ = 0.125f * 1.44269504088896f;
                    u32x2 w; w.x = cvt_pk(v[0] * QS_, v[1] * QS_); w.y = cvt_pk(v[2] * QS_, v[3] * QS_);
                    *(u32x2*)(row < MP ? Qb + hm64(row, col >> 6) + (col & 63) : Qb + (size_t)row * 1024 + col) = w;
                } else if (reg == 1 || reg == 2) {
                    const int c = col - (reg == 1 ? 1024 : 2048);
                    float* o = row < MP ? out + (reg == 1 ? O_PK : O_PV) + (size_t)row * 1024 + c : out + (reg == 1 ? O_SK : O_SV) + (size_t)(row - MP) * 1024 + c;
                    *(f32x4*)o = v;
                    if (row < MP) { u32x2 w; w.x = cvt_pk(v[0], v[1]); w.y = cvt_pk(v[2], v[3]);
                        *(u32x2*)((reg == 1 ? Kb : Vb) + hm64(row, c >> 6) + (c & 63)) = w; }
                } else {
                    const int c = col - 3072;
                    if (c < CSH) {
                        { u32x2 w; w.x = cvt_pk(v[0], v[1]); w.y = cvt_pk(v[2], v[3]); *(u32x2*)(RW + (size_t)row * CSH + c) = w; }
                        if (row >= MP) *(f32x4*)(out + O_SRW + (size_t)(row - MP) * CSH + c) = v;
                        else if ((row & (SEQ - 1)) == SEQ - 1) *(f32x4*)(out + O_PRW + (size_t)(row >> 11) * CSH + c) = v;
                    }
                }
            }
        EPI_LOOP_END
    }
};
struct EpiBf {
    bf16_t* C; int ldc;
    DI void operator()(const AccT& acc, const pg8::Unit& u, int wr, int wc, int fr, int fq) const {
        const int row0 = u.pm * 256 + wr * 64 + fr, col0 = u.pn * 256 + wc * 32 + 4 * fq;
#pragma unroll
        for (int ai = 0; ai < 2; ++ai)
#pragma unroll
            for (int m = 0; m < 4; ++m) { const int row = row0 + ai * 128 + m * 16;
#pragma unroll
                for (int bj = 0; bj < 2; ++bj)
#pragma unroll
                    for (int n = 0; n < 2; ++n) { const int col = col0 + bj * 128 + n * 16; const f32x4 v = acc[ai][bj][m][n];
                        u32x2 w; w.x = cvt_pk(v[0], v[1]); w.y = cvt_pk(v[2], v[3]);
                        *(u32x2*)(C + (size_t)row * ldc + col) = w; }
                asm volatile("" ::: "memory");
            }
    }
};
struct EpiWo {
    const float *xp; const float* gf; float* X1; bf16_t* H; float* RSS;
    DI void operator()(const AccT& acc, const pg8::Unit& u, int wr, int wc, int fr, int fq) const {
        const int row0 = u.pm * 256 + wr * 64 + fr, col0 = u.pn * 256 + wc * 32 + 4 * fq;
#pragma unroll
        for (int ai = 0; ai < 2; ++ai)
#pragma unroll
            for (int m = 0; m < 4; ++m) {
                const int row = row0 + ai * 128 + m * 16; float ss = 0.f;
#pragma unroll
                for (int bj = 0; bj < 2; ++bj)
#pragma unroll
                    for (int n = 0; n < 2; ++n) {
                        const int col = col0 + bj * 128 + n * 16;
                        const f32x4 x1 = *(const f32x4*)(xp + (size_t)row * D + col) + acc[ai][bj][m][n];
                        *(f32x4*)(X1 + (size_t)row * D + col) = x1;
                        const f32x4 gg = *(const f32x4*)(gf + col);
                        u32x2 w; w.x = cvt_pk(x1[0] * gg[0], x1[1] * gg[1]); w.y = cvt_pk(x1[2] * gg[2], x1[3] * gg[3]);
                        *(u32x2*)(H + (size_t)row * D + col) = w;
                        ss += (x1[0] * x1[0] + x1[1] * x1[1]) + (x1[2] * x1[2] + x1[3] * x1[3]);
                    }
                ss += __shfl_xor(ss, 16); ss += __shfl_xor(ss, 32);
                if (fq == 0) atomic_add_f32(RSS + row, ss);
            }
    }
};
#define DPP_MOV(v, ctrl) __int_as_float(__builtin_amdgcn_update_dpp(0, __float_as_int(v), (ctrl), 0xf, 0xf, false))
#define DPP_SHR(oldv, v, ctrl) __int_as_float(__builtin_amdgcn_update_dpp(__float_as_int(oldv), __float_as_int(v), (ctrl), 0xf, 0xf, false))
struct EpiUpF {
    bf16_t* ACT; float* out; const float* RSS; const float* cw; const float* cb; float* EDGE; LAS float* xch;
    DI void operator()(const AccT& acc, const pg8::Unit& u, int wr, int wc, int fr, int fq) const {
        const int wave = wr * 4 + wc, row0 = u.pm * 256 + wr * 64 + fr, f0 = u.pn * 128 + wc * 32 + 4 * fq;
#define UPF_RS(ai_, m_) rsqrtf(RSS[row0 + (ai_) * 128 + (m_) * 16] * (1.f / D) + 1e-6f)
        if (fr >= 14) {
#pragma unroll
            for (int ai = 0; ai < 2; ++ai)
#pragma unroll
                for (int bj = 0; bj < 2; ++bj)
#pragma unroll
                    for (int n = 0; n < 2; ++n)
                        *(LAS f32x4*)(xch + wave * 256 + ((((ai * 2 + (fr - 14)) * 2 + bj) * 2 + n) * 4 + fq) * 4) = acc[ai][bj][3][n] * UPF_RS(ai, 3);
        }
        asm volatile("s_waitcnt lgkmcnt(0)" ::: "memory"); __builtin_amdgcn_s_barrier(); asm volatile("" ::: "memory");
        __builtin_amdgcn_s_barrier(); asm volatile("" ::: "memory");
        const bool prompt = u.pm < MP / 256;
#pragma unroll
        for (int n = 0; n < 2; ++n) {
            const int f = f0 + 16 * n;
            asm volatile("" ::: "memory");
            const f32x4 w0g = *(const f32x4*)(cw + f), w1g = *(const f32x4*)(cw + FF2 + f), w2g = *(const f32x4*)(cw + 2 * FF2 + f), bg = *(const f32x4*)(cb + f);
#pragma unroll
            for (int ai = 0; ai < 2; ++ai) {
                const bool have = (wr == 1) || (ai == 1);
                const int nbw = wr == 1 ? wave - 4 : wave + 4, nai = wr == 1 ? ai : 0;
                f32x4 pg = {0.f, 0.f, 0.f, 0.f}, pv = {0.f, 0.f, 0.f, 0.f};
                if (have && fr >= 14) {
                    pg = *(const LAS f32x4*)(xch + nbw * 256 + ((((nai * 2 + (fr - 14)) * 2 + 0) * 2 + n) * 4 + fq) * 4);
                    pv = *(const LAS f32x4*)(xch + nbw * 256 + ((((nai * 2 + (fr - 14)) * 2 + 1) * 2 + n) * 4 + fq) * 4);
                }
#pragma unroll
                for (int m = 0; m < 4; ++m) {
                    const int row = row0 + ai * 128 + m * 16;
                    const float rsm = UPF_RS(ai, m);
                    const f32x4 g = acc[ai][0][m][n] * rsm, v = acc[ai][1][m][n] * rsm;
                    float o[4];
#pragma unroll
                    for (int e = 0; e < 4; ++e) {
                        const float g1 = DPP_SHR(DPP_MOV(pg[e], 0x121), g[e], 0x111), g2 = DPP_SHR(DPP_MOV(pg[e], 0x122), g[e], 0x112);
                        const float cg = bg[e] + w0g[e] * g2 + w1g[e] * g1 + w2g[e] * g[e];
                        o[e] = cg * __builtin_amdgcn_rcpf(1.f + __expf(-cg));
                    }
                    {
                        const f32x4 w0v = *(const f32x4*)(cw + FF + f), w1v = *(const f32x4*)(cw + FF2 + FF + f), w2v = *(const f32x4*)(cw + 2 * FF2 + FF + f), bv = *(const f32x4*)(cb + FF + f);
#pragma unroll
                        for (int e = 0; e < 4; ++e) {
                            const float v1 = DPP_SHR(DPP_MOV(pv[e], 0x121), v[e], 0x111), v2 = DPP_SHR(DPP_MOV(pv[e], 0x122), v[e], 0x112);
                            o[e] *= bv[e] + w0v[e] * v2 + w1v[e] * v1 + w2v[e] * v[e];
                        }
                        asm volatile("" ::: "memory");
                    }
                    const int tr = wr * 64 + ai * 128 + m * 16 + fr;
                    if (prompt) {
                        u32x2 w; w.x = cvt_pk(o[0], o[1]); w.y = cvt_pk(o[2], o[3]);
                        *(u32x2*)((char*)ACT + ((unsigned)row * (unsigned)FF + (unsigned)f) * 2u) = w;
                    }
                    if (prompt ? (tr < 2 || tr >= 254) : tr < MS) {
                        const int er = prompt ? u.pm * 4 + (tr < 2 ? tr : tr - 252) : 128 + tr;
                        float* ed = (float*)((char*)EDGE + ((unsigned)er * (unsigned)FF2 + (unsigned)f) * 4u);
                        *(f32x4*)ed = g; *(f32x4*)(ed + FF) = v;
                    }
                    pg = g; pv = v;
                }
            }
        }
    }
#undef UPF_RS
};
#ifndef MK_P11_SCALE
#define MK_P11_SCALE 1.0f
#endif
struct EpiDn {
    float* X1;
    DI void operator()(const AccT& acc, const pg8::Unit& u, int wr, int wc, int fr, int fq) const {
        EPI_LOOP_BEGIN
            if (row < MT) { float* p = X1 + (size_t)row * D + col; *(f32x4*)p = *(const f32x4*)p + v * MK_P11_SCALE; }
        EPI_LOOP_END
    }
};

template <bool UPPERM = false>
DI void transpose_item(const float* W, int K, int N, bf16_t* WT, int ldt, float* scr, int item, int lane) {
    const int nblk = N / 32, kb = item / nblk, nb = item % nblk, k0 = 64 * kb, n0 = 32 * nb;
    const int d0 = UPPERM ? (((n0 < FF ? n0 : n0 - FF) >> 7) * 256 + (n0 < FF ? 0 : 128) + ((n0 < FF ? n0 : n0 - FF) & 127)) : n0;
    {
        f32x4 v[8];
#pragma unroll
        for (int i = 0; i < 8; ++i) v[i] = *(const f32x4*)(W + (size_t)(k0 + 8 * i + (lane >> 3)) * N + n0 + 4 * (lane & 7));
#pragma unroll
        for (int i = 0; i < 8; ++i) { float* d = scr + (8 * i + (lane >> 3)) * 33 + 4 * (lane & 7); d[0] = v[i].x; d[1] = v[i].y; d[2] = v[i].z; d[3] = v[i].w; }
    }
    __builtin_amdgcn_fence(__ATOMIC_RELEASE, "wavefront"); asm volatile("s_waitcnt lgkmcnt(0)" ::: "memory");
    const int c = lane & 7;
#pragma unroll
    for (int j = 0; j < 4; ++j) { const int n = (lane >> 3) + 8 * j; const float* s = scr + (8 * c) * 33 + n;
        u32x4 o; o.x = pk2(s[0 * 33], s[1 * 33]); o.y = pk2(s[2 * 33], s[3 * 33]); o.z = pk2(s[4 * 33], s[5 * 33]); o.w = pk2(s[6 * 33], s[7 * 33]);
        *(u32x4*)(WT + (size_t)(d0 + n) * ldt + k0 + 8 * c) = o; }
    asm volatile("s_waitcnt lgkmcnt(0)" ::: "memory");
}
DI void rms_row_bf16(const float* xrow, const float* g, bf16_t* orow, int lane) {
    const f32x4* xr = (const f32x4*)xrow + lane; const f32x4* gr = (const f32x4*)g + lane;
    f32x4 v[8]; float s = 0.f;
#pragma unroll
    for (int j = 0; j < 8; ++j) { v[j] = xr[64 * j]; s += (v[j].x * v[j].x + v[j].y * v[j].y) + (v[j].z * v[j].z + v[j].w * v[j].w); }
    const float rstd = rsqrtf(wave_sum(s) * (1.f / D) + 1e-6f);
    u32x2* o8 = (u32x2*)orow + lane;
#pragma unroll
    for (int j = 0; j < 8; ++j) { const f32x4 gg = gr[64 * j]; u32x2 w; w.x = pk2(v[j].x * rstd * gg.x, v[j].y * rstd * gg.y); w.y = pk2(v[j].z * rstd * gg.z, v[j].w * rstd * gg.w); o8[64 * j] = w; }
}
DI void rms_row_f32(const float* xrow, const float* g, float* orow, int lane) {
    const f32x4* xr = (const f32x4*)xrow + lane; const f32x4* gr = (const f32x4*)g + lane;
    f32x4 v[8]; float s = 0.f;
#pragma unroll
    for (int j = 0; j < 8; ++j) { v[j] = xr[64 * j]; s += (v[j].x * v[j].x + v[j].y * v[j].y) + (v[j].z * v[j].z + v[j].w * v[j].w); }
    const float rstd = rsqrtf(wave_sum(s) * (1.f / D) + 1e-6f);
    f32x4* o = (f32x4*)orow + lane;
#pragma unroll
    for (int j = 0; j < 8; ++j) { const f32x4 gg = gr[64 * j]; o[64 * j] = v[j] * rstd * gg; }
}
DI void zero_row_bf16(bf16_t* orow, int ncols, int lane) {
    for (int c = lane * 8; c < ncols; c += 512) *(u32x4*)(orow + c) = (u32x4){0u, 0u, 0u, 0u};
}

DI void phase_prologue(const Args& a, unsigned char* lds, int gw, int ngw, int lane, int wave) {
    unsigned char* ws = a.ws;
    float* scr = (float*)(lds + wave * 16384);
    bf16_t* Win = (bf16_t*)(ws + WS_WIN); bf16_t* Wlo = (bf16_t*)(ws + WS_WLO);
    constexpr int IT_IN = (D / 64) * (CIN / 32);
    for (int it = gw; it < IT_IN; it += ngw) transpose_item(a.in[I_WIN], D, CIN, Win, D, scr, it, lane);
    for (int r = CIN + gw; r < NIN; r += ngw) zero_row_bf16(Win + (size_t)r * D, D, lane);
    {
        const int gt = gw * 64 + lane, ngt = ngw * 64;
        for (int i = gt; i < NLO * KLO; i += ngt) {
            const int n = i / KLO, k = i % KLO; float v = 0.f;
            if (n < 1024) { if (k < 64) v = a.in[I_WUP][k * 1024 + n]; }
            else if (n < 2048) { if (k >= 64 && k < 128) v = a.in[I_AUP][(k - 64) * 1024 + (n - 1024)]; }
            else { if (k >= 128 && k < 288) v = a.in[I_GUP][(k - 128) * 1024 + (n - 2048)]; }
            Wlo[i] = (bf16_t)bf_rne(v);
        }
    }
    { float* RSS = (float*)(ws + WS_RSS); for (int i = gw * 64 + lane; i < MPAD; i += ngw * 64) RSS[i] = 0.f; }
    bf16_t* H = (bf16_t*)(ws + WS_H);
    for (int m = gw; m < MPAD; m += ngw) {
        if (m < MT) rms_row_bf16(m < MP ? a.in[I_XP] + (size_t)m * D : a.in[I_XS] + (size_t)(m - MP) * D, a.in[I_NMG], H + (size_t)m * D, lane);
        else zero_row_bf16(H + (size_t)m * D, D, lane);
    }
}


DI void convert_wo_wup(const Args& a, unsigned char* lds, int wi, int nw, int wave, int lane) {
    float* scr = (float*)(lds + wave * 16384);
    constexpr int IT_O = (D / 64) * (D / 32), IT_UP = (D / 64) * (FF2 / 32);
    for (int it = wi; it < IT_O + IT_UP; it += nw) {
        if (it < IT_O) transpose_item(a.in[I_WO], D, D, (bf16_t*)(a.ws + WS_WO), D, scr, it, lane);
        else transpose_item<true>(a.in[I_FUP], D, FF2, (bf16_t*)(a.ws + WS_WUP), D, scr, it - IT_O, lane);
    }
}
DI void convert_wdn(const Args& a, unsigned char* lds, int wi, int nw, int wave, int lane) {
    float* scr = (float*)(lds + wave * 16384);
    constexpr int IT_DN = (FF / 64) * (D / 32);
    for (int it = wi; it < IT_DN; it += nw) transpose_item(a.in[I_FDN], FF, D, (bf16_t*)(a.ws + WS_WDN), FF, scr, it, lane);
}

DI float rw_prev_val(const Args& a, const bf16_t* RW, int m, int j) {
    if (m < MP) return (m & (SEQ - 1)) == 0 ? 0.f : bf2f(RW[(size_t)(m - 1) * CSH + j]);
    return a.in[I_SSH][(size_t)(m - MP) * CSH + j];
}
DI void lora_input_row(const Args& a, int m, int lane) {
    bf16_t* ALO = (bf16_t*)(a.ws + WS_ALO) + (size_t)m * KLO;
    if (m >= MT) { for (int c = lane; c < KLO; c += 64) ALO[c] = 0; return; }
    const bf16_t* RW = (const bf16_t*)(a.ws + WS_RW);
    const bf16_t* cur = RW + (size_t)m * CSH;
    for (int c = lane; c < KLO; c += 64) {
        float v = 0.f;
        if (c < 288) {
            const int j = 3072 + c; const float x = bf2f(cur[j]), p = rw_prev_val(a, RW, m, j); const float xs = x + a.in[I_MU][j] * (p - x);
            v = c < 64 ? 1.f - 2.f * __builtin_amdgcn_rcpf(1.f + __expf(2.f * xs)) : (c < 128 ? xs : __builtin_amdgcn_rcpf(1.f + __expf(-xs)));
        }
        ALO[c] = (bf16_t)bf_rne(v);
    }
}

DI int crow(int reg, int h) { return (reg & 3) + 8 * (reg >> 2) + 4 * h; }
typedef short s16x4 __attribute__((ext_vector_type(4)));
constexpr int VPITCH = 192;
DI void attn_prompt_unit(const Args& a, unsigned char* lds, int unit, int wave, int lane) {
    const bf16_t* Qb = (const bf16_t*)(a.ws + WS_QB); const bf16_t* Kb = (const bf16_t*)(a.ws + WS_KB); const bf16_t* Vb = (const bf16_t*)(a.ws + WS_VB);
    bf16_t* PO = (bf16_t*)(a.ws + WS_PART); float* PML = (float*)(a.ws + WS_PML);
    LAS unsigned char* img = (LAS unsigned char*)lds + wave * (32 * VPITCH);
    const int blk = unit & 63, br = (unit >> 6) % 3, bh = unit / 192, b = bh >> 4, h = bh & 15;
    const int rate = br == 0 ? 1 : (br == 1 ? 4 : 16), L = SEQ / rate, bpc = L / 32;
    const int rho = blk / bpc, l0 = (blk % bpc) * 32;
    const int r = lane & 31, hh = lane >> 5;
    const int mq = b * SEQ + rho + rate * (l0 + r);
    bf16x8 qf[4];
#pragma unroll
    for (int ks = 0; ks < 4; ++ks) qf[ks] = *(const bf16x8*)(Qb + ((size_t)bh * SEQ + rho + rate * (l0 + r)) * 64 + ks * 16 + 8 * hh);
    f32x16 o0, o1;
#pragma unroll
    for (int i = 0; i < 16; ++i) { o0[i] = 0.f; o1[i] = 0.f; }
    float mrun = -1e30f, lrun = 0.f;
    const int lq = l0 + r;
    const int c0 = l0 >= 128 ? 0 : (128 - l0) >> 5;
    const bf16_t* kbase = Kb + ((size_t)bh * SEQ + rho) * 64 + 8 * hh;
    const bf16_t* vbase = Vb + ((size_t)bh * SEQ + rho) * 64 + 8 * (lane & 7);
    bf16x8 kreg[4]; u32x4 vreg[4];
#define AT_PREFETCH(ch_) do { const int lk0_ = l0 - 128 + 32 * (ch_); \
        _Pragma("unroll") for (int ks = 0; ks < 4; ++ks) kreg[ks] = *(const bf16x8*)(kbase + (size_t)(rate * (lk0_ + r)) * 64 + ks * 16); \
        _Pragma("unroll") for (int i = 0; i < 4; ++i) vreg[i] = *(const u32x4*)(vbase + (size_t)(rate * (lk0_ + 8 * i + (lane >> 3))) * 64); } while (0)
    AT_PREFETCH(c0);
    const int i16 = lane & 15, tq = i16 >> 2, tp = i16 & 3, g16 = (lane >> 4) & 1;
    const unsigned troff = (unsigned)((4 * hh + tq) * VPITCH + g16 * 32 + 8 * tp);
    for (int ch = c0; ch < 5; ++ch) {
        const int lk0 = l0 - 128 + 32 * ch;
        bf16x8 kf[4];
#pragma unroll
        for (int ks = 0; ks < 4; ++ks) kf[ks] = kreg[ks];
#pragma unroll
        for (int i = 0; i < 4; ++i) *(LAS u32x4*)(img + (8 * i + (lane >> 3)) * VPITCH + 16 * (lane & 7)) = vreg[i];
        if (ch + 1 < 5) AT_PREFETCH(ch + 1);
        f32x16 st;
#pragma unroll
        for (int i = 0; i < 16; ++i) st[i] = 0.f;
#pragma unroll
        for (int ks = 0; ks < 4; ++ks) st = __builtin_amdgcn_mfma_f32_32x32x16_bf16(kf[ks], qf[ks], st, 0, 0, 0);
        float cmax = -1e30f;
        if (ch == 0 || ch == 4) {
#pragma unroll
            for (int i = 0; i < 16; ++i) { const int lk = lk0 + crow(i, hh); const bool ok = (lk <= lq) && (lk >= lq - 128); st[i] = ok ? st[i] : -1e30f; }
        }
#pragma unroll
        for (int i = 0; i < 16; ++i) cmax = fmaxf(cmax, st[i]);
        cmax = fmaxf(cmax, __shfl_xor(cmax, 32));
        const float mnew = fmaxf(mrun, cmax), alpha = __builtin_amdgcn_exp2f(mrun - mnew);
        float ps = 0.f;
#pragma unroll
        for (int i = 0; i < 16; ++i) { const float p = __builtin_amdgcn_exp2f(st[i] - mnew); st[i] = p; ps += p; }
        lrun = lrun * alpha + ps; mrun = mnew;
#pragma unroll
        for (int i = 0; i < 16; ++i) { o0[i] *= alpha; o1[i] *= alpha; }
#pragma unroll
        for (int s = 0; s < 2; ++s) {
            u32x4 pp; pp.x = pk2(st[8 * s], st[8 * s + 1]); pp.y = pk2(st[8 * s + 2], st[8 * s + 3]); pp.z = pk2(st[8 * s + 4], st[8 * s + 5]); pp.w = pk2(st[8 * s + 6], st[8 * s + 7]);
            const bf16x8 pf = __builtin_bit_cast(bf16x8, pp);
#pragma unroll
            for (int dt = 0; dt < 2; ++dt) {
                const s16x4 lo = __builtin_amdgcn_ds_read_tr16_b64_v4i16((LAS s16x4*)(img + troff + (16 * s) * VPITCH + dt * 64));
                const s16x4 hi = __builtin_amdgcn_ds_read_tr16_b64_v4i16((LAS s16x4*)(img + troff + (16 * s + 8) * VPITCH + dt * 64));
                const bf16x8 vf = __builtin_shufflevector(lo, hi, 0, 1, 2, 3, 4, 5, 6, 7);
                if (dt == 0) o0 = __builtin_amdgcn_mfma_f32_32x32x16_bf16(vf, pf, o0, 0, 0, 0);
                else o1 = __builtin_amdgcn_mfma_f32_32x32x16_bf16(vf, pf, o1, 0, 0, 0);
            }
        }
    }
#undef AT_PREFETCH
    const float ltot = lrun + __shfl_xor(lrun, 32);
    bf16_t* po = PO + ((size_t)br * MP + mq) * 1024 + h * 64;
#pragma unroll
    for (int g = 0; g < 4; ++g) {
        u32x2 w0, w1; w0.x = pk2(o0[4 * g], o0[4 * g + 1]); w0.y = pk2(o0[4 * g + 2], o0[4 * g + 3]); w1.x = pk2(o1[4 * g], o1[4 * g + 1]); w1.y = pk2(o1[4 * g + 2], o1[4 * g + 3]);
        *(u32x2*)(po + 8 * g + 4 * hh) = w0; *(u32x2*)(po + 32 + 8 * g + 4 * hh) = w1;
    }
    if (hh == 0) { float* pm = PML + (((size_t)br * MP + mq) * 16 + h) * 2; pm[0] = mrun; pm[1] = ltot; }
}
DI float sum16(float v) { v = DPP_ADD(v, 0xB1); v = DPP_ADD(v, 0x4E); v = DPP_ADD(v, 0x141); v = DPP_ADD(v, 0x140); return v; }
DI void attn_merge_task(const Args& a, int task, int lane) {
    const int m = task >> 2, h = (task & 3) * 4 + (lane >> 4), d = 4 * (lane & 15);
    const bf16_t* PO = (const bf16_t*)(a.ws + WS_PART); const float* PML = (const float*)(a.ws + WS_PML);
    bf16_t* O = (bf16_t*)(a.ws + WS_O);
    float mb[3], lb[3]; f32x4 ob[3];
#pragma unroll
    for (int br = 0; br < 3; ++br) { const float* pm = PML + (((size_t)br * MP + m) * 16 + h) * 2; mb[br] = pm[0]; lb[br] = pm[1];
        const u32x2 w = *(const u32x2*)(PO + ((size_t)br * MP + m) * 1024 + h * 64 + d);
        ob[br] = (f32x4){__uint_as_float(w.x << 16), __uint_as_float(w.x & 0xffff0000u), __uint_as_float(w.y << 16), __uint_as_float(w.y & 0xffff0000u)}; }
    const float M = fmaxf(mb[0], fmaxf(mb[1], mb[2]));
    f32x4 num = {0.f, 0.f, 0.f, 0.f}; float den = 0.f;
#pragma unroll
    for (int br = 0; br < 3; ++br) { const float w = __builtin_amdgcn_exp2f(mb[br] - M); num += ob[br] * w; den += w * lb[br]; }
    const f32x4 o = num * __builtin_amdgcn_rcpf(den);
    const float ss = sum16(o.x * o.x + o.y * o.y + o.z * o.z + o.w * o.w) * (1.f / 64.f);
    const float rs = rsqrtf(ss + 1e-6f);
    const f32x4 gg = *(const f32x4*)(a.in[I_AOG] + h * 64 + d);
    u32x2 w; w.x = pk2(o.x * rs * gg.x, o.y * rs * gg.y); w.y = pk2(o.z * rs * gg.z, o.w * rs * gg.w);
    *(u32x2*)(O + (size_t)m * D + h * 64 + d) = w;
}
DI void attn_sample_wg(const Args& a, unsigned char* lds, int unit, int wave, int lane) {
    float* part = (float*)lds;
    const int bh = unit * 2 + (wave >> 2), qt = wave & 3, b = bh >> 4, h = bh & 15, g = lane >> 4, l16 = lane & 15;
    const bf16_t* Qb = (const bf16_t*)(a.ws + WS_QB);
    const float* ck = a.in[I_CK] + (size_t)b * 2048 * 1024 + h * 64 + 4 * l16; const float* cv = a.in[I_CV] + (size_t)b * 2048 * 1024 + h * 64 + 4 * l16;
    const float* nk = a.out + O_SK + (size_t)b * 1024 + h * 64 + 4 * l16; const float* nv = a.out + O_SV + (size_t)b * 1024 + h * 64 + 4 * l16;
    const u32x2 qw = *(const u32x2*)(Qb + (size_t)(MP + b) * 1024 + h * 64 + 4 * l16);
    const float q0 = __uint_as_float(qw.x << 16), q1 = __uint_as_float(qw.x & 0xffff0000u), q2 = __uint_as_float(qw.y << 16), q3 = __uint_as_float(qw.y & 0xffff0000u);
    float mrun = -1e30f, lrun = 0.f; f32x4 acc = {0.f, 0.f, 0.f, 0.f};
    const int e0 = qt * 97, e1 = e0 + 97 < 387 ? e0 + 97 : 387;
    for (int ito = 0; ito < 25; ito += 5) {
        f32x4 kv[5], vv[5]; bool valid[5];
#pragma unroll
        for (int k = 0; k < 5; ++k) {
            const int e = e0 + (ito + k) * 4 + g; valid[k] = e < e1;
            const int ee = valid[k] ? e : e0, br = ee / 129, j = ee % 129, rate = br == 0 ? 1 : (br == 1 ? 4 : 16);
            const int row = 2048 - rate * j;
            const float* kp = j == 0 ? nk : ck + (size_t)row * 1024; const float* vp = j == 0 ? nv : cv + (size_t)row * 1024;
            kv[k] = *(const f32x4*)kp; vv[k] = *(const f32x4*)vp;
        }
#pragma unroll
        for (int k = 0; k < 5; ++k) {
            float s = sum16(q0 * kv[k].x + q1 * kv[k].y + q2 * kv[k].z + q3 * kv[k].w);
            if (!valid[k]) s = -1e30f;
            const float mnew = fmaxf(mrun, s), alpha = __builtin_amdgcn_exp2f(mrun - mnew), p = valid[k] ? __builtin_amdgcn_exp2f(s - mnew) : 0.f;
            lrun = lrun * alpha + p; acc = acc * alpha + vv[k] * p; mrun = mnew;
        }
    }
#pragma unroll
    for (int o = 16; o < 64; o <<= 1) {
        const float mo = __shfl_xor(mrun, o), lo = __shfl_xor(lrun, o);
        f32x4 ao; ao.x = __shfl_xor(acc.x, o); ao.y = __shfl_xor(acc.y, o); ao.z = __shfl_xor(acc.z, o); ao.w = __shfl_xor(acc.w, o);
        const float mn = fmaxf(mrun, mo), w0 = __builtin_amdgcn_exp2f(mrun - mn), w1 = __builtin_amdgcn_exp2f(mo - mn);
        lrun = lrun * w0 + lo * w1; acc = acc * w0 + ao * w1; mrun = mn;
    }
    if (g == 0) { *(f32x4*)(part + wave * 68 + 4 * l16) = acc; if (l16 == 0) { part[wave * 68 + 64] = mrun; part[wave * 68 + 65] = lrun; } }
    __syncthreads();
    if (qt == 0 && g == 0) {
        float M = -1e30f;
#pragma unroll
        for (int w = 0; w < 4; ++w) M = fmaxf(M, part[(wave + w) * 68 + 64]);
        f32x4 num = {0.f, 0.f, 0.f, 0.f}; float den = 0.f;
#pragma unroll
        for (int w = 0; w < 4; ++w) { const float wt = __builtin_amdgcn_exp2f(part[(wave + w) * 68 + 64] - M); num += *(const f32x4*)(part + (wave + w) * 68 + 4 * l16) * wt; den += part[(wave + w) * 68 + 65] * wt; }
        const f32x4 o = num * (1.f / den);
        const float ss = sum16(o.x * o.x + o.y * o.y + o.z * o.z + o.w * o.w);
        const float rs = rsqrtf(ss * (1.f / 64.f) + 1e-6f);
        const f32x4 gg = *(const f32x4*)(a.in[I_AOG] + h * 64 + 4 * l16);
        u32x2 w; w.x = pk2(o.x * rs * gg.x, o.y * rs * gg.y); w.y = pk2(o.z * rs * gg.z, o.w * rs * gg.w);
        *(u32x2*)((bf16_t*)(a.ws + WS_O) + (size_t)(MP + b) * D + h * 64 + 4 * l16) = w;
    }
    __syncthreads();
}

struct PrepParams { float mu_r, mu_k, mu_v, w0, a0, kk, ka, rk; };
struct PrepRaw { float cr, ck, cv, pr, pk, pv, lw, la, lg; };
DI void prep_params(const Args& a, PrepParams& P, int c) {
    P.mu_r = a.in[I_MU][c]; P.mu_k = a.in[I_MU][1024 + c]; P.mu_v = a.in[I_MU][2048 + c];
    P.w0 = a.in[I_W0][c]; P.a0 = a.in[I_A0][c]; P.kk = a.in[I_KK][c]; P.ka = a.in[I_KA][c]; P.rk = a.in[I_RK][c];
}
DI void prep_load(const Args& a, PrepRaw& R, const bf16_t* RW, int m, const bf16_t* Lrow, int c) {
    const bf16_t* cur = RW + (size_t)m * CSH;
    R.cr = bf2f(cur[c]); R.ck = bf2f(cur[1024 + c]); R.cv = bf2f(cur[2048 + c]);
    R.pr = rw_prev_val(a, RW, m, c); R.pk = rw_prev_val(a, RW, m, 1024 + c); R.pv = rw_prev_val(a, RW, m, 2048 + c);
    R.lw = bf2f(Lrow[c]); R.la = bf2f(Lrow[1024 + c]); R.lg = bf2f(Lrow[2048 + c]);
}
DI void prep_finish(const PrepRaw& R, const PrepParams& P, float* dst, float& g_out, float& bonus_out, int lane) {
    const float xr = R.cr + P.mu_r * (R.pr - R.cr), xk = R.ck + P.mu_k * (R.pk - R.ck), xv = R.cv + P.mu_v * (R.pv - R.cv);
    const float x = -(P.w0 + R.lw);
    const float sp = x > 20.f ? x : __logf(1.f + __expf(x));
    const float decay = __expf(-__expf(-sp - 0.5f));
    const float av = __builtin_amdgcn_rcpf(1.f + __expf(-(P.a0 + R.la)));
    float kkv = xk * P.kk;
    const float n2 = wave_sum(kkv * kkv);
    kkv = kkv * fminf(__builtin_amdgcn_rsqf(n2), 1e12f);
    const float keff = xk * (1.f + (av - 1.f) * P.ka);
    const float bon = wave_sum(xr * keff * P.rk) * xv;
    dst[lane] = xr; dst[64 + lane] = decay; dst[128 + lane] = keff; dst[192 + lane] = xv; dst[256 + lane] = -kkv; dst[320 + lane] = kkv * av;
    g_out = R.lg; bonus_out = bon;
}
DI float scan_step(float (&S)[64], const float* sv, float vi) {
    const f32x4* r4 = (const f32x4*)sv; const f32x4* w4 = (const f32x4*)(sv + 64); const f32x4* k4 = (const f32x4*)(sv + 128);
    const f32x4* a4 = (const f32x4*)(sv + 256); const f32x4* b4 = (const f32x4*)(sv + 320);
    float sa0 = 0.f, sa1 = 0.f;
#pragma unroll
    for (int j = 0; j < 16; ++j) { const f32x4 av = a4[j]; sa0 = fmaf(S[4 * j], av.x, sa0); sa1 = fmaf(S[4 * j + 1], av.y, sa1); sa0 = fmaf(S[4 * j + 2], av.z, sa0); sa1 = fmaf(S[4 * j + 3], av.w, sa1); }
    const float sa = sa0 + sa1;
    float y0 = 0.f, y1 = 0.f;
#pragma unroll
    for (int j = 0; j < 16; ++j) {
        const f32x4 bv = b4[j], kv = k4[j], wv = w4[j], rv = r4[j];
        float t;
        t = fmaf(vi, kv.x, sa * bv.x); S[4 * j] = fmaf(S[4 * j], wv.x, t); y0 = fmaf(S[4 * j], rv.x, y0);
        t = fmaf(vi, kv.y, sa * bv.y); S[4 * j + 1] = fmaf(S[4 * j + 1], wv.y, t); y1 = fmaf(S[4 * j + 1], rv.y, y1);
        t = fmaf(vi, kv.z, sa * bv.z); S[4 * j + 2] = fmaf(S[4 * j + 2], wv.z, t); y0 = fmaf(S[4 * j + 2], rv.z, y0);
        t = fmaf(vi, kv.w, sa * bv.w); S[4 * j + 3] = fmaf(S[4 * j + 3], wv.w, t); y1 = fmaf(S[4 * j + 3], rv.w, y1);
        if ((j & 3) == 3) asm volatile("" ::: "memory");
    }
    return y0 + y1;
}
DI void rwkv_post(const Args& a, float y, float g, float bonus, int m, int c) {
    const float mean = wave_sum(y) * (1.f / 64.f); const float d = y - mean; const float var = wave_sum(d * d) * (1.f / 64.f);
    const float yn = d * rsqrtf(var + 64e-5f) * a.in[I_LNW][c] + a.in[I_LNB][c];
    ((bf16_t*)(a.ws + WS_O))[(size_t)m * D + 1024 + c] = (bf16_t)bf_rne((yn + bonus) * g);
}

#define WG_BAR_LDS() do { asm volatile("s_waitcnt lgkmcnt(0)" ::: "memory"); __builtin_amdgcn_s_barrier(); asm volatile("" ::: "memory"); } while (0)
typedef float f32x2 __attribute__((ext_vector_type(2)));
DI f32x2 fma2(f32x2 a, f32x2 b, f32x2 c) { return __builtin_elementwise_fma(a, b, c); }
DI void scan_dot_a(const f32x2 (&Z)[32], const f32x2 (&P)[32], const float* sv, float& sz, float& sp) {
    const f32x4* a4 = (const f32x4*)(sv + 256);
    f32x2 saz = {0.f, 0.f}, sap = {0.f, 0.f};
#pragma unroll
    for (int j = 0; j < 16; ++j) { const f32x4 av = a4[j]; const f32x2 a0 = {av.x, av.y}, a1 = {av.z, av.w};
        saz = fma2(Z[2 * j], a0, saz); sap = fma2(P[2 * j], a0, sap); saz = fma2(Z[2 * j + 1], a1, saz); sap = fma2(P[2 * j + 1], a1, sap);
        if ((j & 7) == 7) asm volatile("" ::: "memory"); }
    sz = saz.x + saz.y; sp = sap.x + sap.y;
}
DI void scan_step3(f32x2 (&Z)[32], f32x2 (&P)[32], const float* sv, const float* svn, float vi, float& sz, float& sp, float& yz, float& yp) {
    const f32x4* r4 = (const f32x4*)sv; const f32x4* w4 = (const f32x4*)(sv + 64); const f32x4* k4 = (const f32x4*)(sv + 128);
    const f32x4* b4 = (const f32x4*)(sv + 320); const f32x4* an4 = (const f32x4*)(svn + 256);
    const f32x2 sz2 = {sz, sz}, sp2 = {sp, sp}, v2 = {vi, vi};
    f32x2 yz2 = {0.f, 0.f}, yp2 = {0.f, 0.f}, nz2 = {0.f, 0.f}, np2 = {0.f, 0.f};
    f32x4 buf[3][5];
#define S3_LD(g, j) do { buf[g][0] = b4[j]; buf[g][1] = k4[j]; buf[g][2] = w4[j]; buf[g][3] = r4[j]; buf[g][4] = an4[j]; asm volatile("" ::: "memory"); } while (0)
    S3_LD(0, 0); S3_LD(1, 1);
#pragma unroll
    for (int j = 0; j < 16; ++j) {
        if (j + 2 < 16) S3_LD((j + 2) % 3, j + 2);
        const f32x4 bv = buf[j % 3][0], kv = buf[j % 3][1], wv = buf[j % 3][2], rv = buf[j % 3][3], av = buf[j % 3][4];
        { const f32x2 b2 = {bv.x, bv.y}, k2 = {kv.x, kv.y}, w2 = {wv.x, wv.y}, r2 = {rv.x, rv.y}, a2 = {av.x, av.y};
          f32x2 tz = sz2 * b2; tz = fma2(v2, k2, tz); Z[2 * j] = fma2(Z[2 * j], w2, tz); yz2 = fma2(Z[2 * j], r2, yz2); nz2 = fma2(Z[2 * j], a2, nz2);
          const f32x2 tp = sp2 * b2; P[2 * j] = fma2(P[2 * j], w2, tp); yp2 = fma2(P[2 * j], r2, yp2); np2 = fma2(P[2 * j], a2, np2); }
        { const f32x2 b2 = {bv.z, bv.w}, k2 = {kv.z, kv.w}, w2 = {wv.z, wv.w}, r2 = {rv.z, rv.w}, a2 = {av.z, av.w};
          f32x2 tz = sz2 * b2; tz = fma2(v2, k2, tz); Z[2 * j + 1] = fma2(Z[2 * j + 1], w2, tz); yz2 = fma2(Z[2 * j + 1], r2, yz2); nz2 = fma2(Z[2 * j + 1], a2, nz2);
          const f32x2 tp = sp2 * b2; P[2 * j + 1] = fma2(P[2 * j + 1], w2, tp); yp2 = fma2(P[2 * j + 1], r2, yp2); np2 = fma2(P[2 * j + 1], a2, np2); }
        asm volatile("" ::: "memory");
    }
#undef S3_LD
    yz = yz2.x + yz2.y; yp = yp2.x + yp2.y; sz = nz2.x + nz2.y; sp = np2.x + np2.y;
}
DI void scan_pass1_unit(const Args& a, unsigned char* lds, int unit, int wave, int lane) {
    float* stg = (float*)lds;
    const int pp = wave & 3, pair = unit * 4 + pp, chain = pair / NS, seg = pair % NS, b = chain >> 4, h = chain & 15, c = h * 64 + lane;
    const int mbase = b * SEQ + seg * SEGL;
    constexpr int NB = SEGL / TB;
    if (wave < 4) {
        bf16_t* YL = (bf16_t*)(a.ws + WS_YL); bf16_t* QS = (bf16_t*)(a.ws + WS_QS); float* ZP = (float*)(a.ws + WS_ZP);
        f32x2 Z[32], P[32];
        int idl = lane; asm volatile("" : "+v"(idl));
#pragma unroll
        for (int j = 0; j < 32; ++j) { Z[j] = (f32x2){0.f, 0.f}; P[j] = (f32x2){idl == 2 * j ? 1.f : 0.f, idl == 2 * j + 1 ? 1.f : 0.f}; }
        WG_BAR_LDS();
        for (int blk = 0; blk < NB; ++blk) {
            const float* sb = stg + (((blk & 1) * 4 + pp) * TB) * 384;
            float sz, sp; scan_dot_a(Z, P, sb, sz, sp);
#pragma unroll 1
            for (int tt = 0; tt < TB; ++tt) {
                const float* sv = sb + tt * 384; const float* svn = sb + (tt + 1 < TB ? tt + 1 : tt) * 384;
                float yz, yp; scan_step3(Z, P, sv, svn, sv[192 + lane], sz, sp, yz, yp);
                const size_t o = (size_t)(mbase + blk * TB + tt) * 1024 + c;
                const unsigned yq = pk2(yz, yp); YL[o] = (bf16_t)(yq & 0xffffu); QS[o] = (bf16_t)(yq >> 16);
            }
            WG_BAR_LDS();
        }
        float* zp = ZP + (size_t)pair * 2 * 4096 + lane * 64;
#pragma unroll
        for (int j = 0; j < 16; ++j) { *(f32x4*)(zp + 4 * j) = (f32x4){Z[2 * j].x, Z[2 * j].y, Z[2 * j + 1].x, Z[2 * j + 1].y};
                                       *(f32x4*)(zp + 4096 + 4 * j) = (f32x4){P[2 * j].x, P[2 * j].y, P[2 * j + 1].x, P[2 * j + 1].y}; }
    } else {
        const bf16_t* RW = (const bf16_t*)(a.ws + WS_RW); const bf16_t* Lb = (const bf16_t*)(a.ws + WS_L);
        bf16_t* GB = (bf16_t*)(a.ws + WS_GB);
        PrepParams Pm; prep_params(a, Pm, c);
        PrepRaw raw[TB];
#define P1_LOAD(blk_) do { _Pragma("unroll") for (int k = 0; k < TB; ++k) { const int m = mbase + (blk_) * TB + k; prep_load(a, raw[k], RW, m, Lb + (size_t)m * NLO, c); } } while (0)
#define P1_FINISH(blk_) do { _Pragma("unroll") for (int k = 0; k < TB; ++k) { const int m = mbase + (blk_) * TB + k; float g, bon; \
            prep_finish(raw[k], Pm, stg + ((((blk_) & 1) * 4 + pp) * TB + k) * 384, g, bon, lane); \
            GB[((size_t)m * 16 + h) * 128 + lane] = (bf16_t)bf_rne(g); GB[((size_t)m * 16 + h) * 128 + 64 + lane] = (bf16_t)bf_rne(bon); } } while (0)
        P1_LOAD(0); P1_FINISH(0); P1_LOAD(1);
        WG_BAR_LDS();
        for (int blk = 0; blk < NB; ++blk) {
            if (blk + 1 < NB) P1_FINISH(blk + 1);
            if (blk + 2 < NB) P1_LOAD(blk + 2);
            WG_BAR_LDS();
        }
#undef P1_LOAD
#undef P1_FINISH
    }
}
DI void scan_sample_unit(const Args& a, unsigned char* lds, int unit, int wave, int lane) {
    float* sv = (float*)(lds + 2 * 4 * TB * 384 * 4) + wave * 384;
    const bf16_t* RW = (const bf16_t*)(a.ws + WS_RW); const bf16_t* Lb = (const bf16_t*)(a.ws + WS_L);
    const int b = unit >> 4, h = unit & 15, c = h * 64 + lane, m = MP + b;
    PrepParams P; prep_params(a, P, c);
    PrepRaw raw; prep_load(a, raw, RW, m, Lb + (size_t)m * NLO, c);
    float g, bon; prep_finish(raw, P, sv, g, bon, lane);
    float S[64];
    const float* s0 = a.in[I_SWKV] + ((size_t)(b * 16 + h) * 64 + lane) * 64;
#pragma unroll
    for (int j = 0; j < 16; ++j) { const f32x4 v = *(const f32x4*)(s0 + 4 * j); S[4 * j] = v.x; S[4 * j + 1] = v.y; S[4 * j + 2] = v.z; S[4 * j + 3] = v.w; }
    const float y = scan_step(S, sv, sv[192 + lane]);
    float* so = a.out + O_SWKV + ((size_t)(b * 16 + h) * 64 + lane) * 64;
#pragma unroll
    for (int j = 0; j < 16; ++j) *(f32x4*)(so + 4 * j) = (f32x4){S[4 * j], S[4 * j + 1], S[4 * j + 2], S[4 * j + 3]};
    rwkv_post(a, y, g, bon, m, c);
}
DI void scan_pass2_unit(const Args& a, unsigned char* lds, int chain, int wave, int lane) {
    float* Ssh = (float*)lds;
    float* Psh = Ssh + 64 * 65;
    const float* ZP = (const float*)(a.ws + WS_ZP); float* SST = (float*)(a.ws + WS_SST);
    const int tid = wave * 64 + lane, l16 = lane & 15, lq = lane >> 4, ib = wave >> 1, jb0 = 2 * (wave & 1);
    f32x4 S0 = {0.f, 0.f, 0.f, 0.f}, S1 = {0.f, 0.f, 0.f, 0.f};
    const float* Z0 = ZP + (size_t)(chain * NS) * 2 * 4096;
    f32x4 pn0 = *(const f32x4*)(Z0 + 4096 + tid * 8), pn1 = *(const f32x4*)(Z0 + 4096 + tid * 8 + 4);
    float zn0[4], zn1[4];
#pragma unroll
    for (int i = 0; i < 4; ++i) { zn0[i] = Z0[(16 * ib + 4 * lq + i) * 64 + 16 * jb0 + l16]; zn1[i] = Z0[(16 * ib + 4 * lq + i) * 64 + 16 * (jb0 + 1) + l16]; }
    for (int s = 0; s < NS; ++s) {
        float* sst = SST + ((size_t)chain * NS + s) * 4096;
#pragma unroll
        for (int i = 0; i < 4; ++i) { const int row = 16 * ib + 4 * lq + i;
            sst[row * 64 + 16 * jb0 + l16] = S0[i]; sst[row * 64 + 16 * (jb0 + 1) + l16] = S1[i];
            Ssh[row * 65 + 16 * jb0 + l16] = S0[i]; Ssh[row * 65 + 16 * (jb0 + 1) + l16] = S1[i]; }
        *(f32x4*)(Psh + tid * 8) = pn0; *(f32x4*)(Psh + tid * 8 + 4) = pn1;
        f32x4 n0 = {zn0[0], zn0[1], zn0[2], zn0[3]}, n1 = {zn1[0], zn1[1], zn1[2], zn1[3]};
        if (s + 1 < NS) {
            const float* Zs = ZP + (size_t)(chain * NS + s + 1) * 2 * 4096;
            pn0 = *(const f32x4*)(Zs + 4096 + tid * 8); pn1 = *(const f32x4*)(Zs + 4096 + tid * 8 + 4);
#pragma unroll
            for (int i = 0; i < 4; ++i) { zn0[i] = Zs[(16 * ib + 4 * lq + i) * 64 + 16 * jb0 + l16]; zn1[i] = Zs[(16 * ib + 4 * lq + i) * 64 + 16 * (jb0 + 1) + l16]; }
        }
        WG_BAR_LDS();
        if (s > 0) {
#pragma unroll
            for (int kk = 0; kk < 16; ++kk) {
                const float af = Ssh[(16 * ib + l16) * 65 + 4 * kk + lq];
                const float b0 = Psh[(4 * kk + lq) * 64 + 16 * jb0 + l16], b1 = Psh[(4 * kk + lq) * 64 + 16 * (jb0 + 1) + l16];
                n0 = __builtin_amdgcn_mfma_f32_16x16x4f32(af, b0, n0, 0, 0, 0);
                n1 = __builtin_amdgcn_mfma_f32_16x16x4f32(af, b1, n1, 0, 0, 0);
            }
        }
        WG_BAR_LDS();
        S0 = n0; S1 = n1;
    }
    float* so = a.out + O_PWKV + (size_t)chain * 4096;
#pragma unroll
    for (int i = 0; i < 4; ++i) { const int row = 16 * ib + 4 * lq + i; so[row * 64 + 16 * jb0 + l16] = S0[i]; so[row * 64 + 16 * (jb0 + 1) + l16] = S1[i]; }
}
DI bf16x8 cvt8(const f32x4 lo, const f32x4 hi) { u32x4 p; p.x = pk2(lo.x, lo.y); p.y = pk2(lo.z, lo.w); p.z = pk2(hi.x, hi.y); p.w = pk2(hi.z, hi.w); return __builtin_bit_cast(bf16x8, p); }
DI void scan_pass3_unit(const Args& a, int unit, int lane) {
    const float* SST = (const float*)(a.ws + WS_SST); const bf16_t* YL = (const bf16_t*)(a.ws + WS_YL); const bf16_t* QS = (const bf16_t*)(a.ws + WS_QS); const bf16_t* GB = (const bf16_t*)(a.ws + WS_GB);
    bf16_t* O = (bf16_t*)(a.ws + WS_O);
    const int sub = unit & 3, pair = unit >> 2, chain = pair / NS, seg = pair % NS, b = chain >> 4, h = chain & 15;
    const int r = lane & 31, hh = lane >> 5;
    const int m = b * SEQ + seg * SEGL + sub * 32 + r;
    f32x16 acc0, acc1;
#pragma unroll
    for (int i = 0; i < 16; ++i) { acc0[i] = 0.f; acc1[i] = 0.f; }
    const bf16_t* qrow = QS + (size_t)m * 1024 + h * 64 + 8 * hh;
    const float* s0 = SST + (size_t)pair * 4096 + (size_t)r * 64 + 8 * hh; const float* s1 = s0 + 32 * 64;
#pragma unroll
    for (int ks = 0; ks < 4; ++ks) {
        const bf16x8 qf = *(const bf16x8*)(qrow + ks * 16);
        const bf16x8 a0 = cvt8(*(const f32x4*)(s0 + ks * 16), *(const f32x4*)(s0 + ks * 16 + 4));
        const bf16x8 a1 = cvt8(*(const f32x4*)(s1 + ks * 16), *(const f32x4*)(s1 + ks * 16 + 4));
        acc0 = __builtin_amdgcn_mfma_f32_32x32x16_bf16(a0, qf, acc0, 0, 0, 0);
        acc1 = __builtin_amdgcn_mfma_f32_32x32x16_bf16(a1, qf, acc1, 0, 0, 0);
    }
    const bf16_t* yl = YL + (size_t)m * 1024 + h * 64 + 4 * hh;
    float y[32]; float sum = 0.f;
#pragma unroll
    for (int rt = 0; rt < 2; ++rt)
#pragma unroll
        for (int g = 0; g < 4; ++g) { const u32x2 yw = *(const u32x2*)(yl + rt * 32 + 8 * g); const f32x4 v = {__uint_as_float(yw.x << 16), __uint_as_float(yw.x & 0xffff0000u), __uint_as_float(yw.y << 16), __uint_as_float(yw.y & 0xffff0000u)};
#pragma unroll
            for (int e = 0; e < 4; ++e) { const float yy = v[e] + (rt == 0 ? acc0[4 * g + e] : acc1[4 * g + e]); y[rt * 16 + 4 * g + e] = yy; sum += yy; } }
    sum += __shfl_xor(sum, 32);
    const float mean = sum * (1.f / 64.f);
    float vs = 0.f;
#pragma unroll
    for (int e = 0; e < 32; ++e) { y[e] -= mean; vs += y[e] * y[e]; }
    vs += __shfl_xor(vs, 32);
    const float rstd = rsqrtf(vs * (1.f / 64.f) + 64e-5f);
    const bf16_t* gb = GB + ((size_t)m * 16 + h) * 128 + 4 * hh;
    const float* lw = a.in[I_LNW] + h * 64 + 4 * hh; const float* lb = a.in[I_LNB] + h * 64 + 4 * hh;
    bf16_t* orow = O + (size_t)m * D + 1024 + h * 64 + 4 * hh;
#pragma unroll
    for (int rt = 0; rt < 2; ++rt)
#pragma unroll
        for (int g = 0; g < 4; ++g) {
            const int off = rt * 32 + 8 * g;
            const f32x4 w4 = *(const f32x4*)(lw + off), b4 = *(const f32x4*)(lb + off);
            const u32x2 gw = *(const u32x2*)(gb + off), bw = *(const u32x2*)(gb + 64 + off);
            const float gg[4] = {__uint_as_float(gw.x << 16), __uint_as_float(gw.x & 0xffff0000u), __uint_as_float(gw.y << 16), __uint_as_float(gw.y & 0xffff0000u)};
            const float bb[4] = {__uint_as_float(bw.x << 16), __uint_as_float(bw.x & 0xffff0000u), __uint_as_float(bw.y << 16), __uint_as_float(bw.y & 0xffff0000u)};
            float o[4];
#pragma unroll
            for (int e = 0; e < 4; ++e) o[e] = (y[rt * 16 + 4 * g + e] * rstd * w4[e] + b4[e] + bb[e]) * gg[e];
            u32x2 w; w.x = pk2(o[0], o[1]); w.y = pk2(o[2], o[3]);
            *(u32x2*)(orow + off) = w;
        }
}

DI void unpack8(const u32x4 w, float (&u)[8]) {
    u[0] = __uint_as_float(w.x << 16); u[1] = __uint_as_float(w.x & 0xffff0000u); u[2] = __uint_as_float(w.y << 16); u[3] = __uint_as_float(w.y & 0xffff0000u);
    u[4] = __uint_as_float(w.z << 16); u[5] = __uint_as_float(w.z & 0xffff0000u); u[6] = __uint_as_float(w.w << 16); u[7] = __uint_as_float(w.w & 0xffff0000u);
}
constexpr int FIX_ROWS = 28 * 2 + MS + 8;
DI void conv_fix(const Args& a, int idx) {
    const int fg = idx % (FF / 8), ri = idx / (FF / 8), f = fg * 8;
    if (ri >= FIX_ROWS) return;
    const float* EDGE = (const float*)(a.ws + WS_U); bf16_t* ACT = (bf16_t*)(a.ws + WS_ACT);
    const float* cw = a.in[I_FCW]; const float* cb = a.in[I_FCB];
    const float *p0, *p1, *p2; int m;
    if (ri < 56) {
        const int ti = ri >> 1, k = ri & 1, pm = ti + 1 + ti / 7;
        m = pm * 256 + k;
        p0 = EDGE + ((size_t)pm * 4 + k) * FF2;
        p1 = k == 0 ? EDGE + ((size_t)(pm - 1) * 4 + 3) * FF2 : EDGE + ((size_t)pm * 4 + 0) * FF2;
        p2 = k == 0 ? EDGE + ((size_t)(pm - 1) * 4 + 2) * FF2 : EDGE + ((size_t)(pm - 1) * 4 + 3) * FF2;
    } else if (ri >= 56 + MS) {
        const int q = ri - 56 - MS, bb = q >> 1, k = q & 1;
        const float* src = EDGE + ((size_t)(bb * 8 + 7) * 4 + 2 + k) * FF2; float* dst = a.out + O_PFFN + ((size_t)bb * 2 + k) * FF2;
#pragma unroll
        for (int p = 0; p < 2; ++p) { *(f32x4*)(dst + p * FF + f) = *(const f32x4*)(src + p * FF + f); *(f32x4*)(dst + p * FF + f + 4) = *(const f32x4*)(src + p * FF + f + 4); }
        return;
    } else {
        const int b = ri - 56; m = MP + b;
        p0 = EDGE + (size_t)(128 + b) * FF2;
        { float* s1 = a.out + O_SFFN + (size_t)b * 2 * FF2 + FF2;
#pragma unroll
          for (int p = 0; p < 2; ++p) { *(f32x4*)(s1 + p * FF + f) = *(const f32x4*)(p0 + p * FF + f); *(f32x4*)(s1 + p * FF + f + 4) = *(const f32x4*)(p0 + p * FF + f + 4); } }
        p1 = a.in[I_SFFN] + (size_t)b * 2 * FF2 + FF2;
        p2 = a.in[I_SFFN] + (size_t)b * 2 * FF2;
        float* so = a.out + O_SFFN + (size_t)b * 2 * FF2;
#pragma unroll
        for (int p = 0; p < 2; ++p) { *(f32x4*)(so + p * FF + f) = *(const f32x4*)(p1 + p * FF + f); *(f32x4*)(so + p * FF + f + 4) = *(const f32x4*)(p1 + p * FF + f + 4); }
    }
    float c[2][8];
#pragma unroll
    for (int p = 0; p < 2; ++p)
#pragma unroll
        for (int j = 0; j < 8; ++j) { const int col = p * FF + f + j; c[p][j] = cb[col] + cw[col] * p2[col] + cw[FF2 + col] * p1[col] + cw[2 * FF2 + col] * p0[col]; }
    float o[8];
#pragma unroll
    for (int j = 0; j < 8; ++j) o[j] = c[0][j] * __builtin_amdgcn_rcpf(1.f + __expf(-c[0][j])) * c[1][j];
    u32x4 w; w.x = pk2(o[0], o[1]); w.y = pk2(o[2], o[3]); w.z = pk2(o[4], o[5]); w.w = pk2(o[6], o[7]);
    *(u32x4*)(ACT + (size_t)m * FF + f) = w;
}

#define XB_TMO      128
#define XB_XCNT(j)  (256  + 64 * (j))
#define XB_XSUB(j)  (1280 + 64 * (j))
#define XB_XGEN(j)  (2304 + 64 * (j))
#define XB_TOP      3328
#define XB_TOPGEN   3392
#define XCD_BAR_WORDS 3456
#define XB_SPIN_CAP (1u << 18)
DI unsigned xb_ld(unsigned* p)              { return __hip_atomic_load(p, __ATOMIC_RELAXED, __HIP_MEMORY_SCOPE_AGENT); }
DI unsigned xb_add(unsigned* p, unsigned v) { return __hip_atomic_fetch_add(p, v, __ATOMIC_RELAXED, __HIP_MEMORY_SCOPE_AGENT); }
DI unsigned xb_xcc_id() { return (unsigned)__builtin_amdgcn_s_getreg((3 << 11) | 20) & 0xFu; }
#define XB_SPIN(cond, bar) do { unsigned _sp = 0; while (cond) { __builtin_amdgcn_s_sleep(1); \
    if ((++_sp & 255u) == 0u) { if (xb_ld(&(bar)[XB_TMO])) break; if (_sp > XB_SPIN_CAP) { atomicAdd(&(bar)[XB_TMO], 1u); break; } } } } while (0)
struct XcdBarrier { unsigned* bar; unsigned x; volatile LAS unsigned* st; };
DI XcdBarrier xcd_barrier_post(unsigned* bar, volatile LAS unsigned* st) {
    XcdBarrier b; b.bar = bar; b.x = xb_xcc_id(); b.st = st;
    if (threadIdx.x == 0) (void)xb_add(&bar[XB_XCNT(b.x)], 1u);
    return b;
}
DI void xcd_barrier_complete(unsigned* bar, unsigned x, unsigned& nloc, unsigned& nx) {
    const unsigned G = gridDim.x * gridDim.y * gridDim.z;
    unsigned sum, cnt, mine, sp = 0u;
    for (;;) {
        sum = 0u; cnt = 0u; mine = 0u;
#pragma unroll
        for (unsigned j = 0; j < 16; ++j) { const unsigned c = xb_ld(&bar[XB_XCNT(j)]); sum += c; cnt += (c > 0u) ? 1u : 0u; mine = (j == x) ? c : mine; }
        if (sum == G) break;
        __builtin_amdgcn_s_sleep(1);
        if ((++sp & 255u) == 0u) { if (xb_ld(&bar[XB_TMO])) break; if (sp > XB_SPIN_CAP) { atomicAdd(&bar[XB_TMO], 1u); break; } }
    }
    nloc = mine > 0u ? mine : 1u; nx = cnt > 0u ? cnt : 1u;
}
DI void xcd_barrier(const XcdBarrier& b) {
    asm volatile("s_waitcnt vmcnt(0)" ::: "memory");
    __syncthreads();
    if (threadIdx.x == 0) {
        unsigned* bar = b.bar;
        __builtin_amdgcn_s_waitcnt(0);
        unsigned nloc = b.st[0], nx = b.st[1];
        if (nloc == 0u) { xcd_barrier_complete(bar, b.x, nloc, nx); b.st[0] = nloc; b.st[1] = nx; }
        const unsigned old = xb_add(&bar[XB_XSUB(b.x)], 1u);
        const unsigned gen = old / nloc;
        if (old + 1u == (gen + 1u) * nloc) {
            __builtin_amdgcn_fence(__ATOMIC_RELEASE, "agent");
            asm volatile("s_waitcnt vmcnt(0)" ::: "memory");
            const unsigned og = xb_add(&bar[XB_TOP], 1u);
            const unsigned tg = og / nx;
            if (og + 1u == (tg + 1u) * nx) xb_add(&bar[XB_TOPGEN], 1u);
            else XB_SPIN(xb_ld(&bar[XB_TOPGEN]) == tg, bar);
            __builtin_amdgcn_fence(__ATOMIC_ACQUIRE, "agent");
            xb_add(&bar[XB_XGEN(b.x)], 1u);
            asm volatile("s_waitcnt vmcnt(0)" ::: "memory");
        } else {
            XB_SPIN(xb_ld(&bar[XB_XGEN(b.x)]) == gen, bar);
            __builtin_amdgcn_fence(__ATOMIC_ACQUIRE, "agent");
            asm volatile("s_waitcnt vmcnt(0)" ::: "memory");
        }
    }
    __syncthreads();
}

DI void skinny_unit(const bf16_t* A, int lda, const bf16_t* Bt, int K, int unit, const float* base, int ldb, float* out, int ldo, unsigned char* lds, int wave, int lane,
                    const float* gf = nullptr, bf16_t* H = nullptr, float* RSS = nullptr) {
    float* red = (float*)lds;
    const int n0 = unit * 32, r = lane & 31, hh = lane >> 5, kw = K / 8, kb = wave * kw;
    f32x16 acc;
#pragma unroll
    for (int i = 0; i < 16; ++i) acc[i] = 0.f;
    const bf16_t* ap = A + (size_t)r * lda + kb + 8 * hh; const bf16_t* bp = Bt + (size_t)(n0 + r) * K + kb + 8 * hh;
#pragma unroll 8
    for (int k = 0; k < kw; k += 16) {
        const bf16x8 af = *(const bf16x8*)(ap + k), bf = *(const bf16x8*)(bp + k);
        acc = __builtin_amdgcn_mfma_f32_32x32x16_bf16(af, bf, acc, 0, 0, 0);
    }
#pragma unroll
    for (int i = 0; i < 16; ++i) red[(wave * 16 + i) * 64 + lane] = acc[i];
    __syncthreads();
#pragma unroll
    for (int q = 0; q < 2; ++q) {
        const int o = threadIdx.x + 512 * q, i = o >> 6, ln = o & 63;
        float sum = 0.f;
#pragma unroll
        for (int w = 0; w < 8; ++w) sum += red[(w * 16 + i) * 64 + ln];
        const int row = crow(i, ln >> 5), col = n0 + (ln & 31);
        const float x1 = base[(size_t)row * ldb + col] + sum * (H ? 1.0f : MK_P11_SCALE);
        out[(size_t)row * ldo + col] = x1;
        if (H) { H[(size_t)row * D + col] = (bf16_t)bf_rne(x1 * gf[col]);
            float ss = x1 * x1;
            ss += __shfl_xor(ss, 1); ss += __shfl_xor(ss, 2); ss += __shfl_xor(ss, 4); ss += __shfl_xor(ss, 8); ss += __shfl_xor(ss, 16);
            if ((ln & 31) == 0) atomic_add_f32(RSS + row, ss); }
    }
    __syncthreads();
}

constexpr int NPH = 14;
template <bool COOP>
__global__ void __launch_bounds__(NTHREADS, 2) mk_fwd(Args a) {
    extern __shared__ __attribute__((aligned(16))) unsigned char lds[];
    const int tid = threadIdx.x, lane = tid & 63, wave = __builtin_amdgcn_readfirstlane(tid >> 6);
    const int G = gridDim.x, bid = blockIdx.x, gw = bid * NWAVES + wave, ngw = G * NWAVES;
    unsigned char* ws = a.ws;
    LAS unsigned char* ldsl = (LAS unsigned char*)lds;
#ifndef PHMASK
#define PHMASK 0xffff
#endif
#define IN(k) (((PHMASK >> (k)) & 1) && a.ph_lo <= (k) && (k) < a.ph_hi)
    XcdBarrier xbar; xbar.bar = (unsigned*)(ws + WS_BAR); xbar.x = 0; xbar.st = nullptr;
    if (COOP) {
        volatile LAS unsigned* st = (volatile LAS unsigned*)(ldsl + LDS_BYTES - 16);
        if (tid < 4) st[tid] = 0u;
        __syncthreads();
        xbar = xcd_barrier_post((unsigned*)(ws + WS_BAR), st);
    }
#define SEAM(k) do { if (COOP && IN(k) && IN((k) + 1)) { if (a.ph_hi > 1000) cg::this_grid().sync(); else xcd_barrier(xbar); } } while (0)

    if (IN(0)) phase_prologue(a, lds, gw, ngw, lane, wave);
    SEAM(0);
    if (IN(1)) {
        pg8::Gemm g{(const bf16_t*)(ws + WS_H), (const bf16_t*)(ws + WS_WIN), MPAD, NIN, D}; pg8::StaticOrder S; S.init(MPAD, NIN, G, bid);
        EpiIn E{(bf16_t*)(ws + WS_QB), (bf16_t*)(ws + WS_KB), (bf16_t*)(ws + WS_VB), (bf16_t*)(ws + WS_RW), a.out};
        pg8::gemm_phase<EpiIn>(ldsl, g, S, E);
        {
            const int nu = (MPAD / 256) * (NIN / 256), rem = nu % G, first = rem == 0 ? 0 : rem, nfree = G - first;
            if (bid >= first) convert_wo_wup(a, lds, (bid - first) * NWAVES + wave, nfree * NWAVES, wave, lane);
        }
    }
    SEAM(1);
    if (IN(2)) {
        for (int u = bid; u < 256; u += G) attn_sample_wg(a, lds, u, wave, lane);
        for (int u = gw; u < 64 * 3 * 64; u += ngw) attn_prompt_unit(a, lds, u, wave, lane);
        for (int m = gw; m < MPAD; m += ngw) lora_input_row(a, m, lane);
    }
    SEAM(2);
    if (IN(3)) {
        pg8::Gemm g{(const bf16_t*)(ws + WS_ALO), (const bf16_t*)(ws + WS_WLO), MPAD, NLO, KLO}; pg8::StaticOrder S; S.init(MPAD, NLO, G, bid);
        EpiBf E{(bf16_t*)(ws + WS_L), NLO};
        pg8::gemm_phase<EpiBf>(ldsl, g, S, E);
#pragma unroll 2
        for (int t = gw; t < MP * 4; t += ngw) attn_merge_task(a, t, lane);
    }
    SEAM(3);
    if (IN(4)) {
#ifndef NO_P1
        for (int u = bid; u < 64 * NS / 4; u += G) scan_pass1_unit(a, lds, u, wave, lane);
#endif

    }
    SEAM(4);
    if (IN(5)) {
        if (G >= 128) {
            if (bid < 64) scan_pass2_unit(a, lds, bid, wave, lane);
            else for (int u = (bid - 64) * NWAVES + wave; u < 512; u += (G - 64) * NWAVES) scan_sample_unit(a, lds, u, wave, lane);
        } else {
            for (int ch = bid; ch < 64; ch += G) scan_pass2_unit(a, lds, ch, wave, lane);
            for (int u = gw; u < 512; u += ngw) scan_sample_unit(a, lds, u, wave, lane);
        }
    }
    SEAM(5);
    if (IN(6)) { for (int u = gw; u < 64 * NS * 4; u += ngw) scan_pass3_unit(a, u, lane); }
    SEAM(6);
    if (IN(7)) {
        pg8::Gemm g{(const bf16_t*)(ws + WS_O), (const bf16_t*)(ws + WS_WO), MP, D, D}; pg8::StaticOrder S; S.init(MP, D, G, bid);
        EpiWo E{a.in[I_XP], a.in[I_NFG], (float*)(ws + WS_X1), (bf16_t*)(ws + WS_H), (float*)(ws + WS_RSS)};
        pg8::gemm_phase<EpiWo>(ldsl, g, S, E);
        for (int u = bid; u < D / 32; u += G)
            skinny_unit((const bf16_t*)(ws + WS_O) + (size_t)MP * D, D, (const bf16_t*)(ws + WS_WO), D, u, a.in[I_XS], D, (float*)(ws + WS_X1) + (size_t)MP * D, D, lds, wave, lane,
                        a.in[I_NFG], (bf16_t*)(ws + WS_H) + (size_t)MP * D, (float*)(ws + WS_RSS) + MP);
    }
    SEAM(7);
    if (IN(9)) {
        pg8::Gemm g{(const bf16_t*)(ws + WS_H), (const bf16_t*)(ws + WS_WUP), MPAD, FF2, D}; pg8::StaticOrder S; S.init(MPAD, FF2, G, bid);
        EpiUpF E{(bf16_t*)(ws + WS_ACT), a.out, (const float*)(ws + WS_RSS), a.in[I_FCW], a.in[I_FCB], (float*)(ws + WS_U), (LAS float*)(ldsl + 131072)};
        pg8::gemm_phase<EpiUpF>(ldsl, g, S, E);
        {
            const int nu = (MPAD / 256) * (FF2 / 256), rem = nu % G, first = rem == 0 ? 0 : rem, nfree = G - first;
            if (bid >= first) convert_wdn(a, lds, (bid - first) * NWAVES + wave, nfree * NWAVES, wave, lane);
        }
    }
    SEAM(9);
    if (IN(10)) { for (int it = bid * NTHREADS + tid; it < FIX_ROWS * (FF / 8); it += G * NTHREADS) conv_fix(a, it); }
    SEAM(10);
    if (IN(11)) {
        pg8::Gemm g{(const bf16_t*)(ws + WS_ACT), (const bf16_t*)(ws + WS_WDN), MP, D, FF}; pg8::StaticOrder S; S.init(MP, D, G, bid);
        EpiDn E{(float*)(ws + WS_X1)};
        pg8::gemm_phase<EpiDn>(ldsl, g, S, E);
        for (int u = bid; u < D / 32; u += G)
            skinny_unit((const bf16_t*)(ws + WS_ACT) + (size_t)MP * FF, FF, (const bf16_t*)(ws + WS_WDN), FF, u, (const float*)(ws + WS_X1) + (size_t)MP * D, D, (float*)(ws + WS_X1) + (size_t)MP * D, D, lds, wave, lane);
    }
    SEAM(11);
    if (IN(12)) {
        for (int m = gw; m < MT; m += ngw)
            rms_row_f32((const float*)(ws + WS_X1) + (size_t)m * D, a.in[I_NFIN], m < MP ? a.out + O_YP + (size_t)m * D : a.out + O_YS + (size_t)(m - MP) * D, lane);
    }
#undef IN
#undef SEAM
}

#ifndef MK_ONE_LAUNCH
#define MK_ONE_LAUNCH 1
#endif
#ifndef MK_DBL_MASK
#define MK_DBL_MASK 0x0
#endif

extern "C" void kernel_launch(void* const* d_in, const int* in_sizes, int n_in, void* d_out, int out_size, void* d_ws, size_t ws_size, hipStream_t stream) {
    static int grid = 0;
    if (!grid) {
        if (n_in != 28 || (size_t)out_size != O_END || ws_size < WS_END) fprintf(stderr, "kernel_launch: unexpected shapes: n_in %d out %d (want %zu) ws %zu (want %zu)\n", n_in, out_size, O_END, ws_size, WS_END);
        int dev = 0, cus = 0; hipGetDevice(&dev); hipDeviceGetAttribute(&cus, hipDeviceAttributeMultiprocessorCount, dev);
        hipFuncSetAttribute((const void*)mk_fwd<true>, hipFuncAttributeMaxDynamicSharedMemorySize, LDS_BYTES);
        hipFuncSetAttribute((const void*)mk_fwd<false>, hipFuncAttributeMaxDynamicSharedMemorySize, LDS_BYTES);
        int per_cu = 0; hipOccupancyMaxActiveBlocksPerMultiprocessor(&per_cu, mk_fwd<true>, NTHREADS, LDS_BYTES);
        if (per_cu < 1) { fprintf(stderr, "kernel_launch: occupancy query says %d blocks/CU\n", per_cu); per_cu = 1; }
        grid = cus > 0 ? cus : 256;
    }
    Args a; memset(&a, 0, sizeof(a));
    for (int i = 0; i < 28; ++i) a.in[i] = (const float*)d_in[i];
    a.out = (float*)d_out; a.ws = (unsigned char*)d_ws;
#if MK_ONE_LAUNCH
    if (hipMemsetAsync((char*)d_ws + WS_BAR, 0, BAR_BYTES, stream) != hipSuccess) { fprintf(stderr, "kernel_launch: memset of the barrier words failed\n"); return; }
    a.ph_lo = 0; a.ph_hi = NPH;
    void* args[] = {&a};
    hipError_t e = hipLaunchCooperativeKernel((const void*)mk_fwd<true>, dim3(grid), dim3(NTHREADS), args, LDS_BYTES, stream);
    if (e != hipSuccess) fprintf(stderr, "cooperative launch failed: %s (grid %d)\n", hipGetErrorString(e), grid);
#else
    for (int p = 0; p < 13; ++p) {
        a.ph_lo = p; a.ph_hi = p + 1;
        mk_fwd<false><<<dim3(grid), dim3(NTHREADS), LDS_BYTES, stream>>>(a);
        if ((MK_DBL_MASK >> p) & 1) mk_fwd<false><<<dim3(grid), dim3(NTHREADS), LDS_BYTES, stream>>>(a);
    }
#endif
}
```

```cpp
#include <hip/hip_runtime.h>
#include <hip/hip_cooperative_groups.h>
#include <cstdio>
#include <cstdint>
#include <cstring>
namespace cg = cooperative_groups;

#define DI __device__ __forceinline__
#define LAS __attribute__((address_space(3)))
typedef unsigned short bf16_t;
typedef short bf16x8 __attribute__((ext_vector_type(8)));
typedef float f32x4 __attribute__((ext_vector_type(4)));
typedef float f32x16 __attribute__((ext_vector_type(16)));
typedef unsigned u32x4 __attribute__((ext_vector_type(4)));
typedef unsigned u32x2 __attribute__((ext_vector_type(2)));

constexpr int D = 2048, MP = 8192, MS = 32, MT = 8224, MPAD = 8448, SEQ = 2048;
constexpr int CIN = 6432, NIN = 6656, CSH = 3360, FF2 = 11264, FF = 5632;
constexpr int NLO = 3072, KLO = 384;
constexpr int NS = 16, SEGL = 128, TB = 8;
constexpr int NTHREADS = 512, NWAVES = 8;
constexpr int LDS_BYTES = 131072 + 16384;

constexpr size_t O_YP = 0;
constexpr size_t O_YS = O_YP + (size_t)MP * D;
constexpr size_t O_PK = O_YS + (size_t)MS * D;
constexpr size_t O_PV = O_PK + (size_t)MP * 1024;
constexpr size_t O_PRW = O_PV + (size_t)MP * 1024;
constexpr size_t O_PWKV = O_PRW + (size_t)4 * CSH;
constexpr size_t O_PFFN = O_PWKV + (size_t)4 * 16 * 4096;
constexpr size_t O_SK = O_PFFN + (size_t)4 * 2 * FF2;
constexpr size_t O_SV = O_SK + (size_t)MS * 1024;
constexpr size_t O_SRW = O_SV + (size_t)MS * 1024;
constexpr size_t O_SWKV = O_SRW + (size_t)MS * CSH;
constexpr size_t O_SFFN = O_SWKV + (size_t)MS * 16 * 4096;
constexpr size_t O_END = O_SFFN + (size_t)MS * 2 * FF2;

constexpr size_t al256(size_t x) { return (x + 255) & ~(size_t)255; }
constexpr size_t WS_WIN = 0;
constexpr size_t WS_WO = WS_WIN + al256((size_t)NIN * D * 2);
constexpr size_t WS_WUP = WS_WO + al256((size_t)D * D * 2);
constexpr size_t WS_WDN = WS_WUP + al256((size_t)FF2 * D * 2);
constexpr size_t WS_WLO = WS_WDN + al256((size_t)D * FF * 2);
constexpr size_t WS_H = WS_WLO + al256((size_t)NLO * KLO * 2);
constexpr size_t WS_QB = WS_H + al256((size_t)MPAD * D * 2);
constexpr size_t WS_KB = WS_QB + al256((size_t)MPAD * 1024 * 2);
constexpr size_t WS_VB = WS_KB + al256((size_t)MPAD * 1024 * 2);
constexpr size_t WS_ALO = WS_VB + al256((size_t)MPAD * 1024 * 2);
constexpr size_t WS_O = WS_ALO + al256((size_t)MPAD * KLO * 2);
constexpr size_t WS_GB = WS_O + al256((size_t)MPAD * D * 2);
constexpr size_t WS_YL = WS_GB + al256((size_t)MT * 2048 * 2);
constexpr size_t WS_QS = WS_YL + al256((size_t)MP * 1024 * 2);
constexpr size_t WS_ZP = WS_QS + al256((size_t)MP * 1024 * 2);
constexpr size_t WS_SST = WS_ZP + al256((size_t)64 * NS * 2 * 4096 * 4);
constexpr size_t WS_X1 = WS_SST + al256((size_t)64 * NS * 4096 * 4);
constexpr size_t WS_PML = WS_X1 + al256((size_t)MPAD * D * 4);
constexpr size_t WS_RA = WS_PML + al256((size_t)3 * MP * 16 * 2 * 4);
constexpr size_t WS_RW = WS_RA;
constexpr size_t WS_L = WS_RW + al256((size_t)MPAD * CSH * 2);
constexpr size_t RA_BYTES_1 = al256((size_t)MPAD * CSH * 2) + al256((size_t)MPAD * NLO * 2);
constexpr size_t RA_BYTES_2 = al256((size_t)MPAD * FF2 * 2);
constexpr size_t WS_U = WS_RA;
constexpr size_t WS_RB = WS_RA + (RA_BYTES_1 > RA_BYTES_2 ? RA_BYTES_1 : RA_BYTES_2);
constexpr size_t WS_PART = WS_RB;
constexpr size_t WS_ACT = WS_RB;
constexpr size_t RB_BYTES_1 = al256((size_t)3 * MP * 1024 * 2);
constexpr size_t RB_BYTES_2 = al256((size_t)MPAD * FF * 2);
constexpr size_t WS_RSS = WS_RB + (RB_BYTES_1 > RB_BYTES_2 ? RB_BYTES_1 : RB_BYTES_2);
constexpr size_t WS_BAR_ = 0; constexpr size_t WS_BAR = al256((size_t)MPAD * 4) + WS_RB + (RB_BYTES_1 > RB_BYTES_2 ? RB_BYTES_1 : RB_BYTES_2);
constexpr size_t BAR_BYTES = 16384;
constexpr size_t WS_END = WS_BAR + BAR_BYTES;

struct Args {
    const float* in[28];
    float* out;
    unsigned char* ws;
    int ph_lo, ph_hi;
};
enum { I_XP = 0, I_XS, I_CK, I_CV, I_SSH, I_SWKV, I_SFFN, I_NMG, I_WIN, I_AOG, I_MU, I_W0, I_WUP, I_A0, I_AUP, I_GUP,
       I_KK, I_KA, I_RK, I_LNW, I_LNB, I_WO, I_NFG, I_FUP, I_FCW, I_FCB, I_FDN, I_NFIN };

typedef float f32x2c __attribute__((ext_vector_type(2)));
typedef __bf16 bf16x2c __attribute__((ext_vector_type(2)));
DI unsigned pk2(float lo, float hi) { const f32x2c v = {lo, hi}; return __builtin_bit_cast(unsigned, __builtin_convertvector(v, bf16x2c)); }
DI unsigned bf_rne(float f) { return pk2(f, 0.f) & 0xffffu; }
DI unsigned cvt_pk(float lo, float hi) { return pk2(lo, hi); }
DI void atomic_add_f32(float* p, float v) { (void)__builtin_amdgcn_global_atomic_fadd_f32((__attribute__((address_space(1))) float*)p, v); }
DI float bf2f(unsigned short b) { return __uint_as_float(((unsigned)b) << 16); }
#define DPP_ADD(v, ctrl) ((v) + __int_as_float(__builtin_amdgcn_update_dpp(0, __float_as_int(v), (ctrl), 0xf, 0xf, false)))
DI float wave_sum(float v) {
    v = DPP_ADD(v, 0xB1);
    v = DPP_ADD(v, 0x4E);
    v = DPP_ADD(v, 0x141);
    v = DPP_ADD(v, 0x140);
    const float s0 = __int_as_float(__builtin_amdgcn_readlane(__float_as_int(v), 0)), s1 = __int_as_float(__builtin_amdgcn_readlane(__float_as_int(v), 16));
    const float s2 = __int_as_float(__builtin_amdgcn_readlane(__float_as_int(v), 32)), s3 = __int_as_float(__builtin_amdgcn_readlane(__float_as_int(v), 48));
    return (s0 + s1) + (s2 + s3);
}

namespace pg8 {
constexpr int BM = 256, BK = 64, HALF = 128, HTB = HALF * BK * 2, STAGE_BYTES = 8 * HTB, NXCD = 8, WGM = 8;
DI int lds_byte(int r, int c) { const int st = (r >> 4) * 2 + (c >> 5), rr = r & 15, cc = c & 31, ob = rr * 64 + cc * 2; return st * 1024 + (ob ^ (((ob >> 9) & 1) << 5)); }
DI void stage_rc(int b, int& R, int& C) { const int st = b / 1024, sb = b % 1024, swz = sb ^ (((sb >> 9) & 1) << 5); R = (st >> 1) * 16 + swz / 64; C = (st & 1) * 32 + (swz % 64) / 2; }
struct Unit { int pm, pn; };
struct Gemm { const bf16_t* A; const bf16_t* Bt; int M, N, K; };
struct StaticOrder {
    int nM, nN, nwg, G, c;
    DI void init(int M, int N, int G_, int c_) { nM = M / BM; nN = N / BM; nwg = nM * nN; G = G_; c = c_; }
    DI bool next(int i, Unit& u) const {
        const long L = (long)i * G + c; if (L >= nwg) return false;
        int wgid = (int)L; { const int q = nwg / NXCD, r = nwg % NXCD, xcd = wgid % NXCD, off = wgid / NXCD; wgid = (xcd < r ? xcd * (q + 1) : r * (q + 1) + (xcd - r) * q) + off; }
        const int nig = WGM * nN, gid = wgid / nig, fm = gid * WGM, gsz = (nM - fm) < WGM ? (nM - fm) : WGM;
        u.pm = fm + ((wgid % nig) % gsz); u.pn = (wgid % nig) / gsz; return true;
    }
};

template <class Epi>
DI void gemm_phase(LAS unsigned char* lds, const Gemm g, const StaticOrder& S, const Epi& E) {
    const int tid = threadIdx.x, wid = __builtin_amdgcn_readfirstlane(tid >> 6), lane = tid & 63, wr = wid >> 2, wc = wid & 3, fr = lane & 15, fq = lane >> 4;
    const int K = g.K, nt = K / BK;
    unsigned voffA[2];
#pragma unroll
    for (int i = 0; i < 2; ++i) { int R, C; stage_rc(tid * 16 + i * 8192, R, C); voffA[i] = (unsigned)(R * K + C) * 2u; }
    const size_t kstep = (size_t)(BK * 2);
    const size_t hstep = (size_t)HALF * K * 2;
    const size_t tstep = 2 * hstep;
    const unsigned ldsw = (unsigned)wid * 1024u;
    const int aoff = lds_byte(wr * 64 + fr, fq * 8), boff = lds_byte(wc * 32 + fr, fq * 8);
#define PG8_SA(b, h) (((b) * 2 + (h)) * HTB)
#define PG8_SB(b, h) ((4 + (b) * 2 + (h)) * HTB)
#define PG8_STAGE(bufoff, gbase, voff) do { _Pragma("unroll") for (int _i = 0; _i < 2; ++_i) \
        __builtin_amdgcn_global_load_lds((const unsigned*)((const char*)(gbase) + (voff)[_i]), (LAS unsigned*)(lds + (bufoff) + ldsw + _i * 8192), 16, 0, 0); } while (0)
#define PG8_LDA(dst, b, h) do { _Pragma("unroll") for (int m = 0; m < 4; ++m) _Pragma("unroll") for (int k = 0; k < 2; ++k) dst[m][k] = *(const LAS bf16x8*)(lds + PG8_SA(b, h) + aoff + m * 2048 + k * 1024); } while (0)
#define PG8_LDB(dst, b, h) do { _Pragma("unroll") for (int n = 0; n < 2; ++n) _Pragma("unroll") for (int k = 0; k < 2; ++k) dst[n][k] = *(const LAS bf16x8*)(lds + PG8_SB(b, h) + boff + n * 2048 + k * 1024); } while (0)
#define PG8_MMA(ai, bj, At, Bt) do { __builtin_amdgcn_s_setprio(1); _Pragma("unroll") for (int m = 0; m < 4; ++m) _Pragma("unroll") for (int n = 0; n < 2; ++n) _Pragma("unroll") for (int k = 0; k < 2; ++k) \
        acc[ai][bj][m][n] = __builtin_amdgcn_mfma_f32_16x16x32_bf16(Bt[n][k], At[m][k], acc[ai][bj][m][n], 0, 0, 0); __builtin_amdgcn_s_setprio(0); } while (0)
#define PG8_WAIT_V(n) asm volatile("s_waitcnt vmcnt(" #n ")" ::: "memory")
#define PG8_WAIT_L(n) asm volatile("s_waitcnt lgkmcnt(" #n ")" ::: "memory")
#define PG8_BAR __builtin_amdgcn_s_barrier()
#define PG8_SCHED __builtin_amdgcn_sched_barrier(0)
    Unit cur, nxt; int ui = 0;
    if (!S.next(0, cur)) return;
    f32x4 acc[2][2][4][2];
#pragma unroll
    for (int a = 0; a < 2; ++a)
#pragma unroll
        for (int b = 0; b < 2; ++b)
#pragma unroll
            for (int m = 0; m < 4; ++m)
#pragma unroll
                for (int n = 0; n < 2; ++n) acc[a][b][m][n] = (f32x4){0.f, 0.f, 0.f, 0.f};
    bf16x8 At[4][2], B0[2][2], B1[2][2];
    const char* cA = (const char*)g.A + (size_t)cur.pm * tstep; const char* cB = (const char*)g.Bt + (size_t)cur.pn * tstep;
    PG8_STAGE(PG8_SB(0, 0), cB, voffA); PG8_STAGE(PG8_SA(0, 0), cA, voffA); PG8_STAGE(PG8_SB(0, 1), cB + hstep, voffA); PG8_STAGE(PG8_SA(0, 1), cA + hstep, voffA);
    if (wr == 1) PG8_BAR;
    PG8_WAIT_V(4); PG8_BAR;
    PG8_STAGE(PG8_SB(1, 0), cB + kstep, voffA); PG8_STAGE(PG8_SA(1, 0), cA + kstep, voffA); PG8_STAGE(PG8_SB(1, 1), cB + hstep + kstep, voffA);
    PG8_WAIT_V(6); PG8_BAR;
    for (;;) {
        const bool has_next = S.next(ui + 1, nxt);
        const char* nA = has_next ? (const char*)g.A + (size_t)nxt.pm * tstep : cA; const char* nB = has_next ? (const char*)g.Bt + (size_t)nxt.pn * tstep : cB;
        for (int t = 0; t < nt; t += 2) {
            const bool last = (t == nt - 2);
            const char* a1 = cA + (size_t)(t + 1) * kstep;
            const char* a2 = last ? nA : cA + (size_t)(t + 2) * kstep; const char* b2 = last ? nB : cB + (size_t)(t + 2) * kstep;
            const char* a3 = a2 + kstep; const char* b3 = b2 + kstep;
            PG8_LDB(B0, 0, 0); PG8_SCHED; PG8_LDA(At, 0, 0); PG8_STAGE(PG8_SA(1, 1), a1 + hstep, voffA);
            PG8_WAIT_L(8); PG8_BAR; PG8_WAIT_L(0); PG8_MMA(0, 0, At, B0); PG8_BAR; PG8_SCHED;
            PG8_LDB(B1, 0, 1); PG8_STAGE(PG8_SB(0, 0), b2, voffA);
            PG8_BAR; PG8_WAIT_L(0); PG8_MMA(0, 1, At, B1); PG8_BAR;
            PG8_LDA(At, 0, 1); PG8_STAGE(PG8_SA(0, 0), a2, voffA);
            PG8_BAR; PG8_WAIT_L(0); PG8_MMA(1, 0, At, B0); PG8_BAR; PG8_SCHED;
            PG8_STAGE(PG8_SB(0, 1), b2 + hstep, voffA);
            PG8_WAIT_V(6); PG8_BAR; PG8_MMA(1, 1, At, B1); PG8_BAR;
            PG8_LDB(B0, 1, 0); PG8_SCHED; PG8_LDA(At, 1, 0); PG8_STAGE(PG8_SA(0, 1), a2 + hstep, voffA);
            PG8_WAIT_L(8); PG8_BAR; PG8_WAIT_L(0); PG8_MMA(0, 0, At, B0); PG8_BAR; PG8_SCHED;
            PG8_LDB(B1, 1, 1); PG8_STAGE(PG8_SB(1, 0), b3, voffA);
            PG8_BAR; PG8_WAIT_L(0); PG8_MMA(0, 1, At, B1); PG8_BAR;
            PG8_LDA(At, 1, 1); PG8_STAGE(PG8_SA(1, 0), a3, voffA);
            PG8_BAR; PG8_WAIT_L(0); PG8_MMA(1, 0, At, B0); PG8_BAR; PG8_SCHED;
            PG8_STAGE(PG8_SB(1, 1), b3 + hstep, voffA);
            PG8_WAIT_V(6); PG8_BAR; PG8_MMA(1, 1, At, B1); PG8_BAR;
        }
        E(acc, cur, wr, wc, fr, fq);
        if (!has_next) break;
#pragma unroll
        for (int a = 0; a < 2; ++a)
#pragma unroll
            for (int b = 0; b < 2; ++b)
#pragma unroll
                for (int m = 0; m < 4; ++m)
#pragma unroll
                    for (int n = 0; n < 2; ++n) acc[a][b][m][n] = (f32x4){0.f, 0.f, 0.f, 0.f};
        cur = nxt; cA = nA; cB = nB; ++ui;
    }
    PG8_WAIT_V(0);
    if (wr == 0) PG8_BAR;
    PG8_BAR;
#undef PG8_SA
#undef PG8_SB
#undef PG8_STAGE
#undef PG8_LDA
#undef PG8_LDB
#undef PG8_MMA
#undef PG8_WAIT_V
#undef PG8_WAIT_L
#undef PG8_BAR
#undef PG8_SCHED
}
}

DI size_t hm64(int row, int h)  { return ((size_t)((row >> 11) * 16 + h) * SEQ + (row & (SEQ - 1))) * 64; }
typedef f32x4 AccT[2][2][4][2];
#define EPI_LOOP_BEGIN \
    const int row0 = u.pm * 256 + wr * 64 + fr, col0 = u.pn * 256 + wc * 32 + 4 * fq; \
    _Pragma("unroll") for (int ai = 0; ai < 2; ++ai) _Pragma("unroll") for (int m = 0; m < 4; ++m) { const int row = row0 + ai * 128 + m * 16; \
    _Pragma("unroll") for (int bj = 0; bj < 2; ++bj) _Pragma("unroll") for (int n = 0; n < 2; ++n) { const int col = col0 + bj * 128 + n * 16; const f32x4 v = acc[ai][bj][m][n];
#define EPI_LOOP_END } }
#define EPI_LOOP_BEGIN_S \
    const int row0 = u.pm * 256 + wr * 64 + fr, col0 = u.pn * 256 + wc * 32 + 4 * fq; \
    _Pragma("unroll") for (int ai = 0; ai < 2; ++ai) _Pragma("unroll") for (int m = 0; m < 4; ++m) { const int row = row0 + ai * 128 + m * 16; \
    _Pragma("unroll") for (int bj = 0; bj < 2; ++bj) _Pragma("unroll") for (int n = 0; n < 2; ++n) { const int col = col0 + bj * 128 + n * 16; const f32x4 v = acc[ai][bj][m][n] * rs[ai][m];

struct EpiIn {
    bf16_t *Qb, *Kb, *Vb; bf16_t* RW; float* out;
    DI void operator()(const AccT& acc, const pg8::Unit& u, int wr, int wc, int fr, int fq) const {
        const int reg = u.pn < 4 ? 0 : (u.pn < 8 ? 1 : (u.pn < 12 ? 2 : 3));
        EPI_LOOP_BEGIN
            if (row < MT) {
                if (reg == 0) {
                    constexpr float QS_ = 0.125f * 1.44269504088896f;
                    u32x2 w; w.x = cvt_pk(v[0] * QS_, v[1] * QS_); w.y = cvt_pk(v[2] * QS_, v[3] * QS_);
                    *(u32x2*)(row < MP ? Qb + hm64(row, col >> 6) + (col & 63) : Qb + (size_t)row * 1024 + col) = w;
                } else if (reg == 1 || reg == 2) {
                    const int c = col - (reg == 1 ? 1024 : 2048);
                    float* o = row < MP ? out + (reg == 1 ? O_PK : O_PV) + (size_t)row * 1024 + c : out + (reg == 1 ? O_SK : O_SV) + (size_t)(row - MP) * 1024 + c;
                    *(f32x4*)o = v;
                    if (row < MP) { u32x2 w; w.x = cvt_pk(v[0], v[1]); w.y = cvt_pk(v[2], v[3]);
                        *(u32x2*)((reg == 1 ? Kb : Vb) + hm64(row, c >> 6) + (c & 63)) = w; }
                } else {
                    const int c = col - 3072;
                    if (c < CSH) {
                        { u32x2 w; w.x = cvt_pk(v[0], v[1]); w.y = cvt_pk(v[2], v[3]); *(u32x2*)(RW + (size_t)row * CSH + c) = w; }
                        if (row >= MP) *(f32x4*)(out + O_SRW + (size_t)(row - MP) * CSH + c) = v;
                        else if ((row & (SEQ - 1)) == SEQ - 1) *(f32x4*)(out + O_PRW + (size_t)(row >> 11) * CSH + c) = v;
                    }
                }
            }
        EPI_LOOP_END
    }
};
struct EpiBf {
    bf16_t* C; int ldc;
    DI void operator()(const AccT& acc, const pg8::Unit& u, int wr, int wc, int fr, int fq) const {
        const int row0 = u.pm * 256 + wr * 64 + fr, col0 = u.pn * 256 + wc * 32 + 4 * fq;
#pragma unroll
        for (int ai = 0; ai < 2; ++ai)
#pragma unroll
            for (int m = 0; m < 4; ++m) { const int row = row0 + ai * 128 + m * 16;
#pragma unroll
                for (int bj = 0; bj < 2; ++bj)
#pragma unroll
                    for (int n = 0; n < 2; ++n) { const int col = col0 + bj * 128 + n * 16; const f32x4 v = acc[ai][bj][m][n];
                        u32x2 w; w.x = cvt_pk(v[0], v[1]); w.y = cvt_pk(v[2], v[3]);
                        *(u32x2*)(C + (size_t)row * ldc + col) = w; }
                asm volatile("" ::: "memory");
            }
    }
};
struct EpiWo {
    const float *xp; const float* gf; float* X1; bf16_t* H; float* RSS;
    DI void operator()(const AccT& acc, const pg8::Unit& u, int wr, int wc, int fr, int fq) const {
        const int row0 = u.pm * 256 + wr * 64 + fr, col0 = u.pn * 256 + wc * 32 + 4 * fq;
        f32x4 gg[2][2];
#pragma unroll
        for (int bj = 0; bj < 2; ++bj)
#pragma unroll
            for (int n = 0; n < 2; ++n) gg[bj][n] = *(const f32x4*)(gf + col0 + bj * 128 + n * 16);
        float ssr[2][4];
#pragma unroll
        for (int aim = 0; aim < 4; ++aim) {
            const int ai = aim >> 1;
            f32x4 xr[4][2][2];
#pragma unroll
            for (int m = 2 * (aim & 1); m < 2 * (aim & 1) + 2; ++m)
#pragma unroll
                for (int bj = 0; bj < 2; ++bj)
#pragma unroll
                    for (int n = 0; n < 2; ++n) xr[m][bj][n] = *(const f32x4*)(xp + (size_t)(row0 + ai * 128 + m * 16) * D + col0 + bj * 128 + n * 16);
            asm volatile("" ::: "memory");
#pragma unroll
            for (int m = 2 * (aim & 1); m < 2 * (aim & 1) + 2; ++m) {
                const int row = row0 + ai * 128 + m * 16; float ss = 0.f;
#pragma unroll
                for (int bj = 0; bj < 2; ++bj)
#pragma unroll
                    for (int n = 0; n < 2; ++n) {
                        const int col = col0 + bj * 128 + n * 16;
                        const f32x4 x1 = xr[m][bj][n] + acc[ai][bj][m][n];
                        *(f32x4*)(X1 + (size_t)row * D + col) = x1;
                        u32x2 w; w.x = cvt_pk(x1[0] * gg[bj][n][0], x1[1] * gg[bj][n][1]); w.y = cvt_pk(x1[2] * gg[bj][n][2], x1[3] * gg[bj][n][3]);
                        *(u32x2*)(H + (size_t)row * D + col) = w;
                        ss += (x1[0] * x1[0] + x1[1] * x1[1]) + (x1[2] * x1[2] + x1[3] * x1[3]);
                    }
                ssr[ai][m] = ss;
            }
            asm volatile("" ::: "memory");
        }
#pragma unroll
        for (int ai = 0; ai < 2; ++ai)
#pragma unroll
            for (int m = 0; m < 4; ++m) { float ss = ssr[ai][m]; ss += __shfl_xor(ss, 16); ss += __shfl_xor(ss, 32); ssr[ai][m] = ss; }
        if (fq == 0) {
#pragma unroll
            for (int ai = 0; ai < 2; ++ai)
#pragma unroll
                for (int m = 0; m < 4; ++m) atomic_add_f32(RSS + row0 + ai * 128 + m * 16, ssr[ai][m]);
        }
    }
};
#define DPP_MOV(v, ctrl) __int_as_float(__builtin_amdgcn_update_dpp(0, __float_as_int(v), (ctrl), 0xf, 0xf, false))
#define DPP_SHR(oldv, v, ctrl) __int_as_float(__builtin_amdgcn_update_dpp(__float_as_int(oldv), __float_as_int(v), (ctrl), 0xf, 0xf, false))
struct EpiUpF {
    bf16_t* ACT; float* out; const float* RSS; const float* cw; const float* cb; float* EDGE; LAS float* xch;
    DI void operator()(const AccT& acc, const pg8::Unit& u, int wr, int wc, int fr, int fq) const {
        const int wave = wr * 4 + wc, row0 = u.pm * 256 + wr * 64 + fr, f0 = u.pn * 128 + wc * 32 + 4 * fq;
#define UPF_RS(ai_, m_) rsqrtf(RSS[row0 + (ai_) * 128 + (m_) * 16] * (1.f / D) + 1e-6f)
        LAS float* taps = xch + 2048; LAS float* rstd = xch + 3072;
        {
            const int tid = wave * 64 + fq * 16 + fr;
#pragma unroll
            for (int q = 0; q < 2; ++q) { const int idx = tid + 512 * q, which = idx >> 7, col = (which >= 4 ? FF : 0) + u.pn * 128 + (idx & 127);
                taps[idx] = (which & 3) < 3 ? cw[(which & 3) * FF2 + col] : cb[col]; }
            if (tid < 256) rstd[tid] = rsqrtf(RSS[u.pm * 256 + tid] * (1.f / D) + 1e-6f);
        }
        if (fr >= 14) {
#pragma unroll
            for (int ai = 0; ai < 2; ++ai)
#pragma unroll
                for (int bj = 0; bj < 2; ++bj)
#pragma unroll
                    for (int n = 0; n < 2; ++n)
                        *(LAS f32x4*)(xch + wave * 256 + ((((ai * 2 + (fr - 14)) * 2 + bj) * 2 + n) * 4 + fq) * 4) = acc[ai][bj][3][n] * UPF_RS(ai, 3);
        }
        asm volatile("s_waitcnt lgkmcnt(0)" ::: "memory"); __builtin_amdgcn_s_barrier(); asm volatile("" ::: "memory");
        __builtin_amdgcn_s_barrier(); asm volatile("" ::: "memory");
        const bool prompt = u.pm < MP / 256;
#pragma unroll
        for (int n = 0; n < 2; ++n) {
            const int f = f0 + 16 * n;
            asm volatile("" ::: "memory");
            const int fl = wc * 32 + 16 * n + 4 * fq;
#pragma unroll
            for (int ai = 0; ai < 2; ++ai) {
                const bool have = (wr == 1) || (ai == 1);
                const int nbw = wr == 1 ? wave - 4 : wave + 4, nai = wr == 1 ? ai : 0;
                f32x4 pg = {0.f, 0.f, 0.f, 0.f}, pv = {0.f, 0.f, 0.f, 0.f};
                if (have && fr >= 14) {
                    pg = *(const LAS f32x4*)(xch + nbw * 256 + ((((nai * 2 + (fr - 14)) * 2 + 0) * 2 + n) * 4 + fq) * 4);
                    pv = *(const LAS f32x4*)(xch + nbw * 256 + ((((nai * 2 + (fr - 14)) * 2 + 1) * 2 + n) * 4 + fq) * 4);
                }
#pragma unroll
                for (int m = 0; m < 4; ++m) {
                    const int row = row0 + ai * 128 + m * 16;
                    const float rsm = rstd[wr * 64 + ai * 128 + m * 16 + fr];
                    const f32x4 g = acc[ai][0][m][n] * rsm, v = acc[ai][1][m][n] * rsm;
                    float o[4];
                    asm volatile("" ::: "memory");
#pragma unroll
                    for (int e = 0; e < 4; ++e) {
                        const float g1 = DPP_SHR(DPP_MOV(pg[e], 0x121), g[e], 0x111), g2 = DPP_SHR(DPP_MOV(pg[e], 0x122), g[e], 0x112);
                        const float cg = taps[384 + fl + e] + taps[fl + e] * g2 + taps[128 + fl + e] * g1 + taps[256 + fl + e] * g[e];
                        o[e] = cg * __builtin_amdgcn_rcpf(1.f + __expf(-cg));
                    }
                    {
#pragma unroll
                        for (int e = 0; e < 4; ++e) {
                            const float v1 = DPP_SHR(DPP_MOV(pv[e], 0x121), v[e], 0x111), v2 = DPP_SHR(DPP_MOV(pv[e], 0x122), v[e], 0x112);
                            o[e] *= taps[896 + fl + e] + taps[512 + fl + e] * v2 + taps[640 + fl + e] * v1 + taps[768 + fl + e] * v[e];
                        }
                        asm volatile("" ::: "memory");
                    }
                    const int tr = wr * 64 + ai * 128 + m * 16 + fr;
                    if (prompt) {
                        u32x2 w; w.x = cvt_pk(o[0], o[1]); w.y = cvt_pk(o[2], o[3]);
                        *(u32x2*)((char*)ACT + ((unsigned)row * (unsigned)FF + (unsigned)f) * 2u) = w;
                    }
                    if (prompt ? (tr < 2 || tr >= 254) : tr < MS) {
                        const int er = prompt ? u.pm * 4 + (tr < 2 ? tr : tr - 252) : 128 + tr;
                        float* ed = (float*)((char*)EDGE + ((unsigned)er * (unsigned)FF2 + (unsigned)f) * 4u);
                        *(f32x4*)ed = g; *(f32x4*)(ed + FF) = v;
                    }
                    pg = g; pv = v;
                }
            }
        }
    }
#undef UPF_RS
};
#ifndef MK_P11_SCALE
#define MK_P11_SCALE 1.0f
#endif
struct EpiDn {
    float* X1;
    DI void operator()(const AccT& acc, const pg8::Unit& u, int wr, int wc, int fr, int fq) const {
        const int row0 = u.pm * 256 + wr * 64 + fr, col0 = u.pn * 256 + wc * 32 + 4 * fq;
#pragma unroll
        for (int ai = 0; ai < 2; ++ai) {
            f32x4 xr[4][2][2];
#pragma unroll
            for (int m = 0; m < 4; ++m)
#pragma unroll
                for (int bj = 0; bj < 2; ++bj)
#pragma unroll
                    for (int n = 0; n < 2; ++n) xr[m][bj][n] = *(const f32x4*)(X1 + (size_t)(row0 + ai * 128 + m * 16) * D + col0 + bj * 128 + n * 16);
            asm volatile("" ::: "memory");
#pragma unroll
            for (int m = 0; m < 4; ++m)
#pragma unroll
                for (int bj = 0; bj < 2; ++bj)
#pragma unroll
                    for (int n = 0; n < 2; ++n) *(f32x4*)(X1 + (size_t)(row0 + ai * 128 + m * 16) * D + col0 + bj * 128 + n * 16) = xr[m][bj][n] + acc[ai][bj][m][n] * MK_P11_SCALE;
            asm volatile("" ::: "memory");
        }
    }
};

template <bool UPPERM = false>
DI void transpose_item(const float* W, int K, int N, bf16_t* WT, int ldt, float* scr, int item, int lane) {
    const int nblk = N / 32, kb = item / nblk, nb = item % nblk, k0 = 64 * kb, n0 = 32 * nb;
    const int d0 = UPPERM ? (((n0 < FF ? n0 : n0 - FF) >> 7) * 256 + (n0 < FF ? 0 : 128) + ((n0 < FF ? n0 : n0 - FF) & 127)) : n0;
    {
        f32x4 v[8];
#pragma unroll
        for (int i = 0; i < 8; ++i) v[i] = *(const f32x4*)(W + (size_t)(k0 + 8 * i + (lane >> 3)) * N + n0 + 4 * (lane & 7));
#pragma unroll
        for (int i = 0; i < 8; ++i) { float* d = scr + (8 * i + (lane >> 3)) * 33 + 4 * (lane & 7); d[0] = v[i].x; d[1] = v[i].y; d[2] = v[i].z; d[3] = v[i].w; }
    }
    __builtin_amdgcn_fence(__ATOMIC_RELEASE, "wavefront"); asm volatile("s_waitcnt lgkmcnt(0)" ::: "memory");
    const int c = lane & 7;
#pragma unroll
    for (int j = 0; j < 4; ++j) { const int n = (lane >> 3) + 8 * j; const float* s = scr + (8 * c) * 33 + n;
        u32x4 o; o.x = pk2(s[0 * 33], s[1 * 33]); o.y = pk2(s[2 * 33], s[3 * 33]); o.z = pk2(s[4 * 33], s[5 * 33]); o.w = pk2(s[6 * 33], s[7 * 33]);
        *(u32x4*)(WT + (size_t)(d0 + n) * ldt + k0 + 8 * c) = o; }
    asm volatile("s_waitcnt lgkmcnt(0)" ::: "memory");
}
DI void rms_row_bf16(const float* xrow, const float* g, bf16_t* orow, int lane) {
    const f32x4* xr = (const f32x4*)xrow + lane; const f32x4* gr = (const f32x4*)g + lane;
    f32x4 v[8]; float s = 0.f;
#pragma unroll
    for (int j = 0; j < 8; ++j) { v[j] = xr[64 * j]; s += (v[j].x * v[j].x + v[j].y * v[j].y) + (v[j].z * v[j].z + v[j].w * v[j].w); }
    const float rstd = rsqrtf(wave_sum(s) * (1.f / D) + 1e-6f);
    u32x2* o8 = (u32x2*)orow + lane;
    f32x4 ggs[8];
#pragma unroll
    for (int j = 0; j < 8; ++j) ggs[j] = gr[64 * j];
#pragma unroll
    for (int j = 0; j < 8; ++j) { const f32x4 gg = ggs[j]; u32x2 w; w.x = pk2(v[j].x * rstd * gg.x, v[j].y * rstd * gg.y); w.y = pk2(v[j].z * rstd * gg.z, v[j].w * rstd * gg.w); o8[64 * j] = w; }
}
DI void rms_row_f32(const float* xrow, const float* g, float* orow, int lane) {
    const f32x4* xr = (const f32x4*)xrow + lane; const f32x4* gr = (const f32x4*)g + lane;
    f32x4 v[8]; float s = 0.f;
#pragma unroll
    for (int j = 0; j < 8; ++j) { v[j] = xr[64 * j]; s += (v[j].x * v[j].x + v[j].y * v[j].y) + (v[j].z * v[j].z + v[j].w * v[j].w); }
    const float rstd = rsqrtf(wave_sum(s) * (1.f / D) + 1e-6f);
    f32x4* o = (f32x4*)orow + lane;
    f32x4 ggs[8];
#pragma unroll
    for (int j = 0; j < 8; ++j) ggs[j] = gr[64 * j];
#pragma unroll
    for (int j = 0; j < 8; ++j) o[64 * j] = v[j] * rstd * ggs[j];
}
DI void zero_row_bf16(bf16_t* orow, int ncols, int lane) {
    for (int c = lane * 8; c < ncols; c += 512) *(u32x4*)(orow + c) = (u32x4){0u, 0u, 0u, 0u};
}

DI void phase_prologue(const Args& a, unsigned char* lds, int gw, int ngw, int lane, int wave) {
    unsigned char* ws = a.ws;
    float* scr = (float*)(lds + wave * 16384);
    bf16_t* Win = (bf16_t*)(ws + WS_WIN); bf16_t* Wlo = (bf16_t*)(ws + WS_WLO);
    constexpr int IT_IN = (D / 64) * (CIN / 32);
    for (int it = gw; it < IT_IN; it += ngw) transpose_item(a.in[I_WIN], D, CIN, Win, D, scr, it, lane);
    for (int r = CIN + gw; r < NIN; r += ngw) zero_row_bf16(Win + (size_t)r * D, D, lane);
    {
        const int gt = gw * 64 + lane, ngt = ngw * 64;
        for (int i = gt; i < NLO * KLO; i += ngt) {
            const int n = i / KLO, k = i % KLO; float v = 0.f;
            if (n < 1024) { if (k < 64) v = a.in[I_WUP][k * 1024 + n]; }
            else if (n < 2048) { if (k >= 64 && k < 128) v = a.in[I_AUP][(k - 64) * 1024 + (n - 1024)]; }
            else { if (k >= 128 && k < 288) v = a.in[I_GUP][(k - 128) * 1024 + (n - 2048)]; }
            Wlo[i] = (bf16_t)bf_rne(v);
        }
    }
    { float* RSS = (float*)(ws + WS_RSS); for (int i = gw * 64 + lane; i < MPAD; i += ngw * 64) RSS[i] = 0.f; }
    bf16_t* H = (bf16_t*)(ws + WS_H);
    for (int m = gw; m < MPAD; m += ngw) {
        if (m < MT) rms_row_bf16(m < MP ? a.in[I_XP] + (size_t)m * D : a.in[I_XS] + (size_t)(m - MP) * D, a.in[I_NMG], H + (size_t)m * D, lane);
        else zero_row_bf16(H + (size_t)m * D, D, lane);
    }
}


DI void convert_wo_wup(const Args& a, unsigned char* lds, int wi, int nw, int wave, int lane) {
    float* scr = (float*)(lds + wave * 16384);
    constexpr int IT_O = (D / 64) * (D / 32), IT_UP = (D / 64) * (FF2 / 32);
    for (int it = wi; it < IT_O + IT_UP; it += nw) {
        if (it < IT_O) transpose_item(a.in[I_WO], D, D, (bf16_t*)(a.ws + WS_WO), D, scr, it, lane);
        else transpose_item<true>(a.in[I_FUP], D, FF2, (bf16_t*)(a.ws + WS_WUP), D, scr, it - IT_O, lane);
    }
}
DI void convert_wdn(const Args& a, unsigned char* lds, int wi, int nw, int wave, int lane) {
    float* scr = (float*)(lds + wave * 16384);
    constexpr int IT_DN = (FF / 64) * (D / 32);
    for (int it = wi; it < IT_DN; it += nw) transpose_item(a.in[I_FDN], FF, D, (bf16_t*)(a.ws + WS_WDN), FF, scr, it, lane);
}

DI float rw_prev_val(const Args& a, const bf16_t* RW, int m, int j) {
    if (m < MP) return (m & (SEQ - 1)) == 0 ? 0.f : bf2f(RW[(size_t)(m - 1) * CSH + j]);
    return a.in[I_SSH][(size_t)(m - MP) * CSH + j];
}
DI void lora_input_row(const Args& a, int m, int lane) {
    bf16_t* ALO = (bf16_t*)(a.ws + WS_ALO) + (size_t)m * KLO;
    if (m >= MT) { for (int c = lane; c < KLO; c += 64) ALO[c] = 0; return; }
    const bf16_t* RW = (const bf16_t*)(a.ws + WS_RW);
    const bf16_t* cur = RW + (size_t)m * CSH;
    float x[5], p[5], mu[5];
#pragma unroll
    for (int i = 0; i < 5; ++i) {
        const int c = lane + 64 * i; const bool ok = c < 288; const int j = 3072 + (ok ? c : 0);
        x[i] = bf2f(cur[j]); mu[i] = a.in[I_MU][j];
        p[i] = m < MP ? ((m & (SEQ - 1)) == 0 ? 0.f : bf2f(RW[(size_t)(m - 1) * CSH + j])) : a.in[I_SSH][(size_t)(m - MP) * CSH + j];
    }
#pragma unroll
    for (int i = 0; i < 6; ++i) {
        const int c = lane + 64 * i; float v = 0.f;
        if (i < 5 && c < 288) {
            const float xs = x[i < 5 ? i : 0] + mu[i < 5 ? i : 0] * (p[i < 5 ? i : 0] - x[i < 5 ? i : 0]);
            v = c < 64 ? 1.f - 2.f * __builtin_amdgcn_rcpf(1.f + __expf(2.f * xs)) : (c < 128 ? xs : __builtin_amdgcn_rcpf(1.f + __expf(-xs)));
        }
        ALO[c] = (bf16_t)bf_rne(v);
    }
}

DI int crow(int reg, int h) { return (reg & 3) + 8 * (reg >> 2) + 4 * h; }
typedef short s16x4 __attribute__((ext_vector_type(4)));
constexpr int VPITCH = 192;
DI void attn_prompt_unit(const Args& a, unsigned char* lds, int unit, int wave, int lane) {
    const bf16_t* Qb = (const bf16_t*)(a.ws + WS_QB); const bf16_t* Kb = (const bf16_t*)(a.ws + WS_KB); const bf16_t* Vb = (const bf16_t*)(a.ws + WS_VB);
    bf16_t* PO = (bf16_t*)(a.ws + WS_PART); float* PML = (float*)(a.ws + WS_PML);
    LAS unsigned char* img = (LAS unsigned char*)lds + wave * (32 * VPITCH);
    const int blk = unit & 63, br = (unit >> 6) % 3, bh = unit / 192, b = bh >> 4, h = bh & 15;
    const int rate = br == 0 ? 1 : (br == 1 ? 4 : 16), L = SEQ / rate, bpc = L / 32;
    const int rho = blk / bpc, l0 = (blk % bpc) * 32;
    const int r = lane & 31, hh = lane >> 5;
    const int mq = b * SEQ + rho + rate * (l0 + r);
    bf16x8 qf[4];
#pragma unroll
    for (int ks = 0; ks < 4; ++ks) qf[ks] = *(const bf16x8*)(Qb + ((size_t)bh * SEQ + rho + rate * (l0 + r)) * 64 + ks * 16 + 8 * hh);
    f32x16 o0, o1;
#pragma unroll
    for (int i = 0; i < 16; ++i) { o0[i] = 0.f; o1[i] = 0.f; }
    float mrun = -1e30f, lrun = 0.f;
    const int lq = l0 + r;
    const int c0 = l0 >= 128 ? 0 : (128 - l0) >> 5;
    const bf16_t* kbase = Kb + ((size_t)bh * SEQ + rho) * 64 + 8 * hh;
    const bf16_t* vbase = Vb + ((size_t)bh * SEQ + rho) * 64 + 8 * (lane & 7);
    bf16x8 kreg[4]; u32x4 vreg[4];
#define AT_PREFETCH(ch_) do { const int lk0_ = l0 - 128 + 32 * (ch_); \
        _Pragma("unroll") for (int ks = 0; ks < 4; ++ks) kreg[ks] = *(const bf16x8*)(kbase + (size_t)(rate * (lk0_ + r)) * 64 + ks * 16); \
        _Pragma("unroll") for (int i = 0; i < 4; ++i) vreg[i] = *(const u32x4*)(vbase + (size_t)(rate * (lk0_ + 8 * i + (lane >> 3))) * 64); } while (0)
    AT_PREFETCH(c0);
    const int i16 = lane & 15, tq = i16 >> 2, tp = i16 & 3, g16 = (lane >> 4) & 1;
    const unsigned troff = (unsigned)((4 * hh + tq) * VPITCH + g16 * 32 + 8 * tp);
    for (int ch = c0; ch < 5; ++ch) {
        const int lk0 = l0 - 128 + 32 * ch;
        bf16x8 kf[4];
#pragma unroll
        for (int ks = 0; ks < 4; ++ks) kf[ks] = kreg[ks];
#pragma unroll
        for (int i = 0; i < 4; ++i) *(LAS u32x4*)(img + (8 * i + (lane >> 3)) * VPITCH + 16 * (lane & 7)) = vreg[i];
        if (ch + 1 < 5) AT_PREFETCH(ch + 1);
        f32x16 st;
#pragma unroll
        for (int i = 0; i < 16; ++i) st[i] = 0.f;
#pragma unroll
        for (int ks = 0; ks < 4; ++ks) st = __builtin_amdgcn_mfma_f32_32x32x16_bf16(kf[ks], qf[ks], st, 0, 0, 0);
        float cmax = -1e30f;
        if (ch == 0 || ch == 4) {
#pragma unroll
            for (int i = 0; i < 16; ++i) { const int lk = lk0 + crow(i, hh); const bool ok = (lk <= lq) && (lk >= lq - 128); st[i] = ok ? st[i] : -1e30f; }
        }
#pragma unroll
        for (int i = 0; i < 16; ++i) cmax = fmaxf(cmax, st[i]);
        cmax = fmaxf(cmax, __shfl_xor(cmax, 32));
        const float mnew = fmaxf(mrun, cmax), alpha = __builtin_amdgcn_exp2f(mrun - mnew);
        float ps = 0.f;
#pragma unroll
        for (int i = 0; i < 16; ++i) { const float p = __builtin_amdgcn_exp2f(st[i] - mnew); st[i] = p; ps += p; }
        lrun = lrun * alpha + ps; mrun = mnew;
#pragma unroll
        for (int i = 0; i < 16; ++i) { o0[i] *= alpha; o1[i] *= alpha; }
#pragma unroll
        for (int s = 0; s < 2; ++s) {
            u32x4 pp; pp.x = pk2(st[8 * s], st[8 * s + 1]); pp.y = pk2(st[8 * s + 2], st[8 * s + 3]); pp.z = pk2(st[8 * s + 4], st[8 * s + 5]); pp.w = pk2(st[8 * s + 6], st[8 * s + 7]);
            const bf16x8 pf = __builtin_bit_cast(bf16x8, pp);
#pragma unroll
            for (int dt = 0; dt < 2; ++dt) {
                const s16x4 lo = __builtin_amdgcn_ds_read_tr16_b64_v4i16((LAS s16x4*)(img + troff + (16 * s) * VPITCH + dt * 64));
                const s16x4 hi = __builtin_amdgcn_ds_read_tr16_b64_v4i16((LAS s16x4*)(img + troff + (16 * s + 8) * VPITCH + dt * 64));
                const bf16x8 vf = __builtin_shufflevector(lo, hi, 0, 1, 2, 3, 4, 5, 6, 7);
                if (dt == 0) o0 = __builtin_amdgcn_mfma_f32_32x32x16_bf16(vf, pf, o0, 0, 0, 0);
                else o1 = __builtin_amdgcn_mfma_f32_32x32x16_bf16(vf, pf, o1, 0, 0, 0);
            }
        }
    }
#undef AT_PREFETCH
    const float ltot = lrun + __shfl_xor(lrun, 32);
    bf16_t* po = PO + ((size_t)br * MP + mq) * 1024 + h * 64;
#pragma unroll
    for (int g = 0; g < 4; ++g) {
        u32x2 w0, w1; w0.x = pk2(o0[4 * g], o0[4 * g + 1]); w0.y = pk2(o0[4 * g + 2], o0[4 * g + 3]); w1.x = pk2(o1[4 * g], o1[4 * g + 1]); w1.y = pk2(o1[4 * g + 2], o1[4 * g + 3]);
        *(u32x2*)(po + 8 * g + 4 * hh) = w0; *(u32x2*)(po + 32 + 8 * g + 4 * hh) = w1;
    }
    if (hh == 0) { float* pm = PML + (((size_t)br * MP + mq) * 16 + h) * 2; pm[0] = mrun; pm[1] = ltot; }
}
DI float sum16(float v) { v = DPP_ADD(v, 0xB1); v = DPP_ADD(v, 0x4E); v = DPP_ADD(v, 0x141); v = DPP_ADD(v, 0x140); return v; }
DI void attn_merge_task(const Args& a, int task, int lane) {
    const int m = task >> 2, h = (task & 3) * 4 + (lane >> 4), d = 4 * (lane & 15);
    const bf16_t* PO = (const bf16_t*)(a.ws + WS_PART); const float* PML = (const float*)(a.ws + WS_PML);
    bf16_t* O = (bf16_t*)(a.ws + WS_O);
    float mb[3], lb[3]; f32x4 ob[3];
#pragma unroll
    for (int br = 0; br < 3; ++br) { const float* pm = PML + (((size_t)br * MP + m) * 16 + h) * 2; mb[br] = pm[0]; lb[br] = pm[1];
        const u32x2 w = *(const u32x2*)(PO + ((size_t)br * MP + m) * 1024 + h * 64 + d);
        ob[br] = (f32x4){__uint_as_float(w.x << 16), __uint_as_float(w.x & 0xffff0000u), __uint_as_float(w.y << 16), __uint_as_float(w.y & 0xffff0000u)}; }
    const float M = fmaxf(mb[0], fmaxf(mb[1], mb[2]));
    f32x4 num = {0.f, 0.f, 0.f, 0.f}; float den = 0.f;
#pragma unroll
    for (int br = 0; br < 3; ++br) { const float w = __builtin_amdgcn_exp2f(mb[br] - M); num += ob[br] * w; den += w * lb[br]; }
    const f32x4 o = num * __builtin_amdgcn_rcpf(den);
    const float ss = sum16(o.x * o.x + o.y * o.y + o.z * o.z + o.w * o.w) * (1.f / 64.f);
    const float rs = rsqrtf(ss + 1e-6f);
    const f32x4 gg = *(const f32x4*)(a.in[I_AOG] + h * 64 + d);
    u32x2 w; w.x = pk2(o.x * rs * gg.x, o.y * rs * gg.y); w.y = pk2(o.z * rs * gg.z, o.w * rs * gg.w);
    *(u32x2*)(O + (size_t)m * D + h * 64 + d) = w;
}
DI void attn_sample_wg(const Args& a, unsigned char* lds, int unit, int wave, int lane) {
    float* part = (float*)lds;
    const int bh = unit * 2 + (wave >> 2), qt = wave & 3, b = bh >> 4, h = bh & 15, g = lane >> 4, l16 = lane & 15;
    const bf16_t* Qb = (const bf16_t*)(a.ws + WS_QB);
    const float* ck = a.in[I_CK] + (size_t)b * 2048 * 1024 + h * 64 + 4 * l16; const float* cv = a.in[I_CV] + (size_t)b * 2048 * 1024 + h * 64 + 4 * l16;
    const float* nk = a.out + O_SK + (size_t)b * 1024 + h * 64 + 4 * l16; const float* nv = a.out + O_SV + (size_t)b * 1024 + h * 64 + 4 * l16;
    const u32x2 qw = *(const u32x2*)(Qb + (size_t)(MP + b) * 1024 + h * 64 + 4 * l16);
    const float q0 = __uint_as_float(qw.x << 16), q1 = __uint_as_float(qw.x & 0xffff0000u), q2 = __uint_as_float(qw.y << 16), q3 = __uint_as_float(qw.y & 0xffff0000u);
    float mrun = -1e30f, lrun = 0.f; f32x4 acc = {0.f, 0.f, 0.f, 0.f};
    const int e0 = qt * 97, e1 = e0 + 97 < 387 ? e0 + 97 : 387;
    for (int ito = 0; ito < 25; ito += 5) {
        f32x4 kv[5], vv[5]; bool valid[5];
#pragma unroll
        for (int k = 0; k < 5; ++k) {
            const int e = e0 + (ito + k) * 4 + g; valid[k] = e < e1;
            const int ee = valid[k] ? e : e0, br = ee / 129, j = ee % 129, rate = br == 0 ? 1 : (br == 1 ? 4 : 16);
            const int row = 2048 - rate * j;
            const float* kp = j == 0 ? nk : ck + (size_t)row * 1024; const float* vp = j == 0 ? nv : cv + (size_t)row * 1024;
            kv[k] = *(const f32x4*)kp; vv[k] = *(const f32x4*)vp;
        }
#pragma unroll
        for (int k = 0; k < 5; ++k) {
            float s = sum16(q0 * kv[k].x + q1 * kv[k].y + q2 * kv[k].z + q3 * kv[k].w);
            if (!valid[k]) s = -1e30f;
            const float mnew = fmaxf(mrun, s), alpha = __builtin_amdgcn_exp2f(mrun - mnew), p = valid[k] ? __builtin_amdgcn_exp2f(s - mnew) : 0.f;
            lrun = lrun * alpha + p; acc = acc * alpha + vv[k] * p; mrun = mnew;
        }
    }
#pragma unroll
    for (int o = 16; o < 64; o <<= 1) {
        const float mo = __shfl_xor(mrun, o), lo = __shfl_xor(lrun, o);
        f32x4 ao; ao.x = __shfl_xor(acc.x, o); ao.y = __shfl_xor(acc.y, o); ao.z = __shfl_xor(acc.z, o); ao.w = __shfl_xor(acc.w, o);
        const float mn = fmaxf(mrun, mo), w0 = __builtin_amdgcn_exp2f(mrun - mn), w1 = __builtin_amdgcn_exp2f(mo - mn);
        lrun = lrun * w0 + lo * w1; acc = acc * w0 + ao * w1; mrun = mn;
    }
    if (g == 0) { *(f32x4*)(part + wave * 68 + 4 * l16) = acc; if (l16 == 0) { part[wave * 68 + 64] = mrun; part[wave * 68 + 65] = lrun; } }
    __syncthreads();
    if (qt == 0 && g == 0) {
        float M = -1e30f;
#pragma unroll
        for (int w = 0; w < 4; ++w) M = fmaxf(M, part[(wave + w) * 68 + 64]);
        f32x4 num = {0.f, 0.f, 0.f, 0.f}; float den = 0.f;
#pragma unroll
        for (int w = 0; w < 4; ++w) { const float wt = __builtin_amdgcn_exp2f(part[(wave + w) * 68 + 64] - M); num += *(const f32x4*)(part + (wave + w) * 68 + 4 * l16) * wt; den += part[(wave + w) * 68 + 65] * wt; }
        const f32x4 o = num * (1.f / den);
        const float ss = sum16(o.x * o.x + o.y * o.y + o.z * o.z + o.w * o.w);
        const float rs = rsqrtf(ss * (1.f / 64.f) + 1e-6f);
        const f32x4 gg = *(const f32x4*)(a.in[I_AOG] + h * 64 + 4 * l16);
        u32x2 w; w.x = pk2(o.x * rs * gg.x, o.y * rs * gg.y); w.y = pk2(o.z * rs * gg.z, o.w * rs * gg.w);
        *(u32x2*)((bf16_t*)(a.ws + WS_O) + (size_t)(MP + b) * D + h * 64 + 4 * l16) = w;
    }
    __syncthreads();
}

struct PrepParams { float mu_r, mu_k, mu_v, w0, a0, kk, ka, rk; };
struct PrepRaw { float cr, ck, cv, pr, pk, pv, lw, la, lg; };
DI void prep_params(const Args& a, PrepParams& P, int c) {
    P.mu_r = a.in[I_MU][c]; P.mu_k = a.in[I_MU][1024 + c]; P.mu_v = a.in[I_MU][2048 + c];
    P.w0 = a.in[I_W0][c]; P.a0 = a.in[I_A0][c]; P.kk = a.in[I_KK][c]; P.ka = a.in[I_KA][c]; P.rk = a.in[I_RK][c];
}
DI void prep_load(const Args& a, PrepRaw& R, const bf16_t* RW, int m, const bf16_t* Lrow, int c) {
    const bf16_t* cur = RW + (size_t)m * CSH;
    R.cr = bf2f(cur[c]); R.ck = bf2f(cur[1024 + c]); R.cv = bf2f(cur[2048 + c]);
    R.pr = rw_prev_val(a, RW, m, c); R.pk = rw_prev_val(a, RW, m, 1024 + c); R.pv = rw_prev_val(a, RW, m, 2048 + c);
    R.lw = bf2f(Lrow[c]); R.la = bf2f(Lrow[1024 + c]); R.lg = bf2f(Lrow[2048 + c]);
}
DI void prep_finish(const PrepRaw& R, const PrepParams& P, float* dst, float& g_out, float& bonus_out, int lane) {
    const float xr = R.cr + P.mu_r * (R.pr - R.cr), xk = R.ck + P.mu_k * (R.pk - R.ck), xv = R.cv + P.mu_v * (R.pv - R.cv);
    const float x = -(P.w0 + R.lw);
    const float sp = x > 20.f ? x : __logf(1.f + __expf(x));
    const float decay = __expf(-__expf(-sp - 0.5f));
    const float av = __builtin_amdgcn_rcpf(1.f + __expf(-(P.a0 + R.la)));
    float kkv = xk * P.kk;
    const float n2 = wave_sum(kkv * kkv);
    kkv = kkv * fminf(__builtin_amdgcn_rsqf(n2), 1e12f);
    const float keff = xk * (1.f + (av - 1.f) * P.ka);
    const float bon = wave_sum(xr * keff * P.rk) * xv;
    dst[lane] = xr; dst[64 + lane] = decay; dst[128 + lane] = keff; dst[192 + lane] = xv; dst[256 + lane] = -kkv; dst[320 + lane] = kkv * av;
    g_out = R.lg; bonus_out = bon;
}
DI float scan_step(float (&S)[64], const float* sv, float vi) {
    const f32x4* r4 = (const f32x4*)sv; const f32x4* w4 = (const f32x4*)(sv + 64); const f32x4* k4 = (const f32x4*)(sv + 128);
    const f32x4* a4 = (const f32x4*)(sv + 256); const f32x4* b4 = (const f32x4*)(sv + 320);
    float sa0 = 0.f, sa1 = 0.f;
#pragma unroll
    for (int j = 0; j < 16; ++j) { const f32x4 av = a4[j]; sa0 = fmaf(S[4 * j], av.x, sa0); sa1 = fmaf(S[4 * j + 1], av.y, sa1); sa0 = fmaf(S[4 * j + 2], av.z, sa0); sa1 = fmaf(S[4 * j + 3], av.w, sa1); }
    const float sa = sa0 + sa1;
    float y0 = 0.f, y1 = 0.f;
#pragma unroll
    for (int j = 0; j < 16; ++j) {
        const f32x4 bv = b4[j], kv = k4[j], wv = w4[j], rv = r4[j];
        float t;
        t = fmaf(vi, kv.x, sa * bv.x); S[4 * j] = fmaf(S[4 * j], wv.x, t); y0 = fmaf(S[4 * j], rv.x, y0);
        t = fmaf(vi, kv.y, sa * bv.y); S[4 * j + 1] = fmaf(S[4 * j + 1], wv.y, t); y1 = fmaf(S[4 * j + 1], rv.y, y1);
        t = fmaf(vi, kv.z, sa * bv.z); S[4 * j + 2] = fmaf(S[4 * j + 2], wv.z, t); y0 = fmaf(S[4 * j + 2], rv.z, y0);
        t = fmaf(vi, kv.w, sa * bv.w); S[4 * j + 3] = fmaf(S[4 * j + 3], wv.w, t); y1 = fmaf(S[4 * j + 3], rv.w, y1);
        if ((j & 3) == 3) asm volatile("" ::: "memory");
    }
    return y0 + y1;
}
DI void rwkv_post(const Args& a, float y, float g, float bonus, int m, int c) {
    const float mean = wave_sum(y) * (1.f / 64.f); const float d = y - mean; const float var = wave_sum(d * d) * (1.f / 64.f);
    const float yn = d * rsqrtf(var + 64e-5f) * a.in[I_LNW][c] + a.in[I_LNB][c];
    ((bf16_t*)(a.ws + WS_O))[(size_t)m * D + 1024 + c] = (bf16_t)bf_rne((yn + bonus) * g);
}

#define WG_BAR_LDS() do { asm volatile("s_waitcnt lgkmcnt(0)" ::: "memory"); __builtin_amdgcn_s_barrier(); asm volatile("" ::: "memory"); } while (0)
typedef float f32x2 __attribute__((ext_vector_type(2)));
DI f32x2 fma2(f32x2 a, f32x2 b, f32x2 c) { return __builtin_elementwise_fma(a, b, c); }
DI void scan_dot_a(const f32x2 (&Z)[32], const f32x2 (&P)[32], const float* sv, float& sz, float& sp) {
    const f32x4* a4 = (const f32x4*)(sv + 256);
    f32x2 saz = {0.f, 0.f}, sap = {0.f, 0.f};
#pragma unroll
    for (int j = 0; j < 16; ++j) { const f32x4 av = a4[j]; const f32x2 a0 = {av.x, av.y}, a1 = {av.z, av.w};
        saz = fma2(Z[2 * j], a0, saz); sap = fma2(P[2 * j], a0, sap); saz = fma2(Z[2 * j + 1], a1, saz); sap = fma2(P[2 * j + 1], a1, sap);
        if ((j & 7) == 7) asm volatile("" ::: "memory"); }
    sz = saz.x + saz.y; sp = sap.x + sap.y;
}
DI void scan_step3(f32x2 (&Z)[32], f32x2 (&P)[32], const float* sv, const float* svn, float vi, float& sz, float& sp, float& yz, float& yp) {
    const f32x4* r4 = (const f32x4*)sv; const f32x4* w4 = (const f32x4*)(sv + 64); const f32x4* k4 = (const f32x4*)(sv + 128);
    const f32x4* b4 = (const f32x4*)(sv + 320); const f32x4* an4 = (const f32x4*)(svn + 256);
    const f32x2 sz2 = {sz, sz}, sp2 = {sp, sp}, v2 = {vi, vi};
    f32x2 yz2 = {0.f, 0.f}, yp2 = {0.f, 0.f}, nz2 = {0.f, 0.f}, np2 = {0.f, 0.f};
    f32x4 buf[3][5];
#define S3_LD(g, j) do { buf[g][0] = b4[j]; buf[g][1] = k4[j]; buf[g][2] = w4[j]; buf[g][3] = r4[j]; buf[g][4] = an4[j]; asm volatile("" ::: "memory"); } while (0)
    S3_LD(0, 0); S3_LD(1, 1);
#pragma unroll
    for (int j = 0; j < 16; ++j) {
        if (j + 2 < 16) S3_LD((j + 2) % 3, j + 2);
        const f32x4 bv = buf[j % 3][0], kv = buf[j % 3][1], wv = buf[j % 3][2], rv = buf[j % 3][3], av = buf[j % 3][4];
        { const f32x2 b2 = {bv.x, bv.y}, k2 = {kv.x, kv.y}, w2 = {wv.x, wv.y}, r2 = {rv.x, rv.y}, a2 = {av.x, av.y};
          f32x2 tz = sz2 * b2; tz = fma2(v2, k2, tz); Z[2 * j] = fma2(Z[2 * j], w2, tz); yz2 = fma2(Z[2 * j], r2, yz2); nz2 = fma2(Z[2 * j], a2, nz2);
          const f32x2 tp = sp2 * b2; P[2 * j] = fma2(P[2 * j], w2, tp); yp2 = fma2(P[2 * j], r2, yp2); np2 = fma2(P[2 * j], a2, np2); }
        { const f32x2 b2 = {bv.z, bv.w}, k2 = {kv.z, kv.w}, w2 = {wv.z, wv.w}, r2 = {rv.z, rv.w}, a2 = {av.z, av.w};
          f32x2 tz = sz2 * b2; tz = fma2(v2, k2, tz); Z[2 * j + 1] = fma2(Z[2 * j + 1], w2, tz); yz2 = fma2(Z[2 * j + 1], r2, yz2); nz2 = fma2(Z[2 * j + 1], a2, nz2);
          const f32x2 tp = sp2 * b2; P[2 * j + 1] = fma2(P[2 * j + 1], w2, tp); yp2 = fma2(P[2 * j + 1], r2, yp2); np2 = fma2(P[2 * j + 1], a2, np2); }
        asm volatile("" ::: "memory");
    }
#undef S3_LD
    yz = yz2.x + yz2.y; yp = yp2.x + yp2.y; sz = nz2.x + nz2.y; sp = np2.x + np2.y;
}
DI void scan_pass1_unit(const Args& a, unsigned char* lds, int unit, int wave, int lane) {
    float* stg = (float*)lds;
    const int pp = wave & 3, pair = unit * 4 + pp, chain = pair / NS, seg = pair % NS, b = chain >> 4, h = chain & 15, c = h * 64 + lane;
    const int mbase = b * SEQ + seg * SEGL;
    constexpr int NB = SEGL / TB;
    if (wave < 4) {
        bf16_t* YL = (bf16_t*)(a.ws + WS_YL); bf16_t* QS = (bf16_t*)(a.ws + WS_QS); float* ZP = (float*)(a.ws + WS_ZP);
        f32x2 Z[32], P[32];
        int idl = lane; asm volatile("" : "+v"(idl));
#pragma unroll
        for (int j = 0; j < 32; ++j) { Z[j] = (f32x2){0.f, 0.f}; P[j] = (f32x2){idl == 2 * j ? 1.f : 0.f, idl == 2 * j + 1 ? 1.f : 0.f}; }
        WG_BAR_LDS();
        for (int blk = 0; blk < NB; ++blk) {
            const float* sb = stg + (((blk & 1) * 4 + pp) * TB) * 384;
            float sz, sp; scan_dot_a(Z, P, sb, sz, sp);
#pragma unroll 1
            for (int tt = 0; tt < TB; ++tt) {
                const float* sv = sb + tt * 384; const float* svn = sb + (tt + 1 < TB ? tt + 1 : tt) * 384;
                float yz, yp; scan_step3(Z, P, sv, svn, sv[192 + lane], sz, sp, yz, yp);
                const size_t o = (size_t)(mbase + blk * TB + tt) * 1024 + c;
                const unsigned yq = pk2(yz, yp); YL[o] = (bf16_t)(yq & 0xffffu); QS[o] = (bf16_t)(yq >> 16);
            }
            WG_BAR_LDS();
        }
        float* zp = ZP + (size_t)pair * 2 * 4096 + lane * 64;
#pragma unroll
        for (int j = 0; j < 16; ++j) { *(f32x4*)(zp + 4 * j) = (f32x4){Z[2 * j].x, Z[2 * j].y, Z[2 * j + 1].x, Z[2 * j + 1].y};
                                       *(f32x4*)(zp + 4096 + 4 * j) = (f32x4){P[2 * j].x, P[2 * j].y, P[2 * j + 1].x, P[2 * j + 1].y}; }
    } else {
        const bf16_t* RW = (const bf16_t*)(a.ws + WS_RW); const bf16_t* Lb = (const bf16_t*)(a.ws + WS_L);
        bf16_t* GB = (bf16_t*)(a.ws + WS_GB);
        PrepParams Pm; prep_params(a, Pm, c);
        PrepRaw raw[TB];
#define P1_LOAD(blk_) do { _Pragma("unroll") for (int k = 0; k < TB; ++k) { const int m = mbase + (blk_) * TB + k; prep_load(a, raw[k], RW, m, Lb + (size_t)m * NLO, c); } } while (0)
#define P1_FINISH(blk_) do { _Pragma("unroll") for (int k = 0; k < TB; ++k) { const int m = mbase + (blk_) * TB + k; float g, bon; \
            prep_finish(raw[k], Pm, stg + ((((blk_) & 1) * 4 + pp) * TB + k) * 384, g, bon, lane); \
            GB[((size_t)m * 16 + h) * 128 + lane] = (bf16_t)bf_rne(g); GB[((size_t)m * 16 + h) * 128 + 64 + lane] = (bf16_t)bf_rne(bon); } } while (0)
        P1_LOAD(0); P1_FINISH(0); P1_LOAD(1);
        WG_BAR_LDS();
        for (int blk = 0; blk < NB; ++blk) {
            if (blk + 1 < NB) P1_FINISH(blk + 1);
            if (blk + 2 < NB) P1_LOAD(blk + 2);
            WG_BAR_LDS();
        }
#undef P1_LOAD
#undef P1_FINISH
    }
}
DI void scan_sample_unit(const Args& a, unsigned char* lds, int unit, int wave, int lane) {
    float* sv = (float*)(lds + 2 * 4 * TB * 384 * 4) + wave * 384;
    const bf16_t* RW = (const bf16_t*)(a.ws + WS_RW); const bf16_t* Lb = (const bf16_t*)(a.ws + WS_L);
    const int b = unit >> 4, h = unit & 15, c = h * 64 + lane, m = MP + b;
    PrepParams P; prep_params(a, P, c);
    PrepRaw raw; prep_load(a, raw, RW, m, Lb + (size_t)m * NLO, c);
    float g, bon; prep_finish(raw, P, sv, g, bon, lane);
    float S[64];
    const float* s0 = a.in[I_SWKV] + ((size_t)(b * 16 + h) * 64 + lane) * 64;
#pragma unroll
    for (int j = 0; j < 16; ++j) { const f32x4 v = *(const f32x4*)(s0 + 4 * j); S[4 * j] = v.x; S[4 * j + 1] = v.y; S[4 * j + 2] = v.z; S[4 * j + 3] = v.w; }
    const float y = scan_step(S, sv, sv[192 + lane]);
    float* so = a.out + O_SWKV + ((size_t)(b * 16 + h) * 64 + lane) * 64;
#pragma unroll
    for (int j = 0; j < 16; ++j) *(f32x4*)(so + 4 * j) = (f32x4){S[4 * j], S[4 * j + 1], S[4 * j + 2], S[4 * j + 3]};
    rwkv_post(a, y, g, bon, m, c);
}
DI void scan_pass2_unit(const Args& a, unsigned char* lds, int chain, int wave, int lane) {
    float* Ssh = (float*)lds;
    float* Psh = Ssh + 64 * 65;
    const float* ZP = (const float*)(a.ws + WS_ZP); float* SST = (float*)(a.ws + WS_SST);
    const int tid = wave * 64 + lane, l16 = lane & 15, lq = lane >> 4, ib = wave >> 1, jb0 = 2 * (wave & 1);
    f32x4 S0 = {0.f, 0.f, 0.f, 0.f}, S1 = {0.f, 0.f, 0.f, 0.f};
    const float* Z0 = ZP + (size_t)(chain * NS) * 2 * 4096;
    f32x4 pn0 = *(const f32x4*)(Z0 + 4096 + tid * 8), pn1 = *(const f32x4*)(Z0 + 4096 + tid * 8 + 4);
    float zn0[4], zn1[4];
#pragma unroll
    for (int i = 0; i < 4; ++i) { zn0[i] = Z0[(16 * ib + 4 * lq + i) * 64 + 16 * jb0 + l16]; zn1[i] = Z0[(16 * ib + 4 * lq + i) * 64 + 16 * (jb0 + 1) + l16]; }
    for (int s = 0; s < NS; ++s) {
        float* sst = SST + ((size_t)chain * NS + s) * 4096;
#pragma unroll
        for (int i = 0; i < 4; ++i) { const int row = 16 * ib + 4 * lq + i;
            sst[row * 64 + 16 * jb0 + l16] = S0[i]; sst[row * 64 + 16 * (jb0 + 1) + l16] = S1[i];
            Ssh[row * 65 + 16 * jb0 + l16] = S0[i]; Ssh[row * 65 + 16 * (jb0 + 1) + l16] = S1[i]; }
        *(f32x4*)(Psh + tid * 8) = pn0; *(f32x4*)(Psh + tid * 8 + 4) = pn1;
        f32x4 n0 = {zn0[0], zn0[1], zn0[2], zn0[3]}, n1 = {zn1[0], zn1[1], zn1[2], zn1[3]};
        if (s + 1 < NS) {
            const float* Zs = ZP + (size_t)(chain * NS + s + 1) * 2 * 4096;
            pn0 = *(const f32x4*)(Zs + 4096 + tid * 8); pn1 = *(const f32x4*)(Zs + 4096 + tid * 8 + 4);
#pragma unroll
            for (int i = 0; i < 4; ++i) { zn0[i] = Zs[(16 * ib + 4 * lq + i) * 64 + 16 * jb0 + l16]; zn1[i] = Zs[(16 * ib + 4 * lq + i) * 64 + 16 * (jb0 + 1) + l16]; }
        }
        WG_BAR_LDS();
        if (s > 0) {
#pragma unroll
            for (int kk = 0; kk < 16; ++kk) {
                const float af = Ssh[(16 * ib + l16) * 65 + 4 * kk + lq];
                const float b0 = Psh[(4 * kk + lq) * 64 + 16 * jb0 + l16], b1 = Psh[(4 * kk + lq) * 64 + 16 * (jb0 + 1) + l16];
                n0 = __builtin_amdgcn_mfma_f32_16x16x4f32(af, b0, n0, 0, 0, 0);
                n1 = __builtin_amdgcn_mfma_f32_16x16x4f32(af, b1, n1, 0, 0, 0);
            }
        }
        WG_BAR_LDS();
        S0 = n0; S1 = n1;
    }
    float* so = a.out + O_PWKV + (size_t)chain * 4096;
#pragma unroll
    for (int i = 0; i < 4; ++i) { const int row = 16 * ib + 4 * lq + i; so[row * 64 + 16 * jb0 + l16] = S0[i]; so[row * 64 + 16 * (jb0 + 1) + l16] = S1[i]; }
}
DI bf16x8 cvt8(const f32x4 lo, const f32x4 hi) { u32x4 p; p.x = pk2(lo.x, lo.y); p.y = pk2(lo.z, lo.w); p.z = pk2(hi.x, hi.y); p.w = pk2(hi.z, hi.w); return __builtin_bit_cast(bf16x8, p); }
DI void scan_pass3_unit(const Args& a, int unit, int lane) {
    const float* SST = (const float*)(a.ws + WS_SST); const bf16_t* YL = (const bf16_t*)(a.ws + WS_YL); const bf16_t* QS = (const bf16_t*)(a.ws + WS_QS); const bf16_t* GB = (const bf16_t*)(a.ws + WS_GB);
    bf16_t* O = (bf16_t*)(a.ws + WS_O);
    const int sub = unit & 3, pair = unit >> 2, chain = pair / NS, seg = pair % NS, b = chain >> 4, h = chain & 15;
    const int r = lane & 31, hh = lane >> 5;
    const int m = b * SEQ + seg * SEGL + sub * 32 + r;
    f32x16 acc0, acc1;
#pragma unroll
    for (int i = 0; i < 16; ++i) { acc0[i] = 0.f; acc1[i] = 0.f; }
    const bf16_t* qrow = QS + (size_t)m * 1024 + h * 64 + 8 * hh;
    const float* s0 = SST + (size_t)pair * 4096 + (size_t)r * 64 + 8 * hh; const float* s1 = s0 + 32 * 64;
#pragma unroll
    for (int ks = 0; ks < 4; ++ks) {
        const bf16x8 qf = *(const bf16x8*)(qrow + ks * 16);
        const bf16x8 a0 = cvt8(*(const f32x4*)(s0 + ks * 16), *(const f32x4*)(s0 + ks * 16 + 4));
        const bf16x8 a1 = cvt8(*(const f32x4*)(s1 + ks * 16), *(const f32x4*)(s1 + ks * 16 + 4));
        acc0 = __builtin_amdgcn_mfma_f32_32x32x16_bf16(a0, qf, acc0, 0, 0, 0);
        acc1 = __builtin_amdgcn_mfma_f32_32x32x16_bf16(a1, qf, acc1, 0, 0, 0);
    }
    const bf16_t* yl = YL + (size_t)m * 1024 + h * 64 + 4 * hh;
    float y[32]; float sum = 0.f;
#pragma unroll
    for (int rt = 0; rt < 2; ++rt)
#pragma unroll
        for (int g = 0; g < 4; ++g) { const u32x2 yw = *(const u32x2*)(yl + rt * 32 + 8 * g); const f32x4 v = {__uint_as_float(yw.x << 16), __uint_as_float(yw.x & 0xffff0000u), __uint_as_float(yw.y << 16), __uint_as_float(yw.y & 0xffff0000u)};
#pragma unroll
            for (int e = 0; e < 4; ++e) { const float yy = v[e] + (rt == 0 ? acc0[4 * g + e] : acc1[4 * g + e]); y[rt * 16 + 4 * g + e] = yy; sum += yy; } }
    sum += __shfl_xor(sum, 32);
    const float mean = sum * (1.f / 64.f);
    float vs = 0.f;
#pragma unroll
    for (int e = 0; e < 32; ++e) { y[e] -= mean; vs += y[e] * y[e]; }
    vs += __shfl_xor(vs, 32);
    const float rstd = rsqrtf(vs * (1.f / 64.f) + 64e-5f);
    const bf16_t* gb = GB + ((size_t)m * 16 + h) * 128 + 4 * hh;
    const float* lw = a.in[I_LNW] + h * 64 + 4 * hh; const float* lb = a.in[I_LNB] + h * 64 + 4 * hh;
    bf16_t* orow = O + (size_t)m * D + 1024 + h * 64 + 4 * hh;
    f32x4 w4s[8], b4s[8]; u32x2 gws[8], bws[8];
#pragma unroll
    for (int q = 0; q < 8; ++q) { const int off = (q >> 2) * 32 + 8 * (q & 3); w4s[q] = *(const f32x4*)(lw + off); b4s[q] = *(const f32x4*)(lb + off); gws[q] = *(const u32x2*)(gb + off); bws[q] = *(const u32x2*)(gb + 64 + off); }
#pragma unroll
    for (int rt = 0; rt < 2; ++rt)
#pragma unroll
        for (int g = 0; g < 4; ++g) {
            const int off = rt * 32 + 8 * g;
            const f32x4 w4 = w4s[rt * 4 + g], b4 = b4s[rt * 4 + g];
            const u32x2 gw = gws[rt * 4 + g], bw = bws[rt * 4 + g];
            const float gg[4] = {__uint_as_float(gw.x << 16), __uint_as_float(gw.x & 0xffff0000u), __uint_as_float(gw.y << 16), __uint_as_float(gw.y & 0xffff0000u)};
            const float bb[4] = {__uint_as_float(bw.x << 16), __uint_as_float(bw.x & 0xffff0000u), __uint_as_float(bw.y << 16), __uint_as_float(bw.y & 0xffff0000u)};
            float o[4];
#pragma unroll
            for (int e = 0; e < 4; ++e) o[e] = (y[rt * 16 + 4 * g + e] * rstd * w4[e] + b4[e] + bb[e]) * gg[e];
            u32x2 w; w.x = pk2(o[0], o[1]); w.y = pk2(o[2], o[3]);
            *(u32x2*)(orow + off) = w;
        }
}

DI void unpack8(const u32x4 w, float (&u)[8]) {
    u[0] = __uint_as_float(w.x << 16); u[1] = __uint_as_float(w.x & 0xffff0000u); u[2] = __uint_as_float(w.y << 16); u[3] = __uint_as_float(w.y & 0xffff0000u);
    u[4] = __uint_as_float(w.z << 16); u[5] = __uint_as_float(w.z & 0xffff0000u); u[6] = __uint_as_float(w.w << 16); u[7] = __uint_as_float(w.w & 0xffff0000u);
}
constexpr int FIX_ROWS = 28 * 2 + MS + 8;
DI void conv_fix(const Args& a, int idx) {
    const int fg = idx % (FF / 8), ri = idx / (FF / 8), f = fg * 8;
    if (ri >= FIX_ROWS) return;
    const float* EDGE = (const float*)(a.ws + WS_U); bf16_t* ACT = (bf16_t*)(a.ws + WS_ACT);
    const float* cw = a.in[I_FCW]; const float* cb = a.in[I_FCB];
    const float *p0, *p1, *p2; int m;
    if (ri < 56) {
        const int ti = ri >> 1, k = ri & 1, pm = ti + 1 + ti / 7;
        m = pm * 256 + k;
        p0 = EDGE + ((size_t)pm * 4 + k) * FF2;
        p1 = k == 0 ? EDGE + ((size_t)(pm - 1) * 4 + 3) * FF2 : EDGE + ((size_t)pm * 4 + 0) * FF2;
        p2 = k == 0 ? EDGE + ((size_t)(pm - 1) * 4 + 2) * FF2 : EDGE + ((size_t)(pm - 1) * 4 + 3) * FF2;
    } else if (ri >= 56 + MS) {
        const int q = ri - 56 - MS, bb = q >> 1, k = q & 1;
        const float* src = EDGE + ((size_t)(bb * 8 + 7) * 4 + 2 + k) * FF2; float* dst = a.out + O_PFFN + ((size_t)bb * 2 + k) * FF2;
#pragma unroll
        for (int p = 0; p < 2; ++p) { *(f32x4*)(dst + p * FF + f) = *(const f32x4*)(src + p * FF + f); *(f32x4*)(dst + p * FF + f + 4) = *(const f32x4*)(src + p * FF + f + 4); }
        return;
    } else {
        const int b = ri - 56; m = MP + b;
        p0 = EDGE + (size_t)(128 + b) * FF2;
        { float* s1 = a.out + O_SFFN + (size_t)b * 2 * FF2 + FF2;
#pragma unroll
          for (int p = 0; p < 2; ++p) { *(f32x4*)(s1 + p * FF + f) = *(const f32x4*)(p0 + p * FF + f); *(f32x4*)(s1 + p * FF + f + 4) = *(const f32x4*)(p0 + p * FF + f + 4); } }
        p1 = a.in[I_SFFN] + (size_t)b * 2 * FF2 + FF2;
        p2 = a.in[I_SFFN] + (size_t)b * 2 * FF2;
        float* so = a.out + O_SFFN + (size_t)b * 2 * FF2;
#pragma unroll
        for (int p = 0; p < 2; ++p) { *(f32x4*)(so + p * FF + f) = *(const f32x4*)(p1 + p * FF + f); *(f32x4*)(so + p * FF + f + 4) = *(const f32x4*)(p1 + p * FF + f + 4); }
    }
    float c[2][8];
#pragma unroll
    for (int p = 0; p < 2; ++p)
#pragma unroll
        for (int j = 0; j < 8; ++j) { const int col = p * FF + f + j; c[p][j] = cb[col] + cw[col] * p2[col] + cw[FF2 + col] * p1[col] + cw[2 * FF2 + col] * p0[col]; }
    float o[8];
#pragma unroll
    for (int j = 0; j < 8; ++j) o[j] = c[0][j] * __builtin_amdgcn_rcpf(1.f + __expf(-c[0][j])) * c[1][j];
    u32x4 w; w.x = pk2(o[0], o[1]); w.y = pk2(o[2], o[3]); w.z = pk2(o[4], o[5]); w.w = pk2(o[6], o[7]);
    *(u32x4*)(ACT + (size_t)m * FF + f) = w;
}

#define XB_TMO      128
#define XB_XCNT(j)  (256  + 64 * (j))
#define XB_XSUB(j)  (1280 + 64 * (j))
#define XB_XGEN(j)  (2304 + 64 * (j))
#define XB_TOP      3328
#define XB_TOPGEN   3392
#define XCD_BAR_WORDS 3456
#define XB_SPIN_CAP (1u << 18)
DI unsigned xb_ld(unsigned* p)              { return __hip_atomic_load(p, __ATOMIC_RELAXED, __HIP_MEMORY_SCOPE_AGENT); }
DI unsigned xb_add(unsigned* p, unsigned v) { return __hip_atomic_fetch_add(p, v, __ATOMIC_RELAXED, __HIP_MEMORY_SCOPE_AGENT); }
DI unsigned xb_xcc_id() { return (unsigned)__builtin_amdgcn_s_getreg((3 << 11) | 20) & 0xFu; }
#define XB_SPIN(cond, bar) do { unsigned _sp = 0; while (cond) { __builtin_amdgcn_s_sleep(1); \
    if ((++_sp & 255u) == 0u) { if (xb_ld(&(bar)[XB_TMO])) break; if (_sp > XB_SPIN_CAP) { atomicAdd(&(bar)[XB_TMO], 1u); break; } } } } while (0)
struct XcdBarrier { unsigned* bar; unsigned x; volatile LAS unsigned* st; };
DI XcdBarrier xcd_barrier_post(unsigned* bar, volatile LAS unsigned* st) {
    XcdBarrier b; b.bar = bar; b.x = xb_xcc_id(); b.st = st;
    if (threadIdx.x == 0) (void)xb_add(&bar[XB_XCNT(b.x)], 1u);
    return b;
}
DI void xcd_barrier_complete(unsigned* bar, unsigned x, unsigned& nloc, unsigned& nx) {
    const unsigned G = gridDim.x * gridDim.y * gridDim.z;
    unsigned sum, cnt, mine, sp = 0u;
    for (;;) {
        sum = 0u; cnt = 0u; mine = 0u;
#pragma unroll
        for (unsigned j = 0; j < 16; ++j) { const unsigned c = xb_ld(&bar[XB_XCNT(j)]); sum += c; cnt += (c > 0u) ? 1u : 0u; mine = (j == x) ? c : mine; }
        if (sum == G) break;
        __builtin_amdgcn_s_sleep(1);
        if ((++sp & 255u) == 0u) { if (xb_ld(&bar[XB_TMO])) break; if (sp > XB_SPIN_CAP) { atomicAdd(&bar[XB_TMO], 1u); break; } }
    }
    nloc = mine > 0u ? mine : 1u; nx = cnt > 0u ? cnt : 1u;
}
DI void xcd_barrier(const XcdBarrier& b) {
    asm volatile("s_waitcnt vmcnt(0)" ::: "memory");
    __syncthreads();
    if (threadIdx.x == 0) {
        unsigned* bar = b.bar;
        __builtin_amdgcn_s_waitcnt(0);
        unsigned nloc = b.st[0], nx = b.st[1];
        if (nloc == 0u) { xcd_barrier_complete(bar, b.x, nloc, nx); b.st[0] = nloc; b.st[1] = nx; }
        const unsigned old = xb_add(&bar[XB_XSUB(b.x)], 1u);
        const unsigned gen = old / nloc;
        if (old + 1u == (gen + 1u) * nloc) {
            __builtin_amdgcn_fence(__ATOMIC_RELEASE, "agent");
            asm volatile("s_waitcnt vmcnt(0)" ::: "memory");
            const unsigned og = xb_add(&bar[XB_TOP], 1u);
            const unsigned tg = og / nx;
            if (og + 1u == (tg + 1u) * nx) xb_add(&bar[XB_TOPGEN], 1u);
            else XB_SPIN(xb_ld(&bar[XB_TOPGEN]) == tg, bar);
            __builtin_amdgcn_fence(__ATOMIC_ACQUIRE, "agent");
            xb_add(&bar[XB_XGEN(b.x)], 1u);
            asm volatile("s_waitcnt vmcnt(0)" ::: "memory");
        } else {
            XB_SPIN(xb_ld(&bar[XB_XGEN(b.x)]) == gen, bar);
            __builtin_amdgcn_fence(__ATOMIC_ACQUIRE, "agent");
            asm volatile("s_waitcnt vmcnt(0)" ::: "memory");
        }
    }
    __syncthreads();
}

DI void skinny_unit(const bf16_t* A, int lda, const bf16_t* Bt, int K, int unit, const float* base, int ldb, float* out, int ldo, unsigned char* lds, int wave, int lane,
                    const float* gf = nullptr, bf16_t* H = nullptr, float* RSS = nullptr) {
    float* red = (float*)lds;
    const int n0 = unit * 32, r = lane & 31, hh = lane >> 5, kw = K / 8, kb = wave * kw;
    f32x16 acc;
#pragma unroll
    for (int i = 0; i < 16; ++i) acc[i] = 0.f;
    const bf16_t* ap = A + (size_t)r * lda + kb + 8 * hh; const bf16_t* bp = Bt + (size_t)(n0 + r) * K + kb + 8 * hh;
    for (int k0 = 0; k0 < kw; k0 += 128) {
        bf16x8 af[8], bf[8];
#pragma unroll
        for (int i = 0; i < 8; ++i) { const int k = k0 + 16 * i < kw ? k0 + 16 * i : 0; af[i] = *(const bf16x8*)(ap + k); bf[i] = *(const bf16x8*)(bp + k); }
#pragma unroll
        for (int i = 0; i < 8; ++i) if (k0 + 16 * i < kw) acc = __builtin_amdgcn_mfma_f32_32x32x16_bf16(af[i], bf[i], acc, 0, 0, 0);
    }
#pragma unroll
    for (int i = 0; i < 16; ++i) red[(wave * 16 + i) * 64 + lane] = acc[i];
    __syncthreads();
#pragma unroll
    for (int q = 0; q < 2; ++q) {
        const int o = threadIdx.x + 512 * q, i = o >> 6, ln = o & 63;
        float sum = 0.f;
#pragma unroll
        for (int w = 0; w < 8; ++w) sum += red[(w * 16 + i) * 64 + ln];
        const int row = crow(i, ln >> 5), col = n0 + (ln & 31);
        const float x1 = base[(size_t)row * ldb + col] + sum * (H ? 1.0f : MK_P11_SCALE);
        out[(size_t)row * ldo + col] = x1;
        if (H) { H[(size_t)row * D + col] = (bf16_t)bf_rne(x1 * gf[col]);
            float ss = x1 * x1;
            ss += __shfl_xor(ss, 1); ss += __shfl_xor(ss, 2); ss += __shfl_xor(ss, 4); ss += __shfl_xor(ss, 8); ss += __shfl_xor(ss, 16);
            if ((ln & 31) == 0) atomic_add_f32(RSS + row, ss); }
    }
    __syncthreads();
}

constexpr int NPH = 14;
template <bool COOP>
__global__ void __launch_bounds__(NTHREADS, 2) mk_fwd(Args a) {
    extern __shared__ __attribute__((aligned(16))) unsigned char lds[];
    const int tid = threadIdx.x, lane = tid & 63, wave = __builtin_amdgcn_readfirstlane(tid >> 6);
    const int G = gridDim.x, bid = blockIdx.x, gw = bid * NWAVES + wave, ngw = G * NWAVES;
    unsigned char* ws = a.ws;
    LAS unsigned char* ldsl = (LAS unsigned char*)lds;
#ifndef PHMASK
#define PHMASK 0xffff
#endif
#define IN(k) (((PHMASK >> (k)) & 1) && a.ph_lo <= (k) && (k) < a.ph_hi)
    XcdBarrier xbar; xbar.bar = (unsigned*)(ws + WS_BAR); xbar.x = 0; xbar.st = nullptr;
    if (COOP) {
        volatile LAS unsigned* st = (volatile LAS unsigned*)(ldsl + LDS_BYTES - 16);
        if (tid < 4) st[tid] = 0u;
        __syncthreads();
        xbar = xcd_barrier_post((unsigned*)(ws + WS_BAR), st);
    }
#define SEAM(k) do { if (COOP && IN(k) && IN((k) + 1)) { if (a.ph_hi > 1000) cg::this_grid().sync(); else xcd_barrier(xbar); } } while (0)

    if (IN(0)) phase_prologue(a, lds, gw, ngw, lane, wave);
    SEAM(0);
    if (IN(1)) {
        pg8::Gemm g{(const bf16_t*)(ws + WS_H), (const bf16_t*)(ws + WS_WIN), MPAD, NIN, D}; pg8::StaticOrder S; S.init(MPAD, NIN, G, bid);
        EpiIn E{(bf16_t*)(ws + WS_QB), (bf16_t*)(ws + WS_KB), (bf16_t*)(ws + WS_VB), (bf16_t*)(ws + WS_RW), a.out};
        pg8::gemm_phase<EpiIn>(ldsl, g, S, E);
        {
            const int nu = (MPAD / 256) * (NIN / 256), rem = nu % G, first = rem == 0 ? 0 : rem, nfree = G - first;
            if (bid >= first) convert_wo_wup(a, lds, (bid - first) * NWAVES + wave, nfree * NWAVES, wave, lane);
        }
    }
    SEAM(1);
    if (IN(2)) {
        for (int u = bid; u < 256; u += G) attn_sample_wg(a, lds, u, wave, lane);
        for (int u = gw; u < 64 * 3 * 64; u += ngw) attn_prompt_unit(a, lds, u, wave, lane);
        for (int m = gw; m < MPAD; m += ngw) lora_input_row(a, m, lane);
    }
    SEAM(2);
    if (IN(3)) {
        pg8::Gemm g{(const bf16_t*)(ws + WS_ALO), (const bf16_t*)(ws + WS_WLO), MPAD, NLO, KLO}; pg8::StaticOrder S; S.init(MPAD, NLO, G, bid);
        EpiBf E{(bf16_t*)(ws + WS_L), NLO};
        pg8::gemm_phase<EpiBf>(ldsl, g, S, E);
#pragma unroll 2
        for (int t = gw; t < MP * 4; t += ngw) attn_merge_task(a, t, lane);
    }
    SEAM(3);
    if (IN(4)) {
#ifndef NO_P1
        for (int u = bid; u < 64 * NS / 4; u += G) scan_pass1_unit(a, lds, u, wave, lane);
#endif

    }
    SEAM(4);
    if (IN(5)) {
        if (G >= 128) {
            if (bid < 64) scan_pass2_unit(a, lds, bid, wave, lane);
            else for (int u = (bid - 64) * NWAVES + wave; u < 512; u += (G - 64) * NWAVES) scan_sample_unit(a, lds, u, wave, lane);
        } else {
            for (int ch = bid; ch < 64; ch += G) scan_pass2_unit(a, lds, ch, wave, lane);
            for (int u = gw; u < 512; u += ngw) scan_sample_unit(a, lds, u, wave, lane);
        }
    }
    SEAM(5);
    if (IN(6)) { for (int u = gw; u < 64 * NS * 4; u += ngw) scan_pass3_unit(a, u, lane); }
    SEAM(6);
    if (IN(7)) {
        pg8::Gemm g{(const bf16_t*)(ws + WS_O), (const bf16_t*)(ws + WS_WO), MP, D, D}; pg8::StaticOrder S; S.init(MP, D, G, bid);
        EpiWo E{a.in[I_XP], a.in[I_NFG], (float*)(ws + WS_X1), (bf16_t*)(ws + WS_H), (float*)(ws + WS_RSS)};
        pg8::gemm_phase<EpiWo>(ldsl, g, S, E);
        for (int u = bid; u < D / 32; u += G)
            skinny_unit((const bf16_t*)(ws + WS_O) + (size_t)MP * D, D, (const bf16_t*)(ws + WS_WO), D, u, a.in[I_XS], D, (float*)(ws + WS_X1) + (size_t)MP * D, D, lds, wave, lane,
                        a.in[I_NFG], (bf16_t*)(ws + WS_H) + (size_t)MP * D, (float*)(ws + WS_RSS) + MP);
    }
    SEAM(7);
    if (IN(9)) {
        pg8::Gemm g{(const bf16_t*)(ws + WS_H), (const bf16_t*)(ws + WS_WUP), MPAD, FF2, D}; pg8::StaticOrder S; S.init(MPAD, FF2, G, bid);
        EpiUpF E{(bf16_t*)(ws + WS_ACT), a.out, (const float*)(ws + WS_RSS), a.in[I_FCW], a.in[I_FCB], (float*)(ws + WS_U), (LAS float*)(ldsl + 131072)};
        pg8::gemm_phase<EpiUpF>(ldsl, g, S, E);
        {
            const int nu = (MPAD / 256) * (FF2 / 256), rem = nu % G, first = rem == 0 ? 0 : rem, nfree = G - first;
            if (bid >= first) convert_wdn(a, lds, (bid - first) * NWAVES + wave, nfree * NWAVES, wave, lane);
        }
    }
    SEAM(9);
    if (IN(10)) { for (int it = bid * NTHREADS + tid; it < FIX_ROWS * (FF / 8); it += G * NTHREADS) conv_fix(a, it); }
    SEAM(10);
    if (IN(11)) {
        pg8::Gemm g{(const bf16_t*)(ws + WS_ACT), (const bf16_t*)(ws + WS_WDN), MP, D, FF}; pg8::StaticOrder S; S.init(MP, D, G, bid);
        EpiDn E{(float*)(ws + WS_X1)};
        pg8::gemm_phase<EpiDn>(ldsl, g, S, E);
        for (int u = bid; u < D / 32; u += G)
            skinny_unit((const bf16_t*)(ws + WS_ACT) + (size_t)MP * FF, FF, (const bf16_t*)(ws + WS_WDN), FF, u, (const float*)(ws + WS_X1) + (size_t)MP * D, D, (float*)(ws + WS_X1) + (size_t)MP * D, D, lds, wave, lane);
    }
    SEAM(11);
    if (IN(12)) {
        for (int m = gw; m < MT; m += ngw)
            rms_row_f32((const float*)(ws + WS_X1) + (size_t)m * D, a.in[I_NFIN], m < MP ? a.out + O_YP + (size_t)m * D : a.out + O_YS + (size_t)(m - MP) * D, lane);
    }
#undef IN
#undef SEAM
}

#ifndef MK_ONE_LAUNCH
#define MK_ONE_LAUNCH 1
#endif
#ifndef MK_DBL_MASK
#define MK_DBL_MASK 0x0
#endif

extern "C" void kernel_launch(void* const* d_in, const int* in_sizes, int n_in, void* d_out, int out_size, void* d_ws, size_t ws_size, hipStream_t stream) {
    static int grid = 0;
    if (!grid) {
        if (n_in != 28 || (size_t)out_size != O_END || ws_size < WS_END) fprintf(stderr, "kernel_launch: unexpected shapes: n_in %d out %d (want %zu) ws %zu (want %zu)\n", n_in, out_size, O_END, ws_size, WS_END);
        int dev = 0, cus = 0; hipGetDevice(&dev); hipDeviceGetAttribute(&cus, hipDeviceAttributeMultiprocessorCount, dev);
        hipFuncSetAttribute((const void*)mk_fwd<true>, hipFuncAttributeMaxDynamicSharedMemorySize, LDS_BYTES);
        hipFuncSetAttribute((const void*)mk_fwd<false>, hipFuncAttributeMaxDynamicSharedMemorySize, LDS_BYTES);
        int per_cu = 0; hipOccupancyMaxActiveBlocksPerMultiprocessor(&per_cu, mk_fwd<true>, NTHREADS, LDS_BYTES);
        if (per_cu < 1) { fprintf(stderr, "kernel_launch: occupancy query says %d blocks/CU\n", per_cu); per_cu = 1; }
        grid = cus > 0 ? cus : 256;
    }
    Args a; memset(&a, 0, sizeof(a));
    for (int i = 0; i < 28; ++i) a.in[i] = (const float*)d_in[i];
    a.out = (float*)d_out; a.ws = (unsigned char*)d_ws;
#if MK_ONE_LAUNCH
    if (hipMemsetAsync((char*)d_ws + WS_BAR, 0, BAR_BYTES, stream) != hipSuccess) { fprintf(stderr, "kernel_launch: memset of the barrier words failed\n"); return; }
    a.ph_lo = 0; a.ph_hi = NPH;
    void* args[] = {&a};
    hipError_t e = hipLaunchCooperativeKernel((const void*)mk_fwd<true>, dim3(grid), dim3(NTHREADS), args, LDS_BYTES, stream);
    if (e != hipSuccess) fprintf(stderr, "cooperative launch failed: %s (grid %d)\n", hipGetErrorString(e), grid);
#else
    for (int p = 0; p < 13; ++p) {
        a.ph_lo = p; a.ph_hi = p + 1;
        mk_fwd<false><<<dim3(grid), dim3(NTHREADS), LDS_BYTES, stream>>>(a);
        if ((MK_DBL_MASK >> p) & 1) mk_fwd<false><<<dim3(grid), dim3(NTHREADS), LDS_BYTES, stream>>>(a);
    }
#endif
}
```

```cpp
#include <hip/hip_runtime.h>
#include <hip/hip_cooperative_groups.h>
#include <cstdio>
#include <cstdint>
#include <cstring>
namespace cg = cooperative_groups;

#define DI __device__ __forceinline__
#define LAS __attribute__((address_space(3)))
typedef unsigned short bf16_t;
typedef short bf16x8 __attribute__((ext_vector_type(8)));
typedef float f32x4 __attribute__((ext_vector_type(4)));
typedef float f32x16 __attribute__((ext_vector_type(16)));
typedef unsigned u32x4 __attribute__((ext_vector_type(4)));
typedef unsigned u32x2 __attribute__((ext_vector_type(2)));

constexpr int D = 2048, MP = 8192, MS = 32, MT = 8224, MPAD = 8448, SEQ = 2048;
constexpr int CIN = 6432, NIN = 6656, CSH = 3360, FF2 = 11264, FF = 5632;
constexpr int NLO = 3072, KLO = 384;
constexpr int NS = 16, SEGL = 128, TB = 8;
constexpr int NTHREADS = 512, NWAVES = 8;
constexpr int LDS_BYTES = 131072 + 16384;

constexpr size_t O_YP = 0;
constexpr size_t O_YS = O_YP + (size_t)MP * D;
constexpr size_t O_PK = O_YS + (size_t)MS * D;
constexpr size_t O_PV = O_PK + (size_t)MP * 1024;
constexpr size_t O_PRW = O_PV + (size_t)MP * 1024;
constexpr size_t O_PWKV = O_PRW + (size_t)4 * CSH;
constexpr size_t O_PFFN = O_PWKV + (size_t)4 * 16 * 4096;
constexpr size_t O_SK = O_PFFN + (size_t)4 * 2 * FF2;
constexpr size_t O_SV = O_SK + (size_t)MS * 1024;
constexpr size_t O_SRW = O_SV + (size_t)MS * 1024;
constexpr size_t O_SWKV = O_SRW + (size_t)MS * CSH;
constexpr size_t O_SFFN = O_SWKV + (size_t)MS * 16 * 4096;
constexpr size_t O_END = O_SFFN + (size_t)MS * 2 * FF2;

constexpr size_t al256(size_t x) { return (x + 255) & ~(size_t)255; }
constexpr size_t WS_WIN = 0;
constexpr size_t WS_WO = WS_WIN + al256((size_t)NIN * D * 2);
constexpr size_t WS_WUP = WS_WO + al256((size_t)D * D * 2);
constexpr size_t WS_WDN = WS_WUP + al256((size_t)FF2 * D * 2);
constexpr size_t WS_WLO = WS_WDN + al256((size_t)D * FF * 2);
constexpr size_t WS_H = WS_WLO + al256((size_t)NLO * KLO * 2);
constexpr size_t WS_QB = WS_H + al256((size_t)MPAD * D * 2);
constexpr size_t WS_KB = WS_QB + al256((size_t)MPAD * 1024 * 2);
constexpr size_t WS_VB = WS_KB + al256((size_t)MPAD * 1024 * 2);
constexpr size_t WS_ALO = WS_VB + al256((size_t)MPAD * 1024 * 2);
constexpr size_t WS_O = WS_ALO + al256((size_t)MPAD * KLO * 2);
constexpr size_t WS_GB = WS_O + al256((size_t)MPAD * D * 2);
constexpr size_t WS_YL = WS_GB + al256((size_t)MT * 2048 * 2);
constexpr size_t WS_QS = WS_YL + al256((size_t)MP * 1024 * 2);
constexpr size_t WS_ZP = WS_QS + al256((size_t)MP * 1024 * 2);
constexpr size_t WS_SST = WS_ZP + al256((size_t)64 * NS * 2 * 4096 * 4);
constexpr size_t WS_X1 = WS_SST + al256((size_t)64 * NS * 4096 * 4);
constexpr size_t WS_PML = WS_X1 + al256((size_t)MPAD * D * 4);
constexpr size_t WS_RA = WS_PML + al256((size_t)3 * MP * 16 * 2 * 4);
constexpr size_t WS_RW = WS_RA;
constexpr size_t WS_L = WS_RW + al256((size_t)MPAD * CSH * 2);
constexpr size_t RA_BYTES_1 = al256((size_t)MPAD * CSH * 2) + al256((size_t)MPAD * NLO * 2);
constexpr size_t RA_BYTES_2 = al256((size_t)MPAD * FF2 * 2);
constexpr size_t WS_U = WS_RA;
constexpr size_t WS_RB = WS_RA + (RA_BYTES_1 > RA_BYTES_2 ? RA_BYTES_1 : RA_BYTES_2);
constexpr size_t WS_PART = WS_RB;
constexpr size_t WS_ACT = WS_RB;
constexpr size_t RB_BYTES_1 = al256((size_t)3 * MP * 1024 * 2);
constexpr size_t RB_BYTES_2 = al256((size_t)MPAD * FF * 2);
constexpr size_t WS_RSS = WS_RB + (RB_BYTES_1 > RB_BYTES_2 ? RB_BYTES_1 : RB_BYTES_2);
constexpr size_t WS_BAR_ = 0; constexpr size_t WS_BAR = al256((size_t)MPAD * 4) + WS_RB + (RB_BYTES_1 > RB_BYTES_2 ? RB_BYTES_1 : RB_BYTES_2);
constexpr size_t BAR_BYTES = 16384;
constexpr size_t WS_END = WS_BAR + BAR_BYTES;

struct Args {
    const float* in[28];
    float* out;
    unsigned char* ws;
    int ph_lo, ph_hi;
};
enum { I_XP = 0, I_XS, I_CK, I_CV, I_SSH, I_SWKV, I_SFFN, I_NMG, I_WIN, I_AOG, I_MU, I_W0, I_WUP, I_A0, I_AUP, I_GUP,
       I_KK, I_KA, I_RK, I_LNW, I_LNB, I_WO, I_NFG, I_FUP, I_FCW, I_FCB, I_FDN, I_NFIN };

typedef float f32x2c __attribute__((ext_vector_type(2)));
typedef __bf16 bf16x2c __attribute__((ext_vector_type(2)));
DI unsigned pk2(float lo, float hi) { const f32x2c v = {lo, hi}; return __builtin_bit_cast(unsigned, __builtin_convertvector(v, bf16x2c)); }
DI unsigned bf_rne(float f) { return pk2(f, 0.f) & 0xffffu; }
DI unsigned cvt_pk(float lo, float hi) { return pk2(lo, hi); }
DI void atomic_add_f32(float* p, float v) { (void)__builtin_amdgcn_global_atomic_fadd_f32((__attribute__((address_space(1))) float*)p, v); }
DI float bf2f(unsigned short b) { return __uint_as_float(((unsigned)b) << 16); }
#define DPP_ADD(v, ctrl) ((v) + __int_as_float(__builtin_amdgcn_update_dpp(0, __float_as_int(v), (ctrl), 0xf, 0xf, false)))
DI float wave_sum(float v) {
    v = DPP_ADD(v, 0xB1);
    v = DPP_ADD(v, 0x4E);
    v = DPP_ADD(v, 0x141);
    v = DPP_ADD(v, 0x140);
    const float s0 = __int_as_float(__builtin_amdgcn_readlane(__float_as_int(v), 0)), s1 = __int_as_float(__builtin_amdgcn_readlane(__float_as_int(v), 16));
    const float s2 = __int_as_float(__builtin_amdgcn_readlane(__float_as_int(v), 32)), s3 = __int_as_float(__builtin_amdgcn_readlane(__float_as_int(v), 48));
    return (s0 + s1) + (s2 + s3);
}

namespace pg8 {
constexpr int BM = 256, BK = 64, HALF = 128, HTB = HALF * BK * 2, STAGE_BYTES = 8 * HTB, NXCD = 8, WGM = 8;
DI int lds_byte(int r, int c) { const int st = (r >> 4) * 2 + (c >> 5), rr = r & 15, cc = c & 31, ob = rr * 64 + cc * 2; return st * 1024 + (ob ^ (((ob >> 9) & 1) << 5)); }
DI void stage_rc(int b, int& R, int& C) { const int st = b / 1024, sb = b % 1024, swz = sb ^ (((sb >> 9) & 1) << 5); R = (st >> 1) * 16 + swz / 64; C = (st & 1) * 32 + (swz % 64) / 2; }
struct Unit { int pm, pn; };
struct Gemm { const bf16_t* A; const bf16_t* Bt; int M, N, K; };
struct StaticOrder {
    int nM, nN, nwg, G, c;
    DI void init(int M, int N, int G_, int c_) { nM = M / BM; nN = N / BM; nwg = nM * nN; G = G_; c = c_; }
    DI bool next(int i, Unit& u) const {
        const long L = (long)i * G + c; if (L >= nwg) return false;
        int wgid = (int)L; { const int q = nwg / NXCD, r = nwg % NXCD, xcd = wgid % NXCD, off = wgid / NXCD; wgid = (xcd < r ? xcd * (q + 1) : r * (q + 1) + (xcd - r) * q) + off; }
        const int nig = WGM * nN, gid = wgid / nig, fm = gid * WGM, gsz = (nM - fm) < WGM ? (nM - fm) : WGM;
        u.pm = fm + ((wgid % nig) % gsz); u.pn = (wgid % nig) / gsz; return true;
    }
};

template <class Epi>
DI void gemm_phase(LAS unsigned char* lds, const Gemm g, const StaticOrder& S, const Epi& E) {
    const int tid = threadIdx.x, wid = __builtin_amdgcn_readfirstlane(tid >> 6), lane = tid & 63, wr = wid >> 2, wc = wid & 3, fr = lane & 15, fq = lane >> 4;
    const int K = g.K, nt = K / BK;
    unsigned voffA[2];
#pragma unroll
    for (int i = 0; i < 2; ++i) { int R, C; stage_rc(tid * 16 + i * 8192, R, C); voffA[i] = (unsigned)(R * K + C) * 2u; }
    const size_t kstep = (size_t)(BK * 2);
    const size_t hstep = (size_t)HALF * K * 2;
    const size_t tstep = 2 * hstep;
    const unsigned ldsw = (unsigned)wid * 1024u;
    const int aoff = lds_byte(wr * 64 + fr, fq * 8), boff = lds_byte(wc * 32 + fr, fq * 8);
#define PG8_SA(b, h) (((b) * 2 + (h)) * HTB)
#define PG8_SB(b, h) ((4 + (b) * 2 + (h)) * HTB)
#define PG8_STAGE(bufoff, gbase, voff) do { _Pragma("unroll") for (int _i = 0; _i < 2; ++_i) \
        __builtin_amdgcn_global_load_lds((const unsigned*)((const char*)(gbase) + (voff)[_i]), (LAS unsigned*)(lds + (bufoff) + ldsw + _i * 8192), 16, 0, 0); } while (0)
#define PG8_LDA(dst, b, h) do { _Pragma("unroll") for (int m = 0; m < 4; ++m) _Pragma("unroll") for (int k = 0; k < 2; ++k) dst[m][k] = *(const LAS bf16x8*)(lds + PG8_SA(b, h) + aoff + m * 2048 + k * 1024); } while (0)
#define PG8_LDB(dst, b, h) do { _Pragma("unroll") for (int n = 0; n < 2; ++n) _Pragma("unroll") for (int k = 0; k < 2; ++k) dst[n][k] = *(const LAS bf16x8*)(lds + PG8_SB(b, h) + boff + n * 2048 + k * 1024); } while (0)
#define PG8_MMA(ai, bj, At, Bt) do { __builtin_amdgcn_s_setprio(1); _Pragma("unroll") for (int m = 0; m < 4; ++m) _Pragma("unroll") for (int n = 0; n < 2; ++n) _Pragma("unroll") for (int k = 0; k < 2; ++k) \
        acc[ai][bj][m][n] = __builtin_amdgcn_mfma_f32_16x16x32_bf16(Bt[n][k], At[m][k], acc[ai][bj][m][n], 0, 0, 0); __builtin_amdgcn_s_setprio(0); } while (0)
#define PG8_WAIT_V(n) asm volatile("s_waitcnt vmcnt(" #n ")" ::: "memory")
#define PG8_WAIT_L(n) asm volatile("s_waitcnt lgkmcnt(" #n ")" ::: "memory")
#define PG8_BAR __builtin_amdgcn_s_barrier()
#define PG8_SCHED __builtin_amdgcn_sched_barrier(0)
    Unit cur, nxt; int ui = 0;
    if (!S.next(0, cur)) return;
    f32x4 acc[2][2][4][2];
#pragma unroll
    for (int a = 0; a < 2; ++a)
#pragma unroll
        for (int b = 0; b < 2; ++b)
#pragma unroll
            for (int m = 0; m < 4; ++m)
#pragma unroll
                for (int n = 0; n < 2; ++n) acc[a][b][m][n] = (f32x4){0.f, 0.f, 0.f, 0.f};
    bf16x8 At[4][2], B0[2][2], B1[2][2];
    const char* cA = (const char*)g.A + (size_t)cur.pm * tstep; const char* cB = (const char*)g.Bt + (size_t)cur.pn * tstep;
    PG8_STAGE(PG8_SB(0, 0), cB, voffA); PG8_STAGE(PG8_SA(0, 0), cA, voffA); PG8_STAGE(PG8_SB(0, 1), cB + hstep, voffA); PG8_STAGE(PG8_SA(0, 1), cA + hstep, voffA);
    if (wr == 1) PG8_BAR;
    PG8_WAIT_V(4); PG8_BAR;
    PG8_STAGE(PG8_SB(1, 0), cB + kstep, voffA); PG8_STAGE(PG8_SA(1, 0), cA + kstep, voffA); PG8_STAGE(PG8_SB(1, 1), cB + hstep + kstep, voffA);
    PG8_WAIT_V(6); PG8_BAR;
    for (;;) {
        const bool has_next = S.next(ui + 1, nxt);
        const char* nA = has_next ? (const char*)g.A + (size_t)nxt.pm * tstep : cA; const char* nB = has_next ? (const char*)g.Bt + (size_t)nxt.pn * tstep : cB;
        for (int t = 0; t < nt; t += 2) {
            const bool last = (t == nt - 2);
            const char* a1 = cA + (size_t)(t + 1) * kstep;
            const char* a2 = last ? nA : cA + (size_t)(t + 2) * kstep; const char* b2 = last ? nB : cB + (size_t)(t + 2) * kstep;
            const char* a3 = a2 + kstep; const char* b3 = b2 + kstep;
            PG8_LDB(B0, 0, 0); PG8_SCHED; PG8_LDA(At, 0, 0); PG8_STAGE(PG8_SA(1, 1), a1 + hstep, voffA);
            PG8_WAIT_L(8); PG8_BAR; PG8_WAIT_L(0); PG8_MMA(0, 0, At, B0); PG8_BAR; PG8_SCHED;
            PG8_LDB(B1, 0, 1); PG8_STAGE(PG8_SB(0, 0), b2, voffA);
            PG8_BAR; PG8_WAIT_L(0); PG8_MMA(0, 1, At, B1); PG8_BAR;
            PG8_LDA(At, 0, 1); PG8_STAGE(PG8_SA(0, 0), a2, voffA);
            PG8_BAR; PG8_WAIT_L(0); PG8_MMA(1, 0, At, B0); PG8_BAR; PG8_SCHED;
            PG8_STAGE(PG8_SB(0, 1), b2 + hstep, voffA);
            PG8_WAIT_V(6); PG8_BAR; PG8_MMA(1, 1, At, B1); PG8_BAR;
            PG8_LDB(B0, 1, 0); PG8_SCHED; PG8_LDA(At, 1, 0); PG8_STAGE(PG8_SA(0, 1), a2 + hstep, voffA);
            PG8_WAIT_L(8); PG8_BAR; PG8_WAIT_L(0); PG8_MMA(0, 0, At, B0); PG8_BAR; PG8_SCHED;
            PG8_LDB(B1, 1, 1); PG8_STAGE(PG8_SB(1, 0), b3, voffA);
            PG8_BAR; PG8_WAIT_L(0); PG8_MMA(0, 1, At, B1); PG8_BAR;
            PG8_LDA(At, 1, 1); PG8_STAGE(PG8_SA(1, 0), a3, voffA);
            PG8_BAR; PG8_WAIT_L(0); PG8_MMA(1, 0, At, B0); PG8_BAR; PG8_SCHED;
            PG8_STAGE(PG8_SB(1, 1), b3 + hstep, voffA);
            PG8_WAIT_V(6); PG8_BAR; PG8_MMA(1, 1, At, B1); PG8_BAR;
        }
        E(acc, cur, wr, wc, fr, fq);
        if (!has_next) break;
#pragma unroll
        for (int a = 0; a < 2; ++a)
#pragma unroll
            for (int b = 0; b < 2; ++b)
#pragma unroll
                for (int m = 0; m < 4; ++m)
#pragma unroll
                    for (int n = 0; n < 2; ++n) acc[a][b][m][n] = (f32x4){0.f, 0.f, 0.f, 0.f};
        cur = nxt; cA = nA; cB = nB; ++ui;
    }
    PG8_WAIT_V(0);
    if (wr == 0) PG8_BAR;
    PG8_BAR;
#undef PG8_SA
#undef PG8_SB
#undef PG8_STAGE
#undef PG8_LDA
#undef PG8_LDB
#undef PG8_MMA
#undef PG8_WAIT_V
#undef PG8_WAIT_L
#undef PG8_BAR
#undef PG8_SCHED
}
}

DI size_t hm64(int row, int h)  { return ((size_t)((row >> 11) * 16 + h) * SEQ + (row & (SEQ - 1))) * 64; }
typedef f32x4 AccT[2][2][4][2];
#define EPI_LOOP_BEGIN \
    const int row0 = u.pm * 256 + wr * 64 + fr, col0 = u.pn * 256 + wc * 32 + 4 * fq; \
    _Pragma("unroll") for (int ai = 0; ai < 2; ++ai) _Pragma("unroll") for (int m = 0; m < 4; ++m) { const int row = row0 + ai * 128 + m * 16; \
    _Pragma("unroll") for (int bj = 0; bj < 2; ++bj) _Pragma("unroll") for (int n = 0; n < 2; ++n) { const int col = col0 + bj * 128 + n * 16; const f32x4 v = acc[ai][bj][m][n];
#define EPI_LOOP_END } }
#define EPI_LOOP_BEGIN_S \
    const int row0 = u.pm * 256 + wr * 64 + fr, col0 = u.pn * 256 + wc * 32 + 4 * fq; \
    _Pragma("unroll") for (int ai = 0; ai < 2; ++ai) _Pragma("unroll") for (int m = 0; m < 4; ++m) { const int row = row0 + ai * 128 + m * 16; \
    _Pragma("unroll") for (int bj = 0; bj < 2; ++bj) _Pragma("unroll") for (int n = 0; n < 2; ++n) { const int col = col0 + bj * 128 + n * 16; const f32x4 v = acc[ai][bj][m][n] * rs[ai][m];

struct EpiIn {
    bf16_t *Qb, *Kb, *Vb; bf16_t* RW; float* out;
    DI void operator()(const AccT& acc, const pg8::Unit& u, int wr, int wc, int fr, int fq) const {
        const int reg = u.pn < 4 ? 0 : (u.pn < 8 ? 1 : (u.pn < 12 ? 2 : 3));
        EPI_LOOP_BEGIN
            if (row < MT) {
                if (reg == 0) {
                    constexpr float QS_ = 0.125f * 1.44269504088896f;
                    u32x2 w; w.x = cvt_pk(v[0] * QS_, v[1] * QS_); w.y = cvt_pk(v[2] * QS_, v[3] * QS_);
                    *(u32x2*)(row < MP ? Qb + hm64(row, col >> 6) + (col & 63) : Qb + (size_t)row * 1024 + col) = w;
                } else if (reg == 1 || reg == 2) {
                    const int c = col - (reg == 1 ? 1024 : 2048);
                    float* o = row < MP ? out + (reg == 1 ? O_PK : O_PV) + (size_t)row * 1024 + c : out + (reg == 1 ? O_SK : O_SV) + (size_t)(row - MP) * 1024 + c;
                    *(f32x4*)o = v;
                    if (row < MP) { u32x2 w; w.x = cvt_pk(v[0], v[1]); w.y = cvt_pk(v[2], v[3]);
                        *(u32x2*)((reg == 1 ? Kb : Vb) + hm64(row, c >> 6) + (c & 63)) = w; }
                } else {
                    const int c = col - 3072;
                    if (c < CSH) {
                        { u32x2 w; w.x = cvt_pk(v[0], v[1]); w.y = cvt_pk(v[2], v[3]); *(u32x2*)(RW + (size_t)row * CSH + c) = w; }
                        if (row >= MP) *(f32x4*)(out + O_SRW + (size_t)(row - MP) * CSH + c) = v;
                        else if ((row & (SEQ - 1)) == SEQ - 1) *(f32x4*)(out + O_PRW + (size_t)(row >> 11) * CSH + c) = v;
                    }
                }
            }
        EPI_LOOP_END
    }
};
struct EpiBf {
    bf16_t* C; int ldc;
    DI void operator()(const AccT& acc, const pg8::Unit& u, int wr, int wc, int fr, int fq) const {
        const int row0 = u.pm * 256 + wr * 64 + fr, col0 = u.pn * 256 + wc * 32 + 4 * fq;
#pragma unroll
        for (int ai = 0; ai < 2; ++ai)
#pragma unroll
            for (int m = 0; m < 4; ++m) { const int row = row0 + ai * 128 + m * 16;
#pragma unroll
                for (int bj = 0; bj < 2; ++bj)
#pragma unroll
                    for (int n = 0; n < 2; ++n) { const int col = col0 + bj * 128 + n * 16; const f32x4 v = acc[ai][bj][m][n];
                        u32x2 w; w.x = cvt_pk(v[0], v[1]); w.y = cvt_pk(v[2], v[3]);
                        *(u32x2*)(C + (size_t)row * ldc + col) = w; }
                asm volatile("" ::: "memory");
            }
    }
};
struct EpiWo {
    const float *xp; const float* gf; float* X1; bf16_t* H; float* RSS;
    DI void operator()(const AccT& acc, const pg8::Unit& u, int wr, int wc, int fr, int fq) const {
        const int row0 = u.pm * 256 + wr * 64 + fr, col0 = u.pn * 256 + wc * 32 + 4 * fq;
        f32x4 gg[2][2];
#pragma unroll
        for (int bj = 0; bj < 2; ++bj)
#pragma unroll
            for (int n = 0; n < 2; ++n) gg[bj][n] = *(const f32x4*)(gf + col0 + bj * 128 + n * 16);
        float ssr[2][4];
#pragma unroll
        for (int aim = 0; aim < 4; ++aim) {
            const int ai = aim >> 1;
            f32x4 xr[4][2][2];
#pragma unroll
            for (int m = 2 * (aim & 1); m < 2 * (aim & 1) + 2; ++m)
#pragma unroll
                for (int bj = 0; bj < 2; ++bj)
#pragma unroll
                    for (int n = 0; n < 2; ++n) xr[m][bj][n] = *(const f32x4*)(xp + (size_t)(row0 + ai * 128 + m * 16) * D + col0 + bj * 128 + n * 16);
            asm volatile("" ::: "memory");
#pragma unroll
            for (int m = 2 * (aim & 1); m < 2 * (aim & 1) + 2; ++m) {
                const int row = row0 + ai * 128 + m * 16; float ss = 0.f;
#pragma unroll
                for (int bj = 0; bj < 2; ++bj)
#pragma unroll
                    for (int n = 0; n < 2; ++n) {
                        const int col = col0 + bj * 128 + n * 16;
                        const f32x4 x1 = xr[m][bj][n] + acc[ai][bj][m][n];
                        *(f32x4*)(X1 + (size_t)row * D + col) = x1;
                        u32x2 w; w.x = cvt_pk(x1[0] * gg[bj][n][0], x1[1] * gg[bj][n][1]); w.y = cvt_pk(x1[2] * gg[bj][n][2], x1[3] * gg[bj][n][3]);
                        *(u32x2*)(H + (size_t)row * D + col) = w;
                        ss += (x1[0] * x1[0] + x1[1] * x1[1]) + (x1[2] * x1[2] + x1[3] * x1[3]);
                    }
                ssr[ai][m] = ss;
            }
            asm volatile("" ::: "memory");
        }
#pragma unroll
        for (int ai = 0; ai < 2; ++ai)
#pragma unroll
            for (int m = 0; m < 4; ++m) { float ss = ssr[ai][m]; ss += __shfl_xor(ss, 16); ss += __shfl_xor(ss, 32); ssr[ai][m] = ss; }
        if (fq == 0) {
#pragma unroll
            for (int ai = 0; ai < 2; ++ai)
#pragma unroll
                for (int m = 0; m < 4; ++m) atomic_add_f32(RSS + row0 + ai * 128 + m * 16, ssr[ai][m]);
        }
    }
};
#define DPP_MOV(v, ctrl) __int_as_float(__builtin_amdgcn_update_dpp(0, __float_as_int(v), (ctrl), 0xf, 0xf, false))
#define DPP_SHR(oldv, v, ctrl) __int_as_float(__builtin_amdgcn_update_dpp(__float_as_int(oldv), __float_as_int(v), (ctrl), 0xf, 0xf, false))
struct EpiUpF {
    bf16_t* ACT; float* out; const float* RSS; const float* cw; const float* cb; float* EDGE; LAS float* xch;
    DI void operator()(const AccT& acc, const pg8::Unit& u, int wr, int wc, int fr, int fq) const {
        const int wave = wr * 4 + wc, row0 = u.pm * 256 + wr * 64 + fr, f0 = u.pn * 128 + wc * 32 + 4 * fq;
#define UPF_RS(ai_, m_) rsqrtf(RSS[row0 + (ai_) * 128 + (m_) * 16] * (1.f / D) + 1e-6f)
        LAS float* taps = xch + 2048; LAS float* rstd = xch + 3072;
        {
            const int tid = wave * 64 + fq * 16 + fr;
#pragma unroll
            for (int q = 0; q < 2; ++q) { const int idx = tid + 512 * q, which = idx >> 7, col = (which >= 4 ? FF : 0) + u.pn * 128 + (idx & 127);
                taps[idx] = (which & 3) < 3 ? cw[(which & 3) * FF2 + col] : cb[col]; }
            if (tid < 256) rstd[tid] = rsqrtf(RSS[u.pm * 256 + tid] * (1.f / D) + 1e-6f);
        }
        if (fr >= 14) {
#pragma unroll
            for (int ai = 0; ai < 2; ++ai)
#pragma unroll
                for (int bj = 0; bj < 2; ++bj)
#pragma unroll
                    for (int n = 0; n < 2; ++n)
                        *(LAS f32x4*)(xch + wave * 256 + ((((ai * 2 + (fr - 14)) * 2 + bj) * 2 + n) * 4 + fq) * 4) = acc[ai][bj][3][n] * UPF_RS(ai, 3);
        }
        asm volatile("s_waitcnt lgkmcnt(0)" ::: "memory"); __builtin_amdgcn_s_barrier(); asm volatile("" ::: "memory");
        __builtin_amdgcn_s_barrier(); asm volatile("" ::: "memory");
        const bool prompt = u.pm < MP / 256;
#pragma unroll
        for (int n = 0; n < 2; ++n) {
            const int f = f0 + 16 * n;
            asm volatile("" ::: "memory");
            const int fl = wc * 32 + 16 * n + 4 * fq;
#pragma unroll
            for (int ai = 0; ai < 2; ++ai) {
                const bool have = (wr == 1) || (ai == 1);
                const int nbw = wr == 1 ? wave - 4 : wave + 4, nai = wr == 1 ? ai : 0;
                f32x4 pg = {0.f, 0.f, 0.f, 0.f}, pv = {0.f, 0.f, 0.f, 0.f};
                if (have && fr >= 14) {
                    pg = *(const LAS f32x4*)(xch + nbw * 256 + ((((nai * 2 + (fr - 14)) * 2 + 0) * 2 + n) * 4 + fq) * 4);
                    pv = *(const LAS f32x4*)(xch + nbw * 256 + ((((nai * 2 + (fr - 14)) * 2 + 1) * 2 + n) * 4 + fq) * 4);
                }
#pragma unroll
                for (int m = 0; m < 4; ++m) {
                    const int row = row0 + ai * 128 + m * 16;
                    const float rsm = rstd[wr * 64 + ai * 128 + m * 16 + fr];
                    const f32x4 g = acc[ai][0][m][n] * rsm, v = acc[ai][1][m][n] * rsm;
                    float o[4];
                    asm volatile("" ::: "memory");
#pragma unroll
                    for (int e = 0; e < 4; ++e) {
                        const float g1 = DPP_SHR(DPP_MOV(pg[e], 0x121), g[e], 0x111), g2 = DPP_SHR(DPP_MOV(pg[e], 0x122), g[e], 0x112);
                        const float cg = taps[384 + fl + e] + taps[fl + e] * g2 + taps[128 + fl + e] * g1 + taps[256 + fl + e] * g[e];
                        o[e] = cg * __builtin_amdgcn_rcpf(1.f + __expf(-cg));
                    }
                    {
#pragma unroll
                        for (int e = 0; e < 4; ++e) {
                            const float v1 = DPP_SHR(DPP_MOV(pv[e], 0x121), v[e], 0x111), v2 = DPP_SHR(DPP_MOV(pv[e], 0x122), v[e], 0x112);
                            o[e] *= taps[896 + fl + e] + taps[512 + fl + e] * v2 + taps[640 + fl + e] * v1 + taps[768 + fl + e] * v[e];
                        }
                        asm volatile("" ::: "memory");
                    }
                    const int tr = wr * 64 + ai * 128 + m * 16 + fr;
                    if (prompt) {
                        u32x2 w; w.x = cvt_pk(o[0], o[1]); w.y = cvt_pk(o[2], o[3]);
                        *(u32x2*)((char*)ACT + ((unsigned)row * (unsigned)FF + (unsigned)f) * 2u) = w;
                    }
                    if (prompt ? (tr < 2 || tr >= 254) : tr < MS) {
                        const int er = prompt ? u.pm * 4 + (tr < 2 ? tr : tr - 252) : 128 + tr;
                        float* ed = (float*)((char*)EDGE + ((unsigned)er * (unsigned)FF2 + (unsigned)f) * 4u);
                        *(f32x4*)ed = g; *(f32x4*)(ed + FF) = v;
                    }
                    pg = g; pv = v;
                }
            }
        }
    }
#undef UPF_RS
};
#ifndef MK_P11_SCALE
#define MK_P11_SCALE 1.0f
#endif
struct EpiDn {
    float* X1;
    DI void operator()(const AccT& acc, const pg8::Unit& u, int wr, int wc, int fr, int fq) const {
        const int row0 = u.pm * 256 + wr * 64 + fr, col0 = u.pn * 256 + wc * 32 + 4 * fq;
#pragma unroll
        for (int ai = 0; ai < 2; ++ai) {
            f32x4 xr[4][2][2];
#pragma unroll
            for (int m = 0; m < 4; ++m)
#pragma unroll
                for (int bj = 0; bj < 2; ++bj)
#pragma unroll
                    for (int n = 0; n < 2; ++n) xr[m][bj][n] = *(const f32x4*)(X1 + (size_t)(row0 + ai * 128 + m * 16) * D + col0 + bj * 128 + n * 16);
            asm volatile("" ::: "memory");
#pragma unroll
            for (int m = 0; m < 4; ++m)
#pragma unroll
                for (int bj = 0; bj < 2; ++bj)
#pragma unroll
                    for (int n = 0; n < 2; ++n) *(f32x4*)(X1 + (size_t)(row0 + ai * 128 + m * 16) * D + col0 + bj * 128 + n * 16) = xr[m][bj][n] + acc[ai][bj][m][n] * MK_P11_SCALE;
            asm volatile("" ::: "memory");
        }
    }
};

template <bool UPPERM = false>
DI void transpose_item(const float* W, int K, int N, bf16_t* WT, int ldt, float* scr, int item, int lane) {
    const int nblk = N / 32, kb = item / nblk, nb = item % nblk, k0 = 64 * kb, n0 = 32 * nb;
    const int d0 = UPPERM ? (((n0 < FF ? n0 : n0 - FF) >> 7) * 256 + (n0 < FF ? 0 : 128) + ((n0 < FF ? n0 : n0 - FF) & 127)) : n0;
    {
        f32x4 v[8];
#pragma unroll
        for (int i = 0; i < 8; ++i) v[i] = *(const f32x4*)(W + (size_t)(k0 + 8 * i + (lane >> 3)) * N + n0 + 4 * (lane & 7));
#pragma unroll
        for (int i = 0; i < 8; ++i) { float* d = scr + (8 * i + (lane >> 3)) * 33 + 4 * (lane & 7); d[0] = v[i].x; d[1] = v[i].y; d[2] = v[i].z; d[3] = v[i].w; }
    }
    __builtin_amdgcn_fence(__ATOMIC_RELEASE, "wavefront"); asm volatile("s_waitcnt lgkmcnt(0)" ::: "memory");
    const int c = lane & 7;
#pragma unroll
    for (int j = 0; j < 4; ++j) { const int n = (lane >> 3) + 8 * j; const float* s = scr + (8 * c) * 33 + n;
        u32x4 o; o.x = pk2(s[0 * 33], s[1 * 33]); o.y = pk2(s[2 * 33], s[3 * 33]); o.z = pk2(s[4 * 33], s[5 * 33]); o.w = pk2(s[6 * 33], s[7 * 33]);
        *(u32x4*)(WT + (size_t)(d0 + n) * ldt + k0 + 8 * c) = o; }
    asm volatile("s_waitcnt lgkmcnt(0)" ::: "memory");
}
DI void rms_row_bf16(const float* xrow, const float* g, bf16_t* orow, int lane) {
    const f32x4* xr = (const f32x4*)xrow + lane; const f32x4* gr = (const f32x4*)g + lane;
    f32x4 v[8]; float s = 0.f;
#pragma unroll
    for (int j = 0; j < 8; ++j) { v[j] = xr[64 * j]; s += (v[j].x * v[j].x + v[j].y * v[j].y) + (v[j].z * v[j].z + v[j].w * v[j].w); }
    const float rstd = rsqrtf(wave_sum(s) * (1.f / D) + 1e-6f);
    u32x2* o8 = (u32x2*)orow + lane;
    f32x4 ggs[8];
#pragma unroll
    for (int j = 0; j < 8; ++j) ggs[j] = gr[64 * j];
#pragma unroll
    for (int j = 0; j < 8; ++j) { const f32x4 gg = ggs[j]; u32x2 w; w.x = pk2(v[j].x * rstd * gg.x, v[j].y * rstd * gg.y); w.y = pk2(v[j].z * rstd * gg.z, v[j].w * rstd * gg.w); o8[64 * j] = w; }
}
DI void rms_row_f32(const float* xrow, const float* g, float* orow, int lane) {
    const f32x4* xr = (const f32x4*)xrow + lane; const f32x4* gr = (const f32x4*)g + lane;
    f32x4 v[8]; float s = 0.f;
#pragma unroll
    for (int j = 0; j < 8; ++j) { v[j] = xr[64 * j]; s += (v[j].x * v[j].x + v[j].y * v[j].y) + (v[j].z * v[j].z + v[j].w * v[j].w); }
    const float rstd = rsqrtf(wave_sum(s) * (1.f / D) + 1e-6f);
    f32x4* o = (f32x4*)orow + lane;
    f32x4 ggs[8];
#pragma unroll
    for (int j = 0; j < 8; ++j) ggs[j] = gr[64 * j];
#pragma unroll
    for (int j = 0; j < 8; ++j) o[64 * j] = v[j] * rstd * ggs[j];
}
DI void zero_row_bf16(bf16_t* orow, int ncols, int lane) {
    for (int c = lane * 8; c < ncols; c += 512) *(u32x4*)(orow + c) = (u32x4){0u, 0u, 0u, 0u};
}

DI void phase_prologue(const Args& a, unsigned char* lds, int gw, int ngw, int lane, int wave) {
    unsigned char* ws = a.ws;
    float* scr = (float*)(lds + wave * 16384);
    bf16_t* Win = (bf16_t*)(ws + WS_WIN); bf16_t* Wlo = (bf16_t*)(ws + WS_WLO);
    constexpr int IT_IN = (D / 64) * (CIN / 32);
    for (int it = gw; it < IT_IN; it += ngw) transpose_item(a.in[I_WIN], D, CIN, Win, D, scr, it, lane);
    for (int r = CIN + gw; r < NIN; r += ngw) zero_row_bf16(Win + (size_t)r * D, D, lane);
    {
        const int gt = gw * 64 + lane, ngt = ngw * 64;
        for (int i = gt; i < NLO * KLO; i += ngt) {
            const int n = i / KLO, k = i % KLO; float v = 0.f;
            if (n < 1024) { if (k < 64) v = a.in[I_WUP][k * 1024 + n]; }
            else if (n < 2048) { if (k >= 64 && k < 128) v = a.in[I_AUP][(k - 64) * 1024 + (n - 1024)]; }
            else { if (k >= 128 && k < 288) v = a.in[I_GUP][(k - 128) * 1024 + (n - 2048)]; }
            Wlo[i] = (bf16_t)bf_rne(v);
        }
    }
    { float* RSS = (float*)(ws + WS_RSS); for (int i = gw * 64 + lane; i < MPAD; i += ngw * 64) RSS[i] = 0.f; }
    bf16_t* H = (bf16_t*)(ws + WS_H);
    for (int m = gw; m < MPAD; m += ngw) {
        if (m < MT) rms_row_bf16(m < MP ? a.in[I_XP] + (size_t)m * D : a.in[I_XS] + (size_t)(m - MP) * D, a.in[I_NMG], H + (size_t)m * D, lane);
        else zero_row_bf16(H + (size_t)m * D, D, lane);
    }
}


DI void convert_wo_wup(const Args& a, unsigned char* lds, int wi, int nw, int wave, int lane) {
    float* scr = (float*)(lds + wave * 16384);
    constexpr int IT_O = (D / 64) * (D / 32), IT_UP = (D / 64) * (FF2 / 32);
    for (int it = wi; it < IT_O + IT_UP; it += nw) {
        if (it < IT_O) transpose_item(a.in[I_WO], D, D, (bf16_t*)(a.ws + WS_WO), D, scr, it, lane);
        else transpose_item<true>(a.in[I_FUP], D, FF2, (bf16_t*)(a.ws + WS_WUP), D, scr, it - IT_O, lane);
    }
}
DI void convert_wdn(const Args& a, unsigned char* lds, int wi, int nw, int wave, int lane) {
    float* scr = (float*)(lds + wave * 16384);
    constexpr int IT_DN = (FF / 64) * (D / 32);
    for (int it = wi; it < IT_DN; it += nw) transpose_item(a.in[I_FDN], FF, D, (bf16_t*)(a.ws + WS_WDN), FF, scr, it, lane);
}

DI float rw_prev_val(const Args& a, const bf16_t* RW, int m, int j) {
    if (m < MP) return (m & (SEQ - 1)) == 0 ? 0.f : bf2f(RW[(size_t)(m - 1) * CSH + j]);
    return a.in[I_SSH][(size_t)(m - MP) * CSH + j];
}
DI void lora_input_row(const Args& a, int m, int lane) {
    bf16_t* ALO = (bf16_t*)(a.ws + WS_ALO) + (size_t)m * KLO;
    if (m >= MT) { for (int c = lane; c < KLO; c += 64) ALO[c] = 0; return; }
    const bf16_t* RW = (const bf16_t*)(a.ws + WS_RW);
    const bf16_t* cur = RW + (size_t)m * CSH;
    float x[5], p[5], mu[5];
#pragma unroll
    for (int i = 0; i < 5; ++i) {
        const int c = lane + 64 * i; const bool ok = c < 288; const int j = 3072 + (ok ? c : 0);
        x[i] = bf2f(cur[j]); mu[i] = a.in[I_MU][j];
        p[i] = m < MP ? ((m & (SEQ - 1)) == 0 ? 0.f : bf2f(RW[(size_t)(m - 1) * CSH + j])) : a.in[I_SSH][(size_t)(m - MP) * CSH + j];
    }
#pragma unroll
    for (int i = 0; i < 6; ++i) {
        const int c = lane + 64 * i; float v = 0.f;
        if (i < 5 && c < 288) {
            const float xs = x[i < 5 ? i : 0] + mu[i < 5 ? i : 0] * (p[i < 5 ? i : 0] - x[i < 5 ? i : 0]);
            v = c < 64 ? 1.f - 2.f * __builtin_amdgcn_rcpf(1.f + __expf(2.f * xs)) : (c < 128 ? xs : __builtin_amdgcn_rcpf(1.f + __expf(-xs)));
        }
        ALO[c] = (bf16_t)bf_rne(v);
    }
}

DI int crow(int reg, int h) { return (reg & 3) + 8 * (reg >> 2) + 4 * h; }
typedef short s16x4 __attribute__((ext_vector_type(4)));
constexpr int VPITCH = 192;
DI void attn_prompt_unit(const Args& a, unsigned char* lds, int unit, int wave, int lane) {
    const bf16_t* Qb = (const bf16_t*)(a.ws + WS_QB); const bf16_t* Kb = (const bf16_t*)(a.ws + WS_KB); const bf16_t* Vb = (const bf16_t*)(a.ws + WS_VB);
    bf16_t* PO = (bf16_t*)(a.ws + WS_PART); float* PML = (float*)(a.ws + WS_PML);
    LAS unsigned char* img = (LAS unsigned char*)lds + wave * (32 * VPITCH);
    const int blk = unit & 63, br = (unit >> 6) % 3, bh = unit / 192, b = bh >> 4, h = bh & 15;
    const int rate = br == 0 ? 1 : (br == 1 ? 4 : 16), L = SEQ / rate, bpc = L / 32;
    const int rho = blk / bpc, l0 = (blk % bpc) * 32;
    const int r = lane & 31, hh = lane >> 5;
    const int mq = b * SEQ + rho + rate * (l0 + r);
    bf16x8 qf[4];
#pragma unroll
    for (int ks = 0; ks < 4; ++ks) qf[ks] = *(const bf16x8*)(Qb + ((size_t)bh * SEQ + rho + rate * (l0 + r)) * 64 + ks * 16 + 8 * hh);
    f32x16 o0, o1;
#pragma unroll
    for (int i = 0; i < 16; ++i) { o0[i] = 0.f; o1[i] = 0.f; }
    float mrun = -1e30f, lrun = 0.f;
    const int lq = l0 + r;
    const int c0 = l0 >= 128 ? 0 : (128 - l0) >> 5;
    const bf16_t* kbase = Kb + ((size_t)bh * SEQ + rho) * 64 + 8 * hh;
    const bf16_t* vbase = Vb + ((size_t)bh * SEQ + rho) * 64 + 8 * (lane & 7);
    bf16x8 kreg[4]; u32x4 vreg[4];
#define AT_PREFETCH(ch_) do { const int lk0_ = l0 - 128 + 32 * (ch_); \
        _Pragma("unroll") for (int ks = 0; ks < 4; ++ks) kreg[ks] = *(const bf16x8*)(kbase + (size_t)(rate * (lk0_ + r)) * 64 + ks * 16); \
        _Pragma("unroll") for (int i = 0; i < 4; ++i) vreg[i] = *(const u32x4*)(vbase + (size_t)(rate * (lk0_ + 8 * i + (lane >> 3))) * 64); } while (0)
    AT_PREFETCH(c0);
    const int i16 = lane & 15, tq = i16 >> 2, tp = i16 & 3, g16 = (lane >> 4) & 1;
    const unsigned troff = (unsigned)((4 * hh + tq) * VPITCH + g16 * 32 + 8 * tp);
    for (int ch = c0; ch < 5; ++ch) {
        const int lk0 = l0 - 128 + 32 * ch;
        bf16x8 kf[4];
#pragma unroll
        for (int ks = 0; ks < 4; ++ks) kf[ks] = kreg[ks];
#pragma unroll
        for (int i = 0; i < 4; ++i) *(LAS u32x4*)(img + (8 * i + (lane >> 3)) * VPITCH + 16 * (lane & 7)) = vreg[i];
        if (ch + 1 < 5) AT_PREFETCH(ch + 1);
        f32x16 st;
#pragma unroll
        for (int i = 0; i < 16; ++i) st[i] = 0.f;
#pragma unroll
        for (int ks = 0; ks < 4; ++ks) st = __builtin_amdgcn_mfma_f32_32x32x16_bf16(kf[ks], qf[ks], st, 0, 0, 0);
        float cmax = -1e30f;
        if (ch == 0 || ch == 4) {
#pragma unroll
            for (int i = 0; i < 16; ++i) { const int lk = lk0 + crow(i, hh); const bool ok = (lk <= lq) && (lk >= lq - 128); st[i] = ok ? st[i] : -1e30f; }
        }
#pragma unroll
        for (int i = 0; i < 16; ++i) cmax = fmaxf(cmax, st[i]);
        cmax = fmaxf(cmax, __shfl_xor(cmax, 32));
        const float mnew = fmaxf(mrun, cmax), alpha = __builtin_amdgcn_exp2f(mrun - mnew);
        float ps = 0.f;
#pragma unroll
        for (int i = 0; i < 16; ++i) { const float p = __builtin_amdgcn_exp2f(st[i] - mnew); st[i] = p; ps += p; }
        lrun = lrun * alpha + ps; mrun = mnew;
#pragma unroll
        for (int i = 0; i < 16; ++i) { o0[i] *= alpha; o1[i] *= alpha; }
#pragma unroll
        for (int s = 0; s < 2; ++s) {
            u32x4 pp; pp.x = pk2(st[8 * s], st[8 * s + 1]); pp.y = pk2(st[8 * s + 2], st[8 * s + 3]); pp.z = pk2(st[8 * s + 4], st[8 * s + 5]); pp.w = pk2(st[8 * s + 6], st[8 * s + 7]);
            const bf16x8 pf = __builtin_bit_cast(bf16x8, pp);
#pragma unroll
            for (int dt = 0; dt < 2; ++dt) {
                const s16x4 lo = __builtin_amdgcn_ds_read_tr16_b64_v4i16((LAS s16x4*)(img + troff + (16 * s) * VPITCH + dt * 64));
                const s16x4 hi = __builtin_amdgcn_ds_read_tr16_b64_v4i16((LAS s16x4*)(img + troff + (16 * s + 8) * VPITCH + dt * 64));
                const bf16x8 vf = __builtin_shufflevector(lo, hi, 0, 1, 2, 3, 4, 5, 6, 7);
                if (dt == 0) o0 = __builtin_amdgcn_mfma_f32_32x32x16_bf16(vf, pf, o0, 0, 0, 0);
                else o1 = __builtin_amdgcn_mfma_f32_32x32x16_bf16(vf, pf, o1, 0, 0, 0);
            }
        }
    }
#undef AT_PREFETCH
    const float ltot = lrun + __shfl_xor(lrun, 32);
    bf16_t* po = PO + ((size_t)br * MP + mq) * 1024 + h * 64;
#pragma unroll
    for (int g = 0; g < 4; ++g) {
        u32x2 w0, w1; w0.x = pk2(o0[4 * g], o0[4 * g + 1]); w0.y = pk2(o0[4 * g + 2], o0[4 * g + 3]); w1.x = pk2(o1[4 * g], o1[4 * g + 1]); w1.y = pk2(o1[4 * g + 2], o1[4 * g + 3]);
        *(u32x2*)(po + 8 * g + 4 * hh) = w0; *(u32x2*)(po + 32 + 8 * g + 4 * hh) = w1;
    }
    if (hh == 0) { float* pm = PML + (((size_t)br * MP + mq) * 16 + h) * 2; pm[0] = mrun; pm[1] = ltot; }
}
DI float sum16(float v) { v = DPP_ADD(v, 0xB1); v = DPP_ADD(v, 0x4E); v = DPP_ADD(v, 0x141); v = DPP_ADD(v, 0x140); return v; }
DI void attn_merge_task(const Args& a, int task, int lane) {
    const int m = task >> 2, h = (task & 3) * 4 + (lane >> 4), d = 4 * (lane & 15);
    const bf16_t* PO = (const bf16_t*)(a.ws + WS_PART); const float* PML = (const float*)(a.ws + WS_PML);
    bf16_t* O = (bf16_t*)(a.ws + WS_O);
    float mb[3], lb[3]; f32x4 ob[3];
#pragma unroll
    for (int br = 0; br < 3; ++br) { const float* pm = PML + (((size_t)br * MP + m) * 16 + h) * 2; mb[br] = pm[0]; lb[br] = pm[1];
        const u32x2 w = *(const u32x2*)(PO + ((size_t)br * MP + m) * 1024 + h * 64 + d);
        ob[br] = (f32x4){__uint_as_float(w.x << 16), __uint_as_float(w.x & 0xffff0000u), __uint_as_float(w.y << 16), __uint_as_float(w.y & 0xffff0000u)}; }
    const float M = fmaxf(mb[0], fmaxf(mb[1], mb[2]));
    f32x4 num = {0.f, 0.f, 0.f, 0.f}; float den = 0.f;
#pragma unroll
    for (int br = 0; br < 3; ++br) { const float w = __builtin_amdgcn_exp2f(mb[br] - M); num += ob[br] * w; den += w * lb[br]; }
    const f32x4 o = num * __builtin_amdgcn_rcpf(den);
    const float ss = sum16(o.x * o.x + o.y * o.y + o.z * o.z + o.w * o.w) * (1.f / 64.f);
    const float rs = rsqrtf(ss + 1e-6f);
    const f32x4 gg = *(const f32x4*)(a.in[I_AOG] + h * 64 + d);
    u32x2 w; w.x = pk2(o.x * rs * gg.x, o.y * rs * gg.y); w.y = pk2(o.z * rs * gg.z, o.w * rs * gg.w);
    *(u32x2*)(O + (size_t)m * D + h * 64 + d) = w;
}
DI void attn_sample_wg(const Args& a, unsigned char* lds, int unit, int wave, int lane) {
    float* part = (float*)lds;
    const int bh = unit * 2 + (wave >> 2), qt = wave & 3, b = bh >> 4, h = bh & 15, g = lane >> 4, l16 = lane & 15;
    const bf16_t* Qb = (const bf16_t*)(a.ws + WS_QB);
    const float* ck = a.in[I_CK] + (size_t)b * 2048 * 1024 + h * 64 + 4 * l16; const float* cv = a.in[I_CV] + (size_t)b * 2048 * 1024 + h * 64 + 4 * l16;
    const float* nk = a.out + O_SK + (size_t)b * 1024 + h * 64 + 4 * l16; const float* nv = a.out + O_SV + (size_t)b * 1024 + h * 64 + 4 * l16;
    const u32x2 qw = *(const u32x2*)(Qb + (size_t)(MP + b) * 1024 + h * 64 + 4 * l16);
    const float q0 = __uint_as_float(qw.x << 16), q1 = __uint_as_float(qw.x & 0xffff0000u), q2 = __uint_as_float(qw.y << 16), q3 = __uint_as_float(qw.y & 0xffff0000u);
    float mrun = -1e30f, lrun = 0.f; f32x4 acc = {0.f, 0.f, 0.f, 0.f};
    const int e0 = qt * 97, e1 = e0 + 97 < 387 ? e0 + 97 : 387;
    for (int ito = 0; ito < 25; ito += 5) {
        f32x4 kv[5], vv[5]; bool valid[5];
#pragma unroll
        for (int k = 0; k < 5; ++k) {
            const int e = e0 + (ito + k) * 4 + g; valid[k] = e < e1;
            const int ee = valid[k] ? e : e0, br = ee / 129, j = ee % 129, rate = br == 0 ? 1 : (br == 1 ? 4 : 16);
            const int row = 2048 - rate * j;
            const float* kp = j == 0 ? nk : ck + (size_t)row * 1024; const float* vp = j == 0 ? nv : cv + (size_t)row * 1024;
            kv[k] = *(const f32x4*)kp; vv[k] = *(const f32x4*)vp;
        }
#pragma unroll
        for (int k = 0; k < 5; ++k) {
            float s = sum16(q0 * kv[k].x + q1 * kv[k].y + q2 * kv[k].z + q3 * kv[k].w);
            if (!valid[k]) s = -1e30f;
            const float mnew = fmaxf(mrun, s), alpha = __builtin_amdgcn_exp2f(mrun - mnew), p = valid[k] ? __builtin_amdgcn_exp2f(s - mnew) : 0.f;
            lrun = lrun * alpha + p; acc = acc * alpha + vv[k] * p; mrun = mnew;
        }
    }
#pragma unroll
    for (int o = 16; o < 64; o <<= 1) {
        const float mo = __shfl_xor(mrun, o), lo = __shfl_xor(lrun, o);
        f32x4 ao; ao.x = __shfl_xor(acc.x, o); ao.y = __shfl_xor(acc.y, o); ao.z = __shfl_xor(acc.z, o); ao.w = __shfl_xor(acc.w, o);
        const float mn = fmaxf(mrun, mo), w0 = __builtin_amdgcn_exp2f(mrun - mn), w1 = __builtin_amdgcn_exp2f(mo - mn);
        lrun = lrun * w0 + lo * w1; acc = acc * w0 + ao * w1; mrun = mn;
    }
    if (g == 0) { *(f32x4*)(part + wave * 68 + 4 * l16) = acc; if (l16 == 0) { part[wave * 68 + 64] = mrun; part[wave * 68 + 65] = lrun; } }
    __syncthreads();
    if (qt == 0 && g == 0) {
        float M = -1e30f;
#pragma unroll
        for (int w = 0; w < 4; ++w) M = fmaxf(M, part[(wave + w) * 68 + 64]);
        f32x4 num = {0.f, 0.f, 0.f, 0.f}; float den = 0.f;
#pragma unroll
        for (int w = 0; w < 4; ++w) { const float wt = __builtin_amdgcn_exp2f(part[(wave + w) * 68 + 64] - M); num += *(const f32x4*)(part + (wave + w) * 68 + 4 * l16) * wt; den += part[(wave + w) * 68 + 65] * wt; }
        const f32x4 o = num * (1.f / den);
        const float ss = sum16(o.x * o.x + o.y * o.y + o.z * o.z + o.w * o.w);
        const float rs = rsqrtf(ss * (1.f / 64.f) + 1e-6f);
        const f32x4 gg = *(const f32x4*)(a.in[I_AOG] + h * 64 + 4 * l16);
        u32x2 w; w.x = pk2(o.x * rs * gg.x, o.y * rs * gg.y); w.y = pk2(o.z * rs * gg.z, o.w * rs * gg.w);
        *(u32x2*)((bf16_t*)(a.ws + WS_O) + (size_t)(MP + b) * D + h * 64 + 4 * l16) = w;
    }
    __syncthreads();
}

struct PrepParams { float mu_r, mu_k, mu_v, w0, a0, kk, ka, rk; };
struct PrepRaw { float cr, ck, cv, pr, pk, pv, lw, la, lg; };
DI void prep_params(const Args& a, PrepParams& P, int c) {
    P.mu_r = a.in[I_MU][c]; P.mu_k = a.in[I_MU][1024 + c]; P.mu_v = a.in[I_MU][2048 + c];
    P.w0 = a.in[I_W0][c]; P.a0 = a.in[I_A0][c]; P.kk = a.in[I_KK][c]; P.ka = a.in[I_KA][c]; P.rk = a.in[I_RK][c];
}
DI void prep_load(const Args& a, PrepRaw& R, const bf16_t* RW, int m, const bf16_t* Lrow, int c) {
    const bf16_t* cur = RW + (size_t)m * CSH;
    R.cr = bf2f(cur[c]); R.ck = bf2f(cur[1024 + c]); R.cv = bf2f(cur[2048 + c]);
    R.pr = rw_prev_val(a, RW, m, c); R.pk = rw_prev_val(a, RW, m, 1024 + c); R.pv = rw_prev_val(a, RW, m, 2048 + c);
    R.lw = bf2f(Lrow[c]); R.la = bf2f(Lrow[1024 + c]); R.lg = bf2f(Lrow[2048 + c]);
}
DI void prep_finish(const PrepRaw& R, const PrepParams& P, float* dst, float& g_out, float& bonus_out, int lane) {
    const float xr = R.cr + P.mu_r * (R.pr - R.cr), xk = R.ck + P.mu_k * (R.pk - R.ck), xv = R.cv + P.mu_v * (R.pv - R.cv);
    const float x = -(P.w0 + R.lw);
    const float sp = x > 20.f ? x : __logf(1.f + __expf(x));
    const float decay = __expf(-__expf(-sp - 0.5f));
    const float av = __builtin_amdgcn_rcpf(1.f + __expf(-(P.a0 + R.la)));
    float kkv = xk * P.kk;
    const float n2 = wave_sum(kkv * kkv);
    kkv = kkv * fminf(__builtin_amdgcn_rsqf(n2), 1e12f);
    const float keff = xk * (1.f + (av - 1.f) * P.ka);
    const float bon = wave_sum(xr * keff * P.rk) * xv;
    dst[lane] = xr; dst[64 + lane] = decay; dst[128 + lane] = keff; dst[192 + lane] = xv; dst[256 + lane] = -kkv; dst[320 + lane] = kkv * av;
    g_out = R.lg; bonus_out = bon;
}
DI float scan_step(float (&S)[64], const float* sv, float vi) {
    const f32x4* r4 = (const f32x4*)sv; const f32x4* w4 = (const f32x4*)(sv + 64); const f32x4* k4 = (const f32x4*)(sv + 128);
    const f32x4* a4 = (const f32x4*)(sv + 256); const f32x4* b4 = (const f32x4*)(sv + 320);
    float sa0 = 0.f, sa1 = 0.f;
#pragma unroll
    for (int j = 0; j < 16; ++j) { const f32x4 av = a4[j]; sa0 = fmaf(S[4 * j], av.x, sa0); sa1 = fmaf(S[4 * j + 1], av.y, sa1); sa0 = fmaf(S[4 * j + 2], av.z, sa0); sa1 = fmaf(S[4 * j + 3], av.w, sa1); }
    const float sa = sa0 + sa1;
    float y0 = 0.f, y1 = 0.f;
#pragma unroll
    for (int j = 0; j < 16; ++j) {
        const f32x4 bv = b4[j], kv = k4[j], wv = w4[j], rv = r4[j];
        float t;
        t = fmaf(vi, kv.x, sa * bv.x); S[4 * j] = fmaf(S[4 * j], wv.x, t); y0 = fmaf(S[4 * j], rv.x, y0);
        t = fmaf(vi, kv.y, sa * bv.y); S[4 * j + 1] = fmaf(S[4 * j + 1], wv.y, t); y1 = fmaf(S[4 * j + 1], rv.y, y1);
        t = fmaf(vi, kv.z, sa * bv.z); S[4 * j + 2] = fmaf(S[4 * j + 2], wv.z, t); y0 = fmaf(S[4 * j + 2], rv.z, y0);
        t = fmaf(vi, kv.w, sa * bv.w); S[4 * j + 3] = fmaf(S[4 * j + 3], wv.w, t); y1 = fmaf(S[4 * j + 3], rv.w, y1);
        if ((j & 3) == 3) asm volatile("" ::: "memory");
    }
    return y0 + y1;
}
DI void rwkv_post(const Args& a, float y, float g, float bonus, int m, int c) {
    const float mean = wave_sum(y) * (1.f / 64.f); const float d = y - mean; const float var = wave_sum(d * d) * (1.f / 64.f);
    const float yn = d * rsqrtf(var + 64e-5f) * a.in[I_LNW][c] + a.in[I_LNB][c];
    ((bf16_t*)(a.ws + WS_O))[(size_t)m * D + 1024 + c] = (bf16_t)bf_rne((yn + bonus) * g);
}

#define WG_BAR_LDS() do { asm volatile("s_waitcnt lgkmcnt(0)" ::: "memory"); __builtin_amdgcn_s_barrier(); asm volatile("" ::: "memory"); } while (0)
typedef float f32x2 __attribute__((ext_vector_type(2)));
DI f32x2 fma2(f32x2 a, f32x2 b, f32x2 c) { return __builtin_elementwise_fma(a, b, c); }
DI void scan_dot_a(const f32x2 (&Z)[32], const f32x2 (&P)[32], const float* sv, float& sz, float& sp) {
    const f32x4* a4 = (const f32x4*)(sv + 256);
    f32x2 saz = {0.f, 0.f}, sap = {0.f, 0.f};
#pragma unroll
    for (int j = 0; j < 16; ++j) { const f32x4 av = a4[j]; const f32x2 a0 = {av.x, av.y}, a1 = {av.z, av.w};
        saz = fma2(Z[2 * j], a0, saz); sap = fma2(P[2 * j], a0, sap); saz = fma2(Z[2 * j + 1], a1, saz); sap = fma2(P[2 * j + 1], a1, sap);
        if ((j & 7) == 7) asm volatile("" ::: "memory"); }
    sz = saz.x + saz.y; sp = sap.x + sap.y;
}
DI void scan_step3(f32x2 (&Z)[32], f32x2 (&P)[32], const float* sv, const float* svn, float vi, float& sz, float& sp, float& yz, float& yp) {
    const f32x4* r4 = (const f32x4*)sv; const f32x4* w4 = (const f32x4*)(sv + 64); const f32x4* k4 = (const f32x4*)(sv + 128);
    const f32x4* b4 = (const f32x4*)(sv + 320); const f32x4* an4 = (const f32x4*)(svn + 256);
    const f32x2 sz2 = {sz, sz}, sp2 = {sp, sp}, v2 = {vi, vi};
    f32x2 yz2 = {0.f, 0.f}, yp2 = {0.f, 0.f}, nz2 = {0.f, 0.f}, np2 = {0.f, 0.f};
    f32x4 buf[3][5];
#define S3_LD(g, j) do { buf[g][0] = b4[j]; buf[g][1] = k4[j]; buf[g][2] = w4[j]; buf[g][3] = r4[j]; buf[g][4] = an4[j]; asm volatile("" ::: "memory"); } while (0)
    S3_LD(0, 0); S3_LD(1, 1);
#pragma unroll
    for (int j = 0; j < 16; ++j) {
        if (j + 2 < 16) S3_LD((j + 2) % 3, j + 2);
        const f32x4 bv = buf[j % 3][0], kv = buf[j % 3][1], wv = buf[j % 3][2], rv = buf[j % 3][3], av = buf[j % 3][4];
        { const f32x2 b2 = {bv.x, bv.y}, k2 = {kv.x, kv.y}, w2 = {wv.x, wv.y}, r2 = {rv.x, rv.y}, a2 = {av.x, av.y};
          f32x2 tz = sz2 * b2; tz = fma2(v2, k2, tz); Z[2 * j] = fma2(Z[2 * j], w2, tz); yz2 = fma2(Z[2 * j], r2, yz2); nz2 = fma2(Z[2 * j], a2, nz2);
          const f32x2 tp = sp2 * b2; P[2 * j] = fma2(P[2 * j], w2, tp); yp2 = fma2(P[2 * j], r2, yp2); np2 = fma2(P[2 * j], a2, np2); }
        { const f32x2 b2 = {bv.z, bv.w}, k2 = {kv.z, kv.w}, w2 = {wv.z, wv.w}, r2 = {rv.z, rv.w}, a2 = {av.z, av.w};
          f32x2 tz = sz2 * b2; tz = fma2(v2, k2, tz); Z[2 * j + 1] = fma2(Z[2 * j + 1], w2, tz); yz2 = fma2(Z[2 * j + 1], r2, yz2); nz2 = fma2(Z[2 * j + 1], a2, nz2);
          const f32x2 tp = sp2 * b2; P[2 * j + 1] = fma2(P[2 * j + 1], w2, tp); yp2 = fma2(P[2 * j + 1], r2, yp2); np2 = fma2(P[2 * j + 1], a2, np2); }
        asm volatile("" ::: "memory");
    }
#undef S3_LD
    yz = yz2.x + yz2.y; yp = yp2.x + yp2.y; sz = nz2.x + nz2.y; sp = np2.x + np2.y;
}
DI void scan_pass1_unit(const Args& a, unsigned char* lds, int unit, int wave, int lane) {
    float* stg = (float*)lds;
    const int pp = wave & 3, pair = unit * 4 + pp, chain = pair / NS, seg = pair % NS, b = chain >> 4, h = chain & 15, c = h * 64 + lane;
    const int mbase = b * SEQ + seg * SEGL;
    constexpr int NB = SEGL / TB;
    if (wave < 4) {
        bf16_t* YL = (bf16_t*)(a.ws + WS_YL); bf16_t* QS = (bf16_t*)(a.ws + WS_QS); float* ZP = (float*)(a.ws + WS_ZP);
        f32x2 Z[32], P[32];
        int idl = lane; asm volatile("" : "+v"(idl));
#pragma unroll
        for (int j = 0; j < 32; ++j) { Z[j] = (f32x2){0.f, 0.f}; P[j] = (f32x2){idl == 2 * j ? 1.f : 0.f, idl == 2 * j + 1 ? 1.f : 0.f}; }
        WG_BAR_LDS();
        for (int blk = 0; blk < NB; ++blk) {
            const float* sb = stg + (((blk & 1) * 4 + pp) * TB) * 384;
            float sz, sp; scan_dot_a(Z, P, sb, sz, sp);
#pragma unroll 1
            for (int tt = 0; tt < TB; ++tt) {
                const float* sv = sb + tt * 384; const float* svn = sb + (tt + 1 < TB ? tt + 1 : tt) * 384;
                float yz, yp; scan_step3(Z, P, sv, svn, sv[192 + lane], sz, sp, yz, yp);
                const size_t o = (size_t)(mbase + blk * TB + tt) * 1024 + c;
                const unsigned yq = pk2(yz, yp); YL[o] = (bf16_t)(yq & 0xffffu); QS[o] = (bf16_t)(yq >> 16);
            }
            WG_BAR_LDS();
        }
        float* zp = ZP + (size_t)pair * 2 * 4096 + lane * 64;
#pragma unroll
        for (int j = 0; j < 16; ++j) { *(f32x4*)(zp + 4 * j) = (f32x4){Z[2 * j].x, Z[2 * j].y, Z[2 * j + 1].x, Z[2 * j + 1].y};
                                       *(f32x4*)(zp + 4096 + 4 * j) = (f32x4){P[2 * j].x, P[2 * j].y, P[2 * j + 1].x, P[2 * j + 1].y}; }
    } else {
        const bf16_t* RW = (const bf16_t*)(a.ws + WS_RW); const bf16_t* Lb = (const bf16_t*)(a.ws + WS_L);
        bf16_t* GB = (bf16_t*)(a.ws + WS_GB);
        PrepParams Pm; prep_params(a, Pm, c);
        PrepRaw raw[TB];
#define P1_LOAD(blk_) do { _Pragma("unroll") for (int k = 0; k < TB; ++k) { const int m = mbase + (blk_) * TB + k; prep_load(a, raw[k], RW, m, Lb + (size_t)m * NLO, c); } } while (0)
#define P1_FINISH(blk_) do { _Pragma("unroll") for (int k = 0; k < TB; ++k) { const int m = mbase + (blk_) * TB + k; float g, bon; \
            prep_finish(raw[k], Pm, stg + ((((blk_) & 1) * 4 + pp) * TB + k) * 384, g, bon, lane); \
            GB[((size_t)m * 16 + h) * 128 + lane] = (bf16_t)bf_rne(g); GB[((size_t)m * 16 + h) * 128 + 64 + lane] = (bf16_t)bf_rne(bon); } } while (0)
        P1_LOAD(0); P1_FINISH(0); P1_LOAD(1);
        WG_BAR_LDS();
        for (int blk = 0; blk < NB; ++blk) {
            if (blk + 1 < NB) P1_FINISH(blk + 1);
            if (blk + 2 < NB) P1_LOAD(blk + 2);
            WG_BAR_LDS();
        }
#undef P1_LOAD
#undef P1_FINISH
    }
}
DI void scan_sample_unit(const Args& a, unsigned char* lds, int unit, int wave, int lane) {
    float* sv = (float*)(lds + 2 * 4 * TB * 384 * 4) + wave * 384;
    const bf16_t* RW = (const bf16_t*)(a.ws + WS_RW); const bf16_t* Lb = (const bf16_t*)(a.ws + WS_L);
    const int b = unit >> 4, h = unit & 15, c = h * 64 + lane, m = MP + b;
    PrepParams P; prep_params(a, P, c);
    PrepRaw raw; prep_load(a, raw, RW, m, Lb + (size_t)m * NLO, c);
    float g, bon; prep_finish(raw, P, sv, g, bon, lane);
    float S[64];
    const float* s0 = a.in[I_SWKV] + ((size_t)(b * 16 + h) * 64 + lane) * 64;
#pragma unroll
    for (int j = 0; j < 16; ++j) { const f32x4 v = *(const f32x4*)(s0 + 4 * j); S[4 * j] = v.x; S[4 * j + 1] = v.y; S[4 * j + 2] = v.z; S[4 * j + 3] = v.w; }
    const float y = scan_step(S, sv, sv[192 + lane]);
    float* so = a.out + O_SWKV + ((size_t)(b * 16 + h) * 64 + lane) * 64;
#pragma unroll
    for (int j = 0; j < 16; ++j) *(f32x4*)(so + 4 * j) = (f32x4){S[4 * j], S[4 * j + 1], S[4 * j + 2], S[4 * j + 3]};
    rwkv_post(a, y, g, bon, m, c);
}
DI void scan_pass2_unit(const Args& a, unsigned char* lds, int chain, int wave, int lane) {
    float* Ssh = (float*)lds;
    float* Psh = Ssh + 64 * 65;
    const float* ZP = (const float*)(a.ws + WS_ZP); float* SST = (float*)(a.ws + WS_SST);
    const int tid = wave * 64 + lane, l16 = lane & 15, lq = lane >> 4, ib = wave >> 1, jb0 = 2 * (wave & 1);
    f32x4 S0 = {0.f, 0.f, 0.f, 0.f}, S1 = {0.f, 0.f, 0.f, 0.f};
    const float* Z0 = ZP + (size_t)(chain * NS) * 2 * 4096;
    f32x4 pn0 = *(const f32x4*)(Z0 + 4096 + tid * 8), pn1 = *(const f32x4*)(Z0 + 4096 + tid * 8 + 4);
    float zn0[4], zn1[4];
#pragma unroll
    for (int i = 0; i < 4; ++i) { zn0[i] = Z0[(16 * ib + 4 * lq + i) * 64 + 16 * jb0 + l16]; zn1[i] = Z0[(16 * ib + 4 * lq + i) * 64 + 16 * (jb0 + 1) + l16]; }
    for (int s = 0; s < NS; ++s) {
        float* sst = SST + ((size_t)chain * NS + s) * 4096;
#pragma unroll
        for (int i = 0; i < 4; ++i) { const int row = 16 * ib + 4 * lq + i;
            sst[row * 64 + 16 * jb0 + l16] = S0[i]; sst[row * 64 + 16 * (jb0 + 1) + l16] = S1[i];
            Ssh[row * 65 + 16 * jb0 + l16] = S0[i]; Ssh[row * 65 + 16 * (jb0 + 1) + l16] = S1[i]; }
        *(f32x4*)(Psh + tid * 8) = pn0; *(f32x4*)(Psh + tid * 8 + 4) = pn1;
        f32x4 n0 = {zn0[0], zn0[1], zn0[2], zn0[3]}, n1 = {zn1[0], zn1[1], zn1[2], zn1[3]};
        if (s + 1 < NS) {
            const float* Zs = ZP + (size_t)(chain * NS + s + 1) * 2 * 4096;
            pn0 = *(const f32x4*)(Zs + 4096 + tid * 8); pn1 = *(const f32x4*)(Zs + 4096 + tid * 8 + 4);
#pragma unroll
            for (int i = 0; i < 4; ++i) { zn0[i] = Zs[(16 * ib + 4 * lq + i) * 64 + 16 * jb0 + l16]; zn1[i] = Zs[(16 * ib + 4 * lq + i) * 64 + 16 * (jb0 + 1) + l16]; }
        }
        WG_BAR_LDS();
        if (s > 0) {
#pragma unroll
            for (int kk = 0; kk < 16; ++kk) {
                const float af = Ssh[(16 * ib + l16) * 65 + 4 * kk + lq];
                const float b0 = Psh[(4 * kk + lq) * 64 + 16 * jb0 + l16], b1 = Psh[(4 * kk + lq) * 64 + 16 * (jb0 + 1) + l16];
                n0 = __builtin_amdgcn_mfma_f32_16x16x4f32(af, b0, n0, 0, 0, 0);
                n1 = __builtin_amdgcn_mfma_f32_16x16x4f32(af, b1, n1, 0, 0, 0);
            }
        }
        WG_BAR_LDS();
        S0 = n0; S1 = n1;
    }
    float* so = a.out + O_PWKV + (size_t)chain * 4096;
#pragma unroll
    for (int i = 0; i < 4; ++i) { const int row = 16 * ib + 4 * lq + i; so[row * 64 + 16 * jb0 + l16] = S0[i]; so[row * 64 + 16 * (jb0 + 1) + l16] = S1[i]; }
}
DI bf16x8 cvt8(const f32x4 lo, const f32x4 hi) { u32x4 p; p.x = pk2(lo.x, lo.y); p.y = pk2(lo.z, lo.w); p.z = pk2(hi.x, hi.y); p.w = pk2(hi.z, hi.w); return __builtin_bit_cast(bf16x8, p); }
DI void scan_pass3_unit(const Args& a, int unit, int lane) {
    const float* SST = (const float*)(a.ws + WS_SST); const bf16_t* YL = (const bf16_t*)(a.ws + WS_YL); const bf16_t* QS = (const bf16_t*)(a.ws + WS_QS); const bf16_t* GB = (const bf16_t*)(a.ws + WS_GB);
    bf16_t* O = (bf16_t*)(a.ws + WS_O);
    const int sub = unit & 3, pair = unit >> 2, chain = pair / NS, seg = pair % NS, b = chain >> 4, h = chain & 15;
    const int r = lane & 31, hh = lane >> 5;
    const int m = b * SEQ + seg * SEGL + sub * 32 + r;
    f32x16 acc0, acc1;
#pragma unroll
    for (int i = 0; i < 16; ++i) { acc0[i] = 0.f; acc1[i] = 0.f; }
    const bf16_t* qrow = QS + (size_t)m * 1024 + h * 64 + 8 * hh;
    const float* s0 = SST + (size_t)pair * 4096 + (size_t)r * 64 + 8 * hh; const float* s1 = s0 + 32 * 64;
#pragma unroll
    for (int ks = 0; ks < 4; ++ks) {
        const bf16x8 qf = *(const bf16x8*)(qrow + ks * 16);
        const bf16x8 a0 = cvt8(*(const f32x4*)(s0 + ks * 16), *(const f32x4*)(s0 + ks * 16 + 4));
        const bf16x8 a1 = cvt8(*(const f32x4*)(s1 + ks * 16), *(const f32x4*)(s1 + ks * 16 + 4));
        acc0 = __builtin_amdgcn_mfma_f32_32x32x16_bf16(a0, qf, acc0, 0, 0, 0);
        acc1 = __builtin_amdgcn_mfma_f32_32x32x16_bf16(a1, qf, acc1, 0, 0, 0);
    }
    const bf16_t* yl = YL + (size_t)m * 1024 + h * 64 + 4 * hh;
    float y[32]; float sum = 0.f;
#pragma unroll
    for (int rt = 0; rt < 2; ++rt)
#pragma unroll
        for (int g = 0; g < 4; ++g) { const u32x2 yw = *(const u32x2*)(yl + rt * 32 + 8 * g); const f32x4 v = {__uint_as_float(yw.x << 16), __uint_as_float(yw.x & 0xffff0000u), __uint_as_float(yw.y << 16), __uint_as_float(yw.y & 0xffff0000u)};
#pragma unroll
            for (int e = 0; e < 4; ++e) { const float yy = v[e] + (rt == 0 ? acc0[4 * g + e] : acc1[4 * g + e]); y[rt * 16 + 4 * g + e] = yy; sum += yy; } }
    sum += __shfl_xor(sum, 32);
    const float mean = sum * (1.f / 64.f);
    float vs = 0.f;
#pragma unroll
    for (int e = 0; e < 32; ++e) { y[e] -= mean; vs += y[e] * y[e]; }
    vs += __shfl_xor(vs, 32);
    const float rstd = rsqrtf(vs * (1.f / 64.f) + 64e-5f);
    const bf16_t* gb = GB + ((size_t)m * 16 + h) * 128 + 4 * hh;
    const float* lw = a.in[I_LNW] + h * 64 + 4 * hh; const float* lb = a.in[I_LNB] + h * 64 + 4 * hh;
    bf16_t* orow = O + (size_t)m * D + 1024 + h * 64 + 4 * hh;
    f32x4 w4s[8], b4s[8]; u32x2 gws[8], bws[8];
#pragma unroll
    for (int q = 0; q < 8; ++q) { const int off = (q >> 2) * 32 + 8 * (q & 3); w4s[q] = *(const f32x4*)(lw + off); b4s[q] = *(const f32x4*)(lb + off); gws[q] = *(const u32x2*)(gb + off); bws[q] = *(const u32x2*)(gb + 64 + off); }
#pragma unroll
    for (int rt = 0; rt < 2; ++rt)
#pragma unroll
        for (int g = 0; g < 4; ++g) {
            const int off = rt * 32 + 8 * g;
            const f32x4 w4 = w4s[rt * 4 + g], b4 = b4s[rt * 4 + g];
            const u32x2 gw = gws[rt * 4 + g], bw = bws[rt * 4 + g];
            const float gg[4] = {__uint_as_float(gw.x << 16), __uint_as_float(gw.x & 0xffff0000u), __uint_as_float(gw.y << 16), __uint_as_float(gw.y & 0xffff0000u)};
            const float bb[4] = {__uint_as_float(bw.x << 16), __uint_as_float(bw.x & 0xffff0000u), __uint_as_float(bw.y << 16), __uint_as_float(bw.y & 0xffff0000u)};
            float o[4];
#pragma unroll
            for (int e = 0; e < 4; ++e) o[e] = (y[rt * 16 + 4 * g + e] * rstd * w4[e] + b4[e] + bb[e]) * gg[e];
            u32x2 w; w.x = pk2(o[0], o[1]); w.y = pk2(o[2], o[3]);
            *(u32x2*)(orow + off) = w;
        }
}

DI void unpack8(const u32x4 w, float (&u)[8]) {
    u[0] = __uint_as_float(w.x << 16); u[1] = __uint_as_float(w.x & 0xffff0000u); u[2] = __uint_as_float(w.y << 16); u[3] = __uint_as_float(w.y & 0xffff0000u);
    u[4] = __uint_as_float(w.z << 16); u[5] = __uint_as_float(w.z & 0xffff0000u); u[6] = __uint_as_float(w.w << 16); u[7] = __uint_as_float(w.w & 0xffff0000u);
}
constexpr int FIX_ROWS = 28 * 2 + MS + 8;
DI void conv_fix(const Args& a, int idx) {
    const int fg = idx % (FF / 8), ri = idx / (FF / 8), f = fg * 8;
    if (ri >= FIX_ROWS) return;
    const float* EDGE = (const float*)(a.ws + WS_U); bf16_t* ACT = (bf16_t*)(a.ws + WS_ACT);
    const float* cw = a.in[I_FCW]; const float* cb = a.in[I_FCB];
    const float *p0, *p1, *p2; int m;
    if (ri < 56) {
        const int ti = ri >> 1, k = ri & 1, pm = ti + 1 + ti / 7;
        m = pm * 256 + k;
        p0 = EDGE + ((size_t)pm * 4 + k) * FF2;
        p1 = k == 0 ? EDGE + ((size_t)(pm - 1) * 4 + 3) * FF2 : EDGE + ((size_t)pm * 4 + 0) * FF2;
        p2 = k == 0 ? EDGE + ((size_t)(pm - 1) * 4 + 2) * FF2 : EDGE + ((size_t)(pm - 1) * 4 + 3) * FF2;
    } else if (ri >= 56 + MS) {
        const int q = ri - 56 - MS, bb = q >> 1, k = q & 1;
        const float* src = EDGE + ((size_t)(bb * 8 + 7) * 4 + 2 + k) * FF2; float* dst = a.out + O_PFFN + ((size_t)bb * 2 + k) * FF2;
#pragma unroll
        for (int p = 0; p < 2; ++p) { *(f32x4*)(dst + p * FF + f) = *(const f32x4*)(src + p * FF + f); *(f32x4*)(dst + p * FF + f + 4) = *(const f32x4*)(src + p * FF + f + 4); }
        return;
    } else {
        const int b = ri - 56; m = MP + b;
        p0 = EDGE + (size_t)(128 + b) * FF2;
        { float* s1 = a.out + O_SFFN + (size_t)b * 2 * FF2 + FF2;
#pragma unroll
          for (int p = 0; p < 2; ++p) { *(f32x4*)(s1 + p * FF + f) = *(const f32x4*)(p0 + p * FF + f); *(f32x4*)(s1 + p * FF + f + 4) = *(const f32x4*)(p0 + p * FF + f + 4); } }
        p1 = a.in[I_SFFN] + (size_t)b * 2 * FF2 + FF2;
        p2 = a.in[I_SFFN] + (size_t)b * 2 * FF2;
        float* so = a.out + O_SFFN + (size_t)b * 2 * FF2;
#pragma unroll
        for (int p = 0; p < 2; ++p) { *(f32x4*)(so + p * FF + f) = *(const f32x4*)(p1 + p * FF + f); *(f32x4*)(so + p * FF + f + 4) = *(const f32x4*)(p1 + p * FF + f + 4); }
    }
    float c[2][8];
#pragma unroll
    for (int p = 0; p < 2; ++p)
#pragma unroll
        for (int j = 0; j < 8; ++j) { const int col = p * FF + f + j; c[p][j] = cb[col] + cw[col] * p2[col] + cw[FF2 + col] * p1[col] + cw[2 * FF2 + col] * p0[col]; }
    float o[8];
#pragma unroll
    for (int j = 0; j < 8; ++j) o[j] = c[0][j] * __builtin_amdgcn_rcpf(1.f + __expf(-c[0][j])) * c[1][j];
    u32x4 w; w.x = pk2(o[0], o[1]); w.y = pk2(o[2], o[3]); w.z = pk2(o[4], o[5]); w.w = pk2(o[6], o[7]);
    *(u32x4*)(ACT + (size_t)m * FF + f) = w;
}

#define XB_TMO      128
#define XB_XCNT(j)  (256  + 64 * (j))
#define XB_XSUB(j)  (1280 + 64 * (j))
#define XB_XGEN(j)  (2304 + 64 * (j))
#define XB_TOP      3328
#define XB_TOPGEN   3392
#define XCD_BAR_WORDS 3456
#define XB_SPIN_CAP (1u << 18)
DI unsigned xb_ld(unsigned* p)              { return __hip_atomic_load(p, __ATOMIC_RELAXED, __HIP_MEMORY_SCOPE_AGENT); }
DI unsigned xb_add(unsigned* p, unsigned v) { return __hip_atomic_fetch_add(p, v, __ATOMIC_RELAXED, __HIP_MEMORY_SCOPE_AGENT); }
DI unsigned xb_xcc_id() { return (unsigned)__builtin_amdgcn_s_getreg((3 << 11) | 20) & 0xFu; }
#define XB_SPIN(cond, bar) do { unsigned _sp = 0; while (cond) { __builtin_amdgcn_s_sleep(1); \
    if ((++_sp & 255u) == 0u) { if (xb_ld(&(bar)[XB_TMO])) break; if (_sp > XB_SPIN_CAP) { atomicAdd(&(bar)[XB_TMO], 1u); break; } } } } while (0)
struct XcdBarrier { unsigned* bar; unsigned x; volatile LAS unsigned* st; };
DI XcdBarrier xcd_barrier_post(unsigned* bar, volatile LAS unsigned* st) {
    XcdBarrier b; b.bar = bar; b.x = xb_xcc_id(); b.st = st;
    if (threadIdx.x == 0) (void)xb_add(&bar[XB_XCNT(b.x)], 1u);
    return b;
}
DI void xcd_barrier_complete(unsigned* bar, unsigned x, unsigned& nloc, unsigned& nx) {
    const unsigned G = gridDim.x * gridDim.y * gridDim.z;
    unsigned sum, cnt, mine, sp = 0u;
    for (;;) {
        sum = 0u; cnt = 0u; mine = 0u;
#pragma unroll
        for (unsigned j = 0; j < 16; ++j) { const unsigned c = xb_ld(&bar[XB_XCNT(j)]); sum += c; cnt += (c > 0u) ? 1u : 0u; mine = (j == x) ? c : mine; }
        if (sum == G) break;
        __builtin_amdgcn_s_sleep(1);
        if ((++sp & 255u) == 0u) { if (xb_ld(&bar[XB_TMO])) break; if (sp > XB_SPIN_CAP) { atomicAdd(&bar[XB_TMO], 1u); break; } }
    }
    nloc = mine > 0u ? mine : 1u; nx = cnt > 0u ? cnt : 1u;
}
DI void xcd_barrier(const XcdBarrier& b) {
    asm volatile("s_waitcnt vmcnt(0)" ::: "memory");
    __syncthreads();
    if (threadIdx.x == 0) {
        unsigned* bar = b.bar;
        __builtin_amdgcn_s_waitcnt(0);
        unsigned nloc = b.st[0], nx = b.st[1];
        if (nloc == 0u) { xcd_barrier_complete(bar, b.x, nloc, nx); b.st[0] = nloc; b.st[1] = nx; }
        const unsigned old = xb_add(&bar[XB_XSUB(b.x)], 1u);
        const unsigned gen = old / nloc;
        if (old + 1u == (gen + 1u) * nloc) {
            __builtin_amdgcn_fence(__ATOMIC_RELEASE, "agent");
            asm volatile("s_waitcnt vmcnt(0)" ::: "memory");
            const unsigned og = xb_add(&bar[XB_TOP], 1u);
            const unsigned tg = og / nx;
            if (og + 1u == (tg + 1u) * nx) xb_add(&bar[XB_TOPGEN], 1u);
            else XB_SPIN(xb_ld(&bar[XB_TOPGEN]) == tg, bar);
            __builtin_amdgcn_fence(__ATOMIC_ACQUIRE, "agent");
            xb_add(&bar[XB_XGEN(b.x)], 1u);
            asm volatile("s_waitcnt vmcnt(0)" ::: "memory");
        } else {
            XB_SPIN(xb_ld(&bar[XB_XGEN(b.x)]) == gen, bar);
            __builtin_amdgcn_fence(__ATOMIC_ACQUIRE, "agent");
            asm volatile("s_waitcnt vmcnt(0)" ::: "memory");
        }
    }
    __syncthreads();
}

DI void skinny_unit(const bf16_t* A, int lda, const bf16_t* Bt, int K, int unit, const float* base, int ldb, float* out, int ldo, unsigned char* lds, int wave, int lane,
                    const float* gf = nullptr, bf16_t* H = nullptr, float* RSS = nullptr) {
    float* red = (float*)lds;
    const int n0 = unit * 32, r = lane & 31, hh = lane >> 5, kw = K / 8, kb = wave * kw;
    f32x16 acc;
#pragma unroll
    for (int i = 0; i < 16; ++i) acc[i] = 0.f;
    const bf16_t* ap = A + (size_t)r * lda + kb + 8 * hh; const bf16_t* bp = Bt + (size_t)(n0 + r) * K + kb + 8 * hh;
    for (int k0 = 0; k0 < kw; k0 += 128) {
        bf16x8 af[8], bf[8];
#pragma unroll
        for (int i = 0; i < 8; ++i) { const int k = k0 + 16 * i < kw ? k0 + 16 * i : 0; af[i] = *(const bf16x8*)(ap + k); bf[i] = *(const bf16x8*)(bp + k); }
#pragma unroll
        for (int i = 0; i < 8; ++i) if (k0 + 16 * i < kw) acc = __builtin_amdgcn_mfma_f32_32x32x16_bf16(af[i], bf[i], acc, 0, 0, 0);
    }
#pragma unroll
    for (int i = 0; i < 16; ++i) red[(wave * 16 + i) * 64 + lane] = acc[i];
    __syncthreads();
#pragma unroll
    for (int q = 0; q < 2; ++q) {
        const int o = threadIdx.x + 512 * q, i = o >> 6, ln = o & 63;
        float sum = 0.f;
#pragma unroll
        for (int w = 0; w < 8; ++w) sum += red[(w * 16 + i) * 64 + ln];
        const int row = crow(i, ln >> 5), col = n0 + (ln & 31);
        const float x1 = base[(size_t)row * ldb + col] + sum * (H ? 1.0f : MK_P11_SCALE);
        out[(size_t)row * ldo + col] = x1;
        if (H) { H[(size_t)row * D + col] = (bf16_t)bf_rne(x1 * gf[col]);
            float ss = x1 * x1;
            ss += __shfl_xor(ss, 1); ss += __shfl_xor(ss, 2); ss += __shfl_xor(ss, 4); ss += __shfl_xor(ss, 8); ss += __shfl_xor(ss, 16);
            if ((ln & 31) == 0) atomic_add_f32(RSS + row, ss); }
    }
    __syncthreads();
}

constexpr int NPH = 14;
template <bool COOP>
__global__ void __launch_bounds__(NTHREADS, 2) mk_fwd(Args a) {
    extern __shared__ __attribute__((aligned(16))) unsigned char lds[];
    const int tid = threadIdx.x, lane = tid & 63, wave = __builtin_amdgcn_readfirstlane(tid >> 6);
    const int G = gridDim.x, bid = blockIdx.x, gw = bid * NWAVES + wave, ngw = G * NWAVES;
    unsigned char* ws = a.ws;
    LAS unsigned char* ldsl = (LAS unsigned char*)lds;
#ifndef PHMASK
#define PHMASK 0xffff
#endif
#define IN(k) (((PHMASK >> (k)) & 1) && a.ph_lo <= (k) && (k) < a.ph_hi)
    XcdBarrier xbar; xbar.bar = (unsigned*)(ws + WS_BAR); xbar.x = 0; xbar.st = nullptr;
    if (COOP) {
        volatile LAS unsigned* st = (volatile LAS unsigned*)(ldsl + LDS_BYTES - 16);
        if (tid < 4) st[tid] = 0u;
        __syncthreads();
        xbar = xcd_barrier_post((unsigned*)(ws + WS_BAR), st);
    }
#define SEAM(k) do { if (COOP && IN(k) && IN((k) + 1)) { if (a.ph_hi > 1000) cg::this_grid().sync(); else xcd_barrier(xbar); } } while (0)

    if (IN(0)) phase_prologue(a, lds, gw, ngw, lane, wave);
    SEAM(0);
    if (IN(1)) {
        pg8::Gemm g{(const bf16_t*)(ws + WS_H), (const bf16_t*)(ws + WS_WIN), MPAD, NIN, D}; pg8::StaticOrder S; S.init(MPAD, NIN, G, bid);
        EpiIn E{(bf16_t*)(ws + WS_QB), (bf16_t*)(ws + WS_KB), (bf16_t*)(ws + WS_VB), (bf16_t*)(ws + WS_RW), a.out};
        pg8::gemm_phase<EpiIn>(ldsl, g, S, E);
        {
            const int nu = (MPAD / 256) * (NIN / 256), rem = nu % G, first = rem == 0 ? 0 : rem, nfree = G - first;
            if (bid >= first) convert_wo_wup(a, lds, (bid - first) * NWAVES + wave, nfree * NWAVES, wave, lane);
        }
    }
    SEAM(1);
    if (IN(2)) {
        for (int u = bid; u < 256; u += G) attn_sample_wg(a, lds, u, wave, lane);
        {
            const int vb = (G % 8 == 0) ? (bid % 8) * (G / 8) + bid / 8 : bid;
            for (int u = vb * NWAVES + wave; u < 64 * 3 * 64; u += ngw) attn_prompt_unit(a, lds, u, wave, lane);
        }
        for (int m = gw; m < MPAD; m += ngw) lora_input_row(a, m, lane);
    }
    SEAM(2);
    if (IN(3)) {
        pg8::Gemm g{(const bf16_t*)(ws + WS_ALO), (const bf16_t*)(ws + WS_WLO), MPAD, NLO, KLO}; pg8::StaticOrder S; S.init(MPAD, NLO, G, bid);
        EpiBf E{(bf16_t*)(ws + WS_L), NLO};
        pg8::gemm_phase<EpiBf>(ldsl, g, S, E);
#pragma unroll 2
        for (int t = gw; t < MP * 4; t += ngw) attn_merge_task(a, t, lane);
    }
    SEAM(3);
    if (IN(4)) {
#ifndef NO_P1
        for (int u = bid; u < 64 * NS / 4; u += G) scan_pass1_unit(a, lds, u, wave, lane);
#endif

    }
    SEAM(4);
    if (IN(5)) {
        if (G >= 128) {
            if (bid < 64) scan_pass2_unit(a, lds, bid, wave, lane);
            else for (int u = (bid - 64) * NWAVES + wave; u < 512; u += (G - 64) * NWAVES) scan_sample_unit(a, lds, u, wave, lane);
        } else {
            for (int ch = bid; ch < 64; ch += G) scan_pass2_unit(a, lds, ch, wave, lane);
            for (int u = gw; u < 512; u += ngw) scan_sample_unit(a, lds, u, wave, lane);
        }
    }
    SEAM(5);
    if (IN(6)) { for (int u = gw; u < 64 * NS * 4; u += ngw) scan_pass3_unit(a, u, lane); }
    SEAM(6);
    if (IN(7)) {
        pg8::Gemm g{(const bf16_t*)(ws + WS_O), (const bf16_t*)(ws + WS_WO), MP, D, D}; pg8::StaticOrder S; S.init(MP, D, G, bid);
        EpiWo E{a.in[I_XP], a.in[I_NFG], (float*)(ws + WS_X1), (bf16_t*)(ws + WS_H), (float*)(ws + WS_RSS)};
        pg8::gemm_phase<EpiWo>(ldsl, g, S, E);
        for (int u = bid; u < D / 32; u += G)
            skinny_unit((const bf16_t*)(ws + WS_O) + (size_t)MP * D, D, (const bf16_t*)(ws + WS_WO), D, u, a.in[I_XS], D, (float*)(ws + WS_X1) + (size_t)MP * D, D, lds, wave, lane,
                        a.in[I_NFG], (bf16_t*)(ws + WS_H) + (size_t)MP * D, (float*)(ws + WS_RSS) + MP);
    }
    SEAM(7);
    if (IN(9)) {
        pg8::Gemm g{(const bf16_t*)(ws + WS_H), (const bf16_t*)(ws + WS_WUP), MPAD, FF2, D}; pg8::StaticOrder S; S.init(MPAD, FF2, G, bid);
        EpiUpF E{(bf16_t*)(ws + WS_ACT), a.out, (const float*)(ws + WS_RSS), a.in[I_FCW], a.in[I_FCB], (float*)(ws + WS_U), (LAS float*)(ldsl + 131072)};
        pg8::gemm_phase<EpiUpF>(ldsl, g, S, E);
        {
            const int nu = (MPAD / 256) * (FF2 / 256), rem = nu % G, first = rem == 0 ? 0 : rem, nfree = G - first;
            if (bid >= first) convert_wdn(a, lds, (bid - first) * NWAVES + wave, nfree * NWAVES, wave, lane);
        }
    }
    SEAM(9);
    if (IN(10)) { for (int it = bid * NTHREADS + tid; it < FIX_ROWS * (FF / 8); it += G * NTHREADS) conv_fix(a, it); }
    SEAM(10);
    if (IN(11)) {
        pg8::Gemm g{(const bf16_t*)(ws + WS_ACT), (const bf16_t*)(ws + WS_WDN), MP, D, FF}; pg8::StaticOrder S; S.init(MP, D, G, bid);
        EpiDn E{(float*)(ws + WS_X1)};
        pg8::gemm_phase<EpiDn>(ldsl, g, S, E);
        for (int u = bid; u < D / 32; u += G)
            skinny_unit((const bf16_t*)(ws + WS_ACT) + (size_t)MP * FF, FF, (const bf16_t*)(ws + WS_WDN), FF, u, (const float*)(ws + WS_X1) + (size_t)MP * D, D, (float*)(ws + WS_X1) + (size_t)MP * D, D, lds, wave, lane);
    }
    SEAM(11);
    if (IN(12)) {
        for (int m = gw; m < MT; m += ngw)
            rms_row_f32((const float*)(ws + WS_X1) + (size_t)m * D, a.in[I_NFIN], m < MP ? a.out + O_YP + (size_t)m * D : a.out + O_YS + (size_t)(m - MP) * D, lane);
    }
#undef IN
#undef SEAM
}

#ifndef MK_ONE_LAUNCH
#define MK_ONE_LAUNCH 1
#endif
#ifndef MK_DBL_MASK
#define MK_DBL_MASK 0x0
#endif

extern "C" void kernel_launch(void* const* d_in, const int* in_sizes, int n_in, void* d_out, int out_size, void* d_ws, size_t ws_size, hipStream_t stream) {
    static int grid = 0;
    if (!grid) {
        if (n_in != 28 || (size_t)out_size != O_END || ws_size < WS_END) fprintf(stderr, "kernel_launch: unexpected shapes: n_in %d out %d (want %zu) ws %zu (want %zu)\n", n_in, out_size, O_END, ws_size, WS_END);
        int dev = 0, cus = 0; hipGetDevice(&dev); hipDeviceGetAttribute(&cus, hipDeviceAttributeMultiprocessorCount, dev);
        hipFuncSetAttribute((const void*)mk_fwd<true>, hipFuncAttributeMaxDynamicSharedMemorySize, LDS_BYTES);
        hipFuncSetAttribute((const void*)mk_fwd<false>, hipFuncAttributeMaxDynamicSharedMemorySize, LDS_BYTES);
        int per_cu = 0; hipOccupancyMaxActiveBlocksPerMultiprocessor(&per_cu, mk_fwd<true>, NTHREADS, LDS_BYTES);
        if (per_cu < 1) { fprintf(stderr, "kernel_launch: occupancy query says %d blocks/CU\n", per_cu); per_cu = 1; }
        grid = cus > 0 ? cus : 256;
    }
    Args a; memset(&a, 0, sizeof(a));
    for (int i = 0; i < 28; ++i) a.in[i] = (const float*)d_in[i];
    a.out = (float*)d_out; a.ws = (unsigned char*)d_ws;
#if MK_ONE_LAUNCH
    if (hipMemsetAsync((char*)d_ws + WS_BAR, 0, BAR_BYTES, stream) != hipSuccess) { fprintf(stderr, "kernel_launch: memset of the barrier words failed\n"); return; }
    a.ph_lo = 0; a.ph_hi = NPH;
    void* args[] = {&a};
    hipError_t e = hipLaunchCooperativeKernel((const void*)mk_fwd<true>, dim3(grid), dim3(NTHREADS), args, LDS_BYTES, stream);
    if (e != hipSuccess) fprintf(stderr, "cooperative launch failed: %s (grid %d)\n", hipGetErrorString(e), grid);
#else
    for (int p = 0; p < 13; ++p) {
        a.ph_lo = p; a.ph_hi = p + 1;
        mk_fwd<false><<<dim3(grid), dim3(NTHREADS), LDS_BYTES, stream>>>(a);
        if ((MK_DBL_MASK >> p) & 1) mk_fwd<false><<<dim3(grid), dim3(NTHREADS), LDS_BYTES, stream>>>(a);
    }
#endif
}
```

```cpp
#include <hip/hip_runtime.h>
#include <hip/hip_cooperative_groups.h>
#include <cstdio>
#include <cstdint>
#include <cstring>
namespace cg = cooperative_groups;

#define DI __device__ __forceinline__
#define LAS __attribute__((address_space(3)))
typedef unsigned short bf16_t;
typedef short bf16x8 __attribute__((ext_vector_type(8)));
typedef float f32x4 __attribute__((ext_vector_type(4)));
typedef float f32x16 __attribute__((ext_vector_type(16)));
typedef unsigned u32x4 __attribute__((ext_vector_type(4)));
typedef unsigned u32x2 __attribute__((ext_vector_type(2)));

constexpr int D = 2048, MP = 8192, MS = 32, MT = 8224, MPAD = 8448, SEQ = 2048;
constexpr int CIN = 6432, NIN = 6656, CSH = 3360, FF2 = 11264, FF = 5632;
constexpr int NLO = 3072, KLO = 384;
constexpr int NS = 16, SEGL = 128, TB = 8;
constexpr int NTHREADS = 512, NWAVES = 8;
constexpr int LDS_BYTES = 131072 + 16384;

constexpr size_t O_YP = 0;
constexpr size_t O_YS = O_YP + (size_t)MP * D;
constexpr size_t O_PK = O_YS + (size_t)MS * D;
constexpr size_t O_PV = O_PK + (size_t)MP * 1024;
constexpr size_t O_PRW = O_PV + (size_t)MP * 1024;
constexpr size_t O_PWKV = O_PRW + (size_t)4 * CSH;
constexpr size_t O_PFFN = O_PWKV + (size_t)4 * 16 * 4096;
constexpr size_t O_SK = O_PFFN + (size_t)4 * 2 * FF2;
constexpr size_t O_SV = O_SK + (size_t)MS * 1024;
constexpr size_t O_SRW = O_SV + (size_t)MS * 1024;
constexpr size_t O_SWKV = O_SRW + (size_t)MS * CSH;
constexpr size_t O_SFFN = O_SWKV + (size_t)MS * 16 * 4096;
constexpr size_t O_END = O_SFFN + (size_t)MS * 2 * FF2;

constexpr size_t al256(size_t x) { return (x + 255) & ~(size_t)255; }
constexpr size_t WS_WIN = 0;
constexpr size_t WS_WO = WS_WIN + al256((size_t)NIN * D * 2);
constexpr size_t WS_WUP = WS_WO + al256((size_t)D * D * 2);
constexpr size_t WS_WDN = WS_WUP + al256((size_t)FF2 * D * 2);
constexpr size_t WS_WLO = WS_WDN + al256((size_t)D * FF * 2);
constexpr size_t WS_H = WS_WLO + al256((size_t)NLO * KLO * 2);
constexpr size_t WS_QB = WS_H + al256((size_t)MPAD * D * 2);
constexpr size_t WS_KB = WS_QB + al256((size_t)MPAD * 1024 * 2);
constexpr size_t WS_VB = WS_KB + al256((size_t)MPAD * 1024 * 2);
constexpr size_t WS_ALO = WS_VB + al256((size_t)MPAD * 1024 * 2);
constexpr size_t WS_O = WS_ALO + al256((size_t)MPAD * KLO * 2);
constexpr size_t WS_GB = WS_O + al256((size_t)MPAD * D * 2);
constexpr size_t WS_YL = WS_GB + al256((size_t)MT * 2048 * 2);
constexpr size_t WS_QS = WS_YL + al256((size_t)MP * 1024 * 2);
constexpr size_t WS_ZP = WS_QS + al256((size_t)MP * 1024 * 2);
constexpr size_t WS_SST = WS_ZP + al256((size_t)64 * NS * 2 * 4096 * 4);
constexpr size_t WS_X1 = WS_SST + al256((size_t)64 * NS * 4096 * 4);
constexpr size_t WS_PML = WS_X1 + al256((size_t)MPAD * D * 4);
constexpr size_t WS_RA = WS_PML + al256((size_t)3 * MP * 16 * 2 * 4);
constexpr size_t WS_RW = WS_RA;
constexpr size_t WS_L = WS_RW + al256((size_t)MPAD * CSH * 2);
constexpr size_t RA_BYTES_1 = al256((size_t)MPAD * CSH * 2) + al256((size_t)MPAD * NLO * 2);
constexpr size_t RA_BYTES_2 = al256((size_t)MPAD * FF2 * 2);
constexpr size_t WS_U = WS_RA;
constexpr size_t WS_RB = WS_RA + (RA_BYTES_1 > RA_BYTES_2 ? RA_BYTES_1 : RA_BYTES_2);
constexpr size_t WS_PART = WS_RB;
constexpr size_t WS_ACT = WS_RB;
constexpr size_t RB_BYTES_1 = al256((size_t)3 * MP * 1024 * 2);
constexpr size_t RB_BYTES_2 = al256((size_t)MPAD * FF * 2);
constexpr size_t WS_RSS = WS_RB + (RB_BYTES_1 > RB_BYTES_2 ? RB_BYTES_1 : RB_BYTES_2);
constexpr size_t WS_BAR_ = 0; constexpr size_t WS_BAR = al256((size_t)MPAD * 4) + WS_RB + (RB_BYTES_1 > RB_BYTES_2 ? RB_BYTES_1 : RB_BYTES_2);
constexpr size_t BAR_BYTES = 16384;
constexpr size_t WS_END = WS_BAR + BAR_BYTES;

struct Args {
    const float* in[28];
    float* out;
    unsigned char* ws;
    int ph_lo, ph_hi;
};
enum { I_XP = 0, I_XS, I_CK, I_CV, I_SSH, I_SWKV, I_SFFN, I_NMG, I_WIN, I_AOG, I_MU, I_W0, I_WUP, I_A0, I_AUP, I_GUP,
       I_KK, I_KA, I_RK, I_LNW, I_LNB, I_WO, I_NFG, I_FUP, I_FCW, I_FCB, I_FDN, I_NFIN };

typedef float f32x2c __attribute__((ext_vector_type(2)));
typedef __bf16 bf16x2c __attribute__((ext_vector_type(2)));
DI unsigned pk2(float lo, float hi) { const f32x2c v = {lo, hi}; return __builtin_bit_cast(unsigned, __builtin_convertvector(v, bf16x2c)); }
DI unsigned bf_rne(float f) { return pk2(f, 0.f) & 0xffffu; }
DI unsigned cvt_pk(float lo, float hi) { return pk2(lo, hi); }
DI void atomic_add_f32(float* p, float v) { (void)__builtin_amdgcn_global_atomic_fadd_f32((__attribute__((address_space(1))) float*)p, v); }
DI float bf2f(unsigned short b) { return __uint_as_float(((unsigned)b) << 16); }
#define DPP_ADD(v, ctrl) ((v) + __int_as_float(__builtin_amdgcn_update_dpp(0, __float_as_int(v), (ctrl), 0xf, 0xf, false)))
DI float wave_sum(float v) {
    v = DPP_ADD(v, 0xB1);
    v = DPP_ADD(v, 0x4E);
    v = DPP_ADD(v, 0x141);
    v = DPP_ADD(v, 0x140);
    const float s0 = __int_as_float(__builtin_amdgcn_readlane(__float_as_int(v), 0)), s1 = __int_as_float(__builtin_amdgcn_readlane(__float_as_int(v), 16));
    const float s2 = __int_as_float(__builtin_amdgcn_readlane(__float_as_int(v), 32)), s3 = __int_as_float(__builtin_amdgcn_readlane(__float_as_int(v), 48));
    return (s0 + s1) + (s2 + s3);
}

namespace pg8 {
constexpr int BM = 256, BK = 64, HALF = 128, HTB = HALF * BK * 2, STAGE_BYTES = 8 * HTB, NXCD = 8, WGM = 8;
DI int lds_byte(int r, int c) { const int st = (r >> 4) * 2 + (c >> 5), rr = r & 15, cc = c & 31, ob = rr * 64 + cc * 2; return st * 1024 + (ob ^ (((ob >> 9) & 1) << 5)); }
DI void stage_rc(int b, int& R, int& C) { const int st = b / 1024, sb = b % 1024, swz = sb ^ (((sb >> 9) & 1) << 5); R = (st >> 1) * 16 + swz / 64; C = (st & 1) * 32 + (swz % 64) / 2; }
struct Unit { int pm, pn; };
struct Gemm { const bf16_t* A; const bf16_t* Bt; int M, N, K; };
struct StaticOrder {
    int nM, nN, nwg, G, c;
    DI void init(int M, int N, int G_, int c_) { nM = M / BM; nN = N / BM; nwg = nM * nN; G = G_; c = c_; }
    DI bool next(int i, Unit& u) const {
        const long L = (long)i * G + c; if (L >= nwg) return false;
        int wgid = (int)L; { const int q = nwg / NXCD, r = nwg % NXCD, xcd = wgid % NXCD, off = wgid / NXCD; wgid = (xcd < r ? xcd * (q + 1) : r * (q + 1) + (xcd - r) * q) + off; }
        const int nig = WGM * nN, gid = wgid / nig, fm = gid * WGM, gsz = (nM - fm) < WGM ? (nM - fm) : WGM;
        u.pm = fm + ((wgid % nig) % gsz); u.pn = (wgid % nig) / gsz; return true;
    }
};

template <class Epi>
DI void gemm_phase(LAS unsigned char* lds, const Gemm g, const StaticOrder& S, const Epi& E) {
    const int tid = threadIdx.x, wid = __builtin_amdgcn_readfirstlane(tid >> 6), lane = tid & 63, wr = wid >> 2, wc = wid & 3, fr = lane & 15, fq = lane >> 4;
    const int K = g.K, nt = K / BK;
    unsigned voffA[2];
#pragma unroll
    for (int i = 0; i < 2; ++i) { int R, C; stage_rc(tid * 16 + i * 8192, R, C); voffA[i] = (unsigned)(R * K + C) * 2u; }
    const size_t kstep = (size_t)(BK * 2);
    const size_t hstep = (size_t)HALF * K * 2;
    const size_t tstep = 2 * hstep;
    const unsigned ldsw = (unsigned)wid * 1024u;
    const int aoff = lds_byte(wr * 64 + fr, fq * 8), boff = lds_byte(wc * 32 + fr, fq * 8);
#define PG8_SA(b, h) (((b) * 2 + (h)) * HTB)
#define PG8_SB(b, h) ((4 + (b) * 2 + (h)) * HTB)
#define PG8_STAGE(bufoff, gbase, voff) do { _Pragma("unroll") for (int _i = 0; _i < 2; ++_i) \
        __builtin_amdgcn_global_load_lds((const unsigned*)((const char*)(gbase) + (voff)[_i]), (LAS unsigned*)(lds + (bufoff) + ldsw + _i * 8192), 16, 0, 0); } while (0)
#define PG8_LDA(dst, b, h) do { _Pragma("unroll") for (int m = 0; m < 4; ++m) _Pragma("unroll") for (int k = 0; k < 2; ++k) dst[m][k] = *(const LAS bf16x8*)(lds + PG8_SA(b, h) + aoff + m * 2048 + k * 1024); } while (0)
#define PG8_LDB(dst, b, h) do { _Pragma("unroll") for (int n = 0; n < 2; ++n) _Pragma("unroll") for (int k = 0; k < 2; ++k) dst[n][k] = *(const LAS bf16x8*)(lds + PG8_SB(b, h) + boff + n * 2048 + k * 1024); } while (0)
#define PG8_MMA(ai, bj, At, Bt) do { __builtin_amdgcn_s_setprio(1); _Pragma("unroll") for (int m = 0; m < 4; ++m) _Pragma("unroll") for (int n = 0; n < 2; ++n) _Pragma("unroll") for (int k = 0; k < 2; ++k) \
        acc[ai][bj][m][n] = __builtin_amdgcn_mfma_f32_16x16x32_bf16(Bt[n][k], At[m][k], acc[ai][bj][m][n], 0, 0, 0); __builtin_amdgcn_s_setprio(0); } while (0)
#define PG8_WAIT_V(n) asm volatile("s_waitcnt vmcnt(" #n ")" ::: "memory")
#define PG8_WAIT_L(n) asm volatile("s_waitcnt lgkmcnt(" #n ")" ::: "memory")
#define PG8_BAR __builtin_amdgcn_s_barrier()
#define PG8_SCHED __builtin_amdgcn_sched_barrier(0)
    Unit cur, nxt; int ui = 0;
    if (!S.next(0, cur)) return;
    f32x4 acc[2][2][4][2];
#pragma unroll
    for (int a = 0; a < 2; ++a)
#pragma unroll
        for (int b = 0; b < 2; ++b)
#pragma unroll
            for (int m = 0; m < 4; ++m)
#pragma unroll
                for (int n = 0; n < 2; ++n) acc[a][b][m][n] = (f32x4){0.f, 0.f, 0.f, 0.f};
    bf16x8 At[4][2], B0[2][2], B1[2][2];
    const char* cA = (const char*)g.A + (size_t)cur.pm * tstep; const char* cB = (const char*)g.Bt + (size_t)cur.pn * tstep;
    PG8_STAGE(PG8_SB(0, 0), cB, voffA); PG8_STAGE(PG8_SA(0, 0), cA, voffA); PG8_STAGE(PG8_SB(0, 1), cB + hstep, voffA); PG8_STAGE(PG8_SA(0, 1), cA + hstep, voffA);
    if (wr == 1) PG8_BAR;
    PG8_WAIT_V(4); PG8_BAR;
    PG8_STAGE(PG8_SB(1, 0), cB + kstep, voffA); PG8_STAGE(PG8_SA(1, 0), cA + kstep, voffA); PG8_STAGE(PG8_SB(1, 1), cB + hstep + kstep, voffA);
    PG8_WAIT_V(6); PG8_BAR;
    for (;;) {
        const bool has_next = S.next(ui + 1, nxt);
        const char* nA = has_next ? (const char*)g.A + (size_t)nxt.pm * tstep : cA; const char* nB = has_next ? (const char*)g.Bt + (size_t)nxt.pn * tstep : cB;
        for (int t = 0; t < nt; t += 2) {
            const bool last = (t == nt - 2);
            const char* a1 = cA + (size_t)(t + 1) * kstep;
            const char* a2 = last ? nA : cA + (size_t)(t + 2) * kstep; const char* b2 = last ? nB : cB + (size_t)(t + 2) * kstep;
            const char* a3 = a2 + kstep; const char* b3 = b2 + kstep;
            PG8_LDB(B0, 0, 0); PG8_SCHED; PG8_LDA(At, 0, 0); PG8_STAGE(PG8_SA(1, 1), a1 + hstep, voffA);
            PG8_WAIT_L(8); PG8_BAR; PG8_WAIT_L(0); PG8_MMA(0, 0, At, B0); PG8_BAR; PG8_SCHED;
            PG8_LDB(B1, 0, 1); PG8_STAGE(PG8_SB(0, 0), b2, voffA);
            PG8_BAR; PG8_WAIT_L(0); PG8_MMA(0, 1, At, B1); PG8_BAR;
            PG8_LDA(At, 0, 1); PG8_STAGE(PG8_SA(0, 0), a2, voffA);
            PG8_BAR; PG8_WAIT_L(0); PG8_MMA(1, 0, At, B0); PG8_BAR; PG8_SCHED;
            PG8_STAGE(PG8_SB(0, 1), b2 + hstep, voffA);
            PG8_WAIT_V(6); PG8_BAR; PG8_MMA(1, 1, At, B1); PG8_BAR;
            PG8_LDB(B0, 1, 0); PG8_SCHED; PG8_LDA(At, 1, 0); PG8_STAGE(PG8_SA(0, 1), a2 + hstep, voffA);
            PG8_WAIT_L(8); PG8_BAR; PG8_WAIT_L(0); PG8_MMA(0, 0, At, B0); PG8_BAR; PG8_SCHED;
            PG8_LDB(B1, 1, 1); PG8_STAGE(PG8_SB(1, 0), b3, voffA);
            PG8_BAR; PG8_WAIT_L(0); PG8_MMA(0, 1, At, B1); PG8_BAR;
            PG8_LDA(At, 1, 1); PG8_STAGE(PG8_SA(1, 0), a3, voffA);
            PG8_BAR; PG8_WAIT_L(0); PG8_MMA(1, 0, At, B0); PG8_BAR; PG8_SCHED;
            PG8_STAGE(PG8_SB(1, 1), b3 + hstep, voffA);
            PG8_WAIT_V(6); PG8_BAR; PG8_MMA(1, 1, At, B1); PG8_BAR;
        }
        E(acc, cur, wr, wc, fr, fq);
        if (!has_next) break;
#pragma unroll
        for (int a = 0; a < 2; ++a)
#pragma unroll
            for (int b = 0; b < 2; ++b)
#pragma unroll
                for (int m = 0; m < 4; ++m)
#pragma unroll
                    for (int n = 0; n < 2; ++n) acc[a][b][m][n] = (f32x4){0.f, 0.f, 0.f, 0.f};
        cur = nxt; cA = nA; cB = nB; ++ui;
    }
    PG8_WAIT_V(0);
    if (wr == 0) PG8_BAR;
    PG8_BAR;
#undef PG8_SA
#undef PG8_SB
#undef PG8_STAGE
#undef PG8_LDA
#undef PG8_LDB
#undef PG8_MMA
#undef PG8_WAIT_V
#undef PG8_WAIT_L
#undef PG8_BAR
#undef PG8_SCHED
}
}

DI size_t hm64(int row, int h)  { return ((size_t)((row >> 11) * 16 + h) * SEQ + (row & (SEQ - 1))) * 64; }
typedef f32x4 AccT[2][2][4][2];
#define EPI_LOOP_BEGIN \
    const int row0 = u.pm * 256 + wr * 64 + fr, col0 = u.pn * 256 + wc * 32 + 4 * fq; \
    _Pragma("unroll") for (int ai = 0; ai < 2; ++ai) _Pragma("unroll") for (int m = 0; m < 4; ++m) { const int row = row0 + ai * 128 + m * 16; \
    _Pragma("unroll") for (int bj = 0; bj < 2; ++bj) _Pragma("unroll") for (int n = 0; n < 2; ++n) { const int col = col0 + bj * 128 + n * 16; const f32x4 v = acc[ai][bj][m][n];
#define EPI_LOOP_END } }
#define EPI_LOOP_BEGIN_S \
    const int row0 = u.pm * 256 + wr * 64 + fr, col0 = u.pn * 256 + wc * 32 + 4 * fq; \
    _Pragma("unroll") for (int ai = 0; ai < 2; ++ai) _Pragma("unroll") for (int m = 0; m < 4; ++m) { const int row = row0 + ai * 128 + m * 16; \
    _Pragma("unroll") for (int bj = 0; bj < 2; ++bj) _Pragma("unroll") for (int n = 0; n < 2; ++n) { const int col = col0 + bj * 128 + n * 16; const f32x4 v = acc[ai][bj][m][n] * rs[ai][m];

struct EpiIn {
    bf16_t *Qb, *Kb, *Vb; bf16_t* RW; float* out;
    DI void operator()(const AccT& acc, const pg8::Unit& u, int wr, int wc, int fr, int fq) const {
        const int reg = u.pn < 4 ? 0 : (u.pn < 8 ? 1 : (u.pn < 12 ? 2 : 3));
        EPI_LOOP_BEGIN
            if (row < MT) {
                if (reg == 0) {
                    constexpr float QS_ = 0.125f * 1.44269504088896f;
                    u32x2 w; w.x = cvt_pk(v[0] * QS_, v[1] * QS_); w.y = cvt_pk(v[2] * QS_, v[3] * QS_);
                    *(u32x2*)(row < MP ? Qb + hm64(row, col >> 6) + (col & 63) : Qb + (size_t)row * 1024 + col) = w;
                } else if (reg == 1 || reg == 2) {
                    const int c = col - (reg == 1 ? 1024 : 2048);
                    float* o = row < MP ? out + (reg == 1 ? O_PK : O_PV) + (size_t)row * 1024 + c : out + (reg == 1 ? O_SK : O_SV) + (size_t)(row - MP) * 1024 + c;
                    *(f32x4*)o = v;
                    if (row < MP) { u32x2 w; w.x = cvt_pk(v[0], v[1]); w.y = cvt_pk(v[2], v[3]);
                        *(u32x2*)((reg == 1 ? Kb : Vb) + hm64(row, c >> 6) + (c & 63)) = w; }
                } else {
                    const int c = col - 3072;
                    if (c < CSH) {
                        { u32x2 w; w.x = cvt_pk(v[0], v[1]); w.y = cvt_pk(v[2], v[3]); *(u32x2*)(RW + (size_t)row * CSH + c) = w; }
                        if (row >= MP) *(f32x4*)(out + O_SRW + (size_t)(row - MP) * CSH + c) = v;
                        else if ((row & (SEQ - 1)) == SEQ - 1) *(f32x4*)(out + O_PRW + (size_t)(row >> 11) * CSH + c) = v;
                    }
                }
            }
        EPI_LOOP_END
    }
};
struct EpiBf {
    bf16_t* C; int ldc;
    DI void operator()(const AccT& acc, const pg8::Unit& u, int wr, int wc, int fr, int fq) const {
        const int row0 = u.pm * 256 + wr * 64 + fr, col0 = u.pn * 256 + wc * 32 + 4 * fq;
#pragma unroll
        for (int ai = 0; ai < 2; ++ai)
#pragma unroll
            for (int m = 0; m < 4; ++m) { const int row = row0 + ai * 128 + m * 16;
#pragma unroll
                for (int bj = 0; bj < 2; ++bj)
#pragma unroll
                    for (int n = 0; n < 2; ++n) { const int col = col0 + bj * 128 + n * 16; const f32x4 v = acc[ai][bj][m][n];
                        u32x2 w; w.x = cvt_pk(v[0], v[1]); w.y = cvt_pk(v[2], v[3]);
                        *(u32x2*)(C + (size_t)row * ldc + col) = w; }
                asm volatile("" ::: "memory");
            }
    }
};
struct EpiWo {
    const float *xp; const float* gf; float* X1; bf16_t* H; float* RSS;
    DI void operator()(const AccT& acc, const pg8::Unit& u, int wr, int wc, int fr, int fq) const {
        const int row0 = u.pm * 256 + wr * 64 + fr, col0 = u.pn * 256 + wc * 32 + 4 * fq;
        f32x4 gg[2][2];
#pragma unroll
        for (int bj = 0; bj < 2; ++bj)
#pragma unroll
            for (int n = 0; n < 2; ++n) gg[bj][n] = *(const f32x4*)(gf + col0 + bj * 128 + n * 16);
        float ssr[2][4];
#pragma unroll
        for (int aim = 0; aim < 4; ++aim) {
            const int ai = aim >> 1;
            f32x4 xr[4][2][2];
#pragma unroll
            for (int m = 2 * (aim & 1); m < 2 * (aim & 1) + 2; ++m)
#pragma unroll
                for (int bj = 0; bj < 2; ++bj)
#pragma unroll
                    for (int n = 0; n < 2; ++n) xr[m][bj][n] = *(const f32x4*)(xp + (size_t)(row0 + ai * 128 + m * 16) * D + col0 + bj * 128 + n * 16);
            asm volatile("" ::: "memory");
#pragma unroll
            for (int m = 2 * (aim & 1); m < 2 * (aim & 1) + 2; ++m) {
                const int row = row0 + ai * 128 + m * 16; float ss = 0.f;
#pragma unroll
                for (int bj = 0; bj < 2; ++bj)
#pragma unroll
                    for (int n = 0; n < 2; ++n) {
                        const int col = col0 + bj * 128 + n * 16;
                        const f32x4 x1 = xr[m][bj][n] + acc[ai][bj][m][n];
                        *(f32x4*)(X1 + (size_t)row * D + col) = x1;
                        u32x2 w; w.x = cvt_pk(x1[0] * gg[bj][n][0], x1[1] * gg[bj][n][1]); w.y = cvt_pk(x1[2] * gg[bj][n][2], x1[3] * gg[bj][n][3]);
                        *(u32x2*)(H + (size_t)row * D + col) = w;
                        ss += (x1[0] * x1[0] + x1[1] * x1[1]) + (x1[2] * x1[2] + x1[3] * x1[3]);
                    }
                ssr[ai][m] = ss;
            }
            asm volatile("" ::: "memory");
        }
#pragma unroll
        for (int ai = 0; ai < 2; ++ai)
#pragma unroll
            for (int m = 0; m < 4; ++m) { float ss = ssr[ai][m]; ss += __shfl_xor(ss, 16); ss += __shfl_xor(ss, 32); ssr[ai][m] = ss; }
        if (fq == 0) {
#pragma unroll
            for (int ai = 0; ai < 2; ++ai)
#pragma unroll
                for (int m = 0; m < 4; ++m) atomic_add_f32(RSS + row0 + ai * 128 + m * 16, ssr[ai][m]);
        }
    }
};
#define DPP_MOV(v, ctrl) __int_as_float(__builtin_amdgcn_update_dpp(0, __float_as_int(v), (ctrl), 0xf, 0xf, false))
#define DPP_SHR(oldv, v, ctrl) __int_as_float(__builtin_amdgcn_update_dpp(__float_as_int(oldv), __float_as_int(v), (ctrl), 0xf, 0xf, false))
struct EpiUpF {
    bf16_t* ACT; float* out; const float* RSS; const float* cw; const float* cb; float* EDGE; LAS float* xch;
    DI void operator()(const AccT& acc, const pg8::Unit& u, int wr, int wc, int fr, int fq) const {
        const int wave = wr * 4 + wc, row0 = u.pm * 256 + wr * 64 + fr, f0 = u.pn * 128 + wc * 32 + 4 * fq;
#define UPF_RS(ai_, m_) rsqrtf(RSS[row0 + (ai_) * 128 + (m_) * 16] * (1.f / D) + 1e-6f)
        LAS float* taps = xch + 2048; LAS float* rstd = xch + 3072;
        {
            const int tid = wave * 64 + fq * 16 + fr;
#pragma unroll
            for (int q = 0; q < 2; ++q) { const int idx = tid + 512 * q, which = idx >> 7, col = (which >= 4 ? FF : 0) + u.pn * 128 + (idx & 127);
                taps[idx] = (which & 3) < 3 ? cw[(which & 3) * FF2 + col] : cb[col]; }
            if (tid < 256) rstd[tid] = rsqrtf(RSS[u.pm * 256 + tid] * (1.f / D) + 1e-6f);
        }
        if (fr >= 14) {
#pragma unroll
            for (int ai = 0; ai < 2; ++ai)
#pragma unroll
                for (int bj = 0; bj < 2; ++bj)
#pragma unroll
                    for (int n = 0; n < 2; ++n)
                        *(LAS f32x4*)(xch + wave * 256 + ((((ai * 2 + (fr - 14)) * 2 + bj) * 2 + n) * 4 + fq) * 4) = acc[ai][bj][3][n] * UPF_RS(ai, 3);
        }
        asm volatile("s_waitcnt lgkmcnt(0)" ::: "memory"); __builtin_amdgcn_s_barrier(); asm volatile("" ::: "memory");
        __builtin_amdgcn_s_barrier(); asm volatile("" ::: "memory");
        const bool prompt = u.pm < MP / 256;
#pragma unroll
        for (int n = 0; n < 2; ++n) {
            const int f = f0 + 16 * n;
            asm volatile("" ::: "memory");
            const int fl = wc * 32 + 16 * n + 4 * fq;
#pragma unroll
            for (int ai = 0; ai < 2; ++ai) {
                const bool have = (wr == 1) || (ai == 1);
                const int nbw = wr == 1 ? wave - 4 : wave + 4, nai = wr == 1 ? ai : 0;
                f32x4 pg = {0.f, 0.f, 0.f, 0.f}, pv = {0.f, 0.f, 0.f, 0.f};
                if (have && fr >= 14) {
                    pg = *(const LAS f32x4*)(xch + nbw * 256 + ((((nai * 2 + (fr - 14)) * 2 + 0) * 2 + n) * 4 + fq) * 4);
                    pv = *(const LAS f32x4*)(xch + nbw * 256 + ((((nai * 2 + (fr - 14)) * 2 + 1) * 2 + n) * 4 + fq) * 4);
                }
#pragma unroll
                for (int m = 0; m < 4; ++m) {
                    const int row = row0 + ai * 128 + m * 16;
                    const float rsm = rstd[wr * 64 + ai * 128 + m * 16 + fr];
                    const f32x4 g = acc[ai][0][m][n] * rsm, v = acc[ai][1][m][n] * rsm;
                    float o[4];
                    asm volatile("" ::: "memory");
#pragma unroll
                    for (int e = 0; e < 4; ++e) {
                        const float g1 = DPP_SHR(DPP_MOV(pg[e], 0x121), g[e], 0x111), g2 = DPP_SHR(DPP_MOV(pg[e], 0x122), g[e], 0x112);
                        const float cg = taps[384 + fl + e] + taps[fl + e] * g2 + taps[128 + fl + e] * g1 + taps[256 + fl + e] * g[e];
                        o[e] = cg * __builtin_amdgcn_rcpf(1.f + __expf(-cg));
                    }
                    {
#pragma unroll
                        for (int e = 0; e < 4; ++e) {
                            const float v1 = DPP_SHR(DPP_MOV(pv[e], 0x121), v[e], 0x111), v2 = DPP_SHR(DPP_MOV(pv[e], 0x122), v[e], 0x112);
                            o[e] *= taps[896 + fl + e] + taps[512 + fl + e] * v2 + taps[640 + fl + e] * v1 + taps[768 + fl + e] * v[e];
                        }
                        asm volatile("" ::: "memory");
                    }
                    const int tr = wr * 64 + ai * 128 + m * 16 + fr;
                    if (prompt) {
                        u32x2 w; w.x = cvt_pk(o[0], o[1]); w.y = cvt_pk(o[2], o[3]);
                        *(u32x2*)((char*)ACT + ((unsigned)row * (unsigned)FF + (unsigned)f) * 2u) = w;
                    }
                    if (prompt ? (tr < 2 || tr >= 254) : tr < MS) {
                        const int er = prompt ? u.pm * 4 + (tr < 2 ? tr : tr - 252) : 128 + tr;
                        float* ed = (float*)((char*)EDGE + ((unsigned)er * (unsigned)FF2 + (unsigned)f) * 4u);
                        *(f32x4*)ed = g; *(f32x4*)(ed + FF) = v;
                    }
                    pg = g; pv = v;
                }
            }
        }
    }
#undef UPF_RS
};
#ifndef MK_P11_SCALE
#define MK_P11_SCALE 1.0f
#endif
struct EpiDn {
    float* X1;
    DI void operator()(const AccT& acc, const pg8::Unit& u, int wr, int wc, int fr, int fq) const {
        const int row0 = u.pm * 256 + wr * 64 + fr, col0 = u.pn * 256 + wc * 32 + 4 * fq;
#pragma unroll
        for (int ai = 0; ai < 2; ++ai) {
            f32x4 xr[4][2][2];
#pragma unroll
            for (int m = 0; m < 4; ++m)
#pragma unroll
                for (int bj = 0; bj < 2; ++bj)
#pragma unroll
                    for (int n = 0; n < 2; ++n) xr[m][bj][n] = *(const f32x4*)(X1 + (size_t)(row0 + ai * 128 + m * 16) * D + col0 + bj * 128 + n * 16);
            asm volatile("" ::: "memory");
#pragma unroll
            for (int m = 0; m < 4; ++m)
#pragma unroll
                for (int bj = 0; bj < 2; ++bj)
#pragma unroll
                    for (int n = 0; n < 2; ++n) *(f32x4*)(X1 + (size_t)(row0 + ai * 128 + m * 16) * D + col0 + bj * 128 + n * 16) = xr[m][bj][n] + acc[ai][bj][m][n] * MK_P11_SCALE;
            asm volatile("" ::: "memory");
        }
    }
};

template <bool UPPERM = false>
DI void transpose_item(const float* W, int K, int N, bf16_t* WT, int ldt, float* scr, int item, int lane) {
    const int nblk = N / 32, kb = item / nblk, nb = item % nblk, k0 = 64 * kb, n0 = 32 * nb;
    const int d0 = UPPERM ? (((n0 < FF ? n0 : n0 - FF) >> 7) * 256 + (n0 < FF ? 0 : 128) + ((n0 < FF ? n0 : n0 - FF) & 127)) : n0;
    {
        f32x4 v[8];
#pragma unroll
        for (int i = 0; i < 8; ++i) v[i] = __builtin_nontemporal_load((const f32x4*)(W + (size_t)(k0 + 8 * i + (lane >> 3)) * N + n0 + 4 * (lane & 7)));
#pragma unroll
        for (int i = 0; i < 8; ++i) { float* d = scr + (8 * i + (lane >> 3)) * 33 + 4 * (lane & 7); d[0] = v[i].x; d[1] = v[i].y; d[2] = v[i].z; d[3] = v[i].w; }
    }
    __builtin_amdgcn_fence(__ATOMIC_RELEASE, "wavefront"); asm volatile("s_waitcnt lgkmcnt(0)" ::: "memory");
    const int c = lane & 7;
#pragma unroll
    for (int j = 0; j < 4; ++j) { const int n = (lane >> 3) + 8 * j; const float* s = scr + (8 * c) * 33 + n;
        u32x4 o; o.x = pk2(s[0 * 33], s[1 * 33]); o.y = pk2(s[2 * 33], s[3 * 33]); o.z = pk2(s[4 * 33], s[5 * 33]); o.w = pk2(s[6 * 33], s[7 * 33]);
        *(u32x4*)(WT + (size_t)(d0 + n) * ldt + k0 + 8 * c) = o; }
    asm volatile("s_waitcnt lgkmcnt(0)" ::: "memory");
}
DI void rms_row_bf16(const float* xrow, const float* g, bf16_t* orow, int lane) {
    const f32x4* xr = (const f32x4*)xrow + lane; const f32x4* gr = (const f32x4*)g + lane;
    f32x4 v[8]; float s = 0.f;
#pragma unroll
    for (int j = 0; j < 8; ++j) { v[j] = xr[64 * j]; s += (v[j].x * v[j].x + v[j].y * v[j].y) + (v[j].z * v[j].z + v[j].w * v[j].w); }
    const float rstd = rsqrtf(wave_sum(s) * (1.f / D) + 1e-6f);
    u32x2* o8 = (u32x2*)orow + lane;
    f32x4 ggs[8];
#pragma unroll
    for (int j = 0; j < 8; ++j) ggs[j] = gr[64 * j];
#pragma unroll
    for (int j = 0; j < 8; ++j) { const f32x4 gg = ggs[j]; u32x2 w; w.x = pk2(v[j].x * rstd * gg.x, v[j].y * rstd * gg.y); w.y = pk2(v[j].z * rstd * gg.z, v[j].w * rstd * gg.w); o8[64 * j] = w; }
}
DI void rms_row_f32(const float* xrow, const float* g, float* orow, int lane) {
    const f32x4* xr = (const f32x4*)xrow + lane; const f32x4* gr = (const f32x4*)g + lane;
    f32x4 v[8]; float s = 0.f;
#pragma unroll
    for (int j = 0; j < 8; ++j) { v[j] = xr[64 * j]; s += (v[j].x * v[j].x + v[j].y * v[j].y) + (v[j].z * v[j].z + v[j].w * v[j].w); }
    const float rstd = rsqrtf(wave_sum(s) * (1.f / D) + 1e-6f);
    f32x4* o = (f32x4*)orow + lane;
    f32x4 ggs[8];
#pragma unroll
    for (int j = 0; j < 8; ++j) ggs[j] = gr[64 * j];
#pragma unroll
    for (int j = 0; j < 8; ++j) o[64 * j] = v[j] * rstd * ggs[j];
}
DI void zero_row_bf16(bf16_t* orow, int ncols, int lane) {
    for (int c = lane * 8; c < ncols; c += 512) *(u32x4*)(orow + c) = (u32x4){0u, 0u, 0u, 0u};
}

DI void phase_prologue(const Args& a, unsigned char* lds, int gw, int ngw, int lane, int wave) {
    unsigned char* ws = a.ws;
    float* scr = (float*)(lds + wave * 16384);
    bf16_t* Win = (bf16_t*)(ws + WS_WIN); bf16_t* Wlo = (bf16_t*)(ws + WS_WLO);
    constexpr int IT_IN = (D / 64) * (CIN / 32);
    for (int it = gw; it < IT_IN; it += ngw) transpose_item(a.in[I_WIN], D, CIN, Win, D, scr, it, lane);
    for (int r = CIN + gw; r < NIN; r += ngw) zero_row_bf16(Win + (size_t)r * D, D, lane);
    {
        const int gt = gw * 64 + lane, ngt = ngw * 64;
        for (int i = gt; i < NLO * KLO; i += ngt) {
            const int n = i / KLO, k = i % KLO; float v = 0.f;
            if (n < 1024) { if (k < 64) v = a.in[I_WUP][k * 1024 + n]; }
            else if (n < 2048) { if (k >= 64 && k < 128) v = a.in[I_AUP][(k - 64) * 1024 + (n - 1024)]; }
            else { if (k >= 128 && k < 288) v = a.in[I_GUP][(k - 128) * 1024 + (n - 2048)]; }
            Wlo[i] = (bf16_t)bf_rne(v);
        }
    }
    { float* RSS = (float*)(ws + WS_RSS); for (int i = gw * 64 + lane; i < MPAD; i += ngw * 64) RSS[i] = 0.f; }
    bf16_t* H = (bf16_t*)(ws + WS_H);
    for (int m = gw; m < MPAD; m += ngw) {
        if (m < MT) rms_row_bf16(m < MP ? a.in[I_XP] + (size_t)m * D : a.in[I_XS] + (size_t)(m - MP) * D, a.in[I_NMG], H + (size_t)m * D, lane);
        else zero_row_bf16(H + (size_t)m * D, D, lane);
    }
}


DI void convert_wo_wup(const Args& a, unsigned char* lds, int wi, int nw, int wave, int lane) {
    float* scr = (float*)(lds + wave * 16384);
    constexpr int IT_O = (D / 64) * (D / 32), IT_UP = (D / 64) * (FF2 / 32);
    for (int it = wi; it < IT_O + IT_UP; it += nw) {
        if (it < IT_O) transpose_item(a.in[I_WO], D, D, (bf16_t*)(a.ws + WS_WO), D, scr, it, lane);
        else transpose_item<true>(a.in[I_FUP], D, FF2, (bf16_t*)(a.ws + WS_WUP), D, scr, it - IT_O, lane);
    }
}
DI void convert_wdn(const Args& a, unsigned char* lds, int wi, int nw, int wave, int lane) {
    float* scr = (float*)(lds + wave * 16384);
    constexpr int IT_DN = (FF / 64) * (D / 32);
    for (int it = wi; it < IT_DN; it += nw) transpose_item(a.in[I_FDN], FF, D, (bf16_t*)(a.ws + WS_WDN), FF, scr, it, lane);
}

DI float rw_prev_val(const Args& a, const bf16_t* RW, int m, int j) {
    if (m < MP) return (m & (SEQ - 1)) == 0 ? 0.f : bf2f(RW[(size_t)(m - 1) * CSH + j]);
    return a.in[I_SSH][(size_t)(m - MP) * CSH + j];
}
DI void lora_input_row(const Args& a, int m, int lane) {
    bf16_t* ALO = (bf16_t*)(a.ws + WS_ALO) + (size_t)m * KLO;
    if (m >= MT) { for (int c = lane; c < KLO; c += 64) ALO[c] = 0; return; }
    const bf16_t* RW = (const bf16_t*)(a.ws + WS_RW);
    const bf16_t* cur = RW + (size_t)m * CSH;
    float x[5], p[5], mu[5];
#pragma unroll
    for (int i = 0; i < 5; ++i) {
        const int c = lane + 64 * i; const bool ok = c < 288; const int j = 3072 + (ok ? c : 0);
        x[i] = bf2f(cur[j]); mu[i] = a.in[I_MU][j];
        p[i] = m < MP ? ((m & (SEQ - 1)) == 0 ? 0.f : bf2f(RW[(size_t)(m - 1) * CSH + j])) : a.in[I_SSH][(size_t)(m - MP) * CSH + j];
    }
#pragma unroll
    for (int i = 0; i < 6; ++i) {
        const int c = lane + 64 * i; float v = 0.f;
        if (i < 5 && c < 288) {
            const float xs = x[i < 5 ? i : 0] + mu[i < 5 ? i : 0] * (p[i < 5 ? i : 0] - x[i < 5 ? i : 0]);
            v = c < 64 ? 1.f - 2.f * __builtin_amdgcn_rcpf(1.f + __expf(2.f * xs)) : (c < 128 ? xs : __builtin_amdgcn_rcpf(1.f + __expf(-xs)));
        }
        ALO[c] = (bf16_t)bf_rne(v);
    }
}

DI int crow(int reg, int h) { return (reg & 3) + 8 * (reg >> 2) + 4 * h; }
typedef short s16x4 __attribute__((ext_vector_type(4)));
constexpr int VPITCH = 192;
DI void attn_prompt_unit(const Args& a, unsigned char* lds, int unit, int wave, int lane) {
    const bf16_t* Qb = (const bf16_t*)(a.ws + WS_QB); const bf16_t* Kb = (const bf16_t*)(a.ws + WS_KB); const bf16_t* Vb = (const bf16_t*)(a.ws + WS_VB);
    bf16_t* PO = (bf16_t*)(a.ws + WS_PART); float* PML = (float*)(a.ws + WS_PML);
    LAS unsigned char* img = (LAS unsigned char*)lds + wave * (32 * VPITCH);
    const int blk = unit & 63, br = (unit >> 6) % 3, bh = unit / 192, b = bh >> 4, h = bh & 15;
    const int rate = br == 0 ? 1 : (br == 1 ? 4 : 16), L = SEQ / rate, bpc = L / 32;
    const int rho = blk / bpc, l0 = (blk % bpc) * 32;
    const int r = lane & 31, hh = lane >> 5;
    const int mq = b * SEQ + rho + rate * (l0 + r);
    bf16x8 qf[4];
#pragma unroll
    for (int ks = 0; ks < 4; ++ks) qf[ks] = *(const bf16x8*)(Qb + ((size_t)bh * SEQ + rho + rate * (l0 + r)) * 64 + ks * 16 + 8 * hh);
    f32x16 o0, o1;
#pragma unroll
    for (int i = 0; i < 16; ++i) { o0[i] = 0.f; o1[i] = 0.f; }
    float mrun = -1e30f, lrun = 0.f;
    const int lq = l0 + r;
    const int c0 = l0 >= 128 ? 0 : (128 - l0) >> 5;
    const bf16_t* kbase = Kb + ((size_t)bh * SEQ + rho) * 64 + 8 * hh;
    const bf16_t* vbase = Vb + ((size_t)bh * SEQ + rho) * 64 + 8 * (lane & 7);
    bf16x8 kreg[4]; u32x4 vreg[4];
#define AT_PREFETCH(ch_) do { const int lk0_ = l0 - 128 + 32 * (ch_); \
        _Pragma("unroll") for (int ks = 0; ks < 4; ++ks) kreg[ks] = *(const bf16x8*)(kbase + (size_t)(rate * (lk0_ + r)) * 64 + ks * 16); \
        _Pragma("unroll") for (int i = 0; i < 4; ++i) vreg[i] = *(const u32x4*)(vbase + (size_t)(rate * (lk0_ + 8 * i + (lane >> 3))) * 64); } while (0)
    AT_PREFETCH(c0);
    const int i16 = lane & 15, tq = i16 >> 2, tp = i16 & 3, g16 = (lane >> 4) & 1;
    const unsigned troff = (unsigned)((4 * hh + tq) * VPITCH + g16 * 32 + 8 * tp);
    for (int ch = c0; ch < 5; ++ch) {
        const int lk0 = l0 - 128 + 32 * ch;
        bf16x8 kf[4];
#pragma unroll
        for (int ks = 0; ks < 4; ++ks) kf[ks] = kreg[ks];
#pragma unroll
        for (int i = 0; i < 4; ++i) *(LAS u32x4*)(img + (8 * i + (lane >> 3)) * VPITCH + 16 * (lane & 7)) = vreg[i];
        if (ch + 1 < 5) AT_PREFETCH(ch + 1);
        f32x16 st;
#pragma unroll
        for (int i = 0; i < 16; ++i) st[i] = 0.f;
#pragma unroll
        for (int ks = 0; ks < 4; ++ks) st = __builtin_amdgcn_mfma_f32_32x32x16_bf16(kf[ks], qf[ks], st, 0, 0, 0);
        float cmax = -1e30f;
        if (ch == 0 || ch == 4) {
#pragma unroll
            for (int i = 0; i < 16; ++i) { const int lk = lk0 + crow(i, hh); const bool ok = (lk <= lq) && (lk >= lq - 128); st[i] = ok ? st[i] : -1e30f; }
        }
#pragma unroll
        for (int i = 0; i < 16; ++i) cmax = fmaxf(cmax, st[i]);
        cmax = fmaxf(cmax, __shfl_xor(cmax, 32));
        const float mnew = fmaxf(mrun, cmax), alpha = __builtin_amdgcn_exp2f(mrun - mnew);
        float ps = 0.f;
#pragma unroll
        for (int i = 0; i < 16; ++i) { const float p = __builtin_amdgcn_exp2f(st[i] - mnew); st[i] = p; ps += p; }
        lrun = lrun * alpha + ps; mrun = mnew;
#pragma unroll
        for (int i = 0; i < 16; ++i) { o0[i] *= alpha; o1[i] *= alpha; }
#pragma unroll
        for (int s = 0; s < 2; ++s) {
            u32x4 pp; pp.x = pk2(st[8 * s], st[8 * s + 1]); pp.y = pk2(st[8 * s + 2], st[8 * s + 3]); pp.z = pk2(st[8 * s + 4], st[8 * s + 5]); pp.w = pk2(st[8 * s + 6], st[8 * s + 7]);
            const bf16x8 pf = __builtin_bit_cast(bf16x8, pp);
#pragma unroll
            for (int dt = 0; dt < 2; ++dt) {
                const s16x4 lo = __builtin_amdgcn_ds_read_tr16_b64_v4i16((LAS s16x4*)(img + troff + (16 * s) * VPITCH + dt * 64));
                const s16x4 hi = __builtin_amdgcn_ds_read_tr16_b64_v4i16((LAS s16x4*)(img + troff + (16 * s + 8) * VPITCH + dt * 64));
                const bf16x8 vf = __builtin_shufflevector(lo, hi, 0, 1, 2, 3, 4, 5, 6, 7);
                if (dt == 0) o0 = __builtin_amdgcn_mfma_f32_32x32x16_bf16(vf, pf, o0, 0, 0, 0);
                else o1 = __builtin_amdgcn_mfma_f32_32x32x16_bf16(vf, pf, o1, 0, 0, 0);
            }
        }
    }
#undef AT_PREFETCH
    const float ltot = lrun + __shfl_xor(lrun, 32);
    bf16_t* po = PO + ((size_t)br * MP + mq) * 1024 + h * 64;
#pragma unroll
    for (int g = 0; g < 4; ++g) {
        u32x2 w0, w1; w0.x = pk2(o0[4 * g], o0[4 * g + 1]); w0.y = pk2(o0[4 * g + 2], o0[4 * g + 3]); w1.x = pk2(o1[4 * g], o1[4 * g + 1]); w1.y = pk2(o1[4 * g + 2], o1[4 * g + 3]);
        *(u32x2*)(po + 8 * g + 4 * hh) = w0; *(u32x2*)(po + 32 + 8 * g + 4 * hh) = w1;
    }
    if (hh == 0) { float* pm = PML + (((size_t)br * MP + mq) * 16 + h) * 2; pm[0] = mrun; pm[1] = ltot; }
}
DI float sum16(float v) { v = DPP_ADD(v, 0xB1); v = DPP_ADD(v, 0x4E); v = DPP_ADD(v, 0x141); v = DPP_ADD(v, 0x140); return v; }
DI void attn_merge_task(const Args& a, int task, int lane) {
    const int m = task >> 2, h = (task & 3) * 4 + (lane >> 4), d = 4 * (lane & 15);
    const bf16_t* PO = (const bf16_t*)(a.ws + WS_PART); const float* PML = (const float*)(a.ws + WS_PML);
    bf16_t* O = (bf16_t*)(a.ws + WS_O);
    float mb[3], lb[3]; f32x4 ob[3];
#pragma unroll
    for (int br = 0; br < 3; ++br) { const float* pm = PML + (((size_t)br * MP + m) * 16 + h) * 2; mb[br] = pm[0]; lb[br] = pm[1];
        const u32x2 w = *(const u32x2*)(PO + ((size_t)br * MP + m) * 1024 + h * 64 + d);
        ob[br] = (f32x4){__uint_as_float(w.x << 16), __uint_as_float(w.x & 0xffff0000u), __uint_as_float(w.y << 16), __uint_as_float(w.y & 0xffff0000u)}; }
    const float M = fmaxf(mb[0], fmaxf(mb[1], mb[2]));
    f32x4 num = {0.f, 0.f, 0.f, 0.f}; float den = 0.f;
#pragma unroll
    for (int br = 0; br < 3; ++br) { const float w = __builtin_amdgcn_exp2f(mb[br] - M); num += ob[br] * w; den += w * lb[br]; }
    const f32x4 o = num * __builtin_amdgcn_rcpf(den);
    const float ss = sum16(o.x * o.x + o.y * o.y + o.z * o.z + o.w * o.w) * (1.f / 64.f);
    const float rs = rsqrtf(ss + 1e-6f);
    const f32x4 gg = *(const f32x4*)(a.in[I_AOG] + h * 64 + d);
    u32x2 w; w.x = pk2(o.x * rs * gg.x, o.y * rs * gg.y); w.y = pk2(o.z * rs * gg.z, o.w * rs * gg.w);
    *(u32x2*)(O + (size_t)m * D + h * 64 + d) = w;
}
DI void attn_sample_wg(const Args& a, unsigned char* lds, int unit, int wave, int lane) {
    float* part = (float*)lds;
    const int bh = unit * 2 + (wave >> 2), qt = wave & 3, b = bh >> 4, h = bh & 15, g = lane >> 4, l16 = lane & 15;
    const bf16_t* Qb = (const bf16_t*)(a.ws + WS_QB);
    const float* ck = a.in[I_CK] + (size_t)b * 2048 * 1024 + h * 64 + 4 * l16; const float* cv = a.in[I_CV] + (size_t)b * 2048 * 1024 + h * 64 + 4 * l16;
    const float* nk = a.out + O_SK + (size_t)b * 1024 + h * 64 + 4 * l16; const float* nv = a.out + O_SV + (size_t)b * 1024 + h * 64 + 4 * l16;
    const u32x2 qw = *(const u32x2*)(Qb + (size_t)(MP + b) * 1024 + h * 64 + 4 * l16);
    const float q0 = __uint_as_float(qw.x << 16), q1 = __uint_as_float(qw.x & 0xffff0000u), q2 = __uint_as_float(qw.y << 16), q3 = __uint_as_float(qw.y & 0xffff0000u);
    float mrun = -1e30f, lrun = 0.f; f32x4 acc = {0.f, 0.f, 0.f, 0.f};
    const int e0 = qt * 97, e1 = e0 + 97 < 387 ? e0 + 97 : 387;
    for (int ito = 0; ito < 25; ito += 5) {
        f32x4 kv[5], vv[5]; bool valid[5];
#pragma unroll
        for (int k = 0; k < 5; ++k) {
            const int e = e0 + (ito + k) * 4 + g; valid[k] = e < e1;
            const int ee = valid[k] ? e : e0, br = ee / 129, j = ee % 129, rate = br == 0 ? 1 : (br == 1 ? 4 : 16);
            const int row = 2048 - rate * j;
            const float* kp = j == 0 ? nk : ck + (size_t)row * 1024; const float* vp = j == 0 ? nv : cv + (size_t)row * 1024;
            kv[k] = __builtin_nontemporal_load((const f32x4*)kp); vv[k] = __builtin_nontemporal_load((const f32x4*)vp);
        }
#pragma unroll
        for (int k = 0; k < 5; ++k) {
            float s = sum16(q0 * kv[k].x + q1 * kv[k].y + q2 * kv[k].z + q3 * kv[k].w);
            if (!valid[k]) s = -1e30f;
            const float mnew = fmaxf(mrun, s), alpha = __builtin_amdgcn_exp2f(mrun - mnew), p = valid[k] ? __builtin_amdgcn_exp2f(s - mnew) : 0.f;
            lrun = lrun * alpha + p; acc = acc * alpha + vv[k] * p; mrun = mnew;
        }
    }
#pragma unroll
    for (int o = 16; o < 64; o <<= 1) {
        const float mo = __shfl_xor(mrun, o), lo = __shfl_xor(lrun, o);
        f32x4 ao; ao.x = __shfl_xor(acc.x, o); ao.y = __shfl_xor(acc.y, o); ao.z = __shfl_xor(acc.z, o); ao.w = __shfl_xor(acc.w, o);
        const float mn = fmaxf(mrun, mo), w0 = __builtin_amdgcn_exp2f(mrun - mn), w1 = __builtin_amdgcn_exp2f(mo - mn);
        lrun = lrun * w0 + lo * w1; acc = acc * w0 + ao * w1; mrun = mn;
    }
    if (g == 0) { *(f32x4*)(part + wave * 68 + 4 * l16) = acc; if (l16 == 0) { part[wave * 68 + 64] = mrun; part[wave * 68 + 65] = lrun; } }
    __syncthreads();
    if (qt == 0 && g == 0) {
        float M = -1e30f;
#pragma unroll
        for (int w = 0; w < 4; ++w) M = fmaxf(M, part[(wave + w) * 68 + 64]);
        f32x4 num = {0.f, 0.f, 0.f, 0.f}; float den = 0.f;
#pragma unroll
        for (int w = 0; w < 4; ++w) { const float wt = __builtin_amdgcn_exp2f(part[(wave + w) * 68 + 64] - M); num += *(const f32x4*)(part + (wave + w) * 68 + 4 * l16) * wt; den += part[(wave + w) * 68 + 65] * wt; }
        const f32x4 o = num * (1.f / den);
        const float ss = sum16(o.x * o.x + o.y * o.y + o.z * o.z + o.w * o.w);
        const float rs = rsqrtf(ss * (1.f / 64.f) + 1e-6f);
        const f32x4 gg = *(const f32x4*)(a.in[I_AOG] + h * 64 + 4 * l16);
        u32x2 w; w.x = pk2(o.x * rs * gg.x, o.y * rs * gg.y); w.y = pk2(o.z * rs * gg.z, o.w * rs * gg.w);
        *(u32x2*)((bf16_t*)(a.ws + WS_O) + (size_t)(MP + b) * D + h * 64 + 4 * l16) = w;
    }
    __syncthreads();
}

struct PrepParams { float mu_r, mu_k, mu_v, w0, a0, kk, ka, rk; };
struct PrepRaw { float cr, ck, cv, pr, pk, pv, lw, la, lg; };
DI void prep_params(const Args& a, PrepParams& P, int c) {
    P.mu_r = a.in[I_MU][c]; P.mu_k = a.in[I_MU][1024 + c]; P.mu_v = a.in[I_MU][2048 + c];
    P.w0 = a.in[I_W0][c]; P.a0 = a.in[I_A0][c]; P.kk = a.in[I_KK][c]; P.ka = a.in[I_KA][c]; P.rk = a.in[I_RK][c];
}
DI void prep_load(const Args& a, PrepRaw& R, const bf16_t* RW, int m, const bf16_t* Lrow, int c) {
    const bf16_t* cur = RW + (size_t)m * CSH;
    R.cr = bf2f(cur[c]); R.ck = bf2f(cur[1024 + c]); R.cv = bf2f(cur[2048 + c]);
    R.pr = rw_prev_val(a, RW, m, c); R.pk = rw_prev_val(a, RW, m, 1024 + c); R.pv = rw_prev_val(a, RW, m, 2048 + c);
    R.lw = bf2f(Lrow[c]); R.la = bf2f(Lrow[1024 + c]); R.lg = bf2f(Lrow[2048 + c]);
}
DI void prep_finish(const PrepRaw& R, const PrepParams& P, float* dst, float& g_out, float& bonus_out, int lane) {
    const float xr = R.cr + P.mu_r * (R.pr - R.cr), xk = R.ck + P.mu_k * (R.pk - R.ck), xv = R.cv + P.mu_v * (R.pv - R.cv);
    const float x = -(P.w0 + R.lw);
    const float sp = x > 20.f ? x : __logf(1.f + __expf(x));
    const float decay = __expf(-__expf(-sp - 0.5f));
    const float av = __builtin_amdgcn_rcpf(1.f + __expf(-(P.a0 + R.la)));
    float kkv = xk * P.kk;
    const float n2 = wave_sum(kkv * kkv);
    kkv = kkv * fminf(__builtin_amdgcn_rsqf(n2), 1e12f);
    const float keff = xk * (1.f + (av - 1.f) * P.ka);
    const float bon = wave_sum(xr * keff * P.rk) * xv;
    dst[lane] = xr; dst[64 + lane] = decay; dst[128 + lane] = keff; dst[192 + lane] = xv; dst[256 + lane] = -kkv; dst[320 + lane] = kkv * av;
    g_out = R.lg; bonus_out = bon;
}
DI float scan_step(float (&S)[64], const float* sv, float vi) {
    const f32x4* r4 = (const f32x4*)sv; const f32x4* w4 = (const f32x4*)(sv + 64); const f32x4* k4 = (const f32x4*)(sv + 128);
    const f32x4* a4 = (const f32x4*)(sv + 256); const f32x4* b4 = (const f32x4*)(sv + 320);
    float sa0 = 0.f, sa1 = 0.f;
#pragma unroll
    for (int j = 0; j < 16; ++j) { const f32x4 av = a4[j]; sa0 = fmaf(S[4 * j], av.x, sa0); sa1 = fmaf(S[4 * j + 1], av.y, sa1); sa0 = fmaf(S[4 * j + 2], av.z, sa0); sa1 = fmaf(S[4 * j + 3], av.w, sa1); }
    const float sa = sa0 + sa1;
    float y0 = 0.f, y1 = 0.f;
#pragma unroll
    for (int j = 0; j < 16; ++j) {
        const f32x4 bv = b4[j], kv = k4[j], wv = w4[j], rv = r4[j];
        float t;
        t = fmaf(vi, kv.x, sa * bv.x); S[4 * j] = fmaf(S[4 * j], wv.x, t); y0 = fmaf(S[4 * j], rv.x, y0);
        t = fmaf(vi, kv.y, sa * bv.y); S[4 * j + 1] = fmaf(S[4 * j + 1], wv.y, t); y1 = fmaf(S[4 * j + 1], rv.y, y1);
        t = fmaf(vi, kv.z, sa * bv.z); S[4 * j + 2] = fmaf(S[4 * j + 2], wv.z, t); y0 = fmaf(S[4 * j + 2], rv.z, y0);
        t = fmaf(vi, kv.w, sa * bv.w); S[4 * j + 3] = fmaf(S[4 * j + 3], wv.w, t); y1 = fmaf(S[4 * j + 3], rv.w, y1);
        if ((j & 3) == 3) asm volatile("" ::: "memory");
    }
    return y0 + y1;
}
DI void rwkv_post(const Args& a, float y, float g, float bonus, int m, int c) {
    const float mean = wave_sum(y) * (1.f / 64.f); const float d = y - mean; const float var = wave_sum(d * d) * (1.f / 64.f);
    const float yn = d * rsqrtf(var + 64e-5f) * a.in[I_LNW][c] + a.in[I_LNB][c];
    ((bf16_t*)(a.ws + WS_O))[(size_t)m * D + 1024 + c] = (bf16_t)bf_rne((yn + bonus) * g);
}

#define WG_BAR_LDS() do { asm volatile("s_waitcnt lgkmcnt(0)" ::: "memory"); __builtin_amdgcn_s_barrier(); asm volatile("" ::: "memory"); } while (0)
typedef float f32x2 __attribute__((ext_vector_type(2)));
DI f32x2 fma2(f32x2 a, f32x2 b, f32x2 c) { return __builtin_elementwise_fma(a, b, c); }
DI void scan_dot_a(const f32x2 (&Z)[32], const f32x2 (&P)[32], const float* sv, float& sz, float& sp) {
    const f32x4* a4 = (const f32x4*)(sv + 256);
    f32x2 saz = {0.f, 0.f}, sap = {0.f, 0.f};
#pragma unroll
    for (int j = 0; j < 16; ++j) { const f32x4 av = a4[j]; const f32x2 a0 = {av.x, av.y}, a1 = {av.z, av.w};
        saz = fma2(Z[2 * j], a0, saz); sap = fma2(P[2 * j], a0, sap); saz = fma2(Z[2 * j + 1], a1, saz); sap = fma2(P[2 * j + 1], a1, sap);
        if ((j & 7) == 7) asm volatile("" ::: "memory"); }
    sz = saz.x + saz.y; sp = sap.x + sap.y;
}
DI void scan_step3(f32x2 (&Z)[32], f32x2 (&P)[32], const float* sv, const float* svn, float vi, float& sz, float& sp, float& yz, float& yp) {
    const f32x4* r4 = (const f32x4*)sv; const f32x4* w4 = (const f32x4*)(sv + 64); const f32x4* k4 = (const f32x4*)(sv + 128);
    const f32x4* b4 = (const f32x4*)(sv + 320); const f32x4* an4 = (const f32x4*)(svn + 256);
    const f32x2 sz2 = {sz, sz}, sp2 = {sp, sp}, v2 = {vi, vi};
    f32x2 yz2 = {0.f, 0.f}, yp2 = {0.f, 0.f}, nz2 = {0.f, 0.f}, np2 = {0.f, 0.f};
    f32x4 buf[3][5];
#define S3_LD(g, j) do { buf[g][0] = b4[j]; buf[g][1] = k4[j]; buf[g][2] = w4[j]; buf[g][3] = r4[j]; buf[g][4] = an4[j]; asm volatile("" ::: "memory"); } while (0)
    S3_LD(0, 0); S3_LD(1, 1);
#pragma unroll
    for (int j = 0; j < 16; ++j) {
        if (j + 2 < 16) S3_LD((j + 2) % 3, j + 2);
        const f32x4 bv = buf[j % 3][0], kv = buf[j % 3][1], wv = buf[j % 3][2], rv = buf[j % 3][3], av = buf[j % 3][4];
        { const f32x2 b2 = {bv.x, bv.y}, k2 = {kv.x, kv.y}, w2 = {wv.x, wv.y}, r2 = {rv.x, rv.y}, a2 = {av.x, av.y};
          f32x2 tz = sz2 * b2; tz = fma2(v2, k2, tz); Z[2 * j] = fma2(Z[2 * j], w2, tz); yz2 = fma2(Z[2 * j], r2, yz2); nz2 = fma2(Z[2 * j], a2, nz2);
          const f32x2 tp = sp2 * b2; P[2 * j] = fma2(P[2 * j], w2, tp); yp2 = fma2(P[2 * j], r2, yp2); np2 = fma2(P[2 * j], a2, np2); }
        { const f32x2 b2 = {bv.z, bv.w}, k2 = {kv.z, kv.w}, w2 = {wv.z, wv.w}, r2 = {rv.z, rv.w}, a2 = {av.z, av.w};
          f32x2 tz = sz2 * b2; tz = fma2(v2, k2, tz); Z[2 * j + 1] = fma2(Z[2 * j + 1], w2, tz); yz2 = fma2(Z[2 * j + 1], r2, yz2); nz2 = fma2(Z[2 * j + 1], a2, nz2);
          const f32x2 tp = sp2 * b2; P[2 * j + 1] = fma2(P[2 * j + 1], w2, tp); yp2 = fma2(P[2 * j + 1], r2, yp2); np2 = fma2(P[2 * j + 1], a2, np2); }
        asm volatile("" ::: "memory");
    }
#undef S3_LD
    yz = yz2.x + yz2.y; yp = yp2.x + yp2.y; sz = nz2.x + nz2.y; sp = np2.x + np2.y;
}
DI void scan_pass1_unit(const Args& a, unsigned char* lds, int unit, int wave, int lane) {
    float* stg = (float*)lds;
    const int pp = wave & 3, pair = unit * 4 + pp, chain = pair / NS, seg = pair % NS, b = chain >> 4, h = chain & 15, c = h * 64 + lane;
    const int mbase = b * SEQ + seg * SEGL;
    constexpr int NB = SEGL / TB;
    if (wave < 4) {
        bf16_t* YL = (bf16_t*)(a.ws + WS_YL); bf16_t* QS = (bf16_t*)(a.ws + WS_QS); float* ZP = (float*)(a.ws + WS_ZP);
        f32x2 Z[32], P[32];
        int idl = lane; asm volatile("" : "+v"(idl));
#pragma unroll
        for (int j = 0; j < 32; ++j) { Z[j] = (f32x2){0.f, 0.f}; P[j] = (f32x2){idl == 2 * j ? 1.f : 0.f, idl == 2 * j + 1 ? 1.f : 0.f}; }
        WG_BAR_LDS();
        for (int blk = 0; blk < NB; ++blk) {
            const float* sb = stg + (((blk & 1) * 4 + pp) * TB) * 384;
            float sz, sp; scan_dot_a(Z, P, sb, sz, sp);
#pragma unroll 1
            for (int tt = 0; tt < TB; ++tt) {
                const float* sv = sb + tt * 384; const float* svn = sb + (tt + 1 < TB ? tt + 1 : tt) * 384;
                float yz, yp; scan_step3(Z, P, sv, svn, sv[192 + lane], sz, sp, yz, yp);
                const size_t o = (size_t)(mbase + blk * TB + tt) * 1024 + c;
                const unsigned yq = pk2(yz, yp); YL[o] = (bf16_t)(yq & 0xffffu); QS[o] = (bf16_t)(yq >> 16);
            }
            WG_BAR_LDS();
        }
        float* zp = ZP + (size_t)pair * 2 * 4096 + lane * 64;
#pragma unroll
        for (int j = 0; j < 16; ++j) { *(f32x4*)(zp + 4 * j) = (f32x4){Z[2 * j].x, Z[2 * j].y, Z[2 * j + 1].x, Z[2 * j + 1].y};
                                       *(f32x4*)(zp + 4096 + 4 * j) = (f32x4){P[2 * j].x, P[2 * j].y, P[2 * j + 1].x, P[2 * j + 1].y}; }
    } else {
        const bf16_t* RW = (const bf16_t*)(a.ws + WS_RW); const bf16_t* Lb = (const bf16_t*)(a.ws + WS_L);
        bf16_t* GB = (bf16_t*)(a.ws + WS_GB);
        PrepParams Pm; prep_params(a, Pm, c);
        PrepRaw raw[TB];
#define P1_LOAD(blk_) do { _Pragma("unroll") for (int k = 0; k < TB; ++k) { const int m = mbase + (blk_) * TB + k; prep_load(a, raw[k], RW, m, Lb + (size_t)m * NLO, c); } } while (0)
#define P1_FINISH(blk_) do { _Pragma("unroll") for (int k = 0; k < TB; ++k) { const int m = mbase + (blk_) * TB + k; float g, bon; \
            prep_finish(raw[k], Pm, stg + ((((blk_) & 1) * 4 + pp) * TB + k) * 384, g, bon, lane); \
            GB[((size_t)m * 16 + h) * 128 + lane] = (bf16_t)bf_rne(g); GB[((size_t)m * 16 + h) * 128 + 64 + lane] = (bf16_t)bf_rne(bon); } } while (0)
        P1_LOAD(0); P1_FINISH(0); P1_LOAD(1);
        WG_BAR_LDS();
        for (int blk = 0; blk < NB; ++blk) {
            if (blk + 1 < NB) P1_FINISH(blk + 1);
            if (blk + 2 < NB) P1_LOAD(blk + 2);
            WG_BAR_LDS();
        }
#undef P1_LOAD
#undef P1_FINISH
    }
}
DI void scan_sample_unit(const Args& a, unsigned char* lds, int unit, int wave, int lane) {
    float* sv = (float*)(lds + 2 * 4 * TB * 384 * 4) + wave * 384;
    const bf16_t* RW = (const bf16_t*)(a.ws + WS_RW); const bf16_t* Lb = (const bf16_t*)(a.ws + WS_L);
    const int b = unit >> 4, h = unit & 15, c = h * 64 + lane, m = MP + b;
    PrepParams P; prep_params(a, P, c);
    PrepRaw raw; prep_load(a, raw, RW, m, Lb + (size_t)m * NLO, c);
    float g, bon; prep_finish(raw, P, sv, g, bon, lane);
    float S[64];
    const float* s0 = a.in[I_SWKV] + ((size_t)(b * 16 + h) * 64 + lane) * 64;
#pragma unroll
    for (int j = 0; j < 16; ++j) { const f32x4 v = *(const f32x4*)(s0 + 4 * j); S[4 * j] = v.x; S[4 * j + 1] = v.y; S[4 * j + 2] = v.z; S[4 * j + 3] = v.w; }
    const float y = scan_step(S, sv, sv[192 + lane]);
    float* so = a.out + O_SWKV + ((size_t)(b * 16 + h) * 64 + lane) * 64;
#pragma unroll
    for (int j = 0; j < 16; ++j) *(f32x4*)(so + 4 * j) = (f32x4){S[4 * j], S[4 * j + 1], S[4 * j + 2], S[4 * j + 3]};
    rwkv_post(a, y, g, bon, m, c);
}
DI void scan_pass2_unit(const Args& a, unsigned char* lds, int chain, int wave, int lane) {
    float* Ssh = (float*)lds;
    float* Psh = Ssh + 64 * 65;
    const float* ZP = (const float*)(a.ws + WS_ZP); float* SST = (float*)(a.ws + WS_SST);
    const int tid = wave * 64 + lane, l16 = lane & 15, lq = lane >> 4, ib = wave >> 1, jb0 = 2 * (wave & 1);
    f32x4 S0 = {0.f, 0.f, 0.f, 0.f}, S1 = {0.f, 0.f, 0.f, 0.f};
    const float* Z0 = ZP + (size_t)(chain * NS) * 2 * 4096;
    f32x4 pn0 = *(const f32x4*)(Z0 + 4096 + tid * 8), pn1 = *(const f32x4*)(Z0 + 4096 + tid * 8 + 4);
    float zn0[4], zn1[4];
#pragma unroll
    for (int i = 0; i < 4; ++i) { zn0[i] = Z0[(16 * ib + 4 * lq + i) * 64 + 16 * jb0 + l16]; zn1[i] = Z0[(16 * ib + 4 * lq + i) * 64 + 16 * (jb0 + 1) + l16]; }
    for (int s = 0; s < NS; ++s) {
        float* sst = SST + ((size_t)chain * NS + s) * 4096;
#pragma unroll
        for (int i = 0; i < 4; ++i) { const int row = 16 * ib + 4 * lq + i;
            sst[row * 64 + 16 * jb0 + l16] = S0[i]; sst[row * 64 + 16 * (jb0 + 1) + l16] = S1[i];
            Ssh[row * 65 + 16 * jb0 + l16] = S0[i]; Ssh[row * 65 + 16 * (jb0 + 1) + l16] = S1[i]; }
        *(f32x4*)(Psh + tid * 8) = pn0; *(f32x4*)(Psh + tid * 8 + 4) = pn1;
        f32x4 n0 = {zn0[0], zn0[1], zn0[2], zn0[3]}, n1 = {zn1[0], zn1[1], zn1[2], zn1[3]};
        if (s + 1 < NS) {
            const float* Zs = ZP + (size_t)(chain * NS + s + 1) * 2 * 4096;
            pn0 = *(const f32x4*)(Zs + 4096 + tid * 8); pn1 = *(const f32x4*)(Zs + 4096 + tid * 8 + 4);
#pragma unroll
            for (int i = 0; i < 4; ++i) { zn0[i] = Zs[(16 * ib + 4 * lq + i) * 64 + 16 * jb0 + l16]; zn1[i] = Zs[(16 * ib + 4 * lq + i) * 64 + 16 * (jb0 + 1) + l16]; }
        }
        WG_BAR_LDS();
        if (s > 0) {
#pragma unroll
            for (int kk = 0; kk < 16; ++kk) {
                const float af = Ssh[(16 * ib + l16) * 65 + 4 * kk + lq];
                const float b0 = Psh[(4 * kk + lq) * 64 + 16 * jb0 + l16], b1 = Psh[(4 * kk + lq) * 64 + 16 * (jb0 + 1) + l16];
                n0 = __builtin_amdgcn_mfma_f32_16x16x4f32(af, b0, n0, 0, 0, 0);
                n1 = __builtin_amdgcn_mfma_f32_16x16x4f32(af, b1, n1, 0, 0, 0);
            }
        }
        WG_BAR_LDS();
        S0 = n0; S1 = n1;
    }
    float* so = a.out + O_PWKV + (size_t)chain * 4096;
#pragma unroll
    for (int i = 0; i < 4; ++i) { const int row = 16 * ib + 4 * lq + i; so[row * 64 + 16 * jb0 + l16] = S0[i]; so[row * 64 + 16 * (jb0 + 1) + l16] = S1[i]; }
}
DI bf16x8 cvt8(const f32x4 lo, const f32x4 hi) { u32x4 p; p.x = pk2(lo.x, lo.y); p.y = pk2(lo.z, lo.w); p.z = pk2(hi.x, hi.y); p.w = pk2(hi.z, hi.w); return __builtin_bit_cast(bf16x8, p); }
DI void scan_pass3_unit(const Args& a, int unit, int lane) {
    const float* SST = (const float*)(a.ws + WS_SST); const bf16_t* YL = (const bf16_t*)(a.ws + WS_YL); const bf16_t* QS = (const bf16_t*)(a.ws + WS_QS); const bf16_t* GB = (const bf16_t*)(a.ws + WS_GB);
    bf16_t* O = (bf16_t*)(a.ws + WS_O);
    const int sub = unit & 3, pair = unit >> 2, chain = pair / NS, seg = pair % NS, b = chain >> 4, h = chain & 15;
    const int r = lane & 31, hh = lane >> 5;
    const int m = b * SEQ + seg * SEGL + sub * 32 + r;
    f32x16 acc0, acc1;
#pragma unroll
    for (int i = 0; i < 16; ++i) { acc0[i] = 0.f; acc1[i] = 0.f; }
    const bf16_t* qrow = QS + (size_t)m * 1024 + h * 64 + 8 * hh;
    const float* s0 = SST + (size_t)pair * 4096 + (size_t)r * 64 + 8 * hh; const float* s1 = s0 + 32 * 64;
#pragma unroll
    for (int ks = 0; ks < 4; ++ks) {
        const bf16x8 qf = *(const bf16x8*)(qrow + ks * 16);
        const bf16x8 a0 = cvt8(*(const f32x4*)(s0 + ks * 16), *(const f32x4*)(s0 + ks * 16 + 4));
        const bf16x8 a1 = cvt8(*(const f32x4*)(s1 + ks * 16), *(const f32x4*)(s1 + ks * 16 + 4));
        acc0 = __builtin_amdgcn_mfma_f32_32x32x16_bf16(a0, qf, acc0, 0, 0, 0);
        acc1 = __builtin_amdgcn_mfma_f32_32x32x16_bf16(a1, qf, acc1, 0, 0, 0);
    }
    const bf16_t* yl = YL + (size_t)m * 1024 + h * 64 + 4 * hh;
    float y[32]; float sum = 0.f;
#pragma unroll
    for (int rt = 0; rt < 2; ++rt)
#pragma unroll
        for (int g = 0; g < 4; ++g) { const u32x2 yw = *(const u32x2*)(yl + rt * 32 + 8 * g); const f32x4 v = {__uint_as_float(yw.x << 16), __uint_as_float(yw.x & 0xffff0000u), __uint_as_float(yw.y << 16), __uint_as_float(yw.y & 0xffff0000u)};
#pragma unroll
            for (int e = 0; e < 4; ++e) { const float yy = v[e] + (rt == 0 ? acc0[4 * g + e] : acc1[4 * g + e]); y[rt * 16 + 4 * g + e] = yy; sum += yy; } }
    sum += __shfl_xor(sum, 32);
    const float mean = sum * (1.f / 64.f);
    float vs = 0.f;
#pragma unroll
    for (int e = 0; e < 32; ++e) { y[e] -= mean; vs += y[e] * y[e]; }
    vs += __shfl_xor(vs, 32);
    const float rstd = rsqrtf(vs * (1.f / 64.f) + 64e-5f);
    const bf16_t* gb = GB + ((size_t)m * 16 + h) * 128 + 4 * hh;
    const float* lw = a.in[I_LNW] + h * 64 + 4 * hh; const float* lb = a.in[I_LNB] + h * 64 + 4 * hh;
    bf16_t* orow = O + (size_t)m * D + 1024 + h * 64 + 4 * hh;
    f32x4 w4s[8], b4s[8]; u32x2 gws[8], bws[8];
#pragma unroll
    for (int q = 0; q < 8; ++q) { const int off = (q >> 2) * 32 + 8 * (q & 3); w4s[q] = *(const f32x4*)(lw + off); b4s[q] = *(const f32x4*)(lb + off); gws[q] = *(const u32x2*)(gb + off); bws[q] = *(const u32x2*)(gb + 64 + off); }
#pragma unroll
    for (int rt = 0; rt < 2; ++rt)
#pragma unroll
        for (int g = 0; g < 4; ++g) {
            const int off = rt * 32 + 8 * g;
            const f32x4 w4 = w4s[rt * 4 + g], b4 = b4s[rt * 4 + g];
            const u32x2 gw = gws[rt * 4 + g], bw = bws[rt * 4 + g];
            const float gg[4] = {__uint_as_float(gw.x << 16), __uint_as_float(gw.x & 0xffff0000u), __uint_as_float(gw.y << 16), __uint_as_float(gw.y & 0xffff0000u)};
            const float bb[4] = {__uint_as_float(bw.x << 16), __uint_as_float(bw.x & 0xffff0000u), __uint_as_float(bw.y << 16), __uint_as_float(bw.y & 0xffff0000u)};
            float o[4];
#pragma unroll
            for (int e = 0; e < 4; ++e) o[e] = (y[rt * 16 + 4 * g + e] * rstd * w4[e] + b4[e] + bb[e]) * gg[e];
            u32x2 w; w.x = pk2(o[0], o[1]); w.y = pk2(o[2], o[3]);
            *(u32x2*)(orow + off) = w;
        }
}

DI void unpack8(const u32x4 w, float (&u)[8]) {
    u[0] = __uint_as_float(w.x << 16); u[1] = __uint_as_float(w.x & 0xffff0000u); u[2] = __uint_as_float(w.y << 16); u[3] = __uint_as_float(w.y & 0xffff0000u);
    u[4] = __uint_as_float(w.z << 16); u[5] = __uint_as_float(w.z & 0xffff0000u); u[6] = __uint_as_float(w.w << 16); u[7] = __uint_as_float(w.w & 0xffff0000u);
}
constexpr int FIX_ROWS = 28 * 2 + MS + 8;
DI void conv_fix(const Args& a, int idx) {
    const int fg = idx % (FF / 8), ri = idx / (FF / 8), f = fg * 8;
    if (ri >= FIX_ROWS) return;
    const float* EDGE = (const float*)(a.ws + WS_U); bf16_t* ACT = (bf16_t*)(a.ws + WS_ACT);
    const float* cw = a.in[I_FCW]; const float* cb = a.in[I_FCB];
    const float *p0, *p1, *p2; int m;
    if (ri < 56) {
        const int ti = ri >> 1, k = ri & 1, pm = ti + 1 + ti / 7;
        m = pm * 256 + k;
        p0 = EDGE + ((size_t)pm * 4 + k) * FF2;
        p1 = k == 0 ? EDGE + ((size_t)(pm - 1) * 4 + 3) * FF2 : EDGE + ((size_t)pm * 4 + 0) * FF2;
        p2 = k == 0 ? EDGE + ((size_t)(pm - 1) * 4 + 2) * FF2 : EDGE + ((size_t)(pm - 1) * 4 + 3) * FF2;
    } else if (ri >= 56 + MS) {
        const int q = ri - 56 - MS, bb = q >> 1, k = q & 1;
        const float* src = EDGE + ((size_t)(bb * 8 + 7) * 4 + 2 + k) * FF2; float* dst = a.out + O_PFFN + ((size_t)bb * 2 + k) * FF2;
#pragma unroll
        for (int p = 0; p < 2; ++p) { *(f32x4*)(dst + p * FF + f) = *(const f32x4*)(src + p * FF + f); *(f32x4*)(dst + p * FF + f + 4) = *(const f32x4*)(src + p * FF + f + 4); }
        return;
    } else {
        const int b = ri - 56; m = MP + b;
        p0 = EDGE + (size_t)(128 + b) * FF2;
        { float* s1 = a.out + O_SFFN + (size_t)b * 2 * FF2 + FF2;
#pragma unroll
          for (int p = 0; p < 2; ++p) { *(f32x4*)(s1 + p * FF + f) = *(const f32x4*)(p0 + p * FF + f); *(f32x4*)(s1 + p * FF + f + 4) = *(const f32x4*)(p0 + p * FF + f + 4); } }
        p1 = a.in[I_SFFN] + (size_t)b * 2 * FF2 + FF2;
        p2 = a.in[I_SFFN] + (size_t)b * 2 * FF2;
        float* so = a.out + O_SFFN + (size_t)b * 2 * FF2;
#pragma unroll
        for (int p = 0; p < 2; ++p) { *(f32x4*)(so + p * FF + f) = *(const f32x4*)(p1 + p * FF + f); *(f32x4*)(so + p * FF + f + 4) = *(const f32x4*)(p1 + p * FF + f + 4); }
    }
    float c[2][8];
#pragma unroll
    for (int p = 0; p < 2; ++p)
#pragma unroll
        for (int j = 0; j < 8; ++j) { const int col = p * FF + f + j; c[p][j] = cb[col] + cw[col] * p2[col] + cw[FF2 + col] * p1[col] + cw[2 * FF2 + col] * p0[col]; }
    float o[8];
#pragma unroll
    for (int j = 0; j < 8; ++j) o[j] = c[0][j] * __builtin_amdgcn_rcpf(1.f + __expf(-c[0][j])) * c[1][j];
    u32x4 w; w.x = pk2(o[0], o[1]); w.y = pk2(o[2], o[3]); w.z = pk2(o[4], o[5]); w.w = pk2(o[6], o[7]);
    *(u32x4*)(ACT + (size_t)m * FF + f) = w;
}

#define XB_TMO      128
#define XB_XCNT(j)  (256  + 64 * (j))
#define XB_XSUB(j)  (1280 + 64 * (j))
#define XB_XGEN(j)  (2304 + 64 * (j))
#define XB_TOP      3328
#define XB_TOPGEN   3392
#define XCD_BAR_WORDS 3456
#define XB_SPIN_CAP (1u << 18)
DI unsigned xb_ld(unsigned* p)              { return __hip_atomic_load(p, __ATOMIC_RELAXED, __HIP_MEMORY_SCOPE_AGENT); }
DI unsigned xb_add(unsigned* p, unsigned v) { return __hip_atomic_fetch_add(p, v, __ATOMIC_RELAXED, __HIP_MEMORY_SCOPE_AGENT); }
DI unsigned xb_xcc_id() { return (unsigned)__builtin_amdgcn_s_getreg((3 << 11) | 20) & 0xFu; }
#define XB_SPIN(cond, bar) do { unsigned _sp = 0; while (cond) { __builtin_amdgcn_s_sleep(1); \
    if ((++_sp & 255u) == 0u) { if (xb_ld(&(bar)[XB_TMO])) break; if (_sp > XB_SPIN_CAP) { atomicAdd(&(bar)[XB_TMO], 1u); break; } } } } while (0)
struct XcdBarrier { unsigned* bar; unsigned x; volatile LAS unsigned* st; };
DI XcdBarrier xcd_barrier_post(unsigned* bar, volatile LAS unsigned* st) {
    XcdBarrier b; b.bar = bar; b.x = xb_xcc_id(); b.st = st;
    if (threadIdx.x == 0) (void)xb_add(&bar[XB_XCNT(b.x)], 1u);
    return b;
}
DI void xcd_barrier_complete(unsigned* bar, unsigned x, unsigned& nloc, unsigned& nx) {
    const unsigned G = gridDim.x * gridDim.y * gridDim.z;
    unsigned sum, cnt, mine, sp = 0u;
    for (;;) {
        sum = 0u; cnt = 0u; mine = 0u;
#pragma unroll
        for (unsigned j = 0; j < 16; ++j) { const unsigned c = xb_ld(&bar[XB_XCNT(j)]); sum += c; cnt += (c > 0u) ? 1u : 0u; mine = (j == x) ? c : mine; }
        if (sum == G) break;
        __builtin_amdgcn_s_sleep(1);
        if ((++sp & 255u) == 0u) { if (xb_ld(&bar[XB_TMO])) break; if (sp > XB_SPIN_CAP) { atomicAdd(&bar[XB_TMO], 1u); break; } }
    }
    nloc = mine > 0u ? mine : 1u; nx = cnt > 0u ? cnt : 1u;
}
DI void xcd_barrier(const XcdBarrier& b) {
    asm volatile("s_waitcnt vmcnt(0)" ::: "memory");
    __syncthreads();
    if (threadIdx.x == 0) {
        unsigned* bar = b.bar;
        __builtin_amdgcn_s_waitcnt(0);
        unsigned nloc = b.st[0], nx = b.st[1];
        if (nloc == 0u) { xcd_barrier_complete(bar, b.x, nloc, nx); b.st[0] = nloc; b.st[1] = nx; }
        const unsigned old = xb_add(&bar[XB_XSUB(b.x)], 1u);
        const unsigned gen = old / nloc;
        if (old + 1u == (gen + 1u) * nloc) {
            __builtin_amdgcn_fence(__ATOMIC_RELEASE, "agent");
            asm volatile("s_waitcnt vmcnt(0)" ::: "memory");
            const unsigned og = xb_add(&bar[XB_TOP], 1u);
            const unsigned tg = og / nx;
            if (og + 1u == (tg + 1u) * nx) xb_add(&bar[XB_TOPGEN], 1u);
            else XB_SPIN(xb_ld(&bar[XB_TOPGEN]) == tg, bar);
            __builtin_amdgcn_fence(__ATOMIC_ACQUIRE, "agent");
            xb_add(&bar[XB_XGEN(b.x)], 1u);
            asm volatile("s_waitcnt vmcnt(0)" ::: "memory");
        } else {
            XB_SPIN(xb_ld(&bar[XB_XGEN(b.x)]) == gen, bar);
            __builtin_amdgcn_fence(__ATOMIC_ACQUIRE, "agent");
            asm volatile("s_waitcnt vmcnt(0)" ::: "memory");
        }
    }
    __syncthreads();
}

DI void skinny_unit(const bf16_t* A, int lda, const bf16_t* Bt, int K, int unit, const float* base, int ldb, float* out, int ldo, unsigned char* lds, int wave, int lane,
                    const float* gf = nullptr, bf16_t* H = nullptr, float* RSS = nullptr) {
    float* red = (float*)lds;
    const int n0 = unit * 32, r = lane & 31, hh = lane >> 5, kw = K / 8, kb = wave * kw;
    f32x16 acc;
#pragma unroll
    for (int i = 0; i < 16; ++i) acc[i] = 0.f;
    const bf16_t* ap = A + (size_t)r * lda + kb + 8 * hh; const bf16_t* bp = Bt + (size_t)(n0 + r) * K + kb + 8 * hh;
    for (int k0 = 0; k0 < kw; k0 += 128) {
        bf16x8 af[8], bf[8];
#pragma unroll
        for (int i = 0; i < 8; ++i) { const int k = k0 + 16 * i < kw ? k0 + 16 * i : 0; af[i] = *(const bf16x8*)(ap + k); bf[i] = *(const bf16x8*)(bp + k); }
#pragma unroll
        for (int i = 0; i < 8; ++i) if (k0 + 16 * i < kw) acc = __builtin_amdgcn_mfma_f32_32x32x16_bf16(af[i], bf[i], acc, 0, 0, 0);
    }
#pragma unroll
    for (int i = 0; i < 16; ++i) red[(wave * 16 + i) * 64 + lane] = acc[i];
    __syncthreads();
#pragma unroll
    for (int q = 0; q < 2; ++q) {
        const int o = threadIdx.x + 512 * q, i = o >> 6, ln = o & 63;
        float sum = 0.f;
#pragma unroll
        for (int w = 0; w < 8; ++w) sum += red[(w * 16 + i) * 64 + ln];
        const int row = crow(i, ln >> 5), col = n0 + (ln & 31);
        const float x1 = base[(size_t)row * ldb + col] + sum * (H ? 1.0f : MK_P11_SCALE);
        out[(size_t)row * ldo + col] = x1;
        if (H) { H[(size_t)row * D + col] = (bf16_t)bf_rne(x1 * gf[col]);
            float ss = x1 * x1;
            ss += __shfl_xor(ss, 1); ss += __shfl_xor(ss, 2); ss += __shfl_xor(ss, 4); ss += __shfl_xor(ss, 8); ss += __shfl_xor(ss, 16);
            if ((ln & 31) == 0) atomic_add_f32(RSS + row, ss); }
    }
    __syncthreads();
}

constexpr int NPH = 14;
template <bool COOP>
__global__ void __launch_bounds__(NTHREADS, 2) mk_fwd(Args a) {
    extern __shared__ __attribute__((aligned(16))) unsigned char lds[];
    const int tid = threadIdx.x, lane = tid & 63, wave = __builtin_amdgcn_readfirstlane(tid >> 6);
    const int G = gridDim.x, bid = blockIdx.x, gw = bid * NWAVES + wave, ngw = G * NWAVES;
    unsigned char* ws = a.ws;
    LAS unsigned char* ldsl = (LAS unsigned char*)lds;
#ifndef PHMASK
#define PHMASK 0xffff
#endif
#define IN(k) (((PHMASK >> (k)) & 1) && a.ph_lo <= (k) && (k) < a.ph_hi)
    XcdBarrier xbar; xbar.bar = (unsigned*)(ws + WS_BAR); xbar.x = 0; xbar.st = nullptr;
    if (COOP) {
        volatile LAS unsigned* st = (volatile LAS unsigned*)(ldsl + LDS_BYTES - 16);
        if (tid < 4) st[tid] = 0u;
        __syncthreads();
        xbar = xcd_barrier_post((unsigned*)(ws + WS_BAR), st);
    }
#define SEAM(k) do { if (COOP && IN(k) && IN((k) + 1)) { if (a.ph_hi > 1000) cg::this_grid().sync(); else xcd_barrier(xbar); } } while (0)

    if (IN(0)) phase_prologue(a, lds, gw, ngw, lane, wave);
    SEAM(0);
    if (IN(1)) {
        pg8::Gemm g{(const bf16_t*)(ws + WS_H), (const bf16_t*)(ws + WS_WIN), MPAD, NIN, D}; pg8::StaticOrder S; S.init(MPAD, NIN, G, bid);
        EpiIn E{(bf16_t*)(ws + WS_QB), (bf16_t*)(ws + WS_KB), (bf16_t*)(ws + WS_VB), (bf16_t*)(ws + WS_RW), a.out};
        pg8::gemm_phase<EpiIn>(ldsl, g, S, E);
        {
            const int nu = (MPAD / 256) * (NIN / 256), rem = nu % G, first = rem == 0 ? 0 : rem, nfree = G - first;
            if (bid >= first) convert_wo_wup(a, lds, (bid - first) * NWAVES + wave, nfree * NWAVES, wave, lane);
        }
    }
    SEAM(1);
    if (IN(2)) {
        for (int u = bid; u < 256; u += G) attn_sample_wg(a, lds, u, wave, lane);
        {
            const int vb = (G % 8 == 0) ? (bid % 8) * (G / 8) + bid / 8 : bid;
            for (int u = vb * NWAVES + wave; u < 64 * 3 * 64; u += ngw) attn_prompt_unit(a, lds, u, wave, lane);
        }
        for (int m = gw; m < MPAD; m += ngw) lora_input_row(a, m, lane);
    }
    SEAM(2);
    if (IN(3)) {
        pg8::Gemm g{(const bf16_t*)(ws + WS_ALO), (const bf16_t*)(ws + WS_WLO), MPAD, NLO, KLO}; pg8::StaticOrder S; S.init(MPAD, NLO, G, bid);
        EpiBf E{(bf16_t*)(ws + WS_L), NLO};
        pg8::gemm_phase<EpiBf>(ldsl, g, S, E);
#pragma unroll 2
        for (int t = gw; t < MP * 4; t += ngw) attn_merge_task(a, t, lane);
    }
    SEAM(3);
    if (IN(4)) {
#ifndef NO_P1
        for (int u = bid; u < 64 * NS / 4; u += G) scan_pass1_unit(a, lds, u, wave, lane);
#endif

    }
    SEAM(4);
    if (IN(5)) {
        if (G >= 128) {
            if (bid < 64) scan_pass2_unit(a, lds, bid, wave, lane);
            else for (int u = (bid - 64) * NWAVES + wave; u < 512; u += (G - 64) * NWAVES) scan_sample_unit(a, lds, u, wave, lane);
        } else {
            for (int ch = bid; ch < 64; ch += G) scan_pass2_unit(a, lds, ch, wave, lane);
            for (int u = gw; u < 512; u += ngw) scan_sample_unit(a, lds, u, wave, lane);
        }
    }
    SEAM(5);
    if (IN(6)) { for (int u = gw; u < 64 * NS * 4; u += ngw) scan_pass3_unit(a, u, lane); }
    SEAM(6);
    if (IN(7)) {
        pg8::Gemm g{(const bf16_t*)(ws + WS_O), (const bf16_t*)(ws + WS_WO), MP, D, D}; pg8::StaticOrder S; S.init(MP, D, G, bid);
        EpiWo E{a.in[I_XP], a.in[I_NFG], (float*)(ws + WS_X1), (bf16_t*)(ws + WS_H), (float*)(ws + WS_RSS)};
        pg8::gemm_phase<EpiWo>(ldsl, g, S, E);
        for (int u = bid; u < D / 32; u += G)
            skinny_unit((const bf16_t*)(ws + WS_O) + (size_t)MP * D, D, (const bf16_t*)(ws + WS_WO), D, u, a.in[I_XS], D, (float*)(ws + WS_X1) + (size_t)MP * D, D, lds, wave, lane,
                        a.in[I_NFG], (bf16_t*)(ws + WS_H) + (size_t)MP * D, (float*)(ws + WS_RSS) + MP);
    }
    SEAM(7);
    if (IN(9)) {
        pg8::Gemm g{(const bf16_t*)(ws + WS_H), (const bf16_t*)(ws + WS_WUP), MPAD, FF2, D}; pg8::StaticOrder S; S.init(MPAD, FF2, G, bid);
        EpiUpF E{(bf16_t*)(ws + WS_ACT), a.out, (const float*)(ws + WS_RSS), a.in[I_FCW], a.in[I_FCB], (float*)(ws + WS_U), (LAS float*)(ldsl + 131072)};
        pg8::gemm_phase<EpiUpF>(ldsl, g, S, E);
        {
            const int nu = (MPAD / 256) * (FF2 / 256), rem = nu % G, first = rem == 0 ? 0 : rem, nfree = G - first;
            if (bid >= first) convert_wdn(a, lds, (bid - first) * NWAVES + wave, nfree * NWAVES, wave, lane);
        }
    }
    SEAM(9);
    if (IN(10)) { for (int it = bid * NTHREADS + tid; it < FIX_ROWS * (FF / 8); it += G * NTHREADS) conv_fix(a, it); }
    SEAM(10);
    if (IN(11)) {
        pg8::Gemm g{(const bf16_t*)(ws + WS_ACT), (const bf16_t*)(ws + WS_WDN), MP, D, FF}; pg8::StaticOrder S; S.init(MP, D, G, bid);
        EpiDn E{(float*)(ws + WS_X1)};
        pg8::gemm_phase<EpiDn>(ldsl, g, S, E);
        for (int u = bid; u < D / 32; u += G)
            skinny_unit((const bf16_t*)(ws + WS_ACT) + (size_t)MP * FF, FF, (const bf16_t*)(ws + WS_WDN), FF, u, (const float*)(ws + WS_X1) + (size_t)MP * D, D, (float*)(ws + WS_X1) + (size_t)MP * D, D, lds, wave, lane);
    }
    SEAM(11);
    if (IN(12)) {
        for (int m = gw; m < MT; m += ngw)
            rms_row_f32((const float*)(ws + WS_X1) + (size_t)m * D, a.in[I_NFIN], m < MP ? a.out + O_YP + (size_t)m * D : a.out + O_YS + (size_t)(m - MP) * D, lane);
    }
#undef IN
#undef SEAM
}

#ifndef MK_ONE_LAUNCH
#define MK_ONE_LAUNCH 1
#endif
#ifndef MK_DBL_MASK
#define MK_DBL_MASK 0x0
#endif

extern "C" void kernel_launch(void* const* d_in, const int* in_sizes, int n_in, void* d_out, int out_size, void* d_ws, size_t ws_size, hipStream_t stream) {
    static int grid = 0;
    if (!grid) {
        if (n_in != 28 || (size_t)out_size != O_END || ws_size < WS_END) fprintf(stderr, "kernel_launch: unexpected shapes: n_in %d out %d (want %zu) ws %zu (want %zu)\n", n_in, out_size, O_END, ws_size, WS_END);
        int dev = 0, cus = 0; hipGetDevice(&dev); hipDeviceGetAttribute(&cus, hipDeviceAttributeMultiprocessorCount, dev);
        hipFuncSetAttribute((const void*)mk_fwd<true>, hipFuncAttributeMaxDynamicSharedMemorySize, LDS_BYTES);
        hipFuncSetAttribute((const void*)mk_fwd<false>, hipFuncAttributeMaxDynamicSharedMemorySize, LDS_BYTES);
        int per_cu = 0; hipOccupancyMaxActiveBlocksPerMultiprocessor(&per_cu, mk_fwd<true>, NTHREADS, LDS_BYTES);
        if (per_cu < 1) { fprintf(stderr, "kernel_launch: occupancy query says %d blocks/CU\n", per_cu); per_cu = 1; }
        grid = cus > 0 ? cus : 256;
    }
    Args a; memset(&a, 0, sizeof(a));
    for (int i = 0; i < 28; ++i) a.in[i] = (const float*)d_in[i];
    a.out = (float*)d_out; a.ws = (unsigned char*)d_ws;
#if MK_ONE_LAUNCH
    if (hipMemsetAsync((char*)d_ws + WS_BAR, 0, BAR_BYTES, stream) != hipSuccess) { fprintf(stderr, "kernel_launch: memset of the barrier words failed\n"); return; }
    a.ph_lo = 0; a.ph_hi = NPH;
    void* args[] = {&a};
    hipError_t e = hipLaunchCooperativeKernel((const void*)mk_fwd<true>, dim3(grid), dim3(NTHREADS), args, LDS_BYTES, stream);
    if (e != hipSuccess) fprintf(stderr, "cooperative launch failed: %s (grid %d)\n", hipGetErrorString(e), grid);
#else
    for (int p = 0; p < 13; ++p) {
        a.ph_lo = p; a.ph_hi = p + 1;
        mk_fwd<false><<<dim3(grid), dim3(NTHREADS), LDS_BYTES, stream>>>(a);
        if ((MK_DBL_MASK >> p) & 1) mk_fwd<false><<<dim3(grid), dim3(NTHREADS), LDS_BYTES, stream>>>(a);
    }
#endif
}
```

```cpp
#include <hip/hip_runtime.h>
#include <hip/hip_cooperative_groups.h>
#include <cstdio>
#include <cstdint>
#include <cstring>
namespace cg = cooperative_groups;

#define DI __device__ __forceinline__
#define LAS __attribute__((address_space(3)))
typedef unsigned short bf16_t;
typedef short bf16x8 __attribute__((ext_vector_type(8)));
typedef float f32x4 __attribute__((ext_vector_type(4)));
typedef float f32x16 __attribute__((ext_vector_type(16)));
typedef unsigned u32x4 __attribute__((ext_vector_type(4)));
typedef unsigned u32x2 __attribute__((ext_vector_type(2)));

constexpr int D = 2048, MP = 8192, MS = 32, MT = 8224, MPAD = 8448, SEQ = 2048;
constexpr int CIN = 6432, NIN = 6656, CSH = 3360, FF2 = 11264, FF = 5632;
constexpr int NLO = 3072, KLO = 384;
constexpr int NS = 16, SEGL = 128, TB = 8;
constexpr int NTHREADS = 512, NWAVES = 8;
constexpr int LDS_BYTES = 131072 + 16384;

constexpr size_t O_YP = 0;
constexpr size_t O_YS = O_YP + (size_t)MP * D;
constexpr size_t O_PK = O_YS + (size_t)MS * D;
constexpr size_t O_PV = O_PK + (size_t)MP * 1024;
constexpr size_t O_PRW = O_PV + (size_t)MP * 1024;
constexpr size_t O_PWKV = O_PRW + (size_t)4 * CSH;
constexpr size_t O_PFFN = O_PWKV + (size_t)4 * 16 * 4096;
constexpr size_t O_SK = O_PFFN + (size_t)4 * 2 * FF2;
constexpr size_t O_SV = O_SK + (size_t)MS * 1024;
constexpr size_t O_SRW = O_SV + (size_t)MS * 1024;
constexpr size_t O_SWKV = O_SRW + (size_t)MS * CSH;
constexpr size_t O_SFFN = O_SWKV + (size_t)MS * 16 * 4096;
constexpr size_t O_END = O_SFFN + (size_t)MS * 2 * FF2;

constexpr size_t al256(size_t x) { return (x + 255) & ~(size_t)255; }
constexpr size_t WS_WIN = 0;
constexpr size_t WS_WO = WS_WIN + al256((size_t)NIN * D * 2);
constexpr size_t WS_WUP = WS_WO + al256((size_t)D * D * 2);
constexpr size_t WS_WDN = WS_WUP + al256((size_t)FF2 * D * 2);
constexpr size_t WS_WLO = WS_WDN + al256((size_t)D * FF * 2);
constexpr size_t WS_H = WS_WLO + al256((size_t)NLO * KLO * 2);
constexpr size_t WS_QB = WS_H + al256((size_t)MPAD * D * 2);
constexpr size_t WS_KB = WS_QB + al256((size_t)MPAD * 1024 * 2);
constexpr size_t WS_VB = WS_KB + al256((size_t)MPAD * 1024 * 2);
constexpr size_t WS_ALO = WS_VB + al256((size_t)MPAD * 1024 * 2);
constexpr size_t WS_O = WS_ALO + al256((size_t)MPAD * KLO * 2);
constexpr size_t WS_GB = WS_O + al256((size_t)MPAD * D * 2);
constexpr size_t WS_YL = WS_GB + al256((size_t)MT * 2048 * 2);
constexpr size_t WS_QS = WS_YL + al256((size_t)MP * 1024 * 2);
constexpr size_t WS_ZP = WS_QS + al256((size_t)MP * 1024 * 2);
constexpr size_t WS_SST = WS_ZP + al256((size_t)64 * NS * 2 * 4096 * 4);
constexpr size_t WS_X1 = WS_SST + al256((size_t)64 * NS * 4096 * 4);
constexpr size_t WS_PML = WS_X1 + al256((size_t)MPAD * D * 4);
constexpr size_t WS_RA = WS_PML + al256((size_t)3 * MP * 16 * 2 * 4);
constexpr size_t WS_RW = WS_RA;
constexpr size_t WS_L = WS_RW + al256((size_t)MPAD * CSH * 2);
constexpr size_t RA_BYTES_1 = al256((size_t)MPAD * CSH * 2) + al256((size_t)MPAD * NLO * 2);
constexpr size_t RA_BYTES_2 = al256((size_t)MPAD * FF2 * 2);
constexpr size_t WS_U = WS_RA;
constexpr size_t WS_RB = WS_RA + (RA_BYTES_1 > RA_BYTES_2 ? RA_BYTES_1 : RA_BYTES_2);
constexpr size_t WS_PART = WS_RB;
constexpr size_t WS_ACT = WS_RB;
constexpr size_t RB_BYTES_1 = al256((size_t)3 * MP * 1024 * 2);
constexpr size_t RB_BYTES_2 = al256((size_t)MPAD * FF * 2);
constexpr size_t WS_RSS = WS_RB + (RB_BYTES_1 > RB_BYTES_2 ? RB_BYTES_1 : RB_BYTES_2);
constexpr size_t WS_BAR_ = 0; constexpr size_t WS_BAR = al256((size_t)MPAD * 4) + WS_RB + (RB_BYTES_1 > RB_BYTES_2 ? RB_BYTES_1 : RB_BYTES_2);
constexpr size_t BAR_BYTES = 16384;
constexpr size_t WS_END = WS_BAR + BAR_BYTES;

struct Args {
    const float* in[28];
    float* out;
    unsigned char* ws;
    int ph_lo, ph_hi;
};
enum { I_XP = 0, I_XS, I_CK, I_CV, I_SSH, I_SWKV, I_SFFN, I_NMG, I_WIN, I_AOG, I_MU, I_W0, I_WUP, I_A0, I_AUP, I_GUP,
       I_KK, I_KA, I_RK, I_LNW, I_LNB, I_WO, I_NFG, I_FUP, I_FCW, I_FCB, I_FDN, I_NFIN };

typedef float f32x2c __attribute__((ext_vector_type(2)));
typedef __bf16 bf16x2c __attribute__((ext_vector_type(2)));
DI unsigned pk2(float lo, float hi) { const f32x2c v = {lo, hi}; return __builtin_bit_cast(unsigned, __builtin_convertvector(v, bf16x2c)); }
DI unsigned bf_rne(float f) { return pk2(f, 0.f) & 0xffffu; }
DI unsigned cvt_pk(float lo, float hi) { return pk2(lo, hi); }
DI void atomic_add_f32(float* p, float v) { (void)__builtin_amdgcn_global_atomic_fadd_f32((__attribute__((address_space(1))) float*)p, v); }
DI float bf2f(unsigned short b) { return __uint_as_float(((unsigned)b) << 16); }
#define DPP_ADD(v, ctrl) ((v) + __int_as_float(__builtin_amdgcn_update_dpp(0, __float_as_int(v), (ctrl), 0xf, 0xf, false)))
DI float wave_sum(float v) {
    v = DPP_ADD(v, 0xB1);
    v = DPP_ADD(v, 0x4E);
    v = DPP_ADD(v, 0x141);
    v = DPP_ADD(v, 0x140);
    const float s0 = __int_as_float(__builtin_amdgcn_readlane(__float_as_int(v), 0)), s1 = __int_as_float(__builtin_amdgcn_readlane(__float_as_int(v), 16));
    const float s2 = __int_as_float(__builtin_amdgcn_readlane(__float_as_int(v), 32)), s3 = __int_as_float(__builtin_amdgcn_readlane(__float_as_int(v), 48));
    return (s0 + s1) + (s2 + s3);
}

namespace pg8 {
constexpr int BM = 256, BK = 64, HALF = 128, HTB = HALF * BK * 2, STAGE_BYTES = 8 * HTB, NXCD = 8, WGM = 8;
DI int lds_byte(int r, int c) { const int st = (r >> 4) * 2 + (c >> 5), rr = r & 15, cc = c & 31, ob = rr * 64 + cc * 2; return st * 1024 + (ob ^ (((ob >> 9) & 1) << 5)); }
DI void stage_rc(int b, int& R, int& C) { const int st = b / 1024, sb = b % 1024, swz = sb ^ (((sb >> 9) & 1) << 5); R = (st >> 1) * 16 + swz / 64; C = (st & 1) * 32 + (swz % 64) / 2; }
struct Unit { int pm, pn; };
struct Gemm { const bf16_t* A; const bf16_t* Bt; int M, N, K; };
struct StaticOrder {
    int nM, nN, nwg, G, c;
    DI void init(int M, int N, int G_, int c_) { nM = M / BM; nN = N / BM; nwg = nM * nN; G = G_; c = c_; }
    DI bool next(int i, Unit& u) const {
        const long L = (long)i * G + c; if (L >= nwg) return false;
        int wgid = (int)L; { const int q = nwg / NXCD, r = nwg % NXCD, xcd = wgid % NXCD, off = wgid / NXCD; wgid = (xcd < r ? xcd * (q + 1) : r * (q + 1) + (xcd - r) * q) + off; }
        const int nig = WGM * nN, gid = wgid / nig, fm = gid * WGM, gsz = (nM - fm) < WGM ? (nM - fm) : WGM;
        u.pm = fm + ((wgid % nig) % gsz); u.pn = (wgid % nig) / gsz; return true;
    }
};

template <class Epi>
DI void gemm_phase(LAS unsigned char* lds, const Gemm g, const StaticOrder& S, const Epi& E) {
    const int tid = threadIdx.x, wid = __builtin_amdgcn_readfirstlane(tid >> 6), lane = tid & 63, wr = wid >> 2, wc = wid & 3, fr = lane & 15, fq = lane >> 4;
    const int K = g.K, nt = K / BK;
    unsigned voffA[2];
#pragma unroll
    for (int i = 0; i < 2; ++i) { int R, C; stage_rc(tid * 16 + i * 8192, R, C); voffA[i] = (unsigned)(R * K + C) * 2u; }
    const size_t kstep = (size_t)(BK * 2);
    const size_t hstep = (size_t)HALF * K * 2;
    const size_t tstep = 2 * hstep;
    const unsigned ldsw = (unsigned)wid * 1024u;
    const int aoff = lds_byte(wr * 64 + fr, fq * 8), boff = lds_byte(wc * 32 + fr, fq * 8);
#define PG8_SA(b, h) (((b) * 2 + (h)) * HTB)
#define PG8_SB(b, h) ((4 + (b) * 2 + (h)) * HTB)
#define PG8_STAGE(bufoff, gbase, voff) do { _Pragma("unroll") for (int _i = 0; _i < 2; ++_i) \
        __builtin_amdgcn_global_load_lds((const unsigned*)((const char*)(gbase) + (voff)[_i]), (LAS unsigned*)(lds + (bufoff) + ldsw + _i * 8192), 16, 0, 0); } while (0)
#define PG8_LDA(dst, b, h) do { _Pragma("unroll") for (int m = 0; m < 4; ++m) _Pragma("unroll") for (int k = 0; k < 2; ++k) dst[m][k] = *(const LAS bf16x8*)(lds + PG8_SA(b, h) + aoff + m * 2048 + k * 1024); } while (0)
#define PG8_LDB(dst, b, h) do { _Pragma("unroll") for (int n = 0; n < 2; ++n) _Pragma("unroll") for (int k = 0; k < 2; ++k) dst[n][k] = *(const LAS bf16x8*)(lds + PG8_SB(b, h) + boff + n * 2048 + k * 1024); } while (0)
#define PG8_MMA(ai, bj, At, Bt) do { __builtin_amdgcn_s_setprio(1); _Pragma("unroll") for (int m = 0; m < 4; ++m) _Pragma("unroll") for (int n = 0; n < 2; ++n) _Pragma("unroll") for (int k = 0; k < 2; ++k) \
        acc[ai][bj][m][n] = __builtin_amdgcn_mfma_f32_16x16x32_bf16(Bt[n][k], At[m][k], acc[ai][bj][m][n], 0, 0, 0); __builtin_amdgcn_s_setprio(0); } while (0)
#define PG8_WAIT_V(n) asm volatile("s_waitcnt vmcnt(" #n ")" ::: "memory")
#define PG8_WAIT_L(n) asm volatile("s_waitcnt lgkmcnt(" #n ")" ::: "memory")
#define PG8_BAR __builtin_amdgcn_s_barrier()
#define PG8_SCHED __builtin_amdgcn_sched_barrier(0)
    Unit cur, nxt; int ui = 0;
    if (!S.next(0, cur)) return;
    f32x4 acc[2][2][4][2];
#pragma unroll
    for (int a = 0; a < 2; ++a)
#pragma unroll
        for (int b = 0; b < 2; ++b)
#pragma unroll
            for (int m = 0; m < 4; ++m)
#pragma unroll
                for (int n = 0; n < 2; ++n) acc[a][b][m][n] = (f32x4){0.f, 0.f, 0.f, 0.f};
    bf16x8 At[4][2], B0[2][2], B1[2][2];
    const char* cA = (const char*)g.A + (size_t)cur.pm * tstep; const char* cB = (const char*)g.Bt + (size_t)cur.pn * tstep;
    PG8_STAGE(PG8_SB(0, 0), cB, voffA); PG8_STAGE(PG8_SA(0, 0), cA, voffA); PG8_STAGE(PG8_SB(0, 1), cB + hstep, voffA); PG8_STAGE(PG8_SA(0, 1), cA + hstep, voffA);
    if (wr == 1) PG8_BAR;
    PG8_WAIT_V(4); PG8_BAR;
    PG8_STAGE(PG8_SB(1, 0), cB + kstep, voffA); PG8_STAGE(PG8_SA(1, 0), cA + kstep, voffA); PG8_STAGE(PG8_SB(1, 1), cB + hstep + kstep, voffA);
    PG8_WAIT_V(6); PG8_BAR;
    for (;;) {
        const bool has_next = S.next(ui + 1, nxt);
        const char* nA = has_next ? (const char*)g.A + (size_t)nxt.pm * tstep : cA; const char* nB = has_next ? (const char*)g.Bt + (size_t)nxt.pn * tstep : cB;
        for (int t = 0; t < nt; t += 2) {
            const bool last = (t == nt - 2);
            const char* a1 = cA + (size_t)(t + 1) * kstep;
            const char* a2 = last ? nA : cA + (size_t)(t + 2) * kstep; const char* b2 = last ? nB : cB + (size_t)(t + 2) * kstep;
            const char* a3 = a2 + kstep; const char* b3 = b2 + kstep;
            PG8_LDB(B0, 0, 0); PG8_SCHED; PG8_LDA(At, 0, 0); PG8_STAGE(PG8_SA(1, 1), a1 + hstep, voffA);
            PG8_WAIT_L(8); PG8_BAR; PG8_WAIT_L(0); PG8_MMA(0, 0, At, B0); PG8_BAR; PG8_SCHED;
            PG8_LDB(B1, 0, 1); PG8_STAGE(PG8_SB(0, 0), b2, voffA);
            PG8_BAR; PG8_WAIT_L(0); PG8_MMA(0, 1, At, B1); PG8_BAR;
            PG8_LDA(At, 0, 1); PG8_STAGE(PG8_SA(0, 0), a2, voffA);
            PG8_BAR; PG8_WAIT_L(0); PG8_MMA(1, 0, At, B0); PG8_BAR; PG8_SCHED;
            PG8_STAGE(PG8_SB(0, 1), b2 + hstep, voffA);
            PG8_WAIT_V(6); PG8_BAR; PG8_MMA(1, 1, At, B1); PG8_BAR;
            PG8_LDB(B0, 1, 0); PG8_SCHED; PG8_LDA(At, 1, 0); PG8_STAGE(PG8_SA(0, 1), a2 + hstep, voffA);
            PG8_WAIT_L(8); PG8_BAR; PG8_WAIT_L(0); PG8_MMA(0, 0, At, B0); PG8_BAR; PG8_SCHED;
            PG8_LDB(B1, 1, 1); PG8_STAGE(PG8_SB(1, 0), b3, voffA);
            PG8_BAR; PG8_WAIT_L(0); PG8_MMA(0, 1, At, B1); PG8_BAR;
            PG8_LDA(At, 1, 1); PG8_STAGE(PG8_SA(1, 0), a3, voffA);
            PG8_BAR; PG8_WAIT_L(0); PG8_MMA(1, 0, At, B0); PG8_BAR; PG8_SCHED;
            PG8_STAGE(PG8_SB(1, 1), b3 + hstep, voffA);
            PG8_WAIT_V(6); PG8_BAR; PG8_MMA(1, 1, At, B1); PG8_BAR;
        }
        E(acc, cur, wr, wc, fr, fq);
        if (!has_next) break;
#pragma unroll
        for (int a = 0; a < 2; ++a)
#pragma unroll
            for (int b = 0; b < 2; ++b)
#pragma unroll
                for (int m = 0; m < 4; ++m)
#pragma unroll
                    for (int n = 0; n < 2; ++n) acc[a][b][m][n] = (f32x4){0.f, 0.f, 0.f, 0.f};
        cur = nxt; cA = nA; cB = nB; ++ui;
    }
    PG8_WAIT_V(0);
    if (wr == 0) PG8_BAR;
    PG8_BAR;
#undef PG8_SA
#undef PG8_SB
#undef PG8_STAGE
#undef PG8_LDA
#undef PG8_LDB
#undef PG8_MMA
#undef PG8_WAIT_V
#undef PG8_WAIT_L
#undef PG8_BAR
#undef PG8_SCHED
}
}

DI size_t hm64(int row, int h)  { return ((size_t)((row >> 11) * 16 + h) * SEQ + (row & (SEQ - 1))) * 64; }
typedef f32x4 AccT[2][2][4][2];
#define EPI_LOOP_BEGIN \
    const int row0 = u.pm * 256 + wr * 64 + fr, col0 = u.pn * 256 + wc * 32 + 4 * fq; \
    _Pragma("unroll") for (int ai = 0; ai < 2; ++ai) _Pragma("unroll") for (int m = 0; m < 4; ++m) { const int row = row0 + ai * 128 + m * 16; \
    _Pragma("unroll") for (int bj = 0; bj < 2; ++bj) _Pragma("unroll") for (int n = 0; n < 2; ++n) { const int col = col0 + bj * 128 + n * 16; const f32x4 v = acc[ai][bj][m][n];
#define EPI_LOOP_END } }
#define EPI_LOOP_BEGIN_S \
    const int row0 = u.pm * 256 + wr * 64 + fr, col0 = u.pn * 256 + wc * 32 + 4 * fq; \
    _Pragma("unroll") for (int ai = 0; ai < 2; ++ai) _Pragma("unroll") for (int m = 0; m < 4; ++m) { const int row = row0 + ai * 128 + m * 16; \
    _Pragma("unroll") for (int bj = 0; bj < 2; ++bj) _Pragma("unroll") for (int n = 0; n < 2; ++n) { const int col = col0 + bj * 128 + n * 16; const f32x4 v = acc[ai][bj][m][n] * rs[ai][m];

struct EpiIn {
    bf16_t *Qb, *Kb, *Vb; bf16_t* RW; float* out;
    DI void operator()(const AccT& acc, const pg8::Unit& u, int wr, int wc, int fr, int fq) const {
        const int reg = u.pn < 4 ? 0 : (u.pn < 8 ? 1 : (u.pn < 12 ? 2 : 3));
        EPI_LOOP_BEGIN
            if (row < MT) {
                if (reg == 0) {
                    constexpr float QS_ = 0.125f * 1.44269504088896f;
                    u32x2 w; w.x = cvt_pk(v[0] * QS_, v[1] * QS_); w.y = cvt_pk(v[2] * QS_, v[3] * QS_);
                    *(u32x2*)(row < MP ? Qb + hm64(row, col >> 6) + (col & 63) : Qb + (size_t)row * 1024 + col) = w;
                } else if (reg == 1 || reg == 2) {
                    const int c = col - (reg == 1 ? 1024 : 2048);
                    float* o = row < MP ? out + (reg == 1 ? O_PK : O_PV) + (size_t)row * 1024 + c : out + (reg == 1 ? O_SK : O_SV) + (size_t)(row - MP) * 1024 + c;
                    __builtin_nontemporal_store(v, (f32x4*)o);
                    if (row < MP) { u32x2 w; w.x = cvt_pk(v[0], v[1]); w.y = cvt_pk(v[2], v[3]);
                        *(u32x2*)((reg == 1 ? Kb : Vb) + hm64(row, c >> 6) + (c & 63)) = w; }
                } else {
                    const int c = col - 3072;
                    if (c < CSH) {
                        { u32x2 w; w.x = cvt_pk(v[0], v[1]); w.y = cvt_pk(v[2], v[3]); *(u32x2*)(RW + (size_t)row * CSH + c) = w; }
                        if (row >= MP) *(f32x4*)(out + O_SRW + (size_t)(row - MP) * CSH + c) = v;
                        else if ((row & (SEQ - 1)) == SEQ - 1) *(f32x4*)(out + O_PRW + (size_t)(row >> 11) * CSH + c) = v;
                    }
                }
            }
        EPI_LOOP_END
    }
};
struct EpiBf {
    bf16_t* C; int ldc;
    DI void operator()(const AccT& acc, const pg8::Unit& u, int wr, int wc, int fr, int fq) const {
        const int row0 = u.pm * 256 + wr * 64 + fr, col0 = u.pn * 256 + wc * 32 + 4 * fq;
#pragma unroll
        for (int ai = 0; ai < 2; ++ai)
#pragma unroll
            for (int m = 0; m < 4; ++m) { const int row = row0 + ai * 128 + m * 16;
#pragma unroll
                for (int bj = 0; bj < 2; ++bj)
#pragma unroll
                    for (int n = 0; n < 2; ++n) { const int col = col0 + bj * 128 + n * 16; const f32x4 v = acc[ai][bj][m][n];
                        u32x2 w; w.x = cvt_pk(v[0], v[1]); w.y = cvt_pk(v[2], v[3]);
                        *(u32x2*)(C + (size_t)row * ldc + col) = w; }
                asm volatile("" ::: "memory");
            }
    }
};
struct EpiWo {
    const float *xp; const float* gf; float* X1; bf16_t* H; float* RSS;
    DI void operator()(const AccT& acc, const pg8::Unit& u, int wr, int wc, int fr, int fq) const {
        const int row0 = u.pm * 256 + wr * 64 + fr, col0 = u.pn * 256 + wc * 32 + 4 * fq;
        f32x4 gg[2][2];
#pragma unroll
        for (int bj = 0; bj < 2; ++bj)
#pragma unroll
            for (int n = 0; n < 2; ++n) gg[bj][n] = *(const f32x4*)(gf + col0 + bj * 128 + n * 16);
        float ssr[2][4];
#pragma unroll
        for (int aim = 0; aim < 4; ++aim) {
            const int ai = aim >> 1;
            f32x4 xr[4][2][2];
#pragma unroll
            for (int m = 2 * (aim & 1); m < 2 * (aim & 1) + 2; ++m)
#pragma unroll
                for (int bj = 0; bj < 2; ++bj)
#pragma unroll
                    for (int n = 0; n < 2; ++n) xr[m][bj][n] = __builtin_nontemporal_load((const f32x4*)(xp + (size_t)(row0 + ai * 128 + m * 16) * D + col0 + bj * 128 + n * 16));
            asm volatile("" ::: "memory");
#pragma unroll
            for (int m = 2 * (aim & 1); m < 2 * (aim & 1) + 2; ++m) {
                const int row = row0 + ai * 128 + m * 16; float ss = 0.f;
#pragma unroll
                for (int bj = 0; bj < 2; ++bj)
#pragma unroll
                    for (int n = 0; n < 2; ++n) {
                        const int col = col0 + bj * 128 + n * 16;
                        const f32x4 x1 = xr[m][bj][n] + acc[ai][bj][m][n];
                        *(f32x4*)(X1 + (size_t)row * D + col) = x1;
                        u32x2 w; w.x = cvt_pk(x1[0] * gg[bj][n][0], x1[1] * gg[bj][n][1]); w.y = cvt_pk(x1[2] * gg[bj][n][2], x1[3] * gg[bj][n][3]);
                        *(u32x2*)(H + (size_t)row * D + col) = w;
                        ss += (x1[0] * x1[0] + x1[1] * x1[1]) + (x1[2] * x1[2] + x1[3] * x1[3]);
                    }
                ssr[ai][m] = ss;
            }
            asm volatile("" ::: "memory");
        }
#pragma unroll
        for (int ai = 0; ai < 2; ++ai)
#pragma unroll
            for (int m = 0; m < 4; ++m) { float ss = ssr[ai][m]; ss += __shfl_xor(ss, 16); ss += __shfl_xor(ss, 32); ssr[ai][m] = ss; }
        if (fq == 0) {
#pragma unroll
            for (int ai = 0; ai < 2; ++ai)
#pragma unroll
                for (int m = 0; m < 4; ++m) atomic_add_f32(RSS + row0 + ai * 128 + m * 16, ssr[ai][m]);
        }
    }
};
#define DPP_MOV(v, ctrl) __int_as_float(__builtin_amdgcn_update_dpp(0, __float_as_int(v), (ctrl), 0xf, 0xf, false))
#define DPP_SHR(oldv, v, ctrl) __int_as_float(__builtin_amdgcn_update_dpp(__float_as_int(oldv), __float_as_int(v), (ctrl), 0xf, 0xf, false))
struct EpiUpF {
    bf16_t* ACT; float* out; const float* RSS; const float* cw; const float* cb; float* EDGE; LAS float* xch;
    DI void operator()(const AccT& acc, const pg8::Unit& u, int wr, int wc, int fr, int fq) const {
        const int wave = wr * 4 + wc, row0 = u.pm * 256 + wr * 64 + fr, f0 = u.pn * 128 + wc * 32 + 4 * fq;
#define UPF_RS(ai_, m_) rsqrtf(RSS[row0 + (ai_) * 128 + (m_) * 16] * (1.f / D) + 1e-6f)
        LAS float* taps = xch + 2048; LAS float* rstd = xch + 3072;
        {
            const int tid = wave * 64 + fq * 16 + fr;
#pragma unroll
            for (int q = 0; q < 2; ++q) { const int idx = tid + 512 * q, which = idx >> 7, col = (which >= 4 ? FF : 0) + u.pn * 128 + (idx & 127);
                taps[idx] = (which & 3) < 3 ? cw[(which & 3) * FF2 + col] : cb[col]; }
            if (tid < 256) rstd[tid] = rsqrtf(RSS[u.pm * 256 + tid] * (1.f / D) + 1e-6f);
        }
        if (fr >= 14) {
#pragma unroll
            for (int ai = 0; ai < 2; ++ai)
#pragma unroll
                for (int bj = 0; bj < 2; ++bj)
#pragma unroll
                    for (int n = 0; n < 2; ++n)
                        *(LAS f32x4*)(xch + wave * 256 + ((((ai * 2 + (fr - 14)) * 2 + bj) * 2 + n) * 4 + fq) * 4) = acc[ai][bj][3][n] * UPF_RS(ai, 3);
        }
        asm volatile("s_waitcnt lgkmcnt(0)" ::: "memory"); __builtin_amdgcn_s_barrier(); asm volatile("" ::: "memory");
        __builtin_amdgcn_s_barrier(); asm volatile("" ::: "memory");
        const bool prompt = u.pm < MP / 256;
#pragma unroll
        for (int n = 0; n < 2; ++n) {
            const int f = f0 + 16 * n;
            asm volatile("" ::: "memory");
            const int fl = wc * 32 + 16 * n + 4 * fq;
#pragma unroll
            for (int ai = 0; ai < 2; ++ai) {
                const bool have = (wr == 1) || (ai == 1);
                const int nbw = wr == 1 ? wave - 4 : wave + 4, nai = wr == 1 ? ai : 0;
                f32x4 pg = {0.f, 0.f, 0.f, 0.f}, pv = {0.f, 0.f, 0.f, 0.f};
                if (have && fr >= 14) {
                    pg = *(const LAS f32x4*)(xch + nbw * 256 + ((((nai * 2 + (fr - 14)) * 2 + 0) * 2 + n) * 4 + fq) * 4);
                    pv = *(const LAS f32x4*)(xch + nbw * 256 + ((((nai * 2 + (fr - 14)) * 2 + 1) * 2 + n) * 4 + fq) * 4);
                }
#pragma unroll
                for (int m = 0; m < 4; ++m) {
                    const int row = row0 + ai * 128 + m * 16;
                    const float rsm = rstd[wr * 64 + ai * 128 + m * 16 + fr];
                    const f32x4 g = acc[ai][0][m][n] * rsm, v = acc[ai][1][m][n] * rsm;
                    float o[4];
                    asm volatile("" ::: "memory");
#pragma unroll
                    for (int e = 0; e < 4; ++e) {
                        const float g1 = DPP_SHR(DPP_MOV(pg[e], 0x121), g[e], 0x111), g2 = DPP_SHR(DPP_MOV(pg[e], 0x122), g[e], 0x112);
                        const float cg = taps[384 + fl + e] + taps[fl + e] * g2 + taps[128 + fl + e] * g1 + taps[256 + fl + e] * g[e];
                        o[e] = cg * __builtin_amdgcn_rcpf(1.f + __expf(-cg));
                    }
                    {
#pragma unroll
                        for (int e = 0; e < 4; ++e) {
                            const float v1 = DPP_SHR(DPP_MOV(pv[e], 0x121), v[e], 0x111), v2 = DPP_SHR(DPP_MOV(pv[e], 0x122), v[e], 0x112);
                            o[e] *= taps[896 + fl + e] + taps[512 + fl + e] * v2 + taps[640 + fl + e] * v1 + taps[768 + fl + e] * v[e];
                        }
                        asm volatile("" ::: "memory");
                    }
                    const int tr = wr * 64 + ai * 128 + m * 16 + fr;
                    if (prompt) {
                        u32x2 w; w.x = cvt_pk(o[0], o[1]); w.y = cvt_pk(o[2], o[3]);
                        *(u32x2*)((char*)ACT + ((unsigned)row * (unsigned)FF + (unsigned)f) * 2u) = w;
                    }
                    if (prompt ? (tr < 2 || tr >= 254) : tr < MS) {
                        const int er = prompt ? u.pm * 4 + (tr < 2 ? tr : tr - 252) : 128 + tr;
                        float* ed = (float*)((char*)EDGE + ((unsigned)er * (unsigned)FF2 + (unsigned)f) * 4u);
                        *(f32x4*)ed = g; *(f32x4*)(ed + FF) = v;
                    }
                    pg = g; pv = v;
                }
            }
        }
    }
#undef UPF_RS
};
#ifndef MK_P11_SCALE
#define MK_P11_SCALE 1.0f
#endif
struct EpiDn {
    float* X1;
    DI void operator()(const AccT& acc, const pg8::Unit& u, int wr, int wc, int fr, int fq) const {
        const int row0 = u.pm * 256 + wr * 64 + fr, col0 = u.pn * 256 + wc * 32 + 4 * fq;
#pragma unroll
        for (int ai = 0; ai < 2; ++ai) {
            f32x4 xr[4][2][2];
#pragma unroll
            for (int m = 0; m < 4; ++m)
#pragma unroll
                for (int bj = 0; bj < 2; ++bj)
#pragma unroll
                    for (int n = 0; n < 2; ++n) xr[m][bj][n] = *(const f32x4*)(X1 + (size_t)(row0 + ai * 128 + m * 16) * D + col0 + bj * 128 + n * 16);
            asm volatile("" ::: "memory");
#pragma unroll
            for (int m = 0; m < 4; ++m)
#pragma unroll
                for (int bj = 0; bj < 2; ++bj)
#pragma unroll
                    for (int n = 0; n < 2; ++n) *(f32x4*)(X1 + (size_t)(row0 + ai * 128 + m * 16) * D + col0 + bj * 128 + n * 16) = xr[m][bj][n] + acc[ai][bj][m][n] * MK_P11_SCALE;
            asm volatile("" ::: "memory");
        }
    }
};

template <bool UPPERM = false>
DI void transpose_item(const float* W, int K, int N, bf16_t* WT, int ldt, float* scr, int item, int lane) {
    const int nblk = N / 32, kb = item / nblk, nb = item % nblk, k0 = 64 * kb, n0 = 32 * nb;
    const int d0 = UPPERM ? (((n0 < FF ? n0 : n0 - FF) >> 7) * 256 + (n0 < FF ? 0 : 128) + ((n0 < FF ? n0 : n0 - FF) & 127)) : n0;
    {
        f32x4 v[8];
#pragma unroll
        for (int i = 0; i < 8; ++i) v[i] = __builtin_nontemporal_load((const f32x4*)(W + (size_t)(k0 + 8 * i + (lane >> 3)) * N + n0 + 4 * (lane & 7)));
#pragma unroll
        for (int i = 0; i < 8; ++i) { float* d = scr + (8 * i + (lane >> 3)) * 33 + 4 * (lane & 7); d[0] = v[i].x; d[1] = v[i].y; d[2] = v[i].z; d[3] = v[i].w; }
    }
    __builtin_amdgcn_fence(__ATOMIC_RELEASE, "wavefront"); asm volatile("s_waitcnt lgkmcnt(0)" ::: "memory");
    const int c = lane & 7;
#pragma unroll
    for (int j = 0; j < 4; ++j) { const int n = (lane >> 3) + 8 * j; const float* s = scr + (8 * c) * 33 + n;
        u32x4 o; o.x = pk2(s[0 * 33], s[1 * 33]); o.y = pk2(s[2 * 33], s[3 * 33]); o.z = pk2(s[4 * 33], s[5 * 33]); o.w = pk2(s[6 * 33], s[7 * 33]);
        *(u32x4*)(WT + (size_t)(d0 + n) * ldt + k0 + 8 * c) = o; }
    asm volatile("s_waitcnt lgkmcnt(0)" ::: "memory");
}
DI void rms_row_bf16(const float* xrow, const float* g, bf16_t* orow, int lane) {
    const f32x4* xr = (const f32x4*)xrow + lane; const f32x4* gr = (const f32x4*)g + lane;
    f32x4 v[8]; float s = 0.f;
#pragma unroll
    for (int j = 0; j < 8; ++j) { v[j] = __builtin_nontemporal_load(xr + 64 * j); s += (v[j].x * v[j].x + v[j].y * v[j].y) + (v[j].z * v[j].z + v[j].w * v[j].w); }
    const float rstd = rsqrtf(wave_sum(s) * (1.f / D) + 1e-6f);
    u32x2* o8 = (u32x2*)orow + lane;
    f32x4 ggs[8];
#pragma unroll
    for (int j = 0; j < 8; ++j) ggs[j] = gr[64 * j];
#pragma unroll
    for (int j = 0; j < 8; ++j) { const f32x4 gg = ggs[j]; u32x2 w; w.x = pk2(v[j].x * rstd * gg.x, v[j].y * rstd * gg.y); w.y = pk2(v[j].z * rstd * gg.z, v[j].w * rstd * gg.w); o8[64 * j] = w; }
}
DI void rms_row_f32(const float* xrow, const float* g, float* orow, int lane) {
    const f32x4* xr = (const f32x4*)xrow + lane; const f32x4* gr = (const f32x4*)g + lane;
    f32x4 v[8]; float s = 0.f;
#pragma unroll
    for (int j = 0; j < 8; ++j) { v[j] = __builtin_nontemporal_load(xr + 64 * j); s += (v[j].x * v[j].x + v[j].y * v[j].y) + (v[j].z * v[j].z + v[j].w * v[j].w); }
    const float rstd = rsqrtf(wave_sum(s) * (1.f / D) + 1e-6f);
    f32x4* o = (f32x4*)orow + lane;
    f32x4 ggs[8];
#pragma unroll
    for (int j = 0; j < 8; ++j) ggs[j] = gr[64 * j];
#pragma unroll
    for (int j = 0; j < 8; ++j) __builtin_nontemporal_store(v[j] * rstd * ggs[j], o + 64 * j);
}
DI void zero_row_bf16(bf16_t* orow, int ncols, int lane) {
    for (int c = lane * 8; c < ncols; c += 512) *(u32x4*)(orow + c) = (u32x4){0u, 0u, 0u, 0u};
}

DI void phase_prologue(const Args& a, unsigned char* lds, int gw, int ngw, int lane, int wave) {
    unsigned char* ws = a.ws;
    float* scr = (float*)(lds + wave * 16384);
    bf16_t* Win = (bf16_t*)(ws + WS_WIN); bf16_t* Wlo = (bf16_t*)(ws + WS_WLO);
    constexpr int IT_IN = (D / 64) * (CIN / 32);
    for (int it = gw; it < IT_IN; it += ngw) transpose_item(a.in[I_WIN], D, CIN, Win, D, scr, it, lane);
    for (int r = CIN + gw; r < NIN; r += ngw) zero_row_bf16(Win + (size_t)r * D, D, lane);
    {
        const int gt = gw * 64 + lane, ngt = ngw * 64;
        for (int i = gt; i < NLO * KLO; i += ngt) {
            const int n = i / KLO, k = i % KLO; float v = 0.f;
            if (n < 1024) { if (k < 64) v = a.in[I_WUP][k * 1024 + n]; }
            else if (n < 2048) { if (k >= 64 && k < 128) v = a.in[I_AUP][(k - 64) * 1024 + (n - 1024)]; }
            else { if (k >= 128 && k < 288) v = a.in[I_GUP][(k - 128) * 1024 + (n - 2048)]; }
            Wlo[i] = (bf16_t)bf_rne(v);
        }
    }
    { float* RSS = (float*)(ws + WS_RSS); for (int i = gw * 64 + lane; i < MPAD; i += ngw * 64) RSS[i] = 0.f; }
    bf16_t* H = (bf16_t*)(ws + WS_H);
    for (int m = gw; m < MPAD; m += ngw) {
        if (m < MT) rms_row_bf16(m < MP ? a.in[I_XP] + (size_t)m * D : a.in[I_XS] + (size_t)(m - MP) * D, a.in[I_NMG], H + (size_t)m * D, lane);
        else zero_row_bf16(H + (size_t)m * D, D, lane);
    }
}


DI void convert_wo_wup(const Args& a, unsigned char* lds, int wi, int nw, int wave, int lane) {
    float* scr = (float*)(lds + wave * 16384);
    constexpr int IT_O = (D / 64) * (D / 32), IT_UP = (D / 64) * (FF2 / 32);
    for (int it = wi; it < IT_O + IT_UP; it += nw) {
        if (it < IT_O) transpose_item(a.in[I_WO], D, D, (bf16_t*)(a.ws + WS_WO), D, scr, it, lane);
        else transpose_item<true>(a.in[I_FUP], D, FF2, (bf16_t*)(a.ws + WS_WUP), D, scr, it - IT_O, lane);
    }
}
DI void convert_wdn(const Args& a, unsigned char* lds, int wi, int nw, int wave, int lane) {
    float* scr = (float*)(lds + wave * 16384);
    constexpr int IT_DN = (FF / 64) * (D / 32);
    for (int it = wi; it < IT_DN; it += nw) transpose_item(a.in[I_FDN], FF, D, (bf16_t*)(a.ws + WS_WDN), FF, scr, it, lane);
}

DI float rw_prev_val(const Args& a, const bf16_t* RW, int m, int j) {
    if (m < MP) return (m & (SEQ - 1)) == 0 ? 0.f : bf2f(RW[(size_t)(m - 1) * CSH + j]);
    return a.in[I_SSH][(size_t)(m - MP) * CSH + j];
}
DI void lora_input_row(const Args& a, int m, int lane) {
    bf16_t* ALO = (bf16_t*)(a.ws + WS_ALO) + (size_t)m * KLO;
    if (m >= MT) { for (int c = lane; c < KLO; c += 64) ALO[c] = 0; return; }
    const bf16_t* RW = (const bf16_t*)(a.ws + WS_RW);
    const bf16_t* cur = RW + (size_t)m * CSH;
    float x[5], p[5], mu[5];
#pragma unroll
    for (int i = 0; i < 5; ++i) {
        const int c = lane + 64 * i; const bool ok = c < 288; const int j = 3072 + (ok ? c : 0);
        x[i] = bf2f(cur[j]); mu[i] = a.in[I_MU][j];
        p[i] = m < MP ? ((m & (SEQ - 1)) == 0 ? 0.f : bf2f(RW[(size_t)(m - 1) * CSH + j])) : a.in[I_SSH][(size_t)(m - MP) * CSH + j];
    }
#pragma unroll
    for (int i = 0; i < 6; ++i) {
        const int c = lane + 64 * i; float v = 0.f;
        if (i < 5 && c < 288) {
            const float xs = x[i < 5 ? i : 0] + mu[i < 5 ? i : 0] * (p[i < 5 ? i : 0] - x[i < 5 ? i : 0]);
            v = c < 64 ? 1.f - 2.f * __builtin_amdgcn_rcpf(1.f + __expf(2.f * xs)) : (c < 128 ? xs : __builtin_amdgcn_rcpf(1.f + __expf(-xs)));
        }
        ALO[c] = (bf16_t)bf_rne(v);
    }
}

DI int crow(int reg, int h) { return (reg & 3) + 8 * (reg >> 2) + 4 * h; }
typedef short s16x4 __attribute__((ext_vector_type(4)));
constexpr int VPITCH = 192;
DI void attn_prompt_unit(const Args& a, unsigned char* lds, int unit, int wave, int lane) {
    const bf16_t* Qb = (const bf16_t*)(a.ws + WS_QB); const bf16_t* Kb = (const bf16_t*)(a.ws + WS_KB); const bf16_t* Vb = (const bf16_t*)(a.ws + WS_VB);
    bf16_t* PO = (bf16_t*)(a.ws + WS_PART); float* PML = (float*)(a.ws + WS_PML);
    LAS unsigned char* img = (LAS unsigned char*)lds + wave * (32 * VPITCH);
    const int blk = unit & 63, br = (unit >> 6) % 3, bh = unit / 192, b = bh >> 4, h = bh & 15;
    const int rate = br == 0 ? 1 : (br == 1 ? 4 : 16), L = SEQ / rate, bpc = L / 32;
    const int rho = blk / bpc, l0 = (blk % bpc) * 32;
    const int r = lane & 31, hh = lane >> 5;
    const int mq = b * SEQ + rho + rate * (l0 + r);
    bf16x8 qf[4];
#pragma unroll
    for (int ks = 0; ks < 4; ++ks) qf[ks] = *(const bf16x8*)(Qb + ((size_t)bh * SEQ + rho + rate * (l0 + r)) * 64 + ks * 16 + 8 * hh);
    f32x16 o0, o1;
#pragma unroll
    for (int i = 0; i < 16; ++i) { o0[i] = 0.f; o1[i] = 0.f; }
    float mrun = -1e30f, lrun = 0.f;
    const int lq = l0 + r;
    const int c0 = l0 >= 128 ? 0 : (128 - l0) >> 5;
    const bf16_t* kbase = Kb + ((size_t)bh * SEQ + rho) * 64 + 8 * hh;
    const bf16_t* vbase = Vb + ((size_t)bh * SEQ + rho) * 64 + 8 * (lane & 7);
    bf16x8 kreg[4]; u32x4 vreg[4];
#define AT_PREFETCH(ch_) do { const int lk0_ = l0 - 128 + 32 * (ch_); \
        _Pragma("unroll") for (int ks = 0; ks < 4; ++ks) kreg[ks] = *(const bf16x8*)(kbase + (size_t)(rate * (lk0_ + r)) * 64 + ks * 16); \
        _Pragma("unroll") for (int i = 0; i < 4; ++i) vreg[i] = *(const u32x4*)(vbase + (size_t)(rate * (lk0_ + 8 * i + (lane >> 3))) * 64); } while (0)
    AT_PREFETCH(c0);
    const int i16 = lane & 15, tq = i16 >> 2, tp = i16 & 3, g16 = (lane >> 4) & 1;
    const unsigned troff = (unsigned)((4 * hh + tq) * VPITCH + g16 * 32 + 8 * tp);
    for (int ch = c0; ch < 5; ++ch) {
        const int lk0 = l0 - 128 + 32 * ch;
        bf16x8 kf[4];
#pragma unroll
        for (int ks = 0; ks < 4; ++ks) kf[ks] = kreg[ks];
#pragma unroll
        for (int i = 0; i < 4; ++i) *(LAS u32x4*)(img + (8 * i + (lane >> 3)) * VPITCH + 16 * (lane & 7)) = vreg[i];
        if (ch + 1 < 5) AT_PREFETCH(ch + 1);
        f32x16 st;
#pragma unroll
        for (int i = 0; i < 16; ++i) st[i] = 0.f;
#pragma unroll
        for (int ks = 0; ks < 4; ++ks) st = __builtin_amdgcn_mfma_f32_32x32x16_bf16(kf[ks], qf[ks], st, 0, 0, 0);
        float cmax = -1e30f;
        if (ch == 0 || ch == 4) {
#pragma unroll
            for (int i = 0; i < 16; ++i) { const int lk = lk0 + crow(i, hh); const bool ok = (lk <= lq) && (lk >= lq - 128); st[i] = ok ? st[i] : -1e30f; }
        }
#pragma unroll
        for (int i = 0; i < 16; ++i) cmax = fmaxf(cmax, st[i]);
        cmax = fmaxf(cmax, __shfl_xor(cmax, 32));
        const float mnew = fmaxf(mrun, cmax), alpha = __builtin_amdgcn_exp2f(mrun - mnew);
        float ps = 0.f;
#pragma unroll
        for (int i = 0; i < 16; ++i) { const float p = __builtin_amdgcn_exp2f(st[i] - mnew); st[i] = p; ps += p; }
        lrun = lrun * alpha + ps; mrun = mnew;
#pragma unroll
        for (int i = 0; i < 16; ++i) { o0[i] *= alpha; o1[i] *= alpha; }
#pragma unroll
        for (int s = 0; s < 2; ++s) {
            u32x4 pp; pp.x = pk2(st[8 * s], st[8 * s + 1]); pp.y = pk2(st[8 * s + 2], st[8 * s + 3]); pp.z = pk2(st[8 * s + 4], st[8 * s + 5]); pp.w = pk2(st[8 * s + 6], st[8 * s + 7]);
            const bf16x8 pf = __builtin_bit_cast(bf16x8, pp);
#pragma unroll
            for (int dt = 0; dt < 2; ++dt) {
                const s16x4 lo = __builtin_amdgcn_ds_read_tr16_b64_v4i16((LAS s16x4*)(img + troff + (16 * s) * VPITCH + dt * 64));
                const s16x4 hi = __builtin_amdgcn_ds_read_tr16_b64_v4i16((LAS s16x4*)(img + troff + (16 * s + 8) * VPITCH + dt * 64));
                const bf16x8 vf = __builtin_shufflevector(lo, hi, 0, 1, 2, 3, 4, 5, 6, 7);
                if (dt == 0) o0 = __builtin_amdgcn_mfma_f32_32x32x16_bf16(vf, pf, o0, 0, 0, 0);
                else o1 = __builtin_amdgcn_mfma_f32_32x32x16_bf16(vf, pf, o1, 0, 0, 0);
            }
        }
    }
#undef AT_PREFETCH
    const float ltot = lrun + __shfl_xor(lrun, 32);
    bf16_t* po = PO + ((size_t)br * MP + mq) * 1024 + h * 64;
#pragma unroll
    for (int g = 0; g < 4; ++g) {
        u32x2 w0, w1; w0.x = pk2(o0[4 * g], o0[4 * g + 1]); w0.y = pk2(o0[4 * g + 2], o0[4 * g + 3]); w1.x = pk2(o1[4 * g], o1[4 * g + 1]); w1.y = pk2(o1[4 * g + 2], o1[4 * g + 3]);
        *(u32x2*)(po + 8 * g + 4 * hh) = w0; *(u32x2*)(po + 32 + 8 * g + 4 * hh) = w1;
    }
    if (hh == 0) { float* pm = PML + (((size_t)br * MP + mq) * 16 + h) * 2; pm[0] = mrun; pm[1] = ltot; }
}
DI float sum16(float v) { v = DPP_ADD(v, 0xB1); v = DPP_ADD(v, 0x4E); v = DPP_ADD(v, 0x141); v = DPP_ADD(v, 0x140); return v; }
DI void attn_merge_task(const Args& a, int task, int lane) {
    const int m = task >> 2, h = (task & 3) * 4 + (lane >> 4), d = 4 * (lane & 15);
    const bf16_t* PO = (const bf16_t*)(a.ws + WS_PART); const float* PML = (const float*)(a.ws + WS_PML);
    bf16_t* O = (bf16_t*)(a.ws + WS_O);
    float mb[3], lb[3]; f32x4 ob[3];
#pragma unroll
    for (int br = 0; br < 3; ++br) { const float* pm = PML + (((size_t)br * MP + m) * 16 + h) * 2; mb[br] = pm[0]; lb[br] = pm[1];
        const u32x2 w = *(const u32x2*)(PO + ((size_t)br * MP + m) * 1024 + h * 64 + d);
        ob[br] = (f32x4){__uint_as_float(w.x << 16), __uint_as_float(w.x & 0xffff0000u), __uint_as_float(w.y << 16), __uint_as_float(w.y & 0xffff0000u)}; }
    const float M = fmaxf(mb[0], fmaxf(mb[1], mb[2]));
    f32x4 num = {0.f, 0.f, 0.f, 0.f}; float den = 0.f;
#pragma unroll
    for (int br = 0; br < 3; ++br) { const float w = __builtin_amdgcn_exp2f(mb[br] - M); num += ob[br] * w; den += w * lb[br]; }
    const f32x4 o = num * __builtin_amdgcn_rcpf(den);
    const float ss = sum16(o.x * o.x + o.y * o.y + o.z * o.z + o.w * o.w) * (1.f / 64.f);
    const float rs = rsqrtf(ss + 1e-6f);
    const f32x4 gg = *(const f32x4*)(a.in[I_AOG] + h * 64 + d);
    u32x2 w; w.x = pk2(o.x * rs * gg.x, o.y * rs * gg.y); w.y = pk2(o.z * rs * gg.z, o.w * rs * gg.w);
    *(u32x2*)(O + (size_t)m * D + h * 64 + d) = w;
}
DI void attn_sample_wg(const Args& a, unsigned char* lds, int unit, int wave, int lane) {
    float* part = (float*)lds;
    const int bh = unit * 2 + (wave >> 2), qt = wave & 3, b = bh >> 4, h = bh & 15, g = lane >> 4, l16 = lane & 15;
    const bf16_t* Qb = (const bf16_t*)(a.ws + WS_QB);
    const float* ck = a.in[I_CK] + (size_t)b * 2048 * 1024 + h * 64 + 4 * l16; const float* cv = a.in[I_CV] + (size_t)b * 2048 * 1024 + h * 64 + 4 * l16;
    const float* nk = a.out + O_SK + (size_t)b * 1024 + h * 64 + 4 * l16; const float* nv = a.out + O_SV + (size_t)b * 1024 + h * 64 + 4 * l16;
    const u32x2 qw = *(const u32x2*)(Qb + (size_t)(MP + b) * 1024 + h * 64 + 4 * l16);
    const float q0 = __uint_as_float(qw.x << 16), q1 = __uint_as_float(qw.x & 0xffff0000u), q2 = __uint_as_float(qw.y << 16), q3 = __uint_as_float(qw.y & 0xffff0000u);
    float mrun = -1e30f, lrun = 0.f; f32x4 acc = {0.f, 0.f, 0.f, 0.f};
    const int e0 = qt * 97, e1 = e0 + 97 < 387 ? e0 + 97 : 387;
    for (int ito = 0; ito < 25; ito += 5) {
        f32x4 kv[5], vv[5]; bool valid[5];
#pragma unroll
        for (int k = 0; k < 5; ++k) {
            const int e = e0 + (ito + k) * 4 + g; valid[k] = e < e1;
            const int ee = valid[k] ? e : e0, br = ee / 129, j = ee % 129, rate = br == 0 ? 1 : (br == 1 ? 4 : 16);
            const int row = 2048 - rate * j;
            const float* kp = j == 0 ? nk : ck + (size_t)row * 1024; const float* vp = j == 0 ? nv : cv + (size_t)row * 1024;
            kv[k] = __builtin_nontemporal_load((const f32x4*)kp); vv[k] = __builtin_nontemporal_load((const f32x4*)vp);
        }
#pragma unroll
        for (int k = 0; k < 5; ++k) {
            float s = sum16(q0 * kv[k].x + q1 * kv[k].y + q2 * kv[k].z + q3 * kv[k].w);
            if (!valid[k]) s = -1e30f;
            const float mnew = fmaxf(mrun, s), alpha = __builtin_amdgcn_exp2f(mrun - mnew), p = valid[k] ? __builtin_amdgcn_exp2f(s - mnew) : 0.f;
            lrun = lrun * alpha + p; acc = acc * alpha + vv[k] * p; mrun = mnew;
        }
    }
#pragma unroll
    for (int o = 16; o < 64; o <<= 1) {
        const float mo = __shfl_xor(mrun, o), lo = __shfl_xor(lrun, o);
        f32x4 ao; ao.x = __shfl_xor(acc.x, o); ao.y = __shfl_xor(acc.y, o); ao.z = __shfl_xor(acc.z, o); ao.w = __shfl_xor(acc.w, o);
        const float mn = fmaxf(mrun, mo), w0 = __builtin_amdgcn_exp2f(mrun - mn), w1 = __builtin_amdgcn_exp2f(mo - mn);
        lrun = lrun * w0 + lo * w1; acc = acc * w0 + ao * w1; mrun = mn;
    }
    if (g == 0) { *(f32x4*)(part + wave * 68 + 4 * l16) = acc; if (l16 == 0) { part[wave * 68 + 64] = mrun; part[wave * 68 + 65] = lrun; } }
    __syncthreads();
    if (qt == 0 && g == 0) {
        float M = -1e30f;
#pragma unroll
        for (int w = 0; w < 4; ++w) M = fmaxf(M, part[(wave + w) * 68 + 64]);
        f32x4 num = {0.f, 0.f, 0.f, 0.f}; float den = 0.f;
#pragma unroll
        for (int w = 0; w < 4; ++w) { const float wt = __builtin_amdgcn_exp2f(part[(wave + w) * 68 + 64] - M); num += *(const f32x4*)(part + (wave + w) * 68 + 4 * l16) * wt; den += part[(wave + w) * 68 + 65] * wt; }
        const f32x4 o = num * (1.f / den);
        const float ss = sum16(o.x * o.x + o.y * o.y + o.z * o.z + o.w * o.w);
        const float rs = rsqrtf(ss * (1.f / 64.f) + 1e-6f);
        const f32x4 gg = *(const f32x4*)(a.in[I_AOG] + h * 64 + 4 * l16);
        u32x2 w; w.x = pk2(o.x * rs * gg.x, o.y * rs * gg.y); w.y = pk2(o.z * rs * gg.z, o.w * rs * gg.w);
        *(u32x2*)((bf16_t*)(a.ws + WS_O) + (size_t)(MP + b) * D + h * 64 + 4 * l16) = w;
    }
    __syncthreads();
}

struct PrepParams { float mu_r, mu_k, mu_v, w0, a0, kk, ka, rk; };
struct PrepRaw { float cr, ck, cv, pr, pk, pv, lw, la, lg; };
DI void prep_params(const Args& a, PrepParams& P, int c) {
    P.mu_r = a.in[I_MU][c]; P.mu_k = a.in[I_MU][1024 + c]; P.mu_v = a.in[I_MU][2048 + c];
    P.w0 = a.in[I_W0][c]; P.a0 = a.in[I_A0][c]; P.kk = a.in[I_KK][c]; P.ka = a.in[I_KA][c]; P.rk = a.in[I_RK][c];
}
DI void prep_load(const Args& a, PrepRaw& R, const bf16_t* RW, int m, const bf16_t* Lrow, int c) {
    const bf16_t* cur = RW + (size_t)m * CSH;
    R.cr = bf2f(cur[c]); R.ck = bf2f(cur[1024 + c]); R.cv = bf2f(cur[2048 + c]);
    R.pr = rw_prev_val(a, RW, m, c); R.pk = rw_prev_val(a, RW, m, 1024 + c); R.pv = rw_prev_val(a, RW, m, 2048 + c);
    R.lw = bf2f(Lrow[c]); R.la = bf2f(Lrow[1024 + c]); R.lg = bf2f(Lrow[2048 + c]);
}
DI void prep_finish(const PrepRaw& R, const PrepParams& P, float* dst, float& g_out, float& bonus_out, int lane) {
    const float xr = R.cr + P.mu_r * (R.pr - R.cr), xk = R.ck + P.mu_k * (R.pk - R.ck), xv = R.cv + P.mu_v * (R.pv - R.cv);
    const float x = -(P.w0 + R.lw);
    const float sp = x > 20.f ? x : __logf(1.f + __expf(x));
    const float decay = __expf(-__expf(-sp - 0.5f));
    const float av = __builtin_amdgcn_rcpf(1.f + __expf(-(P.a0 + R.la)));
    float kkv = xk * P.kk;
    const float n2 = wave_sum(kkv * kkv);
    kkv = kkv * fminf(__builtin_amdgcn_rsqf(n2), 1e12f);
    const float keff = xk * (1.f + (av - 1.f) * P.ka);
    const float bon = wave_sum(xr * keff * P.rk) * xv;
    dst[lane] = xr; dst[64 + lane] = decay; dst[128 + lane] = keff; dst[192 + lane] = xv; dst[256 + lane] = -kkv; dst[320 + lane] = kkv * av;
    g_out = R.lg; bonus_out = bon;
}
DI float scan_step(float (&S)[64], const float* sv, float vi) {
    const f32x4* r4 = (const f32x4*)sv; const f32x4* w4 = (const f32x4*)(sv + 64); const f32x4* k4 = (const f32x4*)(sv + 128);
    const f32x4* a4 = (const f32x4*)(sv + 256); const f32x4* b4 = (const f32x4*)(sv + 320);
    float sa0 = 0.f, sa1 = 0.f;
#pragma unroll
    for (int j = 0; j < 16; ++j) { const f32x4 av = a4[j]; sa0 = fmaf(S[4 * j], av.x, sa0); sa1 = fmaf(S[4 * j + 1], av.y, sa1); sa0 = fmaf(S[4 * j + 2], av.z, sa0); sa1 = fmaf(S[4 * j + 3], av.w, sa1); }
    const float sa = sa0 + sa1;
    float y0 = 0.f, y1 = 0.f;
#pragma unroll
    for (int j = 0; j < 16; ++j) {
        const f32x4 bv = b4[j], kv = k4[j], wv = w4[j], rv = r4[j];
        float t;
        t = fmaf(vi, kv.x, sa * bv.x); S[4 * j] = fmaf(S[4 * j], wv.x, t); y0 = fmaf(S[4 * j], rv.x, y0);
        t = fmaf(vi, kv.y, sa * bv.y); S[4 * j + 1] = fmaf(S[4 * j + 1], wv.y, t); y1 = fmaf(S[4 * j + 1], rv.y, y1);
        t = fmaf(vi, kv.z, sa * bv.z); S[4 * j + 2] = fmaf(S[4 * j + 2], wv.z, t); y0 = fmaf(S[4 * j + 2], rv.z, y0);
        t = fmaf(vi, kv.w, sa * bv.w); S[4 * j + 3] = fmaf(S[4 * j + 3], wv.w, t); y1 = fmaf(S[4 * j + 3], rv.w, y1);
        if ((j & 3) == 3) asm volatile("" ::: "memory");
    }
    return y0 + y1;
}
DI void rwkv_post(const Args& a, float y, float g, float bonus, int m, int c) {
    const float mean = wave_sum(y) * (1.f / 64.f); const float d = y - mean; const float var = wave_sum(d * d) * (1.f / 64.f);
    const float yn = d * rsqrtf(var + 64e-5f) * a.in[I_LNW][c] + a.in[I_LNB][c];
    ((bf16_t*)(a.ws + WS_O))[(size_t)m * D + 1024 + c] = (bf16_t)bf_rne((yn + bonus) * g);
}

#define WG_BAR_LDS() do { asm volatile("s_waitcnt lgkmcnt(0)" ::: "memory"); __builtin_amdgcn_s_barrier(); asm volatile("" ::: "memory"); } while (0)
typedef float f32x2 __attribute__((ext_vector_type(2)));
DI f32x2 fma2(f32x2 a, f32x2 b, f32x2 c) { return __builtin_elementwise_fma(a, b, c); }
DI void scan_dot_a(const f32x2 (&Z)[32], const f32x2 (&P)[32], const float* sv, float& sz, float& sp) {
    const f32x4* a4 = (const f32x4*)(sv + 256);
    f32x2 saz = {0.f, 0.f}, sap = {0.f, 0.f};
#pragma unroll
    for (int j = 0; j < 16; ++j) { const f32x4 av = a4[j]; const f32x2 a0 = {av.x, av.y}, a1 = {av.z, av.w};
        saz = fma2(Z[2 * j], a0, saz); sap = fma2(P[2 * j], a0, sap); saz = fma2(Z[2 * j + 1], a1, saz); sap = fma2(P[2 * j + 1], a1, sap);
        if ((j & 7) == 7) asm volatile("" ::: "memory"); }
    sz = saz.x + saz.y; sp = sap.x + sap.y;
}
DI void scan_step3(f32x2 (&Z)[32], f32x2 (&P)[32], const float* sv, const float* svn, float vi, float& sz, float& sp, float& yz, float& yp) {
    const f32x4* r4 = (const f32x4*)sv; const f32x4* w4 = (const f32x4*)(sv + 64); const f32x4* k4 = (const f32x4*)(sv + 128);
    const f32x4* b4 = (const f32x4*)(sv + 320); const f32x4* an4 = (const f32x4*)(svn + 256);
    const f32x2 sz2 = {sz, sz}, sp2 = {sp, sp}, v2 = {vi, vi};
    f32x2 yz2 = {0.f, 0.f}, yp2 = {0.f, 0.f}, nz2 = {0.f, 0.f}, np2 = {0.f, 0.f};
    f32x4 buf[3][5];
#define S3_LD(g, j) do { buf[g][0] = b4[j]; buf[g][1] = k4[j]; buf[g][2] = w4[j]; buf[g][3] = r4[j]; buf[g][4] = an4[j]; asm volatile("" ::: "memory"); } while (0)
    S3_LD(0, 0); S3_LD(1, 1);
#pragma unroll
    for (int j = 0; j < 16; ++j) {
        if (j + 2 < 16) S3_LD((j + 2) % 3, j + 2);
        const f32x4 bv = buf[j % 3][0], kv = buf[j % 3][1], wv = buf[j % 3][2], rv = buf[j % 3][3], av = buf[j % 3][4];
        { const f32x2 b2 = {bv.x, bv.y}, k2 = {kv.x, kv.y}, w2 = {wv.x, wv.y}, r2 = {rv.x, rv.y}, a2 = {av.x, av.y};
          f32x2 tz = sz2 * b2; tz = fma2(v2, k2, tz); Z[2 * j] = fma2(Z[2 * j], w2, tz); yz2 = fma2(Z[2 * j], r2, yz2); nz2 = fma2(Z[2 * j], a2, nz2);
          const f32x2 tp = sp2 * b2; P[2 * j] = fma2(P[2 * j], w2, tp); yp2 = fma2(P[2 * j], r2, yp2); np2 = fma2(P[2 * j], a2, np2); }
        { const f32x2 b2 = {bv.z, bv.w}, k2 = {kv.z, kv.w}, w2 = {wv.z, wv.w}, r2 = {rv.z, rv.w}, a2 = {av.z, av.w};
          f32x2 tz = sz2 * b2; tz = fma2(v2, k2, tz); Z[2 * j + 1] = fma2(Z[2 * j + 1], w2, tz); yz2 = fma2(Z[2 * j + 1], r2, yz2); nz2 = fma2(Z[2 * j + 1], a2, nz2);
          const f32x2 tp = sp2 * b2; P[2 * j + 1] = fma2(P[2 * j + 1], w2, tp); yp2 = fma2(P[2 * j + 1], r2, yp2); np2 = fma2(P[2 * j + 1], a2, np2); }
        asm volatile("" ::: "memory");
    }
#undef S3_LD
    yz = yz2.x + yz2.y; yp = yp2.x + yp2.y; sz = nz2.x + nz2.y; sp = np2.x + np2.y;
}
DI void scan_pass1_unit(const Args& a, unsigned char* lds, int unit, int wave, int lane) {
    float* stg = (float*)lds;
    const int pp = wave & 3, pair = unit * 4 + pp, chain = pair / NS, seg = pair % NS, b = chain >> 4, h = chain & 15, c = h * 64 + lane;
    const int mbase = b * SEQ + seg * SEGL;
    constexpr int NB = SEGL / TB;
    if (wave < 4) {
        bf16_t* YL = (bf16_t*)(a.ws + WS_YL); bf16_t* QS = (bf16_t*)(a.ws + WS_QS); float* ZP = (float*)(a.ws + WS_ZP);
        f32x2 Z[32], P[32];
        int idl = lane; asm volatile("" : "+v"(idl));
#pragma unroll
        for (int j = 0; j < 32; ++j) { Z[j] = (f32x2){0.f, 0.f}; P[j] = (f32x2){idl == 2 * j ? 1.f : 0.f, idl == 2 * j + 1 ? 1.f : 0.f}; }
        WG_BAR_LDS();
        for (int blk = 0; blk < NB; ++blk) {
            const float* sb = stg + (((blk & 1) * 4 + pp) * TB) * 384;
            float sz, sp; scan_dot_a(Z, P, sb, sz, sp);
#pragma unroll 1
            for (int tt = 0; tt < TB; ++tt) {
                const float* sv = sb + tt * 384; const float* svn = sb + (tt + 1 < TB ? tt + 1 : tt) * 384;
                float yz, yp; scan_step3(Z, P, sv, svn, sv[192 + lane], sz, sp, yz, yp);
                const size_t o = (size_t)(mbase + blk * TB + tt) * 1024 + c;
                const unsigned yq = pk2(yz, yp); YL[o] = (bf16_t)(yq & 0xffffu); QS[o] = (bf16_t)(yq >> 16);
            }
            WG_BAR_LDS();
        }
        float* zp = ZP + (size_t)pair * 2 * 4096 + lane * 64;
#pragma unroll
        for (int j = 0; j < 16; ++j) { *(f32x4*)(zp + 4 * j) = (f32x4){Z[2 * j].x, Z[2 * j].y, Z[2 * j + 1].x, Z[2 * j + 1].y};
                                       *(f32x4*)(zp + 4096 + 4 * j) = (f32x4){P[2 * j].x, P[2 * j].y, P[2 * j + 1].x, P[2 * j + 1].y}; }
    } else {
        const bf16_t* RW = (const bf16_t*)(a.ws + WS_RW); const bf16_t* Lb = (const bf16_t*)(a.ws + WS_L);
        bf16_t* GB = (bf16_t*)(a.ws + WS_GB);
        PrepParams Pm; prep_params(a, Pm, c);
        PrepRaw raw[TB];
#define P1_LOAD(blk_) do { _Pragma("unroll") for (int k = 0; k < TB; ++k) { const int m = mbase + (blk_) * TB + k; prep_load(a, raw[k], RW, m, Lb + (size_t)m * NLO, c); } } while (0)
#define P1_FINISH(blk_) do { _Pragma("unroll") for (int k = 0; k < TB; ++k) { const int m = mbase + (blk_) * TB + k; float g, bon; \
            prep_finish(raw[k], Pm, stg + ((((blk_) & 1) * 4 + pp) * TB + k) * 384, g, bon, lane); \
            GB[((size_t)m * 16 + h) * 128 + lane] = (bf16_t)bf_rne(g); GB[((size_t)m * 16 + h) * 128 + 64 + lane] = (bf16_t)bf_rne(bon); } } while (0)
        P1_LOAD(0); P1_FINISH(0); P1_LOAD(1);
        WG_BAR_LDS();
        for (int blk = 0; blk < NB; ++blk) {
            if (blk + 1 < NB) P1_FINISH(blk + 1);
            if (blk + 2 < NB) P1_LOAD(blk + 2);
            WG_BAR_LDS();
        }
#undef P1_LOAD
#undef P1_FINISH
    }
}
DI void scan_sample_unit(const Args& a, unsigned char* lds, int unit, int wave, int lane) {
    float* sv = (float*)(lds + 2 * 4 * TB * 384 * 4) + wave * 384;
    const bf16_t* RW = (const bf16_t*)(a.ws + WS_RW); const bf16_t* Lb = (const bf16_t*)(a.ws + WS_L);
    const int b = unit >> 4, h = unit & 15, c = h * 64 + lane, m = MP + b;
    PrepParams P; prep_params(a, P, c);
    PrepRaw raw; prep_load(a, raw, RW, m, Lb + (size_t)m * NLO, c);
    float g, bon; prep_finish(raw, P, sv, g, bon, lane);
    float S[64];
    const float* s0 = a.in[I_SWKV] + ((size_t)(b * 16 + h) * 64 + lane) * 64;
#pragma unroll
    for (int j = 0; j < 16; ++j) { const f32x4 v = *(const f32x4*)(s0 + 4 * j); S[4 * j] = v.x; S[4 * j + 1] = v.y; S[4 * j + 2] = v.z; S[4 * j + 3] = v.w; }
    const float y = scan_step(S, sv, sv[192 + lane]);
    float* so = a.out + O_SWKV + ((size_t)(b * 16 + h) * 64 + lane) * 64;
#pragma unroll
    for (int j = 0; j < 16; ++j) *(f32x4*)(so + 4 * j) = (f32x4){S[4 * j], S[4 * j + 1], S[4 * j + 2], S[4 * j + 3]};
    rwkv_post(a, y, g, bon, m, c);
}
DI void scan_pass2_unit(const Args& a, unsigned char* lds, int chain, int wave, int lane) {
    float* Ssh = (float*)lds;
    float* Psh = Ssh + 64 * 65;
    const float* ZP = (const float*)(a.ws + WS_ZP); float* SST = (float*)(a.ws + WS_SST);
    const int tid = wave * 64 + lane, l16 = lane & 15, lq = lane >> 4, ib = wave >> 1, jb0 = 2 * (wave & 1);
    f32x4 S0 = {0.f, 0.f, 0.f, 0.f}, S1 = {0.f, 0.f, 0.f, 0.f};
    const float* Z0 = ZP + (size_t)(chain * NS) * 2 * 4096;
    f32x4 pn0 = *(const f32x4*)(Z0 + 4096 + tid * 8), pn1 = *(const f32x4*)(Z0 + 4096 + tid * 8 + 4);
    float zn0[4], zn1[4];
#pragma unroll
    for (int i = 0; i < 4; ++i) { zn0[i] = Z0[(16 * ib + 4 * lq + i) * 64 + 16 * jb0 + l16]; zn1[i] = Z0[(16 * ib + 4 * lq + i) * 64 + 16 * (jb0 + 1) + l16]; }
    for (int s = 0; s < NS; ++s) {
        float* sst = SST + ((size_t)chain * NS + s) * 4096;
#pragma unroll
        for (int i = 0; i < 4; ++i) { const int row = 16 * ib + 4 * lq + i;
            sst[row * 64 + 16 * jb0 + l16] = S0[i]; sst[row * 64 + 16 * (jb0 + 1) + l16] = S1[i];
            Ssh[row * 65 + 16 * jb0 + l16] = S0[i]; Ssh[row * 65 + 16 * (jb0 + 1) + l16] = S1[i]; }
        *(f32x4*)(Psh + tid * 8) = pn0; *(f32x4*)(Psh + tid * 8 + 4) = pn1;
        f32x4 n0 = {zn0[0], zn0[1], zn0[2], zn0[3]}, n1 = {zn1[0], zn1[1], zn1[2], zn1[3]};
        if (s + 1 < NS) {
            const float* Zs = ZP + (size_t)(chain * NS + s + 1) * 2 * 4096;
            pn0 = *(const f32x4*)(Zs + 4096 + tid * 8); pn1 = *(const f32x4*)(Zs + 4096 + tid * 8 + 4);
#pragma unroll
            for (int i = 0; i < 4; ++i) { zn0[i] = Zs[(16 * ib + 4 * lq + i) * 64 + 16 * jb0 + l16]; zn1[i] = Zs[(16 * ib + 4 * lq + i) * 64 + 16 * (jb0 + 1) + l16]; }
        }
        WG_BAR_LDS();
        if (s > 0) {
#pragma unroll
            for (int kk = 0; kk < 16; ++kk) {
                const float af = Ssh[(16 * ib + l16) * 65 + 4 * kk + lq];
                const float b0 = Psh[(4 * kk + lq) * 64 + 16 * jb0 + l16], b1 = Psh[(4 * kk + lq) * 64 + 16 * (jb0 + 1) + l16];
                n0 = __builtin_amdgcn_mfma_f32_16x16x4f32(af, b0, n0, 0, 0, 0);
                n1 = __builtin_amdgcn_mfma_f32_16x16x4f32(af, b1, n1, 0, 0, 0);
            }
        }
        WG_BAR_LDS();
        S0 = n0; S1 = n1;
    }
    float* so = a.out + O_PWKV + (size_t)chain * 4096;
#pragma unroll
    for (int i = 0; i < 4; ++i) { const int row = 16 * ib + 4 * lq + i; so[row * 64 + 16 * jb0 + l16] = S0[i]; so[row * 64 + 16 * (jb0 + 1) + l16] = S1[i]; }
}
DI bf16x8 cvt8(const f32x4 lo, const f32x4 hi) { u32x4 p; p.x = pk2(lo.x, lo.y); p.y = pk2(lo.z, lo.w); p.z = pk2(hi.x, hi.y); p.w = pk2(hi.z, hi.w); return __builtin_bit_cast(bf16x8, p); }
DI void scan_pass3_unit(const Args& a, int unit, int lane) {
    const float* SST = (const float*)(a.ws + WS_SST); const bf16_t* YL = (const bf16_t*)(a.ws + WS_YL); const bf16_t* QS = (const bf16_t*)(a.ws + WS_QS); const bf16_t* GB = (const bf16_t*)(a.ws + WS_GB);
    bf16_t* O = (bf16_t*)(a.ws + WS_O);
    const int sub = unit & 3, pair = unit >> 2, chain = pair / NS, seg = pair % NS, b = chain >> 4, h = chain & 15;
    const int r = lane & 31, hh = lane >> 5;
    const int m = b * SEQ + seg * SEGL + sub * 32 + r;
    f32x16 acc0, acc1;
#pragma unroll
    for (int i = 0; i < 16; ++i) { acc0[i] = 0.f; acc1[i] = 0.f; }
    const bf16_t* qrow = QS + (size_t)m * 1024 + h * 64 + 8 * hh;
    const float* s0 = SST + (size_t)pair * 4096 + (size_t)r * 64 + 8 * hh; const float* s1 = s0 + 32 * 64;
#pragma unroll
    for (int ks = 0; ks < 4; ++ks) {
        const bf16x8 qf = *(const bf16x8*)(qrow + ks * 16);
        const bf16x8 a0 = cvt8(*(const f32x4*)(s0 + ks * 16), *(const f32x4*)(s0 + ks * 16 + 4));
        const bf16x8 a1 = cvt8(*(const f32x4*)(s1 + ks * 16), *(const f32x4*)(s1 + ks * 16 + 4));
        acc0 = __builtin_amdgcn_mfma_f32_32x32x16_bf16(a0, qf, acc0, 0, 0, 0);
        acc1 = __builtin_amdgcn_mfma_f32_32x32x16_bf16(a1, qf, acc1, 0, 0, 0);
    }
    const bf16_t* yl = YL + (size_t)m * 1024 + h * 64 + 4 * hh;
    float y[32]; float sum = 0.f;
#pragma unroll
    for (int rt = 0; rt < 2; ++rt)
#pragma unroll
        for (int g = 0; g < 4; ++g) { const u32x2 yw = *(const u32x2*)(yl + rt * 32 + 8 * g); const f32x4 v = {__uint_as_float(yw.x << 16), __uint_as_float(yw.x & 0xffff0000u), __uint_as_float(yw.y << 16), __uint_as_float(yw.y & 0xffff0000u)};
#pragma unroll
            for (int e = 0; e < 4; ++e) { const float yy = v[e] + (rt == 0 ? acc0[4 * g + e] : acc1[4 * g + e]); y[rt * 16 + 4 * g + e] = yy; sum += yy; } }
    sum += __shfl_xor(sum, 32);
    const float mean = sum * (1.f / 64.f);
    float vs = 0.f;
#pragma unroll
    for (int e = 0; e < 32; ++e) { y[e] -= mean; vs += y[e] * y[e]; }
    vs += __shfl_xor(vs, 32);
    const float rstd = rsqrtf(vs * (1.f / 64.f) + 64e-5f);
    const bf16_t* gb = GB + ((size_t)m * 16 + h) * 128 + 4 * hh;
    const float* lw = a.in[I_LNW] + h * 64 + 4 * hh; const float* lb = a.in[I_LNB] + h * 64 + 4 * hh;
    bf16_t* orow = O + (size_t)m * D + 1024 + h * 64 + 4 * hh;
    f32x4 w4s[8], b4s[8]; u32x2 gws[8], bws[8];
#pragma unroll
    for (int q = 0; q < 8; ++q) { const int off = (q >> 2) * 32 + 8 * (q & 3); w4s[q] = *(const f32x4*)(lw + off); b4s[q] = *(const f32x4*)(lb + off); gws[q] = *(const u32x2*)(gb + off); bws[q] = *(const u32x2*)(gb + 64 + off); }
#pragma unroll
    for (int rt = 0; rt < 2; ++rt)
#pragma unroll
        for (int g = 0; g < 4; ++g) {
            const int off = rt * 32 + 8 * g;
            const f32x4 w4 = w4s[rt * 4 + g], b4 = b4s[rt * 4 + g];
            const u32x2 gw = gws[rt * 4 + g], bw = bws[rt * 4 + g];
            const float gg[4] = {__uint_as_float(gw.x << 16), __uint_as_float(gw.x & 0xffff0000u), __uint_as_float(gw.y << 16), __uint_as_float(gw.y & 0xffff0000u)};
            const float bb[4] = {__uint_as_float(bw.x << 16), __uint_as_float(bw.x & 0xffff0000u), __uint_as_float(bw.y << 16), __uint_as_float(bw.y & 0xffff0000u)};
            float o[4];
#pragma unroll
            for (int e = 0; e < 4; ++e) o[e] = (y[rt * 16 + 4 * g + e] * rstd * w4[e] + b4[e] + bb[e]) * gg[e];
            u32x2 w; w.x = pk2(o[0], o[1]); w.y = pk2(o[2], o[3]);
            *(u32x2*)(orow + off) = w;
        }
}

DI void unpack8(const u32x4 w, float (&u)[8]) {
    u[0] = __uint_as_float(w.x << 16); u[1] = __uint_as_float(w.x & 0xffff0000u); u[2] = __uint_as_float(w.y << 16); u[3] = __uint_as_float(w.y & 0xffff0000u);
    u[4] = __uint_as_float(w.z << 16); u[5] = __uint_as_float(w.z & 0xffff0000u); u[6] = __uint_as_float(w.w << 16); u[7] = __uint_as_float(w.w & 0xffff0000u);
}
constexpr int FIX_ROWS = 28 * 2 + MS + 8;
DI void conv_fix(const Args& a, int idx) {
    const int fg = idx % (FF / 8), ri = idx / (FF / 8), f = fg * 8;
    if (ri >= FIX_ROWS) return;
    const float* EDGE = (const float*)(a.ws + WS_U); bf16_t* ACT = (bf16_t*)(a.ws + WS_ACT);
    const float* cw = a.in[I_FCW]; const float* cb = a.in[I_FCB];
    const float *p0, *p1, *p2; int m;
    if (ri < 56) {
        const int ti = ri >> 1, k = ri & 1, pm = ti + 1 + ti / 7;
        m = pm * 256 + k;
        p0 = EDGE + ((size_t)pm * 4 + k) * FF2;
        p1 = k == 0 ? EDGE + ((size_t)(pm - 1) * 4 + 3) * FF2 : EDGE + ((size_t)pm * 4 + 0) * FF2;
        p2 = k == 0 ? EDGE + ((size_t)(pm - 1) * 4 + 2) * FF2 : EDGE + ((size_t)(pm - 1) * 4 + 3) * FF2;
    } else if (ri >= 56 + MS) {
        const int q = ri - 56 - MS, bb = q >> 1, k = q & 1;
        const float* src = EDGE + ((size_t)(bb * 8 + 7) * 4 + 2 + k) * FF2; float* dst = a.out + O_PFFN + ((size_t)bb * 2 + k) * FF2;
#pragma unroll
        for (int p = 0; p < 2; ++p) { *(f32x4*)(dst + p * FF + f) = *(const f32x4*)(src + p * FF + f); *(f32x4*)(dst + p * FF + f + 4) = *(const f32x4*)(src + p * FF + f + 4); }
        return;
    } else {
        const int b = ri - 56; m = MP + b;
        p0 = EDGE + (size_t)(128 + b) * FF2;
        { float* s1 = a.out + O_SFFN + (size_t)b * 2 * FF2 + FF2;
#pragma unroll
          for (int p = 0; p < 2; ++p) { *(f32x4*)(s1 + p * FF + f) = *(const f32x4*)(p0 + p * FF + f); *(f32x4*)(s1 + p * FF + f + 4) = *(const f32x4*)(p0 + p * FF + f + 4); } }
        p1 = a.in[I_SFFN] + (size_t)b * 2 * FF2 + FF2;
        p2 = a.in[I_SFFN] + (size_t)b * 2 * FF2;
        float* so = a.out + O_SFFN + (size_t)b * 2 * FF2;
#pragma unroll
        for (int p = 0; p < 2; ++p) { *(f32x4*)(so + p * FF + f) = *(const f32x4*)(p1 + p * FF + f); *(f32x4*)(so + p * FF + f + 4) = *(const f32x4*)(p1 + p * FF + f + 4); }
    }
    float c[2][8];
#pragma unroll
    for (int p = 0; p < 2; ++p)
#pragma unroll
        for (int j = 0; j < 8; ++j) { const int col = p * FF + f + j; c[p][j] = cb[col] + cw[col] * p2[col] + cw[FF2 + col] * p1[col] + cw[2 * FF2 + col] * p0[col]; }
    float o[8];
#pragma unroll
    for (int j = 0; j < 8; ++j) o[j] = c[0][j] * __builtin_amdgcn_rcpf(1.f + __expf(-c[0][j])) * c[1][j];
    u32x4 w; w.x = pk2(o[0], o[1]); w.y = pk2(o[2], o[3]); w.z = pk2(o[4], o[5]); w.w = pk2(o[6], o[7]);
    *(u32x4*)(ACT + (size_t)m * FF + f) = w;
}

#define XB_TMO      128
#define XB_XCNT(j)  (256  + 64 * (j))
#define XB_XSUB(j)  (1280 + 64 * (j))
#define XB_XGEN(j)  (2304 + 64 * (j))
#define XB_TOP      3328
#define XB_TOPGEN   3392
#define XCD_BAR_WORDS 3456
#define XB_SPIN_CAP (1u << 18)
DI unsigned xb_ld(unsigned* p)              { return __hip_atomic_load(p, __ATOMIC_RELAXED, __HIP_MEMORY_SCOPE_AGENT); }
DI unsigned xb_add(unsigned* p, unsigned v) { return __hip_atomic_fetch_add(p, v, __ATOMIC_RELAXED, __HIP_MEMORY_SCOPE_AGENT); }
DI unsigned xb_xcc_id() { return (unsigned)__builtin_amdgcn_s_getreg((3 << 11) | 20) & 0xFu; }
#define XB_SPIN(cond, bar) do { unsigned _sp = 0; while (cond) { __builtin_amdgcn_s_sleep(1); \
    if ((++_sp & 255u) == 0u) { if (xb_ld(&(bar)[XB_TMO])) break; if (_sp > XB_SPIN_CAP) { atomicAdd(&(bar)[XB_TMO], 1u); break; } } } } while (0)
struct XcdBarrier { unsigned* bar; unsigned x; volatile LAS unsigned* st; };
DI XcdBarrier xcd_barrier_post(unsigned* bar, volatile LAS unsigned* st) {
    XcdBarrier b; b.bar = bar; b.x = xb_xcc_id(); b.st = st;
    if (threadIdx.x == 0) (void)xb_add(&bar[XB_XCNT(b.x)], 1u);
    return b;
}
DI void xcd_barrier_complete(unsigned* bar, unsigned x, unsigned& nloc, unsigned& nx) {
    const unsigned G = gridDim.x * gridDim.y * gridDim.z;
    unsigned sum, cnt, mine, sp = 0u;
    for (;;) {
        sum = 0u; cnt = 0u; mine = 0u;
#pragma unroll
        for (unsigned j = 0; j < 16; ++j) { const unsigned c = xb_ld(&bar[XB_XCNT(j)]); sum += c; cnt += (c > 0u) ? 1u : 0u; mine = (j == x) ? c : mine; }
        if (sum == G) break;
        __builtin_amdgcn_s_sleep(1);
        if ((++sp & 255u) == 0u) { if (xb_ld(&bar[XB_TMO])) break; if (sp > XB_SPIN_CAP) { atomicAdd(&bar[XB_TMO], 1u); break; } }
    }
    nloc = mine > 0u ? mine : 1u; nx = cnt > 0u ? cnt : 1u;
}
DI void xcd_barrier(const XcdBarrier& b) {
    asm volatile("s_waitcnt vmcnt(0)" ::: "memory");
    __syncthreads();
    if (threadIdx.x == 0) {
        unsigned* bar = b.bar;
        __builtin_amdgcn_s_waitcnt(0);
        unsigned nloc = b.st[0], nx = b.st[1];
        if (nloc == 0u) { xcd_barrier_complete(bar, b.x, nloc, nx); b.st[0] = nloc; b.st[1] = nx; }
        const unsigned old = xb_add(&bar[XB_XSUB(b.x)], 1u);
        const unsigned gen = old / nloc;
        if (old + 1u == (gen + 1u) * nloc) {
            __builtin_amdgcn_fence(__ATOMIC_RELEASE, "agent");
            asm volatile("s_waitcnt vmcnt(0)" ::: "memory");
            const unsigned og = xb_add(&bar[XB_TOP], 1u);
            const unsigned tg = og / nx;
            if (og + 1u == (tg + 1u) * nx) xb_add(&bar[XB_TOPGEN], 1u);
            else XB_SPIN(xb_ld(&bar[XB_TOPGEN]) == tg, bar);
            __builtin_amdgcn_fence(__ATOMIC_ACQUIRE, "agent");
            xb_add(&bar[XB_XGEN(b.x)], 1u);
            asm volatile("s_waitcnt vmcnt(0)" ::: "memory");
        } else {
            XB_SPIN(xb_ld(&bar[XB_XGEN(b.x)]) == gen, bar);
            __builtin_amdgcn_fence(__ATOMIC_ACQUIRE, "agent");
            asm volatile("s_waitcnt vmcnt(0)" ::: "memory");
        }
    }
    __syncthreads();
}

DI void skinny_unit(const bf16_t* A, int lda, const bf16_t* Bt, int K, int unit, const float* base, int ldb, float* out, int ldo, unsigned char* lds, int wave, int lane,
                    const float* gf = nullptr, bf16_t* H = nullptr, float* RSS = nullptr) {
    float* red = (float*)lds;
    const int n0 = unit * 32, r = lane & 31, hh = lane >> 5, kw = K / 8, kb = wave * kw;
    f32x16 acc;
#pragma unroll
    for (int i = 0; i < 16; ++i) acc[i] = 0.f;
    const bf16_t* ap = A + (size_t)r * lda + kb + 8 * hh; const bf16_t* bp = Bt + (size_t)(n0 + r) * K + kb + 8 * hh;
    for (int k0 = 0; k0 < kw; k0 += 128) {
        bf16x8 af[8], bf[8];
#pragma unroll
        for (int i = 0; i < 8; ++i) { const int k = k0 + 16 * i < kw ? k0 + 16 * i : 0; af[i] = *(const bf16x8*)(ap + k); bf[i] = *(const bf16x8*)(bp + k); }
#pragma unroll
        for (int i = 0; i < 8; ++i) if (k0 + 16 * i < kw) acc = __builtin_amdgcn_mfma_f32_32x32x16_bf16(af[i], bf[i], acc, 0, 0, 0);
    }
#pragma unroll
    for (int i = 0; i < 16; ++i) red[(wave * 16 + i) * 64 + lane] = acc[i];
    __syncthreads();
#pragma unroll
    for (int q = 0; q < 2; ++q) {
        const int o = threadIdx.x + 512 * q, i = o >> 6, ln = o & 63;
        float sum = 0.f;
#pragma unroll
        for (int w = 0; w < 8; ++w) sum += red[(w * 16 + i) * 64 + ln];
        const int row = crow(i, ln >> 5), col = n0 + (ln & 31);
        const float x1 = base[(size_t)row * ldb + col] + sum * (H ? 1.0f : MK_P11_SCALE);
        out[(size_t)row * ldo + col] = x1;
        if (H) { H[(size_t)row * D + col] = (bf16_t)bf_rne(x1 * gf[col]);
            float ss = x1 * x1;
            ss += __shfl_xor(ss, 1); ss += __shfl_xor(ss, 2); ss += __shfl_xor(ss, 4); ss += __shfl_xor(ss, 8); ss += __shfl_xor(ss, 16);
            if ((ln & 31) == 0) atomic_add_f32(RSS + row, ss); }
    }
    __syncthreads();
}

constexpr int NPH = 14;
template <bool COOP>
__global__ void __launch_bounds__(NTHREADS, 2) mk_fwd(Args a) {
    extern __shared__ __attribute__((aligned(16))) unsigned char lds[];
    const int tid = threadIdx.x, lane = tid & 63, wave = __builtin_amdgcn_readfirstlane(tid >> 6);
    const int G = gridDim.x, bid = blockIdx.x, gw = bid * NWAVES + wave, ngw = G * NWAVES;
    unsigned char* ws = a.ws;
    LAS unsigned char* ldsl = (LAS unsigned char*)lds;
#ifndef PHMASK
#define PHMASK 0xffff
#endif
#define IN(k) (((PHMASK >> (k)) & 1) && a.ph_lo <= (k) && (k) < a.ph_hi)
    XcdBarrier xbar; xbar.bar = (unsigned*)(ws + WS_BAR); xbar.x = 0; xbar.st = nullptr;
    if (COOP) {
        volatile LAS unsigned* st = (volatile LAS unsigned*)(ldsl + LDS_BYTES - 16);
        if (tid < 4) st[tid] = 0u;
        __syncthreads();
        xbar = xcd_barrier_post((unsigned*)(ws + WS_BAR), st);
    }
#define SEAM(k) do { if (COOP && IN(k) && IN((k) + 1)) { if (a.ph_hi > 1000) cg::this_grid().sync(); else xcd_barrier(xbar); } } while (0)

    if (IN(0)) phase_prologue(a, lds, gw, ngw, lane, wave);
    SEAM(0);
    if (IN(1)) {
        pg8::Gemm g{(const bf16_t*)(ws + WS_H), (const bf16_t*)(ws + WS_WIN), MPAD, NIN, D}; pg8::StaticOrder S; S.init(MPAD, NIN, G, bid);
        EpiIn E{(bf16_t*)(ws + WS_QB), (bf16_t*)(ws + WS_KB), (bf16_t*)(ws + WS_VB), (bf16_t*)(ws + WS_RW), a.out};
        pg8::gemm_phase<EpiIn>(ldsl, g, S, E);
        {
            const int nu = (MPAD / 256) * (NIN / 256), rem = nu % G, first = rem == 0 ? 0 : rem, nfree = G - first;
            if (bid >= first) convert_wo_wup(a, lds, (bid - first) * NWAVES + wave, nfree * NWAVES, wave, lane);
        }
    }
    SEAM(1);
    if (IN(2)) {
        for (int u = bid; u < 256; u += G) attn_sample_wg(a, lds, u, wave, lane);
        {
            const int vb = (G % 8 == 0) ? (bid % 8) * (G / 8) + bid / 8 : bid;
            for (int u = vb * NWAVES + wave; u < 64 * 3 * 64; u += ngw) attn_prompt_unit(a, lds, u, wave, lane);
        }
        for (int m = gw; m < MPAD; m += ngw) lora_input_row(a, m, lane);
    }
    SEAM(2);
    if (IN(3)) {
        pg8::Gemm g{(const bf16_t*)(ws + WS_ALO), (const bf16_t*)(ws + WS_WLO), MPAD, NLO, KLO}; pg8::StaticOrder S; S.init(MPAD, NLO, G, bid);
        EpiBf E{(bf16_t*)(ws + WS_L), NLO};
        pg8::gemm_phase<EpiBf>(ldsl, g, S, E);
#pragma unroll 2
        for (int t = gw; t < MP * 4; t += ngw) attn_merge_task(a, t, lane);
    }
    SEAM(3);
    if (IN(4)) {
#ifndef NO_P1
        for (int u = bid; u < 64 * NS / 4; u += G) scan_pass1_unit(a, lds, u, wave, lane);
#endif

    }
    SEAM(4);
    if (IN(5)) {
        if (G >= 128) {
            if (bid < 64) scan_pass2_unit(a, lds, bid, wave, lane);
            else for (int u = (bid - 64) * NWAVES + wave; u < 512; u += (G - 64) * NWAVES) scan_sample_unit(a, lds, u, wave, lane);
        } else {
            for (int ch = bid; ch < 64; ch += G) scan_pass2_unit(a, lds, ch, wave, lane);
            for (int u = gw; u < 512; u += ngw) scan_sample_unit(a, lds, u, wave, lane);
        }
    }
    SEAM(5);
    if (IN(6)) { for (int u = gw; u < 64 * NS * 4; u += ngw) scan_pass3_unit(a, u, lane); }
    SEAM(6);
    if (IN(7)) {
        pg8::Gemm g{(const bf16_t*)(ws + WS_O), (const bf16_t*)(ws + WS_WO), MP, D, D}; pg8::StaticOrder S; S.init(MP, D, G, bid);
        EpiWo E{a.in[I_XP], a.in[I_NFG], (float*)(ws + WS_X1), (bf16_t*)(ws + WS_H), (float*)(ws + WS_RSS)};
        pg8::gemm_phase<EpiWo>(ldsl, g, S, E);
        for (int u = bid; u < D / 32; u += G)
            skinny_unit((const bf16_t*)(ws + WS_O) + (size_t)MP * D, D, (const bf16_t*)(ws + WS_WO), D, u, a.in[I_XS], D, (float*)(ws + WS_X1) + (size_t)MP * D, D, lds, wave, lane,
                        a.in[I_NFG], (bf16_t*)(ws + WS_H) + (size_t)MP * D, (float*)(ws + WS_RSS) + MP);
    }
    SEAM(7);
    if (IN(9)) {
        pg8::Gemm g{(const bf16_t*)(ws + WS_H), (const bf16_t*)(ws + WS_WUP), MPAD, FF2, D}; pg8::StaticOrder S; S.init(MPAD, FF2, G, bid);
        EpiUpF E{(bf16_t*)(ws + WS_ACT), a.out, (const float*)(ws + WS_RSS), a.in[I_FCW], a.in[I_FCB], (float*)(ws + WS_U), (LAS float*)(ldsl + 131072)};
        pg8::gemm_phase<EpiUpF>(ldsl, g, S, E);
        {
            const int nu = (MPAD / 256) * (FF2 / 256), rem = nu % G, first = rem == 0 ? 0 : rem, nfree = G - first;
            if (bid >= first) convert_wdn(a, lds, (bid - first) * NWAVES + wave, nfree * NWAVES, wave, lane);
        }
    }
    SEAM(9);
    if (IN(10)) { for (int it = bid * NTHREADS + tid; it < FIX_ROWS * (FF / 8); it += G * NTHREADS) conv_fix(a, it); }
    SEAM(10);
    if (IN(11)) {
        pg8::Gemm g{(const bf16_t*)(ws + WS_ACT), (const bf16_t*)(ws + WS_WDN), MP, D, FF}; pg8::StaticOrder S; S.init(MP, D, G, bid);
        EpiDn E{(float*)(ws + WS_X1)};
        pg8::gemm_phase<EpiDn>(ldsl, g, S, E);
        for (int u = bid; u < D / 32; u += G)
            skinny_unit((const bf16_t*)(ws + WS_ACT) + (size_t)MP * FF, FF, (const bf16_t*)(ws + WS_WDN), FF, u, (const float*)(ws + WS_X1) + (size_t)MP * D, D, (float*)(ws + WS_X1) + (size_t)MP * D, D, lds, wave, lane);
    }
    SEAM(11);
    if (IN(12)) {
        for (int m = gw; m < MT; m += ngw)
            rms_row_f32((const float*)(ws + WS_X1) + (size_t)m * D, a.in[I_NFIN], m < MP ? a.out + O_YP + (size_t)m * D : a.out + O_YS + (size_t)(m - MP) * D, lane);
    }
#undef IN
#undef SEAM
}

#ifndef MK_ONE_LAUNCH
#define MK_ONE_LAUNCH 1
#endif
#ifndef MK_DBL_MASK
#define MK_DBL_MASK 0x0
#endif

extern "C" void kernel_launch(void* const* d_in, const int* in_sizes, int n_in, void* d_out, int out_size, void* d_ws, size_t ws_size, hipStream_t stream) {
    static int grid = 0;
    if (!grid) {
        if (n_in != 28 || (size_t)out_size != O_END || ws_size < WS_END) fprintf(stderr, "kernel_launch: unexpected shapes: n_in %d out %d (want %zu) ws %zu (want %zu)\n", n_in, out_size, O_END, ws_size, WS_END);
        int dev = 0, cus = 0; hipGetDevice(&dev); hipDeviceGetAttribute(&cus, hipDeviceAttributeMultiprocessorCount, dev);
        hipFuncSetAttribute((const void*)mk_fwd<true>, hipFuncAttributeMaxDynamicSharedMemorySize, LDS_BYTES);
        hipFuncSetAttribute((const void*)mk_fwd<false>, hipFuncAttributeMaxDynamicSharedMemorySize, LDS_BYTES);
        int per_cu = 0; hipOccupancyMaxActiveBlocksPerMultiprocessor(&per_cu, mk_fwd<true>, NTHREADS, LDS_BYTES);
        if (per_cu < 1) { fprintf(stderr, "kernel_launch: occupancy query says %d blocks/CU\n", per_cu); per_cu = 1; }
        grid = cus > 0 ? cus : 256;
    }
    Args a; memset(&a, 0, sizeof(a));
    for (int i = 0; i < 28; ++i) a.in[i] = (const float*)d_in[i];
    a.out = (float*)d_out; a.ws = (unsigned char*)d_ws;
#if MK_ONE_LAUNCH
    if (hipMemsetAsync((char*)d_ws + WS_BAR, 0, BAR_BYTES, stream) != hipSuccess) { fprintf(stderr, "kernel_launch: memset of the barrier words failed\n"); return; }
    a.ph_lo = 0; a.ph_hi = NPH;
    void* args[] = {&a};
    hipError_t e = hipLaunchCooperativeKernel((const void*)mk_fwd<true>, dim3(grid), dim3(NTHREADS), args, LDS_BYTES, stream);
    if (e != hipSuccess) fprintf(stderr, "cooperative launch failed: %s (grid %d)\n", hipGetErrorString(e), grid);
#else
    for (int p = 0; p < 13; ++p) {
        a.ph_lo = p; a.ph_hi = p + 1;
        mk_fwd<false><<<dim3(grid), dim3(NTHREADS), LDS_BYTES, stream>>>(a);
        if ((MK_DBL_MASK >> p) & 1) mk_fwd<false><<<dim3(grid), dim3(NTHREADS), LDS_BYTES, stream>>>(a);
    }
#endif
}
```

```cpp
#include <hip/hip_runtime.h>
#include <hip/hip_cooperative_groups.h>
#include <cstdio>
#include <cstdint>
#include <cstring>
namespace cg = cooperative_groups;

#define DI __device__ __forceinline__
#define LAS __attribute__((address_space(3)))
typedef unsigned short bf16_t;
typedef short bf16x8 __attribute__((ext_vector_type(8)));
typedef float f32x4 __attribute__((ext_vector_type(4)));
typedef float f32x16 __attribute__((ext_vector_type(16)));
typedef unsigned u32x4 __attribute__((ext_vector_type(4)));
typedef unsigned u32x2 __attribute__((ext_vector_type(2)));

constexpr int D = 2048, MP = 8192, MS = 32, MT = 8224, MPAD = 8448, SEQ = 2048;
constexpr int CIN = 6432, NIN = 6656, CSH = 3360, FF2 = 11264, FF = 5632;
constexpr int NLO = 3072, KLO = 384;
constexpr int NS = 16, SEGL = 128, TB = 8;
constexpr int NTHREADS = 512, NWAVES = 8;
constexpr int LDS_BYTES = 131072 + 16384;

constexpr size_t O_YP = 0;
constexpr size_t O_YS = O_YP + (size_t)MP * D;
constexpr size_t O_PK = O_YS + (size_t)MS * D;
constexpr size_t O_PV = O_PK + (size_t)MP * 1024;
constexpr size_t O_PRW = O_PV + (size_t)MP * 1024;
constexpr size_t O_PWKV = O_PRW + (size_t)4 * CSH;
constexpr size_t O_PFFN = O_PWKV + (size_t)4 * 16 * 4096;
constexpr size_t O_SK = O_PFFN + (size_t)4 * 2 * FF2;
constexpr size_t O_SV = O_SK + (size_t)MS * 1024;
constexpr size_t O_SRW = O_SV + (size_t)MS * 1024;
constexpr size_t O_SWKV = O_SRW + (size_t)MS * CSH;
constexpr size_t O_SFFN = O_SWKV + (size_t)MS * 16 * 4096;
constexpr size_t O_END = O_SFFN + (size_t)MS * 2 * FF2;

constexpr size_t al256(size_t x) { return (x + 255) & ~(size_t)255; }
constexpr size_t WS_WIN = 0;
constexpr size_t WS_WO = WS_WIN + al256((size_t)NIN * D * 2);
constexpr size_t WS_WUP = WS_WO + al256((size_t)D * D * 2);
constexpr size_t WS_WDN = WS_WUP + al256((size_t)FF2 * D * 2);
constexpr size_t WS_WLO = WS_WDN + al256((size_t)D * FF * 2);
constexpr size_t WS_H = WS_WLO + al256((size_t)NLO * KLO * 2);
constexpr size_t WS_QB = WS_H + al256((size_t)MPAD * D * 2);
constexpr size_t WS_KB = WS_QB + al256((size_t)MPAD * 1024 * 2);
constexpr size_t WS_VB = WS_KB + al256((size_t)MPAD * 1024 * 2);
constexpr size_t WS_ALO = WS_VB + al256((size_t)MPAD * 1024 * 2);
constexpr size_t WS_O = WS_ALO + al256((size_t)MPAD * KLO * 2);
constexpr size_t WS_GB = WS_O + al256((size_t)MPAD * D * 2);
constexpr size_t WS_YL = WS_GB + al256((size_t)MT * 2048 * 2);
constexpr size_t WS_QS = WS_YL + al256((size_t)MP * 1024 * 2);
constexpr size_t WS_ZP = WS_QS + al256((size_t)MP * 1024 * 2);
constexpr size_t WS_SST = WS_ZP + al256((size_t)64 * NS * 2 * 4096 * 4);
constexpr size_t WS_X1 = WS_SST + al256((size_t)64 * NS * 4096 * 4);
constexpr size_t WS_PML = WS_X1 + al256((size_t)MPAD * D * 4);
constexpr size_t WS_RA = WS_PML + al256((size_t)3 * MP * 16 * 2 * 4);
constexpr size_t WS_RW = WS_RA;
constexpr size_t WS_L = WS_RW + al256((size_t)MPAD * CSH * 2);
constexpr size_t RA_BYTES_1 = al256((size_t)MPAD * CSH * 2) + al256((size_t)MPAD * NLO * 2);
constexpr size_t RA_BYTES_2 = al256((size_t)MPAD * FF2 * 2);
constexpr size_t WS_U = WS_RA;
constexpr size_t WS_RB = WS_RA + (RA_BYTES_1 > RA_BYTES_2 ? RA_BYTES_1 : RA_BYTES_2);
constexpr size_t WS_PART = WS_RB;
constexpr size_t WS_ACT = WS_RB;
constexpr size_t RB_BYTES_1 = al256((size_t)3 * MP * 1024 * 2);
constexpr size_t RB_BYTES_2 = al256((size_t)MPAD * FF * 2);
constexpr size_t WS_RSS = WS_RB + (RB_BYTES_1 > RB_BYTES_2 ? RB_BYTES_1 : RB_BYTES_2);
constexpr size_t WS_BAR_ = 0; constexpr size_t WS_BAR = al256((size_t)MPAD * 4) + WS_RB + (RB_BYTES_1 > RB_BYTES_2 ? RB_BYTES_1 : RB_BYTES_2);
constexpr size_t BAR_BYTES = 16384;
constexpr size_t WS_END = WS_BAR + BAR_BYTES;

struct Args {
    const float* in[28];
    float* out;
    unsigned char* ws;
    int ph_lo, ph_hi;
};
enum { I_XP = 0, I_XS, I_CK, I_CV, I_SSH, I_SWKV, I_SFFN, I_NMG, I_WIN, I_AOG, I_MU, I_W0, I_WUP, I_A0, I_AUP, I_GUP,
       I_KK, I_KA, I_RK, I_LNW, I_LNB, I_WO, I_NFG, I_FUP, I_FCW, I_FCB, I_FDN, I_NFIN };

typedef float f32x2c __attribute__((ext_vector_type(2)));
typedef __bf16 bf16x2c __attribute__((ext_vector_type(2)));
DI unsigned pk2(float lo, float hi) { const f32x2c v = {lo, hi}; return __builtin_bit_cast(unsigned, __builtin_convertvector(v, bf16x2c)); }
DI unsigned bf_rne(float f) { return pk2(f, 0.f) & 0xffffu; }
DI unsigned cvt_pk(float lo, float hi) { return pk2(lo, hi); }
DI void atomic_add_f32(float* p, float v) { (void)__builtin_amdgcn_global_atomic_fadd_f32((__attribute__((address_space(1))) float*)p, v); }
DI float bf2f(unsigned short b) { return __uint_as_float(((unsigned)b) << 16); }
#define DPP_ADD(v, ctrl) ((v) + __int_as_float(__builtin_amdgcn_update_dpp(0, __float_as_int(v), (ctrl), 0xf, 0xf, false)))
DI float wave_sum(float v) {
    v = DPP_ADD(v, 0xB1);
    v = DPP_ADD(v, 0x4E);
    v = DPP_ADD(v, 0x141);
    v = DPP_ADD(v, 0x140);
    const float s0 = __int_as_float(__builtin_amdgcn_readlane(__float_as_int(v), 0)), s1 = __int_as_float(__builtin_amdgcn_readlane(__float_as_int(v), 16));
    const float s2 = __int_as_float(__builtin_amdgcn_readlane(__float_as_int(v), 32)), s3 = __int_as_float(__builtin_amdgcn_readlane(__float_as_int(v), 48));
    return (s0 + s1) + (s2 + s3);
}

namespace pg8 {
constexpr int BM = 256, BK = 64, HALF = 128, HTB = HALF * BK * 2, STAGE_BYTES = 8 * HTB, NXCD = 8, WGM = 8;
DI int lds_byte(int r, int c) { const int st = (r >> 4) * 2 + (c >> 5), rr = r & 15, cc = c & 31, ob = rr * 64 + cc * 2; return st * 1024 + (ob ^ (((ob >> 9) & 1) << 5)); }
DI void stage_rc(int b, int& R, int& C) { const int st = b / 1024, sb = b % 1024, swz = sb ^ (((sb >> 9) & 1) << 5); R = (st >> 1) * 16 + swz / 64; C = (st & 1) * 32 + (swz % 64) / 2; }
struct Unit { int pm, pn; };
struct Gemm { const bf16_t* A; const bf16_t* Bt; int M, N, K; };
struct StaticOrder {
    int nM, nN, nwg, G, c;
    DI void init(int M, int N, int G_, int c_) { nM = M / BM; nN = N / BM; nwg = nM * nN; G = G_; c = c_; }
    DI bool next(int i, Unit& u) const {
        const long L = (long)i * G + c; if (L >= nwg) return false;
        int wgid = (int)L; { const int q = nwg / NXCD, r = nwg % NXCD, xcd = wgid % NXCD, off = wgid / NXCD; wgid = (xcd < r ? xcd * (q + 1) : r * (q + 1) + (xcd - r) * q) + off; }
        const int nig = WGM * nN, gid = wgid / nig, fm = gid * WGM, gsz = (nM - fm) < WGM ? (nM - fm) : WGM;
        u.pm = fm + ((wgid % nig) % gsz); u.pn = (wgid % nig) / gsz; return true;
    }
};

template <class Epi>
DI void gemm_phase(LAS unsigned char* lds, const Gemm g, const StaticOrder& S, const Epi& E) {
    const int tid = threadIdx.x, wid = __builtin_amdgcn_readfirstlane(tid >> 6), lane = tid & 63, wr = wid >> 2, wc = wid & 3, fr = lane & 15, fq = lane >> 4;
    const int K = g.K, nt = K / BK;
    unsigned voffA[2];
#pragma unroll
    for (int i = 0; i < 2; ++i) { int R, C; stage_rc(tid * 16 + i * 8192, R, C); voffA[i] = (unsigned)(R * K + C) * 2u; }
    const size_t kstep = (size_t)(BK * 2);
    const size_t hstep = (size_t)HALF * K * 2;
    const size_t tstep = 2 * hstep;
    const unsigned ldsw = (unsigned)wid * 1024u;
    const int aoff = lds_byte(wr * 64 + fr, fq * 8), boff = lds_byte(wc * 32 + fr, fq * 8);
#define PG8_SA(b, h) (((b) * 2 + (h)) * HTB)
#define PG8_SB(b, h) ((4 + (b) * 2 + (h)) * HTB)
#define PG8_STAGE(bufoff, gbase, voff) do { _Pragma("unroll") for (int _i = 0; _i < 2; ++_i) \
        __builtin_amdgcn_global_load_lds((const unsigned*)((const char*)(gbase) + (voff)[_i]), (LAS unsigned*)(lds + (bufoff) + ldsw + _i * 8192), 16, 0, 0); } while (0)
#define PG8_LDA(dst, b, h) do { _Pragma("unroll") for (int m = 0; m < 4; ++m) _Pragma("unroll") for (int k = 0; k < 2; ++k) dst[m][k] = *(const LAS bf16x8*)(lds + PG8_SA(b, h) + aoff + m * 2048 + k * 1024); } while (0)
#define PG8_LDB(dst, b, h) do { _Pragma("unroll") for (int n = 0; n < 2; ++n) _Pragma("unroll") for (int k = 0; k < 2; ++k) dst[n][k] = *(const LAS bf16x8*)(lds + PG8_SB(b, h) + boff + n * 2048 + k * 1024); } while (0)
#define PG8_MMA(ai, bj, At, Bt) do { __builtin_amdgcn_s_setprio(1); _Pragma("unroll") for (int m = 0; m < 4; ++m) _Pragma("unroll") for (int n = 0; n < 2; ++n) _Pragma("unroll") for (int k = 0; k < 2; ++k) \
        acc[ai][bj][m][n] = __builtin_amdgcn_mfma_f32_16x16x32_bf16(Bt[n][k], At[m][k], acc[ai][bj][m][n], 0, 0, 0); __builtin_amdgcn_s_setprio(0); } while (0)
#define PG8_WAIT_V(n) asm volatile("s_waitcnt vmcnt(" #n ")" ::: "memory")
#define PG8_WAIT_L(n) asm volatile("s_waitcnt lgkmcnt(" #n ")" ::: "memory")
#define PG8_BAR __builtin_amdgcn_s_barrier()
#define PG8_SCHED __builtin_amdgcn_sched_barrier(0)
    Unit cur, nxt; int ui = 0;
    if (!S.next(0, cur)) return;
    f32x4 acc[2][2][4][2];
#pragma unroll
    for (int a = 0; a < 2; ++a)
#pragma unroll
        for (int b = 0; b < 2; ++b)
#pragma unroll
            for (int m = 0; m < 4; ++m)
#pragma unroll
                for (int n = 0; n < 2; ++n) acc[a][b][m][n] = (f32x4){0.f, 0.f, 0.f, 0.f};
    bf16x8 At[4][2], B0[2][2], B1[2][2];
    const char* cA = (const char*)g.A + (size_t)cur.pm * tstep; const char* cB = (const char*)g.Bt + (size_t)cur.pn * tstep;
    PG8_STAGE(PG8_SB(0, 0), cB, voffA); PG8_STAGE(PG8_SA(0, 0), cA, voffA); PG8_STAGE(PG8_SB(0, 1), cB + hstep, voffA); PG8_STAGE(PG8_SA(0, 1), cA + hstep, voffA);
    if (wr == 1) PG8_BAR;
    PG8_WAIT_V(4); PG8_BAR;
    PG8_STAGE(PG8_SB(1, 0), cB + kstep, voffA); PG8_STAGE(PG8_SA(1, 0), cA + kstep, voffA); PG8_STAGE(PG8_SB(1, 1), cB + hstep + kstep, voffA);
    PG8_WAIT_V(6); PG8_BAR;
    for (;;) {
        const bool has_next = S.next(ui + 1, nxt);
        const char* nA = has_next ? (const char*)g.A + (size_t)nxt.pm * tstep : cA; const char* nB = has_next ? (const char*)g.Bt + (size_t)nxt.pn * tstep : cB;
        for (int t = 0; t < nt; t += 2) {
            const bool last = (t == nt - 2);
            const char* a1 = cA + (size_t)(t + 1) * kstep;
            const char* a2 = last ? nA : cA + (size_t)(t + 2) * kstep; const char* b2 = last ? nB : cB + (size_t)(t + 2) * kstep;
            const char* a3 = a2 + kstep; const char* b3 = b2 + kstep;
            PG8_LDB(B0, 0, 0); PG8_SCHED; PG8_LDA(At, 0, 0); PG8_STAGE(PG8_SA(1, 1), a1 + hstep, voffA);
            PG8_WAIT_L(8); PG8_BAR; PG8_WAIT_L(0); PG8_MMA(0, 0, At, B0); PG8_BAR; PG8_SCHED;
            PG8_LDB(B1, 0, 1); PG8_STAGE(PG8_SB(0, 0), b2, voffA);
            PG8_BAR; PG8_WAIT_L(0); PG8_MMA(0, 1, At, B1); PG8_BAR;
            PG8_LDA(At, 0, 1); PG8_STAGE(PG8_SA(0, 0), a2, voffA);
            PG8_BAR; PG8_WAIT_L(0); PG8_MMA(1, 0, At, B0); PG8_BAR; PG8_SCHED;
            PG8_STAGE(PG8_SB(0, 1), b2 + hstep, voffA);
            PG8_WAIT_V(6); PG8_BAR; PG8_MMA(1, 1, At, B1); PG8_BAR;
            PG8_LDB(B0, 1, 0); PG8_SCHED; PG8_LDA(At, 1, 0); PG8_STAGE(PG8_SA(0, 1), a2 + hstep, voffA);
            PG8_WAIT_L(8); PG8_BAR; PG8_WAIT_L(0); PG8_MMA(0, 0, At, B0); PG8_BAR; PG8_SCHED;
            PG8_LDB(B1, 1, 1); PG8_STAGE(PG8_SB(1, 0), b3, voffA);
            PG8_BAR; PG8_WAIT_L(0); PG8_MMA(0, 1, At, B1); PG8_BAR;
            PG8_LDA(At, 1, 1); PG8_STAGE(PG8_SA(1, 0), a3, voffA);
            PG8_BAR; PG8_WAIT_L(0); PG8_MMA(1, 0, At, B0); PG8_BAR; PG8_SCHED;
            PG8_STAGE(PG8_SB(1, 1), b3 + hstep, voffA);
            PG8_WAIT_V(6); PG8_BAR; PG8_MMA(1, 1, At, B1); PG8_BAR;
        }
        E(acc, cur, wr, wc, fr, fq);
        if (!has_next) break;
#pragma unroll
        for (int a = 0; a < 2; ++a)
#pragma unroll
            for (int b = 0; b < 2; ++b)
#pragma unroll
                for (int m = 0; m < 4; ++m)
#pragma unroll
                    for (int n = 0; n < 2; ++n) acc[a][b][m][n] = (f32x4){0.f, 0.f, 0.f, 0.f};
        cur = nxt; cA = nA; cB = nB; ++ui;
    }
    PG8_WAIT_V(0);
    if (wr == 0) PG8_BAR;
    PG8_BAR;
#undef PG8_SA
#undef PG8_SB
#undef PG8_STAGE
#undef PG8_LDA
#undef PG8_LDB
#undef PG8_MMA
#undef PG8_WAIT_V
#undef PG8_WAIT_L
#undef PG8_BAR
#undef PG8_SCHED
}
}

DI size_t hm64(int row, int h)  { return ((size_t)((row >> 11) * 16 + h) * SEQ + (row & (SEQ - 1))) * 64; }
typedef f32x4 AccT[2][2][4][2];
#define EPI_LOOP_BEGIN \
    const int row0 = u.pm * 256 + wr * 64 + fr, col0 = u.pn * 256 + wc * 32 + 4 * fq; \
    _Pragma("unroll") for (int ai = 0; ai < 2; ++ai) _Pragma("unroll") for (int m = 0; m < 4; ++m) { const int row = row0 + ai * 128 + m * 16; \
    _Pragma("unroll") for (int bj = 0; bj < 2; ++bj) _Pragma("unroll") for (int n = 0; n < 2; ++n) { const int col = col0 + bj * 128 + n * 16; const f32x4 v = acc[ai][bj][m][n];
#define EPI_LOOP_END } }
#define EPI_LOOP_BEGIN_S \
    const int row0 = u.pm * 256 + wr * 64 + fr, col0 = u.pn * 256 + wc * 32 + 4 * fq; \
    _Pragma("unroll") for (int ai = 0; ai < 2; ++ai) _Pragma("unroll") for (int m = 0; m < 4; ++m) { const int row = row0 + ai * 128 + m * 16; \
    _Pragma("unroll") for (int bj = 0; bj < 2; ++bj) _Pragma("unroll") for (int n = 0; n < 2; ++n) { const int col = col0 + bj * 128 + n * 16; const f32x4 v = acc[ai][bj][m][n] * rs[ai][m];

struct EpiIn {
    bf16_t *Qb, *Kb, *Vb; bf16_t* RW; float* out;
    DI void operator()(const AccT& acc, const pg8::Unit& u, int wr, int wc, int fr, int fq) const {
        const int reg = u.pn < 4 ? 0 : (u.pn < 8 ? 1 : (u.pn < 12 ? 2 : 3));
        EPI_LOOP_BEGIN
            if (row < MT) {
                if (reg == 0) {
                    constexpr float QS_ = 0.125f * 1.44269504088896f;
                    u32x2 w; w.x = cvt_pk(v[0] * QS_, v[1] * QS_); w.y = cvt_pk(v[2] * QS_, v[3] * QS_);
                    *(u32x2*)(row < MP ? Qb + hm64(row, col >> 6) + (col & 63) : Qb + (size_t)row * 1024 + col) = w;
                } else if (reg == 1 || reg == 2) {
                    const int c = col - (reg == 1 ? 1024 : 2048);
                    float* o = row < MP ? out + (reg == 1 ? O_PK : O_PV) + (size_t)row * 1024 + c : out + (reg == 1 ? O_SK : O_SV) + (size_t)(row - MP) * 1024 + c;
                    __builtin_nontemporal_store(v, (f32x4*)o);
                    if (row < MP) { u32x2 w; w.x = cvt_pk(v[0], v[1]); w.y = cvt_pk(v[2], v[3]);
                        *(u32x2*)((reg == 1 ? Kb : Vb) + hm64(row, c >> 6) + (c & 63)) = w; }
                } else {
                    const int c = col - 3072;
                    if (c < CSH) {
                        { u32x2 w; w.x = cvt_pk(v[0], v[1]); w.y = cvt_pk(v[2], v[3]); *(u32x2*)(RW + (size_t)row * CSH + c) = w; }
                        if (row >= MP) *(f32x4*)(out + O_SRW + (size_t)(row - MP) * CSH + c) = v;
                        else if ((row & (SEQ - 1)) == SEQ - 1) *(f32x4*)(out + O_PRW + (size_t)(row >> 11) * CSH + c) = v;
                    }
                }
            }
        EPI_LOOP_END
    }
};
struct EpiBf {
    bf16_t* C; int ldc;
    DI void operator()(const AccT& acc, const pg8::Unit& u, int wr, int wc, int fr, int fq) const {
        const int row0 = u.pm * 256 + wr * 64 + fr, col0 = u.pn * 256 + wc * 32 + 4 * fq;
#pragma unroll
        for (int ai = 0; ai < 2; ++ai)
#pragma unroll
            for (int m = 0; m < 4; ++m) { const int row = row0 + ai * 128 + m * 16;
#pragma unroll
                for (int bj = 0; bj < 2; ++bj)
#pragma unroll
                    for (int n = 0; n < 2; ++n) { const int col = col0 + bj * 128 + n * 16; const f32x4 v = acc[ai][bj][m][n];
                        u32x2 w; w.x = cvt_pk(v[0], v[1]); w.y = cvt_pk(v[2], v[3]);
                        *(u32x2*)(C + (size_t)row * ldc + col) = w; }
                asm volatile("" ::: "memory");
            }
    }
};
struct EpiWo {
    const float *xp; const float* gf; float* X1; bf16_t* H; float* RSS;
    DI void operator()(const AccT& acc, const pg8::Unit& u, int wr, int wc, int fr, int fq) const {
        const int row0 = u.pm * 256 + wr * 64 + fr, col0 = u.pn * 256 + wc * 32 + 4 * fq;
        f32x4 gg[2][2];
#pragma unroll
        for (int bj = 0; bj < 2; ++bj)
#pragma unroll
            for (int n = 0; n < 2; ++n) gg[bj][n] = *(const f32x4*)(gf + col0 + bj * 128 + n * 16);
        float ssr[2][4];
#pragma unroll
        for (int aim = 0; aim < 4; ++aim) {
            const int ai = aim >> 1;
            f32x4 xr[4][2][2];
#pragma unroll
            for (int m = 2 * (aim & 1); m < 2 * (aim & 1) + 2; ++m)
#pragma unroll
                for (int bj = 0; bj < 2; ++bj)
#pragma unroll
                    for (int n = 0; n < 2; ++n) xr[m][bj][n] = __builtin_nontemporal_load((const f32x4*)(xp + (size_t)(row0 + ai * 128 + m * 16) * D + col0 + bj * 128 + n * 16));
            asm volatile("" ::: "memory");
#pragma unroll
            for (int m = 2 * (aim & 1); m < 2 * (aim & 1) + 2; ++m) {
                const int row = row0 + ai * 128 + m * 16; float ss = 0.f;
#pragma unroll
                for (int bj = 0; bj < 2; ++bj)
#pragma unroll
                    for (int n = 0; n < 2; ++n) {
                        const int col = col0 + bj * 128 + n * 16;
                        const f32x4 x1 = xr[m][bj][n] + acc[ai][bj][m][n];
                        *(f32x4*)(X1 + (size_t)row * D + col) = x1;
                        u32x2 w; w.x = cvt_pk(x1[0] * gg[bj][n][0], x1[1] * gg[bj][n][1]); w.y = cvt_pk(x1[2] * gg[bj][n][2], x1[3] * gg[bj][n][3]);
                        *(u32x2*)(H + (size_t)row * D + col) = w;
                        ss += (x1[0] * x1[0] + x1[1] * x1[1]) + (x1[2] * x1[2] + x1[3] * x1[3]);
                    }
                ssr[ai][m] = ss;
            }
            asm volatile("" ::: "memory");
        }
#pragma unroll
        for (int ai = 0; ai < 2; ++ai)
#pragma unroll
            for (int m = 0; m < 4; ++m) { float ss = ssr[ai][m]; ss += __shfl_xor(ss, 16); ss += __shfl_xor(ss, 32); ssr[ai][m] = ss; }
        if (fq == 0) {
#pragma unroll
            for (int ai = 0; ai < 2; ++ai)
#pragma unroll
                for (int m = 0; m < 4; ++m) atomic_add_f32(RSS + row0 + ai * 128 + m * 16, ssr[ai][m]);
        }
    }
};
#define DPP_MOV(v, ctrl) __int_as_float(__builtin_amdgcn_update_dpp(0, __float_as_int(v), (ctrl), 0xf, 0xf, false))
#define DPP_SHR(oldv, v, ctrl) __int_as_float(__builtin_amdgcn_update_dpp(__float_as_int(oldv), __float_as_int(v), (ctrl), 0xf, 0xf, false))
struct EpiUpF {
    bf16_t* ACT; float* out; const float* RSS; const float* cw; const float* cb; float* EDGE; LAS float* xch;
    DI void operator()(const AccT& acc, const pg8::Unit& u, int wr, int wc, int fr, int fq) const {
        const int wave = wr * 4 + wc, row0 = u.pm * 256 + wr * 64 + fr, f0 = u.pn * 128 + wc * 32 + 4 * fq;
#define UPF_RS(ai_, m_) rsqrtf(RSS[row0 + (ai_) * 128 + (m_) * 16] * (1.f / D) + 1e-6f)
        LAS float* taps = xch + 2048; LAS float* rstd = xch + 3072;
        {
            const int tid = wave * 64 + fq * 16 + fr;
#pragma unroll
            for (int q = 0; q < 2; ++q) { const int idx = tid + 512 * q, which = idx >> 7, col = (which >= 4 ? FF : 0) + u.pn * 128 + (idx & 127);
                taps[idx] = (which & 3) < 3 ? cw[(which & 3) * FF2 + col] : cb[col]; }
            if (tid < 256) rstd[tid] = rsqrtf(RSS[u.pm * 256 + tid] * (1.f / D) + 1e-6f);
        }
        if (fr >= 14) {
#pragma unroll
            for (int ai = 0; ai < 2; ++ai)
#pragma unroll
                for (int bj = 0; bj < 2; ++bj)
#pragma unroll
                    for (int n = 0; n < 2; ++n)
                        *(LAS f32x4*)(xch + wave * 256 + ((((ai * 2 + (fr - 14)) * 2 + bj) * 2 + n) * 4 + fq) * 4) = acc[ai][bj][3][n] * UPF_RS(ai, 3);
        }
        asm volatile("s_waitcnt lgkmcnt(0)" ::: "memory"); __builtin_amdgcn_s_barrier(); asm volatile("" ::: "memory");
        __builtin_amdgcn_s_barrier(); asm volatile("" ::: "memory");
        const bool prompt = u.pm < MP / 256;
#pragma unroll
        for (int n = 0; n < 2; ++n) {
            const int f = f0 + 16 * n;
            asm volatile("" ::: "memory");
            const int fl = wc * 32 + 16 * n + 4 * fq;
#pragma unroll
            for (int ai = 0; ai < 2; ++ai) {
                const bool have = (wr == 1) || (ai == 1);
                const int nbw = wr == 1 ? wave - 4 : wave + 4, nai = wr == 1 ? ai : 0;
                f32x4 pg = {0.f, 0.f, 0.f, 0.f}, pv = {0.f, 0.f, 0.f, 0.f};
                if (have && fr >= 14) {
                    pg = *(const LAS f32x4*)(xch + nbw * 256 + ((((nai * 2 + (fr - 14)) * 2 + 0) * 2 + n) * 4 + fq) * 4);
                    pv = *(const LAS f32x4*)(xch + nbw * 256 + ((((nai * 2 + (fr - 14)) * 2 + 1) * 2 + n) * 4 + fq) * 4);
                }
#pragma unroll
                for (int m = 0; m < 4; ++m) {
                    const int row = row0 + ai * 128 + m * 16;
                    const float rsm = rstd[wr * 64 + ai * 128 + m * 16 + fr];
                    const f32x4 g = acc[ai][0][m][n] * rsm, v = acc[ai][1][m][n] * rsm;
                    float o[4];
                    asm volatile("" ::: "memory");
#pragma unroll
                    for (int e = 0; e < 4; ++e) {
                        const float g1 = DPP_SHR(DPP_MOV(pg[e], 0x121), g[e], 0x111), g2 = DPP_SHR(DPP_MOV(pg[e], 0x122), g[e], 0x112);
                        const float cg = taps[384 + fl + e] + taps[fl + e] * g2 + taps[128 + fl + e] * g1 + taps[256 + fl + e] * g[e];
                        o[e] = cg * __builtin_amdgcn_rcpf(1.f + __expf(-cg));
                    }
                    {
#pragma unroll
                        for (int e = 0; e < 4; ++e) {
                            const float v1 = DPP_SHR(DPP_MOV(pv[e], 0x121), v[e], 0x111), v2 = DPP_SHR(DPP_MOV(pv[e], 0x122), v[e], 0x112);
                            o[e] *= taps[896 + fl + e] + taps[512 + fl + e] * v2 + taps[640 + fl + e] * v1 + taps[768 + fl + e] * v[e];
                        }
                        asm volatile("" ::: "memory");
                    }
                    const int tr = wr * 64 + ai * 128 + m * 16 + fr;
                    if (prompt) {
                        u32x2 w; w.x = cvt_pk(o[0], o[1]); w.y = cvt_pk(o[2], o[3]);
                        *(u32x2*)((char*)ACT + ((unsigned)row * (unsigned)FF + (unsigned)f) * 2u) = w;
                    }
                    if (prompt ? (tr < 2 || tr >= 254) : tr < MS) {
                        const int er = prompt ? u.pm * 4 + (tr < 2 ? tr : tr - 252) : 128 + tr;
                        float* ed = (float*)((char*)EDGE + ((unsigned)er * (unsigned)FF2 + (unsigned)f) * 4u);
                        *(f32x4*)ed = g; *(f32x4*)(ed + FF) = v;
                    }
                    pg = g; pv = v;
                }
            }
        }
    }
#undef UPF_RS
};
#ifndef MK_P11_SCALE
#define MK_P11_SCALE 1.0f
#endif
struct EpiDn {
    float* X1;
    DI void operator()(const AccT& acc, const pg8::Unit& u, int wr, int wc, int fr, int fq) const {
        const int row0 = u.pm * 256 + wr * 64 + fr, col0 = u.pn * 256 + wc * 32 + 4 * fq;
#pragma unroll
        for (int ai = 0; ai < 2; ++ai) {
            f32x4 xr[4][2][2];
#pragma unroll
            for (int m = 0; m < 4; ++m)
#pragma unroll
                for (int bj = 0; bj < 2; ++bj)
#pragma unroll
                    for (int n = 0; n < 2; ++n) xr[m][bj][n] = *(const f32x4*)(X1 + (size_t)(row0 + ai * 128 + m * 16) * D + col0 + bj * 128 + n * 16);
            asm volatile("" ::: "memory");
#pragma unroll
            for (int m = 0; m < 4; ++m)
#pragma unroll
                for (int bj = 0; bj < 2; ++bj)
#pragma unroll
                    for (int n = 0; n < 2; ++n) *(f32x4*)(X1 + (size_t)(row0 + ai * 128 + m * 16) * D + col0 + bj * 128 + n * 16) = xr[m][bj][n] + acc[ai][bj][m][n] * MK_P11_SCALE;
            asm volatile("" ::: "memory");
        }
    }
};

template <bool UPPERM = false, bool NTST = false>
DI void transpose_item(const float* W, int K, int N, bf16_t* WT, int ldt, float* scr, int item, int lane) {
    const int nblk = N / 32, kb = item / nblk, nb = item % nblk, k0 = 64 * kb, n0 = 32 * nb;
    const int d0 = UPPERM ? (((n0 < FF ? n0 : n0 - FF) >> 7) * 256 + (n0 < FF ? 0 : 128) + ((n0 < FF ? n0 : n0 - FF) & 127)) : n0;
    {
        f32x4 v[8];
#pragma unroll
        for (int i = 0; i < 8; ++i) v[i] = __builtin_nontemporal_load((const f32x4*)(W + (size_t)(k0 + 8 * i + (lane >> 3)) * N + n0 + 4 * (lane & 7)));
#pragma unroll
        for (int i = 0; i < 8; ++i) { float* d = scr + (8 * i + (lane >> 3)) * 33 + 4 * (lane & 7); d[0] = v[i].x; d[1] = v[i].y; d[2] = v[i].z; d[3] = v[i].w; }
    }
    __builtin_amdgcn_fence(__ATOMIC_RELEASE, "wavefront"); asm volatile("s_waitcnt lgkmcnt(0)" ::: "memory");
    const int c = lane & 7;
#pragma unroll
    for (int j = 0; j < 4; ++j) { const int n = (lane >> 3) + 8 * j; const float* s = scr + (8 * c) * 33 + n;
        u32x4 o; o.x = pk2(s[0 * 33], s[1 * 33]); o.y = pk2(s[2 * 33], s[3 * 33]); o.z = pk2(s[4 * 33], s[5 * 33]); o.w = pk2(s[6 * 33], s[7 * 33]);
        if (NTST) __builtin_nontemporal_store(o, (u32x4*)(WT + (size_t)(d0 + n) * ldt + k0 + 8 * c));
        else *(u32x4*)(WT + (size_t)(d0 + n) * ldt + k0 + 8 * c) = o; }
    asm volatile("s_waitcnt lgkmcnt(0)" ::: "memory");
}
DI void rms_row_bf16(const float* xrow, const float* g, bf16_t* orow, int lane) {
    const f32x4* xr = (const f32x4*)xrow + lane; const f32x4* gr = (const f32x4*)g + lane;
    f32x4 v[8]; float s = 0.f;
#pragma unroll
    for (int j = 0; j < 8; ++j) { v[j] = __builtin_nontemporal_load(xr + 64 * j); s += (v[j].x * v[j].x + v[j].y * v[j].y) + (v[j].z * v[j].z + v[j].w * v[j].w); }
    const float rstd = rsqrtf(wave_sum(s) * (1.f / D) + 1e-6f);
    u32x2* o8 = (u32x2*)orow + lane;
    f32x4 ggs[8];
#pragma unroll
    for (int j = 0; j < 8; ++j) ggs[j] = gr[64 * j];
#pragma unroll
    for (int j = 0; j < 8; ++j) { const f32x4 gg = ggs[j]; u32x2 w; w.x = pk2(v[j].x * rstd * gg.x, v[j].y * rstd * gg.y); w.y = pk2(v[j].z * rstd * gg.z, v[j].w * rstd * gg.w); o8[64 * j] = w; }
}
DI void rms_row_f32(const float* xrow, const float* g, float* orow, int lane) {
    const f32x4* xr = (const f32x4*)xrow + lane; const f32x4* gr = (const f32x4*)g + lane;
    f32x4 v[8]; float s = 0.f;
#pragma unroll
    for (int j = 0; j < 8; ++j) { v[j] = __builtin_nontemporal_load(xr + 64 * j); s += (v[j].x * v[j].x + v[j].y * v[j].y) + (v[j].z * v[j].z + v[j].w * v[j].w); }
    const float rstd = rsqrtf(wave_sum(s) * (1.f / D) + 1e-6f);
    f32x4* o = (f32x4*)orow + lane;
    f32x4 ggs[8];
#pragma unroll
    for (int j = 0; j < 8; ++j) ggs[j] = gr[64 * j];
#pragma unroll
    for (int j = 0; j < 8; ++j) __builtin_nontemporal_store(v[j] * rstd * ggs[j], o + 64 * j);
}
DI void zero_row_bf16(bf16_t* orow, int ncols, int lane) {
    for (int c = lane * 8; c < ncols; c += 512) *(u32x4*)(orow + c) = (u32x4){0u, 0u, 0u, 0u};
}

DI void phase_prologue(const Args& a, unsigned char* lds, int gw, int ngw, int lane, int wave) {
    unsigned char* ws = a.ws;
    float* scr = (float*)(lds + wave * 16384);
    bf16_t* Win = (bf16_t*)(ws + WS_WIN); bf16_t* Wlo = (bf16_t*)(ws + WS_WLO);
    constexpr int IT_IN = (D / 64) * (CIN / 32);
    for (int it = gw; it < IT_IN; it += ngw) transpose_item(a.in[I_WIN], D, CIN, Win, D, scr, it, lane);
    for (int r = CIN + gw; r < NIN; r += ngw) zero_row_bf16(Win + (size_t)r * D, D, lane);
    {
        const int gt = gw * 64 + lane, ngt = ngw * 64;
        for (int i = gt; i < NLO * KLO; i += ngt) {
            const int n = i / KLO, k = i % KLO; float v = 0.f;
            if (n < 1024) { if (k < 64) v = a.in[I_WUP][k * 1024 + n]; }
            else if (n < 2048) { if (k >= 64 && k < 128) v = a.in[I_AUP][(k - 64) * 1024 + (n - 1024)]; }
            else { if (k >= 128 && k < 288) v = a.in[I_GUP][(k - 128) * 1024 + (n - 2048)]; }
            Wlo[i] = (bf16_t)bf_rne(v);
        }
    }
    { float* RSS = (float*)(ws + WS_RSS); for (int i = gw * 64 + lane; i < MPAD; i += ngw * 64) RSS[i] = 0.f; }
    bf16_t* H = (bf16_t*)(ws + WS_H);
    for (int m = gw; m < MPAD; m += ngw) {
        if (m < MT) rms_row_bf16(m < MP ? a.in[I_XP] + (size_t)m * D : a.in[I_XS] + (size_t)(m - MP) * D, a.in[I_NMG], H + (size_t)m * D, lane);
        else zero_row_bf16(H + (size_t)m * D, D, lane);
    }
}


DI void convert_wo_wup(const Args& a, unsigned char* lds, int wi, int nw, int wave, int lane) {
    float* scr = (float*)(lds + wave * 16384);
    constexpr int IT_O = (D / 64) * (D / 32), IT_UP = (D / 64) * (FF2 / 32);
    for (int it = wi; it < IT_O + IT_UP; it += nw) {
        if (it < IT_O) transpose_item<false, true>(a.in[I_WO], D, D, (bf16_t*)(a.ws + WS_WO), D, scr, it, lane);
        else transpose_item<true, true>(a.in[I_FUP], D, FF2, (bf16_t*)(a.ws + WS_WUP), D, scr, it - IT_O, lane);
    }
}
DI void convert_wdn(const Args& a, unsigned char* lds, int wi, int nw, int wave, int lane) {
    float* scr = (float*)(lds + wave * 16384);
    constexpr int IT_DN = (FF / 64) * (D / 32);
    for (int it = wi; it < IT_DN; it += nw) transpose_item<false, true>(a.in[I_FDN], FF, D, (bf16_t*)(a.ws + WS_WDN), FF, scr, it, lane);
}

DI float rw_prev_val(const Args& a, const bf16_t* RW, int m, int j) {
    if (m < MP) return (m & (SEQ - 1)) == 0 ? 0.f : bf2f(RW[(size_t)(m - 1) * CSH + j]);
    return a.in[I_SSH][(size_t)(m - MP) * CSH + j];
}
DI void lora_input_row(const Args& a, int m, int lane) {
    bf16_t* ALO = (bf16_t*)(a.ws + WS_ALO) + (size_t)m * KLO;
    if (m >= MT) { for (int c = lane; c < KLO; c += 64) ALO[c] = 0; return; }
    const bf16_t* RW = (const bf16_t*)(a.ws + WS_RW);
    const bf16_t* cur = RW + (size_t)m * CSH;
    float x[5], p[5], mu[5];
#pragma unroll
    for (int i = 0; i < 5; ++i) {
        const int c = lane + 64 * i; const bool ok = c < 288; const int j = 3072 + (ok ? c : 0);
        x[i] = bf2f(cur[j]); mu[i] = a.in[I_MU][j];
        p[i] = m < MP ? ((m & (SEQ - 1)) == 0 ? 0.f : bf2f(RW[(size_t)(m - 1) * CSH + j])) : a.in[I_SSH][(size_t)(m - MP) * CSH + j];
    }
#pragma unroll
    for (int i = 0; i < 6; ++i) {
        const int c = lane + 64 * i; float v = 0.f;
        if (i < 5 && c < 288) {
            const float xs = x[i < 5 ? i : 0] + mu[i < 5 ? i : 0] * (p[i < 5 ? i : 0] - x[i < 5 ? i : 0]);
            v = c < 64 ? 1.f - 2.f * __builtin_amdgcn_rcpf(1.f + __expf(2.f * xs)) : (c < 128 ? xs : __builtin_amdgcn_rcpf(1.f + __expf(-xs)));
        }
        ALO[c] = (bf16_t)bf_rne(v);
    }
}

DI int crow(int reg, int h) { return (reg & 3) + 8 * (reg >> 2) + 4 * h; }
typedef short s16x4 __attribute__((ext_vector_type(4)));
constexpr int VPITCH = 192;
DI void attn_prompt_unit(const Args& a, unsigned char* lds, int unit, int wave, int lane) {
    const bf16_t* Qb = (const bf16_t*)(a.ws + WS_QB); const bf16_t* Kb = (const bf16_t*)(a.ws + WS_KB); const bf16_t* Vb = (const bf16_t*)(a.ws + WS_VB);
    bf16_t* PO = (bf16_t*)(a.ws + WS_PART); float* PML = (float*)(a.ws + WS_PML);
    LAS unsigned char* img = (LAS unsigned char*)lds + wave * (32 * VPITCH);
    const int blk = unit & 63, br = (unit >> 6) % 3, bh = unit / 192, b = bh >> 4, h = bh & 15;
    const int rate = br == 0 ? 1 : (br == 1 ? 4 : 16), L = SEQ / rate, bpc = L / 32;
    const int rho = blk / bpc, l0 = (blk % bpc) * 32;
    const int r = lane & 31, hh = lane >> 5;
    const int mq = b * SEQ + rho + rate * (l0 + r);
    bf16x8 qf[4];
#pragma unroll
    for (int ks = 0; ks < 4; ++ks) qf[ks] = *(const bf16x8*)(Qb + ((size_t)bh * SEQ + rho + rate * (l0 + r)) * 64 + ks * 16 + 8 * hh);
    f32x16 o0, o1;
#pragma unroll
    for (int i = 0; i < 16; ++i) { o0[i] = 0.f; o1[i] = 0.f; }
    float mrun = -1e30f, lrun = 0.f;
    const int lq = l0 + r;
    const int c0 = l0 >= 128 ? 0 : (128 - l0) >> 5;
    const bf16_t* kbase = Kb + ((size_t)bh * SEQ + rho) * 64 + 8 * hh;
    const bf16_t* vbase = Vb + ((size_t)bh * SEQ + rho) * 64 + 8 * (lane & 7);
    bf16x8 kreg[4]; u32x4 vreg[4];
#define AT_PREFETCH(ch_) do { const int lk0_ = l0 - 128 + 32 * (ch_); \
        _Pragma("unroll") for (int ks = 0; ks < 4; ++ks) kreg[ks] = *(const bf16x8*)(kbase + (size_t)(rate * (lk0_ + r)) * 64 + ks * 16); \
        _Pragma("unroll") for (int i = 0; i < 4; ++i) vreg[i] = *(const u32x4*)(vbase + (size_t)(rate * (lk0_ + 8 * i + (lane >> 3))) * 64); } while (0)
    AT_PREFETCH(c0);
    const int i16 = lane & 15, tq = i16 >> 2, tp = i16 & 3, g16 = (lane >> 4) & 1;
    const unsigned troff = (unsigned)((4 * hh + tq) * VPITCH + g16 * 32 + 8 * tp);
    for (int ch = c0; ch < 5; ++ch) {
        const int lk0 = l0 - 128 + 32 * ch;
        bf16x8 kf[4];
#pragma unroll
        for (int ks = 0; ks < 4; ++ks) kf[ks] = kreg[ks];
#pragma unroll
        for (int i = 0; i < 4; ++i) *(LAS u32x4*)(img + (8 * i + (lane >> 3)) * VPITCH + 16 * (lane & 7)) = vreg[i];
        if (ch + 1 < 5) AT_PREFETCH(ch + 1);
        f32x16 st;
#pragma unroll
        for (int i = 0; i < 16; ++i) st[i] = 0.f;
#pragma unroll
        for (int ks = 0; ks < 4; ++ks) st = __builtin_amdgcn_mfma_f32_32x32x16_bf16(kf[ks], qf[ks], st, 0, 0, 0);
        float cmax = -1e30f;
        if (ch == 0 || ch == 4) {
#pragma unroll
            for (int i = 0; i < 16; ++i) { const int lk = lk0 + crow(i, hh); const bool ok = (lk <= lq) && (lk >= lq - 128); st[i] = ok ? st[i] : -1e30f; }
        }
#pragma unroll
        for (int i = 0; i < 16; ++i) cmax = fmaxf(cmax, st[i]);
        cmax = fmaxf(cmax, __shfl_xor(cmax, 32));
        const float mnew = fmaxf(mrun, cmax), alpha = __builtin_amdgcn_exp2f(mrun - mnew);
        float ps = 0.f;
#pragma unroll
        for (int i = 0; i < 16; ++i) { const float p = __builtin_amdgcn_exp2f(st[i] - mnew); st[i] = p; ps += p; }
        lrun = lrun * alpha + ps; mrun = mnew;
#pragma unroll
        for (int i = 0; i < 16; ++i) { o0[i] *= alpha; o1[i] *= alpha; }
#pragma unroll
        for (int s = 0; s < 2; ++s) {
            u32x4 pp; pp.x = pk2(st[8 * s], st[8 * s + 1]); pp.y = pk2(st[8 * s + 2], st[8 * s + 3]); pp.z = pk2(st[8 * s + 4], st[8 * s + 5]); pp.w = pk2(st[8 * s + 6], st[8 * s + 7]);
            const bf16x8 pf = __builtin_bit_cast(bf16x8, pp);
#pragma unroll
            for (int dt = 0; dt < 2; ++dt) {
                const s16x4 lo = __builtin_amdgcn_ds_read_tr16_b64_v4i16((LAS s16x4*)(img + troff + (16 * s) * VPITCH + dt * 64));
                const s16x4 hi = __builtin_amdgcn_ds_read_tr16_b64_v4i16((LAS s16x4*)(img + troff + (16 * s + 8) * VPITCH + dt * 64));
                const bf16x8 vf = __builtin_shufflevector(lo, hi, 0, 1, 2, 3, 4, 5, 6, 7);
                if (dt == 0) o0 = __builtin_amdgcn_mfma_f32_32x32x16_bf16(vf, pf, o0, 0, 0, 0);
                else o1 = __builtin_amdgcn_mfma_f32_32x32x16_bf16(vf, pf, o1, 0, 0, 0);
            }
        }
    }
#undef AT_PREFETCH
    const float ltot = lrun + __shfl_xor(lrun, 32);
    bf16_t* po = PO + ((size_t)br * MP + mq) * 1024 + h * 64;
#pragma unroll
    for (int g = 0; g < 4; ++g) {
        u32x2 w0, w1; w0.x = pk2(o0[4 * g], o0[4 * g + 1]); w0.y = pk2(o0[4 * g + 2], o0[4 * g + 3]); w1.x = pk2(o1[4 * g], o1[4 * g + 1]); w1.y = pk2(o1[4 * g + 2], o1[4 * g + 3]);
        *(u32x2*)(po + 8 * g + 4 * hh) = w0; *(u32x2*)(po + 32 + 8 * g + 4 * hh) = w1;
    }
    if (hh == 0) { float* pm = PML + (((size_t)br * MP + mq) * 16 + h) * 2; pm[0] = mrun; pm[1] = ltot; }
}
DI float sum16(float v) { v = DPP_ADD(v, 0xB1); v = DPP_ADD(v, 0x4E); v = DPP_ADD(v, 0x141); v = DPP_ADD(v, 0x140); return v; }
DI void attn_merge_task(const Args& a, int task, int lane) {
    const int m = task >> 2, h = (task & 3) * 4 + (lane >> 4), d = 4 * (lane & 15);
    const bf16_t* PO = (const bf16_t*)(a.ws + WS_PART); const float* PML = (const float*)(a.ws + WS_PML);
    bf16_t* O = (bf16_t*)(a.ws + WS_O);
    float mb[3], lb[3]; f32x4 ob[3];
#pragma unroll
    for (int br = 0; br < 3; ++br) { const float* pm = PML + (((size_t)br * MP + m) * 16 + h) * 2; mb[br] = pm[0]; lb[br] = pm[1];
        const u32x2 w = *(const u32x2*)(PO + ((size_t)br * MP + m) * 1024 + h * 64 + d);
        ob[br] = (f32x4){__uint_as_float(w.x << 16), __uint_as_float(w.x & 0xffff0000u), __uint_as_float(w.y << 16), __uint_as_float(w.y & 0xffff0000u)}; }
    const float M = fmaxf(mb[0], fmaxf(mb[1], mb[2]));
    f32x4 num = {0.f, 0.f, 0.f, 0.f}; float den = 0.f;
#pragma unroll
    for (int br = 0; br < 3; ++br) { const float w = __builtin_amdgcn_exp2f(mb[br] - M); num += ob[br] * w; den += w * lb[br]; }
    const f32x4 o = num * __builtin_amdgcn_rcpf(den);
    const float ss = sum16(o.x * o.x + o.y * o.y + o.z * o.z + o.w * o.w) * (1.f / 64.f);
    const float rs = rsqrtf(ss + 1e-6f);
    const f32x4 gg = *(const f32x4*)(a.in[I_AOG] + h * 64 + d);
    u32x2 w; w.x = pk2(o.x * rs * gg.x, o.y * rs * gg.y); w.y = pk2(o.z * rs * gg.z, o.w * rs * gg.w);
    *(u32x2*)(O + (size_t)m * D + h * 64 + d) = w;
}
DI void attn_sample_wg(const Args& a, unsigned char* lds, int unit, int wave, int lane) {
    float* part = (float*)lds;
    const int bh = unit * 2 + (wave >> 2), qt = wave & 3, b = bh >> 4, h = bh & 15, g = lane >> 4, l16 = lane & 15;
    const bf16_t* Qb = (const bf16_t*)(a.ws + WS_QB);
    const float* ck = a.in[I_CK] + (size_t)b * 2048 * 1024 + h * 64 + 4 * l16; const float* cv = a.in[I_CV] + (size_t)b * 2048 * 1024 + h * 64 + 4 * l16;
    const float* nk = a.out + O_SK + (size_t)b * 1024 + h * 64 + 4 * l16; const float* nv = a.out + O_SV + (size_t)b * 1024 + h * 64 + 4 * l16;
    const u32x2 qw = *(const u32x2*)(Qb + (size_t)(MP + b) * 1024 + h * 64 + 4 * l16);
    const float q0 = __uint_as_float(qw.x << 16), q1 = __uint_as_float(qw.x & 0xffff0000u), q2 = __uint_as_float(qw.y << 16), q3 = __uint_as_float(qw.y & 0xffff0000u);
    float mrun = -1e30f, lrun = 0.f; f32x4 acc = {0.f, 0.f, 0.f, 0.f};
    const int e0 = qt * 97, e1 = e0 + 97 < 387 ? e0 + 97 : 387;
    for (int ito = 0; ito < 25; ito += 5) {
        f32x4 kv[5], vv[5]; bool valid[5];
#pragma unroll
        for (int k = 0; k < 5; ++k) {
            const int e = e0 + (ito + k) * 4 + g; valid[k] = e < e1;
            const int ee = valid[k] ? e : e0, br = ee / 129, j = ee % 129, rate = br == 0 ? 1 : (br == 1 ? 4 : 16);
            const int row = 2048 - rate * j;
            const float* kp = j == 0 ? nk : ck + (size_t)row * 1024; const float* vp = j == 0 ? nv : cv + (size_t)row * 1024;
            kv[k] = __builtin_nontemporal_load((const f32x4*)kp); vv[k] = __builtin_nontemporal_load((const f32x4*)vp);
        }
#pragma unroll
        for (int k = 0; k < 5; ++k) {
            float s = sum16(q0 * kv[k].x + q1 * kv[k].y + q2 * kv[k].z + q3 * kv[k].w);
            if (!valid[k]) s = -1e30f;
            const float mnew = fmaxf(mrun, s), alpha = __builtin_amdgcn_exp2f(mrun - mnew), p = valid[k] ? __builtin_amdgcn_exp2f(s - mnew) : 0.f;
            lrun = lrun * alpha + p; acc = acc * alpha + vv[k] * p; mrun = mnew;
        }
    }
#pragma unroll
    for (int o = 16; o < 64; o <<= 1) {
        const float mo = __shfl_xor(mrun, o), lo = __shfl_xor(lrun, o);
        f32x4 ao; ao.x = __shfl_xor(acc.x, o); ao.y = __shfl_xor(acc.y, o); ao.z = __shfl_xor(acc.z, o); ao.w = __shfl_xor(acc.w, o);
        const float mn = fmaxf(mrun, mo), w0 = __builtin_amdgcn_exp2f(mrun - mn), w1 = __builtin_amdgcn_exp2f(mo - mn);
        lrun = lrun * w0 + lo * w1; acc = acc * w0 + ao * w1; mrun = mn;
    }
    if (g == 0) { *(f32x4*)(part + wave * 68 + 4 * l16) = acc; if (l16 == 0) { part[wave * 68 + 64] = mrun; part[wave * 68 + 65] = lrun; } }
    __syncthreads();
    if (qt == 0 && g == 0) {
        float M = -1e30f;
#pragma unroll
        for (int w = 0; w < 4; ++w) M = fmaxf(M, part[(wave + w) * 68 + 64]);
        f32x4 num = {0.f, 0.f, 0.f, 0.f}; float den = 0.f;
#pragma unroll
        for (int w = 0; w < 4; ++w) { const float wt = __builtin_amdgcn_exp2f(part[(wave + w) * 68 + 64] - M); num += *(const f32x4*)(part + (wave + w) * 68 + 4 * l16) * wt; den += part[(wave + w) * 68 + 65] * wt; }
        const f32x4 o = num * (1.f / den);
        const float ss = sum16(o.x * o.x + o.y * o.y + o.z * o.z + o.w * o.w);
        const float rs = rsqrtf(ss * (1.f / 64.f) + 1e-6f);
        const f32x4 gg = *(const f32x4*)(a.in[I_AOG] + h * 64 + 4 * l16);
        u32x2 w; w.x = pk2(o.x * rs * gg.x, o.y * rs * gg.y); w.y = pk2(o.z * rs * gg.z, o.w * rs * gg.w);
        *(u32x2*)((bf16_t*)(a.ws + WS_O) + (size_t)(MP + b) * D + h * 64 + 4 * l16) = w;
    }
    __syncthreads();
}

struct PrepParams { float mu_r, mu_k, mu_v, w0, a0, kk, ka, rk; };
struct PrepRaw { float cr, ck, cv, pr, pk, pv, lw, la, lg; };
DI void prep_params(const Args& a, PrepParams& P, int c) {
    P.mu_r = a.in[I_MU][c]; P.mu_k = a.in[I_MU][1024 + c]; P.mu_v = a.in[I_MU][2048 + c];
    P.w0 = a.in[I_W0][c]; P.a0 = a.in[I_A0][c]; P.kk = a.in[I_KK][c]; P.ka = a.in[I_KA][c]; P.rk = a.in[I_RK][c];
}
DI void prep_load(const Args& a, PrepRaw& R, const bf16_t* RW, int m, const bf16_t* Lrow, int c) {
    const bf16_t* cur = RW + (size_t)m * CSH;
    R.cr = bf2f(cur[c]); R.ck = bf2f(cur[1024 + c]); R.cv = bf2f(cur[2048 + c]);
    R.pr = rw_prev_val(a, RW, m, c); R.pk = rw_prev_val(a, RW, m, 1024 + c); R.pv = rw_prev_val(a, RW, m, 2048 + c);
    R.lw = bf2f(Lrow[c]); R.la = bf2f(Lrow[1024 + c]); R.lg = bf2f(Lrow[2048 + c]);
}
DI void prep_finish(const PrepRaw& R, const PrepParams& P, float* dst, float& g_out, float& bonus_out, int lane) {
    const float xr = R.cr + P.mu_r * (R.pr - R.cr), xk = R.ck + P.mu_k * (R.pk - R.ck), xv = R.cv + P.mu_v * (R.pv - R.cv);
    const float x = -(P.w0 + R.lw);
    const float sp = x > 20.f ? x : __logf(1.f + __expf(x));
    const float decay = __expf(-__expf(-sp - 0.5f));
    const float av = __builtin_amdgcn_rcpf(1.f + __expf(-(P.a0 + R.la)));
    float kkv = xk * P.kk;
    const float n2 = wave_sum(kkv * kkv);
    kkv = kkv * fminf(__builtin_amdgcn_rsqf(n2), 1e12f);
    const float keff = xk * (1.f + (av - 1.f) * P.ka);
    const float bon = wave_sum(xr * keff * P.rk) * xv;
    dst[lane] = xr; dst[64 + lane] = decay; dst[128 + lane] = keff; dst[192 + lane] = xv; dst[256 + lane] = -kkv; dst[320 + lane] = kkv * av;
    g_out = R.lg; bonus_out = bon;
}
DI float scan_step(float (&S)[64], const float* sv, float vi) {
    const f32x4* r4 = (const f32x4*)sv; const f32x4* w4 = (const f32x4*)(sv + 64); const f32x4* k4 = (const f32x4*)(sv + 128);
    const f32x4* a4 = (const f32x4*)(sv + 256); const f32x4* b4 = (const f32x4*)(sv + 320);
    float sa0 = 0.f, sa1 = 0.f;
#pragma unroll
    for (int j = 0; j < 16; ++j) { const f32x4 av = a4[j]; sa0 = fmaf(S[4 * j], av.x, sa0); sa1 = fmaf(S[4 * j + 1], av.y, sa1); sa0 = fmaf(S[4 * j + 2], av.z, sa0); sa1 = fmaf(S[4 * j + 3], av.w, sa1); }
    const float sa = sa0 + sa1;
    float y0 = 0.f, y1 = 0.f;
#pragma unroll
    for (int j = 0; j < 16; ++j) {
        const f32x4 bv = b4[j], kv = k4[j], wv = w4[j], rv = r4[j];
        float t;
        t = fmaf(vi, kv.x, sa * bv.x); S[4 * j] = fmaf(S[4 * j], wv.x, t); y0 = fmaf(S[4 * j], rv.x, y0);
        t = fmaf(vi, kv.y, sa * bv.y); S[4 * j + 1] = fmaf(S[4 * j + 1], wv.y, t); y1 = fmaf(S[4 * j + 1], rv.y, y1);
        t = fmaf(vi, kv.z, sa * bv.z); S[4 * j + 2] = fmaf(S[4 * j + 2], wv.z, t); y0 = fmaf(S[4 * j + 2], rv.z, y0);
        t = fmaf(vi, kv.w, sa * bv.w); S[4 * j + 3] = fmaf(S[4 * j + 3], wv.w, t); y1 = fmaf(S[4 * j + 3], rv.w, y1);
        if ((j & 3) == 3) asm volatile("" ::: "memory");
    }
    return y0 + y1;
}
DI void rwkv_post(const Args& a, float y, float g, float bonus, int m, int c) {
    const float mean = wave_sum(y) * (1.f / 64.f); const float d = y - mean; const float var = wave_sum(d * d) * (1.f / 64.f);
    const float yn = d * rsqrtf(var + 64e-5f) * a.in[I_LNW][c] + a.in[I_LNB][c];
    ((bf16_t*)(a.ws + WS_O))[(size_t)m * D + 1024 + c] = (bf16_t)bf_rne((yn + bonus) * g);
}

#define WG_BAR_LDS() do { asm volatile("s_waitcnt lgkmcnt(0)" ::: "memory"); __builtin_amdgcn_s_barrier(); asm volatile("" ::: "memory"); } while (0)
typedef float f32x2 __attribute__((ext_vector_type(2)));
DI f32x2 fma2(f32x2 a, f32x2 b, f32x2 c) { return __builtin_elementwise_fma(a, b, c); }
DI void scan_dot_a(const f32x2 (&Z)[32], const f32x2 (&P)[32], const float* sv, float& sz, float& sp) {
    const f32x4* a4 = (const f32x4*)(sv + 256);
    f32x2 saz = {0.f, 0.f}, sap = {0.f, 0.f};
#pragma unroll
    for (int j = 0; j < 16; ++j) { const f32x4 av = a4[j]; const f32x2 a0 = {av.x, av.y}, a1 = {av.z, av.w};
        saz = fma2(Z[2 * j], a0, saz); sap = fma2(P[2 * j], a0, sap); saz = fma2(Z[2 * j + 1], a1, saz); sap = fma2(P[2 * j + 1], a1, sap);
        if ((j & 7) == 7) asm volatile("" ::: "memory"); }
    sz = saz.x + saz.y; sp = sap.x + sap.y;
}
DI void scan_step3(f32x2 (&Z)[32], f32x2 (&P)[32], const float* sv, const float* svn, float vi, float& sz, float& sp, float& yz, float& yp) {
    const f32x4* r4 = (const f32x4*)sv; const f32x4* w4 = (const f32x4*)(sv + 64); const f32x4* k4 = (const f32x4*)(sv + 128);
    const f32x4* b4 = (const f32x4*)(sv + 320); const f32x4* an4 = (const f32x4*)(svn + 256);
    const f32x2 sz2 = {sz, sz}, sp2 = {sp, sp}, v2 = {vi, vi};
    f32x2 yz2 = {0.f, 0.f}, yp2 = {0.f, 0.f}, nz2 = {0.f, 0.f}, np2 = {0.f, 0.f};
    f32x4 buf[3][5];
#define S3_LD(g, j) do { buf[g][0] = b4[j]; buf[g][1] = k4[j]; buf[g][2] = w4[j]; buf[g][3] = r4[j]; buf[g][4] = an4[j]; asm volatile("" ::: "memory"); } while (0)
    S3_LD(0, 0); S3_LD(1, 1);
#pragma unroll
    for (int j = 0; j < 16; ++j) {
        if (j + 2 < 16) S3_LD((j + 2) % 3, j + 2);
        const f32x4 bv = buf[j % 3][0], kv = buf[j % 3][1], wv = buf[j % 3][2], rv = buf[j % 3][3], av = buf[j % 3][4];
        { const f32x2 b2 = {bv.x, bv.y}, k2 = {kv.x, kv.y}, w2 = {wv.x, wv.y}, r2 = {rv.x, rv.y}, a2 = {av.x, av.y};
          f32x2 tz = sz2 * b2; tz = fma2(v2, k2, tz); Z[2 * j] = fma2(Z[2 * j], w2, tz); yz2 = fma2(Z[2 * j], r2, yz2); nz2 = fma2(Z[2 * j], a2, nz2);
          const f32x2 tp = sp2 * b2; P[2 * j] = fma2(P[2 * j], w2, tp); yp2 = fma2(P[2 * j], r2, yp2); np2 = fma2(P[2 * j], a2, np2); }
        { const f32x2 b2 = {bv.z, bv.w}, k2 = {kv.z, kv.w}, w2 = {wv.z, wv.w}, r2 = {rv.z, rv.w}, a2 = {av.z, av.w};
          f32x2 tz = sz2 * b2; tz = fma2(v2, k2, tz); Z[2 * j + 1] = fma2(Z[2 * j + 1], w2, tz); yz2 = fma2(Z[2 * j + 1], r2, yz2); nz2 = fma2(Z[2 * j + 1], a2, nz2);
          const f32x2 tp = sp2 * b2; P[2 * j + 1] = fma2(P[2 * j + 1], w2, tp); yp2 = fma2(P[2 * j + 1], r2, yp2); np2 = fma2(P[2 * j + 1], a2, np2); }
        asm volatile("" ::: "memory");
    }
#undef S3_LD
    yz = yz2.x + yz2.y; yp = yp2.x + yp2.y; sz = nz2.x + nz2.y; sp = np2.x + np2.y;
}
DI void scan_pass1_unit(const Args& a, unsigned char* lds, int unit, int wave, int lane) {
    float* stg = (float*)lds;
    const int pp = wave & 3, pair = unit * 4 + pp, chain = pair / NS, seg = pair % NS, b = chain >> 4, h = chain & 15, c = h * 64 + lane;
    const int mbase = b * SEQ + seg * SEGL;
    constexpr int NB = SEGL / TB;
    if (wave < 4) {
        bf16_t* YL = (bf16_t*)(a.ws + WS_YL); bf16_t* QS = (bf16_t*)(a.ws + WS_QS); float* ZP = (float*)(a.ws + WS_ZP);
        f32x2 Z[32], P[32];
        int idl = lane; asm volatile("" : "+v"(idl));
#pragma unroll
        for (int j = 0; j < 32; ++j) { Z[j] = (f32x2){0.f, 0.f}; P[j] = (f32x2){idl == 2 * j ? 1.f : 0.f, idl == 2 * j + 1 ? 1.f : 0.f}; }
        WG_BAR_LDS();
        for (int blk = 0; blk < NB; ++blk) {
            const float* sb = stg + (((blk & 1) * 4 + pp) * TB) * 384;
            float sz, sp; scan_dot_a(Z, P, sb, sz, sp);
#pragma unroll 1
            for (int tt = 0; tt < TB; ++tt) {
                const float* sv = sb + tt * 384; const float* svn = sb + (tt + 1 < TB ? tt + 1 : tt) * 384;
                float yz, yp; scan_step3(Z, P, sv, svn, sv[192 + lane], sz, sp, yz, yp);
                const size_t o = (size_t)(mbase + blk * TB + tt) * 1024 + c;
                const unsigned yq = pk2(yz, yp); YL[o] = (bf16_t)(yq & 0xffffu); QS[o] = (bf16_t)(yq >> 16);
            }
            WG_BAR_LDS();
        }
        float* zp = ZP + (size_t)pair * 2 * 4096 + lane * 64;
#pragma unroll
        for (int j = 0; j < 16; ++j) { *(f32x4*)(zp + 4 * j) = (f32x4){Z[2 * j].x, Z[2 * j].y, Z[2 * j + 1].x, Z[2 * j + 1].y};
                                       *(f32x4*)(zp + 4096 + 4 * j) = (f32x4){P[2 * j].x, P[2 * j].y, P[2 * j + 1].x, P[2 * j + 1].y}; }
    } else {
        const bf16_t* RW = (const bf16_t*)(a.ws + WS_RW); const bf16_t* Lb = (const bf16_t*)(a.ws + WS_L);
        bf16_t* GB = (bf16_t*)(a.ws + WS_GB);
        PrepParams Pm; prep_params(a, Pm, c);
        PrepRaw raw[TB];
#define P1_LOAD(blk_) do { _Pragma("unroll") for (int k = 0; k < TB; ++k) { const int m = mbase + (blk_) * TB + k; prep_load(a, raw[k], RW, m, Lb + (size_t)m * NLO, c); } } while (0)
#define P1_FINISH(blk_) do { _Pragma("unroll") for (int k = 0; k < TB; ++k) { const int m = mbase + (blk_) * TB + k; float g, bon; \
            prep_finish(raw[k], Pm, stg + ((((blk_) & 1) * 4 + pp) * TB + k) * 384, g, bon, lane); \
            GB[((size_t)m * 16 + h) * 128 + lane] = (bf16_t)bf_rne(g); GB[((size_t)m * 16 + h) * 128 + 64 + lane] = (bf16_t)bf_rne(bon); } } while (0)
        P1_LOAD(0); P1_FINISH(0); P1_LOAD(1);
        WG_BAR_LDS();
        for (int blk = 0; blk < NB; ++blk) {
            if (blk + 1 < NB) P1_FINISH(blk + 1);
            if (blk + 2 < NB) P1_LOAD(blk + 2);
            WG_BAR_LDS();
        }
#undef P1_LOAD
#undef P1_FINISH
    }
}
DI void scan_sample_unit(const Args& a, unsigned char* lds, int unit, int wave, int lane) {
    float* sv = (float*)(lds + 2 * 4 * TB * 384 * 4) + wave * 384;
    const bf16_t* RW = (const bf16_t*)(a.ws + WS_RW); const bf16_t* Lb = (const bf16_t*)(a.ws + WS_L);
    const int b = unit >> 4, h = unit & 15, c = h * 64 + lane, m = MP + b;
    PrepParams P; prep_params(a, P, c);
    PrepRaw raw; prep_load(a, raw, RW, m, Lb + (size_t)m * NLO, c);
    float g, bon; prep_finish(raw, P, sv, g, bon, lane);
    float S[64];
    const float* s0 = a.in[I_SWKV] + ((size_t)(b * 16 + h) * 64 + lane) * 64;
#pragma unroll
    for (int j = 0; j < 16; ++j) { const f32x4 v = *(const f32x4*)(s0 + 4 * j); S[4 * j] = v.x; S[4 * j + 1] = v.y; S[4 * j + 2] = v.z; S[4 * j + 3] = v.w; }
    const float y = scan_step(S, sv, sv[192 + lane]);
    float* so = a.out + O_SWKV + ((size_t)(b * 16 + h) * 64 + lane) * 64;
#pragma unroll
    for (int j = 0; j < 16; ++j) *(f32x4*)(so + 4 * j) = (f32x4){S[4 * j], S[4 * j + 1], S[4 * j + 2], S[4 * j + 3]};
    rwkv_post(a, y, g, bon, m, c);
}
DI void scan_pass2_unit(const Args& a, unsigned char* lds, int chain, int wave, int lane) {
    float* Ssh = (float*)lds;
    float* Psh = Ssh + 64 * 65;
    const float* ZP = (const float*)(a.ws + WS_ZP); float* SST = (float*)(a.ws + WS_SST);
    const int tid = wave * 64 + lane, l16 = lane & 15, lq = lane >> 4, ib = wave >> 1, jb0 = 2 * (wave & 1);
    f32x4 S0 = {0.f, 0.f, 0.f, 0.f}, S1 = {0.f, 0.f, 0.f, 0.f};
    const float* Z0 = ZP + (size_t)(chain * NS) * 2 * 4096;
    f32x4 pn0 = *(const f32x4*)(Z0 + 4096 + tid * 8), pn1 = *(const f32x4*)(Z0 + 4096 + tid * 8 + 4);
    float zn0[4], zn1[4];
#pragma unroll
    for (int i = 0; i < 4; ++i) { zn0[i] = Z0[(16 * ib + 4 * lq + i) * 64 + 16 * jb0 + l16]; zn1[i] = Z0[(16 * ib + 4 * lq + i) * 64 + 16 * (jb0 + 1) + l16]; }
    for (int s = 0; s < NS; ++s) {
        float* sst = SST + ((size_t)chain * NS + s) * 4096;
#pragma unroll
        for (int i = 0; i < 4; ++i) { const int row = 16 * ib + 4 * lq + i;
            sst[row * 64 + 16 * jb0 + l16] = S0[i]; sst[row * 64 + 16 * (jb0 + 1) + l16] = S1[i];
            Ssh[row * 65 + 16 * jb0 + l16] = S0[i]; Ssh[row * 65 + 16 * (jb0 + 1) + l16] = S1[i]; }
        *(f32x4*)(Psh + tid * 8) = pn0; *(f32x4*)(Psh + tid * 8 + 4) = pn1;
        f32x4 n0 = {zn0[0], zn0[1], zn0[2], zn0[3]}, n1 = {zn1[0], zn1[1], zn1[2], zn1[3]};
        if (s + 1 < NS) {
            const float* Zs = ZP + (size_t)(chain * NS + s + 1) * 2 * 4096;
            pn0 = *(const f32x4*)(Zs + 4096 + tid * 8); pn1 = *(const f32x4*)(Zs + 4096 + tid * 8 + 4);
#pragma unroll
            for (int i = 0; i < 4; ++i) { zn0[i] = Zs[(16 * ib + 4 * lq + i) * 64 + 16 * jb0 + l16]; zn1[i] = Zs[(16 * ib + 4 * lq + i) * 64 + 16 * (jb0 + 1) + l16]; }
        }
        WG_BAR_LDS();
        if (s > 0) {
#pragma unroll
            for (int kk = 0; kk < 16; ++kk) {
                const float af = Ssh[(16 * ib + l16) * 65 + 4 * kk + lq];
                const float b0 = Psh[(4 * kk + lq) * 64 + 16 * jb0 + l16], b1 = Psh[(4 * kk + lq) * 64 + 16 * (jb0 + 1) + l16];
                n0 = __builtin_amdgcn_mfma_f32_16x16x4f32(af, b0, n0, 0, 0, 0);
                n1 = __builtin_amdgcn_mfma_f32_16x16x4f32(af, b1, n1, 0, 0, 0);
            }
        }
        WG_BAR_LDS();
        S0 = n0; S1 = n1;
    }
    float* so = a.out + O_PWKV + (size_t)chain * 4096;
#pragma unroll
    for (int i = 0; i < 4; ++i) { const int row = 16 * ib + 4 * lq + i; so[row * 64 + 16 * jb0 + l16] = S0[i]; so[row * 64 + 16 * (jb0 + 1) + l16] = S1[i]; }
}
DI bf16x8 cvt8(const f32x4 lo, const f32x4 hi) { u32x4 p; p.x = pk2(lo.x, lo.y); p.y = pk2(lo.z, lo.w); p.z = pk2(hi.x, hi.y); p.w = pk2(hi.z, hi.w); return __builtin_bit_cast(bf16x8, p); }
DI void scan_pass3_unit(const Args& a, int unit, int lane) {
    const float* SST = (const float*)(a.ws + WS_SST); const bf16_t* YL = (const bf16_t*)(a.ws + WS_YL); const bf16_t* QS = (const bf16_t*)(a.ws + WS_QS); const bf16_t* GB = (const bf16_t*)(a.ws + WS_GB);
    bf16_t* O = (bf16_t*)(a.ws + WS_O);
    const int sub = unit & 3, pair = unit >> 2, chain = pair / NS, seg = pair % NS, b = chain >> 4, h = chain & 15;
    const int r = lane & 31, hh = lane >> 5;
    const int m = b * SEQ + seg * SEGL + sub * 32 + r;
    f32x16 acc0, acc1;
#pragma unroll
    for (int i = 0; i < 16; ++i) { acc0[i] = 0.f; acc1[i] = 0.f; }
    const bf16_t* qrow = QS + (size_t)m * 1024 + h * 64 + 8 * hh;
    const float* s0 = SST + (size_t)pair * 4096 + (size_t)r * 64 + 8 * hh; const float* s1 = s0 + 32 * 64;
#pragma unroll
    for (int ks = 0; ks < 4; ++ks) {
        const bf16x8 qf = *(const bf16x8*)(qrow + ks * 16);
        const bf16x8 a0 = cvt8(*(const f32x4*)(s0 + ks * 16), *(const f32x4*)(s0 + ks * 16 + 4));
        const bf16x8 a1 = cvt8(*(const f32x4*)(s1 + ks * 16), *(const f32x4*)(s1 + ks * 16 + 4));
        acc0 = __builtin_amdgcn_mfma_f32_32x32x16_bf16(a0, qf, acc0, 0, 0, 0);
        acc1 = __builtin_amdgcn_mfma_f32_32x32x16_bf16(a1, qf, acc1, 0, 0, 0);
    }
    const bf16_t* yl = YL + (size_t)m * 1024 + h * 64 + 4 * hh;
    float y[32]; float sum = 0.f;
#pragma unroll
    for (int rt = 0; rt < 2; ++rt)
#pragma unroll
        for (int g = 0; g < 4; ++g) { const u32x2 yw = *(const u32x2*)(yl + rt * 32 + 8 * g); const f32x4 v = {__uint_as_float(yw.x << 16), __uint_as_float(yw.x & 0xffff0000u), __uint_as_float(yw.y << 16), __uint_as_float(yw.y & 0xffff0000u)};
#pragma unroll
            for (int e = 0; e < 4; ++e) { const float yy = v[e] + (rt == 0 ? acc0[4 * g + e] : acc1[4 * g + e]); y[rt * 16 + 4 * g + e] = yy; sum += yy; } }
    sum += __shfl_xor(sum, 32);
    const float mean = sum * (1.f / 64.f);
    float vs = 0.f;
#pragma unroll
    for (int e = 0; e < 32; ++e) { y[e] -= mean; vs += y[e] * y[e]; }
    vs += __shfl_xor(vs, 32);
    const float rstd = rsqrtf(vs * (1.f / 64.f) + 64e-5f);
    const bf16_t* gb = GB + ((size_t)m * 16 + h) * 128 + 4 * hh;
    const float* lw = a.in[I_LNW] + h * 64 + 4 * hh; const float* lb = a.in[I_LNB] + h * 64 + 4 * hh;
    bf16_t* orow = O + (size_t)m * D + 1024 + h * 64 + 4 * hh;
    f32x4 w4s[8], b4s[8]; u32x2 gws[8], bws[8];
#pragma unroll
    for (int q = 0; q < 8; ++q) { const int off = (q >> 2) * 32 + 8 * (q & 3); w4s[q] = *(const f32x4*)(lw + off); b4s[q] = *(const f32x4*)(lb + off); gws[q] = *(const u32x2*)(gb + off); bws[q] = *(const u32x2*)(gb + 64 + off); }
#pragma unroll
    for (int rt = 0; rt < 2; ++rt)
#pragma unroll
        for (int g = 0; g < 4; ++g) {
            const int off = rt * 32 + 8 * g;
            const f32x4 w4 = w4s[rt * 4 + g], b4 = b4s[rt * 4 + g];
            const u32x2 gw = gws[rt * 4 + g], bw = bws[rt * 4 + g];
            const float gg[4] = {__uint_as_float(gw.x << 16), __uint_as_float(gw.x & 0xffff0000u), __uint_as_float(gw.y << 16), __uint_as_float(gw.y & 0xffff0000u)};
            const float bb[4] = {__uint_as_float(bw.x << 16), __uint_as_float(bw.x & 0xffff0000u), __uint_as_float(bw.y << 16), __uint_as_float(bw.y & 0xffff0000u)};
            float o[4];
#pragma unroll
            for (int e = 0; e < 4; ++e) o[e] = (y[rt * 16 + 4 * g + e] * rstd * w4[e] + b4[e] + bb[e]) * gg[e];
            u32x2 w; w.x = pk2(o[0], o[1]); w.y = pk2(o[2], o[3]);
            *(u32x2*)(orow + off) = w;
        }
}

DI void unpack8(const u32x4 w, float (&u)[8]) {
    u[0] = __uint_as_float(w.x << 16); u[1] = __uint_as_float(w.x & 0xffff0000u); u[2] = __uint_as_float(w.y << 16); u[3] = __uint_as_float(w.y & 0xffff0000u);
    u[4] = __uint_as_float(w.z << 16); u[5] = __uint_as_float(w.z & 0xffff0000u); u[6] = __uint_as_float(w.w << 16); u[7] = __uint_as_float(w.w & 0xffff0000u);
}
constexpr int FIX_ROWS = 28 * 2 + MS + 8;
DI void conv_fix(const Args& a, int idx) {
    const int fg = idx % (FF / 8), ri = idx / (FF / 8), f = fg * 8;
    if (ri >= FIX_ROWS) return;
    const float* EDGE = (const float*)(a.ws + WS_U); bf16_t* ACT = (bf16_t*)(a.ws + WS_ACT);
    const float* cw = a.in[I_FCW]; const float* cb = a.in[I_FCB];
    const float *p0, *p1, *p2; int m;
    if (ri < 56) {
        const int ti = ri >> 1, k = ri & 1, pm = ti + 1 + ti / 7;
        m = pm * 256 + k;
        p0 = EDGE + ((size_t)pm * 4 + k) * FF2;
        p1 = k == 0 ? EDGE + ((size_t)(pm - 1) * 4 + 3) * FF2 : EDGE + ((size_t)pm * 4 + 0) * FF2;
        p2 = k == 0 ? EDGE + ((size_t)(pm - 1) * 4 + 2) * FF2 : EDGE + ((size_t)(pm - 1) * 4 + 3) * FF2;
    } else if (ri >= 56 + MS) {
        const int q = ri - 56 - MS, bb = q >> 1, k = q & 1;
        const float* src = EDGE + ((size_t)(bb * 8 + 7) * 4 + 2 + k) * FF2; float* dst = a.out + O_PFFN + ((size_t)bb * 2 + k) * FF2;
#pragma unroll
        for (int p = 0; p < 2; ++p) { *(f32x4*)(dst + p * FF + f) = *(const f32x4*)(src + p * FF + f); *(f32x4*)(dst + p * FF + f + 4) = *(const f32x4*)(src + p * FF + f + 4); }
        return;
    } else {
        const int b = ri - 56; m = MP + b;
        p0 = EDGE + (size_t)(128 + b) * FF2;
        { float* s1 = a.out + O_SFFN + (size_t)b * 2 * FF2 + FF2;
#pragma unroll
          for (int p = 0; p < 2; ++p) { *(f32x4*)(s1 + p * FF + f) = *(const f32x4*)(p0 + p * FF + f); *(f32x4*)(s1 + p * FF + f + 4) = *(const f32x4*)(p0 + p * FF + f + 4); } }
        p1 = a.in[I_SFFN] + (size_t)b * 2 * FF2 + FF2;
        p2 = a.in[I_SFFN] + (size_t)b * 2 * FF2;
        float* so = a.out + O_SFFN + (size_t)b * 2 * FF2;
#pragma unroll
        for (int p = 0; p < 2; ++p) { *(f32x4*)(so + p * FF + f) = *(const f32x4*)(p1 + p * FF + f); *(f32x4*)(so + p * FF + f + 4) = *(const f32x4*)(p1 + p * FF + f + 4); }
    }
    float c[2][8];
#pragma unroll
    for (int p = 0; p < 2; ++p)
#pragma unroll
        for (int j = 0; j < 8; ++j) { const int col = p * FF + f + j; c[p][j] = cb[col] + cw[col] * p2[col] + cw[FF2 + col] * p1[col] + cw[2 * FF2 + col] * p0[col]; }
    float o[8];
#pragma unroll
    for (int j = 0; j < 8; ++j) o[j] = c[0][j] * __builtin_amdgcn_rcpf(1.f + __expf(-c[0][j])) * c[1][j];
    u32x4 w; w.x = pk2(o[0], o[1]); w.y = pk2(o[2], o[3]); w.z = pk2(o[4], o[5]); w.w = pk2(o[6], o[7]);
    *(u32x4*)(ACT + (size_t)m * FF + f) = w;
}

#define XB_TMO      128
#define XB_XCNT(j)  (256  + 64 * (j))
#define XB_XSUB(j)  (1280 + 64 * (j))
#define XB_XGEN(j)  (2304 + 64 * (j))
#define XB_TOP      3328
#define XB_TOPGEN   3392
#define XCD_BAR_WORDS 3456
#define XB_SPIN_CAP (1u << 18)
DI unsigned xb_ld(unsigned* p)              { return __hip_atomic_load(p, __ATOMIC_RELAXED, __HIP_MEMORY_SCOPE_AGENT); }
DI unsigned xb_add(unsigned* p, unsigned v) { return __hip_atomic_fetch_add(p, v, __ATOMIC_RELAXED, __HIP_MEMORY_SCOPE_AGENT); }
DI unsigned xb_xcc_id() { return (unsigned)__builtin_amdgcn_s_getreg((3 << 11) | 20) & 0xFu; }
#define XB_SPIN(cond, bar) do { unsigned _sp = 0; while (cond) { __builtin_amdgcn_s_sleep(1); \
    if ((++_sp & 255u) == 0u) { if (xb_ld(&(bar)[XB_TMO])) break; if (_sp > XB_SPIN_CAP) { atomicAdd(&(bar)[XB_TMO], 1u); break; } } } } while (0)
struct XcdBarrier { unsigned* bar; unsigned x; volatile LAS unsigned* st; };
DI XcdBarrier xcd_barrier_post(unsigned* bar, volatile LAS unsigned* st) {
    XcdBarrier b; b.bar = bar; b.x = xb_xcc_id(); b.st = st;
    if (threadIdx.x == 0) (void)xb_add(&bar[XB_XCNT(b.x)], 1u);
    return b;
}
DI void xcd_barrier_complete(unsigned* bar, unsigned x, unsigned& nloc, unsigned& nx) {
    const unsigned G = gridDim.x * gridDim.y * gridDim.z;
    unsigned sum, cnt, mine, sp = 0u;
    for (;;) {
        sum = 0u; cnt = 0u; mine = 0u;
#pragma unroll
        for (unsigned j = 0; j < 16; ++j) { const unsigned c = xb_ld(&bar[XB_XCNT(j)]); sum += c; cnt += (c > 0u) ? 1u : 0u; mine = (j == x) ? c : mine; }
        if (sum == G) break;
        __builtin_amdgcn_s_sleep(1);
        if ((++sp & 255u) == 0u) { if (xb_ld(&bar[XB_TMO])) break; if (sp > XB_SPIN_CAP) { atomicAdd(&bar[XB_TMO], 1u); break; } }
    }
    nloc = mine > 0u ? mine : 1u; nx = cnt > 0u ? cnt : 1u;
}
DI void xcd_barrier(const XcdBarrier& b) {
    asm volatile("s_waitcnt vmcnt(0)" ::: "memory");
    __syncthreads();
    if (threadIdx.x == 0) {
        unsigned* bar = b.bar;
        __builtin_amdgcn_s_waitcnt(0);
        unsigned nloc = b.st[0], nx = b.st[1];
        if (nloc == 0u) { xcd_barrier_complete(bar, b.x, nloc, nx); b.st[0] = nloc; b.st[1] = nx; }
        const unsigned old = xb_add(&bar[XB_XSUB(b.x)], 1u);
        const unsigned gen = old / nloc;
        if (old + 1u == (gen + 1u) * nloc) {
            __builtin_amdgcn_fence(__ATOMIC_RELEASE, "agent");
            asm volatile("s_waitcnt vmcnt(0)" ::: "memory");
            const unsigned og = xb_add(&bar[XB_TOP], 1u);
            const unsigned tg = og / nx;
            if (og + 1u == (tg + 1u) * nx) xb_add(&bar[XB_TOPGEN], 1u);
            else XB_SPIN(xb_ld(&bar[XB_TOPGEN]) == tg, bar);
            __builtin_amdgcn_fence(__ATOMIC_ACQUIRE, "agent");
            xb_add(&bar[XB_XGEN(b.x)], 1u);
            asm volatile("s_waitcnt vmcnt(0)" ::: "memory");
        } else {
            XB_SPIN(xb_ld(&bar[XB_XGEN(b.x)]) == gen, bar);
            __builtin_amdgcn_fence(__ATOMIC_ACQUIRE, "agent");
            asm volatile("s_waitcnt vmcnt(0)" ::: "memory");
        }
    }
    __syncthreads();
}

DI void skinny_unit(const bf16_t* A, int lda, const bf16_t* Bt, int K, int unit, const float* base, int ldb, float* out, int ldo, unsigned char* lds, int wave, int lane,
                    const float* gf = nullptr, bf16_t* H = nullptr, float* RSS = nullptr) {
    float* red = (float*)lds;
    const int n0 = unit * 32, r = lane & 31, hh = lane >> 5, kw = K / 8, kb = wave * kw;
    f32x16 acc;
#pragma unroll
    for (int i = 0; i < 16; ++i) acc[i] = 0.f;
    const bf16_t* ap = A + (size_t)r * lda + kb + 8 * hh; const bf16_t* bp = Bt + (size_t)(n0 + r) * K + kb + 8 * hh;
    for (int k0 = 0; k0 < kw; k0 += 128) {
        bf16x8 af[8], bf[8];
#pragma unroll
        for (int i = 0; i < 8; ++i) { const int k = k0 + 16 * i < kw ? k0 + 16 * i : 0; af[i] = *(const bf16x8*)(ap + k); bf[i] = *(const bf16x8*)(bp + k); }
#pragma unroll
        for (int i = 0; i < 8; ++i) if (k0 + 16 * i < kw) acc = __builtin_amdgcn_mfma_f32_32x32x16_bf16(af[i], bf[i], acc, 0, 0, 0);
    }
#pragma unroll
    for (int i = 0; i < 16; ++i) red[(wave * 16 + i) * 64 + lane] = acc[i];
    __syncthreads();
#pragma unroll
    for (int q = 0; q < 2; ++q) {
        const int o = threadIdx.x + 512 * q, i = o >> 6, ln = o & 63;
        float sum = 0.f;
#pragma unroll
        for (int w = 0; w < 8; ++w) sum += red[(w * 16 + i) * 64 + ln];
        const int row = crow(i, ln >> 5), col = n0 + (ln & 31);
        const float x1 = base[(size_t)row * ldb + col] + sum * (H ? 1.0f : MK_P11_SCALE);
        out[(size_t)row * ldo + col] = x1;
        if (H) { H[(size_t)row * D + col] = (bf16_t)bf_rne(x1 * gf[col]);
            float ss = x1 * x1;
            ss += __shfl_xor(ss, 1); ss += __shfl_xor(ss, 2); ss += __shfl_xor(ss, 4); ss += __shfl_xor(ss, 8); ss += __shfl_xor(ss, 16);
            if ((ln & 31) == 0) atomic_add_f32(RSS + row, ss); }
    }
    __syncthreads();
}

constexpr int NPH = 14;
template <bool COOP>
__global__ void __launch_bounds__(NTHREADS, 2) mk_fwd(Args a) {
    extern __shared__ __attribute__((aligned(16))) unsigned char lds[];
    const int tid = threadIdx.x, lane = tid & 63, wave = __builtin_amdgcn_readfirstlane(tid >> 6);
    const int G = gridDim.x, bid = blockIdx.x, gw = bid * NWAVES + wave, ngw = G * NWAVES;
    unsigned char* ws = a.ws;
    LAS unsigned char* ldsl = (LAS unsigned char*)lds;
#ifndef PHMASK
#define PHMASK 0xffff
#endif
#define IN(k) (((PHMASK >> (k)) & 1) && a.ph_lo <= (k) && (k) < a.ph_hi)
    XcdBarrier xbar; xbar.bar = (unsigned*)(ws + WS_BAR); xbar.x = 0; xbar.st = nullptr;
    if (COOP) {
        volatile LAS unsigned* st = (volatile LAS unsigned*)(ldsl + LDS_BYTES - 16);
        if (tid < 4) st[tid] = 0u;
        __syncthreads();
        xbar = xcd_barrier_post((unsigned*)(ws + WS_BAR), st);
    }
#define SEAM(k) do { if (COOP && IN(k) && IN((k) + 1)) { if (a.ph_hi > 1000) cg::this_grid().sync(); else xcd_barrier(xbar); } } while (0)

    if (IN(0)) phase_prologue(a, lds, gw, ngw, lane, wave);
    SEAM(0);
    if (IN(1)) {
        pg8::Gemm g{(const bf16_t*)(ws + WS_H), (const bf16_t*)(ws + WS_WIN), MPAD, NIN, D}; pg8::StaticOrder S; S.init(MPAD, NIN, G, bid);
        EpiIn E{(bf16_t*)(ws + WS_QB), (bf16_t*)(ws + WS_KB), (bf16_t*)(ws + WS_VB), (bf16_t*)(ws + WS_RW), a.out};
        pg8::gemm_phase<EpiIn>(ldsl, g, S, E);
        {
            const int nu = (MPAD / 256) * (NIN / 256), rem = nu % G, first = rem == 0 ? 0 : rem, nfree = G - first;
            if (bid >= first) convert_wo_wup(a, lds, (bid - first) * NWAVES + wave, nfree * NWAVES, wave, lane);
        }
    }
    SEAM(1);
    if (IN(2)) {
        for (int u = bid; u < 256; u += G) attn_sample_wg(a, lds, u, wave, lane);
        {
            const int vb = (G % 8 == 0) ? (bid % 8) * (G / 8) + bid / 8 : bid;
            for (int u = vb * NWAVES + wave; u < 64 * 3 * 64; u += ngw) attn_prompt_unit(a, lds, u, wave, lane);
        }
        for (int m = gw; m < MPAD; m += ngw) lora_input_row(a, m, lane);
    }
    SEAM(2);
    if (IN(3)) {
        pg8::Gemm g{(const bf16_t*)(ws + WS_ALO), (const bf16_t*)(ws + WS_WLO), MPAD, NLO, KLO}; pg8::StaticOrder S; S.init(MPAD, NLO, G, bid);
        EpiBf E{(bf16_t*)(ws + WS_L), NLO};
        pg8::gemm_phase<EpiBf>(ldsl, g, S, E);
#pragma unroll 2
        for (int t = gw; t < MP * 4; t += ngw) attn_merge_task(a, t, lane);
    }
    SEAM(3);
    if (IN(4)) {
#ifndef NO_P1
        for (int u = bid; u < 64 * NS / 4; u += G) scan_pass1_unit(a, lds, u, wave, lane);
#endif

    }
    SEAM(4);
    if (IN(5)) {
        if (G >= 128) {
            if (bid < 64) scan_pass2_unit(a, lds, bid, wave, lane);
            else for (int u = (bid - 64) * NWAVES + wave; u < 512; u += (G - 64) * NWAVES) scan_sample_unit(a, lds, u, wave, lane);
        } else {
            for (int ch = bid; ch < 64; ch += G) scan_pass2_unit(a, lds, ch, wave, lane);
            for (int u = gw; u < 512; u += ngw) scan_sample_unit(a, lds, u, wave, lane);
        }
    }
    SEAM(5);
    if (IN(6)) { for (int u = gw; u < 64 * NS * 4; u += ngw) scan_pass3_unit(a, u, lane); }
    SEAM(6);
    if (IN(7)) {
        pg8::Gemm g{(const bf16_t*)(ws + WS_O), (const bf16_t*)(ws + WS_WO), MP, D, D}; pg8::StaticOrder S; S.init(MP, D, G, bid);
        EpiWo E{a.in[I_XP], a.in[I_NFG], (float*)(ws + WS_X1), (bf16_t*)(ws + WS_H), (float*)(ws + WS_RSS)};
        pg8::gemm_phase<EpiWo>(ldsl, g, S, E);
        for (int u = bid; u < D / 32; u += G)
            skinny_unit((const bf16_t*)(ws + WS_O) + (size_t)MP * D, D, (const bf16_t*)(ws + WS_WO), D, u, a.in[I_XS], D, (float*)(ws + WS_X1) + (size_t)MP * D, D, lds, wave, lane,
                        a.in[I_NFG], (bf16_t*)(ws + WS_H) + (size_t)MP * D, (float*)(ws + WS_RSS) + MP);
    }
    SEAM(7);
    if (IN(9)) {
        pg8::Gemm g{(const bf16_t*)(ws + WS_H), (const bf16_t*)(ws + WS_WUP), MPAD, FF2, D}; pg8::StaticOrder S; S.init(MPAD, FF2, G, bid);
        EpiUpF E{(bf16_t*)(ws + WS_ACT), a.out, (const float*)(ws + WS_RSS), a.in[I_FCW], a.in[I_FCB], (float*)(ws + WS_U), (LAS float*)(ldsl + 131072)};
        pg8::gemm_phase<EpiUpF>(ldsl, g, S, E);
        {
            const int nu = (MPAD / 256) * (FF2 / 256), rem = nu % G, first = rem == 0 ? 0 : rem, nfree = G - first;
            if (bid >= first) convert_wdn(a, lds, (bid - first) * NWAVES + wave, nfree * NWAVES, wave, lane);
        }
    }
    SEAM(9);
    if (IN(10)) { for (int it = bid * NTHREADS + tid; it < FIX_ROWS * (FF / 8); it += G * NTHREADS) conv_fix(a, it); }
    SEAM(10);
    if (IN(11)) {
        pg8::Gemm g{(const bf16_t*)(ws + WS_ACT), (const bf16_t*)(ws + WS_WDN), MP, D, FF}; pg8::StaticOrder S; S.init(MP, D, G, bid);
        EpiDn E{(float*)(ws + WS_X1)};
        pg8::gemm_phase<EpiDn>(ldsl, g, S, E);
        for (int u = bid; u < D / 32; u += G)
            skinny_unit((const bf16_t*)(ws + WS_ACT) + (size_t)MP * FF, FF, (const bf16_t*)(ws + WS_WDN), FF, u, (const float*)(ws + WS_X1) + (size_t)MP * D, D, (float*)(ws + WS_X1) + (size_t)MP * D, D, lds, wave, lane);
    }
    SEAM(11);
    if (IN(12)) {
        for (int m = gw; m < MT; m += ngw)
            rms_row_f32((const float*)(ws + WS_X1) + (size_t)m * D, a.in[I_NFIN], m < MP ? a.out + O_YP + (size_t)m * D : a.out + O_YS + (size_t)(m - MP) * D, lane);
    }
#undef IN
#undef SEAM
}

#ifndef MK_ONE_LAUNCH
#define MK_ONE_LAUNCH 1
#endif
#ifndef MK_DBL_MASK
#define MK_DBL_MASK 0x0
#endif

extern "C" void kernel_launch(void* const* d_in, const int* in_sizes, int n_in, void* d_out, int out_size, void* d_ws, size_t ws_size, hipStream_t stream) {
    static int grid = 0;
    if (!grid) {
        if (n_in != 28 || (size_t)out_size != O_END || ws_size < WS_END) fprintf(stderr, "kernel_launch: unexpected shapes: n_in %d out %d (want %zu) ws %zu (want %zu)\n", n_in, out_size, O_END, ws_size, WS_END);
        int dev = 0, cus = 0; hipGetDevice(&dev); hipDeviceGetAttribute(&cus, hipDeviceAttributeMultiprocessorCount, dev);
        hipFuncSetAttribute((const void*)mk_fwd<true>, hipFuncAttributeMaxDynamicSharedMemorySize, LDS_BYTES);
        hipFuncSetAttribute((const void*)mk_fwd<false>, hipFuncAttributeMaxDynamicSharedMemorySize, LDS_BYTES);
        int per_cu = 0; hipOccupancyMaxActiveBlocksPerMultiprocessor(&per_cu, mk_fwd<true>, NTHREADS, LDS_BYTES);
        if (per_cu < 1) { fprintf(stderr, "kernel_launch: occupancy query says %d blocks/CU\n", per_cu); per_cu = 1; }
        grid = cus > 0 ? cus : 256;
    }
    Args a; memset(&a, 0, sizeof(a));
    for (int i = 0; i < 28; ++i) a.in[i] = (const float*)d_in[i];
    a.out = (float*)d_out; a.ws = (unsigned char*)d_ws;
#if MK_ONE_LAUNCH
    if (hipMemsetAsync((char*)d_ws + WS_BAR, 0, BAR_BYTES, stream) != hipSuccess) { fprintf(stderr, "kernel_launch: memset of the barrier words failed\n"); return; }
    a.ph_lo = 0; a.ph_hi = NPH;
    void* args[] = {&a};
    hipError_t e = hipLaunchCooperativeKernel((const void*)mk_fwd<true>, dim3(grid), dim3(NTHREADS), args, LDS_BYTES, stream);
    if (e != hipSuccess) fprintf(stderr, "cooperative launch failed: %s (grid %d)\n", hipGetErrorString(e), grid);
#else
    for (int p = 0; p < 13; ++p) {
        a.ph_lo = p; a.ph_hi = p + 1;
        mk_fwd<false><<<dim3(grid), dim3(NTHREADS), LDS_BYTES, stream>>>(a);
        if ((MK_DBL_MASK >> p) & 1) mk_fwd<false><<<dim3(grid), dim3(NTHREADS), LDS_BYTES, stream>>>(a);
    }
#endif
}
```
